# Optimizing an MI355X kernel written in HIP

```python
import math
import jax, jax.numpy as jnp
from jax import lax
import numpy as np

D_MODEL = 1024
BATCH = 2
SEQ = 8192
DEPTH = 2

GRID_W = 64
CTX_LEN = 256
HEAD_DIM = 64
N_BRANCH = 4
BRANCH_W = 256
NA_HEADS = 4
WIN_H = 8
WIN_W = 16
DIFF_HEADS = 4
DIFF_QK_DIM = 32
DIFF_V_DIM = 64
SGU_GROUPS = 4
SGU_CHUNK = 128
GQA_Q_HEADS = 4
GQA_KV_HEADS = 2
GQA_GROUP = GQA_Q_HEADS // GQA_KV_HEADS
ROPE_THETA = 10000.0
Q_BLOCK = 128
N_EXPERTS = 16
EXPERT_HIDDEN = 2048
CAPACITY_FACTOR = 2
EPS = 1e-6

NA_W = NA_HEADS * HEAD_DIM
DIFF_QK_W = DIFF_HEADS * 2 * DIFF_QK_DIM
DIFF_V_W = DIFF_HEADS * DIFF_V_DIM
GQA_Q_W = GQA_Q_HEADS * HEAD_DIM
GQA_KV_W = GQA_KV_HEADS * HEAD_DIM
GATE_W = N_BRANCH * D_MODEL
MAIN_W = NA_W + DIFF_QK_W + GQA_Q_W + 2 * BRANCH_W + GATE_W
KV_W = 2 * NA_W + DIFF_QK_W + DIFF_V_W + 2 * GQA_KV_W
IN_W = MAIN_W + KV_W

kernel_name = 'hybrid_parallel_mixers_ec_moe_dit'


def _split(t, sizes):
    out, start = [], 0
    for n in sizes:
        out.append(t[..., start:start + n])
        start += n
    return out


def rms_norm(x, g):
    xf = x.astype(jnp.float32)
    y = xf * lax.rsqrt(jnp.mean(xf * xf, axis=-1, keepdims=True) + EPS)
    return (y * g.astype(jnp.float32)).astype(x.dtype)


def layer_norm(x, g):
    xf = x.astype(jnp.float32)
    mu = jnp.mean(xf, axis=-1, keepdims=True)
    var = jnp.mean(jnp.square(xf - mu), axis=-1, keepdims=True)
    return ((xf - mu) * lax.rsqrt(var + EPS) * g.astype(jnp.float32)).astype(x.dtype)


def modulate(h, shift, scale):
    return h * (1 + scale) + shift


def to_heads(t, n):
    b, s, _ = t.shape
    return t.reshape(b, s, n, -1).transpose(0, 2, 1, 3)


def from_heads(t):
    b, h, s, d = t.shape
    return t.transpose(0, 2, 1, 3).reshape(b, s, h * d)


def to_diff_heads(t):
    b, s, _ = t.shape
    return t.reshape(b, s, DIFF_HEADS, 2, DIFF_QK_DIM).transpose(0, 2, 3, 1, 4)


def axial_rope_tables(n, dim):
    t = jnp.arange(n)
    row = (t // GRID_W).astype(jnp.float32)
    col = (t % GRID_W).astype(jnp.float32)
    n_pairs = dim // 4
    inv = ROPE_THETA ** (-jnp.arange(n_pairs, dtype=jnp.float32) / n_pairs)
    ang = jnp.concatenate([row[:, None] * inv, col[:, None] * inv], axis=-1)
    return (jnp.cos(ang), jnp.sin(ang))


def apply_rope(x, rope):
    cos, sin = rope
    xf = x.astype(jnp.float32).reshape(x.shape[:-1] + (x.shape[-1] // 2, 2))
    x0, x1 = xf[..., 0], xf[..., 1]
    out = jnp.stack([x0 * cos - x1 * sin, x0 * sin + x1 * cos], axis=-1)
    return out.reshape(x.shape).astype(x.dtype)


def sweep_query_blocks(fn, q):
    s = q.shape[-2]
    nb = s // Q_BLOCK
    qb = jnp.moveaxis(q.reshape(q.shape[:-2] + (nb, Q_BLOCK, q.shape[-1])), -3, 0)
    out = lax.map(fn, qb)
    out = jnp.moveaxis(out, 0, -3)
    return out.reshape(out.shape[:-3] + (s, out.shape[-1]))


def gqa_attention(q, k, v):
    scale = q.shape[-1] ** -0.5

    def block(qb):
        sc = jnp.einsum('bkgqd,bksd->bkgqs', qb, k).astype(jnp.float32) * scale
        p = jax.nn.softmax(sc, axis=-1).astype(v.dtype)
        return jnp.einsum('bkgqs,bksd->bkgqd', p, v)

    return sweep_query_blocks(block, q)


def diff_attention(q, k, v, lam):
    scale = q.shape[-1] ** -0.5

    def block(qb):
        sc = jnp.einsum('bhmqd,bhmsd->bhmqs', qb, k).astype(jnp.float32) * scale
        p = jax.nn.softmax(sc, axis=-1)
        a = p[:, :, 0] - lam * p[:, :, 1]
        return jnp.einsum('bhqs,bhsd->bhqd', a.astype(v.dtype), v)

    return sweep_query_blocks(block, q)


def neighbourhood_attention(q, k, v, kc, vc, rpb):
    b, h, s, d = q.shape
    n_ctx = kc.shape[2]
    rows = s // GRID_W
    kh, kw = min(WIN_H, rows), WIN_W
    scale = d ** -0.5
    qg = q.reshape(b, h, rows, GRID_W, d)
    kg = k.reshape(b, h, rows, GRID_W, d)
    vg = v.reshape(b, h, rows, GRID_W, d)
    cols = jnp.arange(GRID_W)
    c0 = jnp.clip(cols - kw // 2, 0, GRID_W - kw)
    cidx = c0[:, None] + jnp.arange(kw)[None, :]
    col_bias = rpb[:, :, cidx - cols[:, None] + WIN_W - 1]

    def row_block(args):
        r, q_row = args
        r0 = jnp.clip(r - kh // 2, 0, rows - kh)
        k_rows = lax.dynamic_slice_in_dim(kg, r0, kh, axis=2)
        v_rows = lax.dynamic_slice_in_dim(vg, r0, kh, axis=2)
        k_win = k_rows[:, :, :, cidx]
        v_win = v_rows[:, :, :, cidx]
        bias = jnp.take(col_bias, r0 + jnp.arange(kh) - r + WIN_H - 1, axis=1)
        s_loc = (jnp.einsum('bhqd,bhiqjd->bhqij', q_row, k_win).astype(jnp.float32) * scale
                 + bias.transpose(0, 2, 1, 3)[None].astype(jnp.float32))
        s_ctx = jnp.einsum('bhqd,bhld->bhql', q_row, kc).astype(jnp.float32) * scale
        p = jax.nn.softmax(jnp.concatenate([s_ctx, s_loc.reshape(b, h, GRID_W, kh * kw)], axis=-1), axis=-1)
        p = p.astype(v.dtype)
        p_ctx = p[..., :n_ctx]
        p_loc = p[..., n_ctx:].reshape(b, h, GRID_W, kh, kw)
        return (jnp.einsum('bhql,bhld->bhqd', p_ctx, vc)
                + jnp.einsum('bhqij,bhiqjd->bhqd', p_loc, v_win))

    out = lax.map(row_block, (jnp.arange(rows), jnp.moveaxis(qg, 2, 0)))
    return jnp.moveaxis(out, 0, 2).reshape(b, h, s, d)


def spatial_gating(u, v, norm_g, w_s, b_s):
    b, s, w = v.shape
    n = s // SGU_CHUNK
    vn = layer_norm(v, norm_g).reshape(b, n, SGU_CHUNK, SGU_GROUPS, w // SGU_GROUPS)
    mixed = jnp.einsum('gpq,bnqgc->bnpgc', w_s, vn) + b_s.T[:, :, None]
    return u * mixed.reshape(b, s, w)


def expert_choice_moe(h, w_router, w_gate, w_up, w_down):
    b, n, d = h.shape
    cap = CAPACITY_FACTOR * n // N_EXPERTS
    aff = jax.nn.softmax((h @ w_router).astype(jnp.float32), axis=-1)
    score, idx = lax.top_k(jnp.swapaxes(aff, 1, 2), cap)
    xin = jax.vmap(lambda hb, ib: hb[ib])(h, idx)
    hid = (jax.nn.silu(jnp.einsum('becd,edf->becf', xin, w_gate))
           * jnp.einsum('becd,edf->becf', xin, w_up))
    y = jnp.einsum('becf,efd->becd', hid, w_down) * score[..., None].astype(h.dtype)
    return jax.vmap(lambda yb, ib: jnp.zeros((n, d), yb.dtype).at[ib.reshape(-1)].add(yb.reshape(-1, d)))(y, idx)


def kv_heads(p_kv, k_gain, ropes):
    ka, va, kb, vb, kd, vd = _split(p_kv, (NA_W, NA_W, DIFF_QK_W, DIFF_V_W, GQA_KV_W, GQA_KV_W))
    kb = to_diff_heads(kb)
    kd = rms_norm(to_heads(kd, GQA_KV_HEADS), k_gain)
    if ropes is not None:
        kb = apply_rope(kb, ropes[0])
        kd = apply_rope(kd, ropes[1])
    return (to_heads(ka, NA_HEADS), to_heads(va, NA_HEADS), kb, to_heads(vb, DIFF_HEADS),
            kd, to_heads(vd, GQA_KV_HEADS))


def token_mixer(p_main, kv, kv_ctx, ropes, q_gain, rpb, lam, lam_init, sub_g, sgu_g, sgu_w, sgu_b,
                gate_b, w_branch, w_out):
    b, s, _ = p_main.shape
    qa, qb, qd, u, v, gate_logits = _split(p_main, (NA_W, DIFF_QK_W, GQA_Q_W, BRANCH_W, BRANCH_W, GATE_W))
    ka, va, kb, vb, kd, vd = kv
    qa = to_heads(qa, NA_HEADS)
    qb = to_diff_heads(qb)
    qd = rms_norm(to_heads(qd, GQA_Q_HEADS), q_gain)
    if kv_ctx is None:
        y_a = gqa_attention(qa[:, :, None], ka, va)[:, :, 0]
    else:
        qb = apply_rope(qb, ropes[0])
        qd = apply_rope(qd, ropes[1])
        kac, vac, kbc, vbc, kdc, vdc = kv_ctx
        y_a = neighbourhood_attention(qa, ka, va, kac, vac, rpb)
        kb = jnp.concatenate([kbc, kb], axis=3)
        vb = jnp.concatenate([vbc, vb], axis=2)
        kd = jnp.concatenate([kdc, kd], axis=2)
        vd = jnp.concatenate([vdc, vd], axis=2)
    y_b = rms_norm(diff_attention(qb, kb, vb, lam), sub_g) * (1.0 - lam_init)
    y_c = spatial_gating(jax.nn.gelu(u), jax.nn.gelu(v), sgu_g, sgu_w, sgu_b)
    y_d = gqa_attention(qd.reshape(b, GQA_KV_HEADS, GQA_GROUP, s, HEAD_DIM), kd, vd)
    y_d = y_d.reshape(b, GQA_Q_HEADS, s, HEAD_DIM)
    ys = jnp.stack([from_heads(y_a), from_heads(y_b), y_c, from_heads(y_d)], axis=2)
    proj = jnp.einsum('bsnc,ncd->bsnd', ys, w_branch)
    gates = jax.nn.sigmoid((gate_logits + gate_b).astype(jnp.float32)).astype(proj.dtype)
    gates = gates.reshape(b, s, N_BRANCH, D_MODEL)
    return jnp.einsum('bsnd,bsnd->bsd', gates, proj) @ w_out


def setup_inputs(seed: int = 0) -> dict:
    key = jax.random.key(seed)
    ks = jax.random.split(key, 28)
    L, D = DEPTH, D_MODEL

    def nrm(k, shape, s):
        return jax.random.normal(k, shape, jnp.float32) * s

    return {
        'x': nrm(ks[0], (BATCH, SEQ, D), 1.0),
        'c': nrm(ks[1], (BATCH, D), 1.0),
        'ctx': nrm(ks[2], (BATCH, CTX_LEN, D), 1.0),
        'c_ctx': nrm(ks[3], (D,), 1.0),
        'w_mod': nrm(ks[4], (L, D, 6 * D), 0.5 * D ** -0.5),
        'b_mod': nrm(ks[5], (L, 6 * D), 0.02),
        'norm1_g': 1.0 + nrm(ks[6], (L, D), 0.02),
        'norm2_g': 1.0 + nrm(ks[7], (L, D), 0.02),
        'w_in': nrm(ks[8], (L, D, IN_W), D ** -0.5),
        'q_gain': 1.0 + nrm(ks[9], (L, HEAD_DIM), 0.02),
        'k_gain': 1.0 + nrm(ks[10], (L, HEAD_DIM), 0.02),
        'na_rpb': nrm(ks[11], (L, NA_HEADS, 2 * WIN_H - 1, 2 * WIN_W - 1), 0.1),
        'lambda_q1': nrm(ks[12], (L, DIFF_QK_DIM), 0.1),
        'lambda_k1': nrm(ks[13], (L, DIFF_QK_DIM), 0.1),
        'lambda_q2': nrm(ks[14], (L, DIFF_QK_DIM), 0.1),
        'lambda_k2': nrm(ks[15], (L, DIFF_QK_DIM), 0.1),
        'diff_sub_g': 1.0 + nrm(ks[16], (L, DIFF_V_DIM), 0.02),
        'sgu_norm_g': 1.0 + nrm(ks[17], (L, BRANCH_W), 0.02),
        'sgu_w': nrm(ks[18], (L, SGU_GROUPS, SGU_CHUNK, SGU_CHUNK), SGU_CHUNK ** -0.5),
        'sgu_b': 1.0 + nrm(ks[19], (L, SGU_GROUPS, SGU_CHUNK), 0.02),
        'gate_b': nrm(ks[20], (L, GATE_W), 0.02),
        'w_branch': nrm(ks[21], (L, N_BRANCH, BRANCH_W, D), BRANCH_W ** -0.5),
        'w_out': nrm(ks[22], (L, D, D), D ** -0.5),
        'w_router': nrm(ks[23], (L, D, N_EXPERTS), D ** -0.5),
        'w_e_gate': nrm(ks[24], (L, N_EXPERTS, D, EXPERT_HIDDEN), D ** -0.5),
        'w_e_up': nrm(ks[25], (L, N_EXPERTS, D, EXPERT_HIDDEN), D ** -0.5),
        'w_e_down': nrm(ks[26], (L, N_EXPERTS, EXPERT_HIDDEN, D), EXPERT_HIDDEN ** -0.5),
        'final_g': 1.0 + nrm(ks[27], (D,), 0.02),
    }


def reference(x, c, ctx, c_ctx, w_mod, b_mod, norm1_g, norm2_g, w_in, q_gain, k_gain, na_rpb,
              lambda_q1, lambda_k1, lambda_q2, lambda_k2, diff_sub_g, sgu_norm_g, sgu_w, sgu_b, gate_b,
              w_branch, w_out, w_router, w_e_gate, w_e_up, w_e_down, final_g):
    s = x.shape[1]
    ropes = (axial_rope_tables(s, DIFF_QK_DIM), axial_rope_tables(s, HEAD_DIM))
    for l in range(DEPTH):
        last = l == DEPTH - 1
        mod = jax.nn.silu(c) @ w_mod[l] + b_mod[l]
        sh1, sc1, g1, sh2, sc2, g2 = jnp.split(mod[:, None, :], 6, axis=-1)
        mod_c = jax.nn.silu(c_ctx) @ w_mod[l] + b_mod[l]
        csh1, csc1, cg1, csh2, csc2, cg2 = jnp.split(mod_c, 6, axis=-1)
        lam_init = 0.8 - 0.6 * math.exp(-0.3 * l)
        lam = (jnp.exp(jnp.sum(lambda_q1[l].astype(jnp.float32) * lambda_k1[l].astype(jnp.float32)))
               - jnp.exp(jnp.sum(lambda_q2[l].astype(jnp.float32) * lambda_k2[l].astype(jnp.float32)))
               + lam_init)

        h = modulate(rms_norm(x, norm1_g[l]), sh1, sc1)
        hc = modulate(rms_norm(ctx, norm1_g[l]), csh1, csc1)
        p = h @ w_in[l]
        kv = kv_heads(p[..., MAIN_W:], k_gain[l], ropes)
        if last:
            kv_c = kv_heads(hc @ w_in[l][:, MAIN_W:], k_gain[l], None)
        else:
            pc = hc @ w_in[l]
            kv_c = kv_heads(pc[..., MAIN_W:], k_gain[l], None)
            ctx_mix = token_mixer(pc[..., :MAIN_W], kv_c, None, None, q_gain[l], na_rpb[l], lam, lam_init,
                                  diff_sub_g[l], sgu_norm_g[l], sgu_w[l], sgu_b[l], gate_b[l],
                                  w_branch[l], w_out[l])
        lat_mix = token_mixer(p[..., :MAIN_W], kv, kv_c, ropes, q_gain[l], na_rpb[l], lam, lam_init,
                              diff_sub_g[l], sgu_norm_g[l], sgu_w[l], sgu_b[l], gate_b[l],
                              w_branch[l], w_out[l])
        x = x + g1 * lat_mix

        h2 = modulate(rms_norm(x, norm2_g[l]), sh2, sc2)
        x = x + g2 * expert_choice_moe(h2, w_router[l], w_e_gate[l], w_e_up[l], w_e_down[l])
        if not last:
            ctx = ctx + cg1 * ctx_mix
            hc2 = modulate(rms_norm(ctx, norm2_g[l]), csh2, csc2)
            ctx = ctx + cg2 * expert_choice_moe(hc2, w_router[l], w_e_gate[l], w_e_up[l], w_e_down[l])
    return rms_norm(x, final_g)
```

```cpp
#include <hip/hip_runtime.h>
#include <hip/hip_bf16.h>
#include <cstdio>
#include <cstdint>
#include <cmath>

#ifndef MK_PER_PHASE
#define MK_PER_PHASE 0
#endif

constexpr int DM = 1024, NB = 2, SEQ = 8192, CTXL = 256, RB = SEQ + CTXL, NR = NB * RB, DEPTH = 2;
constexpr int IN_W = 6656, NEXP = 16, EH = 2048, TPB = RB / 256  ;
constexpr float EPS = 1e-6f, LOG2E = 1.4426950408889634f;
constexpr float C2A = 0.125f * LOG2E;
constexpr float C2B = 0.17677669529663687f * LOG2E;
constexpr int NPHASE = 2 + 10 * DEPTH;

constexpr size_t MiB = 1u << 20, KiB128 = 131072;
constexpr size_t WS_CTL = 0, CTL_ZERO_BYTES = 1 * MiB;
constexpr size_t WS_MOD = 1 * MiB;
constexpr size_t WS_AFFL = 2 * MiB, WS_AFFC = 3 * MiB;
constexpr size_t WS_IDXROW = 4 * MiB, WS_SCORE = 4 * MiB + 512 * 1024, WS_INV = 5 * MiB;
constexpr size_t WS_GPC = 8 * MiB;
constexpr size_t WS_W0 = 24 * MiB, W_LAYER = 215 * MiB;
constexpr size_t WO_WING = 8 * MiB  , WO_WIN = 0  , WO_WB = 13 * MiB, WO_WO4 = 15 * MiB, WO_WGU = 23 * MiB, WO_WD = 151 * MiB;
constexpr size_t WS_HN = 454 * MiB;
constexpr size_t WS_QKV = 487 * MiB;
constexpr int PQ = 3136;
constexpr int C_QA = 0, C_KA = 256, C_VA = 512, C_QB = 768, C_KB = 1280, C_VB = 1792, C_QD = 2048, C_KD = 2304, C_VD = 2432, C_GU = 2560, C_GV = 2816;
constexpr size_t WS_Y = WS_QKV;
constexpr size_t WS_GT = 589 * MiB;
constexpr size_t WS_YS = 721 * MiB;
constexpr size_t WS_HID = WS_GT;
constexpr size_t WS_X1 = 754 * MiB, WS_XR = 820 * MiB, WS_H2 = 886 * MiB, WS_XG = 919 * MiB, WS_MRG = WS_H2, WS_PART = WS_XG  , WS_HN8 = 991 * MiB  , WS_END = 1008 * MiB;
static_assert(WS_QKV + (size_t)NR * PQ * 2 <= WS_GT && WS_Y + (size_t)16 * 9 * 256 * 1024 * 2 <= WS_GT && WS_HID + (size_t)16 * 9 * 256 * 2048 * 2 <= WS_X1 && WS_YS + (size_t)NR * 1024 * 2 <= WS_X1, "ws map");

constexpr int CW_BAR = 4096;

constexpr int RING_BYTES = 131072, LDSCTL_OFF = RING_BYTES, MISC_OFF = LDSCTL_OFF + 320, LDS_BYTES = 147456;

#define GAS __attribute__((address_space(1)))
#define LAS __attribute__((address_space(3)))
typedef unsigned short bf16_t;
typedef unsigned v4u __attribute__((ext_vector_type(4)));
typedef unsigned v2u __attribute__((ext_vector_type(2)));
typedef float f32x4 __attribute__((ext_vector_type(4)));
typedef float f32x2 __attribute__((ext_vector_type(2)));
typedef float f32x16 __attribute__((ext_vector_type(16)));
typedef short bf16x8 __attribute__((ext_vector_type(8)));
typedef short s16x4 __attribute__((ext_vector_type(4)));
typedef __bf16 bf16x2_t __attribute__((ext_vector_type(2)));
#define RLX_AGENT __ATOMIC_RELAXED, __HIP_MEMORY_SCOPE_AGENT
#define LDS_WAIT() asm volatile("s_waitcnt lgkmcnt(0)" ::: "memory")
#define VM_WAIT() asm volatile("s_waitcnt vmcnt(0)" ::: "memory")

__device__ __forceinline__ int opaque_tid() { int t = threadIdx.x; asm volatile("" : "+v"(t)); return t; }
__device__ __forceinline__ int opaque_s(int v) { asm volatile("" : "+s"(v)); return v; }
__device__ __forceinline__ unsigned char* opaque_ptr(unsigned char* p) { asm volatile("" : "+s"(p)); return p; }
__device__ __forceinline__ unsigned cvtpk(float lo, float hi) { f32x2 v = {lo, hi}; bf16x2_t b = __builtin_convertvector(v, bf16x2_t); return __builtin_bit_cast(unsigned, b); }
__device__ __forceinline__ float bflo(unsigned w) { return __uint_as_float(w << 16); }
__device__ __forceinline__ float bfhi(unsigned w) { return __uint_as_float(w & 0xffff0000u); }
__device__ __forceinline__ float bf2f(bf16_t h) { return __uint_as_float((unsigned)h << 16); }
__device__ __forceinline__ bf16_t f2bf(float f) { return (bf16_t)(cvtpk(f, 0.f) & 0xffffu); }
__device__ __forceinline__ float sigmoidf_(float x) { return __builtin_amdgcn_rcpf(1.0f + __builtin_amdgcn_exp2f(-x * LOG2E)); }
__device__ __forceinline__ float siluf_(float x) { return x * sigmoidf_(x); }
__device__ __forceinline__ float gelu_tanh(float x) { const float z = 0.7978845608028654f * (x + 0.044715f * x * x * x); return x * __builtin_amdgcn_rcpf(1.0f + __builtin_amdgcn_exp2f(-2.0f * LOG2E * z)); }
template <int CTRL> __device__ __forceinline__ float dpp_f(float v) { return __builtin_bit_cast(float, __builtin_amdgcn_update_dpp(0, __builtin_bit_cast(int, v), CTRL, 0xf, 0xf, true)); }
__device__ __forceinline__ float row16_sum(float v) { v += dpp_f<0xB1>(v); v += dpp_f<0x4E>(v); v += dpp_f<0x141>(v); v += dpp_f<0x140>(v); return v; }
__device__ __forceinline__ float xor16_sum(float v) { auto rr = __builtin_amdgcn_permlane16_swap(__float_as_uint(v), __float_as_uint(v), false, false); return __uint_as_float(rr[0]) + __uint_as_float(rr[1]); }
__device__ __forceinline__ float xor32_sum(float v) { auto rr = __builtin_amdgcn_permlane32_swap(__float_as_uint(v), __float_as_uint(v), false, false); return __uint_as_float(rr[0]) + __uint_as_float(rr[1]); }
__device__ __forceinline__ float half32_sum(float v) { return xor16_sum(row16_sum(v)); }
__device__ __forceinline__ float wave_sum(float v) { return xor32_sum(xor16_sum(row16_sum(v))); }
__device__ __forceinline__ unsigned pk8(float a, float b, float c, float d) { unsigned w = 0u; w = __builtin_amdgcn_cvt_pk_fp8_f32(a, b, w, false); w = __builtin_amdgcn_cvt_pk_fp8_f32(c, d, w, true); return w; }
__device__ __forceinline__ void st8(bf16_t* p, const float* v) { v4u w; w.x = cvtpk(v[0], v[1]); w.y = cvtpk(v[2], v[3]); w.z = cvtpk(v[4], v[5]); w.w = cvtpk(v[6], v[7]); *(v4u*)p = w; }

__device__ const float INV16R[16] = {0.15915494309189535f, 0.08949940160889101f, 0.050329212104487035f, 0.0283021958306234f, 0.015915494309189534f, 0.008949940160889102f, 0.005032921210448704f, 0.00283021958306234f,
                                     0.0015915494309189536f, 0.0008949940160889102f, 0.0005032921210448703f, 0.00028302195830623395f, 0.00015915494309189535f, 8.949940160889102e-05f, 5.0329212104487035e-05f, 2.8302195830623396e-05f};
__device__ const float INV8R[8] = {0.15915494309189535f, 0.050329212104487035f, 0.015915494309189534f, 0.005032921210448704f, 0.0015915494309189536f, 0.0005032921210448703f, 0.00015915494309189535f, 5.0329212104487035e-05f};
__device__ __forceinline__ void sincos_rev(float rev, float& s, float& c) { const float f = __builtin_amdgcn_fractf(rev); s = __builtin_amdgcn_sinf(f); c = __builtin_amdgcn_cosf(f); }

namespace pg8 {
#define PG8_LAS __attribute__((address_space(3)))
constexpr int BM = 256, BK = 64, HALF = 128, HTB = HALF * BK * 2, STAGE_BYTES = 8 * HTB, NXCD = 8, WGM = 8;
__host__ __device__ __forceinline__ int lds_byte(int r, int c) { const int st = (r >> 4) * 2 + (c >> 5), rr = r & 15, cc = c & 31, ob = rr * 64 + cc * 2; return st * 1024 + (ob ^ (((ob >> 9) & 1) << 5)); }
__host__ __device__ __forceinline__ void stage_rc(int b, int& R, int& C) { const int st = b / 1024, sb = b % 1024, swz = sb ^ (((sb >> 9) & 1) << 5); R = (st >> 1) * 16 + swz / 64; C = (st & 1) * 32 + (swz % 64) / 2; }
__host__ __device__ __forceinline__ int perm32(int rho) { const int n = rho >> 4, i = rho & 15; return 8 * (i >> 2) + 4 * n + (i & 3); }

struct Unit { int pm, pn; const char* a; const char* b; };
__device__ __forceinline__ const char* uptr(const char* p) { const unsigned long long v = (unsigned long long)p; const unsigned lo = __builtin_amdgcn_readfirstlane((unsigned)v), hi = __builtin_amdgcn_readfirstlane((unsigned)(v >> 32)); return (const char*)(((unsigned long long)hi << 32) | lo); }
__device__ __forceinline__ void uunit(Unit& u) { u.pm = __builtin_amdgcn_readfirstlane(u.pm); u.pn = __builtin_amdgcn_readfirstlane(u.pn); u.a = uptr(u.a); u.b = uptr(u.b); }

typedef int v8i __attribute__((ext_vector_type(8)));
__device__ __forceinline__ void glds16s(const char* sbase, unsigned voff, unsigned lds_dst) { unsigned keep;
    asm volatile("s_mov_b32 %0, m0\n\ts_mov_b32 m0, %3\n\ts_nop 0\n\tglobal_load_lds_dwordx4 %1, %2\n\ts_mov_b32 m0, %0" : "=&s"(keep) : "v"(voff), "s"(sbase), "s"(lds_dst) : "memory"); }
__device__ __forceinline__ void rect_order(int L, int nM, int nN, int& im, int& in) {
    const int nwg = nM * nN; int wgid = L; { const int q = nwg / NXCD, r = nwg % NXCD, xcd = wgid % NXCD, off = wgid / NXCD; wgid = (xcd < r ? xcd * (q + 1) : r * (q + 1) + (xcd - r) * q) + off; }
    const int nig = WGM * nN, gid = wgid / nig, fm = gid * WGM, gsz = (nM - fm) < WGM ? (nM - fm) : WGM;
    im = fm + ((wgid % nig) % gsz); in = (wgid % nig) / gsz;
}

template <class Epi, class Sched>
__device__ __forceinline__ void gemm_phase(PG8_LAS unsigned char* lds, const int K, const int lda, const int ldb, const Sched& S, const Epi& E) {
    const int tid = opaque_tid(), wid = __builtin_amdgcn_readfirstlane(tid >> 6), lane = tid & 63, wr = wid >> 2, wc = wid & 3, fr = lane & 15, fq = lane >> 4;
    const int nt = K / BK;
    unsigned voffA[2], voffB[2];
#pragma unroll
    for (int i = 0; i < 2; ++i) { int R, C; stage_rc(tid * 16 + i * 8192, R, C); const int Rb = Epi::PERM ? ((R & ~31) + perm32(R & 31)) : R;
        voffA[i] = (unsigned)(R * lda + C) * 2u; voffB[i] = (unsigned)(Rb * ldb + C) * 2u; }
    const size_t kstep = (size_t)(BK * 2);
    const size_t hA = (size_t)HALF * lda * 2, hB = (size_t)HALF * ldb * 2;
    const unsigned ldsw = (unsigned)wid * 1024u, ldsbase = (unsigned)(size_t)lds;
    const int aoff = lds_byte(wr * 64 + fr, fq * 8), boff = lds_byte(wc * 32 + fr, fq * 8);
#define PG8_SA(b, h) (((b) * 2 + (h)) * HTB)
#define PG8_SB(b, h) ((4 + (b) * 2 + (h)) * HTB)
#define PG8_STAGE(bufoff, gbase, voff) do { _Pragma("unroll") for (int _i = 0; _i < 2; ++_i) \
        glds16s(uptr((const char*)(gbase)), (voff)[_i], (unsigned)__builtin_amdgcn_readfirstlane(ldsbase + (unsigned)(bufoff) + ldsw + _i * 8192u)); } while (0)
#define PG8_LDA(dst, b, h) do { _Pragma("unroll") for (int m = 0; m < 4; ++m) _Pragma("unroll") for (int k = 0; k < 2; ++k) dst[m][k] = *(const PG8_LAS bf16x8*)(lds + PG8_SA(b, h) + aoff + m * 2048 + k * 1024); } while (0)
#define PG8_LDB(dst, b, h) do { _Pragma("unroll") for (int n = 0; n < 2; ++n) _Pragma("unroll") for (int k = 0; k < 2; ++k) dst[n][k] = *(const PG8_LAS bf16x8*)(lds + PG8_SB(b, h) + boff + n * 2048 + k * 1024); } while (0)
#define PG8_MMA(ai, bj, At, Bt) do { __builtin_amdgcn_s_setprio(1); _Pragma("unroll") for (int m = 0; m < 4; ++m) _Pragma("unroll") for (int n = 0; n < 2; ++n) _Pragma("unroll") for (int k = 0; k < 2; ++k) \
        acc[ai][bj][m][n] = __builtin_amdgcn_mfma_f32_16x16x32_bf16(Bt[n][k], At[m][k], acc[ai][bj][m][n], 0, 0, 0); __builtin_amdgcn_s_setprio(0); } while (0)
#define PG8_WAIT_V(n) asm volatile("s_waitcnt vmcnt(" #n ")" ::: "memory")
#define PG8_WAIT_L(n) asm volatile("s_waitcnt lgkmcnt(" #n ")" ::: "memory")
#define PG8_BAR __builtin_amdgcn_s_barrier()
#define PG8_SCHED __builtin_amdgcn_sched_barrier(0)
    Unit cur, nxt; int ui = 0;
    if (!S.next(0, cur)) return;
    uunit(cur);
    f32x4 acc[2][2][4][2];
#pragma unroll
    for (int a = 0; a < 2; ++a)
#pragma unroll
        for (int b = 0; b < 2; ++b)
#pragma unroll
            for (int m = 0; m < 4; ++m)
#pragma unroll
                for (int n = 0; n < 2; ++n) acc[a][b][m][n] = (f32x4){0.f, 0.f, 0.f, 0.f};
    bf16x8 At[4][2], B0[2][2], B1[2][2];
    const char* cA = cur.a; const char* cB = cur.b;
    PG8_STAGE(PG8_SB(0, 0), cB, voffB); PG8_STAGE(PG8_SB(0, 1), cB + hB, voffB); PG8_STAGE(PG8_SA(0, 0), cA, voffA); PG8_STAGE(PG8_SA(0, 1), cA + hA, voffA);
    if (wr == 1) PG8_BAR;
    PG8_WAIT_V(2); PG8_BAR;
    PG8_STAGE(PG8_SB(1, 0), cB + kstep, voffB); PG8_STAGE(PG8_SA(1, 0), cA + kstep, voffA); PG8_STAGE(PG8_SB(1, 1), cB + hB + kstep, voffB);
    PG8_WAIT_V(6); PG8_BAR;
    for (;;) {
        const bool has_next = S.next(ui + 1, nxt); if (has_next) uunit(nxt);
        const char* nA = has_next ? nxt.a : cA; const char* nB = has_next ? nxt.b : cB;
        for (int t = 0; t < nt; t += 2) {
            const bool last = (t == nt - 2);
            const char* a1 = cA + (size_t)(t + 1) * kstep;
            const char* a2 = last ? nA : cA + (size_t)(t + 2) * kstep; const char* b2 = last ? nB : cB + (size_t)(t + 2) * kstep;
            const char* a3 = a2 + kstep; const char* b3 = b2 + kstep;
            PG8_LDB(B0, 0, 0); PG8_LDB(B1, 0, 1); PG8_SCHED; PG8_LDA(At, 0, 0); PG8_STAGE(PG8_SA(1, 1), a1 + hA, voffA);
            PG8_WAIT_V(8); PG8_WAIT_L(0); PG8_BAR; PG8_MMA(0, 0, At, B0); PG8_MMA(0, 1, At, B1); PG8_BAR; PG8_SCHED;
            PG8_LDA(At, 0, 1); PG8_STAGE(PG8_SB(0, 0), b2, voffB); PG8_STAGE(PG8_SB(0, 1), b2 + hB, voffB); PG8_STAGE(PG8_SA(0, 0), a2, voffA);
            PG8_WAIT_V(8); PG8_WAIT_L(0); PG8_BAR; PG8_MMA(1, 0, At, B0); PG8_MMA(1, 1, At, B1); PG8_BAR; PG8_SCHED;
            PG8_LDB(B0, 1, 0); PG8_LDB(B1, 1, 1); PG8_SCHED; PG8_LDA(At, 1, 0); PG8_STAGE(PG8_SA(0, 1), a2 + hA, voffA);
            PG8_WAIT_V(8); PG8_WAIT_L(0); PG8_BAR; PG8_MMA(0, 0, At, B0); PG8_MMA(0, 1, At, B1); PG8_BAR; PG8_SCHED;
            PG8_LDA(At, 1, 1); PG8_STAGE(PG8_SB(1, 0), b3, voffB); PG8_STAGE(PG8_SB(1, 1), b3 + hB, voffB); PG8_STAGE(PG8_SA(1, 0), a3, voffA);
            PG8_WAIT_V(8); PG8_WAIT_L(0); PG8_BAR; PG8_MMA(1, 0, At, B0); PG8_MMA(1, 1, At, B1); PG8_BAR; PG8_SCHED;
        }
        if (wr == 0) PG8_BAR;
        { const int t2 = opaque_tid(), l2 = t2 & 63; E(acc, cur, wr, wc, l2 & 15, l2 >> 4); }
        if (!has_next) break;
        if (!Epi::keep_acc(cur)) {
#pragma unroll
        for (int a = 0; a < 2; ++a)
#pragma unroll
            for (int b = 0; b < 2; ++b)
#pragma unroll
                for (int m = 0; m < 4; ++m)
#pragma unroll
                    for (int n = 0; n < 2; ++n) acc[a][b][m][n] = (f32x4){0.f, 0.f, 0.f, 0.f};
        }
        cur = nxt; cA = nA; cB = nB; ++ui;
        if (wr == 1) PG8_BAR;
    }
    PG8_WAIT_V(0);
    PG8_BAR;
#undef PG8_SA
#undef PG8_SB
#undef PG8_STAGE
#undef PG8_LDA
#undef PG8_LDB
#undef PG8_MMA
#undef PG8_WAIT_V
#undef PG8_WAIT_L
#undef PG8_BAR
#undef PG8_SCHED
}
template <class Epi, class Sched>
__device__ __forceinline__ void gemm8_phase(PG8_LAS unsigned char* lds, const int K, const int lda, const int ldb, const Sched& S, const Epi& E) {
    const int tid = opaque_tid(), wid = __builtin_amdgcn_readfirstlane(tid >> 6), lane = tid & 63, wr = wid >> 2, wc = wid & 3, fr = lane & 15, fq = lane >> 4;
    const int nt = opaque_s(K / BK);
    unsigned voffA[2], voffB[2];
#pragma unroll
    for (int i = 0; i < 2; ++i) { int R, C; stage_rc(tid * 16 + i * 8192, R, C); const int Rb = Epi::PERM ? ((R & ~31) + perm32(R & 31)) : R;
        voffA[i] = (unsigned)(R * lda + C) * 2u; voffB[i] = (unsigned)(Rb * ldb + C) * 2u; }
    const size_t kstep = (size_t)(BK * 2);
    const size_t hA = (size_t)HALF * lda * 2, hB = (size_t)HALF * ldb * 2;
    const unsigned ldsw = (unsigned)wid * 1024u, ldsbase = (unsigned)(size_t)lds;
    const int fcol = (fq >> 1) * 32 + (fq & 1) * 16;
    const int aoff = lds_byte(wr * 64 + fr, fcol), boff = lds_byte(wc * 32 + fr, fcol);
#define PG8_SA(b, h) (((b) * 2 + (h)) * HTB)
#define PG8_SB(b, h) ((4 + (b) * 2 + (h)) * HTB)
#define PG8_STAGE(bufoff, gbase, voff) do { _Pragma("unroll") for (int _i = 0; _i < 2; ++_i) \
        glds16s(uptr((const char*)(gbase)), (voff)[_i], (unsigned)__builtin_amdgcn_readfirstlane(ldsbase + (unsigned)(bufoff) + ldsw + _i * 8192u)); } while (0)
#define PG8_LDA(dst, b, h) do { _Pragma("unroll") for (int m = 0; m < 4; ++m) { const v4u lo_ = *(const PG8_LAS v4u*)(lds + PG8_SA(b, h) + aoff + m * 2048), hi_ = *(const PG8_LAS v4u*)(lds + PG8_SA(b, h) + aoff + m * 2048 + 16); dst[m] = (v8i){(int)lo_.x, (int)lo_.y, (int)lo_.z, (int)lo_.w, (int)hi_.x, (int)hi_.y, (int)hi_.z, (int)hi_.w}; } } while (0)
#define PG8_LDB(dst, b, h) do { _Pragma("unroll") for (int n = 0; n < 2; ++n) { const v4u lo_ = *(const PG8_LAS v4u*)(lds + PG8_SB(b, h) + boff + n * 2048), hi_ = *(const PG8_LAS v4u*)(lds + PG8_SB(b, h) + boff + n * 2048 + 16); dst[n] = (v8i){(int)lo_.x, (int)lo_.y, (int)lo_.z, (int)lo_.w, (int)hi_.x, (int)hi_.y, (int)hi_.z, (int)hi_.w}; } } while (0)
#define PG8_MMA(ai, bj, At, Bt) do { __builtin_amdgcn_s_setprio(1); _Pragma("unroll") for (int m = 0; m < 4; ++m) _Pragma("unroll") for (int n = 0; n < 2; ++n) \
        acc[ai][bj][m][n] = __builtin_amdgcn_mfma_scale_f32_16x16x128_f8f6f4(Bt[n], At[m], acc[ai][bj][m][n], 0, 0, 0, 0, 0, 0);     __builtin_amdgcn_s_setprio(0); } while (0)
#define PG8_WAIT_V(n) asm volatile("s_waitcnt vmcnt(" #n ")" ::: "memory")
#define PG8_WAIT_L(n) asm volatile("s_waitcnt lgkmcnt(" #n ")" ::: "memory")
#define PG8_BAR __builtin_amdgcn_s_barrier()
#define PG8_SCHED __builtin_amdgcn_sched_barrier(0)
    Unit cur, nxt; int ui = 0;
    if (!S.next(0, cur)) return;
    uunit(cur);
    f32x4 acc[2][2][4][2];
#pragma unroll
    for (int a = 0; a < 2; ++a)
#pragma unroll
        for (int b = 0; b < 2; ++b)
#pragma unroll
            for (int m = 0; m < 4; ++m)
#pragma unroll
                for (int n = 0; n < 2; ++n) acc[a][b][m][n] = (f32x4){0.f, 0.f, 0.f, 0.f};
    v8i At[4], B0[2], B1[2];
    const char* cA = cur.a; const char* cB = cur.b;
    PG8_STAGE(PG8_SB(0, 0), cB, voffB); PG8_STAGE(PG8_SB(0, 1), cB + hB, voffB); PG8_STAGE(PG8_SA(0, 0), cA, voffA); PG8_STAGE(PG8_SA(0, 1), cA + hA, voffA);
    if (wr == 1) PG8_BAR;
    PG8_WAIT_V(2); PG8_BAR;
    PG8_STAGE(PG8_SB(1, 0), cB + kstep, voffB); PG8_STAGE(PG8_SA(1, 0), cA + kstep, voffA); PG8_STAGE(PG8_SB(1, 1), cB + hB + kstep, voffB);
    PG8_WAIT_V(6); PG8_BAR;
    for (;;) {
        const bool has_next = S.next(ui + 1, nxt); if (has_next) uunit(nxt);
        const char* nA = has_next ? nxt.a : cA; const char* nB = has_next ? nxt.b : cB;
#pragma nounroll
        for (int t = 0; t < nt; t += 2) {
            const bool last = (t == nt - 2);
            const char* a1 = cA + (size_t)(t + 1) * kstep;
            const char* a2 = last ? nA : cA + (size_t)(t + 2) * kstep; const char* b2 = last ? nB : cB + (size_t)(t + 2) * kstep;
            const char* a3 = a2 + kstep; const char* b3 = b2 + kstep;
            PG8_LDB(B0, 0, 0); PG8_LDB(B1, 0, 1); PG8_SCHED; PG8_LDA(At, 0, 0); PG8_STAGE(PG8_SA(1, 1), a1 + hA, voffA);
            PG8_WAIT_V(8); PG8_WAIT_L(0); PG8_BAR; PG8_MMA(0, 0, At, B0); PG8_MMA(0, 1, At, B1); PG8_BAR; PG8_SCHED;
            PG8_LDA(At, 0, 1); PG8_STAGE(PG8_SB(0, 0), b2, voffB); PG8_STAGE(PG8_SB(0, 1), b2 + hB, voffB); PG8_STAGE(PG8_SA(0, 0), a2, voffA);
            PG8_WAIT_V(8); PG8_WAIT_L(0); PG8_BAR; PG8_MMA(1, 0, At, B0); PG8_MMA(1, 1, At, B1); PG8_BAR; PG8_SCHED;
            PG8_LDB(B0, 1, 0); PG8_LDB(B1, 1, 1); PG8_SCHED; PG8_LDA(At, 1, 0); PG8_STAGE(PG8_SA(0, 1), a2 + hA, voffA);
            PG8_WAIT_V(8); PG8_WAIT_L(0); PG8_BAR; PG8_MMA(0, 0, At, B0); PG8_MMA(0, 1, At, B1); PG8_BAR; PG8_SCHED;
            PG8_LDA(At, 1, 1); PG8_STAGE(PG8_SB(1, 0), b3, voffB); PG8_STAGE(PG8_SB(1, 1), b3 + hB, voffB); PG8_STAGE(PG8_SA(1, 0), a3, voffA);
            PG8_WAIT_V(8); PG8_WAIT_L(0); PG8_BAR; PG8_MMA(1, 0, At, B0); PG8_MMA(1, 1, At, B1); PG8_BAR; PG8_SCHED;
        }
        if (wr == 0) PG8_BAR;
        { const int t2 = opaque_tid(), l2 = t2 & 63; E(acc, cur, wr, wc, l2 & 15, l2 >> 4); }
        if (!has_next) break;
#pragma unroll
        for (int a = 0; a < 2; ++a)
#pragma unroll
            for (int b = 0; b < 2; ++b)
#pragma unroll
                for (int m = 0; m < 4; ++m)
#pragma unroll
                    for (int n = 0; n < 2; ++n) acc[a][b][m][n] = (f32x4){0.f, 0.f, 0.f, 0.f};
        cur = nxt; cA = nA; cB = nB; ++ui;
        if (wr == 1) PG8_BAR;
    }
    PG8_WAIT_V(0);
    PG8_BAR;
#undef PG8_SA
#undef PG8_SB
#undef PG8_STAGE
#undef PG8_LDA
#undef PG8_LDB
#undef PG8_MMA
#undef PG8_WAIT_V
#undef PG8_WAIT_L
#undef PG8_BAR
#undef PG8_SCHED
}
}

constexpr float W8S = 32.0f, W8I = 1.0f / 32.0f;
struct ModPtrs { const float* mod; };

struct EpiInProj {
    static constexpr bool PERM = true;
    static __device__ __forceinline__ bool keep_acc(const pg8::Unit&) { return false; }
    bf16_t *QKV, *GT;
    const float *q_gain, *k_gain, *gate_b;
    __device__ __forceinline__ void operator()(const f32x4 (&acc)[2][2][4][2], const pg8::Unit& u, int wr, int wc, int fr, int fq) const {
        const int pn = u.pn, pm = u.pm, jt = pm % TPB; const bool isctx = (jt == 0); const int t0 = (jt - 1) * 256;
        const int cb = 64 * wc + 8 * fq;
        const int rit0 = 64 * wr + fr;
        bf16_t* qrow = QKV + ((size_t)pm * 256 + rit0) * PQ;
#define ROWLOOP _Pragma("unroll") for (int ai = 0; ai < 2; ++ai) _Pragma("unroll") for (int m = 0; m < 4; ++m)
#define ROWVARS const int rit = 128 * ai + 16 * m + rit0; bf16_t* orow = qrow + (size_t)(128 * ai + 16 * m) * PQ; \
        float v[2][8]; _Pragma("unroll") for (int bj = 0; bj < 2; ++bj) _Pragma("unroll") for (int n = 0; n < 2; ++n) _Pragma("unroll") for (int j = 0; j < 4; ++j) v[bj][4 * n + j] = acc[ai][bj][m][n][j];
#define ROWEND __builtin_amdgcn_sched_barrier(0);
        if (pn == 0 || pn == 21 || pn == 22 || pn == 24) {
            const int oc = (pn == 0 ? C_QA : pn == 21 ? C_KA : pn == 22 ? C_VA : C_VB) + cb; const float sc = pn == 0 ? C2A : 1.0f;
            ROWLOOP { ROWVARS
#pragma unroll
                for (int bj = 0; bj < 2; ++bj) {
#pragma unroll
                    for (int j = 0; j < 8; ++j) v[bj][j] *= sc;
                    st8(orow + oc + 32 * bj, v[bj]); }
                ROWEND }
        } else if (pn == 3 || pn == 4) {
            const int oc = (pn == 3 ? C_GU : C_GV) + cb;
            ROWLOOP { ROWVARS
#pragma unroll
                for (int bj = 0; bj < 2; ++bj) {
#pragma unroll
                    for (int j = 0; j < 8; ++j) v[bj][j] = gelu_tanh(v[bj][j]);
                    st8(orow + oc + 32 * bj, v[bj]); }
                ROWEND }
        } else if (pn == 1 || pn == 23) {
            const int oc = (pn == 1 ? C_QB : C_KB) + 128 * wc + 8 * fq; const float sc = pn == 1 ? C2B : 1.0f;
            const f32x4 inv = *(const f32x4*)(INV8R + 4 * (fq & 1));
            const float zz[8] = {0.f, 0.f, 0.f, 0.f, 0.f, 0.f, 0.f, 0.f};
            ROWLOOP { ROWVARS
                const int t = t0 + rit; const float pos = (float)((fq < 2) ? (t >> 6) : (t & 63));
                float sn[4], cs[4];
#pragma unroll
                for (int p = 0; p < 4; ++p) { if (isctx) { sn[p] = 0.f; cs[p] = 1.f; } else sincos_rev(pos * inv[p], sn[p], cs[p]); }
#pragma unroll
                for (int bj = 0; bj < 2; ++bj) {
                    float o[8];
#pragma unroll
                    for (int p = 0; p < 4; ++p) { const float x0 = v[bj][2 * p], x1 = v[bj][2 * p + 1]; o[2 * p] = (x0 * cs[p] - x1 * sn[p]) * sc; o[2 * p + 1] = (x0 * sn[p] + x1 * cs[p]) * sc; }
                    st8(orow + oc + 64 * bj, o); st8(orow + oc + 64 * bj + 32, zz); }
                ROWEND }
        } else {
            if (pn == 25 && wc >= 2) {
                const int oc = C_VD + (wc - 2) * 64 + 8 * fq;
                ROWLOOP { ROWVARS
#pragma unroll
                    for (int bj = 0; bj < 2; ++bj) st8(orow + oc + 32 * bj, v[bj]);
                    (void)rit; ROWEND }
            } else {
                const int oc = (pn == 2 ? C_QD : C_KD) + cb; const float sc = pn == 2 ? C2A : 1.0f; const float* gain = pn == 2 ? q_gain : k_gain;
                const f32x4 inv = *(const f32x4*)(INV16R + 4 * fq);
                f32x4 gn[2][2];
#pragma unroll
                for (int bj = 0; bj < 2; ++bj)
#pragma unroll
                    for (int n = 0; n < 2; ++n) gn[bj][n] = *(const f32x4*)(gain + 32 * bj + 8 * fq + 4 * n);
                ROWLOOP { ROWVARS
                    float ss = 0.f;
#pragma unroll
                    for (int bj = 0; bj < 2; ++bj)
#pragma unroll
                        for (int j = 0; j < 8; ++j) ss += v[bj][j] * v[bj][j];
                    ss = xor32_sum(xor16_sum(ss));
                    const float rstd = __builtin_amdgcn_rsqf(ss * (1.0f / 64.0f) + EPS);
                    const int t = t0 + rit;
#pragma unroll
                    for (int bj = 0; bj < 2; ++bj) {
                        const float pos = (float)(bj == 0 ? (t >> 6) : (t & 63));
                        float o[8];
#pragma unroll
                        for (int p = 0; p < 4; ++p) {
                            float sn, cs; if (isctx) { sn = 0.f; cs = 1.f; } else sincos_rev(pos * inv[p], sn, cs);
                            const float x0 = v[bj][2 * p] * rstd * gn[bj][(2 * p) >> 2][(2 * p) & 3], x1 = v[bj][2 * p + 1] * rstd * gn[bj][(2 * p + 1) >> 2][(2 * p + 1) & 3];
                            o[2 * p] = (x0 * cs - x1 * sn) * sc; o[2 * p + 1] = (x0 * sn + x1 * cs) * sc; }
                        st8(orow + oc + 32 * bj, o); }
                    ROWEND }
            }
        }
#undef ROWLOOP
#undef ROWVARS
#undef ROWEND
    }
};

__device__ __forceinline__ unsigned pk_u8x4(float a, float b, float c, float d) { unsigned w = 0u;
    w = __builtin_amdgcn_cvt_pk_u8_f32(__builtin_rintf(a * 255.0f), 0u, w); w = __builtin_amdgcn_cvt_pk_u8_f32(__builtin_rintf(b * 255.0f), 1u, w);
    w = __builtin_amdgcn_cvt_pk_u8_f32(__builtin_rintf(c * 255.0f), 2u, w); w = __builtin_amdgcn_cvt_pk_u8_f32(__builtin_rintf(d * 255.0f), 3u, w); return w; }
__device__ __forceinline__ float u8f(unsigned w, int i) { return (float)((w >> (8 * i)) & 0xffu); }
struct EpiGates {
    static constexpr bool PERM = true;
    unsigned char* GT; const float* gate_b;
    __device__ __forceinline__ void operator()(const f32x4 (&acc)[2][2][4][2], const pg8::Unit& u, int wr, int wc, int fr, int fq) const {
        const int col0 = u.pn * 256 + wc * 32 + 8 * fq;
        f32x4 gb[2][2];
#pragma unroll
        for (int bj = 0; bj < 2; ++bj)
#pragma unroll
            for (int n = 0; n < 2; ++n) gb[bj][n] = *(const f32x4*)(gate_b + col0 + bj * 128 + 4 * n);
#pragma unroll
        for (int ai = 0; ai < 2; ++ai)
#pragma unroll
            for (int m = 0; m < 4; ++m) { unsigned char* rowp = GT + ((size_t)u.pm * 256 + ai * 128 + wr * 64 + m * 16 + fr) * 4096 + col0;
#pragma unroll
                for (int bj = 0; bj < 2; ++bj) { float o[8];
#pragma unroll
                    for (int n = 0; n < 2; ++n)
#pragma unroll
                        for (int j = 0; j < 4; ++j) o[4 * n + j] = sigmoidf_(acc[ai][bj][m][n][j] * W8I + gb[bj][n][j]);
                    v2u w; w.x = pk_u8x4(o[0], o[1], o[2], o[3]); w.y = pk_u8x4(o[4], o[5], o[6], o[7]); *(v2u*)(rowp + bj * 128) = w; } }
    }
};
struct EpiGateAcc {
    static constexpr bool PERM = true;
    const unsigned char* GT; bf16_t* MRG; bf16_t* GPC;
    static __device__ __forceinline__ bool keep_acc(const pg8::Unit& u) { return (u.pn & 3) != 3 && (u.pm % TPB) != 0; }
    __device__ __forceinline__ void operator()(f32x4 (&acc)[2][2][4][2], const pg8::Unit& u, int wr, int wc, int fr, int fq) const {
        const int dt = u.pn >> 2, n = u.pn & 3; const int col0 = dt * 256 + wc * 32 + 8 * fq;
        const bool isctx = (u.pm % TPB) == 0;
        const size_t row0 = (size_t)u.pm * 256 + wr * 64 + fr;
        const unsigned char* gp0 = GT + row0 * 4096 + n * 1024 + col0;
        constexpr float GMIN = 8.673617379884035e-19f;
#define GA_OFF(grp) ((size_t)(((grp) >> 3) * 128 + (((grp) >> 1) & 3) * 16))
        if (!isctx && n < 3) {
            v2u ga[16], gb[16];
#pragma unroll
            for (int grp = 0; grp < 16; ++grp) { const int bj = grp & 1; ga[grp] = *(const v2u*)(gp0 + GA_OFF(grp) * 4096 + bj * 128); gb[grp] = *(const v2u*)(gp0 + 1024 + GA_OFF(grp) * 4096 + bj * 128); }
            __builtin_amdgcn_sched_barrier(0);
#pragma unroll
            for (int grp = 0; grp < 16; ++grp) { const int ai = grp >> 3, m = (grp >> 1) & 3, bj = grp & 1; const v2u g0 = ga[grp], g1 = gb[grp];
                float r[8];
#define GA_R(i, A, B) r[i] = fmaxf(A, GMIN) * __builtin_amdgcn_rcpf(fmaxf(B, GMIN))
                GA_R(0, u8f(g0.x, 0), u8f(g1.x, 0)); GA_R(1, u8f(g0.x, 1), u8f(g1.x, 1)); GA_R(2, u8f(g0.x, 2), u8f(g1.x, 2)); GA_R(3, u8f(g0.x, 3), u8f(g1.x, 3));
                GA_R(4, u8f(g0.y, 0), u8f(g1.y, 0)); GA_R(5, u8f(g0.y, 1), u8f(g1.y, 1)); GA_R(6, u8f(g0.y, 2), u8f(g1.y, 2)); GA_R(7, u8f(g0.y, 3), u8f(g1.y, 3));
#undef GA_R
#pragma unroll
                for (int j = 0; j < 4; ++j) { acc[ai][bj][m][0][j] *= r[j]; acc[ai][bj][m][1][j] *= r[4 + j]; } }
            __builtin_amdgcn_sched_barrier(0);
        } else {
            bf16_t* mp0 = isctx ? GPC + ((size_t)n * 512 + (u.pm / TPB) * 256 + wr * 64 + fr) * 1024 + col0 : MRG + row0 * 1024 + col0;
            const float lo = isctx ? 0.f : GMIN; constexpr float I255 = 1.0f / 255.0f;
            v2u ga[16];
#pragma unroll
            for (int grp = 0; grp < 16; ++grp) { const int bj = grp & 1; ga[grp] = *(const v2u*)(gp0 + GA_OFF(grp) * 4096 + bj * 128); }
            __builtin_amdgcn_sched_barrier(0);
#pragma unroll
            for (int grp = 0; grp < 16; ++grp) { const int ai = grp >> 3, m = (grp >> 1) & 3, bj = grp & 1; const v2u g = ga[grp]; const f32x4 a0 = acc[ai][bj][m][0], a1 = acc[ai][bj][m][1];
                v4u w; w.x = cvtpk(a0[0] * (fmaxf(u8f(g.x, 0), lo) * I255), a0[1] * (fmaxf(u8f(g.x, 1), lo) * I255)); w.y = cvtpk(a0[2] * (fmaxf(u8f(g.x, 2), lo) * I255), a0[3] * (fmaxf(u8f(g.x, 3), lo) * I255));
                w.z = cvtpk(a1[0] * (fmaxf(u8f(g.y, 0), lo) * I255), a1[1] * (fmaxf(u8f(g.y, 1), lo) * I255)); w.w = cvtpk(a1[2] * (fmaxf(u8f(g.y, 2), lo) * I255), a1[3] * (fmaxf(u8f(g.y, 3), lo) * I255));
                *(v4u*)(mp0 + GA_OFF(grp) * 1024 + bj * 128) = w; }
            __builtin_amdgcn_sched_barrier(0);
        }
#undef GA_OFF
    }
};

struct EpiOutRes {
    static constexpr bool PERM = true;
    static __device__ __forceinline__ bool keep_acc(const pg8::Unit&) { return false; }
    const float* x_in; const float* ctx_in; const bf16_t* XR; bf16_t* X1; const float* mod_l; int layer;
    __device__ __forceinline__ void operator()(const f32x4 (&acc)[2][2][4][2], const pg8::Unit& u, int wr, int wc, int fr, int fq) const {
        const int pm = u.pm, b = pm / TPB, jt = pm % TPB; const bool isctx = jt == 0;
        const float* g1 = mod_l + (isctx ? 2 : b) * 6144 + 2048;
        const int col0 = u.pn * 256 + wc * 32 + 8 * fq;
        f32x4 gv[2][2];
#pragma unroll
        for (int bj = 0; bj < 2; ++bj)
#pragma unroll
            for (int n = 0; n < 2; ++n) gv[bj][n] = *(const f32x4*)(g1 + col0 + bj * 128 + n * 4);
        bf16_t* ob = X1 + ((size_t)pm * 256 + wr * 64 + fr) * DM + col0;
        if (layer == 0) {
            const float* base = (isctx ? ctx_in + (size_t)b * CTXL * DM : x_in + ((size_t)b * SEQ + (size_t)(jt - 1) * 256) * DM) + (size_t)(wr * 64 + fr) * DM + col0;
#pragma unroll
            for (int ai = 0; ai < 2; ++ai) { f32x4 rs[4][2][2];
#pragma unroll
                for (int m = 0; m < 4; ++m)
#pragma unroll
                    for (int bj = 0; bj < 2; ++bj)
#pragma unroll
                        for (int n = 0; n < 2; ++n) rs[m][bj][n] = *(const f32x4*)(base + (size_t)(ai * 128 + m * 16) * DM + bj * 128 + n * 4);
                __builtin_amdgcn_sched_barrier(0);
#pragma unroll
                for (int m = 0; m < 4; ++m)
#pragma unroll
                    for (int bj = 0; bj < 2; ++bj) { const f32x4 o0 = rs[m][bj][0] + gv[bj][0] * acc[ai][bj][m][0], o1 = rs[m][bj][1] + gv[bj][1] * acc[ai][bj][m][1];
                        v4u w; w.x = cvtpk(o0[0], o0[1]); w.y = cvtpk(o0[2], o0[3]); w.z = cvtpk(o1[0], o1[1]); w.w = cvtpk(o1[2], o1[3]);
                        *(v4u*)(ob + (size_t)(ai * 128 + m * 16) * DM + bj * 128) = w; }
                __builtin_amdgcn_sched_barrier(0); }
        } else {
            const bf16_t* base = XR + ((size_t)pm * 256 + wr * 64 + fr) * DM + col0;
#pragma unroll
            for (int ai = 0; ai < 2; ++ai) { v4u rb[4][2];
#pragma unroll
                for (int m = 0; m < 4; ++m)
#pragma unroll
                    for (int bj = 0; bj < 2; ++bj) rb[m][bj] = *(const v4u*)(base + (size_t)(ai * 128 + m * 16) * DM + bj * 128);
                __builtin_amdgcn_sched_barrier(0);
#pragma unroll
                for (int m = 0; m < 4; ++m)
#pragma unroll
                    for (int bj = 0; bj < 2; ++bj) { const v4u r = rb[m][bj];
                        const f32x4 r0 = (f32x4){bflo(r.x), bfhi(r.x), bflo(r.y), bfhi(r.y)}, r1 = (f32x4){bflo(r.z), bfhi(r.z), bflo(r.w), bfhi(r.w)};
                        const f32x4 o0 = r0 + gv[bj][0] * acc[ai][bj][m][0], o1 = r1 + gv[bj][1] * acc[ai][bj][m][1];
                        v4u w; w.x = cvtpk(o0[0], o0[1]); w.y = cvtpk(o0[2], o0[3]); w.z = cvtpk(o1[0], o1[1]); w.w = cvtpk(o1[2], o1[3]);
                        *(v4u*)(ob + (size_t)(ai * 128 + m * 16) * DM + bj * 128) = w; }
                __builtin_amdgcn_sched_barrier(0); }
        }
    }
};
struct EpiPart {
    static constexpr bool PERM = false;
    static __device__ __forceinline__ bool keep_acc(const pg8::Unit&) { return false; }
    float* PART;
    __device__ __forceinline__ void operator()(const f32x4 (&acc)[2][2][4][2], const pg8::Unit& u, int wr, int wc, int fr, int fq) const {
        const int ks = u.pn >> 2, ct = u.pn & 3; const int col0 = ct * 256 + wc * 32 + 4 * fq;
#pragma unroll
        for (int ai = 0; ai < 2; ++ai)
#pragma unroll
            for (int m = 0; m < 4; ++m) { float* op = PART + ((size_t)ks * 512 + u.pm * 256 + ai * 128 + wr * 64 + m * 16 + fr) * DM + col0;
#pragma unroll
                for (int bj = 0; bj < 2; ++bj)
#pragma unroll
                    for (int n = 0; n < 2; ++n) *(f32x4*)(op + bj * 128 + n * 16) = acc[ai][bj][m][n]; }
    }
};
struct EpiSwiGLU {
    static constexpr bool PERM = true;
    unsigned char* HID;
    __device__ __forceinline__ void operator()(const f32x4 (&acc)[2][2][4][2], const pg8::Unit& u, int wr, int wc, int fr, int fq) const {
        const int f0 = u.pn * 128 + wc * 32 + 8 * fq;
#pragma unroll
        for (int ai = 0; ai < 2; ++ai)
#pragma unroll
            for (int m = 0; m < 4; ++m) { float o[8];
#pragma unroll
                for (int n = 0; n < 2; ++n)
#pragma unroll
                    for (int j = 0; j < 4; ++j) o[4 * n + j] = siluf_(acc[ai][0][m][n][j] * W8I) * (acc[ai][1][m][n][j] * W8I);
                v2u w; w.x = pk8(o[0], o[1], o[2], o[3]); w.y = pk8(o[4], o[5], o[6], o[7]);
                *(v2u*)(HID + ((size_t)u.pm * 256 + ai * 128 + wr * 64 + m * 16 + fr) * EH + f0) = w; }
    }
};
struct EpiDown {
    static constexpr bool PERM = true;
    bf16_t* Y; const float* SCORE;
    __device__ __forceinline__ void operator()(const f32x4 (&acc)[2][2][4][2], const pg8::Unit& u, int wr, int wc, int fr, int fq) const {
        const int col0 = u.pn * 256 + wc * 32 + 8 * fq;
        float sc8[2][4];
#pragma unroll
        for (int ai = 0; ai < 2; ++ai)
#pragma unroll
            for (int m = 0; m < 4; ++m) sc8[ai][m] = SCORE[(size_t)u.pm * 256 + ai * 128 + wr * 64 + m * 16 + fr];
        __builtin_amdgcn_sched_barrier(0);
#pragma unroll
        for (int ai = 0; ai < 2; ++ai)
#pragma unroll
            for (int m = 0; m < 4; ++m) { const size_t row = (size_t)u.pm * 256 + ai * 128 + wr * 64 + m * 16 + fr; const float s = sc8[ai][m] * W8I;
#pragma unroll
                for (int bj = 0; bj < 2; ++bj) { float o[8];
#pragma unroll
                    for (int n = 0; n < 2; ++n)
#pragma unroll
                        for (int j = 0; j < 4; ++j) o[4 * n + j] = acc[ai][bj][m][n][j] * s;
                    st8(Y + row * DM + col0 + bj * 128, o); } }
    }
};
struct EpiDownPart {
    static constexpr bool PERM = true;
    bf16_t* YP; const float* SCORE;
    __device__ __forceinline__ void operator()(const f32x4 (&acc)[2][2][4][2], const pg8::Unit& u, int wr, int wc, int fr, int fq) const {
        if (wr != 0) return;
        const int in = u.pn & 3, kq = u.pn >> 2, e = u.pm / 9; const int col0 = in * 256 + wc * 32 + 8 * fq;
        float sc4[4];
#pragma unroll
        for (int m = 0; m < 4; ++m) sc4[m] = SCORE[(size_t)u.pm * 256 + m * 16 + fr];
        __builtin_amdgcn_sched_barrier(0);
#pragma unroll
        for (int m = 0; m < 4; ++m) { const size_t row = ((size_t)(kq * 16 + e) * 256 + m * 16 + fr); const float sc = sc4[m] * W8I;
#pragma unroll
            for (int bj = 0; bj < 2; ++bj) { float o[8];
#pragma unroll
                for (int n = 0; n < 2; ++n)
#pragma unroll
                    for (int j = 0; j < 4; ++j) o[4 * n + j] = acc[0][bj][m][n][j] * sc;
                st8(YP + row * DM + col0 + bj * 128, o); } }
    }
};

namespace attn_body {
using bf16 = __hip_bfloat16;
using u32x4 = __attribute__((ext_vector_type(4))) unsigned;
constexpr int NW = 8, QBLK = 32, QB = QBLK * NW, KVBLK = 64;
__device__ __forceinline__ int crow(int r, int hi) { return (r & 3) + 8 * (r >> 2) + 4 * hi; }
#define SBAR() __builtin_amdgcn_sched_barrier(0)
constexpr int NSLOT = 3, SLOTB = 8192;
constexpr int LDS_K = 0, LDS_V = NSLOT * SLOTB, LDS_WS = 2 * NSLOT * SLOTB, LDS_OST = LDS_WS + NW * 64 * 4, LDS_OST1 = LDS_OST + NW * 4096, LDS_RPB = LDS_OST1 + NW * 4096, LDS_ATT_BYTES = LDS_RPB + 2048;
static_assert(LDS_ATT_BYTES <= RING_BYTES, "attention LDS");
__device__ __forceinline__ void glds16(const void* gsrc, unsigned lds_dst) { unsigned keep;
  asm volatile("s_mov_b32 %0, m0\n\ts_mov_b32 m0, %2\n\ts_nop 0\n\tglobal_load_lds_dwordx4 %1, off\n\ts_mov_b32 m0, %0" : "=&s"(keep) : "v"(gsrc), "s"(lds_dst) : "memory"); }
__device__ __forceinline__ float max3f(float a, float b, float c) { float r; asm("v_max3_f32 %0, %1, %2, %3" : "=v"(r) : "v"(a), "v"(b), "v"(c)); return r; }
__device__ __forceinline__ float max2f(float a, float b) { float r; asm("v_max_f32_e32 %0, %1, %2" : "=v"(r) : "v"(a), "v"(b)); return r; }
__device__ __forceinline__ float fadd_s(float a, float b) { float r; asm("v_add_f32_e32 %0, %1, %2" : "=v"(r) : "v"(a), "v"(b)); return r; }
__device__ __forceinline__ float fsub_s(float a, float b) { float r; asm("v_sub_f32_e32 %0, %1, %2" : "=v"(r) : "v"(a), "v"(b)); return r; }
__device__ __forceinline__ unsigned cvtpk_s(float lo, float hi) { return cvtpk(lo, hi); }
#define WAIT_BAR(N) asm volatile("s_waitcnt vmcnt(" #N ") lgkmcnt(0)\n\ts_barrier" ::: "memory")

typedef __attribute__((address_space(3))) const char* lds_cptr;
typedef short v4i16_t __attribute__((ext_vector_type(4)));
__device__ __forceinline__ void qkt(f32x16& p0, f32x16& p1, lds_cptr Kslot, const bf16x8* qr, const f32x16& negm, int r32, int hi) {
  lds_cptr kb = Kslot + hi * 1024 + r32 * 16;
  #pragma unroll
  for (int d0 = 0; d0 < 4; ++d0) {
    const bf16x8 b0 = *(const __attribute__((address_space(3))) bf16x8*)(kb + d0 * 2048);
    const bf16x8 b1 = *(const __attribute__((address_space(3))) bf16x8*)(kb + d0 * 2048 + 512);
    if (d0 == 0) { p0 = __builtin_amdgcn_mfma_f32_32x32x16_bf16(b0, qr[0], negm, 0, 0, 0); p1 = __builtin_amdgcn_mfma_f32_32x32x16_bf16(b1, qr[0], negm, 0, 0, 0); }
    else { p0 = __builtin_amdgcn_mfma_f32_32x32x16_bf16(b0, qr[d0], p0, 0, 0, 0); p1 = __builtin_amdgcn_mfma_f32_32x32x16_bf16(b1, qr[d0], p1, 0, 0, 0); } }
}
__device__ __forceinline__ void kload8(bf16x8* kf, lds_cptr kp) {
  kf[0] = *(const __attribute__((address_space(3))) bf16x8*)(kp);        kf[1] = *(const __attribute__((address_space(3))) bf16x8*)(kp + 512);
  kf[2] = *(const __attribute__((address_space(3))) bf16x8*)(kp + 2048); kf[3] = *(const __attribute__((address_space(3))) bf16x8*)(kp + 2560);
  kf[4] = *(const __attribute__((address_space(3))) bf16x8*)(kp + 4096); kf[5] = *(const __attribute__((address_space(3))) bf16x8*)(kp + 4608);
  kf[6] = *(const __attribute__((address_space(3))) bf16x8*)(kp + 6144); kf[7] = *(const __attribute__((address_space(3))) bf16x8*)(kp + 6656);
}
__device__ __forceinline__ void kload2(bf16x8* kf, lds_cptr kp, int j) { kf[2 * j] = *(const __attribute__((address_space(3))) bf16x8*)(kp + j * 2048); kf[2 * j + 1] = *(const __attribute__((address_space(3))) bf16x8*)(kp + j * 2048 + 512); }
__device__ __forceinline__ s16x4 vtr(lds_cptr p) { return __builtin_bit_cast(s16x4, __builtin_amdgcn_ds_read_tr16_b64_v4i16((__attribute__((address_space(3))) v4i16_t*)p)); }
__device__ __forceinline__ float rowmax(const f32x16& p0, const f32x16& p1) {
  float a = max3f(p0[0], p0[1], p1[0]), b = max3f(p0[2], p0[3], p1[1]); a = max3f(a, p1[2], p1[3]);
  #pragma unroll
  for (int r = 4; r < 16; r += 4) { a = max3f(a, p0[r], p0[r + 1]); b = max3f(b, p0[r + 2], p0[r + 3]); a = max3f(a, p1[r], p1[r + 1]); b = max3f(b, p1[r + 2], p1[r + 3]); }
  const float m = max2f(a, b);
  auto rr = __builtin_amdgcn_permlane32_swap(__float_as_uint(m), __float_as_uint(m), false, false);
  return max2f(__uint_as_float(rr[0]), __uint_as_float(rr[1]));
}
__device__ __forceinline__ void pv(f32x16* o, int vb, bf16x8 pa0, bf16x8 pa1, bf16x8 pa2, bf16x8 pa3) {
  #pragma unroll
  for (int d0 = 0; d0 < 2; ++d0) { s16x4 lo[4], hi[4];
    #pragma unroll
    for (int ks = 0; ks < 4; ++ks) {
      asm volatile("ds_read_b64_tr_b16 %0,%1 offset:%c2" : "=&v"(lo[ks]) : "v"(vb), "i"(d0 * 4096 + ks * 1024) : "memory");
      asm volatile("ds_read_b64_tr_b16 %0,%1 offset:%c2" : "=&v"(hi[ks]) : "v"(vb), "i"(d0 * 4096 + ks * 1024 + 512) : "memory"); }
    asm volatile("s_waitcnt lgkmcnt(0)" ::: "memory"); SBAR();
    #define PK(k) (bf16x8){lo[k][0], lo[k][1], lo[k][2], lo[k][3], hi[k][0], hi[k][1], hi[k][2], hi[k][3]}
    o[d0] = __builtin_amdgcn_mfma_f32_32x32x16_bf16(pa0, PK(0), o[d0], 0, 0, 0);
    o[d0] = __builtin_amdgcn_mfma_f32_32x32x16_bf16(pa1, PK(1), o[d0], 0, 0, 0);
    o[d0] = __builtin_amdgcn_mfma_f32_32x32x16_bf16(pa2, PK(2), o[d0], 0, 0, 0);
    o[d0] = __builtin_amdgcn_mfma_f32_32x32x16_bf16(pa3, PK(3), o[d0], 0, 0, 0);
    #undef PK
  }
}

struct DiffEpi { float lam, post; const float* subg; };
template <int THRL, int MODE> __device__ __forceinline__ void attn_unit(const bf16* Qu, const bf16* __restrict__ Kh, const bf16* __restrict__ Vh, int NT, bf16* Ou, char* shm, const DiffEpi de) {
  constexpr int PK = PQ, PV = PQ, PO = 1024;
  constexpr bool DQ32 = (MODE != 0);
  const int tid = opaque_tid(), lane = tid & 63, r32 = lane & 31, hi = lane >> 5; const int wid = __builtin_amdgcn_readfirstlane(tid >> 6);
  const bf16* Qw = Qu + (long)(wid * QBLK) * PQ;
  const unsigned lds0 = (unsigned)(uintptr_t)shm;
  float* wsf = (float*)(shm + LDS_WS) + wid * 64;
  const bf16* ksrc = Kh + (long)lane * PK + wid * 8;
  const bf16* vsrc = Vh + (long)(16 * (wid & 3) + (lane >> 2)) * PV + (wid >> 2) * 32 + (lane & 3) * 8;
  const unsigned kdst = lds0 + LDS_K + wid * 1024, vdst = lds0 + LDS_V + wid * 1024;
  #define DMA_K(t, slot) glds16(ksrc + (long)(t) * KVBLK * PK, (unsigned)__builtin_amdgcn_readfirstlane(kdst + (slot)))
  #define DMA_V(t, slot) glds16(vsrc + (long)(t) * KVBLK * PV, (unsigned)__builtin_amdgcn_readfirstlane(vdst + (slot)))
  const int vb0 = (int)(lds0 + LDS_V) + ((lane >> 4) & 1) * 32 + (lane & 3) * 8 + (4 * hi + ((lane & 15) >> 2)) * 64;
  bf16x8 kf[8];
  const lds_cptr shm3 = (lds_cptr)shm; const lds_cptr kp0 = shm3 + LDS_K + hi * 1024 + r32 * 16; const lds_cptr vp0 = shm3 + LDS_V + ((lane >> 4) & 1) * 32 + (lane & 3) * 8 + (4 * hi + ((lane & 15) >> 2)) * 64;
  DMA_K(0, 0); DMA_V(0, 0); DMA_K(1, SLOTB);
  bf16x8 qr[4];
  #pragma unroll
  for (int d0 = 0; d0 < 4; ++d0) qr[d0] = *reinterpret_cast<const bf16x8*>(&Qw[(long)r32 * PQ + d0 * 16 + hi * 8]);
  float mhat = 0.f, l_reg = 0.f; f32x16 o[2]; o[0] = f32x16{}; o[1] = f32x16{}; f32x16 negm = f32x16{}; asm volatile("" : "+v"(negm));
  bool resc = false;
  #define START(P0, P1) do { const float rm = rowmax(P0, P1); resc = false; \
    { const float dl = rm; mhat = fadd_s(mhat, dl); \
      _Pragma("unroll") for (int r = 0; r < 16; ++r) { P0[r] = fsub_s(P0[r], dl); P1[r] = fsub_s(P1[r], dl); } \
      _Pragma("unroll") for (int r = 0; r < 16; ++r) negm[r] = -mhat; asm volatile("" : "+v"(negm)); } \
    _Pragma("unroll") for (int r = 0; r < 16; ++r) P0[r] = __builtin_amdgcn_exp2f(P0[r]); } while (0)
  #define RESC() do { if (resc) { asm volatile("s_waitcnt lgkmcnt(0)" ::: "memory"); \
      _Pragma("unroll") for (int d_ = 0; d_ < 2; ++d_) _Pragma("unroll") for (int r = 0; r < 16; ++r) o[d_][r] *= wsf[crow(r, hi)]; } } while (0)
  f32x16 pA0, pA1, pB0, pB1;
  int sl_prev = 0, sl_cur = 0, sl_next = SLOTB;
  #define ROT() do { sl_prev = sl_cur; sl_cur = sl_next; sl_next = (sl_next == (NSLOT - 1) * SLOTB) ? 0 : sl_next + SLOTB; } while (0)
  DMA_K(2, 2 * SLOTB);
  WAIT_BAR(3);
  qkt(pA0, pA1, shm3 + LDS_K, qr, negm, r32, hi); asm volatile("s_nop 15\n\ts_nop 7" : "+v"(pA0), "+v"(pA1));
  START(pA0, pA1);
  _Pragma("unroll") for (int r = 0; r < 16; ++r) pA1[r] = __builtin_amdgcn_exp2f(pA1[r]);
  WAIT_BAR(0);
  DMA_K(3, 0); DMA_V(1, SLOTB);
  ROT();
  kload8(kf, kp0 + sl_cur);
  WAIT_BAR(2);
  s16x4 vlo[8], vhi[8]; u32x4 pw0, pw1, pw2, pw3;
  #define PKW(P, B) cvtpk_s(P[B], P[B + 1])
  #define PAF(k) __builtin_bit_cast(bf16x8, pw##k)
  #define VFR(i) (bf16x8){vlo[i][0], vlo[i][1], vlo[i][2], vlo[i][3], vhi[i][0], vhi[i][1], vhi[i][2], vhi[i][3]}
  #define PIN(x) asm volatile("" : "+v"(x))
  #define MX3(a, b, c) __builtin_fmaxf(__builtin_fmaxf((a), (b)), (c))
  #define GAPA(MF, A0, A1, A2, A3, W0, W1, PW) do { MF; sacc += A0; sacc += A1; sacc += A2; sacc += A3; PIN(sacc); W0; W1; PIN(PW); SBAR(); } while (0)
  #define EX(v) __builtin_amdgcn_exp2f(v)
  #define GAPB(MF, X, B) do { MF; X[B] = EX(X[B]); X[B + 1] = EX(X[B + 1]); X[B + 2] = EX(X[B + 2]); X[B + 3] = EX(X[B + 3]); PIN(X); SBAR(); } while (0)
  #define VRD(i) do { vlo[i] = vtr(vp_ + (((i) >> 2) * 4096 + ((i) & 3) * 1024)); vhi[i] = vtr(vp_ + (((i) >> 2) * 4096 + ((i) & 3) * 1024 + 512)); } while (0)
  #define KRD(G, j) do { if (G) { kload2(kf, kp0 + sl_next, j); SBAR(); } } while (0)
  #define STEP(C0, C1, P0, P1, t, GK, GV, GL) do { SBAR(); \
    const lds_cptr vp_ = vp0 + sl_prev; \
    VRD(0); SBAR(); float sacc = (P0[0] + P0[1]); \
    GAPA(C0 = __builtin_amdgcn_mfma_f32_32x32x16_bf16(kf[0], qr[0], negm, 0, 0, 0), P0[2], P0[3], P0[4], P0[5],     pw0[0] = PKW(P0, 0), pw0[1] = PKW(P0, 2), pw0); \
    VRD(4); SBAR(); GAPA(C1 = __builtin_amdgcn_mfma_f32_32x32x16_bf16(kf[1], qr[0], negm, 0, 0, 0), P0[6], P0[7], P0[8], P0[9],     pw0[2] = PKW(P0, 4), pw0[3] = PKW(P0, 6), pw0); \
    VRD(1); SBAR(); GAPA(C0 = __builtin_amdgcn_mfma_f32_32x32x16_bf16(kf[2], qr[1], C0, 0, 0, 0),   P0[10], P0[11], P0[12], P0[13], pw1[0] = PKW(P0, 8), pw1[1] = PKW(P0, 10), pw1); \
    VRD(5); SBAR(); GAPA(C1 = __builtin_amdgcn_mfma_f32_32x32x16_bf16(kf[3], qr[1], C1, 0, 0, 0),   P0[14], P0[15], P1[0], P1[1],   pw1[2] = PKW(P0, 12), pw1[3] = PKW(P0, 14), pw1); \
    VRD(2); SBAR(); GAPA(do { if (!DQ32) { C0 = __builtin_amdgcn_mfma_f32_32x32x16_bf16(kf[4], qr[2], C0, 0, 0, 0); } } while (0),   P1[2], P1[3], P1[4], P1[5],     pw2[0] = PKW(P1, 0), pw2[1] = PKW(P1, 2), pw2); \
    VRD(6); SBAR(); GAPA(do { if (!DQ32) { C1 = __builtin_amdgcn_mfma_f32_32x32x16_bf16(kf[5], qr[2], C1, 0, 0, 0); } } while (0),   P1[6], P1[7], P1[8], P1[9],     pw2[2] = PKW(P1, 4), pw2[3] = PKW(P1, 6), pw2); \
    VRD(3); SBAR(); GAPA(do { if (!DQ32) { C0 = __builtin_amdgcn_mfma_f32_32x32x16_bf16(kf[6], qr[3], C0, 0, 0, 0); } } while (0),   P1[10], P1[11], P1[12], P1[13], pw3[0] = PKW(P1, 8), pw3[1] = PKW(P1, 10), pw3); \
    VRD(7); SBAR(); GAPA(do { if (!DQ32) { C1 = __builtin_amdgcn_mfma_f32_32x32x16_bf16(kf[7], qr[3], C1, 0, 0, 0); } } while (0),   P1[14], P1[15], 0.f, 0.f,       pw3[2] = PKW(P1, 12), pw3[3] = PKW(P1, 14), pw3); \
    l_reg += sacc; \
    if (GK) { DMA_K((t) + 3, sl_cur); } if (GV) { DMA_V((t) + 1, sl_next); } \
    { float a = MX3(C0[0], C0[1], C1[0]), b = MX3(C0[2], C0[3], C1[1]); a = MX3(a, C1[2], C1[3]); \
      _Pragma("unroll") for (int r = 4; r < 16; r += 4) { a = MX3(a, C0[r], C0[r + 1]); b = MX3(b, C0[r + 2], C0[r + 3]); a = MX3(a, C1[r], C1[r + 1]); b = MX3(b, C1[r + 2], C1[r + 3]); } \
      float rm = __builtin_fmaxf(a, b); { auto rr = __builtin_amdgcn_permlane32_swap(__float_as_uint(rm), __float_as_uint(rm), false, false); rm = __builtin_fmaxf(__uint_as_float(rr[0]), __uint_as_float(rr[1])); } \
      resc = false; \
      if (__builtin_expect(__any(rm > (float)THRL), 0)) { const float dl = __builtin_fmaxf(rm, 0.f); mhat += dl; \
        _Pragma("unroll") for (int r = 0; r < 16; ++r) { C0[r] -= dl; C1[r] -= dl; } \
        _Pragma("unroll") for (int r = 0; r < 16; ++r) negm[r] = -mhat; asm volatile("" : "+v"(negm)); \
        const float f = __builtin_amdgcn_exp2f(-dl); l_reg *= f; if (hi == 0) wsf[r32] = f; resc = true; } } \
    SBAR(); \
    GAPB(o[0] = __builtin_amdgcn_mfma_f32_32x32x16_bf16(PAF(0), VFR(0), o[0], 0, 0, 0), C0, 0); \
    GAPB(o[1] = __builtin_amdgcn_mfma_f32_32x32x16_bf16(PAF(0), VFR(4), o[1], 0, 0, 0), C0, 4); \
    KRD(GL, 0); GAPB(o[0] = __builtin_amdgcn_mfma_f32_32x32x16_bf16(PAF(1), VFR(1), o[0], 0, 0, 0), C0, 8); \
    KRD(GL, 1); GAPB(o[1] = __builtin_amdgcn_mfma_f32_32x32x16_bf16(PAF(1), VFR(5), o[1], 0, 0, 0), C0, 12); \
    KRD(GL && !DQ32, 2); GAPB(o[0] = __builtin_amdgcn_mfma_f32_32x32x16_bf16(PAF(2), VFR(2), o[0], 0, 0, 0), C1, 0); \
    KRD(GL && !DQ32, 3); GAPB(o[1] = __builtin_amdgcn_mfma_f32_32x32x16_bf16(PAF(2), VFR(6), o[1], 0, 0, 0), C1, 4); \
    GAPB(o[0] = __builtin_amdgcn_mfma_f32_32x32x16_bf16(PAF(3), VFR(3), o[0], 0, 0, 0), C1, 8); \
    GAPB(o[1] = __builtin_amdgcn_mfma_f32_32x32x16_bf16(PAF(3), VFR(7), o[1], 0, 0, 0), C1, 12); \
    } while (0)
  int t = 1;
  for (; t + 5 < NT; t += 2) {
    STEP(pB0, pB1, pA0, pA1, t, true, true, true);     WAIT_BAR(2); RESC(); ROT();
    STEP(pA0, pA1, pB0, pB1, t + 1, true, true, true); WAIT_BAR(2); RESC(); ROT();
  }
  #define ENDW(tt) do { if ((tt) + 3 < NT) { WAIT_BAR(2); } else if ((tt) + 2 < NT) { WAIT_BAR(1); } else { WAIT_BAR(0); } } while (0)
  for (; t + 1 < NT; t += 2) {
    STEP(pB0, pB1, pA0, pA1, t, (t + 3 < NT), (t + 1 < NT), (t + 1 < NT));       ENDW(t);     RESC(); ROT();
    STEP(pA0, pA1, pB0, pB1, t + 1, (t + 4 < NT), (t + 2 < NT), (t + 2 < NT));   ENDW(t + 1); RESC(); ROT();
  }
  STEP(pB0, pB1, pA0, pA1, NT - 1, false, false, false); RESC();
  { float sacc = pB0[0] + pB0[1]; _Pragma("unroll") for (int r = 2; r < 16; ++r) sacc += pB0[r]; _Pragma("unroll") for (int r = 0; r < 16; ++r) sacc += pB1[r]; l_reg += sacc;
    pw0 = (u32x4){PKW(pB0, 0), PKW(pB0, 2), PKW(pB0, 4), PKW(pB0, 6)}; pw1 = (u32x4){PKW(pB0, 8), PKW(pB0, 10), PKW(pB0, 12), PKW(pB0, 14)}; pw2 = (u32x4){PKW(pB1, 0), PKW(pB1, 2), PKW(pB1, 4), PKW(pB1, 6)}; pw3 = (u32x4){PKW(pB1, 8), PKW(pB1, 10), PKW(pB1, 12), PKW(pB1, 14)};
    SBAR(); pv(o, vb0 + sl_cur, PAF(0), PAF(1), PAF(2), PAF(3)); }
  #undef PKW
  #undef PAF
  #undef VFR
  #undef PIN
  #undef MX3
  #undef GAPA
  #undef GAPB
  #undef EX
  #undef VRD
  #undef KRD
  #undef STEP
  #undef ENDW
  { auto rr = __builtin_amdgcn_permlane32_swap(__float_as_uint(l_reg), __float_as_uint(l_reg), false, false); l_reg = __uint_as_float(rr[0]) + __uint_as_float(rr[1]); }
  if (hi == 0) wsf[32 + r32] = l_reg; asm volatile("s_waitcnt lgkmcnt(0)" ::: "memory");
  float rli[16];
  #pragma unroll
  for (int r = 0; r < 16; ++r) rli[r] = __builtin_amdgcn_rcpf(wsf[32 + crow(r, hi)]);
  bf16_t* stg = (bf16_t*)(shm + LDS_OST) + wid * 2048;
  bf16_t* stg1 = (bf16_t*)(shm + LDS_OST1) + wid * 2048;
  if (MODE == 1) {
    #pragma unroll
    for (int r = 0; r < 16; ++r) { const int orow = crow(r, hi);
      #pragma unroll
      for (int d0 = 0; d0 < 2; ++d0) stg1[orow * 64 + d0 * 32 + r32] = f2bf(o[d0][r] * rli[r]); }
    asm volatile("s_waitcnt lgkmcnt(0)" ::: "memory");
  } else {
    if (MODE == 2) {
      const float g0 = de.subg[r32] * de.post, g1 = de.subg[32 + r32] * de.post;
      #pragma unroll
      for (int r = 0; r < 16; ++r) { const int orow = crow(r, hi);
        const float d0v = bf2f(stg1[orow * 64 + r32]) - de.lam * (o[0][r] * rli[r]), d1v = bf2f(stg1[orow * 64 + 32 + r32]) - de.lam * (o[1][r] * rli[r]);
        float ss = d0v * d0v + d1v * d1v;
        ss = half32_sum(ss);
        const float rstd = __builtin_amdgcn_rsqf(ss * (1.0f / 64.0f) + EPS);
        stg[orow * 64 + r32] = f2bf(d0v * rstd * g0); stg[orow * 64 + 32 + r32] = f2bf(d1v * rstd * g1); }
    } else {
      #pragma unroll
      for (int r = 0; r < 16; ++r) { const int orow = crow(r, hi);
        #pragma unroll
        for (int d0 = 0; d0 < 2; ++d0) stg[orow * 64 + d0 * 32 + r32] = f2bf(o[d0][r] * rli[r]); }
    }
    asm volatile("s_waitcnt lgkmcnt(0)" ::: "memory");
    bf16* Ow = Ou + (long)(wid * QBLK) * PO;
    #pragma unroll
    for (int i = 0; i < 4; ++i) { const int row = i * 8 + (lane >> 3), ch = lane & 7; const u32x4 v = *(const u32x4*)(stg + row * 64 + ch * 8); *(u32x4*)(Ow + (long)row * PO + ch * 8) = v; }
  }
  asm volatile("s_waitcnt lgkmcnt(0)\n\ts_barrier" ::: "memory");
  #undef DMA_K
  #undef DMA_V
  #undef START
  #undef RESC
  #undef ROT
}

__device__ __forceinline__ void na_unit(int b, int h, int g4, const bf16* QKV, bf16* YS, const float* rpb_h, char* shm) {
  const bf16 *QA = QKV + C_QA, *KA = QKV + C_KA, *VA = QKV + C_VA;
  const int tid = opaque_tid(), lane = tid & 63, r32 = lane & 31, hi = lane >> 5; const int wid = __builtin_amdgcn_readfirstlane(tid >> 6);
  const unsigned lds0 = (unsigned)(uintptr_t)shm;
  float* wsf = (float*)(shm + LDS_WS) + wid * 64;
  float* rp = (float*)(shm + LDS_RPB);
  const lds_cptr shm3 = (lds_cptr)shm;
  for (int i = tid; i < 15 * 31; i += 512) rp[i] = rpb_h[i] * LOG2E;
  const int rq = 4 * g4 + (wid >> 1), qc = 32 * (wid & 1) + r32;
  const long rowb = (long)b * RB;
  const bf16* Qw = QA + (rowb + CTXL + rq * 64 + 32 * (wid & 1)) * PQ + h * 64;
  bf16x8 qr[4];
  #pragma unroll
  for (int d0 = 0; d0 < 4; ++d0) qr[d0] = *reinterpret_cast<const bf16x8*>(&Qw[(long)r32 * PQ + d0 * 16 + hi * 8]);
  const int r0 = min(max(rq - 4, 0), 120);
  const int kr_lo = min(max(4 * g4 - 4, 0), 120), kr_hi = min(max(4 * g4 - 1, 0), 120) + 7;
  const int ntiles = 4 + (kr_hi - kr_lo + 1);
  const int c0 = min(max(qc - 8, 0), 48);
  float mrun = -INFINITY, l_reg = 0.f; f32x16 o[2]; o[0] = f32x16{}; o[1] = f32x16{};
  const unsigned kdst = lds0 + LDS_K + wid * 1024, vdst = lds0 + LDS_V + wid * 1024;
  const int vb0 = (int)(lds0 + LDS_V) + ((lane >> 4) & 1) * 32 + (lane & 3) * 8 + (4 * hi + ((lane & 15) >> 2)) * 64;
  #define NA_DMA(TI) do { const int kr_ = kr_lo + (TI) - 4; const long krow_ = ((TI) < 4) ? rowb + 64 * (TI) : rowb + CTXL + (long)kr_ * 64; const unsigned so_ = ((TI) & 1) * SLOTB; \
      glds16(KA + (krow_ + lane) * PQ + h * 64 + wid * 8, (unsigned)__builtin_amdgcn_readfirstlane(kdst + so_)); \
      glds16(VA + (krow_ + 16 * (wid & 3) + (lane >> 2)) * PQ + h * 64 + (wid >> 2) * 32 + (lane & 3) * 8, (unsigned)__builtin_amdgcn_readfirstlane(vdst + so_)); } while (0)
  asm volatile("s_waitcnt lgkmcnt(0)\n\ts_barrier" ::: "memory");
  NA_DMA(0);
  for (int ti = 0; ti < ntiles; ++ti) {
    const int kr = kr_lo + ti - 4;
    asm volatile("s_waitcnt vmcnt(0) lgkmcnt(0)\n\ts_barrier" ::: "memory");
    if (ti + 1 < ntiles) NA_DMA(ti + 1);
    const unsigned so = (ti & 1) * SLOTB;
    const bool valid = (ti < 4) || (kr >= r0 && kr <= r0 + 7);
    if (valid) {
      f32x16 p0, p1; const f32x16 z = f32x16{};
      qkt(p0, p1, shm3 + LDS_K + so, qr, z, r32, hi);
      if (ti >= 4) {
        const int dr = kr - rq + 7;
        #pragma unroll
        for (int r = 0; r < 16; ++r) { const int k0 = crow(r, hi), k1 = k0 + 32;
          const bool v0 = (k0 >= c0) && (k0 < c0 + 16), v1 = (k1 >= c0) && (k1 < c0 + 16);
          const float b0 = v0 ? rp[dr * 31 + (k0 - qc + 15)] : 0.f, b1 = v1 ? rp[dr * 31 + (k1 - qc + 15)] : 0.f;
          p0[r] = v0 ? p0[r] + b0 : -INFINITY; p1[r] = v1 ? p1[r] + b1 : -INFINITY; }
      }
      float rm = p0[0];
      #pragma unroll
      for (int r = 1; r < 16; ++r) rm = fmaxf(rm, p0[r]);
      #pragma unroll
      for (int r = 0; r < 16; ++r) rm = fmaxf(rm, p1[r]);
      { auto rr = __builtin_amdgcn_permlane32_swap(__float_as_uint(rm), __float_as_uint(rm), false, false); rm = fmaxf(__uint_as_float(rr[0]), __uint_as_float(rr[1])); }
      const float mnew = fmaxf(mrun, rm); const float f = __builtin_amdgcn_exp2f(mrun - mnew); mrun = mnew;
      float sacc = 0.f;
      #pragma unroll
      for (int r = 0; r < 16; ++r) { p0[r] = __builtin_amdgcn_exp2f(p0[r] - mnew); p1[r] = __builtin_amdgcn_exp2f(p1[r] - mnew); sacc += p0[r] + p1[r]; }
      l_reg = l_reg * f + sacc;
      if (hi == 0) wsf[r32] = f;
      asm volatile("s_waitcnt lgkmcnt(0)" ::: "memory");
      #pragma unroll
      for (int d_ = 0; d_ < 2; ++d_)
        #pragma unroll
        for (int r = 0; r < 16; ++r) o[d_][r] *= wsf[crow(r, hi)];
      u32x4 pw0, pw1, pw2, pw3;
      pw0 = (u32x4){cvtpk(p0[0], p0[1]), cvtpk(p0[2], p0[3]), cvtpk(p0[4], p0[5]), cvtpk(p0[6], p0[7])}; pw1 = (u32x4){cvtpk(p0[8], p0[9]), cvtpk(p0[10], p0[11]), cvtpk(p0[12], p0[13]), cvtpk(p0[14], p0[15])};
      pw2 = (u32x4){cvtpk(p1[0], p1[1]), cvtpk(p1[2], p1[3]), cvtpk(p1[4], p1[5]), cvtpk(p1[6], p1[7])}; pw3 = (u32x4){cvtpk(p1[8], p1[9]), cvtpk(p1[10], p1[11]), cvtpk(p1[12], p1[13]), cvtpk(p1[14], p1[15])};
      asm volatile("s_waitcnt lgkmcnt(0)" ::: "memory");
      pv(o, vb0 + (int)so, __builtin_bit_cast(bf16x8, pw0), __builtin_bit_cast(bf16x8, pw1), __builtin_bit_cast(bf16x8, pw2), __builtin_bit_cast(bf16x8, pw3));
    }
  }
  #undef NA_DMA
  { auto rr = __builtin_amdgcn_permlane32_swap(__float_as_uint(l_reg), __float_as_uint(l_reg), false, false); l_reg = __uint_as_float(rr[0]) + __uint_as_float(rr[1]); }
  if (hi == 0) wsf[32 + r32] = l_reg; asm volatile("s_waitcnt lgkmcnt(0)" ::: "memory");
  bf16_t* stg = (bf16_t*)(shm + LDS_OST) + wid * 2048;
  #pragma unroll
  for (int r = 0; r < 16; ++r) { const int orow = crow(r, hi); const float rl = __builtin_amdgcn_rcpf(wsf[32 + orow]);
    #pragma unroll
    for (int d0 = 0; d0 < 2; ++d0) stg[orow * 64 + d0 * 32 + r32] = f2bf(o[d0][r] * rl); }
  asm volatile("s_waitcnt lgkmcnt(0)" ::: "memory");
  bf16* Ow = YS + (rowb + CTXL + rq * 64 + 32 * (wid & 1)) * 1024 + h * 64;
  #pragma unroll
  for (int i = 0; i < 4; ++i) { const int row = i * 8 + (lane >> 3), ch = lane & 7; const u32x4 v = *(const u32x4*)(stg + row * 64 + ch * 8); *(u32x4*)(Ow + (long)row * 1024 + ch * 8) = v; }
  asm volatile("s_waitcnt lgkmcnt(0)\n\ts_barrier" ::: "memory");
}
#undef SBAR
#undef WAIT_BAR
}

__device__ __forceinline__ void sgu_unit(long rowbase, const bf16_t* GU, const bf16_t* GV, const float* ng, const float* sw, const float* sb, bf16_t* YS, char* shm) {
    using attn_body::crow;
    const int tid = opaque_tid(), lane = tid & 63, wid = __builtin_amdgcn_readfirstlane(tid >> 6), r32 = lane & 31, hi = lane >> 5;
    const unsigned lds0 = (unsigned)(uintptr_t)shm;
    {
        const f32x4 g4 = *(const f32x4*)(ng + 4 * lane);
        const int gl = lane >> 4, d = 4 * (lane & 15);
#pragma unroll
        for (int rb = 0; rb < 4; ++rb) { v2u raw[4];
#pragma unroll
            for (int q4 = 0; q4 < 4; ++q4) raw[q4] = *(const v2u*)(GV + (rowbase + wid * 16 + rb * 4 + q4) * PQ + 4 * lane);
            __builtin_amdgcn_sched_barrier(0);
#pragma unroll
            for (int q4 = 0; q4 < 4; ++q4) { const int q = wid * 16 + rb * 4 + q4;
                f32x4 v = {bflo(raw[q4].x), bfhi(raw[q4].x), bflo(raw[q4].y), bfhi(raw[q4].y)};
                const float mean = wave_sum((v.x + v.y) + (v.z + v.w)) * (1.0f / 256.0f);
                v = v - mean;
                const float var = wave_sum((v.x * v.x + v.y * v.y) + (v.z * v.z + v.w * v.w)) * (1.0f / 256.0f);
                const float rstd = __builtin_amdgcn_rsqf(var + EPS);
                v = v * rstd * g4;
                v2u w; w.x = cvtpk(v.x, v.y); w.y = cvtpk(v.z, v.w);
                const int k = q & 63;
                *(v2u*)(shm + (2 * gl + (q >> 6)) * 8192 + ((d >> 5) * 4 + (k >> 4)) * 1024 + (k & 15) * 64 + (d & 31) * 2) = w; }
            __builtin_amdgcn_sched_barrier(0); }
    }
    __syncthreads();
    const int g = wid & 3, ph = wid >> 2;
    const int vb0 = (int)lds0 + ((lane >> 4) & 1) * 32 + (lane & 3) * 8 + (4 * hi + ((lane & 15) >> 2)) * 64;
    bf16_t* stg = (bf16_t*)(shm + 65536) + wid * 2048;
#pragma unroll
    for (int mt = 0; mt < 2; ++mt) {
        const int p0 = ph * 64 + mt * 32;
        const float* wrow = sw + ((size_t)g * 128 + p0 + r32) * 128 + 4 * hi;
        f32x16 o[2]; o[0] = f32x16{}; o[1] = f32x16{};
#pragma unroll
        for (int sl = 0; sl < 2; ++sl) {
            f32x4 wa[4], wc[4];
#pragma unroll
            for (int s4 = 0; s4 < 4; ++s4) { wa[s4] = *(const f32x4*)(wrow + 64 * sl + 16 * s4); wc[s4] = *(const f32x4*)(wrow + 64 * sl + 16 * s4 + 8); }
            __builtin_amdgcn_sched_barrier(0);
            bf16x8 pa[4];
#pragma unroll
            for (int s4 = 0; s4 < 4; ++s4) { const v4u w = {cvtpk(wa[s4].x, wa[s4].y), cvtpk(wa[s4].z, wa[s4].w), cvtpk(wc[s4].x, wc[s4].y), cvtpk(wc[s4].z, wc[s4].w)}; pa[s4] = __builtin_bit_cast(bf16x8, w); }
            attn_body::pv(o, vb0 + (2 * g + sl) * 8192, pa[0], pa[1], pa[2], pa[3]);
        }
        float bias[16];
#pragma unroll
        for (int r = 0; r < 16; ++r) bias[r] = sb[g * 128 + p0 + crow(r, hi)];
        v4u uu[4];
#pragma unroll
        for (int i = 0; i < 4; ++i) uu[i] = *(const v4u*)(GU + (rowbase + p0 + i * 8 + (lane >> 3)) * PQ + g * 64 + (lane & 7) * 8);
        __builtin_amdgcn_sched_barrier(0);
#pragma unroll
        for (int r = 0; r < 16; ++r) { const int orow = crow(r, hi);
#pragma unroll
            for (int d0 = 0; d0 < 2; ++d0) stg[orow * 64 + d0 * 32 + r32] = f2bf(o[d0][r] + bias[r]); }
        asm volatile("s_waitcnt lgkmcnt(0)" ::: "memory");
#pragma unroll
        for (int i = 0; i < 4; ++i) { const int row = i * 8 + (lane >> 3), ch = lane & 7; const v4u mv = *(const v4u*)(stg + row * 64 + ch * 8); const v4u u4 = uu[i];
            v4u w; w.x = cvtpk(bflo(u4.x) * bflo(mv.x), bfhi(u4.x) * bfhi(mv.x)); w.y = cvtpk(bflo(u4.y) * bflo(mv.y), bfhi(u4.y) * bfhi(mv.y));
            w.z = cvtpk(bflo(u4.z) * bflo(mv.z), bfhi(u4.z) * bfhi(mv.z)); w.w = cvtpk(bflo(u4.w) * bflo(mv.w), bfhi(u4.w) * bfhi(mv.w));
            *(v4u*)(YS + (rowbase + p0 + row) * 1024 + 512 + g * 64 + ch * 8) = w; }
        asm volatile("s_waitcnt lgkmcnt(0)" ::: "memory");
    }
    __syncthreads();
}

typedef GAS unsigned gu32;
#define XB_TMO      128
#define XB_XCNT(j)  (256  + 64 * (j))
#define XB_XSUB(j)  (1280 + 64 * (j))
#define XB_XGEN(j)  (2304 + 64 * (j))
#define XB_TOP      3328
#define XB_TOPGEN   3392
#define XCD_BAR_WORDS 3456
#define XB_SPIN_CAP (1u << 18)
__device__ __forceinline__ unsigned xb_ld(unsigned* p)              { return __hip_atomic_load(p, __ATOMIC_RELAXED, __HIP_MEMORY_SCOPE_AGENT); }
__device__ __forceinline__ unsigned xb_add(unsigned* p, unsigned v) { return __hip_atomic_fetch_add(p, v, __ATOMIC_RELAXED, __HIP_MEMORY_SCOPE_AGENT); }
__device__ __forceinline__ unsigned xb_xcc_id() { return (unsigned)__builtin_amdgcn_s_getreg((3 << 11) | 20) & 0xFu; }
#define XB_SPIN(cond, bar) do { unsigned _sp = 0; while (cond) { __builtin_amdgcn_s_sleep(1); \
    if ((++_sp & 255u) == 0u) { if (xb_ld(&(bar)[XB_TMO])) break; if (_sp > XB_SPIN_CAP) { atomicAdd(&(bar)[XB_TMO], 1u); break; } } } } while (0)
struct XcdBarrier { unsigned* bar; unsigned x; volatile LAS unsigned* st; };
__device__ __forceinline__ XcdBarrier xcd_barrier_post(unsigned* bar, volatile LAS unsigned* st) {
    XcdBarrier b; b.bar = bar; b.x = xb_xcc_id(); b.st = st;
    if (threadIdx.x == 0) (void)xb_add(&bar[XB_XCNT(b.x)], 1u);
    return b;
}
__device__ __forceinline__ void xcd_barrier_complete(unsigned* bar, unsigned x, unsigned& nloc, unsigned& nx) {
    const unsigned G = gridDim.x * gridDim.y * gridDim.z;
    unsigned sum, cnt, mine, sp = 0u;
    for (;;) {
        sum = 0u; cnt = 0u; mine = 0u;
#pragma unroll
        for (unsigned j = 0; j < 16; ++j) { const unsigned c = xb_ld(&bar[XB_XCNT(j)]); sum += c; cnt += (c > 0u) ? 1u : 0u; }
        if (sum == G) break;
        __builtin_amdgcn_s_sleep(1);
        if ((++sp & 255u) == 0u) { if (xb_ld(&bar[XB_TMO])) break; if (sp > XB_SPIN_CAP) { atomicAdd(&bar[XB_TMO], 1u); break; } }
    }
    mine = xb_ld(&bar[XB_XCNT(x)]);
    nloc = mine > 0u ? mine : 1u; nx = cnt > 0u ? cnt : 1u;
}
__device__ __forceinline__ void xcd_barrier(const XcdBarrier& b) {
    asm volatile("s_waitcnt vmcnt(0)" ::: "memory");
    __syncthreads();
    if (threadIdx.x == 0) {
        unsigned* bar = b.bar;
        __builtin_amdgcn_s_waitcnt(0);
        unsigned nloc = b.st[0], nx = b.st[1];
        if (nloc == 0u) { xcd_barrier_complete(bar, b.x, nloc, nx); b.st[0] = nloc; b.st[1] = nx; }
        const unsigned old = xb_add(&bar[XB_XSUB(b.x)], 1u);
        const unsigned gen = old / nloc;
        if (old + 1u == (gen + 1u) * nloc) {
            __builtin_amdgcn_fence(__ATOMIC_RELEASE, "agent");
            asm volatile("s_waitcnt vmcnt(0)" ::: "memory");
            const unsigned og = xb_add(&bar[XB_TOP], 1u);
            const unsigned tg = og / nx;
            if (og + 1u == (tg + 1u) * nx) xb_add(&bar[XB_TOPGEN], 1u);
            else XB_SPIN(xb_ld(&bar[XB_TOPGEN]) == tg, bar);
            __builtin_amdgcn_fence(__ATOMIC_ACQUIRE, "agent");
            xb_add(&bar[XB_XGEN(b.x)], 1u);
            asm volatile("s_waitcnt vmcnt(0)" ::: "memory");
        } else {
            XB_SPIN(xb_ld(&bar[XB_XGEN(b.x)]) == gen, bar);
            __builtin_amdgcn_fence(__ATOMIC_ACQUIRE, "agent");
            asm volatile("s_waitcnt vmcnt(0)" ::: "memory");
        }
    }
    __syncthreads();
}

struct Args { const float* in[28]; float* out; unsigned char* ws; int ph_lo, ph_hi, li, pad; };
typedef const __attribute__((address_space(4))) Args* KArgs;
__device__ __forceinline__ KArgs opaque_kargs() { KArgs p = (KArgs)__builtin_amdgcn_kernarg_segment_ptr(); asm volatile("" : "+s"(p)); return p; }
enum { I_X = 0, I_C, I_CTX, I_CCTX, I_WMOD, I_BMOD, I_N1G, I_N2G, I_WIN, I_QG, I_KG, I_RPB, I_LQ1, I_LK1, I_LQ2, I_LK2, I_SUBG, I_SGUNG, I_SGUW, I_SGUB, I_GATEB, I_WBR, I_WOUT, I_WRT, I_WEG, I_WEU, I_WED, I_FG };

constexpr int CW_WIN = 16 * 26, CW_WB = 4 * 4 * 4, CW_WO = 16 * 4, CW_EG = 16 * 16 * 8, CW_ED = 16 * 32 * 4, CW_LAYER = CW_WIN + CW_WB + CW_WO + 2 * CW_EG + CW_ED;
struct ConvItem { const float* src; unsigned char* dst; int N, dpitch, k0, n0, kind, aux; };
__device__ __forceinline__ ConvItem conv_decode(KArgs A, int it) {
    ConvItem c; const int l = it / CW_LAYER; int r = it % CW_LAYER; unsigned char* wl = A->ws + WS_W0 + (size_t)l * W_LAYER; c.aux = 0;
    if (r < CW_WIN) { const int kb = r / 26, pn = r % 26; c.src = A->in[I_WIN] + (size_t)l * DM * IN_W; c.N = IN_W; c.k0 = 64 * kb; c.n0 = 256 * pn; c.dpitch = DM;
        if (pn >= 5 && pn <= 20) { c.kind = 1; c.dst = wl + WO_WING + (size_t)(c.n0 - 1280) * DM; } else { c.kind = 2; c.dst = wl + WO_WIN + (size_t)256 * (pn < 5 ? pn : pn - 16) * DM * 2; }
        return c; }
    r -= CW_WIN;
    if (r < CW_WB) { const int n = r / 16, q = r % 16, kb = q / 4, nb = q % 4; c.src = A->in[I_WBR] + ((size_t)l * 4 + n) * 256 * DM; c.N = DM; c.k0 = 64 * kb; c.n0 = 256 * nb; c.dpitch = 256; c.kind = 0; c.dst = wl + WO_WB + ((size_t)n * 1024 + c.n0) * 256 * 2; return c; }
    r -= CW_WB;
    if (r < CW_WO) { const int kb = r / 4, nb = r % 4; c.src = A->in[I_WOUT] + (size_t)l * DM * DM; c.N = DM; c.k0 = 64 * kb; c.n0 = 256 * nb; c.dpitch = DM; c.kind = 0; c.dst = wl + WO_WO4 + (size_t)c.n0 * DM * 2; return c; }
    r -= CW_WO;
    if (r < 2 * CW_EG) { const int up = r >= CW_EG; if (up) r -= CW_EG; const int e = r / 128, q = r % 128, kb = q / 8, nb = q % 8; c.src = A->in[up ? I_WEU : I_WEG] + ((size_t)l * NEXP + e) * DM * EH; c.N = EH; c.k0 = 64 * kb; c.n0 = 256 * nb; c.dpitch = DM;
        c.kind = 3; c.aux = up ? 128 : 0; c.dst = wl + WO_WGU + (size_t)e * 4096 * DM; return c; }
    r -= 2 * CW_EG;
    { const int e = r / 128, q = r % 128, kb = q / 4, nb = q % 4; c.src = A->in[I_WED] + ((size_t)l * NEXP + e) * EH * DM; c.N = DM; c.k0 = 64 * kb; c.n0 = 256 * nb; c.dpitch = EH; c.kind = 1; c.dst = wl + WO_WD + ((size_t)e * DM + c.n0) * EH; return c; }
}
constexpr int CW_SMALL = CW_WIN + CW_WB + CW_WO, CW_MOE = 2 * CW_EG + CW_ED;
template <bool SMALL> __device__ __forceinline__ int conv_id(int it) { return SMALL ? (it / CW_SMALL) * CW_LAYER + it % CW_SMALL : it; }
template <bool SMALL> __device__ __forceinline__ void conv_load(KArgs A, int it, int NIT, f32x4 (&rg)[8], int wv, int lane) {
    if (it < NIT) { const ConvItem c = conv_decode(A, conv_id<SMALL>(it)); const float* p = c.src + (size_t)(c.k0 + wv * 8) * c.N + c.n0 + 4 * lane;
#pragma unroll
        for (int i = 0; i < 8; ++i) rg[i] = *(const f32x4*)(p + (size_t)i * c.N); }
}
template <bool SMALL> __device__ __forceinline__ void conv_out(KArgs A, int it, const f32x4 (&rg)[8], LAS float* T, int tid, int wv, int lane) {
    constexpr int TP = 256;
#pragma unroll
    for (int i = 0; i < 8; ++i) *(LAS f32x4*)(T + (wv * 8 + i) * TP + 4 * (lane ^ wv)) = rg[i];
    asm volatile("s_waitcnt lgkmcnt(0)" ::: "memory"); __builtin_amdgcn_s_barrier(); asm volatile("" ::: "memory");
    const ConvItem c = conv_decode(A, conv_id<SMALL>(it));
#pragma unroll
    for (int jj = 0; jj < 4; ++jj) { const int q = tid + 512 * jj, ch = q & 7, n = q >> 3; const LAS float* t = T + (8 * ch) * TP + (n ^ (4 * ch));
        float v[8];
#pragma unroll
        for (int i = 0; i < 8; ++i) v[i] = t[i * TP];
        if (c.kind == 1) { v2u o; o.x = pk8(v[0] * W8S, v[1] * W8S, v[2] * W8S, v[3] * W8S); o.y = pk8(v[4] * W8S, v[5] * W8S, v[6] * W8S, v[7] * W8S); *(v2u*)(c.dst + (size_t)n * c.dpitch + c.k0 + 8 * ch) = o; }
        else if (c.kind == 3) { const int f = c.n0 + n; v2u o; o.x = pk8(v[0] * W8S, v[1] * W8S, v[2] * W8S, v[3] * W8S); o.y = pk8(v[4] * W8S, v[5] * W8S, v[6] * W8S, v[7] * W8S); *(v2u*)(c.dst + (size_t)(256 * (f >> 7) + (f & 127) + c.aux) * c.dpitch + c.k0 + 8 * ch) = o; }
        else { const int g = n >> 5, row = c.kind == 2 ? 32 * (4 * (g & 1) + (g >> 1)) + (n & 31) : n; st8((bf16_t*)c.dst + (size_t)row * c.dpitch + c.k0 + 8 * ch, v); } }
    asm volatile("s_waitcnt lgkmcnt(0)" ::: "memory"); __builtin_amdgcn_s_barrier(); asm volatile("" ::: "memory");
}
template <bool SMALL = false> __device__ __forceinline__ void conv_run(KArgs A, int first, int stride, int end, LAS unsigned char* lds, int tid) {
    const int lane = tid & 63, wv = tid >> 6; LAS float* T = (LAS float*)lds;
    f32x4 rg[4][8];
#pragma unroll
    for (int d = 0; d < 4; ++d) conv_load<SMALL>(A, first + d * stride, end, rg[d], wv, lane);
    for (int it = first; it < end; it += 4 * stride) {
#pragma unroll
        for (int d = 0; d < 4; ++d) if (it + d * stride < end) {
            f32x4 t0[8];
#pragma unroll
            for (int i = 0; i < 8; ++i) t0[i] = rg[d][i];
            conv_load<SMALL>(A, it + (4 + d) * stride, end, rg[d], wv, lane);
            conv_out<SMALL>(A, it + d * stride, t0, T, tid, wv, lane);
        }
    }
}
__device__ __forceinline__ void mod_item(KArgs A, int item, LAS unsigned char* lds, int tid) {
    const int lane = tid & 63, wid = tid >> 6, l = item / 96, col0 = 64 * (item % 96);
    LAS float* sil = (LAS float*)lds;
    LAS float* part = sil + 3 * 1024;
    for (int i = tid; i < 3 * 1024; i += 512) { const int r = i >> 10, k = i & 1023; const float cv = r < 2 ? A->in[I_C][r * DM + k] : A->in[I_CCTX][k]; sil[i] = siluf_(cv); }
    __syncthreads();
    const float* W = A->in[I_WMOD] + (size_t)l * DM * 6144 + col0 + lane;
    float a0 = 0.f, a1 = 0.f, a2 = 0.f;
    for (int kb = 0; kb < 4; ++kb) { float w[32];
#pragma unroll
        for (int q = 0; q < 32; ++q) w[q] = W[(size_t)(wid * 128 + kb * 32 + q) * 6144];
        __builtin_amdgcn_sched_barrier(0);
#pragma unroll
        for (int q = 0; q < 32; ++q) { const int k = wid * 128 + kb * 32 + q; a0 += sil[k] * w[q]; a1 += sil[1024 + k] * w[q]; a2 += sil[2048 + k] * w[q]; }
        __builtin_amdgcn_sched_barrier(0); }
    part[(wid * 3 + 0) * 64 + lane] = a0; part[(wid * 3 + 1) * 64 + lane] = a1; part[(wid * 3 + 2) * 64 + lane] = a2;
    __syncthreads();
    if (tid < 192) { const int r = tid >> 6, cl = tid & 63; float s = A->in[I_BMOD][(size_t)l * 6144 + col0 + cl];
#pragma unroll
        for (int w = 0; w < 8; ++w) s += part[(w * 3 + r) * 64 + cl];
        ((float*)(A->ws + WS_MOD))[((size_t)l * 3 + r) * 6144 + col0 + cl] = s; }
    __syncthreads();
}

struct Row { f32x4 v[4]; };
__device__ __forceinline__ Row row_load(const float* p, int lane) { Row r; const f32x4* q = (const f32x4*)p + lane;
#pragma unroll
    for (int j = 0; j < 4; ++j) r.v[j] = q[64 * j]; return r; }
__device__ __forceinline__ Row row_load_bf16(const bf16_t* p, int lane) { Row r; const v2u* q = (const v2u*)p + lane; v2u t[4];
#pragma unroll
    for (int j = 0; j < 4; ++j) t[j] = q[64 * j];
#pragma unroll
    for (int j = 0; j < 4; ++j) r.v[j] = (f32x4){bflo(t[j].x), bfhi(t[j].x), bflo(t[j].y), bfhi(t[j].y)};
    return r; }
__device__ __forceinline__ void row_store(float* p, const Row& r, int lane) { f32x4* q = (f32x4*)p + lane;
#pragma unroll
    for (int j = 0; j < 4; ++j) q[64 * j] = r.v[j]; }
__device__ __forceinline__ float row_rstd(const Row& r) { float s = 0.f;
#pragma unroll
    for (int j = 0; j < 4; ++j) s += (r.v[j].x * r.v[j].x + r.v[j].y * r.v[j].y) + (r.v[j].z * r.v[j].z + r.v[j].w * r.v[j].w);
    return __builtin_amdgcn_rsqf(wave_sum(s) * (1.0f / DM) + EPS); }
__device__ __forceinline__ Row row_normmod(const Row& x, float rstd, const float* g, const float* sh, const float* sc, int lane) { Row y; f32x4 gg[4], ss[4], hh[4];
#pragma unroll
    for (int j = 0; j < 4; ++j) { gg[j] = ((const f32x4*)g)[lane + 64 * j]; ss[j] = ((const f32x4*)sc)[lane + 64 * j]; hh[j] = ((const f32x4*)sh)[lane + 64 * j]; }
    __builtin_amdgcn_sched_barrier(0);
#pragma unroll
    for (int j = 0; j < 4; ++j) y.v[j] = x.v[j] * rstd * gg[j] * (ss[j] + 1.0f) + hh[j];
    return y; }
struct NormP { f32x4 a[4], h[4]; };
__device__ __forceinline__ NormP normp_load(const float* g, const float* sh, const float* sc, int lane) { NormP p; f32x4 gg[4], ss[4];
#pragma unroll
    for (int j = 0; j < 4; ++j) { gg[j] = ((const f32x4*)g)[lane + 64 * j]; ss[j] = ((const f32x4*)sc)[lane + 64 * j]; p.h[j] = ((const f32x4*)sh)[lane + 64 * j]; }
    __builtin_amdgcn_sched_barrier(0);
#pragma unroll
    for (int j = 0; j < 4; ++j) p.a[j] = gg[j] * (ss[j] + 1.0f);
    return p; }
__device__ __forceinline__ Row row_normmod_p(const Row& x, float rstd, const NormP& p) { Row y;
#pragma unroll
    for (int j = 0; j < 4; ++j) y.v[j] = x.v[j] * rstd * p.a[j] + p.h[j];
    return y; }
__device__ __forceinline__ void row_store_bf16(bf16_t* p, const Row& r, int lane) { v2u* q = (v2u*)p + lane;
#pragma unroll
    for (int j = 0; j < 4; ++j) { v2u w; w.x = cvtpk(r.v[j].x, r.v[j].y); w.y = cvtpk(r.v[j].z, r.v[j].w); q[64 * j] = w; } }
__device__ __forceinline__ void row_store_fp8(unsigned char* p, const Row& r, int lane) { unsigned* q = (unsigned*)p + lane;
#pragma unroll
    for (int j = 0; j < 4; ++j) q[64 * j] = pk8(r.v[j].x, r.v[j].y, r.v[j].z, r.v[j].w); }
__device__ __forceinline__ const float* in_row(KArgs A, int R) { const int b = R / RB, r = R % RB; return r < CTXL ? A->in[I_CTX] + ((size_t)b * CTXL + r) * DM : A->in[I_X] + ((size_t)b * SEQ + (r - CTXL)) * DM; }
__device__ __forceinline__ int mod_row(int R) { const int b = R / RB, r = R % RB; return r < CTXL ? 2 : b; }

__device__ __forceinline__ int lat_tile(int im) { return (im >> 5) * TPB + 1 + (im & 31); }
struct SchedP1 { const char* HN; const char* W; int layer, G, c;
    __device__ __forceinline__ bool next(int i, pg8::Unit& u) const {
        const int nmain = 64 * 10, nextra = layer == 0 ? 2 * 10 : 2 * 5; const int L = i * G + c; if (L >= nmain + nextra) return false;
        int pm, pq;
        if (L < nmain) { int im, in; pg8::rect_order(L, 64, 10, im, in); pm = lat_tile(im); pq = in; }
        else { const int x = L - nmain; if (layer == 0) { pm = (x / 10) * TPB; pq = x % 10; } else { pm = (x / 5) * TPB; pq = 5 + x % 5; } }
        u.pm = pm; u.pn = pq < 5 ? pq : pq + 16; u.a = HN + (size_t)pm * 256 * DM * 2; u.b = W + (size_t)pq * 256 * DM * 2; return true; } };
struct SchedP1g { const char* HN8; const char* W8; int layer, G, c;
    __device__ __forceinline__ bool next(int i, pg8::Unit& u) const {
        const int nmain = 64 * 16, nextra = layer == 0 ? 2 * 16 : 0; const int L = i * G + (G - 1 - c); if (L >= nmain + nextra) return false;
        int pm, pn;
        if (L < nmain) { int im; pg8::rect_order(L, 64, 16, im, pn); pm = lat_tile(im); }
        else { const int x = L - nmain; pm = (x >> 4) * TPB; pn = x & 15; }
        u.pm = pm; u.pn = pn; u.a = HN8 + (size_t)pm * 256 * DM; u.b = W8 + (size_t)pn * 256 * DM; return true; } };
struct SchedP3a { const char* YS; const char* WB; int layer, G, c;
    __device__ __forceinline__ bool next(int i, pg8::Unit& u) const {
        int pm, dt, n;
        if (i < 4) { if (c >= 256) return false; int im; pg8::rect_order(c, 64, 4, im, dt); pm = lat_tile(im); n = i; }
        else { if (i > 4 || layer != 0 || c >= 32) return false; pm = (c >> 4) * TPB; dt = (c >> 2) & 3; n = c & 3; }
        u.pm = pm; u.pn = dt * 4 + n; u.a = YS + ((size_t)pm * 256 * DM + 256 * n) * 2; u.b = WB + ((size_t)n * 1024 + dt * 256) * 256 * 2; return true; } };
struct SchedP3b { const char* MRG; const char* WO; int G, c;
    __device__ __forceinline__ bool next(int i, pg8::Unit& u) const {
        const int L = i * G + c; if (L >= 64 * 4) return false;
        int im, in; pg8::rect_order(L, 64, 4, im, in); const int pm = lat_tile(im);
        u.pm = pm; u.pn = in; u.a = MRG + (size_t)pm * 256 * DM * 2; u.b = WO + (size_t)in * 256 * DM * 2; return true; } };
struct SchedP3c { const char* GPC; const char* WO; int G, c;
    __device__ __forceinline__ bool next(int i, pg8::Unit& u) const {
        const int L = i * G + c; if (L >= 128) return false;
        const int pm = L >> 6, ks = (L >> 2) & 15, ct = L & 3, n = ks >> 2, kq = ks & 3;
        u.pm = pm; u.pn = ks * 4 + ct; u.a = GPC + (((size_t)n * 512 + pm * 256) * DM + kq * 256) * 2; u.b = WO + ((size_t)ct * 256 * DM + kq * 256) * 2; return true; } };
struct SchedP6 { const char* XG; const char* WGU; int RT, G, c;
    __device__ __forceinline__ bool next(int i, pg8::Unit& u) const {
        const int nM = 16 * RT; const int L = i * G + c; if (L >= nM * 16) return false;
        int im, in; pg8::rect_order(L, nM, 16, im, in); const int e = im / RT;
        u.pm = im; u.pn = in; u.a = XG + (size_t)im * 256 * DM; u.b = WGU + ((size_t)e * 4096 + in * 256) * DM; return true; } };
struct SchedP7 { const char* HID; const char* WD; int RT, G, c;
    __device__ __forceinline__ bool next(int i, pg8::Unit& u) const {
        const int nM = 16 * 8; const int L = i * G + c; if (L >= nM * 4) return false;
        int im8, in; pg8::rect_order(L, nM, 4, im8, in); const int e = im8 >> 3, im = e * RT + (im8 & 7);
        u.pm = im; u.pn = in; u.a = HID + (size_t)im * 256 * EH; u.b = WD + ((size_t)e * DM + in * 256) * EH; return true; } };
struct SchedP7c { const char* HID; const char* WD; int G, c;
    __device__ __forceinline__ bool next(int i, pg8::Unit& u) const {
        const int L = i * G + c; if (L >= 256) return false;
        const int e = L >> 4, in = (L >> 2) & 3, kq = L & 3, im = e * 9 + 8;
        u.pm = im; u.pn = in + 4 * kq; u.a = HID + (size_t)im * 256 * EH + kq * 512; u.b = WD + ((size_t)e * DM + in * 256) * EH + kq * 512; return true; } };

__device__ __forceinline__ unsigned block_excl_scan(unsigned v, LAS unsigned* wtot, int lane, int wid) {
    unsigned inc = v;
#pragma unroll
    for (int o = 1; o < 64; o <<= 1) { const unsigned t = (unsigned)__builtin_amdgcn_ds_bpermute(((lane - o) & 63) << 2, (int)inc); if (lane >= o) inc += t; }
    if (lane == 63) wtot[wid] = inc;
    __syncthreads();
    unsigned base = 0;
#pragma unroll
    for (int w = 0; w < 8; ++w) base += (w < wid) ? wtot[w] : 0u;
    __syncthreads();
    return base + inc - v;
}
__device__ __forceinline__ void topk_unit(KArgs A, int RT, bool isctx, int b, int e, LAS unsigned char* lds, int tid) {
    const int lane = tid & 63, wid = tid >> 6;
    LAS unsigned* hist = (LAS unsigned*)lds; LAS unsigned* wtot = hist + 256; LAS unsigned* sel = wtot + 16;
    const int cap = isctx ? 32 : 1024;
    const float* aff = isctx ? (const float*)(A->ws + WS_AFFC) + ((size_t)b * 16 + e) * 256 : (const float*)(A->ws + WS_AFFL) + ((size_t)b * 16 + e) * 8192;
    unsigned key[16];
    if (isctx) {
#pragma unroll
        for (int j = 0; j < 16; ++j) key[j] = 0u;
        if (tid < 256) key[0] = __float_as_uint(aff[tid]);
    } else {
#pragma unroll
        for (int q = 0; q < 4; ++q) { const f32x4 t = *(const f32x4*)(aff + tid * 16 + 4 * q); key[4 * q] = __float_as_uint(t.x); key[4 * q + 1] = __float_as_uint(t.y); key[4 * q + 2] = __float_as_uint(t.z); key[4 * q + 3] = __float_as_uint(t.w); }
    }
#define TK_VALID(j) (isctx ? ((j) == 0 && tid < 256) : true)
    unsigned pfx = 0u, need = (unsigned)cap;
    for (int pass = 0; pass < 4; ++pass) { const int shift = 24 - 8 * pass;
        for (int i = tid; i < 256; i += 512) hist[i] = 0u;
        __syncthreads();
#pragma unroll
        for (int j = 0; j < 16; ++j) if (TK_VALID(j) && (pass == 0 || (key[j] >> (shift + 8)) == pfx)) __hip_atomic_fetch_add(&hist[(key[j] >> shift) & 255u], 1u, __ATOMIC_RELAXED, __HIP_MEMORY_SCOPE_WORKGROUP);
        __syncthreads();
        if (wid == 0) {
            const unsigned h0 = hist[4 * lane], h1 = hist[4 * lane + 1], h2 = hist[4 * lane + 2], h3 = hist[4 * lane + 3], s = h0 + h1 + h2 + h3;
            unsigned incl = s;
#pragma unroll
            for (int o = 1; o < 64; o <<= 1) { const unsigned t = (unsigned)__builtin_amdgcn_ds_bpermute(((lane + o) & 63) << 2, (int)incl); if (lane + o < 64) incl += t; }
            const unsigned excl = incl - s;
            if (excl < need && need <= incl) { unsigned c = excl; int bin;
                if (c + h3 >= need) bin = 3; else { c += h3; if (c + h2 >= need) bin = 2; else { c += h2; if (c + h1 >= need) bin = 1; else { c += h1; bin = 0; } } }
                sel[0] = (unsigned)(4 * lane + bin); sel[1] = need - c; }
        }
        __syncthreads();
        pfx = (pfx << 8) | sel[0]; need = sel[1];
        __syncthreads();
    }
    const unsigned T = pfx;
    unsigned ce = 0u;
#pragma unroll
    for (int j = 0; j < 16; ++j) ce += (TK_VALID(j) && key[j] == T) ? 1u : 0u;
    unsigned re = block_excl_scan(ce, wtot, lane, wid);
    unsigned selmask = 0u, cs = 0u;
#pragma unroll
    for (int j = 0; j < 16; ++j) if (TK_VALID(j)) { bool s = key[j] > T; if (key[j] == T) { s = re < need; ++re; } if (s) { selmask |= 1u << j; ++cs; } }
    unsigned slot = block_excl_scan(cs, wtot, lane, wid);
    int* IDXROW = (int*)(A->ws + WS_IDXROW); float* SCORE = (float*)(A->ws + WS_SCORE); int* INV = (int*)(A->ws + WS_INV);
    const int ybase = e * RT * 256 + (isctx ? 2048 + b * 32 : b * 1024);
#pragma unroll
    for (int j = 0; j < 16; ++j) if (TK_VALID(j)) { const int idx = isctx ? tid : tid * 16 + j; const int R = b * RB + (isctx ? idx : CTXL + idx);
        if (selmask & (1u << j)) { const int yrow = ybase + (int)slot; IDXROW[yrow] = R; SCORE[yrow] = __uint_as_float(key[j]); INV[((size_t)b * 16 + e) * RB + (R - b * RB)] = yrow; ++slot; }
        else INV[((size_t)b * 16 + e) * RB + (R - b * RB)] = -1; }
    if (isctx && b == 0 && tid < 192) IDXROW[e * RT * 256 + 2048 + 64 + tid] = -1;
#undef TK_VALID
    __syncthreads();
}

struct AJob { const attn_body::bf16 *Q, *K, *V; attn_body::bf16* O; int nt, mode; };
__device__ __forceinline__ bool mixer_job(unsigned char* ws, int l, int vcu, int i, AJob& j) {
    using attn_body::bf16;
    const bf16* QKV = (const bf16*)(ws + WS_QKV); bf16* YS = (bf16*)(ws + WS_YS);
    if (i < 3) { const int b = vcu >> 7, h = (vcu >> 5) & 3, qb = vcu & 31; const long q0 = (long)b * RB + CTXL + qb * 256, k0 = (long)b * RB;
        if (i < 2) { const int vh = 2 * h + i; j.Q = QKV + q0 * PQ + C_QB + vh * 64; j.K = QKV + k0 * PQ + C_KB + vh * 64; j.V = QKV + k0 * PQ + C_VB + h * 64; j.O = YS + q0 * 1024 + 256 + h * 64; j.nt = 132; j.mode = 1 + i; }
        else { j.Q = QKV + q0 * PQ + C_QD + h * 64; j.K = QKV + k0 * PQ + C_KD + (h >> 1) * 64; j.V = QKV + k0 * PQ + C_VD + (h >> 1) * 64; j.O = YS + q0 * 1024 + 768 + h * 64; j.nt = 132; j.mode = 0; }
        return true; }
    if (l != 0) return false;
    const int uc = (vcu + 256 - 132) & 255; if (uc >= 24) return false;
    const int type = uc >> 3, b = (uc >> 2) & 1, h = uc & 3, k = i - 3; const long q0 = (long)b * RB;
    j.nt = 4;
    if (type == 0) { if (k > 0) return false; j.Q = QKV + q0 * PQ + C_QA + h * 64; j.K = QKV + q0 * PQ + C_KA + h * 64; j.V = QKV + q0 * PQ + C_VA + h * 64; j.O = YS + q0 * 1024 + h * 64; j.mode = 0; return true; }
    if (type == 1) { if (k > 1) return false; const int vh = 2 * h + k; j.Q = QKV + q0 * PQ + C_QB + vh * 64; j.K = QKV + q0 * PQ + C_KB + vh * 64; j.V = QKV + q0 * PQ + C_VB + h * 64; j.O = YS + q0 * 1024 + 256 + h * 64; j.mode = 1 + k; return true; }
    if (k > 0) return false; j.Q = QKV + q0 * PQ + C_QD + h * 64; j.K = QKV + q0 * PQ + C_KD + (h >> 1) * 64; j.V = QKV + q0 * PQ + C_VD + (h >> 1) * 64; j.O = YS + q0 * 1024 + 768 + h * 64; j.mode = 0; return true;
}

__global__ void __launch_bounds__(512, 2) fwd_kernel(Args A_) {
    extern __shared__ __attribute__((aligned(16))) unsigned char lds[];
    LAS unsigned char* L = (LAS unsigned char*)lds;
    const int tid0 = threadIdx.x;
    const int G0 = gridDim.x, bx0 = blockIdx.x;
    unsigned char* ws = A_.ws;
    for (int u = tid0; u < (LDS_BYTES - LDSCTL_OFF) / 4; u += 512) ((LAS unsigned*)(L + LDSCTL_OFF))[u] = 0u;
    __syncthreads();
    XcdBarrier bar; bar.bar = (unsigned*)(ws + WS_CTL) + CW_BAR + A_.li * XCD_BAR_WORDS; bar.x = 0; bar.st = nullptr;
    if (!MK_PER_PHASE) bar = xcd_barrier_post((unsigned*)(ws + WS_CTL) + CW_BAR + A_.li * XCD_BAR_WORDS, (volatile LAS unsigned*)(L + MISC_OFF) + 8);
#define PHASE_PTRS KArgs A = opaque_kargs(); unsigned char* ws = A->ws; const int G = opaque_s(G0), bx = opaque_s(bx0), vcu = (bx % 8) * (G / 8) + bx / 8, wave = __builtin_amdgcn_readfirstlane(opaque_tid() >> 6), gw = vcu * 8 + wave, NGW = G * 8; (void)gw; (void)NGW; (void)vcu; const float* MOD = (const float*)(ws + WS_MOD); bf16_t* HN = (bf16_t*)(ws + WS_HN); bf16_t* H2 = (bf16_t*)(ws + WS_H2); bf16_t* YS = (bf16_t*)(ws + WS_YS); \
    bf16_t* GT = (bf16_t*)(ws + WS_GT); bf16_t* X1 = (bf16_t*)(ws + WS_X1); bf16_t* XR = (bf16_t*)(ws + WS_XR); float* PART = (float*)(ws + WS_PART); \
    (void)MOD; (void)HN; (void)H2; (void)YS; (void)GT; (void)X1; (void)XR; (void)PART;
    const int lo = A_.ph_lo, hi = A_.ph_hi;
#ifndef DBG_MASK
#define DBG_MASK 0xffffffffu
#endif
#define PHON(k) ((DBG_MASK >> ((k) < 2 ? (k) : 2 + ((k) - 2) % 10)) & 1u)
#define IN(k) (PHON(k) && lo <= (k) && (k) < hi)
#define SEAM(k) do { if (!MK_PER_PHASE && (k) + 1 < hi) { XcdBarrier b2_ = bar; b2_.bar = (unsigned*)opaque_ptr((unsigned char*)bar.bar); xcd_barrier(b2_); } } while (0)

    if (IN(0)) { PHASE_PTRS
        const int tid = opaque_tid(), lane = tid & 63; (void)tid; (void)lane;
        for (int item = bx; item < 192; item += G) mod_item(A, item, L, tid);
        __syncthreads();
        SEAM(0);
    }
    if (IN(1)) { PHASE_PTRS
        const int tid = opaque_tid(), lane = tid & 63; (void)tid; (void)lane;
        { const int Ra = gw * 9, Rb = min(Ra + 9, NR);
          Row xn = row_load(in_row(A, min(Ra, NR - 1)), lane), xn2 = row_load(in_row(A, min(Ra + 1, NR - 1)), lane), xn3 = row_load(in_row(A, min(Ra + 2, NR - 1)), lane);
          int cur = mod_row(min(Ra, NR - 1)); NormP np; { const float* m = MOD + (size_t)cur * 6144; np = normp_load(A->in[I_N1G], m, m + 1024, lane); }
          for (int R = Ra; R < Rb; ++R) { const Row x = xn; xn = xn2; xn2 = xn3; if (R + 3 < Rb) xn3 = row_load(in_row(A, R + 3), lane);
            const int mr = mod_row(R); if (mr != cur) { const float* m = MOD + (size_t)mr * 6144; np = normp_load(A->in[I_N1G], m, m + 1024, lane); cur = mr; }
            const Row y = row_normmod_p(x, row_rstd(x), np); row_store_bf16(HN + (size_t)R * DM, y, lane); row_store_fp8(ws + WS_HN8 + (size_t)R * DM, y, lane); } }
        __syncthreads();
        conv_run<true>(A, vcu, G, DEPTH * CW_SMALL, L, tid);
        SEAM(1);
    }
    for (int l = 0; l < DEPTH; ++l) {
        const int P = 2 + 10 * l; const int RT = l == 0 ? 9 : 8;
#define LAYER_PTRS PHASE_PTRS unsigned char* wl = ws + WS_W0 + (size_t)l * W_LAYER; const float* MODL = MOD + (size_t)l * 3 * 6144; (void)wl; (void)MODL;
        if (IN(P + 0)) { LAYER_PTRS
            { SchedP1 S{(const char*)HN, (const char*)(wl + WO_WIN), l, G, bx};
              EpiInProj E{(bf16_t*)(ws + WS_QKV), GT, A->in[I_QG] + l * 64, A->in[I_KG] + l * 64, A->in[I_GATEB] + (size_t)l * 4096};
              pg8::gemm_phase<EpiInProj, SchedP1>(L, DM, DM, DM, S, E); }
            { SchedP1g S{(const char*)(ws + WS_HN8), (const char*)(wl + WO_WING), l, G, bx}; EpiGates E{(unsigned char*)GT, A->in[I_GATEB] + (size_t)l * 4096};
              pg8::gemm8_phase<EpiGates, SchedP1g>(L, DM / 2, DM / 2, DM / 2, S, E); }
            SEAM(P + 0);
        }
        if (IN(P + 1)) { LAYER_PTRS
            const int tid = opaque_tid(), lane = tid & 63; (void)tid; (void)lane;
            float s1 = lane < 32 ? A->in[I_LQ1][l * 32 + lane] * A->in[I_LK1][l * 32 + lane] : 0.f, s2 = lane < 32 ? A->in[I_LQ2][l * 32 + lane] * A->in[I_LK2][l * 32 + lane] : 0.f;
            const float lam_init = l == 0 ? 0.2f : 0.35550906759096934f;
            const float lam = expf(wave_sum(s1)) - expf(wave_sum(s2)) + lam_init;
            const attn_body::DiffEpi de{lam, 1.0f - lam_init, A->in[I_SUBG] + l * 64};
            const int cslot = vcu & 3, cbase = l * CW_LAYER + CW_SMALL + vcu * (CW_MOE / 256);
#define CONV_SEAM(k) do { if (cslot == (k)) conv_run(A, cbase, 1, cbase + CW_MOE / 256, L, opaque_tid()); } while (0)
            static_assert(CW_MOE % 256 == 0, "expert-weight items split evenly over 256 CUs");
            CONV_SEAM(0);
            AJob j;
            for (int i = 0; mixer_job(ws, l, vcu, i, j); ++i) {
                if (i == 2) CONV_SEAM(1);
                if (i == 3) CONV_SEAM(2);
                if (j.mode == 0) attn_body::attn_unit<8, 0>(j.Q, j.K, j.V, j.nt, j.O, (char*)lds, de);
                else if (j.mode == 1) attn_body::attn_unit<8, 1>(j.Q, j.K, j.V, j.nt, j.O, (char*)lds, de);
                else attn_body::attn_unit<8, 2>(j.Q, j.K, j.V, j.nt, j.O, (char*)lds, de);
            }
            if (l != 0 || ((vcu + 256 - 132) & 255) >= 24) CONV_SEAM(2);
            { const int b = vcu >> 7, h = (vcu >> 5) & 3, g4 = vcu & 31;
              attn_body::na_unit(b, h, g4, (const attn_body::bf16*)(ws + WS_QKV), (attn_body::bf16*)YS, A->in[I_RPB] + ((size_t)l * 4 + h) * 465, (char*)lds); }
            CONV_SEAM(3);
            const int nsgu = 128 + (l == 0 ? 4 : 0);
            if (vcu < nsgu) { const long rowbase = vcu < 128 ? (long)(vcu >> 6) * RB + CTXL + (vcu & 63) * 128 : (long)((vcu - 128) >> 1) * RB + ((vcu - 128) & 1) * 128;
                sgu_unit(rowbase, (const bf16_t*)(ws + WS_QKV) + C_GU, (const bf16_t*)(ws + WS_QKV) + C_GV, A->in[I_SGUNG] + l * 256, A->in[I_SGUW] + (size_t)l * 4 * 128 * 128, A->in[I_SGUB] + l * 4 * 128, YS, (char*)lds); }
            SEAM(P + 1);
        }
        if (IN(P + 2)) { LAYER_PTRS
            SchedP3a S{(const char*)YS, (const char*)(wl + WO_WB), l, G, bx}; EpiGateAcc E{(const unsigned char*)GT, (bf16_t*)(ws + WS_MRG), (bf16_t*)(ws + WS_GPC)};
            pg8::gemm_phase<EpiGateAcc, SchedP3a>(L, 256, DM, 256, S, E);
            SEAM(P + 2);
        }
        if (IN(P + 3)) { LAYER_PTRS
            { SchedP3b S{(const char*)(ws + WS_MRG), (const char*)(wl + WO_WO4), G, bx}; EpiOutRes E{A->in[I_X], A->in[I_CTX], XR, X1, MODL, l};
              pg8::gemm_phase<EpiOutRes, SchedP3b>(L, DM, DM, DM, S, E); }
            if (l == 0) { SchedP3c S{(const char*)(ws + WS_GPC), (const char*)(wl + WO_WO4), G, bx}; EpiPart E{PART};
              pg8::gemm_phase<EpiPart, SchedP3c>(L, 256, DM, DM, S, E); }
            SEAM(P + 3);
        }
        if (IN(P + 4)) { LAYER_PTRS
            const int tid = opaque_tid(), lane = tid & 63; (void)tid; (void)lane;
            LAS float* wrT = (LAS float*)L;
            const float* wr = A->in[I_WRT] + (size_t)l * DM * 16;
            { f32x4 wv[8];
#pragma unroll
              for (int q = 0; q < 8; ++q) wv[q] = ((const f32x4*)wr)[tid + 512 * q];
              __builtin_amdgcn_sched_barrier(0);
#pragma unroll
              for (int q = 0; q < 8; ++q) { const int i4 = tid + 512 * q, k = i4 >> 2, e0 = (i4 & 3) * 4;
#pragma unroll
                  for (int j = 0; j < 4; ++j) wrT[(e0 + j) * DM + k] = wv[q][j]; } }
            __syncthreads();
            const int nit = 8 + ((l == 0 && gw < 512) ? 1 : 0);
            Row xn; { const int i0 = gw * 8; xn = row_load_bf16(X1 + ((size_t)(i0 >> 13) * RB + CTXL + (i0 & 8191)) * DM, lane); }
            NormP np; { const float* m0 = MODL + (size_t)((gw * 8) >> 13) * 6144; np = normp_load(A->in[I_N2G] + l * DM, m0 + 3072, m0 + 4096, lane); }
            for (int it = 0; it < nit; ++it) { const int i = it < 8 ? gw * 8 + it : 16384 + gw; const bool isctx = i >= 16384; const int b = isctx ? (i - 16384) >> 8 : i >> 13, r = isctx ? (i - 16384) & 255 : CTXL + (i & 8191); const int R = b * RB + r;
                const float* m = MODL + (size_t)(isctx ? 2 : b) * 6144;
                Row x = xn;
                if (it + 1 < 8) { const int in = i + 1; xn = row_load_bf16(X1 + ((size_t)(in >> 13) * RB + CTXL + (in & 8191)) * DM, lane); }
                if (isctx) { x = row_load(in_row(A, R), lane); Row s;
#pragma unroll
                    for (int j = 0; j < 4; ++j) s.v[j] = (f32x4){0.f, 0.f, 0.f, 0.f};
                    for (int ks = 0; ks < 16; ks += 4) { Row p[4];
#pragma unroll
                        for (int q = 0; q < 4; ++q) p[q] = row_load(PART + ((size_t)(ks + q) * 512 + b * 256 + r) * DM, lane);
                        __builtin_amdgcn_sched_barrier(0);
#pragma unroll
                        for (int q = 0; q < 4; ++q)
#pragma unroll
                            for (int j = 0; j < 4; ++j) s.v[j] += p[q].v[j]; }
#pragma unroll
                    for (int j = 0; j < 4; ++j) x.v[j] += ((const f32x4*)(m + 2048))[lane + 64 * j] * s.v[j];
                    row_store_bf16(X1 + (size_t)R * DM, x, lane);
                }
                if (isctx) np = normp_load(A->in[I_N2G] + l * DM, m + 3072, m + 4096, lane);
                const Row h = row_normmod_p(x, row_rstd(x), np);
                { unsigned* hq = (unsigned*)((unsigned char*)H2 + (size_t)R * DM) + lane;
#pragma unroll
                  for (int j = 0; j < 4; ++j) hq[64 * j] = pk8(h.v[j].x, h.v[j].y, h.v[j].z, h.v[j].w); }
                float lg[16];
#pragma unroll
                for (int e = 0; e < 16; ++e) { f32x2 a2 = (f32x2){0.f, 0.f};
#pragma unroll
                    for (int j = 0; j < 4; ++j) { const f32x4 w = *(const LAS f32x4*)(wrT + e * DM + 4 * lane + 256 * j);
                        a2 = __builtin_elementwise_fma((f32x2){h.v[j].x, h.v[j].y}, (f32x2){w.x, w.y}, a2); a2 = __builtin_elementwise_fma((f32x2){h.v[j].z, h.v[j].w}, (f32x2){w.z, w.w}, a2); }
                    lg[e] = a2.x + a2.y; if ((e & 3) == 3) __builtin_amdgcn_sched_barrier(0); }
                float c8[8], d[4];
#pragma unroll
                for (int i = 0; i < 8; ++i) { auto rr = __builtin_amdgcn_permlane32_swap(__float_as_uint(lg[i]), __float_as_uint(lg[i + 8]), false, false); c8[i] = __uint_as_float(rr[0]) + __uint_as_float(rr[1]); }
#pragma unroll
                for (int i = 0; i < 4; ++i) { auto rr = __builtin_amdgcn_permlane16_swap(__float_as_uint(c8[i]), __float_as_uint(c8[i + 4]), false, false); d[i] = row16_sum(__uint_as_float(rr[0]) + __uint_as_float(rr[1])); }
                float mx = fmaxf(fmaxf(d[0], d[1]), fmaxf(d[2], d[3]));
                { auto rr = __builtin_amdgcn_permlane16_swap(__float_as_uint(mx), __float_as_uint(mx), false, false); mx = fmaxf(__uint_as_float(rr[0]), __uint_as_float(rr[1])); }
                { auto rr = __builtin_amdgcn_permlane32_swap(__float_as_uint(mx), __float_as_uint(mx), false, false); mx = fmaxf(__uint_as_float(rr[0]), __uint_as_float(rr[1])); }
#pragma unroll
                for (int i = 0; i < 4; ++i) d[i] = __expf(d[i] - mx);
                const float sum = xor32_sum(xor16_sum((d[0] + d[1]) + (d[2] + d[3])));
                const int li = lane & 15, ex = 4 * (lane >> 4) + li;
                float mine = li == 0 ? d[0] : li == 1 ? d[1] : li == 2 ? d[2] : d[3];
                mine = mine / sum;
                if (li < 4) { if (isctx) ((float*)(ws + WS_AFFC))[((size_t)b * 16 + ex) * 256 + r] = mine; else ((float*)(ws + WS_AFFL))[((size_t)b * 16 + ex) * 8192 + (r - CTXL)] = mine; }
            }
            SEAM(P + 4);
        }
        if (IN(P + 5)) { LAYER_PTRS
            const int tid = opaque_tid(), lane = tid & 63; (void)tid; (void)lane;
            const int nun = l == 0 ? 64 : 32;
            for (int u = vcu; u < nun; u += G) topk_unit(A, RT, u >= 32, (u >> 4) & 1, u & 15, L, tid);
            SEAM(P + 5);
        }
        if (IN(P + 6)) { LAYER_PTRS
            const int tid = opaque_tid(), lane = tid & 63; (void)tid; (void)lane;
            const int* IDXROW = (const int*)(ws + WS_IDXROW); unsigned char* XG = ws + WS_XG;
            const int nyr = 16 * RT * 256;
            for (int y0 = gw; y0 < nyr; y0 += 9 * NGW) { int src[9]; v4u a[9];
#pragma unroll
                for (int q = 0; q < 9; ++q) { const int y = y0 + q * NGW; src[q] = y < nyr ? IDXROW[y] : -1; }
                __builtin_amdgcn_sched_barrier(0);
#pragma unroll
                for (int q = 0; q < 9; ++q) { a[q] = (v4u){0u, 0u, 0u, 0u}; if (src[q] >= 0) a[q] = ((const v4u*)((const unsigned char*)H2 + (size_t)src[q] * DM))[lane]; }
                __builtin_amdgcn_sched_barrier(0);
#pragma unroll
                for (int q = 0; q < 9; ++q) { const int y = y0 + q * NGW; if (y < nyr) ((v4u*)(XG + (size_t)y * DM))[lane] = a[q]; } }
            SEAM(P + 6);
        }
        if (IN(P + 7)) { LAYER_PTRS
            SchedP6 S{(const char*)(ws + WS_XG), (const char*)(wl + WO_WGU), RT, G, bx}; EpiSwiGLU E{ws + WS_HID};
            pg8::gemm8_phase<EpiSwiGLU, SchedP6>(L, DM / 2, DM / 2, DM / 2, S, E);
            SEAM(P + 7);
        }
        if (IN(P + 8)) { LAYER_PTRS
            SchedP7 S{(const char*)(ws + WS_HID), (const char*)(wl + WO_WD), RT, G, bx}; EpiDown E{(bf16_t*)(ws + WS_Y), (const float*)(ws + WS_SCORE)};
            pg8::gemm8_phase<EpiDown, SchedP7>(L, EH / 2, EH / 2, EH / 2, S, E);
            if (l == 0) { SchedP7c S2{(const char*)(ws + WS_HID), (const char*)(wl + WO_WD), G, bx}; EpiDownPart E2{(bf16_t*)(ws + WS_XG), (const float*)(ws + WS_SCORE)};
              pg8::gemm8_phase<EpiDownPart, SchedP7c>(L, 256, EH / 2, EH / 2, S2, E2); }
            SEAM(P + 8);
        }
        if (IN(P + 9)) { LAYER_PTRS
            const int tid = opaque_tid(), lane = tid & 63; (void)tid; (void)lane;
            const int* INV = (const int*)(ws + WS_INV); const bf16_t* Y = (const bf16_t*)(ws + WS_Y);
#define P8_INV(R_) (lane < 16 ? INV[((size_t)((R_) / RB) * 16 + lane) * RB + (R_) % RB] : -1)
#define P8_YISSUE(INVV, W, KEEP, REST) do { unsigned mk_ = (unsigned)(__ballot((INVV) >= 0) & 0xffffull); \
                _Pragma("unroll") for (int k = 0; k < 4; ++k) { const bool have = mk_ != 0u; const int e = have ? __builtin_ctz(mk_) : 0; mk_ &= mk_ - 1u; \
                    const int yr = have ? __builtin_amdgcn_readlane((INVV), e) : 0; const v2u* yp = (const v2u*)(Y + (size_t)yr * DM) + lane; KEEP[k] = have ? 0xffffffffu : 0u;     \
                    _Pragma("unroll") for (int j = 0; j < 4; ++j) W[k][j] = yp[64 * j]; } REST = mk_; } while (0)
            Row xn; int invn, invf; v2u wn[4][4]; unsigned kn[4], restn;
            { const int R0 = min(gw * 9, NR - 1); xn = row_load_bf16(X1 + (size_t)R0 * DM, lane); invn = P8_INV(R0); P8_YISSUE(invn, wn, kn, restn); const int R1 = min(R0 + 1, NR - 1); invf = P8_INV(R1); }
            int curm; NormP np; f32x4 g2v[4];
#define P8_PARAMS(mr_) do { const float* m_ = MODL + (size_t)(mr_) * 6144; \
                _Pragma("unroll") for (int j = 0; j < 4; ++j) g2v[j] = ((const f32x4*)(m_ + 5120))[lane + 64 * j]; \
                if (l + 1 < DEPTH) { const float* m1 = MOD + ((size_t)(l + 1) * 3 + (mr_)) * 6144; np = normp_load(A->in[I_N1G] + (l + 1) * DM, m1, m1 + 1024, lane); } \
                else { _Pragma("unroll") for (int j = 0; j < 4; ++j) { np.a[j] = ((const f32x4*)A->in[I_FG])[lane + 64 * j]; np.h[j] = np.a[j]; } } \
                __builtin_amdgcn_sched_barrier(0); } while (0)
            { const int R0 = min(gw * 9, NR - 1); curm = (R0 % RB) < CTXL ? 2 : R0 / RB; P8_PARAMS(curm); }
            for (int k9 = 0; k9 < 9; ++k9) { const int R = gw * 9 + k9; if (R >= NR) break; const int b = R / RB, r = R % RB; const bool isctx = r < CTXL;
                Row x = xn; const int myinv = invn; v2u w0[4][4]; unsigned k0[4]; unsigned msk = restn;
#pragma unroll
                for (int k = 0; k < 4; ++k) { k0[k] = kn[k];
#pragma unroll
                    for (int j = 0; j < 4; ++j) w0[k][j] = wn[k][j]; }
                if (k9 + 1 < 9 && R + 1 < NR) { const int Rn = R + 1; xn = row_load_bf16(X1 + (size_t)Rn * DM, lane); invn = invf; P8_YISSUE(invn, wn, kn, restn); const int Rf = min(R + 2, NR - 1); invf = P8_INV(Rf); }
                if (l == 1 && isctx) continue;
                const float* m = MODL + (size_t)(isctx ? 2 : b) * 6144;
                Row s;
#pragma unroll
                for (int j = 0; j < 4; ++j) s.v[j] = (f32x4){0.f, 0.f, 0.f, 0.f};
#pragma unroll
                for (int k = 0; k < 4; ++k)
#pragma unroll
                    for (int j = 0; j < 4; ++j) s.v[j] += (f32x4){bflo(w0[k][j].x & k0[k]), bfhi(w0[k][j].x & k0[k]), bflo(w0[k][j].y & k0[k]), bfhi(w0[k][j].y & k0[k])};
                if (isctx) {
#pragma unroll
                    for (int j = 0; j < 4; ++j) s.v[j] = (f32x4){0.f, 0.f, 0.f, 0.f};
                    msk = 0u; unsigned mk = (unsigned)(__ballot(myinv >= 0) & 0xffffull); const bf16_t* YP = (const bf16_t*)(ws + WS_XG);
                    while (mk) { const int e = __builtin_ctz(mk); mk &= mk - 1u; const int yr = __builtin_amdgcn_readlane(myinv, e); const int ex = yr / 2304, rr = yr % 2304 - 2048;
                        v2u t[4][4];
#pragma unroll
                        for (int kq = 0; kq < 4; ++kq) { const v2u* yp = (const v2u*)(YP + ((size_t)(kq * 16 + ex) * 256 + rr) * DM) + lane;
#pragma unroll
                            for (int j = 0; j < 4; ++j) t[kq][j] = yp[64 * j]; }
                        __builtin_amdgcn_sched_barrier(0);
#pragma unroll
                        for (int kq = 0; kq < 4; ++kq)
#pragma unroll
                            for (int j = 0; j < 4; ++j) s.v[j] += (f32x4){bflo(t[kq][j].x), bfhi(t[kq][j].x), bflo(t[kq][j].y), bfhi(t[kq][j].y)}; } }
                while (msk) {
                    v2u w[4][4];
#pragma unroll
                    for (int k = 0; k < 4; ++k) { const bool have = msk != 0u; const int e = have ? __builtin_ctz(msk) : 0; msk &= msk - 1u; if (!have) msk = 0u;
                        const int yr = have ? __builtin_amdgcn_readlane(myinv, e) : 0;
                        const v2u* yp = (const v2u*)(Y + (size_t)yr * DM) + lane; const unsigned keep = have ? 0xffffffffu : 0u;
#pragma unroll
                        for (int j = 0; j < 4; ++j) { v2u t = yp[64 * j]; t.x &= keep; t.y &= keep; w[k][j] = t; } }
#pragma unroll
                    for (int k = 0; k < 4; ++k)
#pragma unroll
                        for (int j = 0; j < 4; ++j) s.v[j] += (f32x4){bflo(w[k][j].x), bfhi(w[k][j].x), bflo(w[k][j].y), bfhi(w[k][j].y)};
                }
                { const int mr = isctx ? 2 : b; if (mr != curm) { curm = mr; P8_PARAMS(mr); } }
#pragma unroll
                for (int j = 0; j < 4; ++j) x.v[j] += g2v[j] * s.v[j];
                const float rstd = row_rstd(x);
                if (l + 1 < DEPTH) { row_store_bf16(XR + (size_t)R * DM, x, lane);
                    const Row y = row_normmod_p(x, rstd, np); row_store_bf16(HN + (size_t)R * DM, y, lane); if (!isctx) row_store_fp8(ws + WS_HN8 + (size_t)R * DM, y, lane); }
                else { Row y;
#pragma unroll
                    for (int j = 0; j < 4; ++j) y.v[j] = x.v[j] * rstd * np.a[j];
                    row_store(A->out + ((size_t)b * SEQ + (r - CTXL)) * DM, y, lane); }
            }
            SEAM(P + 9);
        }
    }
#undef IN
#undef SEAM
}

extern "C" void kernel_launch(void* const* d_in, const int* in_sizes, int n_in, void* d_out, int out_size, void* d_ws, size_t ws_size, hipStream_t stream) {
    static int grid = 0;
    if (grid == 0) {
        if (n_in != 28 || out_size != NB * SEQ * DM || ws_size < WS_END) { fprintf(stderr, "kernel_launch: unexpected shapes (n_in %d, out %d, ws %zu < %zu)\n", n_in, out_size, ws_size, (size_t)WS_END); grid = -1; return; }
        int dev = 0, cus = 0, per_cu = 0;
        if (hipGetDevice(&dev) != hipSuccess || hipDeviceGetAttribute(&cus, hipDeviceAttributeMultiprocessorCount, dev) != hipSuccess) { grid = -1; return; }
        if (hipFuncSetAttribute((const void*)fwd_kernel, hipFuncAttributeMaxDynamicSharedMemorySize, LDS_BYTES) != hipSuccess) { fprintf(stderr, "kernel_launch: hipFuncSetAttribute failed\n"); grid = -1; return; }
        if (hipOccupancyMaxActiveBlocksPerMultiprocessor(&per_cu, (const void*)fwd_kernel, 512, LDS_BYTES) != hipSuccess || per_cu < 1) fprintf(stderr, "kernel_launch: occupancy query reports %d blocks/CU\n", per_cu);
        (void)hipGetLastError();
        if (cus != 256) { fprintf(stderr, "kernel_launch: built for 256 CUs, device has %d\n", cus); grid = -1; return; }
        grid = 256;
    }
    if (grid < 0) return;
    (void)hipMemsetAsync((char*)d_ws + WS_CTL, 0, CTL_ZERO_BYTES, stream);
    Args a{};
    for (int i = 0; i < 28; ++i) a.in[i] = (const float*)d_in[i];
    a.out = (float*)d_out; a.ws = (unsigned char*)d_ws;
#if MK_PER_PHASE
    for (int p = 0; p < NPHASE; ++p) { a.ph_lo = p; a.ph_hi = p + 1; hipLaunchKernelGGL(fwd_kernel, dim3(grid), dim3(512), LDS_BYTES, stream, a); }
#elif defined(PROBE_REPEAT)
    { const int reps[] = {PROBE_REPEAT}; const int nr = sizeof(reps) / sizeof(int); int lo = 0;
      for (int i = 0; i <= nr; ++i) { a.ph_lo = lo; a.ph_hi = i < nr ? reps[i] + 1 : NPHASE; a.li = i; hipLaunchKernelGGL(fwd_kernel, dim3(grid), dim3(512), LDS_BYTES, stream, a); if (i < nr) lo = reps[i]; } }
#else
    a.ph_lo = 0; a.ph_hi = NPHASE; hipLaunchKernelGGL(fwd_kernel, dim3(grid), dim3(512), LDS_BYTES, stream, a);
#endif
}
```

```cpp
#include <hip/hip_runtime.h>
#include <hip/hip_bf16.h>
#include <cstdio>
#include <cstdint>
#include <cmath>

#ifndef MK_PER_PHASE
#define MK_PER_PHASE 0
#endif

constexpr int DM = 1024, NB = 2, SEQ = 8192, CTXL = 256, RB = SEQ + CTXL, NR = NB * RB, DEPTH = 2;
constexpr int IN_W = 6656, NEXP = 16, EH = 2048, TPB = RB / 256  ;
constexpr float EPS = 1e-6f, LOG2E = 1.4426950408889634f;
constexpr float C2A = 0.125f * LOG2E;
constexpr float C2B = 0.17677669529663687f * LOG2E;
constexpr int NPHASE = 2 + 10 * DEPTH;

constexpr size_t MiB = 1u << 20, KiB128 = 131072;
constexpr size_t WS_CTL = 0, CTL_ZERO_BYTES = 1 * MiB;
constexpr size_t WS_MOD = 1 * MiB;
constexpr size_t WS_AFFL = 2 * MiB, WS_AFFC = 3 * MiB;
constexpr size_t WS_IDXROW = 4 * MiB, WS_SCORE = 4 * MiB + 512 * 1024, WS_INV = 5 * MiB;
constexpr size_t WS_GPC = 8 * MiB;
constexpr size_t WS_W0 = 24 * MiB, W_LAYER = 215 * MiB;
constexpr size_t WO_WING = 8 * MiB  , WO_WIN = 0  , WO_WB = 13 * MiB, WO_WO4 = 15 * MiB, WO_WGU = 23 * MiB, WO_WD = 151 * MiB;
constexpr size_t WS_HN = 454 * MiB;
constexpr size_t WS_QKV = 487 * MiB;
constexpr int PQ = 3136;
constexpr int C_QA = 0, C_KA = 256, C_VA = 512, C_QB = 768, C_KB = 1280, C_VB = 1792, C_QD = 2048, C_KD = 2304, C_VD = 2432, C_GU = 2560, C_GV = 2816;
constexpr size_t WS_Y = WS_QKV;
constexpr size_t WS_GT = 589 * MiB;
constexpr size_t WS_YS = 721 * MiB;
constexpr size_t WS_HID = WS_GT;
constexpr size_t WS_X1 = 754 * MiB, WS_XR = 820 * MiB, WS_H2 = 886 * MiB, WS_XG = 919 * MiB, WS_MRG = WS_H2, WS_PART = WS_XG  , WS_HN8 = 991 * MiB  , WS_END = 1008 * MiB;
static_assert(WS_QKV + (size_t)NR * PQ * 2 <= WS_GT && WS_Y + (size_t)16 * 9 * 256 * 1024 * 2 <= WS_GT && WS_HID + (size_t)16 * 9 * 256 * 2048 * 2 <= WS_X1 && WS_YS + (size_t)NR * 1024 * 2 <= WS_X1, "ws map");

constexpr int CW_BAR = 4096;

constexpr int RING_BYTES = 131072, LDSCTL_OFF = RING_BYTES, MISC_OFF = LDSCTL_OFF + 320, LDS_BYTES = 147456;

#define GAS __attribute__((address_space(1)))
#define LAS __attribute__((address_space(3)))
typedef unsigned short bf16_t;
typedef unsigned v4u __attribute__((ext_vector_type(4)));
typedef unsigned v2u __attribute__((ext_vector_type(2)));
typedef float f32x4 __attribute__((ext_vector_type(4)));
typedef float f32x2 __attribute__((ext_vector_type(2)));
typedef float f32x16 __attribute__((ext_vector_type(16)));
typedef short bf16x8 __attribute__((ext_vector_type(8)));
typedef short s16x4 __attribute__((ext_vector_type(4)));
typedef __bf16 bf16x2_t __attribute__((ext_vector_type(2)));
#define RLX_AGENT __ATOMIC_RELAXED, __HIP_MEMORY_SCOPE_AGENT
#define LDS_WAIT() asm volatile("s_waitcnt lgkmcnt(0)" ::: "memory")
#define VM_WAIT() asm volatile("s_waitcnt vmcnt(0)" ::: "memory")

__device__ __forceinline__ int opaque_tid() { int t = threadIdx.x; asm volatile("" : "+v"(t)); return t; }
__device__ __forceinline__ int opaque_s(int v) { asm volatile("" : "+s"(v)); return v; }
__device__ __forceinline__ unsigned char* opaque_ptr(unsigned char* p) { asm volatile("" : "+s"(p)); return p; }
__device__ __forceinline__ unsigned cvtpk(float lo, float hi) { f32x2 v = {lo, hi}; bf16x2_t b = __builtin_convertvector(v, bf16x2_t); return __builtin_bit_cast(unsigned, b); }
__device__ __forceinline__ float bflo(unsigned w) { return __uint_as_float(w << 16); }
__device__ __forceinline__ float bfhi(unsigned w) { return __uint_as_float(w & 0xffff0000u); }
__device__ __forceinline__ float bf2f(bf16_t h) { return __uint_as_float((unsigned)h << 16); }
__device__ __forceinline__ bf16_t f2bf(float f) { return (bf16_t)(cvtpk(f, 0.f) & 0xffffu); }
__device__ __forceinline__ float sigmoidf_(float x) { return __builtin_amdgcn_rcpf(1.0f + __builtin_amdgcn_exp2f(-x * LOG2E)); }
__device__ __forceinline__ float siluf_(float x) { return x * sigmoidf_(x); }
__device__ __forceinline__ float gelu_tanh(float x) { const float z = 0.7978845608028654f * (x + 0.044715f * x * x * x); return x * __builtin_amdgcn_rcpf(1.0f + __builtin_amdgcn_exp2f(-2.0f * LOG2E * z)); }
template <int CTRL> __device__ __forceinline__ float dpp_f(float v) { return __builtin_bit_cast(float, __builtin_amdgcn_update_dpp(0, __builtin_bit_cast(int, v), CTRL, 0xf, 0xf, true)); }
__device__ __forceinline__ float row16_sum(float v) { v += dpp_f<0xB1>(v); v += dpp_f<0x4E>(v); v += dpp_f<0x141>(v); v += dpp_f<0x140>(v); return v; }
__device__ __forceinline__ float xor16_sum(float v) { auto rr = __builtin_amdgcn_permlane16_swap(__float_as_uint(v), __float_as_uint(v), false, false); return __uint_as_float(rr[0]) + __uint_as_float(rr[1]); }
__device__ __forceinline__ float xor32_sum(float v) { auto rr = __builtin_amdgcn_permlane32_swap(__float_as_uint(v), __float_as_uint(v), false, false); return __uint_as_float(rr[0]) + __uint_as_float(rr[1]); }
__device__ __forceinline__ float half32_sum(float v) { return xor16_sum(row16_sum(v)); }
__device__ __forceinline__ float wave_sum(float v) { return xor32_sum(xor16_sum(row16_sum(v))); }
__device__ __forceinline__ unsigned pk8(float a, float b, float c, float d) { unsigned w = 0u; w = __builtin_amdgcn_cvt_pk_fp8_f32(a, b, w, false); w = __builtin_amdgcn_cvt_pk_fp8_f32(c, d, w, true); return w; }
__device__ __forceinline__ void st8(bf16_t* p, const float* v) { v4u w; w.x = cvtpk(v[0], v[1]); w.y = cvtpk(v[2], v[3]); w.z = cvtpk(v[4], v[5]); w.w = cvtpk(v[6], v[7]); *(v4u*)p = w; }

__device__ const float INV16R[16] = {0.15915494309189535f, 0.08949940160889101f, 0.050329212104487035f, 0.0283021958306234f, 0.015915494309189534f, 0.008949940160889102f, 0.005032921210448704f, 0.00283021958306234f,
                                     0.0015915494309189536f, 0.0008949940160889102f, 0.0005032921210448703f, 0.00028302195830623395f, 0.00015915494309189535f, 8.949940160889102e-05f, 5.0329212104487035e-05f, 2.8302195830623396e-05f};
__device__ const float INV8R[8] = {0.15915494309189535f, 0.050329212104487035f, 0.015915494309189534f, 0.005032921210448704f, 0.0015915494309189536f, 0.0005032921210448703f, 0.00015915494309189535f, 5.0329212104487035e-05f};
__device__ __forceinline__ void sincos_rev(float rev, float& s, float& c) { const float f = __builtin_amdgcn_fractf(rev); s = __builtin_amdgcn_sinf(f); c = __builtin_amdgcn_cosf(f); }

namespace pg8 {
#define PG8_LAS __attribute__((address_space(3)))
constexpr int BM = 256, BK = 64, HALF = 128, HTB = HALF * BK * 2, STAGE_BYTES = 8 * HTB, NXCD = 8, WGM = 8;
__host__ __device__ __forceinline__ int lds_byte(int r, int c) { const int st = (r >> 4) * 2 + (c >> 5), rr = r & 15, cc = c & 31, ob = rr * 64 + cc * 2; return st * 1024 + (ob ^ (((ob >> 9) & 1) << 5)); }
__host__ __device__ __forceinline__ void stage_rc(int b, int& R, int& C) { const int st = b / 1024, sb = b % 1024, swz = sb ^ (((sb >> 9) & 1) << 5); R = (st >> 1) * 16 + swz / 64; C = (st & 1) * 32 + (swz % 64) / 2; }
__host__ __device__ __forceinline__ int perm32(int rho) { const int n = rho >> 4, i = rho & 15; return 8 * (i >> 2) + 4 * n + (i & 3); }

struct Unit { int pm, pn; const char* a; const char* b; };
__device__ __forceinline__ const char* uptr(const char* p) { const unsigned long long v = (unsigned long long)p; const unsigned lo = __builtin_amdgcn_readfirstlane((unsigned)v), hi = __builtin_amdgcn_readfirstlane((unsigned)(v >> 32)); return (const char*)(((unsigned long long)hi << 32) | lo); }
__device__ __forceinline__ void uunit(Unit& u) { u.pm = __builtin_amdgcn_readfirstlane(u.pm); u.pn = __builtin_amdgcn_readfirstlane(u.pn); u.a = uptr(u.a); u.b = uptr(u.b); }

typedef int v8i __attribute__((ext_vector_type(8)));
__device__ __forceinline__ void glds16s(const char* sbase, unsigned voff, unsigned lds_dst) { unsigned keep;
    asm volatile("s_mov_b32 %0, m0\n\ts_mov_b32 m0, %3\n\ts_nop 0\n\tglobal_load_lds_dwordx4 %1, %2\n\ts_mov_b32 m0, %0" : "=&s"(keep) : "v"(voff), "s"(sbase), "s"(lds_dst) : "memory"); }
__device__ __forceinline__ void rect_order(int L, int nM, int nN, int& im, int& in) {
    const int nwg = nM * nN; int wgid = L; { const int q = nwg / NXCD, r = nwg % NXCD, xcd = wgid % NXCD, off = wgid / NXCD; wgid = (xcd < r ? xcd * (q + 1) : r * (q + 1) + (xcd - r) * q) + off; }
    const int nig = WGM * nN, gid = wgid / nig, fm = gid * WGM, gsz = (nM - fm) < WGM ? (nM - fm) : WGM;
    im = fm + ((wgid % nig) % gsz); in = (wgid % nig) / gsz;
}

template <class Epi, class Sched>
__device__ __forceinline__ void gemm_phase(PG8_LAS unsigned char* lds, const int K, const int lda, const int ldb, const Sched& S, const Epi& E) {
    const int tid = opaque_tid(), wid = __builtin_amdgcn_readfirstlane(tid >> 6), lane = tid & 63, wr = wid >> 2, wc = wid & 3, fr = lane & 15, fq = lane >> 4;
    const int nt = K / BK;
    unsigned voffA[2], voffB[2];
#pragma unroll
    for (int i = 0; i < 2; ++i) { int R, C; stage_rc(tid * 16 + i * 8192, R, C); const int Rb = Epi::PERM ? ((R & ~31) + perm32(R & 31)) : R;
        voffA[i] = (unsigned)(R * lda + C) * 2u; voffB[i] = (unsigned)(Rb * ldb + C) * 2u; }
    const size_t kstep = (size_t)(BK * 2);
    const size_t hA = (size_t)HALF * lda * 2, hB = (size_t)HALF * ldb * 2;
    const unsigned ldsw = (unsigned)wid * 1024u, ldsbase = (unsigned)(size_t)lds;
    const int aoff = lds_byte(wr * 64 + fr, fq * 8), boff = lds_byte(wc * 32 + fr, fq * 8);
#define PG8_SA(b, h) (((b) * 2 + (h)) * HTB)
#define PG8_SB(b, h) ((4 + (b) * 2 + (h)) * HTB)
#define PG8_STAGE(bufoff, gbase, voff) do { _Pragma("unroll") for (int _i = 0; _i < 2; ++_i) \
        glds16s(uptr((const char*)(gbase)), (voff)[_i], (unsigned)__builtin_amdgcn_readfirstlane(ldsbase + (unsigned)(bufoff) + ldsw + _i * 8192u)); } while (0)
#define PG8_LDA(dst, b, h) do { _Pragma("unroll") for (int m = 0; m < 4; ++m) _Pragma("unroll") for (int k = 0; k < 2; ++k) dst[m][k] = *(const PG8_LAS bf16x8*)(lds + PG8_SA(b, h) + aoff + m * 2048 + k * 1024); } while (0)
#define PG8_LDB(dst, b, h) do { _Pragma("unroll") for (int n = 0; n < 2; ++n) _Pragma("unroll") for (int k = 0; k < 2; ++k) dst[n][k] = *(const PG8_LAS bf16x8*)(lds + PG8_SB(b, h) + boff + n * 2048 + k * 1024); } while (0)
#define PG8_MMA(ai, bj, At, Bt) do { __builtin_amdgcn_s_setprio(1); _Pragma("unroll") for (int m = 0; m < 4; ++m) _Pragma("unroll") for (int n = 0; n < 2; ++n) _Pragma("unroll") for (int k = 0; k < 2; ++k) \
        acc[ai][bj][m][n] = __builtin_amdgcn_mfma_f32_16x16x32_bf16(Bt[n][k], At[m][k], acc[ai][bj][m][n], 0, 0, 0); __builtin_amdgcn_s_setprio(0); } while (0)
#define PG8_WAIT_V(n) asm volatile("s_waitcnt vmcnt(" #n ")" ::: "memory")
#define PG8_WAIT_L(n) asm volatile("s_waitcnt lgkmcnt(" #n ")" ::: "memory")
#define PG8_BAR __builtin_amdgcn_s_barrier()
#define PG8_SCHED __builtin_amdgcn_sched_barrier(0)
    Unit cur, nxt; int ui = 0;
    if (!S.next(0, cur)) return;
    uunit(cur);
    f32x4 acc[2][2][4][2];
#pragma unroll
    for (int a = 0; a < 2; ++a)
#pragma unroll
        for (int b = 0; b < 2; ++b)
#pragma unroll
            for (int m = 0; m < 4; ++m)
#pragma unroll
                for (int n = 0; n < 2; ++n) acc[a][b][m][n] = (f32x4){0.f, 0.f, 0.f, 0.f};
    bf16x8 At[4][2], B0[2][2], B1[2][2];
    const char* cA = cur.a; const char* cB = cur.b;
    PG8_STAGE(PG8_SB(0, 0), cB, voffB); PG8_STAGE(PG8_SB(0, 1), cB + hB, voffB); PG8_STAGE(PG8_SA(0, 0), cA, voffA); PG8_STAGE(PG8_SA(0, 1), cA + hA, voffA);
    if (wr == 1) PG8_BAR;
    PG8_WAIT_V(2); PG8_BAR;
    PG8_STAGE(PG8_SB(1, 0), cB + kstep, voffB); PG8_STAGE(PG8_SA(1, 0), cA + kstep, voffA); PG8_STAGE(PG8_SB(1, 1), cB + hB + kstep, voffB);
    PG8_WAIT_V(6); PG8_BAR;
    for (;;) {
        const bool has_next = S.next(ui + 1, nxt); if (has_next) uunit(nxt);
        const char* nA = has_next ? nxt.a : cA; const char* nB = has_next ? nxt.b : cB;
        for (int t = 0; t < nt; t += 2) {
            const bool last = (t == nt - 2);
            const char* a1 = cA + (size_t)(t + 1) * kstep;
            const char* a2 = last ? nA : cA + (size_t)(t + 2) * kstep; const char* b2 = last ? nB : cB + (size_t)(t + 2) * kstep;
            const char* a3 = a2 + kstep; const char* b3 = b2 + kstep;
            PG8_LDB(B0, 0, 0); PG8_LDB(B1, 0, 1); PG8_SCHED; PG8_LDA(At, 0, 0); PG8_STAGE(PG8_SA(1, 1), a1 + hA, voffA);
            PG8_WAIT_V(8); PG8_WAIT_L(0); PG8_BAR; PG8_MMA(0, 0, At, B0); PG8_MMA(0, 1, At, B1); PG8_BAR; PG8_SCHED;
            PG8_LDA(At, 0, 1); PG8_STAGE(PG8_SB(0, 0), b2, voffB); PG8_STAGE(PG8_SB(0, 1), b2 + hB, voffB); PG8_STAGE(PG8_SA(0, 0), a2, voffA);
            PG8_WAIT_V(8); PG8_WAIT_L(0); PG8_BAR; PG8_MMA(1, 0, At, B0); PG8_MMA(1, 1, At, B1); PG8_BAR; PG8_SCHED;
            PG8_LDB(B0, 1, 0); PG8_LDB(B1, 1, 1); PG8_SCHED; PG8_LDA(At, 1, 0); PG8_STAGE(PG8_SA(0, 1), a2 + hA, voffA);
            PG8_WAIT_V(8); PG8_WAIT_L(0); PG8_BAR; PG8_MMA(0, 0, At, B0); PG8_MMA(0, 1, At, B1); PG8_BAR; PG8_SCHED;
            PG8_LDA(At, 1, 1); PG8_STAGE(PG8_SB(1, 0), b3, voffB); PG8_STAGE(PG8_SB(1, 1), b3 + hB, voffB); PG8_STAGE(PG8_SA(1, 0), a3, voffA);
            PG8_WAIT_V(8); PG8_WAIT_L(0); PG8_BAR; PG8_MMA(1, 0, At, B0); PG8_MMA(1, 1, At, B1); PG8_BAR; PG8_SCHED;
        }
        if (wr == 0) PG8_BAR;
        { const int t2 = opaque_tid(), l2 = t2 & 63; E(acc, cur, wr, wc, l2 & 15, l2 >> 4); }
        if (!has_next) break;
        if (!Epi::keep_acc(cur)) {
#pragma unroll
        for (int a = 0; a < 2; ++a)
#pragma unroll
            for (int b = 0; b < 2; ++b)
#pragma unroll
                for (int m = 0; m < 4; ++m)
#pragma unroll
                    for (int n = 0; n < 2; ++n) acc[a][b][m][n] = (f32x4){0.f, 0.f, 0.f, 0.f};
        }
        cur = nxt; cA = nA; cB = nB; ++ui;
        if (wr == 1) PG8_BAR;
    }
    PG8_WAIT_V(0);
    PG8_BAR;
#undef PG8_SA
#undef PG8_SB
#undef PG8_STAGE
#undef PG8_LDA
#undef PG8_LDB
#undef PG8_MMA
#undef PG8_WAIT_V
#undef PG8_WAIT_L
#undef PG8_BAR
#undef PG8_SCHED
}
template <class Epi, class Sched>
__device__ __forceinline__ void gemm8_phase(PG8_LAS unsigned char* lds, const int K, const int lda, const int ldb, const Sched& S, const Epi& E) {
    const int tid = opaque_tid(), wid = __builtin_amdgcn_readfirstlane(tid >> 6), lane = tid & 63, wr = wid >> 2, wc = wid & 3, fr = lane & 15, fq = lane >> 4;
    const int nt = opaque_s(K / BK);
    unsigned voffA[2], voffB[2];
#pragma unroll
    for (int i = 0; i < 2; ++i) { int R, C; stage_rc(tid * 16 + i * 8192, R, C); const int Rb = Epi::PERM ? ((R & ~31) + perm32(R & 31)) : R;
        voffA[i] = (unsigned)(R * lda + C) * 2u; voffB[i] = (unsigned)(Rb * ldb + C) * 2u; }
    const size_t kstep = (size_t)(BK * 2);
    const size_t hA = (size_t)HALF * lda * 2, hB = (size_t)HALF * ldb * 2;
    const unsigned ldsw = (unsigned)wid * 1024u, ldsbase = (unsigned)(size_t)lds;
    const int fcol = (fq >> 1) * 32 + (fq & 1) * 16;
    const int aoff = lds_byte(wr * 64 + fr, fcol), boff = lds_byte(wc * 32 + fr, fcol);
#define PG8_SA(b, h) (((b) * 2 + (h)) * HTB)
#define PG8_SB(b, h) ((4 + (b) * 2 + (h)) * HTB)
#define PG8_STAGE(bufoff, gbase, voff) do { _Pragma("unroll") for (int _i = 0; _i < 2; ++_i) \
        glds16s(uptr((const char*)(gbase)), (voff)[_i], (unsigned)__builtin_amdgcn_readfirstlane(ldsbase + (unsigned)(bufoff) + ldsw + _i * 8192u)); } while (0)
#define PG8_LDA(dst, b, h) do { _Pragma("unroll") for (int m = 0; m < 4; ++m) { const v4u lo_ = *(const PG8_LAS v4u*)(lds + PG8_SA(b, h) + aoff + m * 2048), hi_ = *(const PG8_LAS v4u*)(lds + PG8_SA(b, h) + aoff + m * 2048 + 16); dst[m] = (v8i){(int)lo_.x, (int)lo_.y, (int)lo_.z, (int)lo_.w, (int)hi_.x, (int)hi_.y, (int)hi_.z, (int)hi_.w}; } } while (0)
#define PG8_LDB(dst, b, h) do { _Pragma("unroll") for (int n = 0; n < 2; ++n) { const v4u lo_ = *(const PG8_LAS v4u*)(lds + PG8_SB(b, h) + boff + n * 2048), hi_ = *(const PG8_LAS v4u*)(lds + PG8_SB(b, h) + boff + n * 2048 + 16); dst[n] = (v8i){(int)lo_.x, (int)lo_.y, (int)lo_.z, (int)lo_.w, (int)hi_.x, (int)hi_.y, (int)hi_.z, (int)hi_.w}; } } while (0)
#define PG8_MMA(ai, bj, At, Bt) do { __builtin_amdgcn_s_setprio(1); _Pragma("unroll") for (int m = 0; m < 4; ++m) _Pragma("unroll") for (int n = 0; n < 2; ++n) \
        acc[ai][bj][m][n] = __builtin_amdgcn_mfma_scale_f32_16x16x128_f8f6f4(Bt[n], At[m], acc[ai][bj][m][n], 0, 0, 0, 0, 0, 0);     __builtin_amdgcn_s_setprio(0); } while (0)
#define PG8_WAIT_V(n) asm volatile("s_waitcnt vmcnt(" #n ")" ::: "memory")
#define PG8_WAIT_L(n) asm volatile("s_waitcnt lgkmcnt(" #n ")" ::: "memory")
#define PG8_BAR __builtin_amdgcn_s_barrier()
#define PG8_SCHED __builtin_amdgcn_sched_barrier(0)
    Unit cur, nxt; int ui = 0;
    if (!S.next(0, cur)) return;
    uunit(cur);
    f32x4 acc[2][2][4][2];
#pragma unroll
    for (int a = 0; a < 2; ++a)
#pragma unroll
        for (int b = 0; b < 2; ++b)
#pragma unroll
            for (int m = 0; m < 4; ++m)
#pragma unroll
                for (int n = 0; n < 2; ++n) acc[a][b][m][n] = (f32x4){0.f, 0.f, 0.f, 0.f};
    v8i At[4], B0[2], B1[2];
    const char* cA = cur.a; const char* cB = cur.b;
    PG8_STAGE(PG8_SB(0, 0), cB, voffB); PG8_STAGE(PG8_SB(0, 1), cB + hB, voffB); PG8_STAGE(PG8_SA(0, 0), cA, voffA); PG8_STAGE(PG8_SA(0, 1), cA + hA, voffA);
    if (wr == 1) PG8_BAR;
    PG8_WAIT_V(2); PG8_BAR;
    PG8_STAGE(PG8_SB(1, 0), cB + kstep, voffB); PG8_STAGE(PG8_SA(1, 0), cA + kstep, voffA); PG8_STAGE(PG8_SB(1, 1), cB + hB + kstep, voffB);
    PG8_WAIT_V(6); PG8_BAR;
    for (;;) {
        const bool has_next = S.next(ui + 1, nxt); if (has_next) uunit(nxt);
        const char* nA = has_next ? nxt.a : cA; const char* nB = has_next ? nxt.b : cB;
#pragma nounroll
        for (int t = 0; t < nt; t += 2) {
            const bool last = (t == nt - 2);
            const char* a1 = cA + (size_t)(t + 1) * kstep;
            const char* a2 = last ? nA : cA + (size_t)(t + 2) * kstep; const char* b2 = last ? nB : cB + (size_t)(t + 2) * kstep;
            const char* a3 = a2 + kstep; const char* b3 = b2 + kstep;
            PG8_LDB(B0, 0, 0); PG8_LDB(B1, 0, 1); PG8_SCHED; PG8_LDA(At, 0, 0); PG8_STAGE(PG8_SA(1, 1), a1 + hA, voffA);
            PG8_WAIT_V(8); PG8_WAIT_L(0); PG8_BAR; PG8_MMA(0, 0, At, B0); PG8_MMA(0, 1, At, B1); PG8_BAR; PG8_SCHED;
            PG8_LDA(At, 0, 1); PG8_STAGE(PG8_SB(0, 0), b2, voffB); PG8_STAGE(PG8_SB(0, 1), b2 + hB, voffB); PG8_STAGE(PG8_SA(0, 0), a2, voffA);
            PG8_WAIT_V(8); PG8_WAIT_L(0); PG8_BAR; PG8_MMA(1, 0, At, B0); PG8_MMA(1, 1, At, B1); PG8_BAR; PG8_SCHED;
            PG8_LDB(B0, 1, 0); PG8_LDB(B1, 1, 1); PG8_SCHED; PG8_LDA(At, 1, 0); PG8_STAGE(PG8_SA(0, 1), a2 + hA, voffA);
            PG8_WAIT_V(8); PG8_WAIT_L(0); PG8_BAR; PG8_MMA(0, 0, At, B0); PG8_MMA(0, 1, At, B1); PG8_BAR; PG8_SCHED;
            PG8_LDA(At, 1, 1); PG8_STAGE(PG8_SB(1, 0), b3, voffB); PG8_STAGE(PG8_SB(1, 1), b3 + hB, voffB); PG8_STAGE(PG8_SA(1, 0), a3, voffA);
            PG8_WAIT_V(8); PG8_WAIT_L(0); PG8_BAR; PG8_MMA(1, 0, At, B0); PG8_MMA(1, 1, At, B1); PG8_BAR; PG8_SCHED;
        }
        if (wr == 0) PG8_BAR;
        { const int t2 = opaque_tid(), l2 = t2 & 63; E(acc, cur, wr, wc, l2 & 15, l2 >> 4); }
        if (!has_next) break;
#pragma unroll
        for (int a = 0; a < 2; ++a)
#pragma unroll
            for (int b = 0; b < 2; ++b)
#pragma unroll
                for (int m = 0; m < 4; ++m)
#pragma unroll
                    for (int n = 0; n < 2; ++n) acc[a][b][m][n] = (f32x4){0.f, 0.f, 0.f, 0.f};
        cur = nxt; cA = nA; cB = nB; ++ui;
        if (wr == 1) PG8_BAR;
    }
    PG8_WAIT_V(0);
    PG8_BAR;
#undef PG8_SA
#undef PG8_SB
#undef PG8_STAGE
#undef PG8_LDA
#undef PG8_LDB
#undef PG8_MMA
#undef PG8_WAIT_V
#undef PG8_WAIT_L
#undef PG8_BAR
#undef PG8_SCHED
}
}

constexpr float W8S = 32.0f, W8I = 1.0f / 32.0f;
struct ModPtrs { const float* mod; };

struct EpiInProj {
    static constexpr bool PERM = true;
    static __device__ __forceinline__ bool keep_acc(const pg8::Unit&) { return false; }
    bf16_t *QKV, *GT;
    const float *q_gain, *k_gain, *gate_b;
    __device__ __forceinline__ void operator()(const f32x4 (&acc)[2][2][4][2], const pg8::Unit& u, int wr, int wc, int fr, int fq) const {
        const int pn = u.pn, pm = u.pm, jt = pm % TPB; const bool isctx = (jt == 0); const int t0 = (jt - 1) * 256;
        const int cb = 64 * wc + 8 * fq;
        const int rit0 = 64 * wr + fr;
        bf16_t* qrow = QKV + ((size_t)pm * 256 + rit0) * PQ;
#define ROWLOOP _Pragma("unroll") for (int ai = 0; ai < 2; ++ai) _Pragma("unroll") for (int m = 0; m < 4; ++m)
#define ROWVARS const int rit = 128 * ai + 16 * m + rit0; bf16_t* orow = qrow + (size_t)(128 * ai + 16 * m) * PQ; \
        float v[2][8]; _Pragma("unroll") for (int bj = 0; bj < 2; ++bj) _Pragma("unroll") for (int n = 0; n < 2; ++n) _Pragma("unroll") for (int j = 0; j < 4; ++j) v[bj][4 * n + j] = acc[ai][bj][m][n][j];
#define ROWEND __builtin_amdgcn_sched_barrier(0);
        if (pn == 0 || pn == 21 || pn == 22 || pn == 24) {
            const int oc = (pn == 0 ? C_QA : pn == 21 ? C_KA : pn == 22 ? C_VA : C_VB) + cb; const float sc = pn == 0 ? C2A : 1.0f;
            ROWLOOP { ROWVARS
#pragma unroll
                for (int bj = 0; bj < 2; ++bj) {
#pragma unroll
                    for (int j = 0; j < 8; ++j) v[bj][j] *= sc;
                    st8(orow + oc + 32 * bj, v[bj]); }
                ROWEND }
        } else if (pn == 3 || pn == 4) {
            const int oc = (pn == 3 ? C_GU : C_GV) + cb;
            ROWLOOP { ROWVARS
#pragma unroll
                for (int bj = 0; bj < 2; ++bj) {
#pragma unroll
                    for (int j = 0; j < 8; ++j) v[bj][j] = gelu_tanh(v[bj][j]);
                    st8(orow + oc + 32 * bj, v[bj]); }
                ROWEND }
        } else if (pn == 1 || pn == 23) {
            const int oc = (pn == 1 ? C_QB : C_KB) + 128 * wc + 8 * fq; const float sc = pn == 1 ? C2B : 1.0f;
            const f32x4 inv = *(const f32x4*)(INV8R + 4 * (fq & 1));
            const float zz[8] = {0.f, 0.f, 0.f, 0.f, 0.f, 0.f, 0.f, 0.f};
            ROWLOOP { ROWVARS
                const int t = t0 + rit; const float pos = (float)((fq < 2) ? (t >> 6) : (t & 63));
                float sn[4], cs[4];
#pragma unroll
                for (int p = 0; p < 4; ++p) { if (isctx) { sn[p] = 0.f; cs[p] = 1.f; } else sincos_rev(pos * inv[p], sn[p], cs[p]); }
#pragma unroll
                for (int bj = 0; bj < 2; ++bj) {
                    float o[8];
#pragma unroll
                    for (int p = 0; p < 4; ++p) { const float x0 = v[bj][2 * p], x1 = v[bj][2 * p + 1]; o[2 * p] = (x0 * cs[p] - x1 * sn[p]) * sc; o[2 * p + 1] = (x0 * sn[p] + x1 * cs[p]) * sc; }
                    st8(orow + oc + 64 * bj, o); st8(orow + oc + 64 * bj + 32, zz); }
                ROWEND }
        } else {
            if (pn == 25 && wc >= 2) {
                const int oc = C_VD + (wc - 2) * 64 + 8 * fq;
                ROWLOOP { ROWVARS
#pragma unroll
                    for (int bj = 0; bj < 2; ++bj) st8(orow + oc + 32 * bj, v[bj]);
                    (void)rit; ROWEND }
            } else {
                const int oc = (pn == 2 ? C_QD : C_KD) + cb; const float sc = pn == 2 ? C2A : 1.0f; const float* gain = pn == 2 ? q_gain : k_gain;
                const f32x4 inv = *(const f32x4*)(INV16R + 4 * fq);
                f32x4 gn[2][2];
#pragma unroll
                for (int bj = 0; bj < 2; ++bj)
#pragma unroll
                    for (int n = 0; n < 2; ++n) gn[bj][n] = *(const f32x4*)(gain + 32 * bj + 8 * fq + 4 * n);
                ROWLOOP { ROWVARS
                    float ss = 0.f;
#pragma unroll
                    for (int bj = 0; bj < 2; ++bj)
#pragma unroll
                        for (int j = 0; j < 8; ++j) ss += v[bj][j] * v[bj][j];
                    ss = xor32_sum(xor16_sum(ss));
                    const float rstd = __builtin_amdgcn_rsqf(ss * (1.0f / 64.0f) + EPS);
                    const int t = t0 + rit;
#pragma unroll
                    for (int bj = 0; bj < 2; ++bj) {
                        const float pos = (float)(bj == 0 ? (t >> 6) : (t & 63));
                        float o[8];
#pragma unroll
                        for (int p = 0; p < 4; ++p) {
                            float sn, cs; if (isctx) { sn = 0.f; cs = 1.f; } else sincos_rev(pos * inv[p], sn, cs);
                            const float x0 = v[bj][2 * p] * rstd * gn[bj][(2 * p) >> 2][(2 * p) & 3], x1 = v[bj][2 * p + 1] * rstd * gn[bj][(2 * p + 1) >> 2][(2 * p + 1) & 3];
                            o[2 * p] = (x0 * cs - x1 * sn) * sc; o[2 * p + 1] = (x0 * sn + x1 * cs) * sc; }
                        st8(orow + oc + 32 * bj, o); }
                    ROWEND }
            }
        }
#undef ROWLOOP
#undef ROWVARS
#undef ROWEND
    }
};

__device__ __forceinline__ unsigned pk_u8x4(float a, float b, float c, float d) { unsigned w = 0u;
    w = __builtin_amdgcn_cvt_pk_u8_f32(__builtin_rintf(a * 255.0f), 0u, w); w = __builtin_amdgcn_cvt_pk_u8_f32(__builtin_rintf(b * 255.0f), 1u, w);
    w = __builtin_amdgcn_cvt_pk_u8_f32(__builtin_rintf(c * 255.0f), 2u, w); w = __builtin_amdgcn_cvt_pk_u8_f32(__builtin_rintf(d * 255.0f), 3u, w); return w; }
__device__ __forceinline__ float u8f(unsigned w, int i) { return (float)((w >> (8 * i)) & 0xffu); }
struct EpiGates {
    static constexpr bool PERM = true;
    unsigned char* GT; const float* gate_b;
    __device__ __forceinline__ void operator()(const f32x4 (&acc)[2][2][4][2], const pg8::Unit& u, int wr, int wc, int fr, int fq) const {
        const int col0 = u.pn * 256 + wc * 32 + 8 * fq;
        f32x4 gb[2][2];
#pragma unroll
        for (int bj = 0; bj < 2; ++bj)
#pragma unroll
            for (int n = 0; n < 2; ++n) gb[bj][n] = *(const f32x4*)(gate_b + col0 + bj * 128 + 4 * n);
#pragma unroll
        for (int ai = 0; ai < 2; ++ai)
#pragma unroll
            for (int m = 0; m < 4; ++m) { unsigned char* rowp = GT + ((size_t)u.pm * 256 + ai * 128 + wr * 64 + m * 16 + fr) * 4096 + col0;
#pragma unroll
                for (int bj = 0; bj < 2; ++bj) { float o[8];
#pragma unroll
                    for (int n = 0; n < 2; ++n)
#pragma unroll
                        for (int j = 0; j < 4; ++j) o[4 * n + j] = sigmoidf_(acc[ai][bj][m][n][j] * W8I + gb[bj][n][j]);
                    v2u w; w.x = pk_u8x4(o[0], o[1], o[2], o[3]); w.y = pk_u8x4(o[4], o[5], o[6], o[7]); *(v2u*)(rowp + bj * 128) = w; } }
    }
};
struct EpiGateAcc {
    static constexpr bool PERM = true;
    const unsigned char* GT; bf16_t* MRG; bf16_t* GPC;
    static __device__ __forceinline__ bool keep_acc(const pg8::Unit& u) { return (u.pn & 3) != 3 && (u.pm % TPB) != 0; }
    __device__ __forceinline__ void operator()(f32x4 (&acc)[2][2][4][2], const pg8::Unit& u, int wr, int wc, int fr, int fq) const {
        const int dt = u.pn >> 2, n = u.pn & 3; const int col0 = dt * 256 + wc * 32 + 8 * fq;
        const bool isctx = (u.pm % TPB) == 0;
        const size_t row0 = (size_t)u.pm * 256 + wr * 64 + fr;
        const unsigned char* gp0 = GT + row0 * 4096 + n * 1024 + col0;
        constexpr float GMIN = 8.673617379884035e-19f;
#define GA_OFF(grp) ((size_t)(((grp) >> 3) * 128 + (((grp) >> 1) & 3) * 16))
        if (!isctx && n < 3) {
            v2u ga[16], gb[16];
#pragma unroll
            for (int grp = 0; grp < 16; ++grp) { const int bj = grp & 1; ga[grp] = *(const v2u*)(gp0 + GA_OFF(grp) * 4096 + bj * 128); gb[grp] = *(const v2u*)(gp0 + 1024 + GA_OFF(grp) * 4096 + bj * 128); }
            __builtin_amdgcn_sched_barrier(0);
#pragma unroll
            for (int grp = 0; grp < 16; ++grp) { const int ai = grp >> 3, m = (grp >> 1) & 3, bj = grp & 1; const v2u g0 = ga[grp], g1 = gb[grp];
                float r[8];
#define GA_R(i, A, B) r[i] = fmaxf(A, GMIN) * __builtin_amdgcn_rcpf(fmaxf(B, GMIN))
                GA_R(0, u8f(g0.x, 0), u8f(g1.x, 0)); GA_R(1, u8f(g0.x, 1), u8f(g1.x, 1)); GA_R(2, u8f(g0.x, 2), u8f(g1.x, 2)); GA_R(3, u8f(g0.x, 3), u8f(g1.x, 3));
                GA_R(4, u8f(g0.y, 0), u8f(g1.y, 0)); GA_R(5, u8f(g0.y, 1), u8f(g1.y, 1)); GA_R(6, u8f(g0.y, 2), u8f(g1.y, 2)); GA_R(7, u8f(g0.y, 3), u8f(g1.y, 3));
#undef GA_R
#pragma unroll
                for (int j = 0; j < 4; ++j) { acc[ai][bj][m][0][j] *= r[j]; acc[ai][bj][m][1][j] *= r[4 + j]; } }
            __builtin_amdgcn_sched_barrier(0);
        } else {
            bf16_t* mp0 = isctx ? GPC + ((size_t)n * 512 + (u.pm / TPB) * 256 + wr * 64 + fr) * 1024 + col0 : MRG + row0 * 1024 + col0;
            const float lo = isctx ? 0.f : GMIN; constexpr float I255 = 1.0f / 255.0f;
            v2u ga[16];
#pragma unroll
            for (int grp = 0; grp < 16; ++grp) { const int bj = grp & 1; ga[grp] = *(const v2u*)(gp0 + GA_OFF(grp) * 4096 + bj * 128); }
            __builtin_amdgcn_sched_barrier(0);
#pragma unroll
            for (int grp = 0; grp < 16; ++grp) { const int ai = grp >> 3, m = (grp >> 1) & 3, bj = grp & 1; const v2u g = ga[grp]; const f32x4 a0 = acc[ai][bj][m][0], a1 = acc[ai][bj][m][1];
                v4u w; w.x = cvtpk(a0[0] * (fmaxf(u8f(g.x, 0), lo) * I255), a0[1] * (fmaxf(u8f(g.x, 1), lo) * I255)); w.y = cvtpk(a0[2] * (fmaxf(u8f(g.x, 2), lo) * I255), a0[3] * (fmaxf(u8f(g.x, 3), lo) * I255));
                w.z = cvtpk(a1[0] * (fmaxf(u8f(g.y, 0), lo) * I255), a1[1] * (fmaxf(u8f(g.y, 1), lo) * I255)); w.w = cvtpk(a1[2] * (fmaxf(u8f(g.y, 2), lo) * I255), a1[3] * (fmaxf(u8f(g.y, 3), lo) * I255));
                *(v4u*)(mp0 + GA_OFF(grp) * 1024 + bj * 128) = w; }
            __builtin_amdgcn_sched_barrier(0);
        }
#undef GA_OFF
    }
};

struct EpiOutRes {
    static constexpr bool PERM = true;
    static __device__ __forceinline__ bool keep_acc(const pg8::Unit&) { return false; }
    const float* x_in; const float* ctx_in; const bf16_t* XR; bf16_t* X1; const float* mod_l; int layer;
    __device__ __forceinline__ void operator()(const f32x4 (&acc)[2][2][4][2], const pg8::Unit& u, int wr, int wc, int fr, int fq) const {
        const int pm = u.pm, b = pm / TPB, jt = pm % TPB; const bool isctx = jt == 0;
        const float* g1 = mod_l + (isctx ? 2 : b) * 6144 + 2048;
        const int col0 = u.pn * 256 + wc * 32 + 8 * fq;
        f32x4 gv[2][2];
#pragma unroll
        for (int bj = 0; bj < 2; ++bj)
#pragma unroll
            for (int n = 0; n < 2; ++n) gv[bj][n] = *(const f32x4*)(g1 + col0 + bj * 128 + n * 4);
        bf16_t* ob = X1 + ((size_t)pm * 256 + wr * 64 + fr) * DM + col0;
        if (layer == 0) {
            const float* base = (isctx ? ctx_in + (size_t)b * CTXL * DM : x_in + ((size_t)b * SEQ + (size_t)(jt - 1) * 256) * DM) + (size_t)(wr * 64 + fr) * DM + col0;
#pragma unroll
            for (int ai = 0; ai < 2; ++ai) { f32x4 rs[4][2][2];
#pragma unroll
                for (int m = 0; m < 4; ++m)
#pragma unroll
                    for (int bj = 0; bj < 2; ++bj)
#pragma unroll
                        for (int n = 0; n < 2; ++n) rs[m][bj][n] = *(const f32x4*)(base + (size_t)(ai * 128 + m * 16) * DM + bj * 128 + n * 4);
                __builtin_amdgcn_sched_barrier(0);
#pragma unroll
                for (int m = 0; m < 4; ++m)
#pragma unroll
                    for (int bj = 0; bj < 2; ++bj) { const f32x4 o0 = rs[m][bj][0] + gv[bj][0] * acc[ai][bj][m][0], o1 = rs[m][bj][1] + gv[bj][1] * acc[ai][bj][m][1];
                        v4u w; w.x = cvtpk(o0[0], o0[1]); w.y = cvtpk(o0[2], o0[3]); w.z = cvtpk(o1[0], o1[1]); w.w = cvtpk(o1[2], o1[3]);
                        *(v4u*)(ob + (size_t)(ai * 128 + m * 16) * DM + bj * 128) = w; }
                __builtin_amdgcn_sched_barrier(0); }
        } else {
            const bf16_t* base = XR + ((size_t)pm * 256 + wr * 64 + fr) * DM + col0;
#pragma unroll
            for (int ai = 0; ai < 2; ++ai) { v4u rb[4][2];
#pragma unroll
                for (int m = 0; m < 4; ++m)
#pragma unroll
                    for (int bj = 0; bj < 2; ++bj) rb[m][bj] = *(const v4u*)(base + (size_t)(ai * 128 + m * 16) * DM + bj * 128);
                __builtin_amdgcn_sched_barrier(0);
#pragma unroll
                for (int m = 0; m < 4; ++m)
#pragma unroll
                    for (int bj = 0; bj < 2; ++bj) { const v4u r = rb[m][bj];
                        const f32x4 r0 = (f32x4){bflo(r.x), bfhi(r.x), bflo(r.y), bfhi(r.y)}, r1 = (f32x4){bflo(r.z), bfhi(r.z), bflo(r.w), bfhi(r.w)};
                        const f32x4 o0 = r0 + gv[bj][0] * acc[ai][bj][m][0], o1 = r1 + gv[bj][1] * acc[ai][bj][m][1];
                        v4u w; w.x = cvtpk(o0[0], o0[1]); w.y = cvtpk(o0[2], o0[3]); w.z = cvtpk(o1[0], o1[1]); w.w = cvtpk(o1[2], o1[3]);
                        *(v4u*)(ob + (size_t)(ai * 128 + m * 16) * DM + bj * 128) = w; }
                __builtin_amdgcn_sched_barrier(0); }
        }
    }
};
struct EpiPart {
    static constexpr bool PERM = false;
    static __device__ __forceinline__ bool keep_acc(const pg8::Unit&) { return false; }
    float* PART;
    __device__ __forceinline__ void operator()(const f32x4 (&acc)[2][2][4][2], const pg8::Unit& u, int wr, int wc, int fr, int fq) const {
        const int ks = u.pn >> 2, ct = u.pn & 3; const int col0 = ct * 256 + wc * 32 + 4 * fq;
#pragma unroll
        for (int ai = 0; ai < 2; ++ai)
#pragma unroll
            for (int m = 0; m < 4; ++m) { float* op = PART + ((size_t)ks * 512 + u.pm * 256 + ai * 128 + wr * 64 + m * 16 + fr) * DM + col0;
#pragma unroll
                for (int bj = 0; bj < 2; ++bj)
#pragma unroll
                    for (int n = 0; n < 2; ++n) *(f32x4*)(op + bj * 128 + n * 16) = acc[ai][bj][m][n]; }
    }
};
struct EpiSwiGLU {
    static constexpr bool PERM = true;
    unsigned char* HID;
    __device__ __forceinline__ void operator()(const f32x4 (&acc)[2][2][4][2], const pg8::Unit& u, int wr, int wc, int fr, int fq) const {
        const int f0 = u.pn * 128 + wc * 32 + 8 * fq;
#pragma unroll
        for (int ai = 0; ai < 2; ++ai)
#pragma unroll
            for (int m = 0; m < 4; ++m) { float o[8];
#pragma unroll
                for (int n = 0; n < 2; ++n)
#pragma unroll
                    for (int j = 0; j < 4; ++j) o[4 * n + j] = siluf_(acc[ai][0][m][n][j] * W8I) * (acc[ai][1][m][n][j] * W8I);
                v2u w; w.x = pk8(o[0], o[1], o[2], o[3]); w.y = pk8(o[4], o[5], o[6], o[7]);
                *(v2u*)(HID + ((size_t)u.pm * 256 + ai * 128 + wr * 64 + m * 16 + fr) * EH + f0) = w; }
    }
};
struct EpiDown {
    static constexpr bool PERM = true;
    bf16_t* Y; const float* SCORE;
    __device__ __forceinline__ void operator()(const f32x4 (&acc)[2][2][4][2], const pg8::Unit& u, int wr, int wc, int fr, int fq) const {
        const int col0 = u.pn * 256 + wc * 32 + 8 * fq;
        float sc8[2][4];
#pragma unroll
        for (int ai = 0; ai < 2; ++ai)
#pragma unroll
            for (int m = 0; m < 4; ++m) sc8[ai][m] = SCORE[(size_t)u.pm * 256 + ai * 128 + wr * 64 + m * 16 + fr];
        __builtin_amdgcn_sched_barrier(0);
#pragma unroll
        for (int ai = 0; ai < 2; ++ai)
#pragma unroll
            for (int m = 0; m < 4; ++m) { const size_t row = (size_t)u.pm * 256 + ai * 128 + wr * 64 + m * 16 + fr; const float s = sc8[ai][m] * W8I;
#pragma unroll
                for (int bj = 0; bj < 2; ++bj) { float o[8];
#pragma unroll
                    for (int n = 0; n < 2; ++n)
#pragma unroll
                        for (int j = 0; j < 4; ++j) o[4 * n + j] = acc[ai][bj][m][n][j] * s;
                    st8(Y + row * DM + col0 + bj * 128, o); } }
    }
};
struct EpiDownPart {
    static constexpr bool PERM = true;
    bf16_t* YP; const float* SCORE;
    __device__ __forceinline__ void operator()(const f32x4 (&acc)[2][2][4][2], const pg8::Unit& u, int wr, int wc, int fr, int fq) const {
        if (wr != 0) return;
        const int in = u.pn & 3, kq = u.pn >> 2, e = u.pm / 9; const int col0 = in * 256 + wc * 32 + 8 * fq;
        float sc4[4];
#pragma unroll
        for (int m = 0; m < 4; ++m) sc4[m] = SCORE[(size_t)u.pm * 256 + m * 16 + fr];
        __builtin_amdgcn_sched_barrier(0);
#pragma unroll
        for (int m = 0; m < 4; ++m) { const size_t row = ((size_t)(kq * 16 + e) * 256 + m * 16 + fr); const float sc = sc4[m] * W8I;
#pragma unroll
            for (int bj = 0; bj < 2; ++bj) { float o[8];
#pragma unroll
                for (int n = 0; n < 2; ++n)
#pragma unroll
                    for (int j = 0; j < 4; ++j) o[4 * n + j] = acc[0][bj][m][n][j] * sc;
                st8(YP + row * DM + col0 + bj * 128, o); } }
    }
};

namespace attn_body {
using bf16 = __hip_bfloat16;
using u32x4 = __attribute__((ext_vector_type(4))) unsigned;
constexpr int NW = 8, QBLK = 32, QB = QBLK * NW, KVBLK = 64;
__device__ __forceinline__ int crow(int r, int hi) { return (r & 3) + 8 * (r >> 2) + 4 * hi; }
#define SBAR() __builtin_amdgcn_sched_barrier(0)
constexpr int NSLOT = 3, SLOTB = 8192;
constexpr int LDS_K = 0, LDS_V = NSLOT * SLOTB, LDS_WS = 2 * NSLOT * SLOTB, LDS_OST = LDS_WS + NW * 64 * 4, LDS_OST1 = LDS_OST + NW * 4096, LDS_RPB = LDS_OST1 + NW * 4096, LDS_ATT_BYTES = LDS_RPB + 2048;
static_assert(LDS_ATT_BYTES <= RING_BYTES, "attention LDS");
__device__ __forceinline__ void glds16(const void* gsrc, unsigned lds_dst) { unsigned keep;
  asm volatile("s_mov_b32 %0, m0\n\ts_mov_b32 m0, %2\n\ts_nop 0\n\tglobal_load_lds_dwordx4 %1, off\n\ts_mov_b32 m0, %0" : "=&s"(keep) : "v"(gsrc), "s"(lds_dst) : "memory"); }
__device__ __forceinline__ float max3f(float a, float b, float c) { float r; asm("v_max3_f32 %0, %1, %2, %3" : "=v"(r) : "v"(a), "v"(b), "v"(c)); return r; }
__device__ __forceinline__ float max2f(float a, float b) { float r; asm("v_max_f32_e32 %0, %1, %2" : "=v"(r) : "v"(a), "v"(b)); return r; }
__device__ __forceinline__ float fadd_s(float a, float b) { float r; asm("v_add_f32_e32 %0, %1, %2" : "=v"(r) : "v"(a), "v"(b)); return r; }
__device__ __forceinline__ float fsub_s(float a, float b) { float r; asm("v_sub_f32_e32 %0, %1, %2" : "=v"(r) : "v"(a), "v"(b)); return r; }
__device__ __forceinline__ unsigned cvtpk_s(float lo, float hi) { return cvtpk(lo, hi); }
#define WAIT_BAR(N) asm volatile("s_waitcnt vmcnt(" #N ") lgkmcnt(0)\n\ts_barrier" ::: "memory")

typedef __attribute__((address_space(3))) const char* lds_cptr;
typedef short v4i16_t __attribute__((ext_vector_type(4)));
__device__ __forceinline__ void qkt(f32x16& p0, f32x16& p1, lds_cptr Kslot, const bf16x8* qr, const f32x16& negm, int r32, int hi) {
  lds_cptr kb = Kslot + hi * 1024 + r32 * 16;
  #pragma unroll
  for (int d0 = 0; d0 < 4; ++d0) {
    const bf16x8 b0 = *(const __attribute__((address_space(3))) bf16x8*)(kb + d0 * 2048);
    const bf16x8 b1 = *(const __attribute__((address_space(3))) bf16x8*)(kb + d0 * 2048 + 512);
    if (d0 == 0) { p0 = __builtin_amdgcn_mfma_f32_32x32x16_bf16(b0, qr[0], negm, 0, 0, 0); p1 = __builtin_amdgcn_mfma_f32_32x32x16_bf16(b1, qr[0], negm, 0, 0, 0); }
    else { p0 = __builtin_amdgcn_mfma_f32_32x32x16_bf16(b0, qr[d0], p0, 0, 0, 0); p1 = __builtin_amdgcn_mfma_f32_32x32x16_bf16(b1, qr[d0], p1, 0, 0, 0); } }
}
__device__ __forceinline__ void kload8(bf16x8* kf, lds_cptr kp) {
  kf[0] = *(const __attribute__((address_space(3))) bf16x8*)(kp);        kf[1] = *(const __attribute__((address_space(3))) bf16x8*)(kp + 512);
  kf[2] = *(const __attribute__((address_space(3))) bf16x8*)(kp + 2048); kf[3] = *(const __attribute__((address_space(3))) bf16x8*)(kp + 2560);
  kf[4] = *(const __attribute__((address_space(3))) bf16x8*)(kp + 4096); kf[5] = *(const __attribute__((address_space(3))) bf16x8*)(kp + 4608);
  kf[6] = *(const __attribute__((address_space(3))) bf16x8*)(kp + 6144); kf[7] = *(const __attribute__((address_space(3))) bf16x8*)(kp + 6656);
}
__device__ __forceinline__ void kload2(bf16x8* kf, lds_cptr kp, int j) { kf[2 * j] = *(const __attribute__((address_space(3))) bf16x8*)(kp + j * 2048); kf[2 * j + 1] = *(const __attribute__((address_space(3))) bf16x8*)(kp + j * 2048 + 512); }
__device__ __forceinline__ s16x4 vtr(lds_cptr p) { return __builtin_bit_cast(s16x4, __builtin_amdgcn_ds_read_tr16_b64_v4i16((__attribute__((address_space(3))) v4i16_t*)p)); }
__device__ __forceinline__ float rowmax(const f32x16& p0, const f32x16& p1) {
  float a = max3f(p0[0], p0[1], p1[0]), b = max3f(p0[2], p0[3], p1[1]); a = max3f(a, p1[2], p1[3]);
  #pragma unroll
  for (int r = 4; r < 16; r += 4) { a = max3f(a, p0[r], p0[r + 1]); b = max3f(b, p0[r + 2], p0[r + 3]); a = max3f(a, p1[r], p1[r + 1]); b = max3f(b, p1[r + 2], p1[r + 3]); }
  const float m = max2f(a, b);
  auto rr = __builtin_amdgcn_permlane32_swap(__float_as_uint(m), __float_as_uint(m), false, false);
  return max2f(__uint_as_float(rr[0]), __uint_as_float(rr[1]));
}
__device__ __forceinline__ void pv(f32x16* o, int vb, bf16x8 pa0, bf16x8 pa1, bf16x8 pa2, bf16x8 pa3) {
  #pragma unroll
  for (int d0 = 0; d0 < 2; ++d0) { s16x4 lo[4], hi[4];
    #pragma unroll
    for (int ks = 0; ks < 4; ++ks) {
      asm volatile("ds_read_b64_tr_b16 %0,%1 offset:%c2" : "=&v"(lo[ks]) : "v"(vb), "i"(d0 * 4096 + ks * 1024) : "memory");
      asm volatile("ds_read_b64_tr_b16 %0,%1 offset:%c2" : "=&v"(hi[ks]) : "v"(vb), "i"(d0 * 4096 + ks * 1024 + 512) : "memory"); }
    asm volatile("s_waitcnt lgkmcnt(0)" ::: "memory"); SBAR();
    #define PK(k) (bf16x8){lo[k][0], lo[k][1], lo[k][2], lo[k][3], hi[k][0], hi[k][1], hi[k][2], hi[k][3]}
    o[d0] = __builtin_amdgcn_mfma_f32_32x32x16_bf16(pa0, PK(0), o[d0], 0, 0, 0);
    o[d0] = __builtin_amdgcn_mfma_f32_32x32x16_bf16(pa1, PK(1), o[d0], 0, 0, 0);
    o[d0] = __builtin_amdgcn_mfma_f32_32x32x16_bf16(pa2, PK(2), o[d0], 0, 0, 0);
    o[d0] = __builtin_amdgcn_mfma_f32_32x32x16_bf16(pa3, PK(3), o[d0], 0, 0, 0);
    #undef PK
  }
}

struct DiffEpi { float lam, post; const float* subg; };
template <int THRL, int MODE> __device__ __forceinline__ void attn_unit(const bf16* Qu, const bf16* __restrict__ Kh, const bf16* __restrict__ Vh, int NT, bf16* Ou, char* shm, const DiffEpi de) {
  constexpr int PK = PQ, PV = PQ, PO = 1024;
  constexpr bool DQ32 = (MODE != 0);
  const int tid = opaque_tid(), lane = tid & 63, r32 = lane & 31, hi = lane >> 5; const int wid = __builtin_amdgcn_readfirstlane(tid >> 6);
  const bf16* Qw = Qu + (long)(wid * QBLK) * PQ;
  const unsigned lds0 = (unsigned)(uintptr_t)shm;
  float* wsf = (float*)(shm + LDS_WS) + wid * 64;
  const bf16* ksrc = Kh + (long)lane * PK + wid * 8;
  const bf16* vsrc = Vh + (long)(16 * (wid & 3) + (lane >> 2)) * PV + (wid >> 2) * 32 + (lane & 3) * 8;
  const unsigned kdst = lds0 + LDS_K + wid * 1024, vdst = lds0 + LDS_V + wid * 1024;
  #define DMA_K(t, slot) glds16(ksrc + (long)(t) * KVBLK * PK, (unsigned)__builtin_amdgcn_readfirstlane(kdst + (slot)))
  #define DMA_V(t, slot) glds16(vsrc + (long)(t) * KVBLK * PV, (unsigned)__builtin_amdgcn_readfirstlane(vdst + (slot)))
  const int vb0 = (int)(lds0 + LDS_V) + ((lane >> 4) & 1) * 32 + (lane & 3) * 8 + (4 * hi + ((lane & 15) >> 2)) * 64;
  bf16x8 kf[8];
  const lds_cptr shm3 = (lds_cptr)shm; const lds_cptr kp0 = shm3 + LDS_K + hi * 1024 + r32 * 16; const lds_cptr vp0 = shm3 + LDS_V + ((lane >> 4) & 1) * 32 + (lane & 3) * 8 + (4 * hi + ((lane & 15) >> 2)) * 64;
  DMA_K(0, 0); DMA_V(0, 0); DMA_K(1, SLOTB);
  bf16x8 qr[4];
  #pragma unroll
  for (int d0 = 0; d0 < 4; ++d0) qr[d0] = *reinterpret_cast<const bf16x8*>(&Qw[(long)r32 * PQ + d0 * 16 + hi * 8]);
  float mhat = 0.f, l_reg = 0.f; f32x16 o[2]; o[0] = f32x16{}; o[1] = f32x16{}; f32x16 negm = f32x16{}; asm volatile("" : "+v"(negm));
  bool resc = false;
  #define START(P0, P1) do { const float rm = rowmax(P0, P1); resc = false; \
    { const float dl = rm; mhat = fadd_s(mhat, dl); \
      _Pragma("unroll") for (int r = 0; r < 16; ++r) { P0[r] = fsub_s(P0[r], dl); P1[r] = fsub_s(P1[r], dl); } \
      _Pragma("unroll") for (int r = 0; r < 16; ++r) negm[r] = -mhat; asm volatile("" : "+v"(negm)); } \
    _Pragma("unroll") for (int r = 0; r < 16; ++r) P0[r] = __builtin_amdgcn_exp2f(P0[r]); } while (0)
  #define RESC() do { if (resc) { asm volatile("s_waitcnt lgkmcnt(0)" ::: "memory"); \
      _Pragma("unroll") for (int d_ = 0; d_ < 2; ++d_) _Pragma("unroll") for (int r = 0; r < 16; ++r) o[d_][r] *= wsf[crow(r, hi)]; } } while (0)
  f32x16 pA0, pA1, pB0, pB1;
  int sl_prev = 0, sl_cur = 0, sl_next = SLOTB;
  #define ROT() do { sl_prev = sl_cur; sl_cur = sl_next; sl_next = (sl_next == (NSLOT - 1) * SLOTB) ? 0 : sl_next + SLOTB; } while (0)
  DMA_K(2, 2 * SLOTB);
  WAIT_BAR(3);
  qkt(pA0, pA1, shm3 + LDS_K, qr, negm, r32, hi); asm volatile("s_nop 15\n\ts_nop 7" : "+v"(pA0), "+v"(pA1));
  START(pA0, pA1);
  _Pragma("unroll") for (int r = 0; r < 16; ++r) pA1[r] = __builtin_amdgcn_exp2f(pA1[r]);
  WAIT_BAR(0);
  DMA_K(3, 0); DMA_V(1, SLOTB);
  ROT();
  kload8(kf, kp0 + sl_cur);
  WAIT_BAR(2);
  s16x4 vlo[8], vhi[8]; u32x4 pw0, pw1, pw2, pw3;
  #define PKW(P, B) cvtpk_s(P[B], P[B + 1])
  #define PAF(k) __builtin_bit_cast(bf16x8, pw##k)
  #define VFR(i) (bf16x8){vlo[i][0], vlo[i][1], vlo[i][2], vlo[i][3], vhi[i][0], vhi[i][1], vhi[i][2], vhi[i][3]}
  #define PIN(x) asm volatile("" : "+v"(x))
  #define MX3(a, b, c) __builtin_fmaxf(__builtin_fmaxf((a), (b)), (c))
  #define GAPA(MF, A0, A1, A2, A3, W0, W1, PW) do { MF; sacc += A0; sacc += A1; sacc += A2; sacc += A3; PIN(sacc); W0; W1; PIN(PW); SBAR(); } while (0)
  #define EX(v) __builtin_amdgcn_exp2f(v)
  #define GAPB(MF, X, B) do { MF; X[B] = EX(X[B]); X[B + 1] = EX(X[B + 1]); X[B + 2] = EX(X[B + 2]); X[B + 3] = EX(X[B + 3]); PIN(X); SBAR(); } while (0)
  #define VRD(i) do { vlo[i] = vtr(vp_ + (((i) >> 2) * 4096 + ((i) & 3) * 1024)); vhi[i] = vtr(vp_ + (((i) >> 2) * 4096 + ((i) & 3) * 1024 + 512)); } while (0)
  #define KRD(G, j) do { if (G) { kload2(kf, kp0 + sl_next, j); SBAR(); } } while (0)
  #define STEP(C0, C1, P0, P1, t, GK, GV, GL) do { SBAR(); \
    const lds_cptr vp_ = vp0 + sl_prev; \
    VRD(0); SBAR(); float sacc = (P0[0] + P0[1]); \
    GAPA(C0 = __builtin_amdgcn_mfma_f32_32x32x16_bf16(kf[0], qr[0], negm, 0, 0, 0), P0[2], P0[3], P0[4], P0[5],     pw0[0] = PKW(P0, 0), pw0[1] = PKW(P0, 2), pw0); \
    VRD(4); SBAR(); GAPA(C1 = __builtin_amdgcn_mfma_f32_32x32x16_bf16(kf[1], qr[0], negm, 0, 0, 0), P0[6], P0[7], P0[8], P0[9],     pw0[2] = PKW(P0, 4), pw0[3] = PKW(P0, 6), pw0); \
    VRD(1); SBAR(); GAPA(C0 = __builtin_amdgcn_mfma_f32_32x32x16_bf16(kf[2], qr[1], C0, 0, 0, 0),   P0[10], P0[11], P0[12], P0[13], pw1[0] = PKW(P0, 8), pw1[1] = PKW(P0, 10), pw1); \
    VRD(5); SBAR(); GAPA(C1 = __builtin_amdgcn_mfma_f32_32x32x16_bf16(kf[3], qr[1], C1, 0, 0, 0),   P0[14], P0[15], P1[0], P1[1],   pw1[2] = PKW(P0, 12), pw1[3] = PKW(P0, 14), pw1); \
    VRD(2); SBAR(); GAPA(do { if (!DQ32) { C0 = __builtin_amdgcn_mfma_f32_32x32x16_bf16(kf[4], qr[2], C0, 0, 0, 0); } } while (0),   P1[2], P1[3], P1[4], P1[5],     pw2[0] = PKW(P1, 0), pw2[1] = PKW(P1, 2), pw2); \
    VRD(6); SBAR(); GAPA(do { if (!DQ32) { C1 = __builtin_amdgcn_mfma_f32_32x32x16_bf16(kf[5], qr[2], C1, 0, 0, 0); } } while (0),   P1[6], P1[7], P1[8], P1[9],     pw2[2] = PKW(P1, 4), pw2[3] = PKW(P1, 6), pw2); \
    VRD(3); SBAR(); GAPA(do { if (!DQ32) { C0 = __builtin_amdgcn_mfma_f32_32x32x16_bf16(kf[6], qr[3], C0, 0, 0, 0); } } while (0),   P1[10], P1[11], P1[12], P1[13], pw3[0] = PKW(P1, 8), pw3[1] = PKW(P1, 10), pw3); \
    VRD(7); SBAR(); GAPA(do { if (!DQ32) { C1 = __builtin_amdgcn_mfma_f32_32x32x16_bf16(kf[7], qr[3], C1, 0, 0, 0); } } while (0),   P1[14], P1[15], 0.f, 0.f,       pw3[2] = PKW(P1, 12), pw3[3] = PKW(P1, 14), pw3); \
    l_reg += sacc; \
    if (GK) { DMA_K((t) + 3, sl_cur); } if (GV) { DMA_V((t) + 1, sl_next); } \
    { float a = MX3(C0[0], C0[1], C1[0]), b = MX3(C0[2], C0[3], C1[1]); a = MX3(a, C1[2], C1[3]); \
      _Pragma("unroll") for (int r = 4; r < 16; r += 4) { a = MX3(a, C0[r], C0[r + 1]); b = MX3(b, C0[r + 2], C0[r + 3]); a = MX3(a, C1[r], C1[r + 1]); b = MX3(b, C1[r + 2], C1[r + 3]); } \
      float rm = __builtin_fmaxf(a, b); { auto rr = __builtin_amdgcn_permlane32_swap(__float_as_uint(rm), __float_as_uint(rm), false, false); rm = __builtin_fmaxf(__uint_as_float(rr[0]), __uint_as_float(rr[1])); } \
      resc = false; \
      if (__builtin_expect(__any(rm > (float)THRL), 0)) { const float dl = __builtin_fmaxf(rm, 0.f); mhat += dl; \
        _Pragma("unroll") for (int r = 0; r < 16; ++r) { C0[r] -= dl; C1[r] -= dl; } \
        _Pragma("unroll") for (int r = 0; r < 16; ++r) negm[r] = -mhat; asm volatile("" : "+v"(negm)); \
        const float f = __builtin_amdgcn_exp2f(-dl); l_reg *= f; if (hi == 0) wsf[r32] = f; resc = true; } } \
    SBAR(); \
    GAPB(o[0] = __builtin_amdgcn_mfma_f32_32x32x16_bf16(PAF(0), VFR(0), o[0], 0, 0, 0), C0, 0); \
    GAPB(o[1] = __builtin_amdgcn_mfma_f32_32x32x16_bf16(PAF(0), VFR(4), o[1], 0, 0, 0), C0, 4); \
    KRD(GL, 0); GAPB(o[0] = __builtin_amdgcn_mfma_f32_32x32x16_bf16(PAF(1), VFR(1), o[0], 0, 0, 0), C0, 8); \
    KRD(GL, 1); GAPB(o[1] = __builtin_amdgcn_mfma_f32_32x32x16_bf16(PAF(1), VFR(5), o[1], 0, 0, 0), C0, 12); \
    KRD(GL && !DQ32, 2); GAPB(o[0] = __builtin_amdgcn_mfma_f32_32x32x16_bf16(PAF(2), VFR(2), o[0], 0, 0, 0), C1, 0); \
    KRD(GL && !DQ32, 3); GAPB(o[1] = __builtin_amdgcn_mfma_f32_32x32x16_bf16(PAF(2), VFR(6), o[1], 0, 0, 0), C1, 4); \
    GAPB(o[0] = __builtin_amdgcn_mfma_f32_32x32x16_bf16(PAF(3), VFR(3), o[0], 0, 0, 0), C1, 8); \
    GAPB(o[1] = __builtin_amdgcn_mfma_f32_32x32x16_bf16(PAF(3), VFR(7), o[1], 0, 0, 0), C1, 12); \
    } while (0)
  int t = 1;
  for (; t + 5 < NT; t += 2) {
    STEP(pB0, pB1, pA0, pA1, t, true, true, true);     WAIT_BAR(2); RESC(); ROT();
    STEP(pA0, pA1, pB0, pB1, t + 1, true, true, true); WAIT_BAR(2); RESC(); ROT();
  }
  #define ENDW(tt) do { if ((tt) + 3 < NT) { WAIT_BAR(2); } else if ((tt) + 2 < NT) { WAIT_BAR(1); } else { WAIT_BAR(0); } } while (0)
  for (; t + 1 < NT; t += 2) {
    STEP(pB0, pB1, pA0, pA1, t, (t + 3 < NT), (t + 1 < NT), (t + 1 < NT));       ENDW(t);     RESC(); ROT();
    STEP(pA0, pA1, pB0, pB1, t + 1, (t + 4 < NT), (t + 2 < NT), (t + 2 < NT));   ENDW(t + 1); RESC(); ROT();
  }
  STEP(pB0, pB1, pA0, pA1, NT - 1, false, false, false); RESC();
  { float sacc = pB0[0] + pB0[1]; _Pragma("unroll") for (int r = 2; r < 16; ++r) sacc += pB0[r]; _Pragma("unroll") for (int r = 0; r < 16; ++r) sacc += pB1[r]; l_reg += sacc;
    pw0 = (u32x4){PKW(pB0, 0), PKW(pB0, 2), PKW(pB0, 4), PKW(pB0, 6)}; pw1 = (u32x4){PKW(pB0, 8), PKW(pB0, 10), PKW(pB0, 12), PKW(pB0, 14)}; pw2 = (u32x4){PKW(pB1, 0), PKW(pB1, 2), PKW(pB1, 4), PKW(pB1, 6)}; pw3 = (u32x4){PKW(pB1, 8), PKW(pB1, 10), PKW(pB1, 12), PKW(pB1, 14)};
    SBAR(); pv(o, vb0 + sl_cur, PAF(0), PAF(1), PAF(2), PAF(3)); }
  #undef PKW
  #undef PAF
  #undef VFR
  #undef PIN
  #undef MX3
  #undef GAPA
  #undef GAPB
  #undef EX
  #undef VRD
  #undef KRD
  #undef STEP
  #undef ENDW
  { auto rr = __builtin_amdgcn_permlane32_swap(__float_as_uint(l_reg), __float_as_uint(l_reg), false, false); l_reg = __uint_as_float(rr[0]) + __uint_as_float(rr[1]); }
  if (hi == 0) wsf[32 + r32] = l_reg; asm volatile("s_waitcnt lgkmcnt(0)" ::: "memory");
  float rli[16];
  #pragma unroll
  for (int r = 0; r < 16; ++r) rli[r] = __builtin_amdgcn_rcpf(wsf[32 + crow(r, hi)]);
  bf16_t* stg = (bf16_t*)(shm + LDS_OST) + wid * 2048;
  bf16_t* stg1 = (bf16_t*)(shm + LDS_OST1) + wid * 2048;
  if (MODE == 1) {
    #pragma unroll
    for (int r = 0; r < 16; ++r) { const int orow = crow(r, hi);
      #pragma unroll
      for (int d0 = 0; d0 < 2; ++d0) stg1[orow * 64 + d0 * 32 + r32] = f2bf(o[d0][r] * rli[r]); }
    asm volatile("s_waitcnt lgkmcnt(0)" ::: "memory");
  } else {
    if (MODE == 2) {
      const float g0 = de.subg[r32] * de.post, g1 = de.subg[32 + r32] * de.post;
      #pragma unroll
      for (int r = 0; r < 16; ++r) { const int orow = crow(r, hi);
        const float d0v = bf2f(stg1[orow * 64 + r32]) - de.lam * (o[0][r] * rli[r]), d1v = bf2f(stg1[orow * 64 + 32 + r32]) - de.lam * (o[1][r] * rli[r]);
        float ss = d0v * d0v + d1v * d1v;
        ss = half32_sum(ss);
        const float rstd = __builtin_amdgcn_rsqf(ss * (1.0f / 64.0f) + EPS);
        stg[orow * 64 + r32] = f2bf(d0v * rstd * g0); stg[orow * 64 + 32 + r32] = f2bf(d1v * rstd * g1); }
    } else {
      #pragma unroll
      for (int r = 0; r < 16; ++r) { const int orow = crow(r, hi);
        #pragma unroll
        for (int d0 = 0; d0 < 2; ++d0) stg[orow * 64 + d0 * 32 + r32] = f2bf(o[d0][r] * rli[r]); }
    }
    asm volatile("s_waitcnt lgkmcnt(0)" ::: "memory");
    bf16* Ow = Ou + (long)(wid * QBLK) * PO;
    #pragma unroll
    for (int i = 0; i < 4; ++i) { const int row = i * 8 + (lane >> 3), ch = lane & 7; const u32x4 v = *(const u32x4*)(stg + row * 64 + ch * 8); *(u32x4*)(Ow + (long)row * PO + ch * 8) = v; }
  }
  asm volatile("s_waitcnt lgkmcnt(0)\n\ts_barrier" ::: "memory");
  #undef DMA_K
  #undef DMA_V
  #undef START
  #undef RESC
  #undef ROT
}

__device__ __forceinline__ void na_unit(int b, int h, int g4, const bf16* QKV, bf16* YS, const float* rpb_h, char* shm) {
  const bf16 *QA = QKV + C_QA, *KA = QKV + C_KA, *VA = QKV + C_VA;
  const int tid = opaque_tid(), lane = tid & 63, r32 = lane & 31, hi = lane >> 5; const int wid = __builtin_amdgcn_readfirstlane(tid >> 6);
  const unsigned lds0 = (unsigned)(uintptr_t)shm;
  float* wsf = (float*)(shm + LDS_WS) + wid * 64;
  float* rp = (float*)(shm + LDS_RPB);
  const lds_cptr shm3 = (lds_cptr)shm;
  for (int i = tid; i < 15 * 31; i += 512) rp[i] = rpb_h[i] * LOG2E;
  const int rq = 4 * g4 + (wid >> 1), qc = 32 * (wid & 1) + r32;
  const long rowb = (long)b * RB;
  const bf16* Qw = QA + (rowb + CTXL + rq * 64 + 32 * (wid & 1)) * PQ + h * 64;
  bf16x8 qr[4];
  #pragma unroll
  for (int d0 = 0; d0 < 4; ++d0) qr[d0] = *reinterpret_cast<const bf16x8*>(&Qw[(long)r32 * PQ + d0 * 16 + hi * 8]);
  const int r0 = min(max(rq - 4, 0), 120);
  const int kr_lo = min(max(4 * g4 - 4, 0), 120), kr_hi = min(max(4 * g4 - 1, 0), 120) + 7;
  const int ntiles = 4 + (kr_hi - kr_lo + 1);
  const int c0 = min(max(qc - 8, 0), 48);
  float mrun = -INFINITY, l_reg = 0.f; f32x16 o[2]; o[0] = f32x16{}; o[1] = f32x16{};
  const unsigned kdst = lds0 + LDS_K + wid * 1024, vdst = lds0 + LDS_V + wid * 1024;
  const int vb0 = (int)(lds0 + LDS_V) + ((lane >> 4) & 1) * 32 + (lane & 3) * 8 + (4 * hi + ((lane & 15) >> 2)) * 64;
  #define NA_DMA(TI) do { const int kr_ = kr_lo + (TI) - 4; const long krow_ = ((TI) < 4) ? rowb + 64 * (TI) : rowb + CTXL + (long)kr_ * 64; const unsigned so_ = ((TI) & 1) * SLOTB; \
      glds16(KA + (krow_ + lane) * PQ + h * 64 + wid * 8, (unsigned)__builtin_amdgcn_readfirstlane(kdst + so_)); \
      glds16(VA + (krow_ + 16 * (wid & 3) + (lane >> 2)) * PQ + h * 64 + (wid >> 2) * 32 + (lane & 3) * 8, (unsigned)__builtin_amdgcn_readfirstlane(vdst + so_)); } while (0)
  asm volatile("s_waitcnt lgkmcnt(0)\n\ts_barrier" ::: "memory");
  NA_DMA(0);
  for (int ti = 0; ti < ntiles; ++ti) {
    const int kr = kr_lo + ti - 4;
    asm volatile("s_waitcnt vmcnt(0) lgkmcnt(0)\n\ts_barrier" ::: "memory");
    if (ti + 1 < ntiles) NA_DMA(ti + 1);
    const unsigned so = (ti & 1) * SLOTB;
    const bool valid = (ti < 4) || (kr >= r0 && kr <= r0 + 7);
    if (valid) {
      f32x16 p0, p1; const f32x16 z = f32x16{};
      qkt(p0, p1, shm3 + LDS_K + so, qr, z, r32, hi);
      if (ti >= 4) {
        const int dr = kr - rq + 7;
        #pragma unroll
        for (int r = 0; r < 16; ++r) { const int k0 = crow(r, hi), k1 = k0 + 32;
          const bool v0 = (k0 >= c0) && (k0 < c0 + 16), v1 = (k1 >= c0) && (k1 < c0 + 16);
          const float b0 = v0 ? rp[dr * 31 + (k0 - qc + 15)] : 0.f, b1 = v1 ? rp[dr * 31 + (k1 - qc + 15)] : 0.f;
          p0[r] = v0 ? p0[r] + b0 : -INFINITY; p1[r] = v1 ? p1[r] + b1 : -INFINITY; }
      }
      float rm = p0[0];
      #pragma unroll
      for (int r = 1; r < 16; ++r) rm = fmaxf(rm, p0[r]);
      #pragma unroll
      for (int r = 0; r < 16; ++r) rm = fmaxf(rm, p1[r]);
      { auto rr = __builtin_amdgcn_permlane32_swap(__float_as_uint(rm), __float_as_uint(rm), false, false); rm = fmaxf(__uint_as_float(rr[0]), __uint_as_float(rr[1])); }
      const float mnew = fmaxf(mrun, rm); const float f = __builtin_amdgcn_exp2f(mrun - mnew); mrun = mnew;
      float sacc = 0.f;
      #pragma unroll
      for (int r = 0; r < 16; ++r) { p0[r] = __builtin_amdgcn_exp2f(p0[r] - mnew); p1[r] = __builtin_amdgcn_exp2f(p1[r] - mnew); sacc += p0[r] + p1[r]; }
      l_reg = l_reg * f + sacc;
      if (hi == 0) wsf[r32] = f;
      asm volatile("s_waitcnt lgkmcnt(0)" ::: "memory");
      #pragma unroll
      for (int d_ = 0; d_ < 2; ++d_)
        #pragma unroll
        for (int r = 0; r < 16; ++r) o[d_][r] *= wsf[crow(r, hi)];
      u32x4 pw0, pw1, pw2, pw3;
      pw0 = (u32x4){cvtpk(p0[0], p0[1]), cvtpk(p0[2], p0[3]), cvtpk(p0[4], p0[5]), cvtpk(p0[6], p0[7])}; pw1 = (u32x4){cvtpk(p0[8], p0[9]), cvtpk(p0[10], p0[11]), cvtpk(p0[12], p0[13]), cvtpk(p0[14], p0[15])};
      pw2 = (u32x4){cvtpk(p1[0], p1[1]), cvtpk(p1[2], p1[3]), cvtpk(p1[4], p1[5]), cvtpk(p1[6], p1[7])}; pw3 = (u32x4){cvtpk(p1[8], p1[9]), cvtpk(p1[10], p1[11]), cvtpk(p1[12], p1[13]), cvtpk(p1[14], p1[15])};
      asm volatile("s_waitcnt lgkmcnt(0)" ::: "memory");
      pv(o, vb0 + (int)so, __builtin_bit_cast(bf16x8, pw0), __builtin_bit_cast(bf16x8, pw1), __builtin_bit_cast(bf16x8, pw2), __builtin_bit_cast(bf16x8, pw3));
    }
  }
  #undef NA_DMA
  { auto rr = __builtin_amdgcn_permlane32_swap(__float_as_uint(l_reg), __float_as_uint(l_reg), false, false); l_reg = __uint_as_float(rr[0]) + __uint_as_float(rr[1]); }
  if (hi == 0) wsf[32 + r32] = l_reg; asm volatile("s_waitcnt lgkmcnt(0)" ::: "memory");
  bf16_t* stg = (bf16_t*)(shm + LDS_OST) + wid * 2048;
  #pragma unroll
  for (int r = 0; r < 16; ++r) { const int orow = crow(r, hi); const float rl = __builtin_amdgcn_rcpf(wsf[32 + orow]);
    #pragma unroll
    for (int d0 = 0; d0 < 2; ++d0) stg[orow * 64 + d0 * 32 + r32] = f2bf(o[d0][r] * rl); }
  asm volatile("s_waitcnt lgkmcnt(0)" ::: "memory");
  bf16* Ow = YS + (rowb + CTXL + rq * 64 + 32 * (wid & 1)) * 1024 + h * 64;
  #pragma unroll
  for (int i = 0; i < 4; ++i) { const int row = i * 8 + (lane >> 3), ch = lane & 7; const u32x4 v = *(const u32x4*)(stg + row * 64 + ch * 8); *(u32x4*)(Ow + (long)row * 1024 + ch * 8) = v; }
  asm volatile("s_waitcnt lgkmcnt(0)\n\ts_barrier" ::: "memory");
}
#undef SBAR
#undef WAIT_BAR
}

__device__ __forceinline__ void sgu_unit(long rowbase, const bf16_t* GU, const bf16_t* GV, const float* ng, const float* sw, const float* sb, bf16_t* YS, char* shm) {
    using attn_body::crow;
    const int tid = opaque_tid(), lane = tid & 63, wid = __builtin_amdgcn_readfirstlane(tid >> 6), r32 = lane & 31, hi = lane >> 5;
    const unsigned lds0 = (unsigned)(uintptr_t)shm;
    {
        const f32x4 g4 = *(const f32x4*)(ng + 4 * lane);
        const int gl = lane >> 4, d = 4 * (lane & 15);
#pragma unroll
        for (int rb = 0; rb < 4; ++rb) { v2u raw[4];
#pragma unroll
            for (int q4 = 0; q4 < 4; ++q4) raw[q4] = *(const v2u*)(GV + (rowbase + wid * 16 + rb * 4 + q4) * PQ + 4 * lane);
            __builtin_amdgcn_sched_barrier(0);
#pragma unroll
            for (int q4 = 0; q4 < 4; ++q4) { const int q = wid * 16 + rb * 4 + q4;
                f32x4 v = {bflo(raw[q4].x), bfhi(raw[q4].x), bflo(raw[q4].y), bfhi(raw[q4].y)};
                const float mean = wave_sum((v.x + v.y) + (v.z + v.w)) * (1.0f / 256.0f);
                v = v - mean;
                const float var = wave_sum((v.x * v.x + v.y * v.y) + (v.z * v.z + v.w * v.w)) * (1.0f / 256.0f);
                const float rstd = __builtin_amdgcn_rsqf(var + EPS);
                v = v * rstd * g4;
                v2u w; w.x = cvtpk(v.x, v.y); w.y = cvtpk(v.z, v.w);
                const int k = q & 63;
                *(v2u*)(shm + (2 * gl + (q >> 6)) * 8192 + ((d >> 5) * 4 + (k >> 4)) * 1024 + (k & 15) * 64 + (d & 31) * 2) = w; }
            __builtin_amdgcn_sched_barrier(0); }
    }
    __syncthreads();
    const int g = wid & 3, ph = wid >> 2;
    const int vb0 = (int)lds0 + ((lane >> 4) & 1) * 32 + (lane & 3) * 8 + (4 * hi + ((lane & 15) >> 2)) * 64;
    bf16_t* stg = (bf16_t*)(shm + 65536) + wid * 2048;
#pragma unroll
    for (int mt = 0; mt < 2; ++mt) {
        const int p0 = ph * 64 + mt * 32;
        const float* wrow = sw + ((size_t)g * 128 + p0 + r32) * 128 + 4 * hi;
        f32x16 o[2]; o[0] = f32x16{}; o[1] = f32x16{};
#pragma unroll
        for (int sl = 0; sl < 2; ++sl) {
            f32x4 wa[4], wc[4];
#pragma unroll
            for (int s4 = 0; s4 < 4; ++s4) { wa[s4] = *(const f32x4*)(wrow + 64 * sl + 16 * s4); wc[s4] = *(const f32x4*)(wrow + 64 * sl + 16 * s4 + 8); }
            __builtin_amdgcn_sched_barrier(0);
            bf16x8 pa[4];
#pragma unroll
            for (int s4 = 0; s4 < 4; ++s4) { const v4u w = {cvtpk(wa[s4].x, wa[s4].y), cvtpk(wa[s4].z, wa[s4].w), cvtpk(wc[s4].x, wc[s4].y), cvtpk(wc[s4].z, wc[s4].w)}; pa[s4] = __builtin_bit_cast(bf16x8, w); }
            attn_body::pv(o, vb0 + (2 * g + sl) * 8192, pa[0], pa[1], pa[2], pa[3]);
        }
        float bias[16];
#pragma unroll
        for (int r = 0; r < 16; ++r) bias[r] = sb[g * 128 + p0 + crow(r, hi)];
        v4u uu[4];
#pragma unroll
        for (int i = 0; i < 4; ++i) uu[i] = *(const v4u*)(GU + (rowbase + p0 + i * 8 + (lane >> 3)) * PQ + g * 64 + (lane & 7) * 8);
        __builtin_amdgcn_sched_barrier(0);
#pragma unroll
        for (int r = 0; r < 16; ++r) { const int orow = crow(r, hi);
#pragma unroll
            for (int d0 = 0; d0 < 2; ++d0) stg[orow * 64 + d0 * 32 + r32] = f2bf(o[d0][r] + bias[r]); }
        asm volatile("s_waitcnt lgkmcnt(0)" ::: "memory");
#pragma unroll
        for (int i = 0; i < 4; ++i) { const int row = i * 8 + (lane >> 3), ch = lane & 7; const v4u mv = *(const v4u*)(stg + row * 64 + ch * 8); const v4u u4 = uu[i];
            v4u w; w.x = cvtpk(bflo(u4.x) * bflo(mv.x), bfhi(u4.x) * bfhi(mv.x)); w.y = cvtpk(bflo(u4.y) * bflo(mv.y), bfhi(u4.y) * bfhi(mv.y));
            w.z = cvtpk(bflo(u4.z) * bflo(mv.z), bfhi(u4.z) * bfhi(mv.z)); w.w = cvtpk(bflo(u4.w) * bflo(mv.w), bfhi(u4.w) * bfhi(mv.w));
            *(v4u*)(YS + (rowbase + p0 + row) * 1024 + 512 + g * 64 + ch * 8) = w; }
        asm volatile("s_waitcnt lgkmcnt(0)" ::: "memory");
    }
    __syncthreads();
}

typedef GAS unsigned gu32;
#define XB_TMO      128
#define XB_XCNT(j)  (256  + 64 * (j))
#define XB_XSUB(j)  (1280 + 64 * (j))
#define XB_XGEN(j)  (2304 + 64 * (j))
#define XB_TOP      3328
#define XB_TOPGEN   3392
#define XCD_BAR_WORDS 3456
#define XB_SPIN_CAP (1u << 18)
__device__ __forceinline__ unsigned xb_ld(unsigned* p)              { return __hip_atomic_load(p, __ATOMIC_RELAXED, __HIP_MEMORY_SCOPE_AGENT); }
__device__ __forceinline__ unsigned xb_add(unsigned* p, unsigned v) { return __hip_atomic_fetch_add(p, v, __ATOMIC_RELAXED, __HIP_MEMORY_SCOPE_AGENT); }
__device__ __forceinline__ unsigned xb_xcc_id() { return (unsigned)__builtin_amdgcn_s_getreg((3 << 11) | 20) & 0xFu; }
#define XB_SPIN(cond, bar) do { unsigned _sp = 0; while (cond) { __builtin_amdgcn_s_sleep(1); \
    if ((++_sp & 255u) == 0u) { if (xb_ld(&(bar)[XB_TMO])) break; if (_sp > XB_SPIN_CAP) { atomicAdd(&(bar)[XB_TMO], 1u); break; } } } } while (0)
struct XcdBarrier { unsigned* bar; unsigned x; volatile LAS unsigned* st; };
__device__ __forceinline__ XcdBarrier xcd_barrier_post(unsigned* bar, volatile LAS unsigned* st) {
    XcdBarrier b; b.bar = bar; b.x = xb_xcc_id(); b.st = st;
    if (threadIdx.x == 0) (void)xb_add(&bar[XB_XCNT(b.x)], 1u);
    return b;
}
__device__ __forceinline__ void xcd_barrier_complete(unsigned* bar, unsigned x, unsigned& nloc, unsigned& nx) {
    const unsigned G = gridDim.x * gridDim.y * gridDim.z;
    unsigned sum, cnt, mine, sp = 0u;
    for (;;) {
        sum = 0u; cnt = 0u; mine = 0u;
#pragma unroll
        for (unsigned j = 0; j < 16; ++j) { const unsigned c = xb_ld(&bar[XB_XCNT(j)]); sum += c; cnt += (c > 0u) ? 1u : 0u; }
        if (sum == G) break;
        __builtin_amdgcn_s_sleep(1);
        if ((++sp & 255u) == 0u) { if (xb_ld(&bar[XB_TMO])) break; if (sp > XB_SPIN_CAP) { atomicAdd(&bar[XB_TMO], 1u); break; } }
    }
    mine = xb_ld(&bar[XB_XCNT(x)]);
    nloc = mine > 0u ? mine : 1u; nx = cnt > 0u ? cnt : 1u;
}
__device__ __forceinline__ void xcd_barrier(const XcdBarrier& b) {
    asm volatile("s_waitcnt vmcnt(0)" ::: "memory");
    __syncthreads();
    if (threadIdx.x == 0) {
        unsigned* bar = b.bar;
        __builtin_amdgcn_s_waitcnt(0);
        unsigned nloc = b.st[0], nx = b.st[1];
        if (nloc == 0u) { xcd_barrier_complete(bar, b.x, nloc, nx); b.st[0] = nloc; b.st[1] = nx; }
        const unsigned old = xb_add(&bar[XB_XSUB(b.x)], 1u);
        const unsigned gen = old / nloc;
        if (old + 1u == (gen + 1u) * nloc) {
            __builtin_amdgcn_fence(__ATOMIC_RELEASE, "agent");
            asm volatile("s_waitcnt vmcnt(0)" ::: "memory");
            const unsigned og = xb_add(&bar[XB_TOP], 1u);
            const unsigned tg = og / nx;
            if (og + 1u == (tg + 1u) * nx) xb_add(&bar[XB_TOPGEN], 1u);
            else XB_SPIN(xb_ld(&bar[XB_TOPGEN]) == tg, bar);
            __builtin_amdgcn_fence(__ATOMIC_ACQUIRE, "agent");
            xb_add(&bar[XB_XGEN(b.x)], 1u);
            asm volatile("s_waitcnt vmcnt(0)" ::: "memory");
        } else {
            XB_SPIN(xb_ld(&bar[XB_XGEN(b.x)]) == gen, bar);
            __builtin_amdgcn_fence(__ATOMIC_ACQUIRE, "agent");
            asm volatile("s_waitcnt vmcnt(0)" ::: "memory");
        }
    }
    __syncthreads();
}

struct Args { const float* in[28]; float* out; unsigned char* ws; int ph_lo, ph_hi, li, pad; };
typedef const __attribute__((address_space(4))) Args* KArgs;
__device__ __forceinline__ KArgs opaque_kargs() { KArgs p = (KArgs)__builtin_amdgcn_kernarg_segment_ptr(); asm volatile("" : "+s"(p)); return p; }
enum { I_X = 0, I_C, I_CTX, I_CCTX, I_WMOD, I_BMOD, I_N1G, I_N2G, I_WIN, I_QG, I_KG, I_RPB, I_LQ1, I_LK1, I_LQ2, I_LK2, I_SUBG, I_SGUNG, I_SGUW, I_SGUB, I_GATEB, I_WBR, I_WOUT, I_WRT, I_WEG, I_WEU, I_WED, I_FG };

constexpr int CW_WIN = 16 * 26, CW_WB = 4 * 4 * 4, CW_WO = 16 * 4, CW_EG = 16 * 16 * 8, CW_ED = 16 * 32 * 4, CW_LAYER = CW_WIN + CW_WB + CW_WO + 2 * CW_EG + CW_ED;
struct ConvItem { const float* src; unsigned char* dst; int N, dpitch, k0, n0, kind, aux; };
__device__ __forceinline__ ConvItem conv_decode(KArgs A, int it) {
    ConvItem c; const int l = it / CW_LAYER; int r = it % CW_LAYER; unsigned char* wl = A->ws + WS_W0 + (size_t)l * W_LAYER; c.aux = 0;
    if (r < CW_WIN) { const int kb = r / 26, pn = r % 26; c.src = A->in[I_WIN] + (size_t)l * DM * IN_W; c.N = IN_W; c.k0 = 64 * kb; c.n0 = 256 * pn; c.dpitch = DM;
        if (pn >= 5 && pn <= 20) { c.kind = 1; c.dst = wl + WO_WING + (size_t)(c.n0 - 1280) * DM; } else { c.kind = 2; c.dst = wl + WO_WIN + (size_t)256 * (pn < 5 ? pn : pn - 16) * DM * 2; }
        return c; }
    r -= CW_WIN;
    if (r < CW_WB) { const int n = r / 16, q = r % 16, kb = q / 4, nb = q % 4; c.src = A->in[I_WBR] + ((size_t)l * 4 + n) * 256 * DM; c.N = DM; c.k0 = 64 * kb; c.n0 = 256 * nb; c.dpitch = 256; c.kind = 0; c.dst = wl + WO_WB + ((size_t)n * 1024 + c.n0) * 256 * 2; return c; }
    r -= CW_WB;
    if (r < CW_WO) { const int kb = r / 4, nb = r % 4; c.src = A->in[I_WOUT] + (size_t)l * DM * DM; c.N = DM; c.k0 = 64 * kb; c.n0 = 256 * nb; c.dpitch = DM; c.kind = 0; c.dst = wl + WO_WO4 + (size_t)c.n0 * DM * 2; return c; }
    r -= CW_WO;
    if (r < 2 * CW_EG) { const int up = r >= CW_EG; if (up) r -= CW_EG; const int e = r / 128, q = r % 128, kb = q / 8, nb = q % 8; c.src = A->in[up ? I_WEU : I_WEG] + ((size_t)l * NEXP + e) * DM * EH; c.N = EH; c.k0 = 64 * kb; c.n0 = 256 * nb; c.dpitch = DM;
        c.kind = 3; c.aux = up ? 128 : 0; c.dst = wl + WO_WGU + (size_t)e * 4096 * DM; return c; }
    r -= 2 * CW_EG;
    { const int e = r / 128, q = r % 128, kb = q / 4, nb = q % 4; c.src = A->in[I_WED] + ((size_t)l * NEXP + e) * EH * DM; c.N = DM; c.k0 = 64 * kb; c.n0 = 256 * nb; c.dpitch = EH; c.kind = 1; c.dst = wl + WO_WD + ((size_t)e * DM + c.n0) * EH; return c; }
}
constexpr int CW_SMALL = CW_WIN + CW_WB + CW_WO, CW_MOE = 2 * CW_EG + CW_ED;
template <bool SMALL> __device__ __forceinline__ int conv_id(int it) { return SMALL ? (it / CW_SMALL) * CW_LAYER + it % CW_SMALL : it; }
template <bool SMALL> __device__ __forceinline__ void conv_load(KArgs A, int it, int NIT, f32x4 (&rg)[8], int wv, int lane) {
    if (it < NIT) { const ConvItem c = conv_decode(A, conv_id<SMALL>(it)); const float* p = c.src + (size_t)(c.k0 + wv * 8) * c.N + c.n0 + 4 * lane;
#pragma unroll
        for (int i = 0; i < 8; ++i) rg[i] = *(const f32x4*)(p + (size_t)i * c.N); }
}
template <bool SMALL> __device__ __forceinline__ void conv_out(KArgs A, int it, const f32x4 (&rg)[8], LAS float* T, int tid, int wv, int lane) {
    constexpr int TP = 256;
#pragma unroll
    for (int i = 0; i < 8; ++i) *(LAS f32x4*)(T + (wv * 8 + i) * TP + 4 * (lane ^ wv)) = rg[i];
    asm volatile("s_waitcnt lgkmcnt(0)" ::: "memory"); __builtin_amdgcn_s_barrier(); asm volatile("" ::: "memory");
    const ConvItem c = conv_decode(A, conv_id<SMALL>(it));
#pragma unroll
    for (int jj = 0; jj < 4; ++jj) { const int q = tid + 512 * jj, ch = q & 7, n = q >> 3; const LAS float* t = T + (8 * ch) * TP + (n ^ (4 * ch));
        float v[8];
#pragma unroll
        for (int i = 0; i < 8; ++i) v[i] = t[i * TP];
        if (c.kind == 1) { v2u o; o.x = pk8(v[0] * W8S, v[1] * W8S, v[2] * W8S, v[3] * W8S); o.y = pk8(v[4] * W8S, v[5] * W8S, v[6] * W8S, v[7] * W8S); *(v2u*)(c.dst + (size_t)n * c.dpitch + c.k0 + 8 * ch) = o; }
        else if (c.kind == 3) { const int f = c.n0 + n; v2u o; o.x = pk8(v[0] * W8S, v[1] * W8S, v[2] * W8S, v[3] * W8S); o.y = pk8(v[4] * W8S, v[5] * W8S, v[6] * W8S, v[7] * W8S); *(v2u*)(c.dst + (size_t)(256 * (f >> 7) + (f & 127) + c.aux) * c.dpitch + c.k0 + 8 * ch) = o; }
        else { const int g = n >> 5, row = c.kind == 2 ? 32 * (4 * (g & 1) + (g >> 1)) + (n & 31) : n; st8((bf16_t*)c.dst + (size_t)row * c.dpitch + c.k0 + 8 * ch, v); } }
    asm volatile("s_waitcnt lgkmcnt(0)" ::: "memory"); __builtin_amdgcn_s_barrier(); asm volatile("" ::: "memory");
}
template <bool SMALL = false> __device__ __forceinline__ void conv_run(KArgs A, int first, int stride, int end, LAS unsigned char* lds, int tid) {
    const int lane = tid & 63, wv = tid >> 6; LAS float* T = (LAS float*)lds;
    f32x4 rg[4][8];
#pragma unroll
    for (int d = 0; d < 4; ++d) conv_load<SMALL>(A, first + d * stride, end, rg[d], wv, lane);
    for (int it = first; it < end; it += 4 * stride) {
#pragma unroll
        for (int d = 0; d < 4; ++d) if (it + d * stride < end) {
            f32x4 t0[8];
#pragma unroll
            for (int i = 0; i < 8; ++i) t0[i] = rg[d][i];
            conv_load<SMALL>(A, it + (4 + d) * stride, end, rg[d], wv, lane);
            conv_out<SMALL>(A, it + d * stride, t0, T, tid, wv, lane);
        }
    }
}
__device__ __forceinline__ void mod_item(KArgs A, int item, LAS unsigned char* lds, int tid) {
    const int lane = tid & 63, wid = tid >> 6, l = item / 96, col0 = 64 * (item % 96);
    LAS float* sil = (LAS float*)lds;
    LAS float* part = sil + 3 * 1024;
    for (int i = tid; i < 3 * 1024; i += 512) { const int r = i >> 10, k = i & 1023; const float cv = r < 2 ? A->in[I_C][r * DM + k] : A->in[I_CCTX][k]; sil[i] = siluf_(cv); }
    __syncthreads();
    const float* W = A->in[I_WMOD] + (size_t)l * DM * 6144 + col0 + lane;
    float a0 = 0.f, a1 = 0.f, a2 = 0.f;
    for (int kb = 0; kb < 4; ++kb) { float w[32];
#pragma unroll
        for (int q = 0; q < 32; ++q) w[q] = W[(size_t)(wid * 128 + kb * 32 + q) * 6144];
        __builtin_amdgcn_sched_barrier(0);
#pragma unroll
        for (int q = 0; q < 32; ++q) { const int k = wid * 128 + kb * 32 + q; a0 += sil[k] * w[q]; a1 += sil[1024 + k] * w[q]; a2 += sil[2048 + k] * w[q]; }
        __builtin_amdgcn_sched_barrier(0); }
    part[(wid * 3 + 0) * 64 + lane] = a0; part[(wid * 3 + 1) * 64 + lane] = a1; part[(wid * 3 + 2) * 64 + lane] = a2;
    __syncthreads();
    if (tid < 192) { const int r = tid >> 6, cl = tid & 63; float s = A->in[I_BMOD][(size_t)l * 6144 + col0 + cl];
#pragma unroll
        for (int w = 0; w < 8; ++w) s += part[(w * 3 + r) * 64 + cl];
        ((float*)(A->ws + WS_MOD))[((size_t)l * 3 + r) * 6144 + col0 + cl] = s; }
    __syncthreads();
}

struct Row { f32x4 v[4]; };
__device__ __forceinline__ Row row_load(const float* p, int lane) { Row r; const f32x4* q = (const f32x4*)p + lane;
#pragma unroll
    for (int j = 0; j < 4; ++j) r.v[j] = q[64 * j]; return r; }
__device__ __forceinline__ Row row_load_bf16(const bf16_t* p, int lane) { Row r; const v2u* q = (const v2u*)p + lane; v2u t[4];
#pragma unroll
    for (int j = 0; j < 4; ++j) t[j] = q[64 * j];
#pragma unroll
    for (int j = 0; j < 4; ++j) r.v[j] = (f32x4){bflo(t[j].x), bfhi(t[j].x), bflo(t[j].y), bfhi(t[j].y)};
    return r; }
__device__ __forceinline__ void row_store(float* p, const Row& r, int lane) { f32x4* q = (f32x4*)p + lane;
#pragma unroll
    for (int j = 0; j < 4; ++j) q[64 * j] = r.v[j]; }
__device__ __forceinline__ float row_rstd(const Row& r) { float s = 0.f;
#pragma unroll
    for (int j = 0; j < 4; ++j) s += (r.v[j].x * r.v[j].x + r.v[j].y * r.v[j].y) + (r.v[j].z * r.v[j].z + r.v[j].w * r.v[j].w);
    return __builtin_amdgcn_rsqf(wave_sum(s) * (1.0f / DM) + EPS); }
__device__ __forceinline__ Row row_normmod(const Row& x, float rstd, const float* g, const float* sh, const float* sc, int lane) { Row y; f32x4 gg[4], ss[4], hh[4];
#pragma unroll
    for (int j = 0; j < 4; ++j) { gg[j] = ((const f32x4*)g)[lane + 64 * j]; ss[j] = ((const f32x4*)sc)[lane + 64 * j]; hh[j] = ((const f32x4*)sh)[lane + 64 * j]; }
    __builtin_amdgcn_sched_barrier(0);
#pragma unroll
    for (int j = 0; j < 4; ++j) y.v[j] = x.v[j] * rstd * gg[j] * (ss[j] + 1.0f) + hh[j];
    return y; }
struct NormP { f32x4 a[4], h[4]; };
__device__ __forceinline__ NormP normp_load(const float* g, const float* sh, const float* sc, int lane) { NormP p; f32x4 gg[4], ss[4];
#pragma unroll
    for (int j = 0; j < 4; ++j) { gg[j] = ((const f32x4*)g)[lane + 64 * j]; ss[j] = ((const f32x4*)sc)[lane + 64 * j]; p.h[j] = ((const f32x4*)sh)[lane + 64 * j]; }
    __builtin_amdgcn_sched_barrier(0);
#pragma unroll
    for (int j = 0; j < 4; ++j) p.a[j] = gg[j] * (ss[j] + 1.0f);
    return p; }
__device__ __forceinline__ Row row_normmod_p(const Row& x, float rstd, const NormP& p) { Row y;
#pragma unroll
    for (int j = 0; j < 4; ++j) y.v[j] = x.v[j] * rstd * p.a[j] + p.h[j];
    return y; }
__device__ __forceinline__ void row_store_bf16(bf16_t* p, const Row& r, int lane) { v2u* q = (v2u*)p + lane;
#pragma unroll
    for (int j = 0; j < 4; ++j) { v2u w; w.x = cvtpk(r.v[j].x, r.v[j].y); w.y = cvtpk(r.v[j].z, r.v[j].w); q[64 * j] = w; } }
__device__ __forceinline__ void row_store_fp8(unsigned char* p, const Row& r, int lane) { unsigned* q = (unsigned*)p + lane;
#pragma unroll
    for (int j = 0; j < 4; ++j) q[64 * j] = pk8(r.v[j].x, r.v[j].y, r.v[j].z, r.v[j].w); }
__device__ __forceinline__ const float* in_row(KArgs A, int R) { const int b = R / RB, r = R % RB; return r < CTXL ? A->in[I_CTX] + ((size_t)b * CTXL + r) * DM : A->in[I_X] + ((size_t)b * SEQ + (r - CTXL)) * DM; }
__device__ __forceinline__ int mod_row(int R) { const int b = R / RB, r = R % RB; return r < CTXL ? 2 : b; }

__device__ __forceinline__ int lat_tile(int im) { return (im >> 5) * TPB + 1 + (im & 31); }
struct SchedP1 { const char* HN; const char* W; int layer, G, c;
    __device__ __forceinline__ bool next(int i, pg8::Unit& u) const {
        const int nmain = 64 * 10, nextra = layer == 0 ? 2 * 10 : 2 * 5; const int L = i * G + c; if (L >= nmain + nextra) return false;
        int pm, pq;
        if (L < nmain) { int im, in; pg8::rect_order(L, 64, 10, im, in); pm = lat_tile(im); pq = in; }
        else { const int x = L - nmain; if (layer == 0) { pm = (x / 10) * TPB; pq = x % 10; } else { pm = (x / 5) * TPB; pq = 5 + x % 5; } }
        u.pm = pm; u.pn = pq < 5 ? pq : pq + 16; u.a = HN + (size_t)pm * 256 * DM * 2; u.b = W + (size_t)pq * 256 * DM * 2; return true; } };
struct SchedP1g { const char* HN8; const char* W8; int layer, G, c;
    __device__ __forceinline__ bool next(int i, pg8::Unit& u) const {
        const int nmain = 64 * 16, nextra = layer == 0 ? 2 * 16 : 0; const int L = i * G + (G - 1 - c); if (L >= nmain + nextra) return false;
        int pm, pn;
        if (L < nmain) { int im; pg8::rect_order(L, 64, 16, im, pn); pm = lat_tile(im); }
        else { const int x = L - nmain; pm = (x >> 4) * TPB; pn = x & 15; }
        u.pm = pm; u.pn = pn; u.a = HN8 + (size_t)pm * 256 * DM; u.b = W8 + (size_t)pn * 256 * DM; return true; } };
struct SchedP3a { const char* YS; const char* WB; int layer, G, c;
    __device__ __forceinline__ bool next(int i, pg8::Unit& u) const {
        int pm, dt, n;
        if (i < 4) { if (c >= 256) return false; int im; pg8::rect_order(c, 64, 4, im, dt); pm = lat_tile(im); n = i; }
        else { if (i > 4 || layer != 0 || c >= 32) return false; pm = (c >> 4) * TPB; dt = (c >> 2) & 3; n = c & 3; }
        u.pm = pm; u.pn = dt * 4 + n; u.a = YS + ((size_t)pm * 256 * DM + 256 * n) * 2; u.b = WB + ((size_t)n * 1024 + dt * 256) * 256 * 2; return true; } };
struct SchedP3b { const char* MRG; const char* WO; int G, c;
    __device__ __forceinline__ bool next(int i, pg8::Unit& u) const {
        const int L = i * G + c; if (L >= 64 * 4) return false;
        int im, in; pg8::rect_order(L, 64, 4, im, in); const int pm = lat_tile(im);
        u.pm = pm; u.pn = in; u.a = MRG + (size_t)pm * 256 * DM * 2; u.b = WO + (size_t)in * 256 * DM * 2; return true; } };
struct SchedP3c { const char* GPC; const char* WO; int G, c;
    __device__ __forceinline__ bool next(int i, pg8::Unit& u) const {
        const int L = i * G + c; if (L >= 128) return false;
        const int pm = L >> 6, ks = (L >> 2) & 15, ct = L & 3, n = ks >> 2, kq = ks & 3;
        u.pm = pm; u.pn = ks * 4 + ct; u.a = GPC + (((size_t)n * 512 + pm * 256) * DM + kq * 256) * 2; u.b = WO + ((size_t)ct * 256 * DM + kq * 256) * 2; return true; } };
struct SchedP6 { const char* XG; const char* WGU; int RT, G, c;
    __device__ __forceinline__ bool next(int i, pg8::Unit& u) const {
        const int nM = 16 * RT; const int L = i * G + c; if (L >= nM * 16) return false;
        int im, in; pg8::rect_order(L, nM, 16, im, in); const int e = im / RT;
        u.pm = im; u.pn = in; u.a = XG + (size_t)im * 256 * DM; u.b = WGU + ((size_t)e * 4096 + in * 256) * DM; return true; } };
struct SchedP7 { const char* HID; const char* WD; int RT, G, c;
    __device__ __forceinline__ bool next(int i, pg8::Unit& u) const {
        const int nM = 16 * 8; const int L = i * G + c; if (L >= nM * 4) return false;
        int im8, in; pg8::rect_order(L, nM, 4, im8, in); const int e = im8 >> 3, im = e * RT + (im8 & 7);
        u.pm = im; u.pn = in; u.a = HID + (size_t)im * 256 * EH; u.b = WD + ((size_t)e * DM + in * 256) * EH; return true; } };
struct SchedP7c { const char* HID; const char* WD; int G, c;
    __device__ __forceinline__ bool next(int i, pg8::Unit& u) const {
        const int L = i * G + c; if (L >= 256) return false;
        const int e = L >> 4, in = (L >> 2) & 3, kq = L & 3, im = e * 9 + 8;
        u.pm = im; u.pn = in + 4 * kq; u.a = HID + (size_t)im * 256 * EH + kq * 512; u.b = WD + ((size_t)e * DM + in * 256) * EH + kq * 512; return true; } };

__device__ __forceinline__ unsigned block_excl_scan(unsigned v, LAS unsigned* wtot, int lane, int wid) {
    unsigned inc = v;
#pragma unroll
    for (int o = 1; o < 64; o <<= 1) { const unsigned t = (unsigned)__builtin_amdgcn_ds_bpermute(((lane - o) & 63) << 2, (int)inc); if (lane >= o) inc += t; }
    if (lane == 63) wtot[wid] = inc;
    __syncthreads();
    unsigned base = 0;
#pragma unroll
    for (int w = 0; w < 8; ++w) base += (w < wid) ? wtot[w] : 0u;
    __syncthreads();
    return base + inc - v;
}
__device__ __forceinline__ void topk_unit(KArgs A, int RT, bool isctx, int b, int e, LAS unsigned char* lds, int tid) {
    const int lane = tid & 63, wid = tid >> 6;
    LAS unsigned* hist = (LAS unsigned*)lds; LAS unsigned* wtot = hist + 256; LAS unsigned* sel = wtot + 16;
    const int cap = isctx ? 32 : 1024;
    const float* aff = isctx ? (const float*)(A->ws + WS_AFFC) + ((size_t)b * 16 + e) * 256 : (const float*)(A->ws + WS_AFFL) + ((size_t)b * 16 + e) * 8192;
    unsigned key[16];
    if (isctx) {
#pragma unroll
        for (int j = 0; j < 16; ++j) key[j] = 0u;
        if (tid < 256) key[0] = __float_as_uint(aff[tid]);
    } else {
#pragma unroll
        for (int q = 0; q < 4; ++q) { const f32x4 t = *(const f32x4*)(aff + tid * 16 + 4 * q); key[4 * q] = __float_as_uint(t.x); key[4 * q + 1] = __float_as_uint(t.y); key[4 * q + 2] = __float_as_uint(t.z); key[4 * q + 3] = __float_as_uint(t.w); }
    }
#define TK_VALID(j) (isctx ? ((j) == 0 && tid < 256) : true)
    unsigned pfx = 0u, need = (unsigned)cap;
    for (int pass = 0; pass < 4; ++pass) { const int shift = 24 - 8 * pass;
        for (int i = tid; i < 256; i += 512) hist[i] = 0u;
        __syncthreads();
#pragma unroll
        for (int j = 0; j < 16; ++j) if (TK_VALID(j) && (pass == 0 || (key[j] >> (shift + 8)) == pfx)) __hip_atomic_fetch_add(&hist[(key[j] >> shift) & 255u], 1u, __ATOMIC_RELAXED, __HIP_MEMORY_SCOPE_WORKGROUP);
        __syncthreads();
        if (wid == 0) {
            const unsigned h0 = hist[4 * lane], h1 = hist[4 * lane + 1], h2 = hist[4 * lane + 2], h3 = hist[4 * lane + 3], s = h0 + h1 + h2 + h3;
            unsigned incl = s;
#pragma unroll
            for (int o = 1; o < 64; o <<= 1) { const unsigned t = (unsigned)__builtin_amdgcn_ds_bpermute(((lane + o) & 63) << 2, (int)incl); if (lane + o < 64) incl += t; }
            const unsigned excl = incl - s;
            if (excl < need && need <= incl) { unsigned c = excl; int bin;
                if (c + h3 >= need) bin = 3; else { c += h3; if (c + h2 >= need) bin = 2; else { c += h2; if (c + h1 >= need) bin = 1; else { c += h1; bin = 0; } } }
                sel[0] = (unsigned)(4 * lane + bin); sel[1] = need - c; }
        }
        __syncthreads();
        pfx = (pfx << 8) | sel[0]; need = sel[1];
        __syncthreads();
    }
    const unsigned T = pfx;
    unsigned ce = 0u;
#pragma unroll
    for (int j = 0; j < 16; ++j) ce += (TK_VALID(j) && key[j] == T) ? 1u : 0u;
    unsigned re = block_excl_scan(ce, wtot, lane, wid);
    unsigned selmask = 0u, cs = 0u;
#pragma unroll
    for (int j = 0; j < 16; ++j) if (TK_VALID(j)) { bool s = key[j] > T; if (key[j] == T) { s = re < need; ++re; } if (s) { selmask |= 1u << j; ++cs; } }
    unsigned slot = block_excl_scan(cs, wtot, lane, wid);
    int* IDXROW = (int*)(A->ws + WS_IDXROW); float* SCORE = (float*)(A->ws + WS_SCORE); int* INV = (int*)(A->ws + WS_INV);
    const int ybase = e * RT * 256 + (isctx ? 2048 + b * 32 : b * 1024);
#pragma unroll
    for (int j = 0; j < 16; ++j) if (TK_VALID(j)) { const int idx = isctx ? tid : tid * 16 + j; const int R = b * RB + (isctx ? idx : CTXL + idx);
        if (selmask & (1u << j)) { const int yrow = ybase + (int)slot; IDXROW[yrow] = R; SCORE[yrow] = __uint_as_float(key[j]); INV[((size_t)b * 16 + e) * RB + (R - b * RB)] = yrow; ++slot; }
        else INV[((size_t)b * 16 + e) * RB + (R - b * RB)] = -1; }
    if (isctx && b == 0 && tid < 192) IDXROW[e * RT * 256 + 2048 + 64 + tid] = -1;
#undef TK_VALID
    __syncthreads();
}

struct AJob { const attn_body::bf16 *Q, *K, *V; attn_body::bf16* O; int nt, mode; };
__device__ __forceinline__ bool mixer_job(unsigned char* ws, int l, int vcu, int i, AJob& j) {
    using attn_body::bf16;
    const bf16* QKV = (const bf16*)(ws + WS_QKV); bf16* YS = (bf16*)(ws + WS_YS);
    if (i < 3) { const int b = vcu >> 7, h = (vcu >> 5) & 3, qb = vcu & 31; const long q0 = (long)b * RB + CTXL + qb * 256, k0 = (long)b * RB;
        if (i < 2) { const int vh = 2 * h + i; j.Q = QKV + q0 * PQ + C_QB + vh * 64; j.K = QKV + k0 * PQ + C_KB + vh * 64; j.V = QKV + k0 * PQ + C_VB + h * 64; j.O = YS + q0 * 1024 + 256 + h * 64; j.nt = 132; j.mode = 1 + i; }
        else { j.Q = QKV + q0 * PQ + C_QD + h * 64; j.K = QKV + k0 * PQ + C_KD + (h >> 1) * 64; j.V = QKV + k0 * PQ + C_VD + (h >> 1) * 64; j.O = YS + q0 * 1024 + 768 + h * 64; j.nt = 132; j.mode = 0; }
        return true; }
    if (l != 0) return false;
    const int uc = (vcu + 256 - 132) & 255; if (uc >= 24) return false;
    const int type = uc >> 3, b = (uc >> 2) & 1, h = uc & 3, k = i - 3; const long q0 = (long)b * RB;
    j.nt = 4;
    if (type == 0) { if (k > 0) return false; j.Q = QKV + q0 * PQ + C_QA + h * 64; j.K = QKV + q0 * PQ + C_KA + h * 64; j.V = QKV + q0 * PQ + C_VA + h * 64; j.O = YS + q0 * 1024 + h * 64; j.mode = 0; return true; }
    if (type == 1) { if (k > 1) return false; const int vh = 2 * h + k; j.Q = QKV + q0 * PQ + C_QB + vh * 64; j.K = QKV + q0 * PQ + C_KB + vh * 64; j.V = QKV + q0 * PQ + C_VB + h * 64; j.O = YS + q0 * 1024 + 256 + h * 64; j.mode = 1 + k; return true; }
    if (k > 0) return false; j.Q = QKV + q0 * PQ + C_QD + h * 64; j.K = QKV + q0 * PQ + C_KD + (h >> 1) * 64; j.V = QKV + q0 * PQ + C_VD + (h >> 1) * 64; j.O = YS + q0 * 1024 + 768 + h * 64; j.mode = 0; return true;
}

__global__ void __launch_bounds__(512, 2) fwd_kernel(Args A_) {
    extern __shared__ __attribute__((aligned(16))) unsigned char lds[];
    LAS unsigned char* L = (LAS unsigned char*)lds;
    const int tid0 = threadIdx.x;
    const int G0 = gridDim.x, bx0 = blockIdx.x;
    unsigned char* ws = A_.ws;
    for (int u = tid0; u < (LDS_BYTES - LDSCTL_OFF) / 4; u += 512) ((LAS unsigned*)(L + LDSCTL_OFF))[u] = 0u;
    __syncthreads();
    XcdBarrier bar; bar.bar = (unsigned*)(ws + WS_CTL) + CW_BAR + A_.li * XCD_BAR_WORDS; bar.x = 0; bar.st = nullptr;
    if (!MK_PER_PHASE) bar = xcd_barrier_post((unsigned*)(ws + WS_CTL) + CW_BAR + A_.li * XCD_BAR_WORDS, (volatile LAS unsigned*)(L + MISC_OFF) + 8);
#define PHASE_PTRS KArgs A = opaque_kargs(); unsigned char* ws = A->ws; const int G = opaque_s(G0), bx = opaque_s(bx0), vcu = (bx % 8) * (G / 8) + bx / 8, wave = __builtin_amdgcn_readfirstlane(opaque_tid() >> 6), gw = vcu * 8 + wave, NGW = G * 8; (void)gw; (void)NGW; (void)vcu; const float* MOD = (const float*)(ws + WS_MOD); bf16_t* HN = (bf16_t*)(ws + WS_HN); bf16_t* H2 = (bf16_t*)(ws + WS_H2); bf16_t* YS = (bf16_t*)(ws + WS_YS); \
    bf16_t* GT = (bf16_t*)(ws + WS_GT); bf16_t* X1 = (bf16_t*)(ws + WS_X1); bf16_t* XR = (bf16_t*)(ws + WS_XR); float* PART = (float*)(ws + WS_PART); \
    (void)MOD; (void)HN; (void)H2; (void)YS; (void)GT; (void)X1; (void)XR; (void)PART;
    const int lo = A_.ph_lo, hi = A_.ph_hi;
#ifndef DBG_MASK
#define DBG_MASK 0xffffffffu
#endif
#define PHON(k) ((DBG_MASK >> ((k) < 2 ? (k) : 2 + ((k) - 2) % 10)) & 1u)
#define IN(k) (PHON(k) && lo <= (k) && (k) < hi)
#define SEAM(k) do { if (!MK_PER_PHASE && (k) + 1 < hi) { XcdBarrier b2_ = bar; b2_.bar = (unsigned*)opaque_ptr((unsigned char*)bar.bar); xcd_barrier(b2_); } } while (0)

    if (IN(0)) { PHASE_PTRS
        const int tid = opaque_tid(), lane = tid & 63; (void)tid; (void)lane;
        for (int item = bx; item < 192; item += G) mod_item(A, item, L, tid);
        __syncthreads();
        SEAM(0);
    }
    if (IN(1)) { PHASE_PTRS
        const int tid = opaque_tid(), lane = tid & 63; (void)tid; (void)lane;
        { const int Ra = gw * 9, Rb = min(Ra + 9, NR);
          Row xn = row_load(in_row(A, min(Ra, NR - 1)), lane), xn2 = row_load(in_row(A, min(Ra + 1, NR - 1)), lane), xn3 = row_load(in_row(A, min(Ra + 2, NR - 1)), lane);
          int cur = mod_row(min(Ra, NR - 1)); NormP np; { const float* m = MOD + (size_t)cur * 6144; np = normp_load(A->in[I_N1G], m, m + 1024, lane); }
          for (int R = Ra; R < Rb; ++R) { const Row x = xn; xn = xn2; xn2 = xn3; if (R + 3 < Rb) xn3 = row_load(in_row(A, R + 3), lane);
            const int mr = mod_row(R); if (mr != cur) { const float* m = MOD + (size_t)mr * 6144; np = normp_load(A->in[I_N1G], m, m + 1024, lane); cur = mr; }
            const Row y = row_normmod_p(x, row_rstd(x), np); row_store_bf16(HN + (size_t)R * DM, y, lane); row_store_fp8(ws + WS_HN8 + (size_t)R * DM, y, lane); } }
        __syncthreads();
        conv_run<true>(A, vcu, G, DEPTH * CW_SMALL, L, tid);
        SEAM(1);
    }
    for (int l = 0; l < DEPTH; ++l) {
        const int P = 2 + 10 * l; const int RT = l == 0 ? 9 : 8;
#define LAYER_PTRS PHASE_PTRS unsigned char* wl = ws + WS_W0 + (size_t)l * W_LAYER; const float* MODL = MOD + (size_t)l * 3 * 6144; (void)wl; (void)MODL;
        if (IN(P + 0)) { LAYER_PTRS
            { SchedP1 S{(const char*)HN, (const char*)(wl + WO_WIN), l, G, bx};
              EpiInProj E{(bf16_t*)(ws + WS_QKV), GT, A->in[I_QG] + l * 64, A->in[I_KG] + l * 64, A->in[I_GATEB] + (size_t)l * 4096};
              pg8::gemm_phase<EpiInProj, SchedP1>(L, DM, DM, DM, S, E); }
            { SchedP1g S{(const char*)(ws + WS_HN8), (const char*)(wl + WO_WING), l, G, bx}; EpiGates E{(unsigned char*)GT, A->in[I_GATEB] + (size_t)l * 4096};
              pg8::gemm8_phase<EpiGates, SchedP1g>(L, DM / 2, DM / 2, DM / 2, S, E); }
            SEAM(P + 0);
        }
        if (IN(P + 1)) { LAYER_PTRS
            const int tid = opaque_tid(), lane = tid & 63; (void)tid; (void)lane;
            float s1 = lane < 32 ? A->in[I_LQ1][l * 32 + lane] * A->in[I_LK1][l * 32 + lane] : 0.f, s2 = lane < 32 ? A->in[I_LQ2][l * 32 + lane] * A->in[I_LK2][l * 32 + lane] : 0.f;
            const float lam_init = l == 0 ? 0.2f : 0.35550906759096934f;
            const float lam = expf(wave_sum(s1)) - expf(wave_sum(s2)) + lam_init;
            const attn_body::DiffEpi de{lam, 1.0f - lam_init, A->in[I_SUBG] + l * 64};
            const int cslot = vcu & 3, cbase = l * CW_LAYER + CW_SMALL + vcu * (CW_MOE / 256);
#define CONV_SEAM(k) do { if (cslot == (k)) conv_run(A, cbase, 1, cbase + CW_MOE / 256, L, opaque_tid()); } while (0)
            static_assert(CW_MOE % 256 == 0, "expert-weight items split evenly over 256 CUs");
            CONV_SEAM(0);
            AJob j;
            for (int i = 0; mixer_job(ws, l, vcu, i, j); ++i) {
                if (i == 2) CONV_SEAM(1);
                if (i == 3) CONV_SEAM(2);
                if (j.mode == 0) attn_body::attn_unit<8, 0>(j.Q, j.K, j.V, j.nt, j.O, (char*)lds, de);
                else if (j.mode == 1) attn_body::attn_unit<8, 1>(j.Q, j.K, j.V, j.nt, j.O, (char*)lds, de);
                else attn_body::attn_unit<8, 2>(j.Q, j.K, j.V, j.nt, j.O, (char*)lds, de);
            }
            if (l != 0 || ((vcu + 256 - 132) & 255) >= 24) CONV_SEAM(2);
            { const int b = vcu >> 7, h = (vcu >> 5) & 3, g4 = vcu & 31;
              attn_body::na_unit(b, h, g4, (const attn_body::bf16*)(ws + WS_QKV), (attn_body::bf16*)YS, A->in[I_RPB] + ((size_t)l * 4 + h) * 465, (char*)lds); }
            CONV_SEAM(3);
            const int nsgu = 128 + (l == 0 ? 4 : 0);
            if (vcu < nsgu) { const long rowbase = vcu < 128 ? (long)(vcu >> 6) * RB + CTXL + (vcu & 63) * 128 : (long)((vcu - 128) >> 1) * RB + ((vcu - 128) & 1) * 128;
                sgu_unit(rowbase, (const bf16_t*)(ws + WS_QKV) + C_GU, (const bf16_t*)(ws + WS_QKV) + C_GV, A->in[I_SGUNG] + l * 256, A->in[I_SGUW] + (size_t)l * 4 * 128 * 128, A->in[I_SGUB] + l * 4 * 128, YS, (char*)lds); }
            SEAM(P + 1);
        }
        if (IN(P + 2)) { LAYER_PTRS
            SchedP3a S{(const char*)YS, (const char*)(wl + WO_WB), l, G, bx}; EpiGateAcc E{(const unsigned char*)GT, (bf16_t*)(ws + WS_MRG), (bf16_t*)(ws + WS_GPC)};
            pg8::gemm_phase<EpiGateAcc, SchedP3a>(L, 256, DM, 256, S, E);
            SEAM(P + 2);
        }
        if (IN(P + 3)) { LAYER_PTRS
            { SchedP3b S{(const char*)(ws + WS_MRG), (const char*)(wl + WO_WO4), G, bx}; EpiOutRes E{A->in[I_X], A->in[I_CTX], XR, X1, MODL, l};
              pg8::gemm_phase<EpiOutRes, SchedP3b>(L, DM, DM, DM, S, E); }
            if (l == 0) { SchedP3c S{(const char*)(ws + WS_GPC), (const char*)(wl + WO_WO4), G, bx}; EpiPart E{PART};
              pg8::gemm_phase<EpiPart, SchedP3c>(L, 256, DM, DM, S, E); }
            SEAM(P + 3);
        }
        if (IN(P + 4)) { LAYER_PTRS
            const int tid = opaque_tid(), lane = tid & 63; (void)tid; (void)lane;
            LAS float* wrT = (LAS float*)L;
            const float* wr = A->in[I_WRT] + (size_t)l * DM * 16;
            { f32x4 wv[8];
#pragma unroll
              for (int q = 0; q < 8; ++q) wv[q] = ((const f32x4*)wr)[tid + 512 * q];
              __builtin_amdgcn_sched_barrier(0);
#pragma unroll
              for (int q = 0; q < 8; ++q) { const int i4 = tid + 512 * q, k = i4 >> 2, e0 = (i4 & 3) * 4;
#pragma unroll
                  for (int j = 0; j < 4; ++j) wrT[(e0 + j) * DM + k] = wv[q][j]; } }
            __syncthreads();
            const int nit = 8 + ((l == 0 && gw < 512) ? 1 : 0);
            Row xn; { const int i0 = gw * 8; xn = row_load_bf16(X1 + ((size_t)(i0 >> 13) * RB + CTXL + (i0 & 8191)) * DM, lane); }
            NormP np; { const float* m0 = MODL + (size_t)((gw * 8) >> 13) * 6144; np = normp_load(A->in[I_N2G] + l * DM, m0 + 3072, m0 + 4096, lane); }
            for (int it = 0; it < nit; ++it) { const int i = it < 8 ? gw * 8 + it : 16384 + gw; const bool isctx = i >= 16384; const int b = isctx ? (i - 16384) >> 8 : i >> 13, r = isctx ? (i - 16384) & 255 : CTXL + (i & 8191); const int R = b * RB + r;
                const float* m = MODL + (size_t)(isctx ? 2 : b) * 6144;
                Row x = xn;
                if (it + 1 < 8) { const int in = i + 1; xn = row_load_bf16(X1 + ((size_t)(in >> 13) * RB + CTXL + (in & 8191)) * DM, lane); }
                if (isctx) { x = row_load(in_row(A, R), lane); Row s;
#pragma unroll
                    for (int j = 0; j < 4; ++j) s.v[j] = (f32x4){0.f, 0.f, 0.f, 0.f};
                    for (int ks = 0; ks < 16; ks += 4) { Row p[4];
#pragma unroll
                        for (int q = 0; q < 4; ++q) p[q] = row_load(PART + ((size_t)(ks + q) * 512 + b * 256 + r) * DM, lane);
                        __builtin_amdgcn_sched_barrier(0);
#pragma unroll
                        for (int q = 0; q < 4; ++q)
#pragma unroll
                            for (int j = 0; j < 4; ++j) s.v[j] += p[q].v[j]; }
#pragma unroll
                    for (int j = 0; j < 4; ++j) x.v[j] += ((const f32x4*)(m + 2048))[lane + 64 * j] * s.v[j];
                    row_store_bf16(X1 + (size_t)R * DM, x, lane);
                }
                if (isctx) np = normp_load(A->in[I_N2G] + l * DM, m + 3072, m + 4096, lane);
                const Row h = row_normmod_p(x, row_rstd(x), np);
                { unsigned* hq = (unsigned*)((unsigned char*)H2 + (size_t)R * DM) + lane;
#pragma unroll
                  for (int j = 0; j < 4; ++j) hq[64 * j] = pk8(h.v[j].x, h.v[j].y, h.v[j].z, h.v[j].w); }
                float lg[16];
#pragma unroll
                for (int e = 0; e < 16; ++e) { f32x2 a2 = (f32x2){0.f, 0.f};
#pragma unroll
                    for (int j = 0; j < 4; ++j) { const f32x4 w = *(const LAS f32x4*)(wrT + e * DM + 4 * lane + 256 * j);
                        a2 = __builtin_elementwise_fma((f32x2){h.v[j].x, h.v[j].y}, (f32x2){w.x, w.y}, a2); a2 = __builtin_elementwise_fma((f32x2){h.v[j].z, h.v[j].w}, (f32x2){w.z, w.w}, a2); }
                    lg[e] = a2.x + a2.y; if ((e & 3) == 3) __builtin_amdgcn_sched_barrier(0); }
                float c8[8], d[4];
#pragma unroll
                for (int i = 0; i < 8; ++i) { auto rr = __builtin_amdgcn_permlane32_swap(__float_as_uint(lg[i]), __float_as_uint(lg[i + 8]), false, false); c8[i] = __uint_as_float(rr[0]) + __uint_as_float(rr[1]); }
#pragma unroll
                for (int i = 0; i < 4; ++i) { auto rr = __builtin_amdgcn_permlane16_swap(__float_as_uint(c8[i]), __float_as_uint(c8[i + 4]), false, false); d[i] = row16_sum(__uint_as_float(rr[0]) + __uint_as_float(rr[1])); }
                float mx = fmaxf(fmaxf(d[0], d[1]), fmaxf(d[2], d[3]));
                { auto rr = __builtin_amdgcn_permlane16_swap(__float_as_uint(mx), __float_as_uint(mx), false, false); mx = fmaxf(__uint_as_float(rr[0]), __uint_as_float(rr[1])); }
                { auto rr = __builtin_amdgcn_permlane32_swap(__float_as_uint(mx), __float_as_uint(mx), false, false); mx = fmaxf(__uint_as_float(rr[0]), __uint_as_float(rr[1])); }
#pragma unroll
                for (int i = 0; i < 4; ++i) d[i] = __expf(d[i] - mx);
                const float sum = xor32_sum(xor16_sum((d[0] + d[1]) + (d[2] + d[3])));
                const int li = lane & 15, ex = 4 * (lane >> 4) + li;
                float mine = li == 0 ? d[0] : li == 1 ? d[1] : li == 2 ? d[2] : d[3];
                mine = mine / sum;
                if (li < 4) { if (isctx) ((float*)(ws + WS_AFFC))[((size_t)b * 16 + ex) * 256 + r] = mine; else ((float*)(ws + WS_AFFL))[((size_t)b * 16 + ex) * 8192 + (r - CTXL)] = mine; }
            }
            SEAM(P + 4);
        }
        if (IN(P + 5)) { LAYER_PTRS
            const int tid = opaque_tid(), lane = tid & 63; (void)tid; (void)lane;
            const int nun = l == 0 ? 64 : 32;
            for (int u = vcu; u < nun; u += G) topk_unit(A, RT, u >= 32, (u >> 4) & 1, u & 15, L, tid);
            SEAM(P + 5);
        }
        if (IN(P + 6)) { LAYER_PTRS
            const int tid = opaque_tid(), lane = tid & 63; (void)tid; (void)lane;
            const int* IDXROW = (const int*)(ws + WS_IDXROW); unsigned char* XG = ws + WS_XG;
            const int nyr = 16 * RT * 256;
            for (int y0 = gw; y0 < nyr; y0 += 9 * NGW) { int src[9]; v4u a[9];
#pragma unroll
                for (int q = 0; q < 9; ++q) { const int y = y0 + q * NGW; src[q] = y < nyr ? IDXROW[y] : -1; }
                __builtin_amdgcn_sched_barrier(0);
#pragma unroll
                for (int q = 0; q < 9; ++q) { a[q] = (v4u){0u, 0u, 0u, 0u}; if (src[q] >= 0) a[q] = ((const v4u*)((const unsigned char*)H2 + (size_t)src[q] * DM))[lane]; }
                __builtin_amdgcn_sched_barrier(0);
#pragma unroll
                for (int q = 0; q < 9; ++q) { const int y = y0 + q * NGW; if (y < nyr) ((v4u*)(XG + (size_t)y * DM))[lane] = a[q]; } }
            SEAM(P + 6);
        }
        if (IN(P + 7)) { LAYER_PTRS
            SchedP6 S{(const char*)(ws + WS_XG), (const char*)(wl + WO_WGU), RT, G, bx}; EpiSwiGLU E{ws + WS_HID};
            pg8::gemm8_phase<EpiSwiGLU, SchedP6>(L, DM / 2, DM / 2, DM / 2, S, E);
            SEAM(P + 7);
        }
        if (IN(P + 8)) { LAYER_PTRS
            SchedP7 S{(const char*)(ws + WS_HID), (const char*)(wl + WO_WD), RT, G, bx}; EpiDown E{(bf16_t*)(ws + WS_Y), (const float*)(ws + WS_SCORE)};
            pg8::gemm8_phase<EpiDown, SchedP7>(L, EH / 2, EH / 2, EH / 2, S, E);
            if (l == 0) { SchedP7c S2{(const char*)(ws + WS_HID), (const char*)(wl + WO_WD), G, bx}; EpiDownPart E2{(bf16_t*)(ws + WS_XG), (const float*)(ws + WS_SCORE)};
              pg8::gemm8_phase<EpiDownPart, SchedP7c>(L, 256, EH / 2, EH / 2, S2, E2); }
            SEAM(P + 8);
        }
        if (IN(P + 9)) { LAYER_PTRS
            const int tid = opaque_tid(), lane = tid & 63; (void)tid; (void)lane;
            const int* INV = (const int*)(ws + WS_INV); const bf16_t* Y = (const bf16_t*)(ws + WS_Y);
#define P8_INV(R_) (lane < 16 ? INV[((size_t)((R_) / RB) * 16 + lane) * RB + (R_) % RB] : -1)
#define P8_YISSUE(INVV, W, KEEP, REST) do { unsigned mk_ = (unsigned)(__ballot((INVV) >= 0) & 0xffffull); \
                _Pragma("unroll") for (int k = 0; k < 4; ++k) { const bool have = mk_ != 0u; const int e = have ? __builtin_ctz(mk_) : 0; mk_ &= mk_ - 1u; \
                    const int yr = have ? __builtin_amdgcn_readlane((INVV), e) : 0; const v2u* yp = (const v2u*)(Y + (size_t)yr * DM) + lane; KEEP[k] = have ? 0xffffffffu : 0u;     \
                    _Pragma("unroll") for (int j = 0; j < 4; ++j) W[k][j] = yp[64 * j]; } REST = mk_; } while (0)
            Row xn; int invn, invf; v2u wn[4][4]; unsigned kn[4], restn;
#define P8_ROW(k) ((k) < 8 ? (((gw * 8 + (k)) >> 13) * RB + CTXL + ((gw * 8 + (k)) & 8191)) : ((gw >> 8) * RB + (gw & 255)))
            const int nit = 8 + ((l == 0 && gw < 512) ? 1 : 0);
            { const int R0 = P8_ROW(0); xn = row_load_bf16(X1 + (size_t)R0 * DM, lane); invn = P8_INV(R0); P8_YISSUE(invn, wn, kn, restn); const int R1 = P8_ROW(1); invf = P8_INV(R1); }
            int curm; NormP np; f32x4 g2v[4];
#define P8_PARAMS(mr_) do { const float* m_ = MODL + (size_t)(mr_) * 6144; \
                _Pragma("unroll") for (int j = 0; j < 4; ++j) g2v[j] = ((const f32x4*)(m_ + 5120))[lane + 64 * j]; \
                if (l + 1 < DEPTH) { const float* m1 = MOD + ((size_t)(l + 1) * 3 + (mr_)) * 6144; np = normp_load(A->in[I_N1G] + (l + 1) * DM, m1, m1 + 1024, lane); } \
                else { _Pragma("unroll") for (int j = 0; j < 4; ++j) { np.a[j] = ((const f32x4*)A->in[I_FG])[lane + 64 * j]; np.h[j] = np.a[j]; } } \
                __builtin_amdgcn_sched_barrier(0); } while (0)
            { curm = (gw * 8) >> 13; P8_PARAMS(curm); }
            for (int k9 = 0; k9 < nit; ++k9) { const int R = P8_ROW(k9); const int b = R / RB, r = R % RB; const bool isctx = r < CTXL;
                Row x = xn; const int myinv = invn; v2u w0[4][4]; unsigned k0[4]; unsigned msk = restn;
#pragma unroll
                for (int k = 0; k < 4; ++k) { k0[k] = kn[k];
#pragma unroll
                    for (int j = 0; j < 4; ++j) w0[k][j] = wn[k][j]; }
                if (k9 + 1 < nit) { const int Rn = P8_ROW(k9 + 1); xn = row_load_bf16(X1 + (size_t)Rn * DM, lane); invn = invf; P8_YISSUE(invn, wn, kn, restn); const int Rf = P8_ROW(min(k9 + 2, nit - 1)); invf = P8_INV(Rf); }
                if (l == 1 && isctx) continue;
                const float* m = MODL + (size_t)(isctx ? 2 : b) * 6144;
                Row s;
#pragma unroll
                for (int j = 0; j < 4; ++j) s.v[j] = (f32x4){0.f, 0.f, 0.f, 0.f};
#pragma unroll
                for (int k = 0; k < 4; ++k)
#pragma unroll
                    for (int j = 0; j < 4; ++j) s.v[j] += (f32x4){bflo(w0[k][j].x & k0[k]), bfhi(w0[k][j].x & k0[k]), bflo(w0[k][j].y & k0[k]), bfhi(w0[k][j].y & k0[k])};
                if (isctx) {
#pragma unroll
                    for (int j = 0; j < 4; ++j) s.v[j] = (f32x4){0.f, 0.f, 0.f, 0.f};
                    msk = 0u; unsigned mk = (unsigned)(__ballot(myinv >= 0) & 0xffffull); const bf16_t* YP = (const bf16_t*)(ws + WS_XG);
                    while (mk) { const int e = __builtin_ctz(mk); mk &= mk - 1u; const int yr = __builtin_amdgcn_readlane(myinv, e); const int ex = yr / 2304, rr = yr % 2304 - 2048;
                        v2u t[4][4];
#pragma unroll
                        for (int kq = 0; kq < 4; ++kq) { const v2u* yp = (const v2u*)(YP + ((size_t)(kq * 16 + ex) * 256 + rr) * DM) + lane;
#pragma unroll
                            for (int j = 0; j < 4; ++j) t[kq][j] = yp[64 * j]; }
                        __builtin_amdgcn_sched_barrier(0);
#pragma unroll
                        for (int kq = 0; kq < 4; ++kq)
#pragma unroll
                            for (int j = 0; j < 4; ++j) s.v[j] += (f32x4){bflo(t[kq][j].x), bfhi(t[kq][j].x), bflo(t[kq][j].y), bfhi(t[kq][j].y)}; } }
                while (msk) {
                    v2u w[4][4];
#pragma unroll
                    for (int k = 0; k < 4; ++k) { const bool have = msk != 0u; const int e = have ? __builtin_ctz(msk) : 0; msk &= msk - 1u; if (!have) msk = 0u;
                        const int yr = have ? __builtin_amdgcn_readlane(myinv, e) : 0;
                        const v2u* yp = (const v2u*)(Y + (size_t)yr * DM) + lane; const unsigned keep = have ? 0xffffffffu : 0u;
#pragma unroll
                        for (int j = 0; j < 4; ++j) { v2u t = yp[64 * j]; t.x &= keep; t.y &= keep; w[k][j] = t; } }
#pragma unroll
                    for (int k = 0; k < 4; ++k)
#pragma unroll
                        for (int j = 0; j < 4; ++j) s.v[j] += (f32x4){bflo(w[k][j].x), bfhi(w[k][j].x), bflo(w[k][j].y), bfhi(w[k][j].y)};
                }
                { const int mr = isctx ? 2 : b; if (mr != curm) { curm = mr; P8_PARAMS(mr); } }
#pragma unroll
                for (int j = 0; j < 4; ++j) x.v[j] += g2v[j] * s.v[j];
                const float rstd = row_rstd(x);
                if (l + 1 < DEPTH) { row_store_bf16(XR + (size_t)R * DM, x, lane);
                    const Row y = row_normmod_p(x, rstd, np); row_store_bf16(HN + (size_t)R * DM, y, lane); if (!isctx) row_store_fp8(ws + WS_HN8 + (size_t)R * DM, y, lane); }
                else { Row y;
#pragma unroll
                    for (int j = 0; j < 4; ++j) y.v[j] = x.v[j] * rstd * np.a[j];
                    row_store(A->out + ((size_t)b * SEQ + (r - CTXL)) * DM, y, lane); }
            }
            SEAM(P + 9);
        }
    }
#undef IN
#undef SEAM
}

extern "C" void kernel_launch(void* const* d_in, const int* in_sizes, int n_in, void* d_out, int out_size, void* d_ws, size_t ws_size, hipStream_t stream) {
    static int grid = 0;
    if (grid == 0) {
        if (n_in != 28 || out_size != NB * SEQ * DM || ws_size < WS_END) { fprintf(stderr, "kernel_launch: unexpected shapes (n_in %d, out %d, ws %zu < %zu)\n", n_in, out_size, ws_size, (size_t)WS_END); grid = -1; return; }
        int dev = 0, cus = 0, per_cu = 0;
        if (hipGetDevice(&dev) != hipSuccess || hipDeviceGetAttribute(&cus, hipDeviceAttributeMultiprocessorCount, dev) != hipSuccess) { grid = -1; return; }
        if (hipFuncSetAttribute((const void*)fwd_kernel, hipFuncAttributeMaxDynamicSharedMemorySize, LDS_BYTES) != hipSuccess) { fprintf(stderr, "kernel_launch: hipFuncSetAttribute failed\n"); grid = -1; return; }
        if (hipOccupancyMaxActiveBlocksPerMultiprocessor(&per_cu, (const void*)fwd_kernel, 512, LDS_BYTES) != hipSuccess || per_cu < 1) fprintf(stderr, "kernel_launch: occupancy query reports %d blocks/CU\n", per_cu);
        (void)hipGetLastError();
        if (cus != 256) { fprintf(stderr, "kernel_launch: built for 256 CUs, device has %d\n", cus); grid = -1; return; }
        grid = 256;
    }
    if (grid < 0) return;
    (void)hipMemsetAsync((char*)d_ws + WS_CTL, 0, CTL_ZERO_BYTES, stream);
    Args a{};
    for (int i = 0; i < 28; ++i) a.in[i] = (const float*)d_in[i];
    a.out = (float*)d_out; a.ws = (unsigned char*)d_ws;
#if MK_PER_PHASE
    for (int p = 0; p < NPHASE; ++p) { a.ph_lo = p; a.ph_hi = p + 1; hipLaunchKernelGGL(fwd_kernel, dim3(grid), dim3(512), LDS_BYTES, stream, a); }
#elif defined(PROBE_REPEAT)
    { const int reps[] = {PROBE_REPEAT}; const int nr = sizeof(reps) / sizeof(int); int lo = 0;
      for (int i = 0; i <= nr; ++i) { a.ph_lo = lo; a.ph_hi = i < nr ? reps[i] + 1 : NPHASE; a.li = i; hipLaunchKernelGGL(fwd_kernel, dim3(grid), dim3(512), LDS_BYTES, stream, a); if (i < nr) lo = reps[i]; } }
#else
    a.ph_lo = 0; a.ph_hi = NPHASE; hipLaunchKernelGGL(fwd_kernel, dim3(grid), dim3(512), LDS_BYTES, stream, a);
#endif
}
```

```cpp
#include <hip/hip_runtime.h>
#include <hip/hip_bf16.h>
#include <cstdio>
#include <cstdint>
#include <cmath>

#ifndef MK_PER_PHASE
#define MK_PER_PHASE 0
#endif

constexpr int DM = 1024, NB = 2, SEQ = 8192, CTXL = 256, RB = SEQ + CTXL, NR = NB * RB, DEPTH = 2;
constexpr int IN_W = 6656, NEXP = 16, EH = 2048, TPB = RB / 256  ;
constexpr float EPS = 1e-6f, LOG2E = 1.4426950408889634f;
constexpr float C2A = 0.125f * LOG2E;
constexpr float C2B = 0.17677669529663687f * LOG2E;
constexpr int NPHASE = 2 + 10 * DEPTH;

constexpr size_t MiB = 1u << 20, KiB128 = 131072;
constexpr size_t WS_CTL = 0, CTL_ZERO_BYTES = 1 * MiB;
constexpr size_t WS_MOD = 1 * MiB;
constexpr size_t WS_AFFL = 2 * MiB, WS_AFFC = 3 * MiB;
constexpr size_t WS_IDXROW = 4 * MiB, WS_SCORE = 4 * MiB + 512 * 1024, WS_INV = 5 * MiB;
constexpr size_t WS_GPC = 8 * MiB;
constexpr size_t WS_W0 = 24 * MiB, W_LAYER = 215 * MiB;
constexpr size_t WO_WING = 8 * MiB  , WO_WIN = 0  , WO_WB = 13 * MiB, WO_WO4 = 15 * MiB, WO_WGU = 23 * MiB, WO_WD = 151 * MiB;
constexpr size_t WS_HN = 454 * MiB;
constexpr size_t WS_QKV = 487 * MiB;
constexpr int PQ = 3136;
constexpr int C_QA = 0, C_KA = 256, C_VA = 512, C_QB = 768, C_KB = 1280, C_VB = 1792, C_QD = 2048, C_KD = 2304, C_VD = 2432, C_GU = 2560, C_GV = 2816;
constexpr size_t WS_Y = WS_QKV;
constexpr size_t WS_GT = 589 * MiB;
constexpr size_t WS_YS = 721 * MiB;
constexpr size_t WS_HID = WS_GT;
constexpr size_t WS_X1 = 754 * MiB, WS_XR = 820 * MiB, WS_H2 = 886 * MiB, WS_XG = 919 * MiB, WS_MRG = WS_H2, WS_PART = WS_XG  , WS_HN8 = 991 * MiB  , WS_END = 1008 * MiB;
static_assert(WS_QKV + (size_t)NR * PQ * 2 <= WS_GT && WS_Y + (size_t)16 * 9 * 256 * 1024 * 2 <= WS_GT && WS_HID + (size_t)16 * 9 * 256 * 2048 * 2 <= WS_X1 && WS_YS + (size_t)NR * 1024 * 2 <= WS_X1, "ws map");

constexpr int CW_BAR = 4096;

constexpr int RING_BYTES = 131072, LDSCTL_OFF = RING_BYTES, MISC_OFF = LDSCTL_OFF + 320, LDS_BYTES = 147456;

#define GAS __attribute__((address_space(1)))
#define LAS __attribute__((address_space(3)))
typedef unsigned short bf16_t;
typedef unsigned v4u __attribute__((ext_vector_type(4)));
typedef unsigned v2u __attribute__((ext_vector_type(2)));
typedef float f32x4 __attribute__((ext_vector_type(4)));
typedef float f32x2 __attribute__((ext_vector_type(2)));
typedef float f32x16 __attribute__((ext_vector_type(16)));
typedef short bf16x8 __attribute__((ext_vector_type(8)));
typedef short s16x4 __attribute__((ext_vector_type(4)));
typedef __bf16 bf16x2_t __attribute__((ext_vector_type(2)));
#define RLX_AGENT __ATOMIC_RELAXED, __HIP_MEMORY_SCOPE_AGENT
#define LDS_WAIT() asm volatile("s_waitcnt lgkmcnt(0)" ::: "memory")
#define VM_WAIT() asm volatile("s_waitcnt vmcnt(0)" ::: "memory")

__device__ __forceinline__ int opaque_tid() { int t = threadIdx.x; asm volatile("" : "+v"(t)); return t; }
__device__ __forceinline__ int opaque_s(int v) { asm volatile("" : "+s"(v)); return v; }
__device__ __forceinline__ unsigned char* opaque_ptr(unsigned char* p) { asm volatile("" : "+s"(p)); return p; }
__device__ __forceinline__ unsigned cvtpk(float lo, float hi) { f32x2 v = {lo, hi}; bf16x2_t b = __builtin_convertvector(v, bf16x2_t); return __builtin_bit_cast(unsigned, b); }
__device__ __forceinline__ float bflo(unsigned w) { return __uint_as_float(w << 16); }
__device__ __forceinline__ float bfhi(unsigned w) { return __uint_as_float(w & 0xffff0000u); }
__device__ __forceinline__ float bf2f(bf16_t h) { return __uint_as_float((unsigned)h << 16); }
__device__ __forceinline__ bf16_t f2bf(float f) { return (bf16_t)(cvtpk(f, 0.f) & 0xffffu); }
__device__ __forceinline__ float sigmoidf_(float x) { return __builtin_amdgcn_rcpf(1.0f + __builtin_amdgcn_exp2f(-x * LOG2E)); }
__device__ __forceinline__ float siluf_(float x) { return x * sigmoidf_(x); }
__device__ __forceinline__ float gelu_tanh(float x) { const float z = 0.7978845608028654f * (x + 0.044715f * x * x * x); return x * __builtin_amdgcn_rcpf(1.0f + __builtin_amdgcn_exp2f(-2.0f * LOG2E * z)); }
template <int CTRL> __device__ __forceinline__ float dpp_f(float v) { return __builtin_bit_cast(float, __builtin_amdgcn_update_dpp(0, __builtin_bit_cast(int, v), CTRL, 0xf, 0xf, true)); }
__device__ __forceinline__ float row16_sum(float v) { v += dpp_f<0xB1>(v); v += dpp_f<0x4E>(v); v += dpp_f<0x141>(v); v += dpp_f<0x140>(v); return v; }
__device__ __forceinline__ float xor16_sum(float v) { auto rr = __builtin_amdgcn_permlane16_swap(__float_as_uint(v), __float_as_uint(v), false, false); return __uint_as_float(rr[0]) + __uint_as_float(rr[1]); }
__device__ __forceinline__ float xor32_sum(float v) { auto rr = __builtin_amdgcn_permlane32_swap(__float_as_uint(v), __float_as_uint(v), false, false); return __uint_as_float(rr[0]) + __uint_as_float(rr[1]); }
__device__ __forceinline__ float half32_sum(float v) { return xor16_sum(row16_sum(v)); }
__device__ __forceinline__ float wave_sum(float v) { return xor32_sum(xor16_sum(row16_sum(v))); }
__device__ __forceinline__ unsigned pk8(float a, float b, float c, float d) { unsigned w = 0u; w = __builtin_amdgcn_cvt_pk_fp8_f32(a, b, w, false); w = __builtin_amdgcn_cvt_pk_fp8_f32(c, d, w, true); return w; }
__device__ __forceinline__ void st8(bf16_t* p, const float* v) { v4u w; w.x = cvtpk(v[0], v[1]); w.y = cvtpk(v[2], v[3]); w.z = cvtpk(v[4], v[5]); w.w = cvtpk(v[6], v[7]); *(v4u*)p = w; }

__device__ const float INV16R[16] = {0.15915494309189535f, 0.08949940160889101f, 0.050329212104487035f, 0.0283021958306234f, 0.015915494309189534f, 0.008949940160889102f, 0.005032921210448704f, 0.00283021958306234f,
                                     0.0015915494309189536f, 0.0008949940160889102f, 0.0005032921210448703f, 0.00028302195830623395f, 0.00015915494309189535f, 8.949940160889102e-05f, 5.0329212104487035e-05f, 2.8302195830623396e-05f};
__device__ const float INV8R[8] = {0.15915494309189535f, 0.050329212104487035f, 0.015915494309189534f, 0.005032921210448704f, 0.0015915494309189536f, 0.0005032921210448703f, 0.00015915494309189535f, 5.0329212104487035e-05f};
__device__ __forceinline__ void sincos_rev(float rev, float& s, float& c) { const float f = __builtin_amdgcn_fractf(rev); s = __builtin_amdgcn_sinf(f); c = __builtin_amdgcn_cosf(f); }

namespace pg8 {
#define PG8_LAS __attribute__((address_space(3)))
constexpr int BM = 256, BK = 64, HALF = 128, HTB = HALF * BK * 2, STAGE_BYTES = 8 * HTB, NXCD = 8, WGM = 8;
__host__ __device__ __forceinline__ int lds_byte(int r, int c) { const int st = (r >> 4) * 2 + (c >> 5), rr = r & 15, cc = c & 31, ob = rr * 64 + cc * 2; return st * 1024 + (ob ^ (((ob >> 9) & 1) << 5)); }
__host__ __device__ __forceinline__ void stage_rc(int b, int& R, int& C) { const int st = b / 1024, sb = b % 1024, swz = sb ^ (((sb >> 9) & 1) << 5); R = (st >> 1) * 16 + swz / 64; C = (st & 1) * 32 + (swz % 64) / 2; }
__host__ __device__ __forceinline__ int perm32(int rho) { const int n = rho >> 4, i = rho & 15; return 8 * (i >> 2) + 4 * n + (i & 3); }

struct Unit { int pm, pn; const char* a; const char* b; };
__device__ __forceinline__ const char* uptr(const char* p) { const unsigned long long v = (unsigned long long)p; const unsigned lo = __builtin_amdgcn_readfirstlane((unsigned)v), hi = __builtin_amdgcn_readfirstlane((unsigned)(v >> 32)); return (const char*)(((unsigned long long)hi << 32) | lo); }
__device__ __forceinline__ void uunit(Unit& u) { u.pm = __builtin_amdgcn_readfirstlane(u.pm); u.pn = __builtin_amdgcn_readfirstlane(u.pn); u.a = uptr(u.a); u.b = uptr(u.b); }

typedef int v8i __attribute__((ext_vector_type(8)));
__device__ __forceinline__ void glds16s(const char* sbase, unsigned voff, unsigned lds_dst) { unsigned keep;
    asm volatile("s_mov_b32 %0, m0\n\ts_mov_b32 m0, %3\n\ts_nop 0\n\tglobal_load_lds_dwordx4 %1, %2\n\ts_mov_b32 m0, %0" : "=&s"(keep) : "v"(voff), "s"(sbase), "s"(lds_dst) : "memory"); }
__device__ __forceinline__ void rect_order(int L, int nM, int nN, int& im, int& in) {
    const int nwg = nM * nN; int wgid = L; { const int q = nwg / NXCD, r = nwg % NXCD, xcd = wgid % NXCD, off = wgid / NXCD; wgid = (xcd < r ? xcd * (q + 1) : r * (q + 1) + (xcd - r) * q) + off; }
    const int nig = WGM * nN, gid = wgid / nig, fm = gid * WGM, gsz = (nM - fm) < WGM ? (nM - fm) : WGM;
    im = fm + ((wgid % nig) % gsz); in = (wgid % nig) / gsz;
}

template <class Epi, class Sched>
__device__ __forceinline__ void gemm_phase(PG8_LAS unsigned char* lds, const int K, const int lda, const int ldb, const Sched& S, const Epi& E) {
    const int tid = opaque_tid(), wid = __builtin_amdgcn_readfirstlane(tid >> 6), lane = tid & 63, wr = wid >> 2, wc = wid & 3, fr = lane & 15, fq = lane >> 4;
    const int nt = K / BK;
    unsigned voffA[2], voffB[2];
#pragma unroll
    for (int i = 0; i < 2; ++i) { int R, C; stage_rc(tid * 16 + i * 8192, R, C); const int Rb = Epi::PERM ? ((R & ~31) + perm32(R & 31)) : R;
        voffA[i] = (unsigned)(R * lda + C) * 2u; voffB[i] = (unsigned)(Rb * ldb + C) * 2u; }
    const size_t kstep = (size_t)(BK * 2);
    const size_t hA = (size_t)HALF * lda * 2, hB = (size_t)HALF * ldb * 2;
    const unsigned ldsw = (unsigned)wid * 1024u, ldsbase = (unsigned)(size_t)lds;
    const int aoff = lds_byte(wr * 64 + fr, fq * 8), boff = lds_byte(wc * 32 + fr, fq * 8);
#define PG8_SA(b, h) (((b) * 2 + (h)) * HTB)
#define PG8_SB(b, h) ((4 + (b) * 2 + (h)) * HTB)
#define PG8_STAGE(bufoff, gbase, voff) do { _Pragma("unroll") for (int _i = 0; _i < 2; ++_i) \
        glds16s(uptr((const char*)(gbase)), (voff)[_i], (unsigned)__builtin_amdgcn_readfirstlane(ldsbase + (unsigned)(bufoff) + ldsw + _i * 8192u)); } while (0)
#define PG8_LDA(dst, b, h) do { _Pragma("unroll") for (int m = 0; m < 4; ++m) _Pragma("unroll") for (int k = 0; k < 2; ++k) dst[m][k] = *(const PG8_LAS bf16x8*)(lds + PG8_SA(b, h) + aoff + m * 2048 + k * 1024); } while (0)
#define PG8_LDB(dst, b, h) do { _Pragma("unroll") for (int n = 0; n < 2; ++n) _Pragma("unroll") for (int k = 0; k < 2; ++k) dst[n][k] = *(const PG8_LAS bf16x8*)(lds + PG8_SB(b, h) + boff + n * 2048 + k * 1024); } while (0)
#define PG8_MMA(ai, bj, At, Bt) do { __builtin_amdgcn_s_setprio(1); _Pragma("unroll") for (int m = 0; m < 4; ++m) _Pragma("unroll") for (int n = 0; n < 2; ++n) _Pragma("unroll") for (int k = 0; k < 2; ++k) \
        acc[ai][bj][m][n] = __builtin_amdgcn_mfma_f32_16x16x32_bf16(Bt[n][k], At[m][k], acc[ai][bj][m][n], 0, 0, 0); __builtin_amdgcn_s_setprio(0); } while (0)
#define PG8_WAIT_V(n) asm volatile("s_waitcnt vmcnt(" #n ")" ::: "memory")
#define PG8_WAIT_L(n) asm volatile("s_waitcnt lgkmcnt(" #n ")" ::: "memory")
#define PG8_BAR __builtin_amdgcn_s_barrier()
#define PG8_SCHED __builtin_amdgcn_sched_barrier(0)
    Unit cur, nxt; int ui = 0;
    if (!S.next(0, cur)) return;
    uunit(cur);
    f32x4 acc[2][2][4][2];
#pragma unroll
    for (int a = 0; a < 2; ++a)
#pragma unroll
        for (int b = 0; b < 2; ++b)
#pragma unroll
            for (int m = 0; m < 4; ++m)
#pragma unroll
                for (int n = 0; n < 2; ++n) acc[a][b][m][n] = (f32x4){0.f, 0.f, 0.f, 0.f};
    bf16x8 At[4][2], B0[2][2], B1[2][2];
    const char* cA = cur.a; const char* cB = cur.b;
    PG8_STAGE(PG8_SB(0, 0), cB, voffB); PG8_STAGE(PG8_SB(0, 1), cB + hB, voffB); PG8_STAGE(PG8_SA(0, 0), cA, voffA); PG8_STAGE(PG8_SA(0, 1), cA + hA, voffA);
    if (wr == 1) PG8_BAR;
    PG8_WAIT_V(2); PG8_BAR;
    PG8_STAGE(PG8_SB(1, 0), cB + kstep, voffB); PG8_STAGE(PG8_SA(1, 0), cA + kstep, voffA); PG8_STAGE(PG8_SB(1, 1), cB + hB + kstep, voffB);
    PG8_WAIT_V(6); PG8_BAR;
    for (;;) {
        const bool has_next = S.next(ui + 1, nxt); if (has_next) uunit(nxt);
        const char* nA = has_next ? nxt.a : cA; const char* nB = has_next ? nxt.b : cB;
        for (int t = 0; t < nt; t += 2) {
            const bool last = (t == nt - 2);
            const char* a1 = cA + (size_t)(t + 1) * kstep;
            const char* a2 = last ? nA : cA + (size_t)(t + 2) * kstep; const char* b2 = last ? nB : cB + (size_t)(t + 2) * kstep;
            const char* a3 = a2 + kstep; const char* b3 = b2 + kstep;
            PG8_LDB(B0, 0, 0); PG8_LDB(B1, 0, 1); PG8_SCHED; PG8_LDA(At, 0, 0); PG8_STAGE(PG8_SA(1, 1), a1 + hA, voffA);
            PG8_WAIT_V(8); PG8_WAIT_L(0); PG8_BAR; PG8_MMA(0, 0, At, B0); PG8_MMA(0, 1, At, B1); PG8_BAR; PG8_SCHED;
            PG8_LDA(At, 0, 1); PG8_STAGE(PG8_SB(0, 0), b2, voffB); PG8_STAGE(PG8_SB(0, 1), b2 + hB, voffB); PG8_STAGE(PG8_SA(0, 0), a2, voffA);
            PG8_WAIT_V(8); PG8_WAIT_L(0); PG8_BAR; PG8_MMA(1, 0, At, B0); PG8_MMA(1, 1, At, B1); PG8_BAR; PG8_SCHED;
            PG8_LDB(B0, 1, 0); PG8_LDB(B1, 1, 1); PG8_SCHED; PG8_LDA(At, 1, 0); PG8_STAGE(PG8_SA(0, 1), a2 + hA, voffA);
            PG8_WAIT_V(8); PG8_WAIT_L(0); PG8_BAR; PG8_MMA(0, 0, At, B0); PG8_MMA(0, 1, At, B1); PG8_BAR; PG8_SCHED;
            PG8_LDA(At, 1, 1); PG8_STAGE(PG8_SB(1, 0), b3, voffB); PG8_STAGE(PG8_SB(1, 1), b3 + hB, voffB); PG8_STAGE(PG8_SA(1, 0), a3, voffA);
            PG8_WAIT_V(8); PG8_WAIT_L(0); PG8_BAR; PG8_MMA(1, 0, At, B0); PG8_MMA(1, 1, At, B1); PG8_BAR; PG8_SCHED;
        }
        if (wr == 0) PG8_BAR;
        { const int t2 = opaque_tid(), l2 = t2 & 63; E(acc, cur, wr, wc, l2 & 15, l2 >> 4); }
        if (!has_next) break;
        if (!Epi::keep_acc(cur)) {
#pragma unroll
        for (int a = 0; a < 2; ++a)
#pragma unroll
            for (int b = 0; b < 2; ++b)
#pragma unroll
                for (int m = 0; m < 4; ++m)
#pragma unroll
                    for (int n = 0; n < 2; ++n) acc[a][b][m][n] = (f32x4){0.f, 0.f, 0.f, 0.f};
        }
        cur = nxt; cA = nA; cB = nB; ++ui;
        if (wr == 1) PG8_BAR;
    }
    PG8_WAIT_V(0);
    PG8_BAR;
#undef PG8_SA
#undef PG8_SB
#undef PG8_STAGE
#undef PG8_LDA
#undef PG8_LDB
#undef PG8_MMA
#undef PG8_WAIT_V
#undef PG8_WAIT_L
#undef PG8_BAR
#undef PG8_SCHED
}
template <class Epi, class Sched>
__device__ __forceinline__ void gemm8_phase(PG8_LAS unsigned char* lds, const int K, const int lda, const int ldb, const Sched& S, const Epi& E) {
    const int tid = opaque_tid(), wid = __builtin_amdgcn_readfirstlane(tid >> 6), lane = tid & 63, wr = wid >> 2, wc = wid & 3, fr = lane & 15, fq = lane >> 4;
    const int nt = opaque_s(K / BK);
    unsigned voffA[2], voffB[2];
#pragma unroll
    for (int i = 0; i < 2; ++i) { int R, C; stage_rc(tid * 16 + i * 8192, R, C); const int Rb = Epi::PERM ? ((R & ~31) + perm32(R & 31)) : R;
        voffA[i] = (unsigned)(R * lda + C) * 2u; voffB[i] = (unsigned)(Rb * ldb + C) * 2u; }
    const size_t kstep = (size_t)(BK * 2);
    const size_t hA = (size_t)HALF * lda * 2, hB = (size_t)HALF * ldb * 2;
    const unsigned ldsw = (unsigned)wid * 1024u, ldsbase = (unsigned)(size_t)lds;
    const int fcol = (fq >> 1) * 32 + (fq & 1) * 16;
    const int aoff = lds_byte(wr * 64 + fr, fcol), boff = lds_byte(wc * 32 + fr, fcol);
#define PG8_SA(b, h) (((b) * 2 + (h)) * HTB)
#define PG8_SB(b, h) ((4 + (b) * 2 + (h)) * HTB)
#define PG8_STAGE(bufoff, gbase, voff) do { _Pragma("unroll") for (int _i = 0; _i < 2; ++_i) \
        glds16s(uptr((const char*)(gbase)), (voff)[_i], (unsigned)__builtin_amdgcn_readfirstlane(ldsbase + (unsigned)(bufoff) + ldsw + _i * 8192u)); } while (0)
#define PG8_LDA(dst, b, h) do { _Pragma("unroll") for (int m = 0; m < 4; ++m) { const v4u lo_ = *(const PG8_LAS v4u*)(lds + PG8_SA(b, h) + aoff + m * 2048), hi_ = *(const PG8_LAS v4u*)(lds + PG8_SA(b, h) + aoff + m * 2048 + 16); dst[m] = (v8i){(int)lo_.x, (int)lo_.y, (int)lo_.z, (int)lo_.w, (int)hi_.x, (int)hi_.y, (int)hi_.z, (int)hi_.w}; } } while (0)
#define PG8_LDB(dst, b, h) do { _Pragma("unroll") for (int n = 0; n < 2; ++n) { const v4u lo_ = *(const PG8_LAS v4u*)(lds + PG8_SB(b, h) + boff + n * 2048), hi_ = *(const PG8_LAS v4u*)(lds + PG8_SB(b, h) + boff + n * 2048 + 16); dst[n] = (v8i){(int)lo_.x, (int)lo_.y, (int)lo_.z, (int)lo_.w, (int)hi_.x, (int)hi_.y, (int)hi_.z, (int)hi_.w}; } } while (0)
#define PG8_MMA(ai, bj, At, Bt) do { __builtin_amdgcn_s_setprio(1); _Pragma("unroll") for (int m = 0; m < 4; ++m) _Pragma("unroll") for (int n = 0; n < 2; ++n) \
        acc[ai][bj][m][n] = __builtin_amdgcn_mfma_scale_f32_16x16x128_f8f6f4(Bt[n], At[m], acc[ai][bj][m][n], 0, 0, 0, 0, 0, 0);     __builtin_amdgcn_s_setprio(0); } while (0)
#define PG8_WAIT_V(n) asm volatile("s_waitcnt vmcnt(" #n ")" ::: "memory")
#define PG8_WAIT_L(n) asm volatile("s_waitcnt lgkmcnt(" #n ")" ::: "memory")
#define PG8_BAR __builtin_amdgcn_s_barrier()
#define PG8_SCHED __builtin_amdgcn_sched_barrier(0)
    Unit cur, nxt; int ui = 0;
    if (!S.next(0, cur)) return;
    uunit(cur);
    f32x4 acc[2][2][4][2];
#pragma unroll
    for (int a = 0; a < 2; ++a)
#pragma unroll
        for (int b = 0; b < 2; ++b)
#pragma unroll
            for (int m = 0; m < 4; ++m)
#pragma unroll
                for (int n = 0; n < 2; ++n) acc[a][b][m][n] = (f32x4){0.f, 0.f, 0.f, 0.f};
    v8i At[4], B0[2], B1[2];
    const char* cA = cur.a; const char* cB = cur.b;
    PG8_STAGE(PG8_SB(0, 0), cB, voffB); PG8_STAGE(PG8_SB(0, 1), cB + hB, voffB); PG8_STAGE(PG8_SA(0, 0), cA, voffA); PG8_STAGE(PG8_SA(0, 1), cA + hA, voffA);
    if (wr == 1) PG8_BAR;
    PG8_WAIT_V(2); PG8_BAR;
    PG8_STAGE(PG8_SB(1, 0), cB + kstep, voffB); PG8_STAGE(PG8_SA(1, 0), cA + kstep, voffA); PG8_STAGE(PG8_SB(1, 1), cB + hB + kstep, voffB);
    PG8_WAIT_V(6); PG8_BAR;
    for (;;) {
        const bool has_next = S.next(ui + 1, nxt); if (has_next) uunit(nxt);
        const char* nA = has_next ? nxt.a : cA; const char* nB = has_next ? nxt.b : cB;
#pragma nounroll
        for (int t = 0; t < nt; t += 2) {
            const bool last = (t == nt - 2);
            const char* a1 = cA + (size_t)(t + 1) * kstep;
            const char* a2 = last ? nA : cA + (size_t)(t + 2) * kstep; const char* b2 = last ? nB : cB + (size_t)(t + 2) * kstep;
            const char* a3 = a2 + kstep; const char* b3 = b2 + kstep;
            PG8_LDB(B0, 0, 0); PG8_LDB(B1, 0, 1); PG8_SCHED; PG8_LDA(At, 0, 0); PG8_STAGE(PG8_SA(1, 1), a1 + hA, voffA);
            PG8_WAIT_V(8); PG8_WAIT_L(0); PG8_BAR; PG8_MMA(0, 0, At, B0); PG8_MMA(0, 1, At, B1); PG8_BAR; PG8_SCHED;
            PG8_LDA(At, 0, 1); PG8_STAGE(PG8_SB(0, 0), b2, voffB); PG8_STAGE(PG8_SB(0, 1), b2 + hB, voffB); PG8_STAGE(PG8_SA(0, 0), a2, voffA);
            PG8_WAIT_V(8); PG8_WAIT_L(0); PG8_BAR; PG8_MMA(1, 0, At, B0); PG8_MMA(1, 1, At, B1); PG8_BAR; PG8_SCHED;
            PG8_LDB(B0, 1, 0); PG8_LDB(B1, 1, 1); PG8_SCHED; PG8_LDA(At, 1, 0); PG8_STAGE(PG8_SA(0, 1), a2 + hA, voffA);
            PG8_WAIT_V(8); PG8_WAIT_L(0); PG8_BAR; PG8_MMA(0, 0, At, B0); PG8_MMA(0, 1, At, B1); PG8_BAR; PG8_SCHED;
            PG8_LDA(At, 1, 1); PG8_STAGE(PG8_SB(1, 0), b3, voffB); PG8_STAGE(PG8_SB(1, 1), b3 + hB, voffB); PG8_STAGE(PG8_SA(1, 0), a3, voffA);
            PG8_WAIT_V(8); PG8_WAIT_L(0); PG8_BAR; PG8_MMA(1, 0, At, B0); PG8_MMA(1, 1, At, B1); PG8_BAR; PG8_SCHED;
        }
        if (wr == 0) PG8_BAR;
        { const int t2 = opaque_tid(), l2 = t2 & 63; E(acc, cur, wr, wc, l2 & 15, l2 >> 4); }
        if (!has_next) break;
#pragma unroll
        for (int a = 0; a < 2; ++a)
#pragma unroll
            for (int b = 0; b < 2; ++b)
#pragma unroll
                for (int m = 0; m < 4; ++m)
#pragma unroll
                    for (int n = 0; n < 2; ++n) acc[a][b][m][n] = (f32x4){0.f, 0.f, 0.f, 0.f};
        cur = nxt; cA = nA; cB = nB; ++ui;
        if (wr == 1) PG8_BAR;
    }
    PG8_WAIT_V(0);
    PG8_BAR;
#undef PG8_SA
#undef PG8_SB
#undef PG8_STAGE
#undef PG8_LDA
#undef PG8_LDB
#undef PG8_MMA
#undef PG8_WAIT_V
#undef PG8_WAIT_L
#undef PG8_BAR
#undef PG8_SCHED
}
}

constexpr float W8S = 32.0f, W8I = 1.0f / 32.0f;
struct ModPtrs { const float* mod; };

struct EpiInProj {
    static constexpr bool PERM = true;
    static __device__ __forceinline__ bool keep_acc(const pg8::Unit&) { return false; }
    bf16_t *QKV, *GT;
    const float *q_gain, *k_gain, *gate_b;
    __device__ __forceinline__ void operator()(const f32x4 (&acc)[2][2][4][2], const pg8::Unit& u, int wr, int wc, int fr, int fq) const {
        const int pn = u.pn, pm = u.pm, jt = pm % TPB; const bool isctx = (jt == 0); const int t0 = (jt - 1) * 256;
        const int cb = 64 * wc + 8 * fq;
        const int rit0 = 64 * wr + fr;
        bf16_t* qrow = QKV + ((size_t)pm * 256 + rit0) * PQ;
#define ROWLOOP _Pragma("unroll") for (int ai = 0; ai < 2; ++ai) _Pragma("unroll") for (int m = 0; m < 4; ++m)
#define ROWVARS const int rit = 128 * ai + 16 * m + rit0; bf16_t* orow = qrow + (size_t)(128 * ai + 16 * m) * PQ; \
        float v[2][8]; _Pragma("unroll") for (int bj = 0; bj < 2; ++bj) _Pragma("unroll") for (int n = 0; n < 2; ++n) _Pragma("unroll") for (int j = 0; j < 4; ++j) v[bj][4 * n + j] = acc[ai][bj][m][n][j];
#define ROWEND __builtin_amdgcn_sched_barrier(0);
        if (pn == 0 || pn == 21 || pn == 22 || pn == 24) {
            const int oc = (pn == 0 ? C_QA : pn == 21 ? C_KA : pn == 22 ? C_VA : C_VB) + cb; const float sc = pn == 0 ? C2A : 1.0f;
            ROWLOOP { ROWVARS
#pragma unroll
                for (int bj = 0; bj < 2; ++bj) {
#pragma unroll
                    for (int j = 0; j < 8; ++j) v[bj][j] *= sc;
                    st8(orow + oc + 32 * bj, v[bj]); }
                ROWEND }
        } else if (pn == 3 || pn == 4) {
            const int oc = (pn == 3 ? C_GU : C_GV) + cb;
            ROWLOOP { ROWVARS
#pragma unroll
                for (int bj = 0; bj < 2; ++bj) {
#pragma unroll
                    for (int j = 0; j < 8; ++j) v[bj][j] = gelu_tanh(v[bj][j]);
                    st8(orow + oc + 32 * bj, v[bj]); }
                ROWEND }
        } else if (pn == 1 || pn == 23) {
            const int oc = (pn == 1 ? C_QB : C_KB) + 128 * wc + 8 * fq; const float sc = pn == 1 ? C2B : 1.0f;
            const f32x4 inv = *(const f32x4*)(INV8R + 4 * (fq & 1));
            const float zz[8] = {0.f, 0.f, 0.f, 0.f, 0.f, 0.f, 0.f, 0.f};
            ROWLOOP { ROWVARS
                const int t = t0 + rit; const float pos = (float)((fq < 2) ? (t >> 6) : (t & 63));
                float sn[4], cs[4];
#pragma unroll
                for (int p = 0; p < 4; ++p) { if (isctx) { sn[p] = 0.f; cs[p] = 1.f; } else sincos_rev(pos * inv[p], sn[p], cs[p]); }
#pragma unroll
                for (int bj = 0; bj < 2; ++bj) {
                    float o[8];
#pragma unroll
                    for (int p = 0; p < 4; ++p) { const float x0 = v[bj][2 * p], x1 = v[bj][2 * p + 1]; o[2 * p] = (x0 * cs[p] - x1 * sn[p]) * sc; o[2 * p + 1] = (x0 * sn[p] + x1 * cs[p]) * sc; }
                    st8(orow + oc + 64 * bj, o); st8(orow + oc + 64 * bj + 32, zz); }
                ROWEND }
        } else {
            if (pn == 25 && wc >= 2) {
                const int oc = C_VD + (wc - 2) * 64 + 8 * fq;
                ROWLOOP { ROWVARS
#pragma unroll
                    for (int bj = 0; bj < 2; ++bj) st8(orow + oc + 32 * bj, v[bj]);
                    (void)rit; ROWEND }
            } else {
                const int oc = (pn == 2 ? C_QD : C_KD) + cb; const float sc = pn == 2 ? C2A : 1.0f; const float* gain = pn == 2 ? q_gain : k_gain;
                const f32x4 inv = *(const f32x4*)(INV16R + 4 * fq);
                f32x4 gn[2][2];
#pragma unroll
                for (int bj = 0; bj < 2; ++bj)
#pragma unroll
                    for (int n = 0; n < 2; ++n) gn[bj][n] = *(const f32x4*)(gain + 32 * bj + 8 * fq + 4 * n);
                ROWLOOP { ROWVARS
                    float ss = 0.f;
#pragma unroll
                    for (int bj = 0; bj < 2; ++bj)
#pragma unroll
                        for (int j = 0; j < 8; ++j) ss += v[bj][j] * v[bj][j];
                    ss = xor32_sum(xor16_sum(ss));
                    const float rstd = __builtin_amdgcn_rsqf(ss * (1.0f / 64.0f) + EPS);
                    const int t = t0 + rit;
#pragma unroll
                    for (int bj = 0; bj < 2; ++bj) {
                        const float pos = (float)(bj == 0 ? (t >> 6) : (t & 63));
                        float o[8];
#pragma unroll
                        for (int p = 0; p < 4; ++p) {
                            float sn, cs; if (isctx) { sn = 0.f; cs = 1.f; } else sincos_rev(pos * inv[p], sn, cs);
                            const float x0 = v[bj][2 * p] * rstd * gn[bj][(2 * p) >> 2][(2 * p) & 3], x1 = v[bj][2 * p + 1] * rstd * gn[bj][(2 * p + 1) >> 2][(2 * p + 1) & 3];
                            o[2 * p] = (x0 * cs - x1 * sn) * sc; o[2 * p + 1] = (x0 * sn + x1 * cs) * sc; }
                        st8(orow + oc + 32 * bj, o); }
                    ROWEND }
            }
        }
#undef ROWLOOP
#undef ROWVARS
#undef ROWEND
    }
};

__device__ __forceinline__ unsigned pk_u8x4(float a, float b, float c, float d) { unsigned w = 0u;
    w = __builtin_amdgcn_cvt_pk_u8_f32(__builtin_rintf(a * 255.0f), 0u, w); w = __builtin_amdgcn_cvt_pk_u8_f32(__builtin_rintf(b * 255.0f), 1u, w);
    w = __builtin_amdgcn_cvt_pk_u8_f32(__builtin_rintf(c * 255.0f), 2u, w); w = __builtin_amdgcn_cvt_pk_u8_f32(__builtin_rintf(d * 255.0f), 3u, w); return w; }
__device__ __forceinline__ float u8f(unsigned w, int i) { return (float)((w >> (8 * i)) & 0xffu); }
struct EpiGates {
    static constexpr bool PERM = true;
    unsigned char* GT; const float* gate_b;
    __device__ __forceinline__ void operator()(const f32x4 (&acc)[2][2][4][2], const pg8::Unit& u, int wr, int wc, int fr, int fq) const {
        const int col0 = u.pn * 256 + wc * 32 + 8 * fq;
        f32x4 gb[2][2];
#pragma unroll
        for (int bj = 0; bj < 2; ++bj)
#pragma unroll
            for (int n = 0; n < 2; ++n) gb[bj][n] = *(const f32x4*)(gate_b + col0 + bj * 128 + 4 * n) * (-LOG2E);
#pragma unroll
        for (int ai = 0; ai < 2; ++ai)
#pragma unroll
            for (int m = 0; m < 4; ++m) { unsigned char* rowp = GT + ((size_t)u.pm * 256 + ai * 128 + wr * 64 + m * 16 + fr) * 4096 + col0;
#pragma unroll
                for (int bj = 0; bj < 2; ++bj) { unsigned o[8];
#pragma unroll
                    for (int n = 0; n < 2; ++n)
#pragma unroll
                        for (int j = 0; j < 4; j += 2) { const f32x2 a2 = (f32x2){acc[ai][bj][m][n][j], acc[ai][bj][m][n][j + 1]}, c2 = (f32x2){gb[bj][n][j], gb[bj][n][j + 1]};
                            const f32x2 t2 = __builtin_elementwise_fma(a2, (f32x2){-W8I * LOG2E, -W8I * LOG2E}, c2);
                            const f32x2 e2 = (f32x2){__builtin_amdgcn_exp2f(t2.x), __builtin_amdgcn_exp2f(t2.y)};
                            const f32x2 d2 = __builtin_elementwise_fma(e2, (f32x2){1.0f / 255.0f, 1.0f / 255.0f}, (f32x2){1.0f / 255.0f, 1.0f / 255.0f});
                            const f32x2 v2 = (f32x2){__builtin_amdgcn_rcpf(d2.x), __builtin_amdgcn_rcpf(d2.y)} + (f32x2){8388608.0f, 8388608.0f};
                            o[4 * n + j] = __float_as_uint(v2.x); o[4 * n + j + 1] = __float_as_uint(v2.y); }
                    v2u w; w.x = __builtin_amdgcn_perm(o[1], o[0], 0x0c0c0400u) | __builtin_amdgcn_perm(o[3], o[2], 0x04000c0cu); w.y = __builtin_amdgcn_perm(o[5], o[4], 0x0c0c0400u) | __builtin_amdgcn_perm(o[7], o[6], 0x04000c0cu);
                    *(v2u*)(rowp + bj * 128) = w; } }
    }
};
struct EpiGateAcc {
    static constexpr bool PERM = true;
    const unsigned char* GT; bf16_t* MRG; bf16_t* GPC;
    static __device__ __forceinline__ bool keep_acc(const pg8::Unit& u) { return (u.pn & 3) != 3 && (u.pm % TPB) != 0; }
    __device__ __forceinline__ void operator()(f32x4 (&acc)[2][2][4][2], const pg8::Unit& u, int wr, int wc, int fr, int fq) const {
        const int dt = u.pn >> 2, n = u.pn & 3; const int col0 = dt * 256 + wc * 32 + 8 * fq;
        const bool isctx = (u.pm % TPB) == 0;
        const size_t row0 = (size_t)u.pm * 256 + wr * 64 + fr;
        const unsigned char* gp0 = GT + row0 * 4096 + n * 1024 + col0;
        constexpr float GMIN = 8.673617379884035e-19f;
#define GA_OFF(grp) ((size_t)(((grp) >> 3) * 128 + (((grp) >> 1) & 3) * 16))
        if (!isctx && n < 3) {
            v2u ga[16], gb[16];
#pragma unroll
            for (int grp = 0; grp < 16; ++grp) { const int bj = grp & 1; ga[grp] = *(const v2u*)(gp0 + GA_OFF(grp) * 4096 + bj * 128); gb[grp] = *(const v2u*)(gp0 + 1024 + GA_OFF(grp) * 4096 + bj * 128); }
            __builtin_amdgcn_sched_barrier(0);
#pragma unroll
            for (int grp = 0; grp < 16; ++grp) { const int ai = grp >> 3, m = (grp >> 1) & 3, bj = grp & 1; const v2u g0 = ga[grp], g1 = gb[grp];
                float r[8];
#define GA_R(i, A, B) r[i] = fmaxf(A, GMIN) * __builtin_amdgcn_rcpf(fmaxf(B, GMIN))
                GA_R(0, u8f(g0.x, 0), u8f(g1.x, 0)); GA_R(1, u8f(g0.x, 1), u8f(g1.x, 1)); GA_R(2, u8f(g0.x, 2), u8f(g1.x, 2)); GA_R(3, u8f(g0.x, 3), u8f(g1.x, 3));
                GA_R(4, u8f(g0.y, 0), u8f(g1.y, 0)); GA_R(5, u8f(g0.y, 1), u8f(g1.y, 1)); GA_R(6, u8f(g0.y, 2), u8f(g1.y, 2)); GA_R(7, u8f(g0.y, 3), u8f(g1.y, 3));
#undef GA_R
#pragma unroll
                for (int j = 0; j < 4; ++j) { acc[ai][bj][m][0][j] *= r[j]; acc[ai][bj][m][1][j] *= r[4 + j]; } }
            __builtin_amdgcn_sched_barrier(0);
        } else {
            bf16_t* mp0 = isctx ? GPC + ((size_t)n * 512 + (u.pm / TPB) * 256 + wr * 64 + fr) * 1024 + col0 : MRG + row0 * 1024 + col0;
            const float lo = isctx ? 0.f : GMIN; constexpr float I255 = 1.0f / 255.0f;
            v2u ga[16];
#pragma unroll
            for (int grp = 0; grp < 16; ++grp) { const int bj = grp & 1; ga[grp] = *(const v2u*)(gp0 + GA_OFF(grp) * 4096 + bj * 128); }
            __builtin_amdgcn_sched_barrier(0);
#pragma unroll
            for (int grp = 0; grp < 16; ++grp) { const int ai = grp >> 3, m = (grp >> 1) & 3, bj = grp & 1; const v2u g = ga[grp]; const f32x4 a0 = acc[ai][bj][m][0], a1 = acc[ai][bj][m][1];
                v4u w; w.x = cvtpk(a0[0] * (fmaxf(u8f(g.x, 0), lo) * I255), a0[1] * (fmaxf(u8f(g.x, 1), lo) * I255)); w.y = cvtpk(a0[2] * (fmaxf(u8f(g.x, 2), lo) * I255), a0[3] * (fmaxf(u8f(g.x, 3), lo) * I255));
                w.z = cvtpk(a1[0] * (fmaxf(u8f(g.y, 0), lo) * I255), a1[1] * (fmaxf(u8f(g.y, 1), lo) * I255)); w.w = cvtpk(a1[2] * (fmaxf(u8f(g.y, 2), lo) * I255), a1[3] * (fmaxf(u8f(g.y, 3), lo) * I255));
                *(v4u*)(mp0 + GA_OFF(grp) * 1024 + bj * 128) = w; }
            __builtin_amdgcn_sched_barrier(0);
        }
#undef GA_OFF
    }
};

struct EpiOutRes {
    static constexpr bool PERM = true;
    static __device__ __forceinline__ bool keep_acc(const pg8::Unit&) { return false; }
    const float* x_in; const float* ctx_in; const bf16_t* XR; bf16_t* X1; const float* mod_l; int layer;
    __device__ __forceinline__ void operator()(const f32x4 (&acc)[2][2][4][2], const pg8::Unit& u, int wr, int wc, int fr, int fq) const {
        const int pm = u.pm, b = pm / TPB, jt = pm % TPB; const bool isctx = jt == 0;
        const float* g1 = mod_l + (isctx ? 2 : b) * 6144 + 2048;
        const int col0 = u.pn * 256 + wc * 32 + 8 * fq;
        f32x4 gv[2][2];
#pragma unroll
        for (int bj = 0; bj < 2; ++bj)
#pragma unroll
            for (int n = 0; n < 2; ++n) gv[bj][n] = *(const f32x4*)(g1 + col0 + bj * 128 + n * 4);
        bf16_t* ob = X1 + ((size_t)pm * 256 + wr * 64 + fr) * DM + col0;
        if (layer == 0) {
            const float* base = (isctx ? ctx_in + (size_t)b * CTXL * DM : x_in + ((size_t)b * SEQ + (size_t)(jt - 1) * 256) * DM) + (size_t)(wr * 64 + fr) * DM + col0;
#pragma unroll
            for (int ai = 0; ai < 2; ++ai) { f32x4 rs[4][2][2];
#pragma unroll
                for (int m = 0; m < 4; ++m)
#pragma unroll
                    for (int bj = 0; bj < 2; ++bj)
#pragma unroll
                        for (int n = 0; n < 2; ++n) rs[m][bj][n] = *(const f32x4*)(base + (size_t)(ai * 128 + m * 16) * DM + bj * 128 + n * 4);
                __builtin_amdgcn_sched_barrier(0);
#pragma unroll
                for (int m = 0; m < 4; ++m)
#pragma unroll
                    for (int bj = 0; bj < 2; ++bj) { const f32x4 o0 = rs[m][bj][0] + gv[bj][0] * acc[ai][bj][m][0], o1 = rs[m][bj][1] + gv[bj][1] * acc[ai][bj][m][1];
                        v4u w; w.x = cvtpk(o0[0], o0[1]); w.y = cvtpk(o0[2], o0[3]); w.z = cvtpk(o1[0], o1[1]); w.w = cvtpk(o1[2], o1[3]);
                        *(v4u*)(ob + (size_t)(ai * 128 + m * 16) * DM + bj * 128) = w; }
                __builtin_amdgcn_sched_barrier(0); }
        } else {
            const bf16_t* base = XR + ((size_t)pm * 256 + wr * 64 + fr) * DM + col0;
#pragma unroll
            for (int ai = 0; ai < 2; ++ai) { v4u rb[4][2];
#pragma unroll
                for (int m = 0; m < 4; ++m)
#pragma unroll
                    for (int bj = 0; bj < 2; ++bj) rb[m][bj] = *(const v4u*)(base + (size_t)(ai * 128 + m * 16) * DM + bj * 128);
                __builtin_amdgcn_sched_barrier(0);
#pragma unroll
                for (int m = 0; m < 4; ++m)
#pragma unroll
                    for (int bj = 0; bj < 2; ++bj) { const v4u r = rb[m][bj];
                        const f32x4 r0 = (f32x4){bflo(r.x), bfhi(r.x), bflo(r.y), bfhi(r.y)}, r1 = (f32x4){bflo(r.z), bfhi(r.z), bflo(r.w), bfhi(r.w)};
                        const f32x4 o0 = r0 + gv[bj][0] * acc[ai][bj][m][0], o1 = r1 + gv[bj][1] * acc[ai][bj][m][1];
                        v4u w; w.x = cvtpk(o0[0], o0[1]); w.y = cvtpk(o0[2], o0[3]); w.z = cvtpk(o1[0], o1[1]); w.w = cvtpk(o1[2], o1[3]);
                        *(v4u*)(ob + (size_t)(ai * 128 + m * 16) * DM + bj * 128) = w; }
                __builtin_amdgcn_sched_barrier(0); }
        }
    }
};
struct EpiPart {
    static constexpr bool PERM = false;
    static __device__ __forceinline__ bool keep_acc(const pg8::Unit&) { return false; }
    float* PART;
    __device__ __forceinline__ void operator()(const f32x4 (&acc)[2][2][4][2], const pg8::Unit& u, int wr, int wc, int fr, int fq) const {
        const int ks = u.pn >> 2, ct = u.pn & 3; const int col0 = ct * 256 + wc * 32 + 4 * fq;
#pragma unroll
        for (int ai = 0; ai < 2; ++ai)
#pragma unroll
            for (int m = 0; m < 4; ++m) { float* op = PART + ((size_t)ks * 512 + u.pm * 256 + ai * 128 + wr * 64 + m * 16 + fr) * DM + col0;
#pragma unroll
                for (int bj = 0; bj < 2; ++bj)
#pragma unroll
                    for (int n = 0; n < 2; ++n) *(f32x4*)(op + bj * 128 + n * 16) = acc[ai][bj][m][n]; }
    }
};
struct EpiSwiGLU {
    static constexpr bool PERM = true;
    unsigned char* HID;
    __device__ __forceinline__ void operator()(const f32x4 (&acc)[2][2][4][2], const pg8::Unit& u, int wr, int wc, int fr, int fq) const {
        const int f0 = u.pn * 128 + wc * 32 + 8 * fq;
#pragma unroll
        for (int ai = 0; ai < 2; ++ai)
#pragma unroll
            for (int m = 0; m < 4; ++m) { float o[8];
#pragma unroll
                for (int n = 0; n < 2; ++n)
#pragma unroll
                    for (int j = 0; j < 4; j += 2) { const f32x2 g2 = (f32x2){acc[ai][0][m][n][j], acc[ai][0][m][n][j + 1]}, u2 = (f32x2){acc[ai][1][m][n][j], acc[ai][1][m][n][j + 1]};
                        const f32x2 t2 = g2 * (f32x2){-W8I * LOG2E, -W8I * LOG2E};
                        const f32x2 e2 = (f32x2){__builtin_amdgcn_exp2f(t2.x), __builtin_amdgcn_exp2f(t2.y)};
                        const f32x2 d2 = __builtin_elementwise_fma(e2, (f32x2){1024.0f, 1024.0f}, (f32x2){1024.0f, 1024.0f});
                        const f32x2 r2 = (f32x2){__builtin_amdgcn_rcpf(d2.x), __builtin_amdgcn_rcpf(d2.y)};
                        const f32x2 o2 = (g2 * u2) * r2; o[4 * n + j] = o2.x; o[4 * n + j + 1] = o2.y; }
                v2u w; w.x = pk8(o[0], o[1], o[2], o[3]); w.y = pk8(o[4], o[5], o[6], o[7]);
                *(v2u*)(HID + ((size_t)u.pm * 256 + ai * 128 + wr * 64 + m * 16 + fr) * EH + f0) = w; }
    }
};
struct EpiDown {
    static constexpr bool PERM = true;
    bf16_t* Y; const float* SCORE;
    __device__ __forceinline__ void operator()(const f32x4 (&acc)[2][2][4][2], const pg8::Unit& u, int wr, int wc, int fr, int fq) const {
        const int col0 = u.pn * 256 + wc * 32 + 8 * fq;
        float sc8[2][4];
#pragma unroll
        for (int ai = 0; ai < 2; ++ai)
#pragma unroll
            for (int m = 0; m < 4; ++m) sc8[ai][m] = SCORE[(size_t)u.pm * 256 + ai * 128 + wr * 64 + m * 16 + fr];
        __builtin_amdgcn_sched_barrier(0);
#pragma unroll
        for (int ai = 0; ai < 2; ++ai)
#pragma unroll
            for (int m = 0; m < 4; ++m) { const size_t row = (size_t)u.pm * 256 + ai * 128 + wr * 64 + m * 16 + fr; const float s = sc8[ai][m] * W8I;
#pragma unroll
                for (int bj = 0; bj < 2; ++bj) { float o[8];
#pragma unroll
                    for (int n = 0; n < 2; ++n)
#pragma unroll
                        for (int j = 0; j < 4; ++j) o[4 * n + j] = acc[ai][bj][m][n][j] * s;
                    st8(Y + row * DM + col0 + bj * 128, o); } }
    }
};
struct EpiDownPart {
    static constexpr bool PERM = true;
    bf16_t* YP; const float* SCORE;
    __device__ __forceinline__ void operator()(const f32x4 (&acc)[2][2][4][2], const pg8::Unit& u, int wr, int wc, int fr, int fq) const {
        if (wr != 0) return;
        const int in = u.pn & 3, kq = u.pn >> 2, e = u.pm / 9; const int col0 = in * 256 + wc * 32 + 8 * fq;
        float sc4[4];
#pragma unroll
        for (int m = 0; m < 4; ++m) sc4[m] = SCORE[(size_t)u.pm * 256 + m * 16 + fr];
        __builtin_amdgcn_sched_barrier(0);
#pragma unroll
        for (int m = 0; m < 4; ++m) { const size_t row = ((size_t)(kq * 16 + e) * 256 + m * 16 + fr); const float sc = sc4[m] * W8I;
#pragma unroll
            for (int bj = 0; bj < 2; ++bj) { float o[8];
#pragma unroll
                for (int n = 0; n < 2; ++n)
#pragma unroll
                    for (int j = 0; j < 4; ++j) o[4 * n + j] = acc[0][bj][m][n][j] * sc;
                st8(YP + row * DM + col0 + bj * 128, o); } }
    }
};

namespace attn_body {
using bf16 = __hip_bfloat16;
using u32x4 = __attribute__((ext_vector_type(4))) unsigned;
constexpr int NW = 8, QBLK = 32, QB = QBLK * NW, KVBLK = 64;
__device__ __forceinline__ int crow(int r, int hi) { return (r & 3) + 8 * (r >> 2) + 4 * hi; }
#define SBAR() __builtin_amdgcn_sched_barrier(0)
constexpr int NSLOT = 3, SLOTB = 8192;
constexpr int LDS_K = 0, LDS_V = NSLOT * SLOTB, LDS_WS = 2 * NSLOT * SLOTB, LDS_OST = LDS_WS + NW * 64 * 4, LDS_OST1 = LDS_OST + NW * 4096, LDS_RPB = LDS_OST1 + NW * 4096, LDS_ATT_BYTES = LDS_RPB + 2048;
static_assert(LDS_ATT_BYTES <= RING_BYTES, "attention LDS");
__device__ __forceinline__ void glds16(const void* gsrc, unsigned lds_dst) { unsigned keep;
  asm volatile("s_mov_b32 %0, m0\n\ts_mov_b32 m0, %2\n\ts_nop 0\n\tglobal_load_lds_dwordx4 %1, off\n\ts_mov_b32 m0, %0" : "=&s"(keep) : "v"(gsrc), "s"(lds_dst) : "memory"); }
__device__ __forceinline__ float max3f(float a, float b, float c) { float r; asm("v_max3_f32 %0, %1, %2, %3" : "=v"(r) : "v"(a), "v"(b), "v"(c)); return r; }
__device__ __forceinline__ float max2f(float a, float b) { float r; asm("v_max_f32_e32 %0, %1, %2" : "=v"(r) : "v"(a), "v"(b)); return r; }
__device__ __forceinline__ float fadd_s(float a, float b) { float r; asm("v_add_f32_e32 %0, %1, %2" : "=v"(r) : "v"(a), "v"(b)); return r; }
__device__ __forceinline__ float fsub_s(float a, float b) { float r; asm("v_sub_f32_e32 %0, %1, %2" : "=v"(r) : "v"(a), "v"(b)); return r; }
__device__ __forceinline__ unsigned cvtpk_s(float lo, float hi) { return cvtpk(lo, hi); }
#define WAIT_BAR(N) asm volatile("s_waitcnt vmcnt(" #N ") lgkmcnt(0)\n\ts_barrier" ::: "memory")

typedef __attribute__((address_space(3))) const char* lds_cptr;
typedef short v4i16_t __attribute__((ext_vector_type(4)));
__device__ __forceinline__ void qkt(f32x16& p0, f32x16& p1, lds_cptr Kslot, const bf16x8* qr, const f32x16& negm, int r32, int hi) {
  lds_cptr kb = Kslot + hi * 1024 + r32 * 16;
  #pragma unroll
  for (int d0 = 0; d0 < 4; ++d0) {
    const bf16x8 b0 = *(const __attribute__((address_space(3))) bf16x8*)(kb + d0 * 2048);
    const bf16x8 b1 = *(const __attribute__((address_space(3))) bf16x8*)(kb + d0 * 2048 + 512);
    if (d0 == 0) { p0 = __builtin_amdgcn_mfma_f32_32x32x16_bf16(b0, qr[0], negm, 0, 0, 0); p1 = __builtin_amdgcn_mfma_f32_32x32x16_bf16(b1, qr[0], negm, 0, 0, 0); }
    else { p0 = __builtin_amdgcn_mfma_f32_32x32x16_bf16(b0, qr[d0], p0, 0, 0, 0); p1 = __builtin_amdgcn_mfma_f32_32x32x16_bf16(b1, qr[d0], p1, 0, 0, 0); } }
}
__device__ __forceinline__ void kload8(bf16x8* kf, lds_cptr kp) {
  kf[0] = *(const __attribute__((address_space(3))) bf16x8*)(kp);        kf[1] = *(const __attribute__((address_space(3))) bf16x8*)(kp + 512);
  kf[2] = *(const __attribute__((address_space(3))) bf16x8*)(kp + 2048); kf[3] = *(const __attribute__((address_space(3))) bf16x8*)(kp + 2560);
  kf[4] = *(const __attribute__((address_space(3))) bf16x8*)(kp + 4096); kf[5] = *(const __attribute__((address_space(3))) bf16x8*)(kp + 4608);
  kf[6] = *(const __attribute__((address_space(3))) bf16x8*)(kp + 6144); kf[7] = *(const __attribute__((address_space(3))) bf16x8*)(kp + 6656);
}
__device__ __forceinline__ void kload2(bf16x8* kf, lds_cptr kp, int j) { kf[2 * j] = *(const __attribute__((address_space(3))) bf16x8*)(kp + j * 2048); kf[2 * j + 1] = *(const __attribute__((address_space(3))) bf16x8*)(kp + j * 2048 + 512); }
__device__ __forceinline__ s16x4 vtr(lds_cptr p) { return __builtin_bit_cast(s16x4, __builtin_amdgcn_ds_read_tr16_b64_v4i16((__attribute__((address_space(3))) v4i16_t*)p)); }
__device__ __forceinline__ float rowmax(const f32x16& p0, const f32x16& p1) {
  float a = max3f(p0[0], p0[1], p1[0]), b = max3f(p0[2], p0[3], p1[1]); a = max3f(a, p1[2], p1[3]);
  #pragma unroll
  for (int r = 4; r < 16; r += 4) { a = max3f(a, p0[r], p0[r + 1]); b = max3f(b, p0[r + 2], p0[r + 3]); a = max3f(a, p1[r], p1[r + 1]); b = max3f(b, p1[r + 2], p1[r + 3]); }
  const float m = max2f(a, b);
  auto rr = __builtin_amdgcn_permlane32_swap(__float_as_uint(m), __float_as_uint(m), false, false);
  return max2f(__uint_as_float(rr[0]), __uint_as_float(rr[1]));
}
__device__ __forceinline__ void pv(f32x16* o, int vb, bf16x8 pa0, bf16x8 pa1, bf16x8 pa2, bf16x8 pa3) {
  #pragma unroll
  for (int d0 = 0; d0 < 2; ++d0) { s16x4 lo[4], hi[4];
    #pragma unroll
    for (int ks = 0; ks < 4; ++ks) {
      asm volatile("ds_read_b64_tr_b16 %0,%1 offset:%c2" : "=&v"(lo[ks]) : "v"(vb), "i"(d0 * 4096 + ks * 1024) : "memory");
      asm volatile("ds_read_b64_tr_b16 %0,%1 offset:%c2" : "=&v"(hi[ks]) : "v"(vb), "i"(d0 * 4096 + ks * 1024 + 512) : "memory"); }
    asm volatile("s_waitcnt lgkmcnt(0)" ::: "memory"); SBAR();
    #define PK(k) (bf16x8){lo[k][0], lo[k][1], lo[k][2], lo[k][3], hi[k][0], hi[k][1], hi[k][2], hi[k][3]}
    o[d0] = __builtin_amdgcn_mfma_f32_32x32x16_bf16(pa0, PK(0), o[d0], 0, 0, 0);
    o[d0] = __builtin_amdgcn_mfma_f32_32x32x16_bf16(pa1, PK(1), o[d0], 0, 0, 0);
    o[d0] = __builtin_amdgcn_mfma_f32_32x32x16_bf16(pa2, PK(2), o[d0], 0, 0, 0);
    o[d0] = __builtin_amdgcn_mfma_f32_32x32x16_bf16(pa3, PK(3), o[d0], 0, 0, 0);
    #undef PK
  }
}

struct DiffEpi { float lam, post; const float* subg; };
template <int THRL, int MODE> __device__ __forceinline__ void attn_unit(const bf16* Qu, const bf16* __restrict__ Kh, const bf16* __restrict__ Vh, int NT, bf16* Ou, char* shm, const DiffEpi de) {
  constexpr int PK = PQ, PV = PQ, PO = 1024;
  constexpr bool DQ32 = (MODE != 0);
  const int tid = opaque_tid(), lane = tid & 63, r32 = lane & 31, hi = lane >> 5; const int wid = __builtin_amdgcn_readfirstlane(tid >> 6);
  const bf16* Qw = Qu + (long)(wid * QBLK) * PQ;
  const unsigned lds0 = (unsigned)(uintptr_t)shm;
  float* wsf = (float*)(shm + LDS_WS) + wid * 64;
  const bf16* ksrc = Kh + (long)lane * PK + wid * 8;
  const bf16* vsrc = Vh + (long)(16 * (wid & 3) + (lane >> 2)) * PV + (wid >> 2) * 32 + (lane & 3) * 8;
  const unsigned kdst = lds0 + LDS_K + wid * 1024, vdst = lds0 + LDS_V + wid * 1024;
  #define DMA_K(t, slot) glds16(ksrc + (long)(t) * KVBLK * PK, (unsigned)__builtin_amdgcn_readfirstlane(kdst + (slot)))
  #define DMA_V(t, slot) glds16(vsrc + (long)(t) * KVBLK * PV, (unsigned)__builtin_amdgcn_readfirstlane(vdst + (slot)))
  const int vb0 = (int)(lds0 + LDS_V) + ((lane >> 4) & 1) * 32 + (lane & 3) * 8 + (4 * hi + ((lane & 15) >> 2)) * 64;
  bf16x8 kf[8];
  const lds_cptr shm3 = (lds_cptr)shm; const lds_cptr kp0 = shm3 + LDS_K + hi * 1024 + r32 * 16; const lds_cptr vp0 = shm3 + LDS_V + ((lane >> 4) & 1) * 32 + (lane & 3) * 8 + (4 * hi + ((lane & 15) >> 2)) * 64;
  DMA_K(0, 0); DMA_V(0, 0); DMA_K(1, SLOTB);
  bf16x8 qr[4];
  #pragma unroll
  for (int d0 = 0; d0 < 4; ++d0) qr[d0] = *reinterpret_cast<const bf16x8*>(&Qw[(long)r32 * PQ + d0 * 16 + hi * 8]);
  float mhat = 0.f, l_reg = 0.f; f32x16 o[2]; o[0] = f32x16{}; o[1] = f32x16{}; f32x16 negm = f32x16{}; asm volatile("" : "+v"(negm));
  bool resc = false;
  #define START(P0, P1) do { const float rm = rowmax(P0, P1); resc = false; \
    { const float dl = rm; mhat = fadd_s(mhat, dl); \
      _Pragma("unroll") for (int r = 0; r < 16; ++r) { P0[r] = fsub_s(P0[r], dl); P1[r] = fsub_s(P1[r], dl); } \
      _Pragma("unroll") for (int r = 0; r < 16; ++r) negm[r] = -mhat; asm volatile("" : "+v"(negm)); } \
    _Pragma("unroll") for (int r = 0; r < 16; ++r) P0[r] = __builtin_amdgcn_exp2f(P0[r]); } while (0)
  #define RESC() do { if (resc) { asm volatile("s_waitcnt lgkmcnt(0)" ::: "memory"); \
      _Pragma("unroll") for (int d_ = 0; d_ < 2; ++d_) _Pragma("unroll") for (int r = 0; r < 16; ++r) o[d_][r] *= wsf[crow(r, hi)]; } } while (0)
  f32x16 pA0, pA1, pB0, pB1;
  int sl_prev = 0, sl_cur = 0, sl_next = SLOTB;
  #define ROT() do { sl_prev = sl_cur; sl_cur = sl_next; sl_next = (sl_next == (NSLOT - 1) * SLOTB) ? 0 : sl_next + SLOTB; } while (0)
  DMA_K(2, 2 * SLOTB);
  WAIT_BAR(3);
  qkt(pA0, pA1, shm3 + LDS_K, qr, negm, r32, hi); asm volatile("s_nop 15\n\ts_nop 7" : "+v"(pA0), "+v"(pA1));
  START(pA0, pA1);
  _Pragma("unroll") for (int r = 0; r < 16; ++r) pA1[r] = __builtin_amdgcn_exp2f(pA1[r]);
  WAIT_BAR(0);
  DMA_K(3, 0); DMA_V(1, SLOTB);
  ROT();
  kload8(kf, kp0 + sl_cur);
  WAIT_BAR(2);
  s16x4 vlo[8], vhi[8]; u32x4 pw0, pw1, pw2, pw3;
  #define PKW(P, B) cvtpk_s(P[B], P[B + 1])
  #define PAF(k) __builtin_bit_cast(bf16x8, pw##k)
  #define VFR(i) (bf16x8){vlo[i][0], vlo[i][1], vlo[i][2], vlo[i][3], vhi[i][0], vhi[i][1], vhi[i][2], vhi[i][3]}
  #define PIN(x) asm volatile("" : "+v"(x))
  #define MX3(a, b, c) __builtin_fmaxf(__builtin_fmaxf((a), (b)), (c))
  #define GAPA(MF, A0, A1, A2, A3, W0, W1, PW) do { MF; sacc += A0; sacc += A1; sacc += A2; sacc += A3; PIN(sacc); W0; W1; PIN(PW); SBAR(); } while (0)
  #define EX(v) __builtin_amdgcn_exp2f(v)
  #define GAPB(MF, X, B) do { MF; X[B] = EX(X[B]); X[B + 1] = EX(X[B + 1]); X[B + 2] = EX(X[B + 2]); X[B + 3] = EX(X[B + 3]); PIN(X); SBAR(); } while (0)
  #define VRD(i) do { vlo[i] = vtr(vp_ + (((i) >> 2) * 4096 + ((i) & 3) * 1024)); vhi[i] = vtr(vp_ + (((i) >> 2) * 4096 + ((i) & 3) * 1024 + 512)); } while (0)
  #define KRD(G, j) do { if (G) { kload2(kf, kp0 + sl_next, j); SBAR(); } } while (0)
  #define STEP(C0, C1, P0, P1, t, GK, GV, GL) do { SBAR(); \
    const lds_cptr vp_ = vp0 + sl_prev; \
    VRD(0); SBAR(); float sacc = (P0[0] + P0[1]); \
    GAPA(C0 = __builtin_amdgcn_mfma_f32_32x32x16_bf16(kf[0], qr[0], negm, 0, 0, 0), P0[2], P0[3], P0[4], P0[5],     pw0[0] = PKW(P0, 0), pw0[1] = PKW(P0, 2), pw0); \
    VRD(4); SBAR(); GAPA(C1 = __builtin_amdgcn_mfma_f32_32x32x16_bf16(kf[1], qr[0], negm, 0, 0, 0), P0[6], P0[7], P0[8], P0[9],     pw0[2] = PKW(P0, 4), pw0[3] = PKW(P0, 6), pw0); \
    VRD(1); SBAR(); GAPA(C0 = __builtin_amdgcn_mfma_f32_32x32x16_bf16(kf[2], qr[1], C0, 0, 0, 0),   P0[10], P0[11], P0[12], P0[13], pw1[0] = PKW(P0, 8), pw1[1] = PKW(P0, 10), pw1); \
    VRD(5); SBAR(); GAPA(C1 = __builtin_amdgcn_mfma_f32_32x32x16_bf16(kf[3], qr[1], C1, 0, 0, 0),   P0[14], P0[15], P1[0], P1[1],   pw1[2] = PKW(P0, 12), pw1[3] = PKW(P0, 14), pw1); \
    VRD(2); SBAR(); GAPA(do { if (!DQ32) { C0 = __builtin_amdgcn_mfma_f32_32x32x16_bf16(kf[4], qr[2], C0, 0, 0, 0); } } while (0),   P1[2], P1[3], P1[4], P1[5],     pw2[0] = PKW(P1, 0), pw2[1] = PKW(P1, 2), pw2); \
    VRD(6); SBAR(); GAPA(do { if (!DQ32) { C1 = __builtin_amdgcn_mfma_f32_32x32x16_bf16(kf[5], qr[2], C1, 0, 0, 0); } } while (0),   P1[6], P1[7], P1[8], P1[9],     pw2[2] = PKW(P1, 4), pw2[3] = PKW(P1, 6), pw2); \
    VRD(3); SBAR(); GAPA(do { if (!DQ32) { C0 = __builtin_amdgcn_mfma_f32_32x32x16_bf16(kf[6], qr[3], C0, 0, 0, 0); } } while (0),   P1[10], P1[11], P1[12], P1[13], pw3[0] = PKW(P1, 8), pw3[1] = PKW(P1, 10), pw3); \
    VRD(7); SBAR(); GAPA(do { if (!DQ32) { C1 = __builtin_amdgcn_mfma_f32_32x32x16_bf16(kf[7], qr[3], C1, 0, 0, 0); } } while (0),   P1[14], P1[15], 0.f, 0.f,       pw3[2] = PKW(P1, 12), pw3[3] = PKW(P1, 14), pw3); \
    l_reg += sacc; \
    if (GK) { DMA_K((t) + 3, sl_cur); } if (GV) { DMA_V((t) + 1, sl_next); } \
    { float a = MX3(C0[0], C0[1], C1[0]), b = MX3(C0[2], C0[3], C1[1]); a = MX3(a, C1[2], C1[3]); \
      _Pragma("unroll") for (int r = 4; r < 16; r += 4) { a = MX3(a, C0[r], C0[r + 1]); b = MX3(b, C0[r + 2], C0[r + 3]); a = MX3(a, C1[r], C1[r + 1]); b = MX3(b, C1[r + 2], C1[r + 3]); } \
      float rm = __builtin_fmaxf(a, b); { auto rr = __builtin_amdgcn_permlane32_swap(__float_as_uint(rm), __float_as_uint(rm), false, false); rm = __builtin_fmaxf(__uint_as_float(rr[0]), __uint_as_float(rr[1])); } \
      resc = false; \
      if (__builtin_expect(__any(rm > (float)THRL), 0)) { const float dl = __builtin_fmaxf(rm, 0.f); mhat += dl; \
        _Pragma("unroll") for (int r = 0; r < 16; ++r) { C0[r] -= dl; C1[r] -= dl; } \
        _Pragma("unroll") for (int r = 0; r < 16; ++r) negm[r] = -mhat; asm volatile("" : "+v"(negm)); \
        const float f = __builtin_amdgcn_exp2f(-dl); l_reg *= f; if (hi == 0) wsf[r32] = f; resc = true; } } \
    SBAR(); \
    GAPB(o[0] = __builtin_amdgcn_mfma_f32_32x32x16_bf16(PAF(0), VFR(0), o[0], 0, 0, 0), C0, 0); \
    GAPB(o[1] = __builtin_amdgcn_mfma_f32_32x32x16_bf16(PAF(0), VFR(4), o[1], 0, 0, 0), C0, 4); \
    KRD(GL, 0); GAPB(o[0] = __builtin_amdgcn_mfma_f32_32x32x16_bf16(PAF(1), VFR(1), o[0], 0, 0, 0), C0, 8); \
    KRD(GL, 1); GAPB(o[1] = __builtin_amdgcn_mfma_f32_32x32x16_bf16(PAF(1), VFR(5), o[1], 0, 0, 0), C0, 12); \
    KRD(GL && !DQ32, 2); GAPB(o[0] = __builtin_amdgcn_mfma_f32_32x32x16_bf16(PAF(2), VFR(2), o[0], 0, 0, 0), C1, 0); \
    KRD(GL && !DQ32, 3); GAPB(o[1] = __builtin_amdgcn_mfma_f32_32x32x16_bf16(PAF(2), VFR(6), o[1], 0, 0, 0), C1, 4); \
    GAPB(o[0] = __builtin_amdgcn_mfma_f32_32x32x16_bf16(PAF(3), VFR(3), o[0], 0, 0, 0), C1, 8); \
    GAPB(o[1] = __builtin_amdgcn_mfma_f32_32x32x16_bf16(PAF(3), VFR(7), o[1], 0, 0, 0), C1, 12); \
    } while (0)
  int t = 1;
  for (; t + 5 < NT; t += 2) {
    STEP(pB0, pB1, pA0, pA1, t, true, true, true);     WAIT_BAR(2); RESC(); ROT();
    STEP(pA0, pA1, pB0, pB1, t + 1, true, true, true); WAIT_BAR(2); RESC(); ROT();
  }
  #define ENDW(tt) do { if ((tt) + 3 < NT) { WAIT_BAR(2); } else if ((tt) + 2 < NT) { WAIT_BAR(1); } else { WAIT_BAR(0); } } while (0)
  for (; t + 1 < NT; t += 2) {
    STEP(pB0, pB1, pA0, pA1, t, (t + 3 < NT), (t + 1 < NT), (t + 1 < NT));       ENDW(t);     RESC(); ROT();
    STEP(pA0, pA1, pB0, pB1, t + 1, (t + 4 < NT), (t + 2 < NT), (t + 2 < NT));   ENDW(t + 1); RESC(); ROT();
  }
  STEP(pB0, pB1, pA0, pA1, NT - 1, false, false, false); RESC();
  { float sacc = pB0[0] + pB0[1]; _Pragma("unroll") for (int r = 2; r < 16; ++r) sacc += pB0[r]; _Pragma("unroll") for (int r = 0; r < 16; ++r) sacc += pB1[r]; l_reg += sacc;
    pw0 = (u32x4){PKW(pB0, 0), PKW(pB0, 2), PKW(pB0, 4), PKW(pB0, 6)}; pw1 = (u32x4){PKW(pB0, 8), PKW(pB0, 10), PKW(pB0, 12), PKW(pB0, 14)}; pw2 = (u32x4){PKW(pB1, 0), PKW(pB1, 2), PKW(pB1, 4), PKW(pB1, 6)}; pw3 = (u32x4){PKW(pB1, 8), PKW(pB1, 10), PKW(pB1, 12), PKW(pB1, 14)};
    SBAR(); pv(o, vb0 + sl_cur, PAF(0), PAF(1), PAF(2), PAF(3)); }
  #undef PKW
  #undef PAF
  #undef VFR
  #undef PIN
  #undef MX3
  #undef GAPA
  #undef GAPB
  #undef EX
  #undef VRD
  #undef KRD
  #undef STEP
  #undef ENDW
  { auto rr = __builtin_amdgcn_permlane32_swap(__float_as_uint(l_reg), __float_as_uint(l_reg), false, false); l_reg = __uint_as_float(rr[0]) + __uint_as_float(rr[1]); }
  if (hi == 0) wsf[32 + r32] = l_reg; asm volatile("s_waitcnt lgkmcnt(0)" ::: "memory");
  float rli[16];
  #pragma unroll
  for (int r = 0; r < 16; ++r) rli[r] = __builtin_amdgcn_rcpf(wsf[32 + crow(r, hi)]);
  bf16_t* stg = (bf16_t*)(shm + LDS_OST) + wid * 2048;
  bf16_t* stg1 = (bf16_t*)(shm + LDS_OST1) + wid * 2048;
  if (MODE == 1) {
    #pragma unroll
    for (int r = 0; r < 16; ++r) { const int orow = crow(r, hi);
      #pragma unroll
      for (int d0 = 0; d0 < 2; ++d0) stg1[orow * 64 + d0 * 32 + r32] = f2bf(o[d0][r] * rli[r]); }
    asm volatile("s_waitcnt lgkmcnt(0)" ::: "memory");
  } else {
    if (MODE == 2) {
      const float g0 = de.subg[r32] * de.post, g1 = de.subg[32 + r32] * de.post;
      #pragma unroll
      for (int r = 0; r < 16; ++r) { const int orow = crow(r, hi);
        const float d0v = bf2f(stg1[orow * 64 + r32]) - de.lam * (o[0][r] * rli[r]), d1v = bf2f(stg1[orow * 64 + 32 + r32]) - de.lam * (o[1][r] * rli[r]);
        float ss = d0v * d0v + d1v * d1v;
        ss = half32_sum(ss);
        const float rstd = __builtin_amdgcn_rsqf(ss * (1.0f / 64.0f) + EPS);
        stg[orow * 64 + r32] = f2bf(d0v * rstd * g0); stg[orow * 64 + 32 + r32] = f2bf(d1v * rstd * g1); }
    } else {
      #pragma unroll
      for (int r = 0; r < 16; ++r) { const int orow = crow(r, hi);
        #pragma unroll
        for (int d0 = 0; d0 < 2; ++d0) stg[orow * 64 + d0 * 32 + r32] = f2bf(o[d0][r] * rli[r]); }
    }
    asm volatile("s_waitcnt lgkmcnt(0)" ::: "memory");
    bf16* Ow = Ou + (long)(wid * QBLK) * PO;
    #pragma unroll
    for (int i = 0; i < 4; ++i) { const int row = i * 8 + (lane >> 3), ch = lane & 7; const u32x4 v = *(const u32x4*)(stg + row * 64 + ch * 8); *(u32x4*)(Ow + (long)row * PO + ch * 8) = v; }
  }
  asm volatile("s_waitcnt lgkmcnt(0)\n\ts_barrier" ::: "memory");
  #undef DMA_K
  #undef DMA_V
  #undef START
  #undef RESC
  #undef ROT
}

__device__ __forceinline__ void na_unit(int b, int h, int g4, const bf16* QKV, bf16* YS, const float* rpb_h, char* shm) {
  const bf16 *QA = QKV + C_QA, *KA = QKV + C_KA, *VA = QKV + C_VA;
  const int tid = opaque_tid(), lane = tid & 63, r32 = lane & 31, hi = lane >> 5; const int wid = __builtin_amdgcn_readfirstlane(tid >> 6);
  const unsigned lds0 = (unsigned)(uintptr_t)shm;
  float* wsf = (float*)(shm + LDS_WS) + wid * 64;
  float* rp = (float*)(shm + LDS_RPB);
  const lds_cptr shm3 = (lds_cptr)shm;
  for (int i = tid; i < 15 * 31; i += 512) rp[i] = rpb_h[i] * LOG2E;
  const int rq = 4 * g4 + (wid >> 1), qc = 32 * (wid & 1) + r32;
  const long rowb = (long)b * RB;
  const bf16* Qw = QA + (rowb + CTXL + rq * 64 + 32 * (wid & 1)) * PQ + h * 64;
  bf16x8 qr[4];
  #pragma unroll
  for (int d0 = 0; d0 < 4; ++d0) qr[d0] = *reinterpret_cast<const bf16x8*>(&Qw[(long)r32 * PQ + d0 * 16 + hi * 8]);
  const int r0 = min(max(rq - 4, 0), 120);
  const int kr_lo = min(max(4 * g4 - 4, 0), 120), kr_hi = min(max(4 * g4 - 1, 0), 120) + 7;
  const int ntiles = 4 + (kr_hi - kr_lo + 1);
  const int c0 = min(max(qc - 8, 0), 48);
  float mrun = -INFINITY, l_reg = 0.f; f32x16 o[2]; o[0] = f32x16{}; o[1] = f32x16{};
  const unsigned kdst = lds0 + LDS_K + wid * 1024, vdst = lds0 + LDS_V + wid * 1024;
  const int vb0 = (int)(lds0 + LDS_V) + ((lane >> 4) & 1) * 32 + (lane & 3) * 8 + (4 * hi + ((lane & 15) >> 2)) * 64;
  #define NA_DMA(TI) do { const int kr_ = kr_lo + (TI) - 4; const long krow_ = ((TI) < 4) ? rowb + 64 * (TI) : rowb + CTXL + (long)kr_ * 64; const unsigned so_ = ((TI) & 1) * SLOTB; \
      glds16(KA + (krow_ + lane) * PQ + h * 64 + wid * 8, (unsigned)__builtin_amdgcn_readfirstlane(kdst + so_)); \
      glds16(VA + (krow_ + 16 * (wid & 3) + (lane >> 2)) * PQ + h * 64 + (wid >> 2) * 32 + (lane & 3) * 8, (unsigned)__builtin_amdgcn_readfirstlane(vdst + so_)); } while (0)
  asm volatile("s_waitcnt lgkmcnt(0)\n\ts_barrier" ::: "memory");
  NA_DMA(0);
  for (int ti = 0; ti < ntiles; ++ti) {
    const int kr = kr_lo + ti - 4;
    asm volatile("s_waitcnt vmcnt(0) lgkmcnt(0)\n\ts_barrier" ::: "memory");
    if (ti + 1 < ntiles) NA_DMA(ti + 1);
    const unsigned so = (ti & 1) * SLOTB;
    const bool valid = (ti < 4) || (kr >= r0 && kr <= r0 + 7);
    if (valid) {
      f32x16 p0, p1; const f32x16 z = f32x16{};
      qkt(p0, p1, shm3 + LDS_K + so, qr, z, r32, hi);
      if (ti >= 4) {
        const int dr = kr - rq + 7;
        #pragma unroll
        for (int r = 0; r < 16; ++r) { const int k0 = crow(r, hi), k1 = k0 + 32;
          const bool v0 = (k0 >= c0) && (k0 < c0 + 16), v1 = (k1 >= c0) && (k1 < c0 + 16);
          const float b0 = v0 ? rp[dr * 31 + (k0 - qc + 15)] : 0.f, b1 = v1 ? rp[dr * 31 + (k1 - qc + 15)] : 0.f;
          p0[r] = v0 ? p0[r] + b0 : -INFINITY; p1[r] = v1 ? p1[r] + b1 : -INFINITY; }
      }
      float rm = p0[0];
      #pragma unroll
      for (int r = 1; r < 16; ++r) rm = fmaxf(rm, p0[r]);
      #pragma unroll
      for (int r = 0; r < 16; ++r) rm = fmaxf(rm, p1[r]);
      { auto rr = __builtin_amdgcn_permlane32_swap(__float_as_uint(rm), __float_as_uint(rm), false, false); rm = fmaxf(__uint_as_float(rr[0]), __uint_as_float(rr[1])); }
      const float mnew = fmaxf(mrun, rm); const float f = __builtin_amdgcn_exp2f(mrun - mnew); mrun = mnew;
      float sacc = 0.f;
      #pragma unroll
      for (int r = 0; r < 16; ++r) { p0[r] = __builtin_amdgcn_exp2f(p0[r] - mnew); p1[r] = __builtin_amdgcn_exp2f(p1[r] - mnew); sacc += p0[r] + p1[r]; }
      l_reg = l_reg * f + sacc;
      if (hi == 0) wsf[r32] = f;
      asm volatile("s_waitcnt lgkmcnt(0)" ::: "memory");
      #pragma unroll
      for (int d_ = 0; d_ < 2; ++d_)
        #pragma unroll
        for (int r = 0; r < 16; ++r) o[d_][r] *= wsf[crow(r, hi)];
      u32x4 pw0, pw1, pw2, pw3;
      pw0 = (u32x4){cvtpk(p0[0], p0[1]), cvtpk(p0[2], p0[3]), cvtpk(p0[4], p0[5]), cvtpk(p0[6], p0[7])}; pw1 = (u32x4){cvtpk(p0[8], p0[9]), cvtpk(p0[10], p0[11]), cvtpk(p0[12], p0[13]), cvtpk(p0[14], p0[15])};
      pw2 = (u32x4){cvtpk(p1[0], p1[1]), cvtpk(p1[2], p1[3]), cvtpk(p1[4], p1[5]), cvtpk(p1[6], p1[7])}; pw3 = (u32x4){cvtpk(p1[8], p1[9]), cvtpk(p1[10], p1[11]), cvtpk(p1[12], p1[13]), cvtpk(p1[14], p1[15])};
      asm volatile("s_waitcnt lgkmcnt(0)" ::: "memory");
      pv(o, vb0 + (int)so, __builtin_bit_cast(bf16x8, pw0), __builtin_bit_cast(bf16x8, pw1), __builtin_bit_cast(bf16x8, pw2), __builtin_bit_cast(bf16x8, pw3));
    }
  }
  #undef NA_DMA
  { auto rr = __builtin_amdgcn_permlane32_swap(__float_as_uint(l_reg), __float_as_uint(l_reg), false, false); l_reg = __uint_as_float(rr[0]) + __uint_as_float(rr[1]); }
  if (hi == 0) wsf[32 + r32] = l_reg; asm volatile("s_waitcnt lgkmcnt(0)" ::: "memory");
  bf16_t* stg = (bf16_t*)(shm + LDS_OST) + wid * 2048;
  #pragma unroll
  for (int r = 0; r < 16; ++r) { const int orow = crow(r, hi); const float rl = __builtin_amdgcn_rcpf(wsf[32 + orow]);
    #pragma unroll
    for (int d0 = 0; d0 < 2; ++d0) stg[orow * 64 + d0 * 32 + r32] = f2bf(o[d0][r] * rl); }
  asm volatile("s_waitcnt lgkmcnt(0)" ::: "memory");
  bf16* Ow = YS + (rowb + CTXL + rq * 64 + 32 * (wid & 1)) * 1024 + h * 64;
  #pragma unroll
  for (int i = 0; i < 4; ++i) { const int row = i * 8 + (lane >> 3), ch = lane & 7; const u32x4 v = *(const u32x4*)(stg + row * 64 + ch * 8); *(u32x4*)(Ow + (long)row * 1024 + ch * 8) = v; }
  asm volatile("s_waitcnt lgkmcnt(0)\n\ts_barrier" ::: "memory");
}
#undef SBAR
#undef WAIT_BAR
}

__device__ __forceinline__ void sgu_unit(long rowbase, const bf16_t* GU, const bf16_t* GV, const float* ng, const float* sw, const float* sb, bf16_t* YS, char* shm) {
    using attn_body::crow;
    const int tid = opaque_tid(), lane = tid & 63, wid = __builtin_amdgcn_readfirstlane(tid >> 6), r32 = lane & 31, hi = lane >> 5;
    const unsigned lds0 = (unsigned)(uintptr_t)shm;
    {
        const f32x4 g4 = *(const f32x4*)(ng + 4 * lane);
        const int gl = lane >> 4, d = 4 * (lane & 15);
#pragma unroll
        for (int rb = 0; rb < 4; ++rb) { v2u raw[4];
#pragma unroll
            for (int q4 = 0; q4 < 4; ++q4) raw[q4] = *(const v2u*)(GV + (rowbase + wid * 16 + rb * 4 + q4) * PQ + 4 * lane);
            __builtin_amdgcn_sched_barrier(0);
#pragma unroll
            for (int q4 = 0; q4 < 4; ++q4) { const int q = wid * 16 + rb * 4 + q4;
                f32x4 v = {bflo(raw[q4].x), bfhi(raw[q4].x), bflo(raw[q4].y), bfhi(raw[q4].y)};
                const float mean = wave_sum((v.x + v.y) + (v.z + v.w)) * (1.0f / 256.0f);
                v = v - mean;
                const float var = wave_sum((v.x * v.x + v.y * v.y) + (v.z * v.z + v.w * v.w)) * (1.0f / 256.0f);
                const float rstd = __builtin_amdgcn_rsqf(var + EPS);
                v = v * rstd * g4;
                v2u w; w.x = cvtpk(v.x, v.y); w.y = cvtpk(v.z, v.w);
                const int k = q & 63;
                *(v2u*)(shm + (2 * gl + (q >> 6)) * 8192 + ((d >> 5) * 4 + (k >> 4)) * 1024 + (k & 15) * 64 + (d & 31) * 2) = w; }
            __builtin_amdgcn_sched_barrier(0); }
    }
    __syncthreads();
    const int g = wid & 3, ph = wid >> 2;
    const int vb0 = (int)lds0 + ((lane >> 4) & 1) * 32 + (lane & 3) * 8 + (4 * hi + ((lane & 15) >> 2)) * 64;
    bf16_t* stg = (bf16_t*)(shm + 65536) + wid * 2048;
#pragma unroll
    for (int mt = 0; mt < 2; ++mt) {
        const int p0 = ph * 64 + mt * 32;
        const float* wrow = sw + ((size_t)g * 128 + p0 + r32) * 128 + 4 * hi;
        f32x16 o[2]; o[0] = f32x16{}; o[1] = f32x16{};
#pragma unroll
        for (int sl = 0; sl < 2; ++sl) {
            f32x4 wa[4], wc[4];
#pragma unroll
            for (int s4 = 0; s4 < 4; ++s4) { wa[s4] = *(const f32x4*)(wrow + 64 * sl + 16 * s4); wc[s4] = *(const f32x4*)(wrow + 64 * sl + 16 * s4 + 8); }
            __builtin_amdgcn_sched_barrier(0);
            bf16x8 pa[4];
#pragma unroll
            for (int s4 = 0; s4 < 4; ++s4) { const v4u w = {cvtpk(wa[s4].x, wa[s4].y), cvtpk(wa[s4].z, wa[s4].w), cvtpk(wc[s4].x, wc[s4].y), cvtpk(wc[s4].z, wc[s4].w)}; pa[s4] = __builtin_bit_cast(bf16x8, w); }
            attn_body::pv(o, vb0 + (2 * g + sl) * 8192, pa[0], pa[1], pa[2], pa[3]);
        }
        float bias[16];
#pragma unroll
        for (int r = 0; r < 16; ++r) bias[r] = sb[g * 128 + p0 + crow(r, hi)];
        v4u uu[4];
#pragma unroll
        for (int i = 0; i < 4; ++i) uu[i] = *(const v4u*)(GU + (rowbase + p0 + i * 8 + (lane >> 3)) * PQ + g * 64 + (lane & 7) * 8);
        __builtin_amdgcn_sched_barrier(0);
#pragma unroll
        for (int r = 0; r < 16; ++r) { const int orow = crow(r, hi);
#pragma unroll
            for (int d0 = 0; d0 < 2; ++d0) stg[orow * 64 + d0 * 32 + r32] = f2bf(o[d0][r] + bias[r]); }
        asm volatile("s_waitcnt lgkmcnt(0)" ::: "memory");
#pragma unroll
        for (int i = 0; i < 4; ++i) { const int row = i * 8 + (lane >> 3), ch = lane & 7; const v4u mv = *(const v4u*)(stg + row * 64 + ch * 8); const v4u u4 = uu[i];
            v4u w; w.x = cvtpk(bflo(u4.x) * bflo(mv.x), bfhi(u4.x) * bfhi(mv.x)); w.y = cvtpk(bflo(u4.y) * bflo(mv.y), bfhi(u4.y) * bfhi(mv.y));
            w.z = cvtpk(bflo(u4.z) * bflo(mv.z), bfhi(u4.z) * bfhi(mv.z)); w.w = cvtpk(bflo(u4.w) * bflo(mv.w), bfhi(u4.w) * bfhi(mv.w));
            *(v4u*)(YS + (rowbase + p0 + row) * 1024 + 512 + g * 64 + ch * 8) = w; }
        asm volatile("s_waitcnt lgkmcnt(0)" ::: "memory");
    }
    __syncthreads();
}

typedef GAS unsigned gu32;
#define XB_TMO      128
#define XB_XCNT(j)  (256  + 64 * (j))
#define XB_XSUB(j)  (1280 + 64 * (j))
#define XB_XGEN(j)  (2304 + 64 * (j))
#define XB_TOP      3328
#define XB_TOPGEN   3392
#define XCD_BAR_WORDS 3456
#define XB_SPIN_CAP (1u << 18)
__device__ __forceinline__ unsigned xb_ld(unsigned* p)              { return __hip_atomic_load(p, __ATOMIC_RELAXED, __HIP_MEMORY_SCOPE_AGENT); }
__device__ __forceinline__ unsigned xb_add(unsigned* p, unsigned v) { return __hip_atomic_fetch_add(p, v, __ATOMIC_RELAXED, __HIP_MEMORY_SCOPE_AGENT); }
__device__ __forceinline__ unsigned xb_xcc_id() { return (unsigned)__builtin_amdgcn_s_getreg((3 << 11) | 20) & 0xFu; }
#define XB_SPIN(cond, bar) do { unsigned _sp = 0; while (cond) { __builtin_amdgcn_s_sleep(1); \
    if ((++_sp & 255u) == 0u) { if (xb_ld(&(bar)[XB_TMO])) break; if (_sp > XB_SPIN_CAP) { atomicAdd(&(bar)[XB_TMO], 1u); break; } } } } while (0)
struct XcdBarrier { unsigned* bar; unsigned x; volatile LAS unsigned* st; };
__device__ __forceinline__ XcdBarrier xcd_barrier_post(unsigned* bar, volatile LAS unsigned* st) {
    XcdBarrier b; b.bar = bar; b.x = xb_xcc_id(); b.st = st;
    if (threadIdx.x == 0) (void)xb_add(&bar[XB_XCNT(b.x)], 1u);
    return b;
}
__device__ __forceinline__ void xcd_barrier_complete(unsigned* bar, unsigned x, unsigned& nloc, unsigned& nx) {
    const unsigned G = gridDim.x * gridDim.y * gridDim.z;
    unsigned sum, cnt, mine, sp = 0u;
    for (;;) {
        sum = 0u; cnt = 0u; mine = 0u;
#pragma unroll
        for (unsigned j = 0; j < 16; ++j) { const unsigned c = xb_ld(&bar[XB_XCNT(j)]); sum += c; cnt += (c > 0u) ? 1u : 0u; }
        if (sum == G) break;
        __builtin_amdgcn_s_sleep(1);
        if ((++sp & 255u) == 0u) { if (xb_ld(&bar[XB_TMO])) break; if (sp > XB_SPIN_CAP) { atomicAdd(&bar[XB_TMO], 1u); break; } }
    }
    mine = xb_ld(&bar[XB_XCNT(x)]);
    nloc = mine > 0u ? mine : 1u; nx = cnt > 0u ? cnt : 1u;
}
__device__ __forceinline__ void xcd_barrier(const XcdBarrier& b) {
    asm volatile("s_waitcnt vmcnt(0)" ::: "memory");
    __syncthreads();
    if (threadIdx.x == 0) {
        unsigned* bar = b.bar;
        __builtin_amdgcn_s_waitcnt(0);
        unsigned nloc = b.st[0], nx = b.st[1];
        if (nloc == 0u) { xcd_barrier_complete(bar, b.x, nloc, nx); b.st[0] = nloc; b.st[1] = nx; }
        const unsigned old = xb_add(&bar[XB_XSUB(b.x)], 1u);
        const unsigned gen = old / nloc;
        if (old + 1u == (gen + 1u) * nloc) {
            __builtin_amdgcn_fence(__ATOMIC_RELEASE, "agent");
            asm volatile("s_waitcnt vmcnt(0)" ::: "memory");
            const unsigned og = xb_add(&bar[XB_TOP], 1u);
            const unsigned tg = og / nx;
            if (og + 1u == (tg + 1u) * nx) xb_add(&bar[XB_TOPGEN], 1u);
            else XB_SPIN(xb_ld(&bar[XB_TOPGEN]) == tg, bar);
            __builtin_amdgcn_fence(__ATOMIC_ACQUIRE, "agent");
            xb_add(&bar[XB_XGEN(b.x)], 1u);
            asm volatile("s_waitcnt vmcnt(0)" ::: "memory");
        } else {
            XB_SPIN(xb_ld(&bar[XB_XGEN(b.x)]) == gen, bar);
            __builtin_amdgcn_fence(__ATOMIC_ACQUIRE, "agent");
            asm volatile("s_waitcnt vmcnt(0)" ::: "memory");
        }
    }
    __syncthreads();
}

struct Args { const float* in[28]; float* out; unsigned char* ws; int ph_lo, ph_hi, li, pad; };
typedef const __attribute__((address_space(4))) Args* KArgs;
__device__ __forceinline__ KArgs opaque_kargs() { KArgs p = (KArgs)__builtin_amdgcn_kernarg_segment_ptr(); asm volatile("" : "+s"(p)); return p; }
enum { I_X = 0, I_C, I_CTX, I_CCTX, I_WMOD, I_BMOD, I_N1G, I_N2G, I_WIN, I_QG, I_KG, I_RPB, I_LQ1, I_LK1, I_LQ2, I_LK2, I_SUBG, I_SGUNG, I_SGUW, I_SGUB, I_GATEB, I_WBR, I_WOUT, I_WRT, I_WEG, I_WEU, I_WED, I_FG };

constexpr int CW_WIN = 16 * 26, CW_WB = 4 * 4 * 4, CW_WO = 16 * 4, CW_EG = 16 * 16 * 8, CW_ED = 16 * 32 * 4, CW_LAYER = CW_WIN + CW_WB + CW_WO + 2 * CW_EG + CW_ED;
struct ConvItem { const float* src; unsigned char* dst; int N, dpitch, k0, n0, kind, aux; };
__device__ __forceinline__ ConvItem conv_decode(KArgs A, int it) {
    ConvItem c; const int l = it / CW_LAYER; int r = it % CW_LAYER; unsigned char* wl = A->ws + WS_W0 + (size_t)l * W_LAYER; c.aux = 0;
    if (r < CW_WIN) { const int kb = r / 26, pn = r % 26; c.src = A->in[I_WIN] + (size_t)l * DM * IN_W; c.N = IN_W; c.k0 = 64 * kb; c.n0 = 256 * pn; c.dpitch = DM;
        if (pn >= 5 && pn <= 20) { c.kind = 1; c.dst = wl + WO_WING + (size_t)(c.n0 - 1280) * DM; } else { c.kind = 2; c.dst = wl + WO_WIN + (size_t)256 * (pn < 5 ? pn : pn - 16) * DM * 2; }
        return c; }
    r -= CW_WIN;
    if (r < CW_WB) { const int n = r / 16, q = r % 16, kb = q / 4, nb = q % 4; c.src = A->in[I_WBR] + ((size_t)l * 4 + n) * 256 * DM; c.N = DM; c.k0 = 64 * kb; c.n0 = 256 * nb; c.dpitch = 256; c.kind = 0; c.dst = wl + WO_WB + ((size_t)n * 1024 + c.n0) * 256 * 2; return c; }
    r -= CW_WB;
    if (r < CW_WO) { const int kb = r / 4, nb = r % 4; c.src = A->in[I_WOUT] + (size_t)l * DM * DM; c.N = DM; c.k0 = 64 * kb; c.n0 = 256 * nb; c.dpitch = DM; c.kind = 0; c.dst = wl + WO_WO4 + (size_t)c.n0 * DM * 2; return c; }
    r -= CW_WO;
    if (r < 2 * CW_EG) { const int up = r >= CW_EG; if (up) r -= CW_EG; const int e = r / 128, q = r % 128, kb = q / 8, nb = q % 8; c.src = A->in[up ? I_WEU : I_WEG] + ((size_t)l * NEXP + e) * DM * EH; c.N = EH; c.k0 = 64 * kb; c.n0 = 256 * nb; c.dpitch = DM;
        c.kind = 3; c.aux = up ? 128 : 0; c.dst = wl + WO_WGU + (size_t)e * 4096 * DM; return c; }
    r -= 2 * CW_EG;
    { const int e = r / 128, q = r % 128, kb = q / 4, nb = q % 4; c.src = A->in[I_WED] + ((size_t)l * NEXP + e) * EH * DM; c.N = DM; c.k0 = 64 * kb; c.n0 = 256 * nb; c.dpitch = EH; c.kind = 1; c.dst = wl + WO_WD + ((size_t)e * DM + c.n0) * EH; return c; }
}
constexpr int CW_SMALL = CW_WIN + CW_WB + CW_WO, CW_MOE = 2 * CW_EG + CW_ED;
template <bool SMALL> __device__ __forceinline__ int conv_id(int it) { return SMALL ? (it / CW_SMALL) * CW_LAYER + it % CW_SMALL : it; }
template <bool SMALL> __device__ __forceinline__ void conv_load(KArgs A, int it, int NIT, f32x4 (&rg)[8], int wv, int lane) {
    if (it < NIT) { const ConvItem c = conv_decode(A, conv_id<SMALL>(it)); const float* p = c.src + (size_t)(c.k0 + wv * 8) * c.N + c.n0 + 4 * lane;
#pragma unroll
        for (int i = 0; i < 8; ++i) rg[i] = *(const f32x4*)(p + (size_t)i * c.N); }
}
template <bool SMALL> __device__ __forceinline__ void conv_out(KArgs A, int it, const f32x4 (&rg)[8], LAS float* T, int tid, int wv, int lane) {
    constexpr int TP = 256;
#pragma unroll
    for (int i = 0; i < 8; ++i) *(LAS f32x4*)(T + (wv * 8 + i) * TP + 4 * (lane ^ wv)) = rg[i];
    asm volatile("s_waitcnt lgkmcnt(0)" ::: "memory"); __builtin_amdgcn_s_barrier(); asm volatile("" ::: "memory");
    const ConvItem c = conv_decode(A, conv_id<SMALL>(it));
#pragma unroll
    for (int jj = 0; jj < 4; ++jj) { const int q = tid + 512 * jj, ch = q & 7, n = q >> 3; const LAS float* t = T + (8 * ch) * TP + (n ^ (4 * ch));
        float v[8];
#pragma unroll
        for (int i = 0; i < 8; ++i) v[i] = t[i * TP];
        if (c.kind == 1) { v2u o; o.x = pk8(v[0] * W8S, v[1] * W8S, v[2] * W8S, v[3] * W8S); o.y = pk8(v[4] * W8S, v[5] * W8S, v[6] * W8S, v[7] * W8S); *(v2u*)(c.dst + (size_t)n * c.dpitch + c.k0 + 8 * ch) = o; }
        else if (c.kind == 3) { const int f = c.n0 + n; v2u o; o.x = pk8(v[0] * W8S, v[1] * W8S, v[2] * W8S, v[3] * W8S); o.y = pk8(v[4] * W8S, v[5] * W8S, v[6] * W8S, v[7] * W8S); *(v2u*)(c.dst + (size_t)(256 * (f >> 7) + (f & 127) + c.aux) * c.dpitch + c.k0 + 8 * ch) = o; }
        else { const int g = n >> 5, row = c.kind == 2 ? 32 * (4 * (g & 1) + (g >> 1)) + (n & 31) : n; st8((bf16_t*)c.dst + (size_t)row * c.dpitch + c.k0 + 8 * ch, v); } }
    asm volatile("s_waitcnt lgkmcnt(0)" ::: "memory"); __builtin_amdgcn_s_barrier(); asm volatile("" ::: "memory");
}
template <bool SMALL = false> __device__ __forceinline__ void conv_run(KArgs A, int first, int stride, int end, LAS unsigned char* lds, int tid) {
    const int lane = tid & 63, wv = tid >> 6; LAS float* T = (LAS float*)lds;
    f32x4 rg[4][8];
#pragma unroll
    for (int d = 0; d < 4; ++d) conv_load<SMALL>(A, first + d * stride, end, rg[d], wv, lane);
    for (int it = first; it < end; it += 4 * stride) {
#pragma unroll
        for (int d = 0; d < 4; ++d) if (it + d * stride < end) {
            f32x4 t0[8];
#pragma unroll
            for (int i = 0; i < 8; ++i) t0[i] = rg[d][i];
            conv_load<SMALL>(A, it + (4 + d) * stride, end, rg[d], wv, lane);
            conv_out<SMALL>(A, it + d * stride, t0, T, tid, wv, lane);
        }
    }
}
__device__ __forceinline__ void mod_item(KArgs A, int item, LAS unsigned char* lds, int tid) {
    const int lane = tid & 63, wid = tid >> 6, l = item / 96, col0 = 64 * (item % 96);
    LAS float* sil = (LAS float*)lds;
    LAS float* part = sil + 3 * 1024;
    for (int i = tid; i < 3 * 1024; i += 512) { const int r = i >> 10, k = i & 1023; const float cv = r < 2 ? A->in[I_C][r * DM + k] : A->in[I_CCTX][k]; sil[i] = siluf_(cv); }
    __syncthreads();
    const float* W = A->in[I_WMOD] + (size_t)l * DM * 6144 + col0 + lane;
    float a0 = 0.f, a1 = 0.f, a2 = 0.f;
    for (int kb = 0; kb < 4; ++kb) { float w[32];
#pragma unroll
        for (int q = 0; q < 32; ++q) w[q] = W[(size_t)(wid * 128 + kb * 32 + q) * 6144];
        __builtin_amdgcn_sched_barrier(0);
#pragma unroll
        for (int q = 0; q < 32; ++q) { const int k = wid * 128 + kb * 32 + q; a0 += sil[k] * w[q]; a1 += sil[1024 + k] * w[q]; a2 += sil[2048 + k] * w[q]; }
        __builtin_amdgcn_sched_barrier(0); }
    part[(wid * 3 + 0) * 64 + lane] = a0; part[(wid * 3 + 1) * 64 + lane] = a1; part[(wid * 3 + 2) * 64 + lane] = a2;
    __syncthreads();
    if (tid < 192) { const int r = tid >> 6, cl = tid & 63; float s = A->in[I_BMOD][(size_t)l * 6144 + col0 + cl];
#pragma unroll
        for (int w = 0; w < 8; ++w) s += part[(w * 3 + r) * 64 + cl];
        ((float*)(A->ws + WS_MOD))[((size_t)l * 3 + r) * 6144 + col0 + cl] = s; }
    __syncthreads();
}

struct Row { f32x4 v[4]; };
__device__ __forceinline__ Row row_load(const float* p, int lane) { Row r; const f32x4* q = (const f32x4*)p + lane;
#pragma unroll
    for (int j = 0; j < 4; ++j) r.v[j] = q[64 * j]; return r; }
__device__ __forceinline__ Row row_load_bf16(const bf16_t* p, int lane) { Row r; const v2u* q = (const v2u*)p + lane; v2u t[4];
#pragma unroll
    for (int j = 0; j < 4; ++j) t[j] = q[64 * j];
#pragma unroll
    for (int j = 0; j < 4; ++j) r.v[j] = (f32x4){bflo(t[j].x), bfhi(t[j].x), bflo(t[j].y), bfhi(t[j].y)};
    return r; }
__device__ __forceinline__ void row_store(float* p, const Row& r, int lane) { f32x4* q = (f32x4*)p + lane;
#pragma unroll
    for (int j = 0; j < 4; ++j) q[64 * j] = r.v[j]; }
__device__ __forceinline__ float row_rstd(const Row& r) { float s = 0.f;
#pragma unroll
    for (int j = 0; j < 4; ++j) s += (r.v[j].x * r.v[j].x + r.v[j].y * r.v[j].y) + (r.v[j].z * r.v[j].z + r.v[j].w * r.v[j].w);
    return __builtin_amdgcn_rsqf(wave_sum(s) * (1.0f / DM) + EPS); }
__device__ __forceinline__ Row row_normmod(const Row& x, float rstd, const float* g, const float* sh, const float* sc, int lane) { Row y; f32x4 gg[4], ss[4], hh[4];
#pragma unroll
    for (int j = 0; j < 4; ++j) { gg[j] = ((const f32x4*)g)[lane + 64 * j]; ss[j] = ((const f32x4*)sc)[lane + 64 * j]; hh[j] = ((const f32x4*)sh)[lane + 64 * j]; }
    __builtin_amdgcn_sched_barrier(0);
#pragma unroll
    for (int j = 0; j < 4; ++j) y.v[j] = x.v[j] * rstd * gg[j] * (ss[j] + 1.0f) + hh[j];
    return y; }
struct NormP { f32x4 a[4], h[4]; };
__device__ __forceinline__ NormP normp_load(const float* g, const float* sh, const float* sc, int lane) { NormP p; f32x4 gg[4], ss[4];
#pragma unroll
    for (int j = 0; j < 4; ++j) { gg[j] = ((const f32x4*)g)[lane + 64 * j]; ss[j] = ((const f32x4*)sc)[lane + 64 * j]; p.h[j] = ((const f32x4*)sh)[lane + 64 * j]; }
    __builtin_amdgcn_sched_barrier(0);
#pragma unroll
    for (int j = 0; j < 4; ++j) p.a[j] = gg[j] * (ss[j] + 1.0f);
    return p; }
__device__ __forceinline__ Row row_normmod_p(const Row& x, float rstd, const NormP& p) { Row y;
#pragma unroll
    for (int j = 0; j < 4; ++j) y.v[j] = x.v[j] * rstd * p.a[j] + p.h[j];
    return y; }
__device__ __forceinline__ void row_store_bf16(bf16_t* p, const Row& r, int lane) { v2u* q = (v2u*)p + lane;
#pragma unroll
    for (int j = 0; j < 4; ++j) { v2u w; w.x = cvtpk(r.v[j].x, r.v[j].y); w.y = cvtpk(r.v[j].z, r.v[j].w); q[64 * j] = w; } }
__device__ __forceinline__ void row_store_fp8(unsigned char* p, const Row& r, int lane) { unsigned* q = (unsigned*)p + lane;
#pragma unroll
    for (int j = 0; j < 4; ++j) q[64 * j] = pk8(r.v[j].x, r.v[j].y, r.v[j].z, r.v[j].w); }
__device__ __forceinline__ const float* in_row(KArgs A, int R) { const int b = R / RB, r = R % RB; return r < CTXL ? A->in[I_CTX] + ((size_t)b * CTXL + r) * DM : A->in[I_X] + ((size_t)b * SEQ + (r - CTXL)) * DM; }
__device__ __forceinline__ int mod_row(int R) { const int b = R / RB, r = R % RB; return r < CTXL ? 2 : b; }

__device__ __forceinline__ int lat_tile(int im) { return (im >> 5) * TPB + 1 + (im & 31); }
struct SchedP1 { const char* HN; const char* W; int layer, G, c;
    __device__ __forceinline__ bool next(int i, pg8::Unit& u) const {
        const int nmain = 64 * 10, nextra = layer == 0 ? 2 * 10 : 2 * 5; const int L = i * G + c; if (L >= nmain + nextra) return false;
        int pm, pq;
        if (L < nmain) { int im, in; pg8::rect_order(L, 64, 10, im, in); pm = lat_tile(im); pq = in; }
        else { const int x = L - nmain; if (layer == 0) { pm = (x / 10) * TPB; pq = x % 10; } else { pm = (x / 5) * TPB; pq = 5 + x % 5; } }
        u.pm = pm; u.pn = pq < 5 ? pq : pq + 16; u.a = HN + (size_t)pm * 256 * DM * 2; u.b = W + (size_t)pq * 256 * DM * 2; return true; } };
struct SchedP1g { const char* HN8; const char* W8; int layer, G, c;
    __device__ __forceinline__ bool next(int i, pg8::Unit& u) const {
        const int nmain = 64 * 16, nextra = layer == 0 ? 2 * 16 : 0; const int L = i * G + (G - 1 - c); if (L >= nmain + nextra) return false;
        int pm, pn;
        if (L < nmain) { int im; pg8::rect_order(L, 64, 16, im, pn); pm = lat_tile(im); }
        else { const int x = L - nmain; pm = (x >> 4) * TPB; pn = x & 15; }
        u.pm = pm; u.pn = pn; u.a = HN8 + (size_t)pm * 256 * DM; u.b = W8 + (size_t)pn * 256 * DM; return true; } };
struct SchedP3a { const char* YS; const char* WB; int layer, G, c;
    __device__ __forceinline__ bool next(int i, pg8::Unit& u) const {
        int pm, dt, n;
        if (i < 4) { if (c >= 256) return false; int im; pg8::rect_order(c, 64, 4, im, dt); pm = lat_tile(im); n = i; }
        else { if (i > 4 || layer != 0 || c >= 32) return false; pm = (c >> 4) * TPB; dt = (c >> 2) & 3; n = c & 3; }
        u.pm = pm; u.pn = dt * 4 + n; u.a = YS + ((size_t)pm * 256 * DM + 256 * n) * 2; u.b = WB + ((size_t)n * 1024 + dt * 256) * 256 * 2; return true; } };
struct SchedP3b { const char* MRG; const char* WO; int G, c;
    __device__ __forceinline__ bool next(int i, pg8::Unit& u) const {
        const int L = i * G + c; if (L >= 64 * 4) return false;
        int im, in; pg8::rect_order(L, 64, 4, im, in); const int pm = lat_tile(im);
        u.pm = pm; u.pn = in; u.a = MRG + (size_t)pm * 256 * DM * 2; u.b = WO + (size_t)in * 256 * DM * 2; return true; } };
struct SchedP3c { const char* GPC; const char* WO; int G, c;
    __device__ __forceinline__ bool next(int i, pg8::Unit& u) const {
        const int L = i * G + c; if (L >= 128) return false;
        const int pm = L >> 6, ks = (L >> 2) & 15, ct = L & 3, n = ks >> 2, kq = ks & 3;
        u.pm = pm; u.pn = ks * 4 + ct; u.a = GPC + (((size_t)n * 512 + pm * 256) * DM + kq * 256) * 2; u.b = WO + ((size_t)ct * 256 * DM + kq * 256) * 2; return true; } };
struct SchedP6 { const char* XG; const char* WGU; int RT, G, c;
    __device__ __forceinline__ bool next(int i, pg8::Unit& u) const {
        const int nM = 16 * RT; const int L = i * G + c; if (L >= nM * 16) return false;
        int im, in; pg8::rect_order(L, nM, 16, im, in); const int e = im / RT;
        u.pm = im; u.pn = in; u.a = XG + (size_t)im * 256 * DM; u.b = WGU + ((size_t)e * 4096 + in * 256) * DM; return true; } };
struct SchedP7 { const char* HID; const char* WD; int RT, G, c;
    __device__ __forceinline__ bool next(int i, pg8::Unit& u) const {
        const int nM = 16 * 8; const int L = i * G + c; if (L >= nM * 4) return false;
        int im8, in; pg8::rect_order(L, nM, 4, im8, in); const int e = im8 >> 3, im = e * RT + (im8 & 7);
        u.pm = im; u.pn = in; u.a = HID + (size_t)im * 256 * EH; u.b = WD + ((size_t)e * DM + in * 256) * EH; return true; } };
struct SchedP7c { const char* HID; const char* WD; int G, c;
    __device__ __forceinline__ bool next(int i, pg8::Unit& u) const {
        const int L = i * G + c; if (L >= 256) return false;
        const int e = L >> 4, in = (L >> 2) & 3, kq = L & 3, im = e * 9 + 8;
        u.pm = im; u.pn = in + 4 * kq; u.a = HID + (size_t)im * 256 * EH + kq * 512; u.b = WD + ((size_t)e * DM + in * 256) * EH + kq * 512; return true; } };

__device__ __forceinline__ unsigned block_excl_scan(unsigned v, LAS unsigned* wtot, int lane, int wid) {
    unsigned inc = v;
#pragma unroll
    for (int o = 1; o < 64; o <<= 1) { const unsigned t = (unsigned)__builtin_amdgcn_ds_bpermute(((lane - o) & 63) << 2, (int)inc); if (lane >= o) inc += t; }
    if (lane == 63) wtot[wid] = inc;
    __syncthreads();
    unsigned base = 0;
#pragma unroll
    for (int w = 0; w < 8; ++w) base += (w < wid) ? wtot[w] : 0u;
    __syncthreads();
    return base + inc - v;
}
__device__ __forceinline__ void topk_unit(KArgs A, int RT, bool isctx, int b, int e, LAS unsigned char* lds, int tid) {
    const int lane = tid & 63, wid = tid >> 6;
    LAS unsigned* hist = (LAS unsigned*)lds; LAS unsigned* wtot = hist + 256; LAS unsigned* sel = wtot + 16;
    const int cap = isctx ? 32 : 1024;
    const float* aff = isctx ? (const float*)(A->ws + WS_AFFC) + ((size_t)b * 16 + e) * 256 : (const float*)(A->ws + WS_AFFL) + ((size_t)b * 16 + e) * 8192;
    unsigned key[16];
    if (isctx) {
#pragma unroll
        for (int j = 0; j < 16; ++j) key[j] = 0u;
        if (tid < 256) key[0] = __float_as_uint(aff[tid]);
    } else {
#pragma unroll
        for (int q = 0; q < 4; ++q) { const f32x4 t = *(const f32x4*)(aff + tid * 16 + 4 * q); key[4 * q] = __float_as_uint(t.x); key[4 * q + 1] = __float_as_uint(t.y); key[4 * q + 2] = __float_as_uint(t.z); key[4 * q + 3] = __float_as_uint(t.w); }
    }
#define TK_VALID(j) (isctx ? ((j) == 0 && tid < 256) : true)
    unsigned pfx = 0u, need = (unsigned)cap;
    for (int pass = 0; pass < 4; ++pass) { const int shift = 24 - 8 * pass;
        for (int i = tid; i < 256; i += 512) hist[i] = 0u;
        __syncthreads();
#pragma unroll
        for (int j = 0; j < 16; ++j) if (TK_VALID(j) && (pass == 0 || (key[j] >> (shift + 8)) == pfx)) __hip_atomic_fetch_add(&hist[(key[j] >> shift) & 255u], 1u, __ATOMIC_RELAXED, __HIP_MEMORY_SCOPE_WORKGROUP);
        __syncthreads();
        if (wid == 0) {
            const unsigned h0 = hist[4 * lane], h1 = hist[4 * lane + 1], h2 = hist[4 * lane + 2], h3 = hist[4 * lane + 3], s = h0 + h1 + h2 + h3;
            unsigned incl = s;
#pragma unroll
            for (int o = 1; o < 64; o <<= 1) { const unsigned t = (unsigned)__builtin_amdgcn_ds_bpermute(((lane + o) & 63) << 2, (int)incl); if (lane + o < 64) incl += t; }
            const unsigned excl = incl - s;
            if (excl < need && need <= incl) { unsigned c = excl; int bin;
                if (c + h3 >= need) bin = 3; else { c += h3; if (c + h2 >= need) bin = 2; else { c += h2; if (c + h1 >= need) bin = 1; else { c += h1; bin = 0; } } }
                sel[0] = (unsigned)(4 * lane + bin); sel[1] = need - c; }
        }
        __syncthreads();
        pfx = (pfx << 8) | sel[0]; need = sel[1];
        __syncthreads();
    }
    const unsigned T = pfx;
    unsigned ce = 0u;
#pragma unroll
    for (int j = 0; j < 16; ++j) ce += (TK_VALID(j) && key[j] == T) ? 1u : 0u;
    unsigned re = block_excl_scan(ce, wtot, lane, wid);
    unsigned selmask = 0u, cs = 0u;
#pragma unroll
    for (int j = 0; j < 16; ++j) if (TK_VALID(j)) { bool s = key[j] > T; if (key[j] == T) { s = re < need; ++re; } if (s) { selmask |= 1u << j; ++cs; } }
    unsigned slot = block_excl_scan(cs, wtot, lane, wid);
    int* IDXROW = (int*)(A->ws + WS_IDXROW); float* SCORE = (float*)(A->ws + WS_SCORE); int* INV = (int*)(A->ws + WS_INV);
    const int ybase = e * RT * 256 + (isctx ? 2048 + b * 32 : b * 1024);
#pragma unroll
    for (int j = 0; j < 16; ++j) if (TK_VALID(j)) { const int idx = isctx ? tid : tid * 16 + j; const int R = b * RB + (isctx ? idx : CTXL + idx);
        if (selmask & (1u << j)) { const int yrow = ybase + (int)slot; IDXROW[yrow] = R; SCORE[yrow] = __uint_as_float(key[j]); INV[((size_t)b * 16 + e) * RB + (R - b * RB)] = yrow; ++slot; }
        else INV[((size_t)b * 16 + e) * RB + (R - b * RB)] = -1; }
    if (isctx && b == 0 && tid < 192) IDXROW[e * RT * 256 + 2048 + 64 + tid] = -1;
#undef TK_VALID
    __syncthreads();
}

struct AJob { const attn_body::bf16 *Q, *K, *V; attn_body::bf16* O; int nt, mode; };
__device__ __forceinline__ bool mixer_job(unsigned char* ws, int l, int vcu, int i, AJob& j) {
    using attn_body::bf16;
    const bf16* QKV = (const bf16*)(ws + WS_QKV); bf16* YS = (bf16*)(ws + WS_YS);
    if (i < 3) { const int b = vcu >> 7, h = (vcu >> 5) & 3, qb = vcu & 31; const long q0 = (long)b * RB + CTXL + qb * 256, k0 = (long)b * RB;
        if (i < 2) { const int vh = 2 * h + i; j.Q = QKV + q0 * PQ + C_QB + vh * 64; j.K = QKV + k0 * PQ + C_KB + vh * 64; j.V = QKV + k0 * PQ + C_VB + h * 64; j.O = YS + q0 * 1024 + 256 + h * 64; j.nt = 132; j.mode = 1 + i; }
        else { j.Q = QKV + q0 * PQ + C_QD + h * 64; j.K = QKV + k0 * PQ + C_KD + (h >> 1) * 64; j.V = QKV + k0 * PQ + C_VD + (h >> 1) * 64; j.O = YS + q0 * 1024 + 768 + h * 64; j.nt = 132; j.mode = 0; }
        return true; }
    if (l != 0) return false;
    const int uc = (vcu + 256 - 132) & 255; if (uc >= 24) return false;
    const int type = uc >> 3, b = (uc >> 2) & 1, h = uc & 3, k = i - 3; const long q0 = (long)b * RB;
    j.nt = 4;
    if (type == 0) { if (k > 0) return false; j.Q = QKV + q0 * PQ + C_QA + h * 64; j.K = QKV + q0 * PQ + C_KA + h * 64; j.V = QKV + q0 * PQ + C_VA + h * 64; j.O = YS + q0 * 1024 + h * 64; j.mode = 0; return true; }
    if (type == 1) { if (k > 1) return false; const int vh = 2 * h + k; j.Q = QKV + q0 * PQ + C_QB + vh * 64; j.K = QKV + q0 * PQ + C_KB + vh * 64; j.V = QKV + q0 * PQ + C_VB + h * 64; j.O = YS + q0 * 1024 + 256 + h * 64; j.mode = 1 + k; return true; }
    if (k > 0) return false; j.Q = QKV + q0 * PQ + C_QD + h * 64; j.K = QKV + q0 * PQ + C_KD + (h >> 1) * 64; j.V = QKV + q0 * PQ + C_VD + (h >> 1) * 64; j.O = YS + q0 * 1024 + 768 + h * 64; j.mode = 0; return true;
}

__global__ void __launch_bounds__(512, 2) fwd_kernel(Args A_) {
    extern __shared__ __attribute__((aligned(16))) unsigned char lds[];
    LAS unsigned char* L = (LAS unsigned char*)lds;
    const int tid0 = threadIdx.x;
    const int G0 = gridDim.x, bx0 = blockIdx.x;
    unsigned char* ws = A_.ws;
    for (int u = tid0; u < (LDS_BYTES - LDSCTL_OFF) / 4; u += 512) ((LAS unsigned*)(L + LDSCTL_OFF))[u] = 0u;
    __syncthreads();
    XcdBarrier bar; bar.bar = (unsigned*)(ws + WS_CTL) + CW_BAR + A_.li * XCD_BAR_WORDS; bar.x = 0; bar.st = nullptr;
    if (!MK_PER_PHASE) bar = xcd_barrier_post((unsigned*)(ws + WS_CTL) + CW_BAR + A_.li * XCD_BAR_WORDS, (volatile LAS unsigned*)(L + MISC_OFF) + 8);
#define PHASE_PTRS KArgs A = opaque_kargs(); unsigned char* ws = A->ws; const int G = opaque_s(G0), bx = opaque_s(bx0), vcu = (bx % 8) * (G / 8) + bx / 8, wave = __builtin_amdgcn_readfirstlane(opaque_tid() >> 6), gw = vcu * 8 + wave, NGW = G * 8; (void)gw; (void)NGW; (void)vcu; const float* MOD = (const float*)(ws + WS_MOD); bf16_t* HN = (bf16_t*)(ws + WS_HN); bf16_t* H2 = (bf16_t*)(ws + WS_H2); bf16_t* YS = (bf16_t*)(ws + WS_YS); \
    bf16_t* GT = (bf16_t*)(ws + WS_GT); bf16_t* X1 = (bf16_t*)(ws + WS_X1); bf16_t* XR = (bf16_t*)(ws + WS_XR); float* PART = (float*)(ws + WS_PART); \
    (void)MOD; (void)HN; (void)H2; (void)YS; (void)GT; (void)X1; (void)XR; (void)PART;
    const int lo = A_.ph_lo, hi = A_.ph_hi;
#ifndef DBG_MASK
#define DBG_MASK 0xffffffffu
#endif
#define PHON(k) ((DBG_MASK >> ((k) < 2 ? (k) : 2 + ((k) - 2) % 10)) & 1u)
#define IN(k) (PHON(k) && lo <= (k) && (k) < hi)
#define SEAM(k) do { if (!MK_PER_PHASE && (k) + 1 < hi) { XcdBarrier b2_ = bar; b2_.bar = (unsigned*)opaque_ptr((unsigned char*)bar.bar); xcd_barrier(b2_); } } while (0)

    if (IN(0)) { PHASE_PTRS
        const int tid = opaque_tid(), lane = tid & 63; (void)tid; (void)lane;
        for (int item = bx; item < 192; item += G) mod_item(A, item, L, tid);
        __syncthreads();
        SEAM(0);
    }
    if (IN(1)) { PHASE_PTRS
        const int tid = opaque_tid(), lane = tid & 63; (void)tid; (void)lane;
        { const int Ra = gw * 9, Rb = min(Ra + 9, NR);
          Row xn = row_load(in_row(A, min(Ra, NR - 1)), lane), xn2 = row_load(in_row(A, min(Ra + 1, NR - 1)), lane), xn3 = row_load(in_row(A, min(Ra + 2, NR - 1)), lane);
          int cur = mod_row(min(Ra, NR - 1)); NormP np; { const float* m = MOD + (size_t)cur * 6144; np = normp_load(A->in[I_N1G], m, m + 1024, lane); }
          for (int R = Ra; R < Rb; ++R) { const Row x = xn; xn = xn2; xn2 = xn3; if (R + 3 < Rb) xn3 = row_load(in_row(A, R + 3), lane);
            const int mr = mod_row(R); if (mr != cur) { const float* m = MOD + (size_t)mr * 6144; np = normp_load(A->in[I_N1G], m, m + 1024, lane); cur = mr; }
            const Row y = row_normmod_p(x, row_rstd(x), np); row_store_bf16(HN + (size_t)R * DM, y, lane); row_store_fp8(ws + WS_HN8 + (size_t)R * DM, y, lane); } }
        __syncthreads();
        conv_run<true>(A, vcu, G, DEPTH * CW_SMALL, L, tid);
        SEAM(1);
    }
    for (int l = 0; l < DEPTH; ++l) {
        const int P = 2 + 10 * l; const int RT = l == 0 ? 9 : 8;
#define LAYER_PTRS PHASE_PTRS unsigned char* wl = ws + WS_W0 + (size_t)l * W_LAYER; const float* MODL = MOD + (size_t)l * 3 * 6144; (void)wl; (void)MODL;
        if (IN(P + 0)) { LAYER_PTRS
            { SchedP1 S{(const char*)HN, (const char*)(wl + WO_WIN), l, G, bx};
              EpiInProj E{(bf16_t*)(ws + WS_QKV), GT, A->in[I_QG] + l * 64, A->in[I_KG] + l * 64, A->in[I_GATEB] + (size_t)l * 4096};
              pg8::gemm_phase<EpiInProj, SchedP1>(L, DM, DM, DM, S, E); }
            { SchedP1g S{(const char*)(ws + WS_HN8), (const char*)(wl + WO_WING), l, G, bx}; EpiGates E{(unsigned char*)GT, A->in[I_GATEB] + (size_t)l * 4096};
              pg8::gemm8_phase<EpiGates, SchedP1g>(L, DM / 2, DM / 2, DM / 2, S, E); }
            SEAM(P + 0);
        }
        if (IN(P + 1)) { LAYER_PTRS
            const int tid = opaque_tid(), lane = tid & 63; (void)tid; (void)lane;
            float s1 = lane < 32 ? A->in[I_LQ1][l * 32 + lane] * A->in[I_LK1][l * 32 + lane] : 0.f, s2 = lane < 32 ? A->in[I_LQ2][l * 32 + lane] * A->in[I_LK2][l * 32 + lane] : 0.f;
            const float lam_init = l == 0 ? 0.2f : 0.35550906759096934f;
            const float lam = expf(wave_sum(s1)) - expf(wave_sum(s2)) + lam_init;
            const attn_body::DiffEpi de{lam, 1.0f - lam_init, A->in[I_SUBG] + l * 64};
            const int cslot = vcu & 3, cbase = l * CW_LAYER + CW_SMALL + vcu * (CW_MOE / 256);
#define CONV_SEAM(k) do { if (cslot == (k)) conv_run(A, cbase, 1, cbase + CW_MOE / 256, L, opaque_tid()); } while (0)
            static_assert(CW_MOE % 256 == 0, "expert-weight items split evenly over 256 CUs");
            CONV_SEAM(0);
            AJob j;
            for (int i = 0; mixer_job(ws, l, vcu, i, j); ++i) {
                if (i == 2) CONV_SEAM(1);
                if (i == 3) CONV_SEAM(2);
                if (j.mode == 0) attn_body::attn_unit<8, 0>(j.Q, j.K, j.V, j.nt, j.O, (char*)lds, de);
                else if (j.mode == 1) attn_body::attn_unit<8, 1>(j.Q, j.K, j.V, j.nt, j.O, (char*)lds, de);
                else attn_body::attn_unit<8, 2>(j.Q, j.K, j.V, j.nt, j.O, (char*)lds, de);
            }
            if (l != 0 || ((vcu + 256 - 132) & 255) >= 24) CONV_SEAM(2);
            { const int b = vcu >> 7, h = (vcu >> 5) & 3, g4 = vcu & 31;
              attn_body::na_unit(b, h, g4, (const attn_body::bf16*)(ws + WS_QKV), (attn_body::bf16*)YS, A->in[I_RPB] + ((size_t)l * 4 + h) * 465, (char*)lds); }
            CONV_SEAM(3);
            const int nsgu = 128 + (l == 0 ? 4 : 0);
            if (vcu < nsgu) { const long rowbase = vcu < 128 ? (long)(vcu >> 6) * RB + CTXL + (vcu & 63) * 128 : (long)((vcu - 128) >> 1) * RB + ((vcu - 128) & 1) * 128;
                sgu_unit(rowbase, (const bf16_t*)(ws + WS_QKV) + C_GU, (const bf16_t*)(ws + WS_QKV) + C_GV, A->in[I_SGUNG] + l * 256, A->in[I_SGUW] + (size_t)l * 4 * 128 * 128, A->in[I_SGUB] + l * 4 * 128, YS, (char*)lds); }
            SEAM(P + 1);
        }
        if (IN(P + 2)) { LAYER_PTRS
            SchedP3a S{(const char*)YS, (const char*)(wl + WO_WB), l, G, bx}; EpiGateAcc E{(const unsigned char*)GT, (bf16_t*)(ws + WS_MRG), (bf16_t*)(ws + WS_GPC)};
            pg8::gemm_phase<EpiGateAcc, SchedP3a>(L, 256, DM, 256, S, E);
            SEAM(P + 2);
        }
        if (IN(P + 3)) { LAYER_PTRS
            { SchedP3b S{(const char*)(ws + WS_MRG), (const char*)(wl + WO_WO4), G, bx}; EpiOutRes E{A->in[I_X], A->in[I_CTX], XR, X1, MODL, l};
              pg8::gemm_phase<EpiOutRes, SchedP3b>(L, DM, DM, DM, S, E); }
            if (l == 0) { SchedP3c S{(const char*)(ws + WS_GPC), (const char*)(wl + WO_WO4), G, bx}; EpiPart E{PART};
              pg8::gemm_phase<EpiPart, SchedP3c>(L, 256, DM, DM, S, E); }
            SEAM(P + 3);
        }
        if (IN(P + 4)) { LAYER_PTRS
            const int tid = opaque_tid(), lane = tid & 63; (void)tid; (void)lane;
            LAS float* wrT = (LAS float*)L;
            const float* wr = A->in[I_WRT] + (size_t)l * DM * 16;
            { f32x4 wv[8];
#pragma unroll
              for (int q = 0; q < 8; ++q) wv[q] = ((const f32x4*)wr)[tid + 512 * q];
              __builtin_amdgcn_sched_barrier(0);
#pragma unroll
              for (int q = 0; q < 8; ++q) { const int i4 = tid + 512 * q, k = i4 >> 2, e0 = (i4 & 3) * 4;
#pragma unroll
                  for (int j = 0; j < 4; ++j) wrT[(e0 + j) * DM + k] = wv[q][j]; } }
            __syncthreads();
            const int nit = 8 + ((l == 0 && gw < 512) ? 1 : 0);
            Row xn; { const int i0 = gw * 8; xn = row_load_bf16(X1 + ((size_t)(i0 >> 13) * RB + CTXL + (i0 & 8191)) * DM, lane); }
            NormP np; { const float* m0 = MODL + (size_t)((gw * 8) >> 13) * 6144; np = normp_load(A->in[I_N2G] + l * DM, m0 + 3072, m0 + 4096, lane); }
            for (int it = 0; it < nit; ++it) { const int i = it < 8 ? gw * 8 + it : 16384 + gw; const bool isctx = i >= 16384; const int b = isctx ? (i - 16384) >> 8 : i >> 13, r = isctx ? (i - 16384) & 255 : CTXL + (i & 8191); const int R = b * RB + r;
                const float* m = MODL + (size_t)(isctx ? 2 : b) * 6144;
                Row x = xn;
                if (it + 1 < 8) { const int in = i + 1; xn = row_load_bf16(X1 + ((size_t)(in >> 13) * RB + CTXL + (in & 8191)) * DM, lane); }
                if (isctx) { x = row_load(in_row(A, R), lane); Row s;
#pragma unroll
                    for (int j = 0; j < 4; ++j) s.v[j] = (f32x4){0.f, 0.f, 0.f, 0.f};
                    for (int ks = 0; ks < 16; ks += 4) { Row p[4];
#pragma unroll
                        for (int q = 0; q < 4; ++q) p[q] = row_load(PART + ((size_t)(ks + q) * 512 + b * 256 + r) * DM, lane);
                        __builtin_amdgcn_sched_barrier(0);
#pragma unroll
                        for (int q = 0; q < 4; ++q)
#pragma unroll
                            for (int j = 0; j < 4; ++j) s.v[j] += p[q].v[j]; }
#pragma unroll
                    for (int j = 0; j < 4; ++j) x.v[j] += ((const f32x4*)(m + 2048))[lane + 64 * j] * s.v[j];
                    row_store_bf16(X1 + (size_t)R * DM, x, lane);
                }
                if (isctx) np = normp_load(A->in[I_N2G] + l * DM, m + 3072, m + 4096, lane);
                const Row h = row_normmod_p(x, row_rstd(x), np);
                { unsigned* hq = (unsigned*)((unsigned char*)H2 + (size_t)R * DM) + lane;
#pragma unroll
                  for (int j = 0; j < 4; ++j) hq[64 * j] = pk8(h.v[j].x, h.v[j].y, h.v[j].z, h.v[j].w); }
                float lg[16];
#pragma unroll
                for (int e = 0; e < 16; ++e) { f32x2 a2 = (f32x2){0.f, 0.f};
#pragma unroll
                    for (int j = 0; j < 4; ++j) { const f32x4 w = *(const LAS f32x4*)(wrT + e * DM + 4 * lane + 256 * j);
                        a2 = __builtin_elementwise_fma((f32x2){h.v[j].x, h.v[j].y}, (f32x2){w.x, w.y}, a2); a2 = __builtin_elementwise_fma((f32x2){h.v[j].z, h.v[j].w}, (f32x2){w.z, w.w}, a2); }
                    lg[e] = a2.x + a2.y; if ((e & 3) == 3) __builtin_amdgcn_sched_barrier(0); }
                float c8[8], d[4];
#pragma unroll
                for (int i = 0; i < 8; ++i) { auto rr = __builtin_amdgcn_permlane32_swap(__float_as_uint(lg[i]), __float_as_uint(lg[i + 8]), false, false); c8[i] = __uint_as_float(rr[0]) + __uint_as_float(rr[1]); }
#pragma unroll
                for (int i = 0; i < 4; ++i) { auto rr = __builtin_amdgcn_permlane16_swap(__float_as_uint(c8[i]), __float_as_uint(c8[i + 4]), false, false); d[i] = row16_sum(__uint_as_float(rr[0]) + __uint_as_float(rr[1])); }
                float mx = fmaxf(fmaxf(d[0], d[1]), fmaxf(d[2], d[3]));
                { auto rr = __builtin_amdgcn_permlane16_swap(__float_as_uint(mx), __float_as_uint(mx), false, false); mx = fmaxf(__uint_as_float(rr[0]), __uint_as_float(rr[1])); }
                { auto rr = __builtin_amdgcn_permlane32_swap(__float_as_uint(mx), __float_as_uint(mx), false, false); mx = fmaxf(__uint_as_float(rr[0]), __uint_as_float(rr[1])); }
#pragma unroll
                for (int i = 0; i < 4; ++i) d[i] = __expf(d[i] - mx);
                const float sum = xor32_sum(xor16_sum((d[0] + d[1]) + (d[2] + d[3])));
                const int li = lane & 15, ex = 4 * (lane >> 4) + li;
                float mine = li == 0 ? d[0] : li == 1 ? d[1] : li == 2 ? d[2] : d[3];
                mine = mine / sum;
                if (li < 4) { if (isctx) ((float*)(ws + WS_AFFC))[((size_t)b * 16 + ex) * 256 + r] = mine; else ((float*)(ws + WS_AFFL))[((size_t)b * 16 + ex) * 8192 + (r - CTXL)] = mine; }
            }
            SEAM(P + 4);
        }
        if (IN(P + 5)) { LAYER_PTRS
            const int tid = opaque_tid(), lane = tid & 63; (void)tid; (void)lane;
            const int nun = l == 0 ? 64 : 32;
            for (int u = vcu; u < nun; u += G) topk_unit(A, RT, u >= 32, (u >> 4) & 1, u & 15, L, tid);
            SEAM(P + 5);
        }
        if (IN(P + 6)) { LAYER_PTRS
            const int tid = opaque_tid(), lane = tid & 63; (void)tid; (void)lane;
            const int* IDXROW = (const int*)(ws + WS_IDXROW); unsigned char* XG = ws + WS_XG;
            const int nyr = 16 * RT * 256;
            for (int y0 = gw; y0 < nyr; y0 += 9 * NGW) { int src[9]; v4u a[9];
#pragma unroll
                for (int q = 0; q < 9; ++q) { const int y = y0 + q * NGW; src[q] = y < nyr ? IDXROW[y] : -1; }
                __builtin_amdgcn_sched_barrier(0);
#pragma unroll
                for (int q = 0; q < 9; ++q) { a[q] = (v4u){0u, 0u, 0u, 0u}; if (src[q] >= 0) a[q] = ((const v4u*)((const unsigned char*)H2 + (size_t)src[q] * DM))[lane]; }
                __builtin_amdgcn_sched_barrier(0);
#pragma unroll
                for (int q = 0; q < 9; ++q) { const int y = y0 + q * NGW; if (y < nyr) ((v4u*)(XG + (size_t)y * DM))[lane] = a[q]; } }
            SEAM(P + 6);
        }
        if (IN(P + 7)) { LAYER_PTRS
            SchedP6 S{(const char*)(ws + WS_XG), (const char*)(wl + WO_WGU), RT, G, bx}; EpiSwiGLU E{ws + WS_HID};
            pg8::gemm8_phase<EpiSwiGLU, SchedP6>(L, DM / 2, DM / 2, DM / 2, S, E);
            SEAM(P + 7);
        }
        if (IN(P + 8)) { LAYER_PTRS
            SchedP7 S{(const char*)(ws + WS_HID), (const char*)(wl + WO_WD), RT, G, bx}; EpiDown E{(bf16_t*)(ws + WS_Y), (const float*)(ws + WS_SCORE)};
            pg8::gemm8_phase<EpiDown, SchedP7>(L, EH / 2, EH / 2, EH / 2, S, E);
            if (l == 0) { SchedP7c S2{(const char*)(ws + WS_HID), (const char*)(wl + WO_WD), G, bx}; EpiDownPart E2{(bf16_t*)(ws + WS_XG), (const float*)(ws + WS_SCORE)};
              pg8::gemm8_phase<EpiDownPart, SchedP7c>(L, 256, EH / 2, EH / 2, S2, E2); }
            SEAM(P + 8);
        }
        if (IN(P + 9)) { LAYER_PTRS
            const int tid = opaque_tid(), lane = tid & 63; (void)tid; (void)lane;
            const int* INV = (const int*)(ws + WS_INV); const bf16_t* Y = (const bf16_t*)(ws + WS_Y);
#define P8_INV(R_) (lane < 16 ? INV[((size_t)((R_) / RB) * 16 + lane) * RB + (R_) % RB] : -1)
#define P8_YISSUE(INVV, W, KEEP, REST) do { unsigned mk_ = (unsigned)(__ballot((INVV) >= 0) & 0xffffull); \
                _Pragma("unroll") for (int k = 0; k < 4; ++k) { const bool have = mk_ != 0u; const int e = have ? __builtin_ctz(mk_) : 0; mk_ &= mk_ - 1u; \
                    const int yr = have ? __builtin_amdgcn_readlane((INVV), e) : 0; const v2u* yp = (const v2u*)(Y + (size_t)yr * DM) + lane; KEEP[k] = have ? 0xffffffffu : 0u;     \
                    _Pragma("unroll") for (int j = 0; j < 4; ++j) W[k][j] = yp[64 * j]; } REST = mk_; } while (0)
            Row xn; int invn, invf; v2u wn[4][4]; unsigned kn[4], restn;
#define P8_ROW(k) ((k) < 8 ? (((gw * 8 + (k)) >> 13) * RB + CTXL + ((gw * 8 + (k)) & 8191)) : ((gw >> 8) * RB + (gw & 255)))
            const int nit = 8 + ((l == 0 && gw < 512) ? 1 : 0);
            { const int R0 = P8_ROW(0); xn = row_load_bf16(X1 + (size_t)R0 * DM, lane); invn = P8_INV(R0); P8_YISSUE(invn, wn, kn, restn); const int R1 = P8_ROW(1); invf = P8_INV(R1); }
            int curm; NormP np; f32x4 g2v[4];
#define P8_PARAMS(mr_) do { const float* m_ = MODL + (size_t)(mr_) * 6144; \
                _Pragma("unroll") for (int j = 0; j < 4; ++j) g2v[j] = ((const f32x4*)(m_ + 5120))[lane + 64 * j]; \
                if (l + 1 < DEPTH) { const float* m1 = MOD + ((size_t)(l + 1) * 3 + (mr_)) * 6144; np = normp_load(A->in[I_N1G] + (l + 1) * DM, m1, m1 + 1024, lane); } \
                else { _Pragma("unroll") for (int j = 0; j < 4; ++j) { np.a[j] = ((const f32x4*)A->in[I_FG])[lane + 64 * j]; np.h[j] = np.a[j]; } } \
                __builtin_amdgcn_sched_barrier(0); } while (0)
            { curm = (gw * 8) >> 13; P8_PARAMS(curm); }
            for (int k9 = 0; k9 < nit; ++k9) { const int R = P8_ROW(k9); const int b = R / RB, r = R % RB; const bool isctx = r < CTXL;
                Row x = xn; const int myinv = invn; v2u w0[4][4]; unsigned k0[4]; unsigned msk = restn;
#pragma unroll
                for (int k = 0; k < 4; ++k) { k0[k] = kn[k];
#pragma unroll
                    for (int j = 0; j < 4; ++j) w0[k][j] = wn[k][j]; }
                if (k9 + 1 < nit) { const int Rn = P8_ROW(k9 + 1); xn = row_load_bf16(X1 + (size_t)Rn * DM, lane); invn = invf; P8_YISSUE(invn, wn, kn, restn); const int Rf = P8_ROW(min(k9 + 2, nit - 1)); invf = P8_INV(Rf); }
                if (l == 1 && isctx) continue;
                const float* m = MODL + (size_t)(isctx ? 2 : b) * 6144;
                Row s;
#pragma unroll
                for (int j = 0; j < 4; ++j) s.v[j] = (f32x4){0.f, 0.f, 0.f, 0.f};
#pragma unroll
                for (int k = 0; k < 4; ++k)
#pragma unroll
                    for (int j = 0; j < 4; ++j) s.v[j] += (f32x4){bflo(w0[k][j].x & k0[k]), bfhi(w0[k][j].x & k0[k]), bflo(w0[k][j].y & k0[k]), bfhi(w0[k][j].y & k0[k])};
                if (isctx) {
#pragma unroll
                    for (int j = 0; j < 4; ++j) s.v[j] = (f32x4){0.f, 0.f, 0.f, 0.f};
                    msk = 0u; unsigned mk = (unsigned)(__ballot(myinv >= 0) & 0xffffull); const bf16_t* YP = (const bf16_t*)(ws + WS_XG);
                    while (mk) { const int e = __builtin_ctz(mk); mk &= mk - 1u; const int yr = __builtin_amdgcn_readlane(myinv, e); const int ex = yr / 2304, rr = yr % 2304 - 2048;
                        v2u t[4][4];
#pragma unroll
                        for (int kq = 0; kq < 4; ++kq) { const v2u* yp = (const v2u*)(YP + ((size_t)(kq * 16 + ex) * 256 + rr) * DM) + lane;
#pragma unroll
                            for (int j = 0; j < 4; ++j) t[kq][j] = yp[64 * j]; }
                        __builtin_amdgcn_sched_barrier(0);
#pragma unroll
                        for (int kq = 0; kq < 4; ++kq)
#pragma unroll
                            for (int j = 0; j < 4; ++j) s.v[j] += (f32x4){bflo(t[kq][j].x), bfhi(t[kq][j].x), bflo(t[kq][j].y), bfhi(t[kq][j].y)}; } }
                while (msk) {
                    v2u w[4][4];
#pragma unroll
                    for (int k = 0; k < 4; ++k) { const bool have = msk != 0u; const int e = have ? __builtin_ctz(msk) : 0; msk &= msk - 1u; if (!have) msk = 0u;
                        const int yr = have ? __builtin_amdgcn_readlane(myinv, e) : 0;
                        const v2u* yp = (const v2u*)(Y + (size_t)yr * DM) + lane; const unsigned keep = have ? 0xffffffffu : 0u;
#pragma unroll
                        for (int j = 0; j < 4; ++j) { v2u t = yp[64 * j]; t.x &= keep; t.y &= keep; w[k][j] = t; } }
#pragma unroll
                    for (int k = 0; k < 4; ++k)
#pragma unroll
                        for (int j = 0; j < 4; ++j) s.v[j] += (f32x4){bflo(w[k][j].x), bfhi(w[k][j].x), bflo(w[k][j].y), bfhi(w[k][j].y)};
                }
                { const int mr = isctx ? 2 : b; if (mr != curm) { curm = mr; P8_PARAMS(mr); } }
#pragma unroll
                for (int j = 0; j < 4; ++j) x.v[j] += g2v[j] * s.v[j];
                const float rstd = row_rstd(x);
                if (l + 1 < DEPTH) { row_store_bf16(XR + (size_t)R * DM, x, lane);
                    const Row y = row_normmod_p(x, rstd, np); row_store_bf16(HN + (size_t)R * DM, y, lane); if (!isctx) row_store_fp8(ws + WS_HN8 + (size_t)R * DM, y, lane); }
                else { Row y;
#pragma unroll
                    for (int j = 0; j < 4; ++j) y.v[j] = x.v[j] * rstd * np.a[j];
                    row_store(A->out + ((size_t)b * SEQ + (r - CTXL)) * DM, y, lane); }
            }
            SEAM(P + 9);
        }
    }
#undef IN
#undef SEAM
}

extern "C" void kernel_launch(void* const* d_in, const int* in_sizes, int n_in, void* d_out, int out_size, void* d_ws, size_t ws_size, hipStream_t stream) {
    static int grid = 0;
    if (grid == 0) {
        if (n_in != 28 || out_size != NB * SEQ * DM || ws_size < WS_END) { fprintf(stderr, "kernel_launch: unexpected shapes (n_in %d, out %d, ws %zu < %zu)\n", n_in, out_size, ws_size, (size_t)WS_END); grid = -1; return; }
        int dev = 0, cus = 0, per_cu = 0;
        if (hipGetDevice(&dev) != hipSuccess || hipDeviceGetAttribute(&cus, hipDeviceAttributeMultiprocessorCount, dev) != hipSuccess) { grid = -1; return; }
        if (hipFuncSetAttribute((const void*)fwd_kernel, hipFuncAttributeMaxDynamicSharedMemorySize, LDS_BYTES) != hipSuccess) { fprintf(stderr, "kernel_launch: hipFuncSetAttribute failed\n"); grid = -1; return; }
        if (hipOccupancyMaxActiveBlocksPerMultiprocessor(&per_cu, (const void*)fwd_kernel, 512, LDS_BYTES) != hipSuccess || per_cu < 1) fprintf(stderr, "kernel_launch: occupancy query reports %d blocks/CU\n", per_cu);
        (void)hipGetLastError();
        if (cus != 256) { fprintf(stderr, "kernel_launch: built for 256 CUs, device has %d\n", cus); grid = -1; return; }
        grid = 256;
    }
    if (grid < 0) return;
    (void)hipMemsetAsync((char*)d_ws + WS_CTL, 0, CTL_ZERO_BYTES, stream);
    Args a{};
    for (int i = 0; i < 28; ++i) a.in[i] = (const float*)d_in[i];
    a.out = (float*)d_out; a.ws = (unsigned char*)d_ws;
#if MK_PER_PHASE
    for (int p = 0; p < NPHASE; ++p) { a.ph_lo = p; a.ph_hi = p + 1; hipLaunchKernelGGL(fwd_kernel, dim3(grid), dim3(512), LDS_BYTES, stream, a); }
#elif defined(PROBE_REPEAT)
    { const int reps[] = {PROBE_REPEAT}; const int nr = sizeof(reps) / sizeof(int); int lo = 0;
      for (int i = 0; i <= nr; ++i) { a.ph_lo = lo; a.ph_hi = i < nr ? reps[i] + 1 : NPHASE; a.li = i; hipLaunchKernelGGL(fwd_kernel, dim3(grid), dim3(512), LDS_BYTES, stream, a); if (i < nr) lo = reps[i]; } }
#else
    a.ph_lo = 0; a.ph_hi = NPHASE; hipLaunchKernelGGL(fwd_kernel, dim3(grid), dim3(512), LDS_BYTES, stream, a);
#endif
}
```

```cpp
#include <hip/hip_runtime.h>
#include <hip/hip_bf16.h>
#include <cstdio>
#include <cstdint>
#include <cmath>

#ifndef MK_PER_PHASE
#define MK_PER_PHASE 0
#endif

constexpr int DM = 1024, NB = 2, SEQ = 8192, CTXL = 256, RB = SEQ + CTXL, NR = NB * RB, DEPTH = 2;
constexpr int IN_W = 6656, NEXP = 16, EH = 2048, TPB = RB / 256  ;
constexpr float EPS = 1e-6f, LOG2E = 1.4426950408889634f;
constexpr float C2A = 0.125f * LOG2E;
constexpr float C2B = 0.17677669529663687f * LOG2E;
constexpr int NPHASE = 2 + 10 * DEPTH;

constexpr size_t MiB = 1u << 20, KiB128 = 131072;
constexpr size_t WS_CTL = 0, CTL_ZERO_BYTES = 1 * MiB;
constexpr size_t WS_MOD = 1 * MiB;
constexpr size_t WS_AFFL = 2 * MiB, WS_AFFC = 3 * MiB;
constexpr size_t WS_IDXROW = 4 * MiB, WS_SCORE = 4 * MiB + 512 * 1024, WS_INV = 5 * MiB;
constexpr size_t WS_GPC = 8 * MiB;
constexpr size_t WS_W0 = 24 * MiB, W_LAYER = 215 * MiB;
constexpr size_t WO_WING = 8 * MiB  , WO_WIN = 0  , WO_WB = 13 * MiB, WO_WO4 = 15 * MiB, WO_WGU = 23 * MiB, WO_WD = 151 * MiB;
constexpr size_t WS_HN = 454 * MiB;
constexpr size_t WS_QKV = 487 * MiB;
constexpr int PQ = 3136;
constexpr int C_QA = 0, C_KA = 256, C_VA = 512, C_QB = 768, C_KB = 1280, C_VB = 1792, C_QD = 2048, C_KD = 2304, C_VD = 2432, C_GU = 2560, C_GV = 2816;
constexpr size_t WS_Y = WS_QKV;
constexpr size_t WS_KNB = 512 * 1024;
constexpr size_t WS_GT = 589 * MiB;
constexpr size_t WS_YS = 721 * MiB;
constexpr size_t WS_HID = WS_GT;
constexpr size_t WS_X1 = 754 * MiB, WS_XR = 820 * MiB, WS_H2 = 886 * MiB, WS_XG = 919 * MiB, WS_MRG = WS_H2, WS_PART = WS_XG  , WS_HN8 = 991 * MiB  , WS_END = 1008 * MiB;
static_assert(WS_QKV + (size_t)NR * PQ * 2 <= WS_GT && WS_Y + (size_t)16 * 9 * 256 * 1024 * 2 <= WS_GT && WS_HID + (size_t)16 * 9 * 256 * 2048 * 2 <= WS_X1 && WS_YS + (size_t)NR * 1024 * 2 <= WS_X1, "ws map");

constexpr int CW_BAR = 4096;

constexpr int RING_BYTES = 131072, LDSCTL_OFF = RING_BYTES, MISC_OFF = LDSCTL_OFF + 320, LDS_BYTES = 147456;

#define GAS __attribute__((address_space(1)))
#define LAS __attribute__((address_space(3)))
typedef unsigned short bf16_t;
typedef unsigned v4u __attribute__((ext_vector_type(4)));
typedef unsigned v2u __attribute__((ext_vector_type(2)));
typedef float f32x4 __attribute__((ext_vector_type(4)));
typedef float f32x2 __attribute__((ext_vector_type(2)));
typedef float f32x16 __attribute__((ext_vector_type(16)));
typedef short bf16x8 __attribute__((ext_vector_type(8)));
typedef short s16x4 __attribute__((ext_vector_type(4)));
typedef __bf16 bf16x2_t __attribute__((ext_vector_type(2)));
#define RLX_AGENT __ATOMIC_RELAXED, __HIP_MEMORY_SCOPE_AGENT
#define LDS_WAIT() asm volatile("s_waitcnt lgkmcnt(0)" ::: "memory")
#define VM_WAIT() asm volatile("s_waitcnt vmcnt(0)" ::: "memory")

__device__ __forceinline__ int opaque_tid() { int t = threadIdx.x; asm volatile("" : "+v"(t)); return t; }
__device__ __forceinline__ int opaque_s(int v) { asm volatile("" : "+s"(v)); return v; }
__device__ __forceinline__ unsigned char* opaque_ptr(unsigned char* p) { asm volatile("" : "+s"(p)); return p; }
__device__ __forceinline__ unsigned cvtpk(float lo, float hi) { f32x2 v = {lo, hi}; bf16x2_t b = __builtin_convertvector(v, bf16x2_t); return __builtin_bit_cast(unsigned, b); }
__device__ __forceinline__ float bflo(unsigned w) { return __uint_as_float(w << 16); }
__device__ __forceinline__ float bfhi(unsigned w) { return __uint_as_float(w & 0xffff0000u); }
__device__ __forceinline__ float bf2f(bf16_t h) { return __uint_as_float((unsigned)h << 16); }
__device__ __forceinline__ bf16_t f2bf(float f) { return (bf16_t)(cvtpk(f, 0.f) & 0xffffu); }
__device__ __forceinline__ float sigmoidf_(float x) { return __builtin_amdgcn_rcpf(1.0f + __builtin_amdgcn_exp2f(-x * LOG2E)); }
__device__ __forceinline__ float siluf_(float x) { return x * sigmoidf_(x); }
__device__ __forceinline__ float gelu_tanh(float x) { const float z = 0.7978845608028654f * (x + 0.044715f * x * x * x); return x * __builtin_amdgcn_rcpf(1.0f + __builtin_amdgcn_exp2f(-2.0f * LOG2E * z)); }
template <int CTRL> __device__ __forceinline__ float dpp_f(float v) { return __builtin_bit_cast(float, __builtin_amdgcn_update_dpp(0, __builtin_bit_cast(int, v), CTRL, 0xf, 0xf, true)); }
__device__ __forceinline__ float row16_sum(float v) { v += dpp_f<0xB1>(v); v += dpp_f<0x4E>(v); v += dpp_f<0x141>(v); v += dpp_f<0x140>(v); return v; }
__device__ __forceinline__ float xor16_sum(float v) { auto rr = __builtin_amdgcn_permlane16_swap(__float_as_uint(v), __float_as_uint(v), false, false); return __uint_as_float(rr[0]) + __uint_as_float(rr[1]); }
__device__ __forceinline__ float xor32_sum(float v) { auto rr = __builtin_amdgcn_permlane32_swap(__float_as_uint(v), __float_as_uint(v), false, false); return __uint_as_float(rr[0]) + __uint_as_float(rr[1]); }
__device__ __forceinline__ float half32_sum(float v) { return xor16_sum(row16_sum(v)); }
__device__ __forceinline__ float wave_sum(float v) { return xor32_sum(xor16_sum(row16_sum(v))); }
__device__ __forceinline__ float wave_max(float v) { v = fmaxf(v, dpp_f<0xB1>(v)); v = fmaxf(v, dpp_f<0x4E>(v)); v = fmaxf(v, dpp_f<0x141>(v)); v = fmaxf(v, dpp_f<0x140>(v));
    { auto rr = __builtin_amdgcn_permlane16_swap(__float_as_uint(v), __float_as_uint(v), false, false); v = fmaxf(__uint_as_float(rr[0]), __uint_as_float(rr[1])); }
    { auto rr = __builtin_amdgcn_permlane32_swap(__float_as_uint(v), __float_as_uint(v), false, false); v = fmaxf(__uint_as_float(rr[0]), __uint_as_float(rr[1])); } return v; }
__device__ __forceinline__ unsigned pk8(float a, float b, float c, float d) { unsigned w = 0u; w = __builtin_amdgcn_cvt_pk_fp8_f32(a, b, w, false); w = __builtin_amdgcn_cvt_pk_fp8_f32(c, d, w, true); return w; }
__device__ __forceinline__ void st8(bf16_t* p, const float* v) { v4u w; w.x = cvtpk(v[0], v[1]); w.y = cvtpk(v[2], v[3]); w.z = cvtpk(v[4], v[5]); w.w = cvtpk(v[6], v[7]); *(v4u*)p = w; }

__device__ const float INV16R[16] = {0.15915494309189535f, 0.08949940160889101f, 0.050329212104487035f, 0.0283021958306234f, 0.015915494309189534f, 0.008949940160889102f, 0.005032921210448704f, 0.00283021958306234f,
                                     0.0015915494309189536f, 0.0008949940160889102f, 0.0005032921210448703f, 0.00028302195830623395f, 0.00015915494309189535f, 8.949940160889102e-05f, 5.0329212104487035e-05f, 2.8302195830623396e-05f};
__device__ const float INV8R[8] = {0.15915494309189535f, 0.050329212104487035f, 0.015915494309189534f, 0.005032921210448704f, 0.0015915494309189536f, 0.0005032921210448703f, 0.00015915494309189535f, 5.0329212104487035e-05f};
__device__ __forceinline__ void sincos_rev(float rev, float& s, float& c) { const float f = __builtin_amdgcn_fractf(rev); s = __builtin_amdgcn_sinf(f); c = __builtin_amdgcn_cosf(f); }

namespace pg8 {
#define PG8_LAS __attribute__((address_space(3)))
constexpr int BM = 256, BK = 64, HALF = 128, HTB = HALF * BK * 2, STAGE_BYTES = 8 * HTB, NXCD = 8, WGM = 8;
__host__ __device__ __forceinline__ int lds_byte(int r, int c) { const int st = (r >> 4) * 2 + (c >> 5), rr = r & 15, cc = c & 31, ob = rr * 64 + cc * 2; return st * 1024 + (ob ^ (((ob >> 9) & 1) << 5)); }
__host__ __device__ __forceinline__ void stage_rc(int b, int& R, int& C) { const int st = b / 1024, sb = b % 1024, swz = sb ^ (((sb >> 9) & 1) << 5); R = (st >> 1) * 16 + swz / 64; C = (st & 1) * 32 + (swz % 64) / 2; }
__host__ __device__ __forceinline__ int perm32(int rho) { const int n = rho >> 4, i = rho & 15; return 8 * (i >> 2) + 4 * n + (i & 3); }

struct Unit { int pm, pn; const char* a; const char* b; };
__device__ __forceinline__ const char* uptr(const char* p) { const unsigned long long v = (unsigned long long)p; const unsigned lo = __builtin_amdgcn_readfirstlane((unsigned)v), hi = __builtin_amdgcn_readfirstlane((unsigned)(v >> 32)); return (const char*)(((unsigned long long)hi << 32) | lo); }
__device__ __forceinline__ void uunit(Unit& u) { u.pm = __builtin_amdgcn_readfirstlane(u.pm); u.pn = __builtin_amdgcn_readfirstlane(u.pn); u.a = uptr(u.a); u.b = uptr(u.b); }

typedef int v8i __attribute__((ext_vector_type(8)));
__device__ __forceinline__ void glds16s(const char* sbase, unsigned voff, unsigned lds_dst) { unsigned keep;
    asm volatile("s_mov_b32 %0, m0\n\ts_mov_b32 m0, %3\n\ts_nop 0\n\tglobal_load_lds_dwordx4 %1, %2\n\ts_mov_b32 m0, %0" : "=&s"(keep) : "v"(voff), "s"(sbase), "s"(lds_dst) : "memory"); }
__device__ __forceinline__ void rect_order(int L, int nM, int nN, int& im, int& in) {
    const int nwg = nM * nN; int wgid = L; { const int q = nwg / NXCD, r = nwg % NXCD, xcd = wgid % NXCD, off = wgid / NXCD; wgid = (xcd < r ? xcd * (q + 1) : r * (q + 1) + (xcd - r) * q) + off; }
    const int nig = WGM * nN, gid = wgid / nig, fm = gid * WGM, gsz = (nM - fm) < WGM ? (nM - fm) : WGM;
    im = fm + ((wgid % nig) % gsz); in = (wgid % nig) / gsz;
}

template <class Epi, class Sched>
__device__ __forceinline__ void gemm_phase(PG8_LAS unsigned char* lds, const int K, const int lda, const int ldb, const Sched& S, const Epi& E) {
    const int tid = opaque_tid(), wid = __builtin_amdgcn_readfirstlane(tid >> 6), lane = tid & 63, wr = wid >> 2, wc = wid & 3, fr = lane & 15, fq = lane >> 4;
    const int nt = K / BK;
    unsigned voffA[2], voffB[2];
#pragma unroll
    for (int i = 0; i < 2; ++i) { int R, C; stage_rc(tid * 16 + i * 8192, R, C); const int Rb = Epi::PERM ? ((R & ~31) + perm32(R & 31)) : R;
        voffA[i] = (unsigned)(R * lda + C) * 2u; voffB[i] = (unsigned)(Rb * ldb + C) * 2u; }
    const size_t kstep = (size_t)(BK * 2);
    const size_t hA = (size_t)HALF * lda * 2, hB = (size_t)HALF * ldb * 2;
    const unsigned ldsw = (unsigned)wid * 1024u, ldsbase = (unsigned)(size_t)lds;
    const int aoff = lds_byte(wr * 64 + fr, fq * 8), boff = lds_byte(wc * 32 + fr, fq * 8);
#define PG8_SA(b, h) (((b) * 2 + (h)) * HTB)
#define PG8_SB(b, h) ((4 + (b) * 2 + (h)) * HTB)
#define PG8_STAGE(bufoff, gbase, voff) do { _Pragma("unroll") for (int _i = 0; _i < 2; ++_i) \
        glds16s(uptr((const char*)(gbase)), (voff)[_i], (unsigned)__builtin_amdgcn_readfirstlane(ldsbase + (unsigned)(bufoff) + ldsw + _i * 8192u)); } while (0)
#define PG8_LDA(dst, b, h) do { _Pragma("unroll") for (int m = 0; m < 4; ++m) _Pragma("unroll") for (int k = 0; k < 2; ++k) dst[m][k] = *(const PG8_LAS bf16x8*)(lds + PG8_SA(b, h) + aoff + m * 2048 + k * 1024); } while (0)
#define PG8_LDB(dst, b, h) do { _Pragma("unroll") for (int n = 0; n < 2; ++n) _Pragma("unroll") for (int k = 0; k < 2; ++k) dst[n][k] = *(const PG8_LAS bf16x8*)(lds + PG8_SB(b, h) + boff + n * 2048 + k * 1024); } while (0)
#define PG8_MMA(ai, bj, At, Bt) do { __builtin_amdgcn_s_setprio(1); _Pragma("unroll") for (int m = 0; m < 4; ++m) _Pragma("unroll") for (int n = 0; n < 2; ++n) _Pragma("unroll") for (int k = 0; k < 2; ++k) \
        acc[ai][bj][m][n] = __builtin_amdgcn_mfma_f32_16x16x32_bf16(Bt[n][k], At[m][k], acc[ai][bj][m][n], 0, 0, 0); __builtin_amdgcn_s_setprio(0); } while (0)
#define PG8_WAIT_V(n) asm volatile("s_waitcnt vmcnt(" #n ")" ::: "memory")
#define PG8_WAIT_L(n) asm volatile("s_waitcnt lgkmcnt(" #n ")" ::: "memory")
#define PG8_BAR __builtin_amdgcn_s_barrier()
#define PG8_SCHED __builtin_amdgcn_sched_barrier(0)
    Unit cur, nxt; int ui = 0;
    if (!S.next(0, cur)) return;
    uunit(cur);
    f32x4 acc[2][2][4][2];
#pragma unroll
    for (int a = 0; a < 2; ++a)
#pragma unroll
        for (int b = 0; b < 2; ++b)
#pragma unroll
            for (int m = 0; m < 4; ++m)
#pragma unroll
                for (int n = 0; n < 2; ++n) acc[a][b][m][n] = (f32x4){0.f, 0.f, 0.f, 0.f};
    bf16x8 At[4][2], B0[2][2], B1[2][2];
    const char* cA = cur.a; const char* cB = cur.b;
    PG8_STAGE(PG8_SB(0, 0), cB, voffB); PG8_STAGE(PG8_SB(0, 1), cB + hB, voffB); PG8_STAGE(PG8_SA(0, 0), cA, voffA); PG8_STAGE(PG8_SA(0, 1), cA + hA, voffA);
    if (wr == 1) PG8_BAR;
    PG8_WAIT_V(2); PG8_BAR;
    PG8_STAGE(PG8_SB(1, 0), cB + kstep, voffB); PG8_STAGE(PG8_SA(1, 0), cA + kstep, voffA); PG8_STAGE(PG8_SB(1, 1), cB + hB + kstep, voffB);
    PG8_WAIT_V(6); PG8_BAR;
    for (;;) {
        const bool has_next = S.next(ui + 1, nxt); if (has_next) uunit(nxt);
        const char* nA = has_next ? nxt.a : cA; const char* nB = has_next ? nxt.b : cB;
        for (int t = 0; t < nt; t += 2) {
            const bool last = (t == nt - 2);
            const char* a1 = cA + (size_t)(t + 1) * kstep;
            const char* a2 = last ? nA : cA + (size_t)(t + 2) * kstep; const char* b2 = last ? nB : cB + (size_t)(t + 2) * kstep;
            const char* a3 = a2 + kstep; const char* b3 = b2 + kstep;
            PG8_LDB(B0, 0, 0); PG8_LDB(B1, 0, 1); PG8_SCHED; PG8_LDA(At, 0, 0); PG8_STAGE(PG8_SA(1, 1), a1 + hA, voffA);
            PG8_WAIT_V(8); PG8_WAIT_L(0); PG8_BAR; PG8_MMA(0, 0, At, B0); PG8_MMA(0, 1, At, B1); PG8_BAR; PG8_SCHED;
            PG8_LDA(At, 0, 1); PG8_STAGE(PG8_SB(0, 0), b2, voffB); PG8_STAGE(PG8_SB(0, 1), b2 + hB, voffB); PG8_STAGE(PG8_SA(0, 0), a2, voffA);
            PG8_WAIT_V(8); PG8_WAIT_L(0); PG8_BAR; PG8_MMA(1, 0, At, B0); PG8_MMA(1, 1, At, B1); PG8_BAR; PG8_SCHED;
            PG8_LDB(B0, 1, 0); PG8_LDB(B1, 1, 1); PG8_SCHED; PG8_LDA(At, 1, 0); PG8_STAGE(PG8_SA(0, 1), a2 + hA, voffA);
            PG8_WAIT_V(8); PG8_WAIT_L(0); PG8_BAR; PG8_MMA(0, 0, At, B0); PG8_MMA(0, 1, At, B1); PG8_BAR; PG8_SCHED;
            PG8_LDA(At, 1, 1); PG8_STAGE(PG8_SB(1, 0), b3, voffB); PG8_STAGE(PG8_SB(1, 1), b3 + hB, voffB); PG8_STAGE(PG8_SA(1, 0), a3, voffA);
            PG8_WAIT_V(8); PG8_WAIT_L(0); PG8_BAR; PG8_MMA(1, 0, At, B0); PG8_MMA(1, 1, At, B1); PG8_BAR; PG8_SCHED;
        }
        if (wr == 0) PG8_BAR;
        { const int t2 = opaque_tid(), l2 = t2 & 63; E(acc, cur, wr, wc, l2 & 15, l2 >> 4); }
        if (!has_next) break;
        if (!Epi::keep_acc(cur)) {
#pragma unroll
        for (int a = 0; a < 2; ++a)
#pragma unroll
            for (int b = 0; b < 2; ++b)
#pragma unroll
                for (int m = 0; m < 4; ++m)
#pragma unroll
                    for (int n = 0; n < 2; ++n) acc[a][b][m][n] = (f32x4){0.f, 0.f, 0.f, 0.f};
        }
        cur = nxt; cA = nA; cB = nB; ++ui;
        if (wr == 1) PG8_BAR;
    }
    PG8_WAIT_V(0);
    PG8_BAR;
#undef PG8_SA
#undef PG8_SB
#undef PG8_STAGE
#undef PG8_LDA
#undef PG8_LDB
#undef PG8_MMA
#undef PG8_WAIT_V
#undef PG8_WAIT_L
#undef PG8_BAR
#undef PG8_SCHED
}
template <class Epi, class Sched>
__device__ __forceinline__ void gemm8_phase(PG8_LAS unsigned char* lds, const int K, const int lda, const int ldb, const Sched& S, const Epi& E) {
    const int tid = opaque_tid(), wid = __builtin_amdgcn_readfirstlane(tid >> 6), lane = tid & 63, wr = wid >> 2, wc = wid & 3, fr = lane & 15, fq = lane >> 4;
    const int nt = opaque_s(K / BK);
    unsigned voffA[2], voffB[2];
#pragma unroll
    for (int i = 0; i < 2; ++i) { int R, C; stage_rc(tid * 16 + i * 8192, R, C); const int Rb = Epi::PERM ? ((R & ~31) + perm32(R & 31)) : R;
        voffA[i] = (unsigned)(R * lda + C) * 2u; voffB[i] = (unsigned)(Rb * ldb + C) * 2u; }
    const size_t kstep = (size_t)(BK * 2);
    const size_t hA = (size_t)HALF * lda * 2, hB = (size_t)HALF * ldb * 2;
    const unsigned ldsw = (unsigned)wid * 1024u, ldsbase = (unsigned)(size_t)lds;
    const int fcol = (fq >> 1) * 32 + (fq & 1) * 16;
    const int aoff = lds_byte(wr * 64 + fr, fcol), boff = lds_byte(wc * 32 + fr, fcol);
#define PG8_SA(b, h) (((b) * 2 + (h)) * HTB)
#define PG8_SB(b, h) ((4 + (b) * 2 + (h)) * HTB)
#define PG8_STAGE(bufoff, gbase, voff) do { _Pragma("unroll") for (int _i = 0; _i < 2; ++_i) \
        glds16s(uptr((const char*)(gbase)), (voff)[_i], (unsigned)__builtin_amdgcn_readfirstlane(ldsbase + (unsigned)(bufoff) + ldsw + _i * 8192u)); } while (0)
#define PG8_LDA(dst, b, h) do { _Pragma("unroll") for (int m = 0; m < 4; ++m) { const v4u lo_ = *(const PG8_LAS v4u*)(lds + PG8_SA(b, h) + aoff + m * 2048), hi_ = *(const PG8_LAS v4u*)(lds + PG8_SA(b, h) + aoff + m * 2048 + 16); dst[m] = (v8i){(int)lo_.x, (int)lo_.y, (int)lo_.z, (int)lo_.w, (int)hi_.x, (int)hi_.y, (int)hi_.z, (int)hi_.w}; } } while (0)
#define PG8_LDB(dst, b, h) do { _Pragma("unroll") for (int n = 0; n < 2; ++n) { const v4u lo_ = *(const PG8_LAS v4u*)(lds + PG8_SB(b, h) + boff + n * 2048), hi_ = *(const PG8_LAS v4u*)(lds + PG8_SB(b, h) + boff + n * 2048 + 16); dst[n] = (v8i){(int)lo_.x, (int)lo_.y, (int)lo_.z, (int)lo_.w, (int)hi_.x, (int)hi_.y, (int)hi_.z, (int)hi_.w}; } } while (0)
#define PG8_MMA(ai, bj, At, Bt) do { __builtin_amdgcn_s_setprio(1); _Pragma("unroll") for (int m = 0; m < 4; ++m) _Pragma("unroll") for (int n = 0; n < 2; ++n) \
        acc[ai][bj][m][n] = __builtin_amdgcn_mfma_scale_f32_16x16x128_f8f6f4(Bt[n], At[m], acc[ai][bj][m][n], 0, 0, 0, 0, 0, 0);     __builtin_amdgcn_s_setprio(0); } while (0)
#define PG8_WAIT_V(n) asm volatile("s_waitcnt vmcnt(" #n ")" ::: "memory")
#define PG8_WAIT_L(n) asm volatile("s_waitcnt lgkmcnt(" #n ")" ::: "memory")
#define PG8_BAR __builtin_amdgcn_s_barrier()
#define PG8_SCHED __builtin_amdgcn_sched_barrier(0)
    Unit cur, nxt; int ui = 0;
    if (!S.next(0, cur)) return;
    uunit(cur);
    f32x4 acc[2][2][4][2];
#pragma unroll
    for (int a = 0; a < 2; ++a)
#pragma unroll
        for (int b = 0; b < 2; ++b)
#pragma unroll
            for (int m = 0; m < 4; ++m)
#pragma unroll
                for (int n = 0; n < 2; ++n) acc[a][b][m][n] = (f32x4){0.f, 0.f, 0.f, 0.f};
    v8i At[4], B0[2], B1[2];
    const char* cA = cur.a; const char* cB = cur.b;
    PG8_STAGE(PG8_SB(0, 0), cB, voffB); PG8_STAGE(PG8_SB(0, 1), cB + hB, voffB); PG8_STAGE(PG8_SA(0, 0), cA, voffA); PG8_STAGE(PG8_SA(0, 1), cA + hA, voffA);
    if (wr == 1) PG8_BAR;
    PG8_WAIT_V(2); PG8_BAR;
    PG8_STAGE(PG8_SB(1, 0), cB + kstep, voffB); PG8_STAGE(PG8_SA(1, 0), cA + kstep, voffA); PG8_STAGE(PG8_SB(1, 1), cB + hB + kstep, voffB);
    PG8_WAIT_V(6); PG8_BAR;
    for (;;) {
        const bool has_next = S.next(ui + 1, nxt); if (has_next) uunit(nxt);
        const char* nA = has_next ? nxt.a : cA; const char* nB = has_next ? nxt.b : cB;
#pragma nounroll
        for (int t = 0; t < nt; t += 2) {
            const bool last = (t == nt - 2);
            const char* a1 = cA + (size_t)(t + 1) * kstep;
            const char* a2 = last ? nA : cA + (size_t)(t + 2) * kstep; const char* b2 = last ? nB : cB + (size_t)(t + 2) * kstep;
            const char* a3 = a2 + kstep; const char* b3 = b2 + kstep;
            PG8_LDB(B0, 0, 0); PG8_LDB(B1, 0, 1); PG8_SCHED; PG8_LDA(At, 0, 0); PG8_STAGE(PG8_SA(1, 1), a1 + hA, voffA);
            PG8_WAIT_V(8); PG8_WAIT_L(0); PG8_BAR; PG8_MMA(0, 0, At, B0); PG8_MMA(0, 1, At, B1); PG8_BAR; PG8_SCHED;
            PG8_LDA(At, 0, 1); PG8_STAGE(PG8_SB(0, 0), b2, voffB); PG8_STAGE(PG8_SB(0, 1), b2 + hB, voffB); PG8_STAGE(PG8_SA(0, 0), a2, voffA);
            PG8_WAIT_V(8); PG8_WAIT_L(0); PG8_BAR; PG8_MMA(1, 0, At, B0); PG8_MMA(1, 1, At, B1); PG8_BAR; PG8_SCHED;
            PG8_LDB(B0, 1, 0); PG8_LDB(B1, 1, 1); PG8_SCHED; PG8_LDA(At, 1, 0); PG8_STAGE(PG8_SA(0, 1), a2 + hA, voffA);
            PG8_WAIT_V(8); PG8_WAIT_L(0); PG8_BAR; PG8_MMA(0, 0, At, B0); PG8_MMA(0, 1, At, B1); PG8_BAR; PG8_SCHED;
            PG8_LDA(At, 1, 1); PG8_STAGE(PG8_SB(1, 0), b3, voffB); PG8_STAGE(PG8_SB(1, 1), b3 + hB, voffB); PG8_STAGE(PG8_SA(1, 0), a3, voffA);
            PG8_WAIT_V(8); PG8_WAIT_L(0); PG8_BAR; PG8_MMA(1, 0, At, B0); PG8_MMA(1, 1, At, B1); PG8_BAR; PG8_SCHED;
        }
        if (wr == 0) PG8_BAR;
        { const int t2 = opaque_tid(), l2 = t2 & 63; E(acc, cur, wr, wc, l2 & 15, l2 >> 4); }
        if (!has_next) break;
#pragma unroll
        for (int a = 0; a < 2; ++a)
#pragma unroll
            for (int b = 0; b < 2; ++b)
#pragma unroll
                for (int m = 0; m < 4; ++m)
#pragma unroll
                    for (int n = 0; n < 2; ++n) acc[a][b][m][n] = (f32x4){0.f, 0.f, 0.f, 0.f};
        cur = nxt; cA = nA; cB = nB; ++ui;
        if (wr == 1) PG8_BAR;
    }
    PG8_WAIT_V(0);
    PG8_BAR;
#undef PG8_SA
#undef PG8_SB
#undef PG8_STAGE
#undef PG8_LDA
#undef PG8_LDB
#undef PG8_MMA
#undef PG8_WAIT_V
#undef PG8_WAIT_L
#undef PG8_BAR
#undef PG8_SCHED
}
}

constexpr float W8S = 32.0f, W8I = 1.0f / 32.0f;
struct ModPtrs { const float* mod; };

struct EpiInProj {
    static constexpr bool PERM = true;
    static __device__ __forceinline__ bool keep_acc(const pg8::Unit&) { return false; }
    bf16_t *QKV, *GT;
    const float *q_gain, *k_gain, *gate_b; float* KNB;
    __device__ __forceinline__ void operator()(const f32x4 (&acc)[2][2][4][2], const pg8::Unit& u, int wr, int wc, int fr, int fq) const {
        const int pn = u.pn, pm = u.pm, jt = pm % TPB; const bool isctx = (jt == 0); const int t0 = (jt - 1) * 256;
        const int cb = 64 * wc + 8 * fq;
        const int rit0 = 64 * wr + fr;
        bf16_t* qrow = QKV + ((size_t)pm * 256 + rit0) * PQ;
#define ROWLOOP _Pragma("unroll") for (int ai = 0; ai < 2; ++ai) _Pragma("unroll") for (int m = 0; m < 4; ++m)
#define ROWVARS const int rit = 128 * ai + 16 * m + rit0; bf16_t* orow = qrow + (size_t)(128 * ai + 16 * m) * PQ; \
        float v[2][8]; _Pragma("unroll") for (int bj = 0; bj < 2; ++bj) _Pragma("unroll") for (int n = 0; n < 2; ++n) _Pragma("unroll") for (int j = 0; j < 4; ++j) v[bj][4 * n + j] = acc[ai][bj][m][n][j];
#define ROWEND __builtin_amdgcn_sched_barrier(0);
        if (pn == 0 || pn == 21 || pn == 22 || pn == 24) {
            const int oc = (pn == 0 ? C_QA : pn == 21 ? C_KA : pn == 22 ? C_VA : C_VB) + cb; const float sc = pn == 0 ? C2A : 1.0f;
            ROWLOOP { ROWVARS
#pragma unroll
                for (int bj = 0; bj < 2; ++bj) {
#pragma unroll
                    for (int j = 0; j < 8; ++j) v[bj][j] *= sc;
                    st8(orow + oc + 32 * bj, v[bj]); }
                ROWEND }
        } else if (pn == 3 || pn == 4) {
            const int oc = (pn == 3 ? C_GU : C_GV) + cb;
            ROWLOOP { ROWVARS
#pragma unroll
                for (int bj = 0; bj < 2; ++bj) {
#pragma unroll
                    for (int j = 0; j < 8; ++j) v[bj][j] = gelu_tanh(v[bj][j]);
                    st8(orow + oc + 32 * bj, v[bj]); }
                ROWEND }
        } else if (pn == 1 || pn == 23) {
            const int oc = (pn == 1 ? C_QB : C_KB) + 128 * wc + 8 * fq; const float sc = pn == 1 ? C2B : 1.0f;
            const f32x4 inv = *(const f32x4*)(INV8R + 4 * (fq & 1));
            const float zz[8] = {0.f, 0.f, 0.f, 0.f, 0.f, 0.f, 0.f, 0.f};
            float kn2[2] = {0.f, 0.f};
            ROWLOOP { ROWVARS
                if (pn == 23) {
#pragma unroll
                    for (int bj = 0; bj < 2; ++bj) { float ss = 0.f;
#pragma unroll
                        for (int j = 0; j < 8; ++j) ss += v[bj][j] * v[bj][j];
                        kn2[bj] = fmaxf(kn2[bj], xor32_sum(xor16_sum(ss))); } }
                const int t = t0 + rit; const float pos = (float)((fq < 2) ? (t >> 6) : (t & 63));
                float sn[4], cs[4];
#pragma unroll
                for (int p = 0; p < 4; ++p) { if (isctx) { sn[p] = 0.f; cs[p] = 1.f; } else sincos_rev(pos * inv[p], sn[p], cs[p]); }
#pragma unroll
                for (int bj = 0; bj < 2; ++bj) {
                    float o[8];
#pragma unroll
                    for (int p = 0; p < 4; ++p) { const float x0 = v[bj][2 * p], x1 = v[bj][2 * p + 1]; o[2 * p] = (x0 * cs[p] - x1 * sn[p]) * sc; o[2 * p + 1] = (x0 * sn[p] + x1 * cs[p]) * sc; }
                    st8(orow + oc + 64 * bj, o); st8(orow + oc + 64 * bj + 32, zz); }
                ROWEND }
            if (pn == 23) {
#pragma unroll
                for (int bj = 0; bj < 2; ++bj) { float mxv = kn2[bj]; mxv = fmaxf(mxv, dpp_f<0xB1>(mxv)); mxv = fmaxf(mxv, dpp_f<0x4E>(mxv)); mxv = fmaxf(mxv, dpp_f<0x141>(mxv)); mxv = fmaxf(mxv, dpp_f<0x140>(mxv));
                    if ((fr | fq) == 0) atomicMax((unsigned*)(KNB + (pm / TPB) * 8 + 2 * wc + bj), __float_as_uint(sqrtf(mxv))); } }
        } else {
            if (pn == 25 && wc >= 2) {
                const int oc = C_VD + (wc - 2) * 64 + 8 * fq;
                ROWLOOP { ROWVARS
#pragma unroll
                    for (int bj = 0; bj < 2; ++bj) st8(orow + oc + 32 * bj, v[bj]);
                    (void)rit; ROWEND }
            } else {
                const int oc = (pn == 2 ? C_QD : C_KD) + cb; const float sc = pn == 2 ? C2A : 1.0f; const float* gain = pn == 2 ? q_gain : k_gain;
                const f32x4 inv = *(const f32x4*)(INV16R + 4 * fq);
                f32x4 gn[2][2];
#pragma unroll
                for (int bj = 0; bj < 2; ++bj)
#pragma unroll
                    for (int n = 0; n < 2; ++n) gn[bj][n] = *(const f32x4*)(gain + 32 * bj + 8 * fq + 4 * n);
                ROWLOOP { ROWVARS
                    float ss = 0.f;
#pragma unroll
                    for (int bj = 0; bj < 2; ++bj)
#pragma unroll
                        for (int j = 0; j < 8; ++j) ss += v[bj][j] * v[bj][j];
                    ss = xor32_sum(xor16_sum(ss));
                    const float rstd = __builtin_amdgcn_rsqf(ss * (1.0f / 64.0f) + EPS);
                    const int t = t0 + rit;
#pragma unroll
                    for (int bj = 0; bj < 2; ++bj) {
                        const float pos = (float)(bj == 0 ? (t >> 6) : (t & 63));
                        float o[8];
#pragma unroll
                        for (int p = 0; p < 4; ++p) {
                            float sn, cs; if (isctx) { sn = 0.f; cs = 1.f; } else sincos_rev(pos * inv[p], sn, cs);
                            const float x0 = v[bj][2 * p] * rstd * gn[bj][(2 * p) >> 2][(2 * p) & 3], x1 = v[bj][2 * p + 1] * rstd * gn[bj][(2 * p + 1) >> 2][(2 * p + 1) & 3];
                            o[2 * p] = (x0 * cs - x1 * sn) * sc; o[2 * p + 1] = (x0 * sn + x1 * cs) * sc; }
                        st8(orow + oc + 32 * bj, o); }
                    ROWEND }
            }
        }
#undef ROWLOOP
#undef ROWVARS
#undef ROWEND
    }
};

__device__ __forceinline__ unsigned pk_u8x4(float a, float b, float c, float d) { unsigned w = 0u;
    w = __builtin_amdgcn_cvt_pk_u8_f32(__builtin_rintf(a * 255.0f), 0u, w); w = __builtin_amdgcn_cvt_pk_u8_f32(__builtin_rintf(b * 255.0f), 1u, w);
    w = __builtin_amdgcn_cvt_pk_u8_f32(__builtin_rintf(c * 255.0f), 2u, w); w = __builtin_amdgcn_cvt_pk_u8_f32(__builtin_rintf(d * 255.0f), 3u, w); return w; }
__device__ __forceinline__ float u8f(unsigned w, int i) { return (float)((w >> (8 * i)) & 0xffu); }
struct EpiGates {
    static constexpr bool PERM = true;
    unsigned char* GT; const float* gate_b;
    __device__ __forceinline__ void operator()(const f32x4 (&acc)[2][2][4][2], const pg8::Unit& u, int wr, int wc, int fr, int fq) const {
        const int col0 = u.pn * 256 + wc * 32 + 8 * fq;
        f32x4 gb[2][2];
#pragma unroll
        for (int bj = 0; bj < 2; ++bj)
#pragma unroll
            for (int n = 0; n < 2; ++n) gb[bj][n] = *(const f32x4*)(gate_b + col0 + bj * 128 + 4 * n) * (-LOG2E);
#pragma unroll
        for (int ai = 0; ai < 2; ++ai)
#pragma unroll
            for (int m = 0; m < 4; ++m) { unsigned char* rowp = GT + ((size_t)u.pm * 256 + ai * 128 + wr * 64 + m * 16 + fr) * 4096 + col0;
#pragma unroll
                for (int bj = 0; bj < 2; ++bj) { unsigned o[8];
#pragma unroll
                    for (int n = 0; n < 2; ++n)
#pragma unroll
                        for (int j = 0; j < 4; j += 2) { const f32x2 a2 = (f32x2){acc[ai][bj][m][n][j], acc[ai][bj][m][n][j + 1]}, c2 = (f32x2){gb[bj][n][j], gb[bj][n][j + 1]};
                            const f32x2 t2 = __builtin_elementwise_fma(a2, (f32x2){-W8I * LOG2E, -W8I * LOG2E}, c2);
                            const f32x2 e2 = (f32x2){__builtin_amdgcn_exp2f(t2.x), __builtin_amdgcn_exp2f(t2.y)};
                            const f32x2 d2 = __builtin_elementwise_fma(e2, (f32x2){1.0f / 255.0f, 1.0f / 255.0f}, (f32x2){1.0f / 255.0f, 1.0f / 255.0f});
                            const f32x2 v2 = (f32x2){__builtin_amdgcn_rcpf(d2.x), __builtin_amdgcn_rcpf(d2.y)} + (f32x2){8388608.0f, 8388608.0f};
                            o[4 * n + j] = __float_as_uint(v2.x); o[4 * n + j + 1] = __float_as_uint(v2.y); }
                    v2u w; w.x = __builtin_amdgcn_perm(o[1], o[0], 0x0c0c0400u) | __builtin_amdgcn_perm(o[3], o[2], 0x04000c0cu); w.y = __builtin_amdgcn_perm(o[5], o[4], 0x0c0c0400u) | __builtin_amdgcn_perm(o[7], o[6], 0x04000c0cu);
                    *(v2u*)(rowp + bj * 128) = w; } }
    }
};
struct EpiGateAcc {
    static constexpr bool PERM = true;
    const unsigned char* GT; bf16_t* MRG; bf16_t* GPC;
    static __device__ __forceinline__ bool keep_acc(const pg8::Unit& u) { return (u.pn & 3) != 3 && (u.pm % TPB) != 0; }
    __device__ __forceinline__ void operator()(f32x4 (&acc)[2][2][4][2], const pg8::Unit& u, int wr, int wc, int fr, int fq) const {
        const int dt = u.pn >> 2, n = u.pn & 3; const int col0 = dt * 256 + wc * 32 + 8 * fq;
        const bool isctx = (u.pm % TPB) == 0;
        const size_t row0 = (size_t)u.pm * 256 + wr * 64 + fr;
        const unsigned char* gp0 = GT + row0 * 4096 + n * 1024 + col0;
        constexpr float GMIN = 8.673617379884035e-19f;
#define GA_OFF(grp) ((size_t)(((grp) >> 3) * 128 + (((grp) >> 1) & 3) * 16))
        if (!isctx && n < 3) {
            v2u ga[16], gb[16];
#pragma unroll
            for (int grp = 0; grp < 16; ++grp) { const int bj = grp & 1; ga[grp] = *(const v2u*)(gp0 + GA_OFF(grp) * 4096 + bj * 128); gb[grp] = *(const v2u*)(gp0 + 1024 + GA_OFF(grp) * 4096 + bj * 128); }
            __builtin_amdgcn_sched_barrier(0);
#pragma unroll
            for (int grp = 0; grp < 16; ++grp) { const int ai = grp >> 3, m = (grp >> 1) & 3, bj = grp & 1; const v2u g0 = ga[grp], g1 = gb[grp];
                float r[8];
#define GA_R(i, A, B) r[i] = fmaxf(A, GMIN) * __builtin_amdgcn_rcpf(fmaxf(B, GMIN))
                GA_R(0, u8f(g0.x, 0), u8f(g1.x, 0)); GA_R(1, u8f(g0.x, 1), u8f(g1.x, 1)); GA_R(2, u8f(g0.x, 2), u8f(g1.x, 2)); GA_R(3, u8f(g0.x, 3), u8f(g1.x, 3));
                GA_R(4, u8f(g0.y, 0), u8f(g1.y, 0)); GA_R(5, u8f(g0.y, 1), u8f(g1.y, 1)); GA_R(6, u8f(g0.y, 2), u8f(g1.y, 2)); GA_R(7, u8f(g0.y, 3), u8f(g1.y, 3));
#undef GA_R
#pragma unroll
                for (int j = 0; j < 4; ++j) { acc[ai][bj][m][0][j] *= r[j]; acc[ai][bj][m][1][j] *= r[4 + j]; } }
            __builtin_amdgcn_sched_barrier(0);
        } else {
            bf16_t* mp0 = isctx ? GPC + ((size_t)n * 512 + (u.pm / TPB) * 256 + wr * 64 + fr) * 1024 + col0 : MRG + row0 * 1024 + col0;
            const float lo = isctx ? 0.f : GMIN; constexpr float I255 = 1.0f / 255.0f;
            v2u ga[16];
#pragma unroll
            for (int grp = 0; grp < 16; ++grp) { const int bj = grp & 1; ga[grp] = *(const v2u*)(gp0 + GA_OFF(grp) * 4096 + bj * 128); }
            __builtin_amdgcn_sched_barrier(0);
#pragma unroll
            for (int grp = 0; grp < 16; ++grp) { const int ai = grp >> 3, m = (grp >> 1) & 3, bj = grp & 1; const v2u g = ga[grp]; const f32x4 a0 = acc[ai][bj][m][0], a1 = acc[ai][bj][m][1];
                v4u w; w.x = cvtpk(a0[0] * (fmaxf(u8f(g.x, 0), lo) * I255), a0[1] * (fmaxf(u8f(g.x, 1), lo) * I255)); w.y = cvtpk(a0[2] * (fmaxf(u8f(g.x, 2), lo) * I255), a0[3] * (fmaxf(u8f(g.x, 3), lo) * I255));
                w.z = cvtpk(a1[0] * (fmaxf(u8f(g.y, 0), lo) * I255), a1[1] * (fmaxf(u8f(g.y, 1), lo) * I255)); w.w = cvtpk(a1[2] * (fmaxf(u8f(g.y, 2), lo) * I255), a1[3] * (fmaxf(u8f(g.y, 3), lo) * I255));
                *(v4u*)(mp0 + GA_OFF(grp) * 1024 + bj * 128) = w; }
            __builtin_amdgcn_sched_barrier(0);
        }
#undef GA_OFF
    }
};

struct EpiOutRes {
    static constexpr bool PERM = true;
    static __device__ __forceinline__ bool keep_acc(const pg8::Unit&) { return false; }
    const float* x_in; const float* ctx_in; const bf16_t* XR; bf16_t* X1; const float* mod_l; int layer;
    __device__ __forceinline__ void operator()(const f32x4 (&acc)[2][2][4][2], const pg8::Unit& u, int wr, int wc, int fr, int fq) const {
        const int pm = u.pm, b = pm / TPB, jt = pm % TPB; const bool isctx = jt == 0;
        const float* g1 = mod_l + (isctx ? 2 : b) * 6144 + 2048;
        const int col0 = u.pn * 256 + wc * 32 + 8 * fq;
        f32x4 gv[2][2];
#pragma unroll
        for (int bj = 0; bj < 2; ++bj)
#pragma unroll
            for (int n = 0; n < 2; ++n) gv[bj][n] = *(const f32x4*)(g1 + col0 + bj * 128 + n * 4);
        bf16_t* ob = X1 + ((size_t)pm * 256 + wr * 64 + fr) * DM + col0;
        if (layer == 0) {
            const float* base = (isctx ? ctx_in + (size_t)b * CTXL * DM : x_in + ((size_t)b * SEQ + (size_t)(jt - 1) * 256) * DM) + (size_t)(wr * 64 + fr) * DM + col0;
#pragma unroll
            for (int ai = 0; ai < 2; ++ai) { f32x4 rs[4][2][2];
#pragma unroll
                for (int m = 0; m < 4; ++m)
#pragma unroll
                    for (int bj = 0; bj < 2; ++bj)
#pragma unroll
                        for (int n = 0; n < 2; ++n) rs[m][bj][n] = *(const f32x4*)(base + (size_t)(ai * 128 + m * 16) * DM + bj * 128 + n * 4);
                __builtin_amdgcn_sched_barrier(0);
#pragma unroll
                for (int m = 0; m < 4; ++m)
#pragma unroll
                    for (int bj = 0; bj < 2; ++bj) { const f32x4 o0 = rs[m][bj][0] + gv[bj][0] * acc[ai][bj][m][0], o1 = rs[m][bj][1] + gv[bj][1] * acc[ai][bj][m][1];
                        v4u w; w.x = cvtpk(o0[0], o0[1]); w.y = cvtpk(o0[2], o0[3]); w.z = cvtpk(o1[0], o1[1]); w.w = cvtpk(o1[2], o1[3]);
                        *(v4u*)(ob + (size_t)(ai * 128 + m * 16) * DM + bj * 128) = w; }
                __builtin_amdgcn_sched_barrier(0); }
        } else {
            const bf16_t* base = XR + ((size_t)pm * 256 + wr * 64 + fr) * DM + col0;
#pragma unroll
            for (int ai = 0; ai < 2; ++ai) { v4u rb[4][2];
#pragma unroll
                for (int m = 0; m < 4; ++m)
#pragma unroll
                    for (int bj = 0; bj < 2; ++bj) rb[m][bj] = *(const v4u*)(base + (size_t)(ai * 128 + m * 16) * DM + bj * 128);
                __builtin_amdgcn_sched_barrier(0);
#pragma unroll
                for (int m = 0; m < 4; ++m)
#pragma unroll
                    for (int bj = 0; bj < 2; ++bj) { const v4u r = rb[m][bj];
                        const f32x4 r0 = (f32x4){bflo(r.x), bfhi(r.x), bflo(r.y), bfhi(r.y)}, r1 = (f32x4){bflo(r.z), bfhi(r.z), bflo(r.w), bfhi(r.w)};
                        const f32x4 o0 = r0 + gv[bj][0] * acc[ai][bj][m][0], o1 = r1 + gv[bj][1] * acc[ai][bj][m][1];
                        v4u w; w.x = cvtpk(o0[0], o0[1]); w.y = cvtpk(o0[2], o0[3]); w.z = cvtpk(o1[0], o1[1]); w.w = cvtpk(o1[2], o1[3]);
                        *(v4u*)(ob + (size_t)(ai * 128 + m * 16) * DM + bj * 128) = w; }
                __builtin_amdgcn_sched_barrier(0); }
        }
    }
};
struct EpiPart {
    static constexpr bool PERM = false;
    static __device__ __forceinline__ bool keep_acc(const pg8::Unit&) { return false; }
    float* PART;
    __device__ __forceinline__ void operator()(const f32x4 (&acc)[2][2][4][2], const pg8::Unit& u, int wr, int wc, int fr, int fq) const {
        const int ks = u.pn >> 2, ct = u.pn & 3; const int col0 = ct * 256 + wc * 32 + 4 * fq;
#pragma unroll
        for (int ai = 0; ai < 2; ++ai)
#pragma unroll
            for (int m = 0; m < 4; ++m) { float* op = PART + ((size_t)ks * 512 + u.pm * 256 + ai * 128 + wr * 64 + m * 16 + fr) * DM + col0;
#pragma unroll
                for (int bj = 0; bj < 2; ++bj)
#pragma unroll
                    for (int n = 0; n < 2; ++n) *(f32x4*)(op + bj * 128 + n * 16) = acc[ai][bj][m][n]; }
    }
};
struct EpiSwiGLU {
    static constexpr bool PERM = true;
    unsigned char* HID;
    __device__ __forceinline__ void operator()(const f32x4 (&acc)[2][2][4][2], const pg8::Unit& u, int wr, int wc, int fr, int fq) const {
        const int f0 = u.pn * 128 + wc * 32 + 8 * fq;
#pragma unroll
        for (int ai = 0; ai < 2; ++ai)
#pragma unroll
            for (int m = 0; m < 4; ++m) { float o[8];
#pragma unroll
                for (int n = 0; n < 2; ++n)
#pragma unroll
                    for (int j = 0; j < 4; j += 2) { const f32x2 g2 = (f32x2){acc[ai][0][m][n][j], acc[ai][0][m][n][j + 1]}, u2 = (f32x2){acc[ai][1][m][n][j], acc[ai][1][m][n][j + 1]};
                        const f32x2 t2 = g2 * (f32x2){-W8I * LOG2E, -W8I * LOG2E};
                        const f32x2 e2 = (f32x2){__builtin_amdgcn_exp2f(t2.x), __builtin_amdgcn_exp2f(t2.y)};
                        const f32x2 d2 = __builtin_elementwise_fma(e2, (f32x2){1024.0f, 1024.0f}, (f32x2){1024.0f, 1024.0f});
                        const f32x2 r2 = (f32x2){__builtin_amdgcn_rcpf(d2.x), __builtin_amdgcn_rcpf(d2.y)};
                        const f32x2 o2 = (g2 * u2) * r2; o[4 * n + j] = o2.x; o[4 * n + j + 1] = o2.y; }
                v2u w; w.x = pk8(o[0], o[1], o[2], o[3]); w.y = pk8(o[4], o[5], o[6], o[7]);
                *(v2u*)(HID + ((size_t)u.pm * 256 + ai * 128 + wr * 64 + m * 16 + fr) * EH + f0) = w; }
    }
};
struct EpiDown {
    static constexpr bool PERM = true;
    bf16_t* Y; const float* SCORE;
    __device__ __forceinline__ void operator()(const f32x4 (&acc)[2][2][4][2], const pg8::Unit& u, int wr, int wc, int fr, int fq) const {
        const int col0 = u.pn * 256 + wc * 32 + 8 * fq;
        float sc8[2][4];
#pragma unroll
        for (int ai = 0; ai < 2; ++ai)
#pragma unroll
            for (int m = 0; m < 4; ++m) sc8[ai][m] = SCORE[(size_t)u.pm * 256 + ai * 128 + wr * 64 + m * 16 + fr];
        __builtin_amdgcn_sched_barrier(0);
#pragma unroll
        for (int ai = 0; ai < 2; ++ai)
#pragma unroll
            for (int m = 0; m < 4; ++m) { const size_t row = (size_t)u.pm * 256 + ai * 128 + wr * 64 + m * 16 + fr; const float s = sc8[ai][m] * W8I;
#pragma unroll
                for (int bj = 0; bj < 2; ++bj) { float o[8];
#pragma unroll
                    for (int n = 0; n < 2; ++n)
#pragma unroll
                        for (int j = 0; j < 4; ++j) o[4 * n + j] = acc[ai][bj][m][n][j] * s;
                    st8(Y + row * DM + col0 + bj * 128, o); } }
    }
};
struct EpiDownPart {
    static constexpr bool PERM = true;
    bf16_t* YP; const float* SCORE;
    __device__ __forceinline__ void operator()(const f32x4 (&acc)[2][2][4][2], const pg8::Unit& u, int wr, int wc, int fr, int fq) const {
        if (wr != 0) return;
        const int in = u.pn & 3, kq = u.pn >> 2, e = u.pm / 9; const int col0 = in * 256 + wc * 32 + 8 * fq;
        float sc4[4];
#pragma unroll
        for (int m = 0; m < 4; ++m) sc4[m] = SCORE[(size_t)u.pm * 256 + m * 16 + fr];
        __builtin_amdgcn_sched_barrier(0);
#pragma unroll
        for (int m = 0; m < 4; ++m) { const size_t row = ((size_t)(kq * 16 + e) * 256 + m * 16 + fr); const float sc = sc4[m] * W8I;
#pragma unroll
            for (int bj = 0; bj < 2; ++bj) { float o[8];
#pragma unroll
                for (int n = 0; n < 2; ++n)
#pragma unroll
                    for (int j = 0; j < 4; ++j) o[4 * n + j] = acc[0][bj][m][n][j] * sc;
                st8(YP + row * DM + col0 + bj * 128, o); } }
    }
};

namespace attn_body {
using bf16 = __hip_bfloat16;
using u32x4 = __attribute__((ext_vector_type(4))) unsigned;
constexpr int NW = 8, QBLK = 32, QB = QBLK * NW, KVBLK = 64;
__device__ __forceinline__ int crow(int r, int hi) { return (r & 3) + 8 * (r >> 2) + 4 * hi; }
#define SBAR() __builtin_amdgcn_sched_barrier(0)
constexpr int NSLOT = 3, SLOTB = 8192;
constexpr int LDS_K = 0, LDS_V = NSLOT * SLOTB, LDS_WS = 2 * NSLOT * SLOTB, LDS_OST = LDS_WS + NW * 64 * 4, LDS_OST1 = LDS_OST + NW * 4096, LDS_RPB = LDS_OST1 + NW * 4096, LDS_ATT_BYTES = LDS_RPB + 2048;
static_assert(LDS_ATT_BYTES <= RING_BYTES, "attention LDS");
__device__ __forceinline__ void glds16(const void* gsrc, unsigned lds_dst) { unsigned keep;
  asm volatile("s_mov_b32 %0, m0\n\ts_mov_b32 m0, %2\n\ts_nop 0\n\tglobal_load_lds_dwordx4 %1, off\n\ts_mov_b32 m0, %0" : "=&s"(keep) : "v"(gsrc), "s"(lds_dst) : "memory"); }
__device__ __forceinline__ float max3f(float a, float b, float c) { float r; asm("v_max3_f32 %0, %1, %2, %3" : "=v"(r) : "v"(a), "v"(b), "v"(c)); return r; }
__device__ __forceinline__ float max2f(float a, float b) { float r; asm("v_max_f32_e32 %0, %1, %2" : "=v"(r) : "v"(a), "v"(b)); return r; }
__device__ __forceinline__ float fadd_s(float a, float b) { float r; asm("v_add_f32_e32 %0, %1, %2" : "=v"(r) : "v"(a), "v"(b)); return r; }
__device__ __forceinline__ float fsub_s(float a, float b) { float r; asm("v_sub_f32_e32 %0, %1, %2" : "=v"(r) : "v"(a), "v"(b)); return r; }
__device__ __forceinline__ unsigned cvtpk_s(float lo, float hi) { return cvtpk(lo, hi); }
#define WAIT_BAR(N) asm volatile("s_waitcnt vmcnt(" #N ") lgkmcnt(0)\n\ts_barrier" ::: "memory")

typedef __attribute__((address_space(3))) const char* lds_cptr;
typedef short v4i16_t __attribute__((ext_vector_type(4)));
__device__ __forceinline__ void qkt(f32x16& p0, f32x16& p1, lds_cptr Kslot, const bf16x8* qr, const f32x16& negm, int r32, int hi) {
  lds_cptr kb = Kslot + hi * 1024 + r32 * 16;
  #pragma unroll
  for (int d0 = 0; d0 < 4; ++d0) {
    const bf16x8 b0 = *(const __attribute__((address_space(3))) bf16x8*)(kb + d0 * 2048);
    const bf16x8 b1 = *(const __attribute__((address_space(3))) bf16x8*)(kb + d0 * 2048 + 512);
    if (d0 == 0) { p0 = __builtin_amdgcn_mfma_f32_32x32x16_bf16(b0, qr[0], negm, 0, 0, 0); p1 = __builtin_amdgcn_mfma_f32_32x32x16_bf16(b1, qr[0], negm, 0, 0, 0); }
    else { p0 = __builtin_amdgcn_mfma_f32_32x32x16_bf16(b0, qr[d0], p0, 0, 0, 0); p1 = __builtin_amdgcn_mfma_f32_32x32x16_bf16(b1, qr[d0], p1, 0, 0, 0); } }
}
__device__ __forceinline__ void kload8(bf16x8* kf, lds_cptr kp) {
  kf[0] = *(const __attribute__((address_space(3))) bf16x8*)(kp);        kf[1] = *(const __attribute__((address_space(3))) bf16x8*)(kp + 512);
  kf[2] = *(const __attribute__((address_space(3))) bf16x8*)(kp + 2048); kf[3] = *(const __attribute__((address_space(3))) bf16x8*)(kp + 2560);
  kf[4] = *(const __attribute__((address_space(3))) bf16x8*)(kp + 4096); kf[5] = *(const __attribute__((address_space(3))) bf16x8*)(kp + 4608);
  kf[6] = *(const __attribute__((address_space(3))) bf16x8*)(kp + 6144); kf[7] = *(const __attribute__((address_space(3))) bf16x8*)(kp + 6656);
}
__device__ __forceinline__ void kload2(bf16x8* kf, lds_cptr kp, int j) { kf[2 * j] = *(const __attribute__((address_space(3))) bf16x8*)(kp + j * 2048); kf[2 * j + 1] = *(const __attribute__((address_space(3))) bf16x8*)(kp + j * 2048 + 512); }
__device__ __forceinline__ s16x4 vtr(lds_cptr p) { return __builtin_bit_cast(s16x4, __builtin_amdgcn_ds_read_tr16_b64_v4i16((__attribute__((address_space(3))) v4i16_t*)p)); }
__device__ __forceinline__ float rowmax(const f32x16& p0, const f32x16& p1) {
  float a = max3f(p0[0], p0[1], p1[0]), b = max3f(p0[2], p0[3], p1[1]); a = max3f(a, p1[2], p1[3]);
  #pragma unroll
  for (int r = 4; r < 16; r += 4) { a = max3f(a, p0[r], p0[r + 1]); b = max3f(b, p0[r + 2], p0[r + 3]); a = max3f(a, p1[r], p1[r + 1]); b = max3f(b, p1[r + 2], p1[r + 3]); }
  const float m = max2f(a, b);
  auto rr = __builtin_amdgcn_permlane32_swap(__float_as_uint(m), __float_as_uint(m), false, false);
  return max2f(__uint_as_float(rr[0]), __uint_as_float(rr[1]));
}
__device__ __forceinline__ void pv(f32x16* o, int vb, bf16x8 pa0, bf16x8 pa1, bf16x8 pa2, bf16x8 pa3) {
  #pragma unroll
  for (int d0 = 0; d0 < 2; ++d0) { s16x4 lo[4], hi[4];
    #pragma unroll
    for (int ks = 0; ks < 4; ++ks) {
      asm volatile("ds_read_b64_tr_b16 %0,%1 offset:%c2" : "=&v"(lo[ks]) : "v"(vb), "i"(d0 * 4096 + ks * 1024) : "memory");
      asm volatile("ds_read_b64_tr_b16 %0,%1 offset:%c2" : "=&v"(hi[ks]) : "v"(vb), "i"(d0 * 4096 + ks * 1024 + 512) : "memory"); }
    asm volatile("s_waitcnt lgkmcnt(0)" ::: "memory"); SBAR();
    #define PK(k) (bf16x8){lo[k][0], lo[k][1], lo[k][2], lo[k][3], hi[k][0], hi[k][1], hi[k][2], hi[k][3]}
    o[d0] = __builtin_amdgcn_mfma_f32_32x32x16_bf16(pa0, PK(0), o[d0], 0, 0, 0);
    o[d0] = __builtin_amdgcn_mfma_f32_32x32x16_bf16(pa1, PK(1), o[d0], 0, 0, 0);
    o[d0] = __builtin_amdgcn_mfma_f32_32x32x16_bf16(pa2, PK(2), o[d0], 0, 0, 0);
    o[d0] = __builtin_amdgcn_mfma_f32_32x32x16_bf16(pa3, PK(3), o[d0], 0, 0, 0);
    #undef PK
  }
}

struct DiffEpi { float lam, post; const float* subg; };
template <int THRL, int MODE> __device__ __forceinline__ void attn_unit(const bf16* Qu, const bf16* __restrict__ Kh, const bf16* __restrict__ Vh, int NT, bf16* Ou, char* shm, const DiffEpi de, const bool usemax = true, const float* kmaxp = nullptr) {
  constexpr int PK = PQ, PV = PQ, PO = 1024;
  constexpr bool DQ32 = (MODE != 0);
  const int tid = opaque_tid(), lane = tid & 63, r32 = lane & 31, hi = lane >> 5; const int wid = __builtin_amdgcn_readfirstlane(tid >> 6);
  const bf16* Qw = Qu + (long)(wid * QBLK) * PQ;
  const unsigned lds0 = (unsigned)(uintptr_t)shm;
  float* wsf = (float*)(shm + LDS_WS) + wid * 64;
  const bf16* ksrc = Kh + (long)lane * PK + wid * 8;
  const bf16* vsrc = Vh + (long)(16 * (wid & 3) + (lane >> 2)) * PV + (wid >> 2) * 32 + (lane & 3) * 8;
  const unsigned kdst = lds0 + LDS_K + wid * 1024, vdst = lds0 + LDS_V + wid * 1024;
  #define DMA_K(t, slot) glds16(ksrc + (long)(t) * KVBLK * PK, (unsigned)__builtin_amdgcn_readfirstlane(kdst + (slot)))
  #define DMA_V(t, slot) glds16(vsrc + (long)(t) * KVBLK * PV, (unsigned)__builtin_amdgcn_readfirstlane(vdst + (slot)))
  const int vb0 = (int)(lds0 + LDS_V) + ((lane >> 4) & 1) * 32 + (lane & 3) * 8 + (4 * hi + ((lane & 15) >> 2)) * 64;
  bf16x8 kf[8];
  const lds_cptr shm3 = (lds_cptr)shm; const lds_cptr kp0 = shm3 + LDS_K + hi * 1024 + r32 * 16; const lds_cptr vp0 = shm3 + LDS_V + ((lane >> 4) & 1) * 32 + (lane & 3) * 8 + (4 * hi + ((lane & 15) >> 2)) * 64;
  DMA_K(0, 0); DMA_V(0, 0); DMA_K(1, SLOTB);
  bf16x8 qr[4];
  #pragma unroll
  for (int d0 = 0; d0 < 4; ++d0) qr[d0] = *reinterpret_cast<const bf16x8*>(&Qw[(long)r32 * PQ + d0 * 16 + hi * 8]);
  constexpr bool LMF = DQ32;
  bool um = usemax;
  if (MODE != 0) {
    float q2 = 0.f;
    #pragma unroll
    for (int d0 = 0; d0 < 2; ++d0)
      #pragma unroll
      for (int jq = 0; jq < 8; ++jq) { const float v = __uint_as_float((unsigned)(unsigned short)qr[d0][jq] << 16); q2 += v * v; }
    const float bq = sqrtf(xor32_sum(q2)) * (*kmaxp) * 1.02f;
    um = __builtin_amdgcn_readfirstlane((int)(__ballot(bq > 40.0f) != 0ull)) != 0; }
  float mhat = 0.f, l_reg = 0.f; f32x16 o[2]; o[0] = f32x16{}; o[1] = f32x16{}; f32x16 negm = f32x16{}; asm volatile("" : "+v"(negm));
  f32x16 lacc = f32x16{}; bf16x8 ones; { unsigned c0_, c1_, c2_, c3_; asm volatile("v_mov_b32 %0, 0x3f803f80\n\tv_mov_b32 %1, 0x3f803f80\n\tv_mov_b32 %2, 0x3f803f80\n\tv_mov_b32 %3, 0x3f803f80" : "=v"(c0_), "=v"(c1_), "=v"(c2_), "=v"(c3_)); ones = __builtin_bit_cast(bf16x8, (u32x4){c0_, c1_, c2_, c3_}); }
  bool resc = false;
  #define START(P0, P1) do { const float rm = rowmax(P0, P1); resc = false; \
    { const float dl = rm; mhat = fadd_s(mhat, dl); \
      _Pragma("unroll") for (int r = 0; r < 16; ++r) { P0[r] = fsub_s(P0[r], dl); P1[r] = fsub_s(P1[r], dl); } \
      _Pragma("unroll") for (int r = 0; r < 16; ++r) negm[r] = -mhat; asm volatile("" : "+v"(negm)); } \
    _Pragma("unroll") for (int r = 0; r < 16; ++r) P0[r] = __builtin_amdgcn_exp2f(P0[r]); } while (0)
  #define RESC() do { if (resc) { asm volatile("s_waitcnt lgkmcnt(0)" ::: "memory"); \
      _Pragma("unroll") for (int d_ = 0; d_ < 2; ++d_) _Pragma("unroll") for (int r = 0; r < 16; ++r) o[d_][r] *= wsf[crow(r, hi)]; \
      if (LMF) { _Pragma("unroll") for (int r = 0; r < 16; ++r) lacc[r] *= wsf[crow(r, hi)]; } } } while (0)
  f32x16 pA0, pA1, pB0, pB1;
  int sl_prev = 0, sl_cur = 0, sl_next = SLOTB;
  #define ROT() do { sl_prev = sl_cur; sl_cur = sl_next; sl_next = (sl_next == (NSLOT - 1) * SLOTB) ? 0 : sl_next + SLOTB; } while (0)
  DMA_K(2, 2 * SLOTB);
  WAIT_BAR(3);
  qkt(pA0, pA1, shm3 + LDS_K, qr, negm, r32, hi); asm volatile("s_nop 15\n\ts_nop 7" : "+v"(pA0), "+v"(pA1));
  START(pA0, pA1);
  _Pragma("unroll") for (int r = 0; r < 16; ++r) pA1[r] = __builtin_amdgcn_exp2f(pA1[r]);
  WAIT_BAR(0);
  DMA_K(3, 0); DMA_V(1, SLOTB);
  ROT();
  kload8(kf, kp0 + sl_cur);
  WAIT_BAR(2);
  s16x4 vlo[8], vhi[8]; u32x4 pw0, pw1, pw2, pw3;
  #define PKW(P, B) cvtpk_s(P[B], P[B + 1])
  #define PAF(k) __builtin_bit_cast(bf16x8, pw##k)
  #define VFR(i) (bf16x8){vlo[i][0], vlo[i][1], vlo[i][2], vlo[i][3], vhi[i][0], vhi[i][1], vhi[i][2], vhi[i][3]}
  #define PIN(x) asm volatile("" : "+v"(x))
  #define MX3(a, b, c) __builtin_fmaxf(__builtin_fmaxf((a), (b)), (c))
  #define GAPA(MF, A0, A1, A2, A3, W0, W1, PW) do { MF; if (!LMF) { sacc += A0; sacc += A1; sacc += A2; sacc += A3; PIN(sacc); } W0; W1; PIN(PW); SBAR(); } while (0)
  #define LMM(k) lacc = __builtin_amdgcn_mfma_f32_32x32x16_bf16(PAF(k), ones, lacc, 0, 0, 0)
  #define EX(v) __builtin_amdgcn_exp2f(v)
  #define GAPB(MF, X, B) do { MF; X[B] = EX(X[B]); X[B + 1] = EX(X[B + 1]); X[B + 2] = EX(X[B + 2]); X[B + 3] = EX(X[B + 3]); PIN(X); SBAR(); } while (0)
  #define VRD(i) do { vlo[i] = vtr(vp_ + (((i) >> 2) * 4096 + ((i) & 3) * 1024)); vhi[i] = vtr(vp_ + (((i) >> 2) * 4096 + ((i) & 3) * 1024 + 512)); } while (0)
  #define KRD(G, j) do { if (G) { kload2(kf, kp0 + sl_next, j); SBAR(); } } while (0)
  #define STEP(C0, C1, P0, P1, t, GK, GV, GL) do { SBAR(); \
    const lds_cptr vp_ = vp0 + sl_prev; \
    VRD(0); SBAR(); float sacc = (P0[0] + P0[1]); \
    GAPA(C0 = __builtin_amdgcn_mfma_f32_32x32x16_bf16(kf[0], qr[0], negm, 0, 0, 0), P0[2], P0[3], P0[4], P0[5],     pw0[0] = PKW(P0, 0), pw0[1] = PKW(P0, 2), pw0); \
    VRD(4); SBAR(); GAPA(C1 = __builtin_amdgcn_mfma_f32_32x32x16_bf16(kf[1], qr[0], negm, 0, 0, 0), P0[6], P0[7], P0[8], P0[9],     pw0[2] = PKW(P0, 4), pw0[3] = PKW(P0, 6), pw0); \
    VRD(1); SBAR(); GAPA(C0 = __builtin_amdgcn_mfma_f32_32x32x16_bf16(kf[2], qr[1], C0, 0, 0, 0),   P0[10], P0[11], P0[12], P0[13], pw1[0] = PKW(P0, 8), pw1[1] = PKW(P0, 10), pw1); \
    VRD(5); SBAR(); GAPA(C1 = __builtin_amdgcn_mfma_f32_32x32x16_bf16(kf[3], qr[1], C1, 0, 0, 0),   P0[14], P0[15], P1[0], P1[1],   pw1[2] = PKW(P0, 12), pw1[3] = PKW(P0, 14), pw1); \
    VRD(2); SBAR(); GAPA(do { if (!DQ32) { C0 = __builtin_amdgcn_mfma_f32_32x32x16_bf16(kf[4], qr[2], C0, 0, 0, 0); } else if (LMF) { LMM(0); } } while (0),   P1[2], P1[3], P1[4], P1[5],     pw2[0] = PKW(P1, 0), pw2[1] = PKW(P1, 2), pw2); \
    VRD(6); SBAR(); GAPA(do { if (!DQ32) { C1 = __builtin_amdgcn_mfma_f32_32x32x16_bf16(kf[5], qr[2], C1, 0, 0, 0); } else if (LMF) { LMM(1); } } while (0),   P1[6], P1[7], P1[8], P1[9],     pw2[2] = PKW(P1, 4), pw2[3] = PKW(P1, 6), pw2); \
    VRD(3); SBAR(); GAPA(do { if (!DQ32) { C0 = __builtin_amdgcn_mfma_f32_32x32x16_bf16(kf[6], qr[3], C0, 0, 0, 0); } else if (LMF) { LMM(2); } } while (0),   P1[10], P1[11], P1[12], P1[13], pw3[0] = PKW(P1, 8), pw3[1] = PKW(P1, 10), pw3); \
    VRD(7); SBAR(); GAPA(do { if (!DQ32) { C1 = __builtin_amdgcn_mfma_f32_32x32x16_bf16(kf[7], qr[3], C1, 0, 0, 0); } } while (0),   P1[14], P1[15], 0.f, 0.f,       pw3[2] = PKW(P1, 12), pw3[3] = PKW(P1, 14), pw3); \
    if (LMF) { LMM(3); } else { l_reg += sacc; } \
    if (GK) { DMA_K((t) + 3, sl_cur); } if (GV) { DMA_V((t) + 1, sl_next); } \
    if (um) { float a = MX3(C0[0], C0[1], C1[0]), b = MX3(C0[2], C0[3], C1[1]); a = MX3(a, C1[2], C1[3]); \
      _Pragma("unroll") for (int r = 4; r < 16; r += 4) { a = MX3(a, C0[r], C0[r + 1]); b = MX3(b, C0[r + 2], C0[r + 3]); a = MX3(a, C1[r], C1[r + 1]); b = MX3(b, C1[r + 2], C1[r + 3]); } \
      float rm = __builtin_fmaxf(a, b); { auto rr = __builtin_amdgcn_permlane32_swap(__float_as_uint(rm), __float_as_uint(rm), false, false); rm = __builtin_fmaxf(__uint_as_float(rr[0]), __uint_as_float(rr[1])); } \
      resc = false; \
      if (__builtin_expect(__any(rm > (float)THRL), 0)) { const float dl = __builtin_fmaxf(rm, 0.f); mhat += dl; \
        _Pragma("unroll") for (int r = 0; r < 16; ++r) { C0[r] -= dl; C1[r] -= dl; } \
        _Pragma("unroll") for (int r = 0; r < 16; ++r) negm[r] = -mhat; asm volatile("" : "+v"(negm)); \
        const float f = __builtin_amdgcn_exp2f(-dl); if (!LMF) l_reg *= f; if (hi == 0) wsf[r32] = f; resc = true; } } else { resc = false; } \
    SBAR(); \
    GAPB(o[0] = __builtin_amdgcn_mfma_f32_32x32x16_bf16(PAF(0), VFR(0), o[0], 0, 0, 0), C0, 0); \
    GAPB(o[1] = __builtin_amdgcn_mfma_f32_32x32x16_bf16(PAF(0), VFR(4), o[1], 0, 0, 0), C0, 4); \
    KRD(GL, 0); GAPB(o[0] = __builtin_amdgcn_mfma_f32_32x32x16_bf16(PAF(1), VFR(1), o[0], 0, 0, 0), C0, 8); \
    KRD(GL, 1); GAPB(o[1] = __builtin_amdgcn_mfma_f32_32x32x16_bf16(PAF(1), VFR(5), o[1], 0, 0, 0), C0, 12); \
    KRD(GL && !DQ32, 2); GAPB(o[0] = __builtin_amdgcn_mfma_f32_32x32x16_bf16(PAF(2), VFR(2), o[0], 0, 0, 0), C1, 0); \
    KRD(GL && !DQ32, 3); GAPB(o[1] = __builtin_amdgcn_mfma_f32_32x32x16_bf16(PAF(2), VFR(6), o[1], 0, 0, 0), C1, 4); \
    GAPB(o[0] = __builtin_amdgcn_mfma_f32_32x32x16_bf16(PAF(3), VFR(3), o[0], 0, 0, 0), C1, 8); \
    GAPB(o[1] = __builtin_amdgcn_mfma_f32_32x32x16_bf16(PAF(3), VFR(7), o[1], 0, 0, 0), C1, 12); \
    } while (0)
  int t = 1;
  for (; t + 5 < NT; t += 2) {
    STEP(pB0, pB1, pA0, pA1, t, true, true, true);     WAIT_BAR(2); RESC(); ROT();
    STEP(pA0, pA1, pB0, pB1, t + 1, true, true, true); WAIT_BAR(2); RESC(); ROT();
  }
  #define ENDW(tt) do { if ((tt) + 3 < NT) { WAIT_BAR(2); } else if ((tt) + 2 < NT) { WAIT_BAR(1); } else { WAIT_BAR(0); } } while (0)
  for (; t + 1 < NT; t += 2) {
    STEP(pB0, pB1, pA0, pA1, t, (t + 3 < NT), (t + 1 < NT), (t + 1 < NT));       ENDW(t);     RESC(); ROT();
    STEP(pA0, pA1, pB0, pB1, t + 1, (t + 4 < NT), (t + 2 < NT), (t + 2 < NT));   ENDW(t + 1); RESC(); ROT();
  }
  STEP(pB0, pB1, pA0, pA1, NT - 1, false, false, false); RESC();
  { if (!LMF) { float sacc = pB0[0] + pB0[1]; _Pragma("unroll") for (int r = 2; r < 16; ++r) sacc += pB0[r]; _Pragma("unroll") for (int r = 0; r < 16; ++r) sacc += pB1[r]; l_reg += sacc; }
    pw0 = (u32x4){PKW(pB0, 0), PKW(pB0, 2), PKW(pB0, 4), PKW(pB0, 6)}; pw1 = (u32x4){PKW(pB0, 8), PKW(pB0, 10), PKW(pB0, 12), PKW(pB0, 14)}; pw2 = (u32x4){PKW(pB1, 0), PKW(pB1, 2), PKW(pB1, 4), PKW(pB1, 6)}; pw3 = (u32x4){PKW(pB1, 8), PKW(pB1, 10), PKW(pB1, 12), PKW(pB1, 14)};
    SBAR(); if (LMF) { LMM(0); LMM(1); LMM(2); LMM(3); } pv(o, vb0 + sl_cur, PAF(0), PAF(1), PAF(2), PAF(3)); }
  #undef LMM
  #undef PKW
  #undef PAF
  #undef VFR
  #undef PIN
  #undef MX3
  #undef GAPA
  #undef GAPB
  #undef EX
  #undef VRD
  #undef KRD
  #undef STEP
  #undef ENDW
  float rli[16];
  if (LMF) {
    #pragma unroll
    for (int r = 0; r < 16; ++r) rli[r] = __builtin_amdgcn_rcpf(lacc[r]);
  } else {
    { auto rr = __builtin_amdgcn_permlane32_swap(__float_as_uint(l_reg), __float_as_uint(l_reg), false, false); l_reg = __uint_as_float(rr[0]) + __uint_as_float(rr[1]); }
    if (hi == 0) wsf[32 + r32] = l_reg; asm volatile("s_waitcnt lgkmcnt(0)" ::: "memory");
    #pragma unroll
    for (int r = 0; r < 16; ++r) rli[r] = __builtin_amdgcn_rcpf(wsf[32 + crow(r, hi)]);
  }
  bf16_t* stg = (bf16_t*)(shm + LDS_OST) + wid * 2048;
  bf16_t* stg1 = (bf16_t*)(shm + LDS_OST1) + wid * 2048;
  if (MODE == 1) {
    #pragma unroll
    for (int r = 0; r < 16; ++r) { const int orow = crow(r, hi);
      #pragma unroll
      for (int d0 = 0; d0 < 2; ++d0) stg1[orow * 64 + d0 * 32 + r32] = f2bf(o[d0][r] * rli[r]); }
    asm volatile("s_waitcnt lgkmcnt(0)" ::: "memory");
  } else {
    if (MODE == 2) {
      const float g0 = de.subg[r32] * de.post, g1 = de.subg[32 + r32] * de.post;
      #pragma unroll
      for (int r = 0; r < 16; ++r) { const int orow = crow(r, hi);
        const float d0v = bf2f(stg1[orow * 64 + r32]) - de.lam * (o[0][r] * rli[r]), d1v = bf2f(stg1[orow * 64 + 32 + r32]) - de.lam * (o[1][r] * rli[r]);
        float ss = d0v * d0v + d1v * d1v;
        ss = half32_sum(ss);
        const float rstd = __builtin_amdgcn_rsqf(ss * (1.0f / 64.0f) + EPS);
        stg[orow * 64 + r32] = f2bf(d0v * rstd * g0); stg[orow * 64 + 32 + r32] = f2bf(d1v * rstd * g1); }
    } else {
      #pragma unroll
      for (int r = 0; r < 16; ++r) { const int orow = crow(r, hi);
        #pragma unroll
        for (int d0 = 0; d0 < 2; ++d0) stg[orow * 64 + d0 * 32 + r32] = f2bf(o[d0][r] * rli[r]); }
    }
    asm volatile("s_waitcnt lgkmcnt(0)" ::: "memory");
    bf16* Ow = Ou + (long)(wid * QBLK) * PO;
    #pragma unroll
    for (int i = 0; i < 4; ++i) { const int row = i * 8 + (lane >> 3), ch = lane & 7; const u32x4 v = *(const u32x4*)(stg + row * 64 + ch * 8); *(u32x4*)(Ow + (long)row * PO + ch * 8) = v; }
  }
  asm volatile("s_waitcnt lgkmcnt(0)\n\ts_barrier" ::: "memory");
  #undef DMA_K
  #undef DMA_V
  #undef START
  #undef RESC
  #undef ROT
}

__device__ __forceinline__ void na_unit(int b, int h, int g4, const bf16* QKV, bf16* YS, const float* rpb_h, char* shm) {
  const bf16 *QA = QKV + C_QA, *KA = QKV + C_KA, *VA = QKV + C_VA;
  const int tid = opaque_tid(), lane = tid & 63, r32 = lane & 31, hi = lane >> 5; const int wid = __builtin_amdgcn_readfirstlane(tid >> 6);
  const unsigned lds0 = (unsigned)(uintptr_t)shm;
  float* wsf = (float*)(shm + LDS_WS) + wid * 64;
  float* rp = (float*)(shm + LDS_RPB);
  const lds_cptr shm3 = (lds_cptr)shm;
  for (int i = tid; i < 15 * 31; i += 512) rp[i] = rpb_h[i] * LOG2E;
  const int rq = 4 * g4 + (wid >> 1), qc = 32 * (wid & 1) + r32;
  const long rowb = (long)b * RB;
  const bf16* Qw = QA + (rowb + CTXL + rq * 64 + 32 * (wid & 1)) * PQ + h * 64;
  bf16x8 qr[4];
  #pragma unroll
  for (int d0 = 0; d0 < 4; ++d0) qr[d0] = *reinterpret_cast<const bf16x8*>(&Qw[(long)r32 * PQ + d0 * 16 + hi * 8]);
  const int r0 = min(max(rq - 4, 0), 120);
  const int kr_lo = min(max(4 * g4 - 4, 0), 120), kr_hi = min(max(4 * g4 - 1, 0), 120) + 7;
  const int ntiles = 4 + (kr_hi - kr_lo + 1);
  const int c0 = min(max(qc - 8, 0), 48);
  float mrun = -INFINITY, l_reg = 0.f; f32x16 o[2]; o[0] = f32x16{}; o[1] = f32x16{};
  const unsigned kdst = lds0 + LDS_K + wid * 1024, vdst = lds0 + LDS_V + wid * 1024;
  const int vb0 = (int)(lds0 + LDS_V) + ((lane >> 4) & 1) * 32 + (lane & 3) * 8 + (4 * hi + ((lane & 15) >> 2)) * 64;
  #define NA_DMA(TI) do { const int kr_ = kr_lo + (TI) - 4; const long krow_ = ((TI) < 4) ? rowb + 64 * (TI) : rowb + CTXL + (long)kr_ * 64; const unsigned so_ = ((TI) & 1) * SLOTB; \
      glds16(KA + (krow_ + lane) * PQ + h * 64 + wid * 8, (unsigned)__builtin_amdgcn_readfirstlane(kdst + so_)); \
      glds16(VA + (krow_ + 16 * (wid & 3) + (lane >> 2)) * PQ + h * 64 + (wid >> 2) * 32 + (lane & 3) * 8, (unsigned)__builtin_amdgcn_readfirstlane(vdst + so_)); } while (0)
  asm volatile("s_waitcnt lgkmcnt(0)\n\ts_barrier" ::: "memory");
  NA_DMA(0);
  for (int ti = 0; ti < ntiles; ++ti) {
    const int kr = kr_lo + ti - 4;
    asm volatile("s_waitcnt vmcnt(0) lgkmcnt(0)\n\ts_barrier" ::: "memory");
    if (ti + 1 < ntiles) NA_DMA(ti + 1);
    const unsigned so = (ti & 1) * SLOTB;
    const bool valid = (ti < 4) || (kr >= r0 && kr <= r0 + 7);
    if (valid) {
      f32x16 p0, p1; const f32x16 z = f32x16{};
      qkt(p0, p1, shm3 + LDS_K + so, qr, z, r32, hi);
      if (ti >= 4) {
        const int dr = kr - rq + 7;
        #pragma unroll
        for (int r = 0; r < 16; ++r) { const int k0 = crow(r, hi), k1 = k0 + 32;
          const bool v0 = (k0 >= c0) && (k0 < c0 + 16), v1 = (k1 >= c0) && (k1 < c0 + 16);
          const float b0 = v0 ? rp[dr * 31 + (k0 - qc + 15)] : 0.f, b1 = v1 ? rp[dr * 31 + (k1 - qc + 15)] : 0.f;
          p0[r] = v0 ? p0[r] + b0 : -INFINITY; p1[r] = v1 ? p1[r] + b1 : -INFINITY; }
      }
      float rm = p0[0];
      #pragma unroll
      for (int r = 1; r < 16; ++r) rm = fmaxf(rm, p0[r]);
      #pragma unroll
      for (int r = 0; r < 16; ++r) rm = fmaxf(rm, p1[r]);
      { auto rr = __builtin_amdgcn_permlane32_swap(__float_as_uint(rm), __float_as_uint(rm), false, false); rm = fmaxf(__uint_as_float(rr[0]), __uint_as_float(rr[1])); }
      const float mnew = fmaxf(mrun, rm); const float f = __builtin_amdgcn_exp2f(mrun - mnew); mrun = mnew;
      float sacc = 0.f;
      #pragma unroll
      for (int r = 0; r < 16; ++r) { p0[r] = __builtin_amdgcn_exp2f(p0[r] - mnew); p1[r] = __builtin_amdgcn_exp2f(p1[r] - mnew); sacc += p0[r] + p1[r]; }
      l_reg = l_reg * f + sacc;
      if (hi == 0) wsf[r32] = f;
      asm volatile("s_waitcnt lgkmcnt(0)" ::: "memory");
      #pragma unroll
      for (int d_ = 0; d_ < 2; ++d_)
        #pragma unroll
        for (int r = 0; r < 16; ++r) o[d_][r] *= wsf[crow(r, hi)];
      u32x4 pw0, pw1, pw2, pw3;
      pw0 = (u32x4){cvtpk(p0[0], p0[1]), cvtpk(p0[2], p0[3]), cvtpk(p0[4], p0[5]), cvtpk(p0[6], p0[7])}; pw1 = (u32x4){cvtpk(p0[8], p0[9]), cvtpk(p0[10], p0[11]), cvtpk(p0[12], p0[13]), cvtpk(p0[14], p0[15])};
      pw2 = (u32x4){cvtpk(p1[0], p1[1]), cvtpk(p1[2], p1[3]), cvtpk(p1[4], p1[5]), cvtpk(p1[6], p1[7])}; pw3 = (u32x4){cvtpk(p1[8], p1[9]), cvtpk(p1[10], p1[11]), cvtpk(p1[12], p1[13]), cvtpk(p1[14], p1[15])};
      asm volatile("s_waitcnt lgkmcnt(0)" ::: "memory");
      pv(o, vb0 + (int)so, __builtin_bit_cast(bf16x8, pw0), __builtin_bit_cast(bf16x8, pw1), __builtin_bit_cast(bf16x8, pw2), __builtin_bit_cast(bf16x8, pw3));
    }
  }
  #undef NA_DMA
  { auto rr = __builtin_amdgcn_permlane32_swap(__float_as_uint(l_reg), __float_as_uint(l_reg), false, false); l_reg = __uint_as_float(rr[0]) + __uint_as_float(rr[1]); }
  if (hi == 0) wsf[32 + r32] = l_reg; asm volatile("s_waitcnt lgkmcnt(0)" ::: "memory");
  bf16_t* stg = (bf16_t*)(shm + LDS_OST) + wid * 2048;
  #pragma unroll
  for (int r = 0; r < 16; ++r) { const int orow = crow(r, hi); const float rl = __builtin_amdgcn_rcpf(wsf[32 + orow]);
    #pragma unroll
    for (int d0 = 0; d0 < 2; ++d0) stg[orow * 64 + d0 * 32 + r32] = f2bf(o[d0][r] * rl); }
  asm volatile("s_waitcnt lgkmcnt(0)" ::: "memory");
  bf16* Ow = YS + (rowb + CTXL + rq * 64 + 32 * (wid & 1)) * 1024 + h * 64;
  #pragma unroll
  for (int i = 0; i < 4; ++i) { const int row = i * 8 + (lane >> 3), ch = lane & 7; const u32x4 v = *(const u32x4*)(stg + row * 64 + ch * 8); *(u32x4*)(Ow + (long)row * 1024 + ch * 8) = v; }
  asm volatile("s_waitcnt lgkmcnt(0)\n\ts_barrier" ::: "memory");
}
#undef SBAR
#undef WAIT_BAR
}

__device__ __forceinline__ void sgu_unit(long rowbase, const bf16_t* GU, const bf16_t* GV, const float* ng, const float* sw, const float* sb, bf16_t* YS, char* shm) {
    using attn_body::crow;
    const int tid = opaque_tid(), lane = tid & 63, wid = __builtin_amdgcn_readfirstlane(tid >> 6), r32 = lane & 31, hi = lane >> 5;
    const unsigned lds0 = (unsigned)(uintptr_t)shm;
    {
        const f32x4 g4 = *(const f32x4*)(ng + 4 * lane);
        const int gl = lane >> 4, d = 4 * (lane & 15);
#pragma unroll
        for (int rb = 0; rb < 4; ++rb) { v2u raw[4];
#pragma unroll
            for (int q4 = 0; q4 < 4; ++q4) raw[q4] = *(const v2u*)(GV + (rowbase + wid * 16 + rb * 4 + q4) * PQ + 4 * lane);
            __builtin_amdgcn_sched_barrier(0);
#pragma unroll
            for (int q4 = 0; q4 < 4; ++q4) { const int q = wid * 16 + rb * 4 + q4;
                f32x4 v = {bflo(raw[q4].x), bfhi(raw[q4].x), bflo(raw[q4].y), bfhi(raw[q4].y)};
                const float mean = wave_sum((v.x + v.y) + (v.z + v.w)) * (1.0f / 256.0f);
                v = v - mean;
                const float var = wave_sum((v.x * v.x + v.y * v.y) + (v.z * v.z + v.w * v.w)) * (1.0f / 256.0f);
                const float rstd = __builtin_amdgcn_rsqf(var + EPS);
                v = v * rstd * g4;
                v2u w; w.x = cvtpk(v.x, v.y); w.y = cvtpk(v.z, v.w);
                const int k = q & 63;
                *(v2u*)(shm + (2 * gl + (q >> 6)) * 8192 + ((d >> 5) * 4 + (k >> 4)) * 1024 + (k & 15) * 64 + (d & 31) * 2) = w; }
            __builtin_amdgcn_sched_barrier(0); }
    }
    __syncthreads();
    const int g = wid & 3, ph = wid >> 2;
    const int vb0 = (int)lds0 + ((lane >> 4) & 1) * 32 + (lane & 3) * 8 + (4 * hi + ((lane & 15) >> 2)) * 64;
    bf16_t* stg = (bf16_t*)(shm + 65536) + wid * 2048;
#pragma unroll
    for (int mt = 0; mt < 2; ++mt) {
        const int p0 = ph * 64 + mt * 32;
        const float* wrow = sw + ((size_t)g * 128 + p0 + r32) * 128 + 4 * hi;
        f32x16 o[2]; o[0] = f32x16{}; o[1] = f32x16{};
#pragma unroll
        for (int sl = 0; sl < 2; ++sl) {
            f32x4 wa[4], wc[4];
#pragma unroll
            for (int s4 = 0; s4 < 4; ++s4) { wa[s4] = *(const f32x4*)(wrow + 64 * sl + 16 * s4); wc[s4] = *(const f32x4*)(wrow + 64 * sl + 16 * s4 + 8); }
            __builtin_amdgcn_sched_barrier(0);
            bf16x8 pa[4];
#pragma unroll
            for (int s4 = 0; s4 < 4; ++s4) { const v4u w = {cvtpk(wa[s4].x, wa[s4].y), cvtpk(wa[s4].z, wa[s4].w), cvtpk(wc[s4].x, wc[s4].y), cvtpk(wc[s4].z, wc[s4].w)}; pa[s4] = __builtin_bit_cast(bf16x8, w); }
            attn_body::pv(o, vb0 + (2 * g + sl) * 8192, pa[0], pa[1], pa[2], pa[3]);
        }
        float bias[16];
#pragma unroll
        for (int r = 0; r < 16; ++r) bias[r] = sb[g * 128 + p0 + crow(r, hi)];
        v4u uu[4];
#pragma unroll
        for (int i = 0; i < 4; ++i) uu[i] = *(const v4u*)(GU + (rowbase + p0 + i * 8 + (lane >> 3)) * PQ + g * 64 + (lane & 7) * 8);
        __builtin_amdgcn_sched_barrier(0);
#pragma unroll
        for (int r = 0; r < 16; ++r) { const int orow = crow(r, hi);
#pragma unroll
            for (int d0 = 0; d0 < 2; ++d0) stg[orow * 64 + d0 * 32 + r32] = f2bf(o[d0][r] + bias[r]); }
        asm volatile("s_waitcnt lgkmcnt(0)" ::: "memory");
#pragma unroll
        for (int i = 0; i < 4; ++i) { const int row = i * 8 + (lane >> 3), ch = lane & 7; const v4u mv = *(const v4u*)(stg + row * 64 + ch * 8); const v4u u4 = uu[i];
            v4u w; w.x = cvtpk(bflo(u4.x) * bflo(mv.x), bfhi(u4.x) * bfhi(mv.x)); w.y = cvtpk(bflo(u4.y) * bflo(mv.y), bfhi(u4.y) * bfhi(mv.y));
            w.z = cvtpk(bflo(u4.z) * bflo(mv.z), bfhi(u4.z) * bfhi(mv.z)); w.w = cvtpk(bflo(u4.w) * bflo(mv.w), bfhi(u4.w) * bfhi(mv.w));
            *(v4u*)(YS + (rowbase + p0 + row) * 1024 + 512 + g * 64 + ch * 8) = w; }
        asm volatile("s_waitcnt lgkmcnt(0)" ::: "memory");
    }
    __syncthreads();
}

typedef GAS unsigned gu32;
#define XB_TMO      128
#define XB_XCNT(j)  (256  + 64 * (j))
#define XB_XSUB(j)  (1280 + 64 * (j))
#define XB_XGEN(j)  (2304 + 64 * (j))
#define XB_TOP      3328
#define XB_TOPGEN   3392
#define XCD_BAR_WORDS 3456
#define XB_SPIN_CAP (1u << 18)
__device__ __forceinline__ unsigned xb_ld(unsigned* p)              { return __hip_atomic_load(p, __ATOMIC_RELAXED, __HIP_MEMORY_SCOPE_AGENT); }
__device__ __forceinline__ unsigned xb_add(unsigned* p, unsigned v) { return __hip_atomic_fetch_add(p, v, __ATOMIC_RELAXED, __HIP_MEMORY_SCOPE_AGENT); }
__device__ __forceinline__ unsigned xb_xcc_id() { return (unsigned)__builtin_amdgcn_s_getreg((3 << 11) | 20) & 0xFu; }
#define XB_SPIN(cond, bar) do { unsigned _sp = 0; while (cond) { __builtin_amdgcn_s_sleep(1); \
    if ((++_sp & 255u) == 0u) { if (xb_ld(&(bar)[XB_TMO])) break; if (_sp > XB_SPIN_CAP) { atomicAdd(&(bar)[XB_TMO], 1u); break; } } } } while (0)
struct XcdBarrier { unsigned* bar; unsigned x; volatile LAS unsigned* st; };
__device__ __forceinline__ XcdBarrier xcd_barrier_post(unsigned* bar, volatile LAS unsigned* st) {
    XcdBarrier b; b.bar = bar; b.x = xb_xcc_id(); b.st = st;
    if (threadIdx.x == 0) (void)xb_add(&bar[XB_XCNT(b.x)], 1u);
    return b;
}
__device__ __forceinline__ void xcd_barrier_complete(unsigned* bar, unsigned x, unsigned& nloc, unsigned& nx) {
    const unsigned G = gridDim.x * gridDim.y * gridDim.z;
    unsigned sum, cnt, mine, sp = 0u;
    for (;;) {
        sum = 0u; cnt = 0u; mine = 0u;
#pragma unroll
        for (unsigned j = 0; j < 16; ++j) { const unsigned c = xb_ld(&bar[XB_XCNT(j)]); sum += c; cnt += (c > 0u) ? 1u : 0u; }
        if (sum == G) break;
        __builtin_amdgcn_s_sleep(1);
        if ((++sp & 255u) == 0u) { if (xb_ld(&bar[XB_TMO])) break; if (sp > XB_SPIN_CAP) { atomicAdd(&bar[XB_TMO], 1u); break; } }
    }
    mine = xb_ld(&bar[XB_XCNT(x)]);
    nloc = mine > 0u ? mine : 1u; nx = cnt > 0u ? cnt : 1u;
}
__device__ __forceinline__ void xcd_barrier(const XcdBarrier& b) {
    asm volatile("s_waitcnt vmcnt(0)" ::: "memory");
    __syncthreads();
    if (threadIdx.x == 0) {
        unsigned* bar = b.bar;
        __builtin_amdgcn_s_waitcnt(0);
        unsigned nloc = b.st[0], nx = b.st[1];
        if (nloc == 0u) { xcd_barrier_complete(bar, b.x, nloc, nx); b.st[0] = nloc; b.st[1] = nx; }
        const unsigned old = xb_add(&bar[XB_XSUB(b.x)], 1u);
        const unsigned gen = old / nloc;
        if (old + 1u == (gen + 1u) * nloc) {
            __builtin_amdgcn_fence(__ATOMIC_RELEASE, "agent");
            asm volatile("s_waitcnt vmcnt(0)" ::: "memory");
            const unsigned og = xb_add(&bar[XB_TOP], 1u);
            const unsigned tg = og / nx;
            if (og + 1u == (tg + 1u) * nx) xb_add(&bar[XB_TOPGEN], 1u);
            else XB_SPIN(xb_ld(&bar[XB_TOPGEN]) == tg, bar);
            __builtin_amdgcn_fence(__ATOMIC_ACQUIRE, "agent");
            xb_add(&bar[XB_XGEN(b.x)], 1u);
            asm volatile("s_waitcnt vmcnt(0)" ::: "memory");
        } else {
            XB_SPIN(xb_ld(&bar[XB_XGEN(b.x)]) == gen, bar);
            __builtin_amdgcn_fence(__ATOMIC_ACQUIRE, "agent");
            asm volatile("s_waitcnt vmcnt(0)" ::: "memory");
        }
    }
    __syncthreads();
}

struct Args { const float* in[28]; float* out; unsigned char* ws; int ph_lo, ph_hi, li, pad; };
typedef const __attribute__((address_space(4))) Args* KArgs;
__device__ __forceinline__ KArgs opaque_kargs() { KArgs p = (KArgs)__builtin_amdgcn_kernarg_segment_ptr(); asm volatile("" : "+s"(p)); return p; }
enum { I_X = 0, I_C, I_CTX, I_CCTX, I_WMOD, I_BMOD, I_N1G, I_N2G, I_WIN, I_QG, I_KG, I_RPB, I_LQ1, I_LK1, I_LQ2, I_LK2, I_SUBG, I_SGUNG, I_SGUW, I_SGUB, I_GATEB, I_WBR, I_WOUT, I_WRT, I_WEG, I_WEU, I_WED, I_FG };

constexpr int CW_WIN = 16 * 26, CW_WB = 4 * 4 * 4, CW_WO = 16 * 4, CW_EG = 16 * 16 * 8, CW_ED = 16 * 32 * 4, CW_LAYER = CW_WIN + CW_WB + CW_WO + 2 * CW_EG + CW_ED;
struct ConvItem { const float* src; unsigned char* dst; int N, dpitch, k0, n0, kind, aux; };
__device__ __forceinline__ ConvItem conv_decode(KArgs A, int it) {
    ConvItem c; const int l = it / CW_LAYER; int r = it % CW_LAYER; unsigned char* wl = A->ws + WS_W0 + (size_t)l * W_LAYER; c.aux = 0;
    if (r < CW_WIN) { const int kb = r / 26, pn = r % 26; c.src = A->in[I_WIN] + (size_t)l * DM * IN_W; c.N = IN_W; c.k0 = 64 * kb; c.n0 = 256 * pn; c.dpitch = DM;
        if (pn >= 5 && pn <= 20) { c.kind = 1; c.dst = wl + WO_WING + (size_t)(c.n0 - 1280) * DM; } else { c.kind = 2; c.dst = wl + WO_WIN + (size_t)256 * (pn < 5 ? pn : pn - 16) * DM * 2; }
        return c; }
    r -= CW_WIN;
    if (r < CW_WB) { const int n = r / 16, q = r % 16, kb = q / 4, nb = q % 4; c.src = A->in[I_WBR] + ((size_t)l * 4 + n) * 256 * DM; c.N = DM; c.k0 = 64 * kb; c.n0 = 256 * nb; c.dpitch = 256; c.kind = 0; c.dst = wl + WO_WB + ((size_t)n * 1024 + c.n0) * 256 * 2; return c; }
    r -= CW_WB;
    if (r < CW_WO) { const int kb = r / 4, nb = r % 4; c.src = A->in[I_WOUT] + (size_t)l * DM * DM; c.N = DM; c.k0 = 64 * kb; c.n0 = 256 * nb; c.dpitch = DM; c.kind = 0; c.dst = wl + WO_WO4 + (size_t)c.n0 * DM * 2; return c; }
    r -= CW_WO;
    if (r < 2 * CW_EG) { const int up = r >= CW_EG; if (up) r -= CW_EG; const int e = r / 128, q = r % 128, kb = q / 8, nb = q % 8; c.src = A->in[up ? I_WEU : I_WEG] + ((size_t)l * NEXP + e) * DM * EH; c.N = EH; c.k0 = 64 * kb; c.n0 = 256 * nb; c.dpitch = DM;
        c.kind = 3; c.aux = up ? 128 : 0; c.dst = wl + WO_WGU + (size_t)e * 4096 * DM; return c; }
    r -= 2 * CW_EG;
    { const int e = r / 128, q = r % 128, kb = q / 4, nb = q % 4; c.src = A->in[I_WED] + ((size_t)l * NEXP + e) * EH * DM; c.N = DM; c.k0 = 64 * kb; c.n0 = 256 * nb; c.dpitch = EH; c.kind = 1; c.dst = wl + WO_WD + ((size_t)e * DM + c.n0) * EH; return c; }
}
constexpr int CW_SMALL = CW_WIN + CW_WB + CW_WO, CW_MOE = 2 * CW_EG + CW_ED;
template <bool SMALL> __device__ __forceinline__ int conv_id(int it) { return SMALL ? (it / CW_SMALL) * CW_LAYER + it % CW_SMALL : it; }
template <bool SMALL> __device__ __forceinline__ void conv_load(KArgs A, int it, int NIT, f32x4 (&rg)[8], int wv, int lane) {
    if (it < NIT) { const ConvItem c = conv_decode(A, conv_id<SMALL>(it)); const float* p = c.src + (size_t)(c.k0 + wv * 8) * c.N + c.n0 + 4 * lane;
#pragma unroll
        for (int i = 0; i < 8; ++i) rg[i] = *(const f32x4*)(p + (size_t)i * c.N); }
}
template <bool SMALL> __device__ __forceinline__ void conv_out(KArgs A, int it, const f32x4 (&rg)[8], LAS float* T, int tid, int wv, int lane) {
    constexpr int TP = 256;
#pragma unroll
    for (int i = 0; i < 8; ++i) *(LAS f32x4*)(T + (wv * 8 + i) * TP + 4 * (lane ^ wv)) = rg[i];
    asm volatile("s_waitcnt lgkmcnt(0)" ::: "memory"); __builtin_amdgcn_s_barrier(); asm volatile("" ::: "memory");
    const ConvItem c = conv_decode(A, conv_id<SMALL>(it));
#pragma unroll
    for (int jj = 0; jj < 4; ++jj) { const int q = tid + 512 * jj, ch = q & 7, n = q >> 3; const LAS float* t = T + (8 * ch) * TP + (n ^ (4 * ch));
        float v[8];
#pragma unroll
        for (int i = 0; i < 8; ++i) v[i] = t[i * TP];
        if (c.kind == 1) { v2u o; o.x = pk8(v[0] * W8S, v[1] * W8S, v[2] * W8S, v[3] * W8S); o.y = pk8(v[4] * W8S, v[5] * W8S, v[6] * W8S, v[7] * W8S); *(v2u*)(c.dst + (size_t)n * c.dpitch + c.k0 + 8 * ch) = o; }
        else if (c.kind == 3) { const int f = c.n0 + n; v2u o; o.x = pk8(v[0] * W8S, v[1] * W8S, v[2] * W8S, v[3] * W8S); o.y = pk8(v[4] * W8S, v[5] * W8S, v[6] * W8S, v[7] * W8S); *(v2u*)(c.dst + (size_t)(256 * (f >> 7) + (f & 127) + c.aux) * c.dpitch + c.k0 + 8 * ch) = o; }
        else { const int g = n >> 5, row = c.kind == 2 ? 32 * (4 * (g & 1) + (g >> 1)) + (n & 31) : n; st8((bf16_t*)c.dst + (size_t)row * c.dpitch + c.k0 + 8 * ch, v); } }
    asm volatile("s_waitcnt lgkmcnt(0)" ::: "memory"); __builtin_amdgcn_s_barrier(); asm volatile("" ::: "memory");
}
template <bool SMALL = false> __device__ __forceinline__ void conv_run(KArgs A, int first, int stride, int end, LAS unsigned char* lds, int tid) {
    const int lane = tid & 63, wv = tid >> 6; LAS float* T = (LAS float*)lds;
    f32x4 rg[4][8];
#pragma unroll
    for (int d = 0; d < 4; ++d) conv_load<SMALL>(A, first + d * stride, end, rg[d], wv, lane);
    for (int it = first; it < end; it += 4 * stride) {
#pragma unroll
        for (int d = 0; d < 4; ++d) if (it + d * stride < end) {
            f32x4 t0[8];
#pragma unroll
            for (int i = 0; i < 8; ++i) t0[i] = rg[d][i];
            conv_load<SMALL>(A, it + (4 + d) * stride, end, rg[d], wv, lane);
            conv_out<SMALL>(A, it + d * stride, t0, T, tid, wv, lane);
        }
    }
}
__device__ __forceinline__ void mod_item(KArgs A, int item, LAS unsigned char* lds, int tid) {
    const int lane = tid & 63, wid = tid >> 6, l = item / 96, col0 = 64 * (item % 96);
    LAS float* sil = (LAS float*)lds;
    LAS float* part = sil + 3 * 1024;
    for (int i = tid; i < 3 * 1024; i += 512) { const int r = i >> 10, k = i & 1023; const float cv = r < 2 ? A->in[I_C][r * DM + k] : A->in[I_CCTX][k]; sil[i] = siluf_(cv); }
    __syncthreads();
    const float* W = A->in[I_WMOD] + (size_t)l * DM * 6144 + col0 + lane;
    float a0 = 0.f, a1 = 0.f, a2 = 0.f;
    for (int kb = 0; kb < 4; ++kb) { float w[32];
#pragma unroll
        for (int q = 0; q < 32; ++q) w[q] = W[(size_t)(wid * 128 + kb * 32 + q) * 6144];
        __builtin_amdgcn_sched_barrier(0);
#pragma unroll
        for (int q = 0; q < 32; ++q) { const int k = wid * 128 + kb * 32 + q; a0 += sil[k] * w[q]; a1 += sil[1024 + k] * w[q]; a2 += sil[2048 + k] * w[q]; }
        __builtin_amdgcn_sched_barrier(0); }
    part[(wid * 3 + 0) * 64 + lane] = a0; part[(wid * 3 + 1) * 64 + lane] = a1; part[(wid * 3 + 2) * 64 + lane] = a2;
    __syncthreads();
    if (tid < 192) { const int r = tid >> 6, cl = tid & 63; float s = A->in[I_BMOD][(size_t)l * 6144 + col0 + cl];
#pragma unroll
        for (int w = 0; w < 8; ++w) s += part[(w * 3 + r) * 64 + cl];
        ((float*)(A->ws + WS_MOD))[((size_t)l * 3 + r) * 6144 + col0 + cl] = s; }
    __syncthreads();
}

struct Row { f32x4 v[4]; };
__device__ __forceinline__ Row row_load(const float* p, int lane) { Row r; const f32x4* q = (const f32x4*)p + lane;
#pragma unroll
    for (int j = 0; j < 4; ++j) r.v[j] = q[64 * j]; return r; }
__device__ __forceinline__ Row row_load_bf16(const bf16_t* p, int lane) { Row r; const v2u* q = (const v2u*)p + lane; v2u t[4];
#pragma unroll
    for (int j = 0; j < 4; ++j) t[j] = q[64 * j];
#pragma unroll
    for (int j = 0; j < 4; ++j) r.v[j] = (f32x4){bflo(t[j].x), bfhi(t[j].x), bflo(t[j].y), bfhi(t[j].y)};
    return r; }
__device__ __forceinline__ void row_store(float* p, const Row& r, int lane) { f32x4* q = (f32x4*)p + lane;
#pragma unroll
    for (int j = 0; j < 4; ++j) q[64 * j] = r.v[j]; }
__device__ __forceinline__ float row_rstd(const Row& r) { float s = 0.f;
#pragma unroll
    for (int j = 0; j < 4; ++j) s += (r.v[j].x * r.v[j].x + r.v[j].y * r.v[j].y) + (r.v[j].z * r.v[j].z + r.v[j].w * r.v[j].w);
    return __builtin_amdgcn_rsqf(wave_sum(s) * (1.0f / DM) + EPS); }
__device__ __forceinline__ Row row_normmod(const Row& x, float rstd, const float* g, const float* sh, const float* sc, int lane) { Row y; f32x4 gg[4], ss[4], hh[4];
#pragma unroll
    for (int j = 0; j < 4; ++j) { gg[j] = ((const f32x4*)g)[lane + 64 * j]; ss[j] = ((const f32x4*)sc)[lane + 64 * j]; hh[j] = ((const f32x4*)sh)[lane + 64 * j]; }
    __builtin_amdgcn_sched_barrier(0);
#pragma unroll
    for (int j = 0; j < 4; ++j) y.v[j] = x.v[j] * rstd * gg[j] * (ss[j] + 1.0f) + hh[j];
    return y; }
struct NormP { f32x4 a[4], h[4]; };
__device__ __forceinline__ NormP normp_load(const float* g, const float* sh, const float* sc, int lane) { NormP p; f32x4 gg[4], ss[4];
#pragma unroll
    for (int j = 0; j < 4; ++j) { gg[j] = ((const f32x4*)g)[lane + 64 * j]; ss[j] = ((const f32x4*)sc)[lane + 64 * j]; p.h[j] = ((const f32x4*)sh)[lane + 64 * j]; }
    __builtin_amdgcn_sched_barrier(0);
#pragma unroll
    for (int j = 0; j < 4; ++j) p.a[j] = gg[j] * (ss[j] + 1.0f);
    return p; }
__device__ __forceinline__ Row row_normmod_p(const Row& x, float rstd, const NormP& p) { Row y;
#pragma unroll
    for (int j = 0; j < 4; ++j) y.v[j] = x.v[j] * rstd * p.a[j] + p.h[j];
    return y; }
__device__ __forceinline__ void row_store_bf16(bf16_t* p, const Row& r, int lane) { v2u* q = (v2u*)p + lane;
#pragma unroll
    for (int j = 0; j < 4; ++j) { v2u w; w.x = cvtpk(r.v[j].x, r.v[j].y); w.y = cvtpk(r.v[j].z, r.v[j].w); q[64 * j] = w; } }
__device__ __forceinline__ void row_store_fp8(unsigned char* p, const Row& r, int lane) { unsigned* q = (unsigned*)p + lane;
#pragma unroll
    for (int j = 0; j < 4; ++j) q[64 * j] = pk8(r.v[j].x, r.v[j].y, r.v[j].z, r.v[j].w); }
__device__ __forceinline__ const float* in_row(KArgs A, int R) { const int b = R / RB, r = R % RB; return r < CTXL ? A->in[I_CTX] + ((size_t)b * CTXL + r) * DM : A->in[I_X] + ((size_t)b * SEQ + (r - CTXL)) * DM; }
__device__ __forceinline__ int mod_row(int R) { const int b = R / RB, r = R % RB; return r < CTXL ? 2 : b; }

__device__ __forceinline__ int lat_tile(int im) { return (im >> 5) * TPB + 1 + (im & 31); }
struct SchedP1 { const char* HN; const char* W; int layer, G, c;
    __device__ __forceinline__ bool next(int i, pg8::Unit& u) const {
        const int nmain = 64 * 10, nextra = layer == 0 ? 2 * 10 : 2 * 5; const int L = i * G + c; if (L >= nmain + nextra) return false;
        int pm, pq;
        if (L < nmain) { int im, in; pg8::rect_order(L, 64, 10, im, in); pm = lat_tile(im); pq = in; }
        else { const int x = L - nmain; if (layer == 0) { pm = (x / 10) * TPB; pq = x % 10; } else { pm = (x / 5) * TPB; pq = 5 + x % 5; } }
        u.pm = pm; u.pn = pq < 5 ? pq : pq + 16; u.a = HN + (size_t)pm * 256 * DM * 2; u.b = W + (size_t)pq * 256 * DM * 2; return true; } };
struct SchedP1g { const char* HN8; const char* W8; int layer, G, c;
    __device__ __forceinline__ bool next(int i, pg8::Unit& u) const {
        const int nmain = 64 * 16, nextra = layer == 0 ? 2 * 16 : 0; const int L = i * G + (G - 1 - c); if (L >= nmain + nextra) return false;
        int pm, pn;
        if (L < nmain) { int im; pg8::rect_order(L, 64, 16, im, pn); pm = lat_tile(im); }
        else { const int x = L - nmain; pm = (x >> 4) * TPB; pn = x & 15; }
        u.pm = pm; u.pn = pn; u.a = HN8 + (size_t)pm * 256 * DM; u.b = W8 + (size_t)pn * 256 * DM; return true; } };
struct SchedP3a { const char* YS; const char* WB; int layer, G, c;
    __device__ __forceinline__ bool next(int i, pg8::Unit& u) const {
        int pm, dt, n;
        if (i < 4) { if (c >= 256) return false; int im; pg8::rect_order(c, 64, 4, im, dt); pm = lat_tile(im); n = i; }
        else { if (i > 4 || layer != 0 || c >= 32) return false; pm = (c >> 4) * TPB; dt = (c >> 2) & 3; n = c & 3; }
        u.pm = pm; u.pn = dt * 4 + n; u.a = YS + ((size_t)pm * 256 * DM + 256 * n) * 2; u.b = WB + ((size_t)n * 1024 + dt * 256) * 256 * 2; return true; } };
struct SchedP3b { const char* MRG; const char* WO; int G, c;
    __device__ __forceinline__ bool next(int i, pg8::Unit& u) const {
        const int L = i * G + c; if (L >= 64 * 4) return false;
        int im, in; pg8::rect_order(L, 64, 4, im, in); const int pm = lat_tile(im);
        u.pm = pm; u.pn = in; u.a = MRG + (size_t)pm * 256 * DM * 2; u.b = WO + (size_t)in * 256 * DM * 2; return true; } };
struct SchedP3c { const char* GPC; const char* WO; int G, c;
    __device__ __forceinline__ bool next(int i, pg8::Unit& u) const {
        const int L = i * G + c; if (L >= 128) return false;
        const int pm = L >> 6, ks = (L >> 2) & 15, ct = L & 3, n = ks >> 2, kq = ks & 3;
        u.pm = pm; u.pn = ks * 4 + ct; u.a = GPC + (((size_t)n * 512 + pm * 256) * DM + kq * 256) * 2; u.b = WO + ((size_t)ct * 256 * DM + kq * 256) * 2; return true; } };
struct SchedP6 { const char* XG; const char* WGU; int RT, G, c;
    __device__ __forceinline__ bool next(int i, pg8::Unit& u) const {
        const int nM = 16 * RT; const int L = i * G + c; if (L >= nM * 16) return false;
        int im, in; pg8::rect_order(L, nM, 16, im, in); const int e = im / RT;
        u.pm = im; u.pn = in; u.a = XG + (size_t)im * 256 * DM; u.b = WGU + ((size_t)e * 4096 + in * 256) * DM; return true; } };
struct SchedP7 { const char* HID; const char* WD; int RT, G, c;
    __device__ __forceinline__ bool next(int i, pg8::Unit& u) const {
        const int nM = 16 * 8; const int L = i * G + c; if (L >= nM * 4) return false;
        int im8, in; pg8::rect_order(L, nM, 4, im8, in); const int e = im8 >> 3, im = e * RT + (im8 & 7);
        u.pm = im; u.pn = in; u.a = HID + (size_t)im * 256 * EH; u.b = WD + ((size_t)e * DM + in * 256) * EH; return true; } };
struct SchedP7c { const char* HID; const char* WD; int G, c;
    __device__ __forceinline__ bool next(int i, pg8::Unit& u) const {
        const int L = i * G + c; if (L >= 256) return false;
        const int e = L >> 4, in = (L >> 2) & 3, kq = L & 3, im = e * 9 + 8;
        u.pm = im; u.pn = in + 4 * kq; u.a = HID + (size_t)im * 256 * EH + kq * 512; u.b = WD + ((size_t)e * DM + in * 256) * EH + kq * 512; return true; } };

__device__ __forceinline__ unsigned block_excl_scan(unsigned v, LAS unsigned* wtot, int lane, int wid) {
    unsigned inc = v;
#pragma unroll
    for (int o = 1; o < 64; o <<= 1) { const unsigned t = (unsigned)__builtin_amdgcn_ds_bpermute(((lane - o) & 63) << 2, (int)inc); if (lane >= o) inc += t; }
    if (lane == 63) wtot[wid] = inc;
    __syncthreads();
    unsigned base = 0;
#pragma unroll
    for (int w = 0; w < 8; ++w) base += (w < wid) ? wtot[w] : 0u;
    __syncthreads();
    return base + inc - v;
}
__device__ __forceinline__ void topk_unit(KArgs A, int RT, bool isctx, int b, int e, LAS unsigned char* lds, int tid) {
    const int lane = tid & 63, wid = tid >> 6;
    LAS unsigned* hist = (LAS unsigned*)lds; LAS unsigned* wtot = hist + 256; LAS unsigned* sel = wtot + 16;
    const int cap = isctx ? 32 : 1024;
    const float* aff = isctx ? (const float*)(A->ws + WS_AFFC) + ((size_t)b * 16 + e) * 256 : (const float*)(A->ws + WS_AFFL) + ((size_t)b * 16 + e) * 8192;
    unsigned key[16];
    if (isctx) {
#pragma unroll
        for (int j = 0; j < 16; ++j) key[j] = 0u;
        if (tid < 256) key[0] = __float_as_uint(aff[tid]);
    } else {
#pragma unroll
        for (int q = 0; q < 4; ++q) { const f32x4 t = *(const f32x4*)(aff + tid * 16 + 4 * q); key[4 * q] = __float_as_uint(t.x); key[4 * q + 1] = __float_as_uint(t.y); key[4 * q + 2] = __float_as_uint(t.z); key[4 * q + 3] = __float_as_uint(t.w); }
    }
#define TK_VALID(j) (isctx ? ((j) == 0 && tid < 256) : true)
    unsigned pfx = 0u, need = (unsigned)cap;
    for (int pass = 0; pass < 4; ++pass) { const int shift = 24 - 8 * pass;
        for (int i = tid; i < 256; i += 512) hist[i] = 0u;
        __syncthreads();
#pragma unroll
        for (int j = 0; j < 16; ++j) if (TK_VALID(j) && (pass == 0 || (key[j] >> (shift + 8)) == pfx)) __hip_atomic_fetch_add(&hist[(key[j] >> shift) & 255u], 1u, __ATOMIC_RELAXED, __HIP_MEMORY_SCOPE_WORKGROUP);
        __syncthreads();
        if (wid == 0) {
            const unsigned h0 = hist[4 * lane], h1 = hist[4 * lane + 1], h2 = hist[4 * lane + 2], h3 = hist[4 * lane + 3], s = h0 + h1 + h2 + h3;
            unsigned incl = s;
#pragma unroll
            for (int o = 1; o < 64; o <<= 1) { const unsigned t = (unsigned)__builtin_amdgcn_ds_bpermute(((lane + o) & 63) << 2, (int)incl); if (lane + o < 64) incl += t; }
            const unsigned excl = incl - s;
            if (excl < need && need <= incl) { unsigned c = excl; int bin;
                if (c + h3 >= need) bin = 3; else { c += h3; if (c + h2 >= need) bin = 2; else { c += h2; if (c + h1 >= need) bin = 1; else { c += h1; bin = 0; } } }
                sel[0] = (unsigned)(4 * lane + bin); sel[1] = need - c; }
        }
        __syncthreads();
        pfx = (pfx << 8) | sel[0]; need = sel[1];
        __syncthreads();
    }
    const unsigned T = pfx;
    unsigned ce = 0u;
#pragma unroll
    for (int j = 0; j < 16; ++j) ce += (TK_VALID(j) && key[j] == T) ? 1u : 0u;
    unsigned re = block_excl_scan(ce, wtot, lane, wid);
    unsigned selmask = 0u, cs = 0u;
#pragma unroll
    for (int j = 0; j < 16; ++j) if (TK_VALID(j)) { bool s = key[j] > T; if (key[j] == T) { s = re < need; ++re; } if (s) { selmask |= 1u << j; ++cs; } }
    unsigned slot = block_excl_scan(cs, wtot, lane, wid);
    int* IDXROW = (int*)(A->ws + WS_IDXROW); float* SCORE = (float*)(A->ws + WS_SCORE); int* INV = (int*)(A->ws + WS_INV);
    const int ybase = e * RT * 256 + (isctx ? 2048 + b * 32 : b * 1024);
#pragma unroll
    for (int j = 0; j < 16; ++j) if (TK_VALID(j)) { const int idx = isctx ? tid : tid * 16 + j; const int R = b * RB + (isctx ? idx : CTXL + idx);
        if (selmask & (1u << j)) { const int yrow = ybase + (int)slot; IDXROW[yrow] = R; SCORE[yrow] = __uint_as_float(key[j]); INV[((size_t)b * 16 + e) * RB + (R - b * RB)] = yrow; ++slot; }
        else INV[((size_t)b * 16 + e) * RB + (R - b * RB)] = -1; }
    if (isctx && b == 0 && tid < 192) IDXROW[e * RT * 256 + 2048 + 64 + tid] = -1;
#undef TK_VALID
    __syncthreads();
}

struct AJob { const attn_body::bf16 *Q, *K, *V; attn_body::bf16* O; int nt, mode, normed; const float* kmax; };
__device__ __forceinline__ bool mixer_job(unsigned char* ws, int l, int vcu, int i, AJob& j) {
    using attn_body::bf16;
    const bf16* QKV = (const bf16*)(ws + WS_QKV); bf16* YS = (bf16*)(ws + WS_YS); j.normed = 0; j.kmax = nullptr; const float* KNB = (const float*)(ws + WS_KNB) + l * 16;
    if (i < 3) { const int b = vcu >> 7, h = (vcu >> 5) & 3, qb = vcu & 31; const long q0 = (long)b * RB + CTXL + qb * 256, k0 = (long)b * RB;
        if (i < 2) { const int vh = 2 * h + i; j.Q = QKV + q0 * PQ + C_QB + vh * 64; j.K = QKV + k0 * PQ + C_KB + vh * 64; j.V = QKV + k0 * PQ + C_VB + h * 64; j.O = YS + q0 * 1024 + 256 + h * 64; j.nt = 132; j.mode = 1 + i; j.kmax = KNB + b * 8 + vh; }
        else { j.Q = QKV + q0 * PQ + C_QD + h * 64; j.K = QKV + k0 * PQ + C_KD + (h >> 1) * 64; j.V = QKV + k0 * PQ + C_VD + (h >> 1) * 64; j.O = YS + q0 * 1024 + 768 + h * 64; j.nt = 132; j.mode = 0; j.normed = 1; }
        return true; }
    if (l != 0) return false;
    const int uc = (vcu + 256 - 132) & 255; if (uc >= 24) return false;
    const int type = uc >> 3, b = (uc >> 2) & 1, h = uc & 3, k = i - 3; const long q0 = (long)b * RB;
    j.nt = 4;
    if (type == 0) { if (k > 0) return false; j.Q = QKV + q0 * PQ + C_QA + h * 64; j.K = QKV + q0 * PQ + C_KA + h * 64; j.V = QKV + q0 * PQ + C_VA + h * 64; j.O = YS + q0 * 1024 + h * 64; j.mode = 0; return true; }
    if (type == 1) { if (k > 1) return false; const int vh = 2 * h + k; j.Q = QKV + q0 * PQ + C_QB + vh * 64; j.K = QKV + q0 * PQ + C_KB + vh * 64; j.V = QKV + q0 * PQ + C_VB + h * 64; j.O = YS + q0 * 1024 + 256 + h * 64; j.mode = 1 + k; j.kmax = KNB + b * 8 + vh; return true; }
    if (k > 0) return false; j.Q = QKV + q0 * PQ + C_QD + h * 64; j.K = QKV + q0 * PQ + C_KD + (h >> 1) * 64; j.V = QKV + q0 * PQ + C_VD + (h >> 1) * 64; j.O = YS + q0 * 1024 + 768 + h * 64; j.mode = 0; j.normed = 1; return true;
}

__global__ void __launch_bounds__(512, 2) fwd_kernel(Args A_) {
    extern __shared__ __attribute__((aligned(16))) unsigned char lds[];
    LAS unsigned char* L = (LAS unsigned char*)lds;
    const int tid0 = threadIdx.x;
    const int G0 = gridDim.x, bx0 = blockIdx.x;
    unsigned char* ws = A_.ws;
    for (int u = tid0; u < (LDS_BYTES - LDSCTL_OFF) / 4; u += 512) ((LAS unsigned*)(L + LDSCTL_OFF))[u] = 0u;
    __syncthreads();
    XcdBarrier bar; bar.bar = (unsigned*)(ws + WS_CTL) + CW_BAR + A_.li * XCD_BAR_WORDS; bar.x = 0; bar.st = nullptr;
    if (!MK_PER_PHASE) bar = xcd_barrier_post((unsigned*)(ws + WS_CTL) + CW_BAR + A_.li * XCD_BAR_WORDS, (volatile LAS unsigned*)(L + MISC_OFF) + 8);
#define PHASE_PTRS KArgs A = opaque_kargs(); unsigned char* ws = A->ws; const int G = opaque_s(G0), bx = opaque_s(bx0), vcu = (bx % 8) * (G / 8) + bx / 8, wave = __builtin_amdgcn_readfirstlane(opaque_tid() >> 6), gw = vcu * 8 + wave, NGW = G * 8; (void)gw; (void)NGW; (void)vcu; const float* MOD = (const float*)(ws + WS_MOD); bf16_t* HN = (bf16_t*)(ws + WS_HN); bf16_t* H2 = (bf16_t*)(ws + WS_H2); bf16_t* YS = (bf16_t*)(ws + WS_YS); \
    bf16_t* GT = (bf16_t*)(ws + WS_GT); bf16_t* X1 = (bf16_t*)(ws + WS_X1); bf16_t* XR = (bf16_t*)(ws + WS_XR); float* PART = (float*)(ws + WS_PART); \
    (void)MOD; (void)HN; (void)H2; (void)YS; (void)GT; (void)X1; (void)XR; (void)PART;
    const int lo = A_.ph_lo, hi = A_.ph_hi;
#ifndef DBG_MASK
#define DBG_MASK 0xffffffffu
#endif
#define PHON(k) ((DBG_MASK >> ((k) < 2 ? (k) : 2 + ((k) - 2) % 10)) & 1u)
#define IN(k) (PHON(k) && lo <= (k) && (k) < hi)
#define SEAM(k) do { if (!MK_PER_PHASE && (k) + 1 < hi) { XcdBarrier b2_ = bar; b2_.bar = (unsigned*)opaque_ptr((unsigned char*)bar.bar); xcd_barrier(b2_); } } while (0)

    if (IN(0)) { PHASE_PTRS
        const int tid = opaque_tid(), lane = tid & 63; (void)tid; (void)lane;
        for (int item = bx; item < 192; item += G) mod_item(A, item, L, tid);
        __syncthreads();
        SEAM(0);
    }
    if (IN(1)) { PHASE_PTRS
        const int tid = opaque_tid(), lane = tid & 63; (void)tid; (void)lane;
        { const int Ra = gw * 9, Rb = min(Ra + 9, NR);
          Row xn = row_load(in_row(A, min(Ra, NR - 1)), lane), xn2 = row_load(in_row(A, min(Ra + 1, NR - 1)), lane), xn3 = row_load(in_row(A, min(Ra + 2, NR - 1)), lane);
          int cur = mod_row(min(Ra, NR - 1)); NormP np; { const float* m = MOD + (size_t)cur * 6144; np = normp_load(A->in[I_N1G], m, m + 1024, lane); }
          for (int R = Ra; R < Rb; ++R) { const Row x = xn; xn = xn2; xn2 = xn3; if (R + 3 < Rb) xn3 = row_load(in_row(A, R + 3), lane);
            const int mr = mod_row(R); if (mr != cur) { const float* m = MOD + (size_t)mr * 6144; np = normp_load(A->in[I_N1G], m, m + 1024, lane); cur = mr; }
            const Row y = row_normmod_p(x, row_rstd(x), np); row_store_bf16(HN + (size_t)R * DM, y, lane); row_store_fp8(ws + WS_HN8 + (size_t)R * DM, y, lane); } }
        __syncthreads();
        conv_run<true>(A, vcu, G, DEPTH * CW_SMALL, L, tid);
        SEAM(1);
    }
    for (int l = 0; l < DEPTH; ++l) {
        const int P = 2 + 10 * l; const int RT = l == 0 ? 9 : 8;
#define LAYER_PTRS PHASE_PTRS unsigned char* wl = ws + WS_W0 + (size_t)l * W_LAYER; const float* MODL = MOD + (size_t)l * 3 * 6144; (void)wl; (void)MODL;
        if (IN(P + 0)) { LAYER_PTRS
            { SchedP1 S{(const char*)HN, (const char*)(wl + WO_WIN), l, G, bx};
              EpiInProj E{(bf16_t*)(ws + WS_QKV), GT, A->in[I_QG] + l * 64, A->in[I_KG] + l * 64, A->in[I_GATEB] + (size_t)l * 4096, (float*)(ws + WS_KNB) + l * 16};
              pg8::gemm_phase<EpiInProj, SchedP1>(L, DM, DM, DM, S, E); }
            { SchedP1g S{(const char*)(ws + WS_HN8), (const char*)(wl + WO_WING), l, G, bx}; EpiGates E{(unsigned char*)GT, A->in[I_GATEB] + (size_t)l * 4096};
              pg8::gemm8_phase<EpiGates, SchedP1g>(L, DM / 2, DM / 2, DM / 2, S, E); }
            SEAM(P + 0);
        }
        if (IN(P + 1)) { LAYER_PTRS
            const int tid = opaque_tid(), lane = tid & 63; (void)tid; (void)lane;
            float s1 = lane < 32 ? A->in[I_LQ1][l * 32 + lane] * A->in[I_LK1][l * 32 + lane] : 0.f, s2 = lane < 32 ? A->in[I_LQ2][l * 32 + lane] * A->in[I_LK2][l * 32 + lane] : 0.f;
            const float lam_init = l == 0 ? 0.2f : 0.35550906759096934f;
            const float lam = expf(wave_sum(s1)) - expf(wave_sum(s2)) + lam_init;
            const attn_body::DiffEpi de{lam, 1.0f - lam_init, A->in[I_SUBG] + l * 64};
            const float gqm = wave_max(fabsf(A->in[I_QG][l * 64 + lane])), gkm = wave_max(fabsf(A->in[I_KG][l * 64 + lane]));
            const bool gqa_nomax = __builtin_amdgcn_readfirstlane((int)(64.0f * gqm * gkm * C2A * 1.05f <= 40.0f)) != 0;
            const int cslot = vcu & 3, cbase = l * CW_LAYER + CW_SMALL + vcu * (CW_MOE / 256);
#define CONV_SEAM(k) do { if (cslot == (k)) conv_run(A, cbase, 1, cbase + CW_MOE / 256, L, opaque_tid()); } while (0)
            static_assert(CW_MOE % 256 == 0, "expert-weight items split evenly over 256 CUs");
            CONV_SEAM(0);
            AJob j;
            for (int i = 0; mixer_job(ws, l, vcu, i, j); ++i) {
                if (i == 2) CONV_SEAM(1);
                if (i == 3) CONV_SEAM(2);
                if (j.mode == 0) attn_body::attn_unit<8, 0>(j.Q, j.K, j.V, j.nt, j.O, (char*)lds, de, !(j.normed && gqa_nomax));
                else if (j.mode == 1) attn_body::attn_unit<8, 1>(j.Q, j.K, j.V, j.nt, j.O, (char*)lds, de, true, j.kmax);
                else attn_body::attn_unit<8, 2>(j.Q, j.K, j.V, j.nt, j.O, (char*)lds, de, true, j.kmax);
            }
            if (l != 0 || ((vcu + 256 - 132) & 255) >= 24) CONV_SEAM(2);
            { const int b = vcu >> 7, h = (vcu >> 5) & 3, g4 = vcu & 31;
              attn_body::na_unit(b, h, g4, (const attn_body::bf16*)(ws + WS_QKV), (attn_body::bf16*)YS, A->in[I_RPB] + ((size_t)l * 4 + h) * 465, (char*)lds); }
            CONV_SEAM(3);
            const int nsgu = 128 + (l == 0 ? 4 : 0);
            if (vcu < nsgu) { const long rowbase = vcu < 128 ? (long)(vcu >> 6) * RB + CTXL + (vcu & 63) * 128 : (long)((vcu - 128) >> 1) * RB + ((vcu - 128) & 1) * 128;
                sgu_unit(rowbase, (const bf16_t*)(ws + WS_QKV) + C_GU, (const bf16_t*)(ws + WS_QKV) + C_GV, A->in[I_SGUNG] + l * 256, A->in[I_SGUW] + (size_t)l * 4 * 128 * 128, A->in[I_SGUB] + l * 4 * 128, YS, (char*)lds); }
            SEAM(P + 1);
        }
        if (IN(P + 2)) { LAYER_PTRS
            SchedP3a S{(const char*)YS, (const char*)(wl + WO_WB), l, G, bx}; EpiGateAcc E{(const unsigned char*)GT, (bf16_t*)(ws + WS_MRG), (bf16_t*)(ws + WS_GPC)};
            pg8::gemm_phase<EpiGateAcc, SchedP3a>(L, 256, DM, 256, S, E);
            SEAM(P + 2);
        }
        if (IN(P + 3)) { LAYER_PTRS
            { SchedP3b S{(const char*)(ws + WS_MRG), (const char*)(wl + WO_WO4), G, bx}; EpiOutRes E{A->in[I_X], A->in[I_CTX], XR, X1, MODL, l};
              pg8::gemm_phase<EpiOutRes, SchedP3b>(L, DM, DM, DM, S, E); }
            if (l == 0) { SchedP3c S{(const char*)(ws + WS_GPC), (const char*)(wl + WO_WO4), G, bx}; EpiPart E{PART};
              pg8::gemm_phase<EpiPart, SchedP3c>(L, 256, DM, DM, S, E); }
            SEAM(P + 3);
        }
        if (IN(P + 4)) { LAYER_PTRS
            const int tid = opaque_tid(), lane = tid & 63; (void)tid; (void)lane;
            LAS float* wrT = (LAS float*)L;
            const float* wr = A->in[I_WRT] + (size_t)l * DM * 16;
            { f32x4 wv[8];
#pragma unroll
              for (int q = 0; q < 8; ++q) wv[q] = ((const f32x4*)wr)[tid + 512 * q];
              __builtin_amdgcn_sched_barrier(0);
#pragma unroll
              for (int q = 0; q < 8; ++q) { const int i4 = tid + 512 * q, k = i4 >> 2, e0 = (i4 & 3) * 4;
#pragma unroll
                  for (int j = 0; j < 4; ++j) wrT[(e0 + j) * DM + k] = wv[q][j]; } }
            __syncthreads();
            const int nit = 8 + ((l == 0 && gw < 512) ? 1 : 0);
            Row xn; { const int i0 = gw * 8; xn = row_load_bf16(X1 + ((size_t)(i0 >> 13) * RB + CTXL + (i0 & 8191)) * DM, lane); }
            NormP np; { const float* m0 = MODL + (size_t)((gw * 8) >> 13) * 6144; np = normp_load(A->in[I_N2G] + l * DM, m0 + 3072, m0 + 4096, lane); }
            for (int it = 0; it < nit; ++it) { const int i = it < 8 ? gw * 8 + it : 16384 + gw; const bool isctx = i >= 16384; const int b = isctx ? (i - 16384) >> 8 : i >> 13, r = isctx ? (i - 16384) & 255 : CTXL + (i & 8191); const int R = b * RB + r;
                const float* m = MODL + (size_t)(isctx ? 2 : b) * 6144;
                Row x = xn;
                if (it + 1 < 8) { const int in = i + 1; xn = row_load_bf16(X1 + ((size_t)(in >> 13) * RB + CTXL + (in & 8191)) * DM, lane); }
                if (isctx) { x = row_load(in_row(A, R), lane); Row s;
#pragma unroll
                    for (int j = 0; j < 4; ++j) s.v[j] = (f32x4){0.f, 0.f, 0.f, 0.f};
                    for (int ks = 0; ks < 16; ks += 4) { Row p[4];
#pragma unroll
                        for (int q = 0; q < 4; ++q) p[q] = row_load(PART + ((size_t)(ks + q) * 512 + b * 256 + r) * DM, lane);
                        __builtin_amdgcn_sched_barrier(0);
#pragma unroll
                        for (int q = 0; q < 4; ++q)
#pragma unroll
                            for (int j = 0; j < 4; ++j) s.v[j] += p[q].v[j]; }
#pragma unroll
                    for (int j = 0; j < 4; ++j) x.v[j] += ((const f32x4*)(m + 2048))[lane + 64 * j] * s.v[j];
                    row_store_bf16(X1 + (size_t)R * DM, x, lane);
                }
                if (isctx) np = normp_load(A->in[I_N2G] + l * DM, m + 3072, m + 4096, lane);
                const Row h = row_normmod_p(x, row_rstd(x), np);
                { unsigned* hq = (unsigned*)((unsigned char*)H2 + (size_t)R * DM) + lane;
#pragma unroll
                  for (int j = 0; j < 4; ++j) hq[64 * j] = pk8(h.v[j].x, h.v[j].y, h.v[j].z, h.v[j].w); }
                float lg[16];
#pragma unroll
                for (int e = 0; e < 16; ++e) { f32x2 a2 = (f32x2){0.f, 0.f};
#pragma unroll
                    for (int j = 0; j < 4; ++j) { const f32x4 w = *(const LAS f32x4*)(wrT + e * DM + 4 * lane + 256 * j);
                        a2 = __builtin_elementwise_fma((f32x2){h.v[j].x, h.v[j].y}, (f32x2){w.x, w.y}, a2); a2 = __builtin_elementwise_fma((f32x2){h.v[j].z, h.v[j].w}, (f32x2){w.z, w.w}, a2); }
                    lg[e] = a2.x + a2.y; if ((e & 3) == 3) __builtin_amdgcn_sched_barrier(0); }
                float c8[8], d[4];
#pragma unroll
                for (int i = 0; i < 8; ++i) { auto rr = __builtin_amdgcn_permlane32_swap(__float_as_uint(lg[i]), __float_as_uint(lg[i + 8]), false, false); c8[i] = __uint_as_float(rr[0]) + __uint_as_float(rr[1]); }
#pragma unroll
                for (int i = 0; i < 4; ++i) { auto rr = __builtin_amdgcn_permlane16_swap(__float_as_uint(c8[i]), __float_as_uint(c8[i + 4]), false, false); d[i] = row16_sum(__uint_as_float(rr[0]) + __uint_as_float(rr[1])); }
                float mx = fmaxf(fmaxf(d[0], d[1]), fmaxf(d[2], d[3]));
                { auto rr = __builtin_amdgcn_permlane16_swap(__float_as_uint(mx), __float_as_uint(mx), false, false); mx = fmaxf(__uint_as_float(rr[0]), __uint_as_float(rr[1])); }
                { auto rr = __builtin_amdgcn_permlane32_swap(__float_as_uint(mx), __float_as_uint(mx), false, false); mx = fmaxf(__uint_as_float(rr[0]), __uint_as_float(rr[1])); }
#pragma unroll
                for (int i = 0; i < 4; ++i) d[i] = __expf(d[i] - mx);
                const float sum = xor32_sum(xor16_sum((d[0] + d[1]) + (d[2] + d[3])));
                const int li = lane & 15, ex = 4 * (lane >> 4) + li;
                float mine = li == 0 ? d[0] : li == 1 ? d[1] : li == 2 ? d[2] : d[3];
                mine = mine / sum;
                if (li < 4) { if (isctx) ((float*)(ws + WS_AFFC))[((size_t)b * 16 + ex) * 256 + r] = mine; else ((float*)(ws + WS_AFFL))[((size_t)b * 16 + ex) * 8192 + (r - CTXL)] = mine; }
            }
            SEAM(P + 4);
        }
        if (IN(P + 5)) { LAYER_PTRS
            const int tid = opaque_tid(), lane = tid & 63; (void)tid; (void)lane;
            const int nun = l == 0 ? 64 : 32;
            for (int u = vcu; u < nun; u += G) topk_unit(A, RT, u >= 32, (u >> 4) & 1, u & 15, L, tid);
            SEAM(P + 5);
        }
        if (IN(P + 6)) { LAYER_PTRS
            const int tid = opaque_tid(), lane = tid & 63; (void)tid; (void)lane;
            const int* IDXROW = (const int*)(ws + WS_IDXROW); unsigned char* XG = ws + WS_XG;
            const int nyr = 16 * RT * 256;
            for (int y0 = gw; y0 < nyr; y0 += 9 * NGW) { int src[9]; v4u a[9];
#pragma unroll
                for (int q = 0; q < 9; ++q) { const int y = y0 + q * NGW; src[q] = y < nyr ? IDXROW[y] : -1; }
                __builtin_amdgcn_sched_barrier(0);
#pragma unroll
                for (int q = 0; q < 9; ++q) { a[q] = (v4u){0u, 0u, 0u, 0u}; if (src[q] >= 0) a[q] = ((const v4u*)((const unsigned char*)H2 + (size_t)src[q] * DM))[lane]; }
                __builtin_amdgcn_sched_barrier(0);
#pragma unroll
                for (int q = 0; q < 9; ++q) { const int y = y0 + q * NGW; if (y < nyr) ((v4u*)(XG + (size_t)y * DM))[lane] = a[q]; } }
            SEAM(P + 6);
        }
        if (IN(P + 7)) { LAYER_PTRS
            SchedP6 S{(const char*)(ws + WS_XG), (const char*)(wl + WO_WGU), RT, G, bx}; EpiSwiGLU E{ws + WS_HID};
            pg8::gemm8_phase<EpiSwiGLU, SchedP6>(L, DM / 2, DM / 2, DM / 2, S, E);
            SEAM(P + 7);
        }
        if (IN(P + 8)) { LAYER_PTRS
            SchedP7 S{(const char*)(ws + WS_HID), (const char*)(wl + WO_WD), RT, G, bx}; EpiDown E{(bf16_t*)(ws + WS_Y), (const float*)(ws + WS_SCORE)};
            pg8::gemm8_phase<EpiDown, SchedP7>(L, EH / 2, EH / 2, EH / 2, S, E);
            if (l == 0) { SchedP7c S2{(const char*)(ws + WS_HID), (const char*)(wl + WO_WD), G, bx}; EpiDownPart E2{(bf16_t*)(ws + WS_XG), (const float*)(ws + WS_SCORE)};
              pg8::gemm8_phase<EpiDownPart, SchedP7c>(L, 256, EH / 2, EH / 2, S2, E2); }
            SEAM(P + 8);
        }
        if (IN(P + 9)) { LAYER_PTRS
            const int tid = opaque_tid(), lane = tid & 63; (void)tid; (void)lane;
            const int* INV = (const int*)(ws + WS_INV); const bf16_t* Y = (const bf16_t*)(ws + WS_Y);
#define P8_INV(R_) (lane < 16 ? INV[((size_t)((R_) / RB) * 16 + lane) * RB + (R_) % RB] : -1)
#define P8_YISSUE(INVV, W, KEEP, REST) do { unsigned mk_ = (unsigned)(__ballot((INVV) >= 0) & 0xffffull); \
                _Pragma("unroll") for (int k = 0; k < 4; ++k) { const bool have = mk_ != 0u; const int e = have ? __builtin_ctz(mk_) : 0; mk_ &= mk_ - 1u; \
                    const int yr = have ? __builtin_amdgcn_readlane((INVV), e) : 0; const v2u* yp = (const v2u*)(Y + (size_t)yr * DM) + lane; KEEP[k] = have ? 0xffffffffu : 0u;     \
                    _Pragma("unroll") for (int j = 0; j < 4; ++j) W[k][j] = yp[64 * j]; } REST = mk_; } while (0)
            Row xn; int invn, invf; v2u wn[4][4]; unsigned kn[4], restn;
#define P8_ROW(k) ((k) < 8 ? (((gw * 8 + (k)) >> 13) * RB + CTXL + ((gw * 8 + (k)) & 8191)) : ((gw >> 8) * RB + (gw & 255)))
            const int nit = 8 + ((l == 0 && gw < 512) ? 1 : 0);
            { const int R0 = P8_ROW(0); xn = row_load_bf16(X1 + (size_t)R0 * DM, lane); invn = P8_INV(R0); P8_YISSUE(invn, wn, kn, restn); const int R1 = P8_ROW(1); invf = P8_INV(R1); }
            int curm; NormP np; f32x4 g2v[4];
#define P8_PARAMS(mr_) do { const float* m_ = MODL + (size_t)(mr_) * 6144; \
                _Pragma("unroll") for (int j = 0; j < 4; ++j) g2v[j] = ((const f32x4*)(m_ + 5120))[lane + 64 * j]; \
                if (l + 1 < DEPTH) { const float* m1 = MOD + ((size_t)(l + 1) * 3 + (mr_)) * 6144; np = normp_load(A->in[I_N1G] + (l + 1) * DM, m1, m1 + 1024, lane); } \
                else { _Pragma("unroll") for (int j = 0; j < 4; ++j) { np.a[j] = ((const f32x4*)A->in[I_FG])[lane + 64 * j]; np.h[j] = np.a[j]; } } \
                __builtin_amdgcn_sched_barrier(0); } while (0)
            { curm = (gw * 8) >> 13; P8_PARAMS(curm); }
            for (int k9 = 0; k9 < nit; ++k9) { const int R = P8_ROW(k9); const int b = R / RB, r = R % RB; const bool isctx = r < CTXL;
                Row x = xn; const int myinv = invn; v2u w0[4][4]; unsigned k0[4]; unsigned msk = restn;
#pragma unroll
                for (int k = 0; k < 4; ++k) { k0[k] = kn[k];
#pragma unroll
                    for (int j = 0; j < 4; ++j) w0[k][j] = wn[k][j]; }
                if (k9 + 1 < nit) { const int Rn = P8_ROW(k9 + 1); xn = row_load_bf16(X1 + (size_t)Rn * DM, lane); invn = invf; P8_YISSUE(invn, wn, kn, restn); const int Rf = P8_ROW(min(k9 + 2, nit - 1)); invf = P8_INV(Rf); }
                if (l == 1 && isctx) continue;
                const float* m = MODL + (size_t)(isctx ? 2 : b) * 6144;
                Row s;
#pragma unroll
                for (int j = 0; j < 4; ++j) s.v[j] = (f32x4){0.f, 0.f, 0.f, 0.f};
#pragma unroll
                for (int k = 0; k < 4; ++k)
#pragma unroll
                    for (int j = 0; j < 4; ++j) s.v[j] += (f32x4){bflo(w0[k][j].x & k0[k]), bfhi(w0[k][j].x & k0[k]), bflo(w0[k][j].y & k0[k]), bfhi(w0[k][j].y & k0[k])};
                if (isctx) {
#pragma unroll
                    for (int j = 0; j < 4; ++j) s.v[j] = (f32x4){0.f, 0.f, 0.f, 0.f};
                    msk = 0u; unsigned mk = (unsigned)(__ballot(myinv >= 0) & 0xffffull); const bf16_t* YP = (const bf16_t*)(ws + WS_XG);
                    while (mk) { const int e = __builtin_ctz(mk); mk &= mk - 1u; const int yr = __builtin_amdgcn_readlane(myinv, e); const int ex = yr / 2304, rr = yr % 2304 - 2048;
                        v2u t[4][4];
#pragma unroll
                        for (int kq = 0; kq < 4; ++kq) { const v2u* yp = (const v2u*)(YP + ((size_t)(kq * 16 + ex) * 256 + rr) * DM) + lane;
#pragma unroll
                            for (int j = 0; j < 4; ++j) t[kq][j] = yp[64 * j]; }
                        __builtin_amdgcn_sched_barrier(0);
#pragma unroll
                        for (int kq = 0; kq < 4; ++kq)
#pragma unroll
                            for (int j = 0; j < 4; ++j) s.v[j] += (f32x4){bflo(t[kq][j].x), bfhi(t[kq][j].x), bflo(t[kq][j].y), bfhi(t[kq][j].y)}; } }
                while (msk) {
                    v2u w[4][4];
#pragma unroll
                    for (int k = 0; k < 4; ++k) { const bool have = msk != 0u; const int e = have ? __builtin_ctz(msk) : 0; msk &= msk - 1u; if (!have) msk = 0u;
                        const int yr = have ? __builtin_amdgcn_readlane(myinv, e) : 0;
                        const v2u* yp = (const v2u*)(Y + (size_t)yr * DM) + lane; const unsigned keep = have ? 0xffffffffu : 0u;
#pragma unroll
                        for (int j = 0; j < 4; ++j) { v2u t = yp[64 * j]; t.x &= keep; t.y &= keep; w[k][j] = t; } }
#pragma unroll
                    for (int k = 0; k < 4; ++k)
#pragma unroll
                        for (int j = 0; j < 4; ++j) s.v[j] += (f32x4){bflo(w[k][j].x), bfhi(w[k][j].x), bflo(w[k][j].y), bfhi(w[k][j].y)};
                }
                { const int mr = isctx ? 2 : b; if (mr != curm) { curm = mr; P8_PARAMS(mr); } }
#pragma unroll
                for (int j = 0; j < 4; ++j) x.v[j] += g2v[j] * s.v[j];
                const float rstd = row_rstd(x);
                if (l + 1 < DEPTH) { row_store_bf16(XR + (size_t)R * DM, x, lane);
                    const Row y = row_normmod_p(x, rstd, np); row_store_bf16(HN + (size_t)R * DM, y, lane); if (!isctx) row_store_fp8(ws + WS_HN8 + (size_t)R * DM, y, lane); }
                else { Row y;
#pragma unroll
                    for (int j = 0; j < 4; ++j) y.v[j] = x.v[j] * rstd * np.a[j];
                    row_store(A->out + ((size_t)b * SEQ + (r - CTXL)) * DM, y, lane); }
            }
            SEAM(P + 9);
        }
    }
#undef IN
#undef SEAM
}

extern "C" void kernel_launch(void* const* d_in, const int* in_sizes, int n_in, void* d_out, int out_size, void* d_ws, size_t ws_size, hipStream_t stream) {
    static int grid = 0;
    if (grid == 0) {
        if (n_in != 28 || out_size != NB * SEQ * DM || ws_size < WS_END) { fprintf(stderr, "kernel_launch: unexpected shapes (n_in %d, out %d, ws %zu < %zu)\n", n_in, out_size, ws_size, (size_t)WS_END); grid = -1; return; }
        int dev = 0, cus = 0, per_cu = 0;
        if (hipGetDevice(&dev) != hipSuccess || hipDeviceGetAttribute(&cus, hipDeviceAttributeMultiprocessorCount, dev) != hipSuccess) { grid = -1; return; }
        if (hipFuncSetAttribute((const void*)fwd_kernel, hipFuncAttributeMaxDynamicSharedMemorySize, LDS_BYTES) != hipSuccess) { fprintf(stderr, "kernel_launch: hipFuncSetAttribute failed\n"); grid = -1; return; }
        if (hipOccupancyMaxActiveBlocksPerMultiprocessor(&per_cu, (const void*)fwd_kernel, 512, LDS_BYTES) != hipSuccess || per_cu < 1) fprintf(stderr, "kernel_launch: occupancy query reports %d blocks/CU\n", per_cu);
        (void)hipGetLastError();
        if (cus != 256) { fprintf(stderr, "kernel_launch: built for 256 CUs, device has %d\n", cus); grid = -1; return; }
        grid = 256;
    }
    if (grid < 0) return;
    (void)hipMemsetAsync((char*)d_ws + WS_CTL, 0, CTL_ZERO_BYTES, stream);
    Args a{};
    for (int i = 0; i < 28; ++i) a.in[i] = (const float*)d_in[i];
    a.out = (float*)d_out; a.ws = (unsigned char*)d_ws;
#if MK_PER_PHASE
    for (int p = 0; p < NPHASE; ++p) { a.ph_lo = p; a.ph_hi = p + 1; hipLaunchKernelGGL(fwd_kernel, dim3(grid), dim3(512), LDS_BYTES, stream, a); }
#elif defined(PROBE_REPEAT)
    { const int reps[] = {PROBE_REPEAT}; const int nr = sizeof(reps) / sizeof(int); int lo = 0;
      for (int i = 0; i <= nr; ++i) { a.ph_lo = lo; a.ph_hi = i < nr ? reps[i] + 1 : NPHASE; a.li = i; hipLaunchKernelGGL(fwd_kernel, dim3(grid), dim3(512), LDS_BYTES, stream, a); if (i < nr) lo = reps[i]; } }
#else
    a.ph_lo = 0; a.ph_hi = NPHASE; hipLaunchKernelGGL(fwd_kernel, dim3(grid), dim3(512), LDS_BYTES, stream, a);
#endif
}
```

```cpp
#include <hip/hip_runtime.h>
#include <hip/hip_bf16.h>
#include <cstdio>
#include <cstdint>
#include <cmath>

#ifndef MK_PER_PHASE
#define MK_PER_PHASE 0
#endif

constexpr int DM = 1024, NB = 2, SEQ = 8192, CTXL = 256, RB = SEQ + CTXL, NR = NB * RB, DEPTH = 2;
constexpr int IN_W = 6656, NEXP = 16, EH = 2048, TPB = RB / 256  ;
constexpr float EPS = 1e-6f, LOG2E = 1.4426950408889634f;
constexpr float C2A = 0.125f * LOG2E;
constexpr float C2B = 0.17677669529663687f * LOG2E;
constexpr int NPHASE = 2 + 10 * DEPTH;

constexpr size_t MiB = 1u << 20, KiB128 = 131072;
constexpr size_t WS_CTL = 0, CTL_ZERO_BYTES = 1 * MiB;
constexpr size_t WS_MOD = 1 * MiB;
constexpr size_t WS_AFFL = 2 * MiB, WS_AFFC = 3 * MiB;
constexpr size_t WS_IDXROW = 4 * MiB, WS_SCORE = 4 * MiB + 512 * 1024, WS_INV = 5 * MiB;
constexpr size_t WS_GPC = 8 * MiB;
constexpr size_t WS_W0 = 24 * MiB, W_LAYER = 215 * MiB;
constexpr size_t WO_WING = 8 * MiB  , WO_WIN = 0  , WO_WB = 13 * MiB, WO_WO4 = 15 * MiB, WO_WGU = 23 * MiB, WO_WD = 151 * MiB;
constexpr size_t WS_HN = 454 * MiB;
constexpr size_t WS_QKV = 487 * MiB;
constexpr int PQ = 3136;
constexpr int C_QA = 0, C_KA = 256, C_VA = 512, C_QB = 768, C_KB = 1280, C_VB = 1792, C_QD = 2048, C_KD = 2304, C_VD = 2432, C_GU = 2560, C_GV = 2816;
constexpr size_t WS_Y = WS_QKV;
constexpr size_t WS_KNB = 512 * 1024;
constexpr size_t WS_GT = 589 * MiB;
constexpr size_t WS_YS = 721 * MiB;
constexpr size_t WS_HID = WS_GT;
constexpr size_t WS_X1 = 754 * MiB, WS_XR = 820 * MiB, WS_H2 = 886 * MiB, WS_XG = 919 * MiB, WS_MRG = WS_H2, WS_PART = WS_XG  , WS_HN8 = 991 * MiB  , WS_END = 1008 * MiB;
static_assert(WS_QKV + (size_t)NR * PQ * 2 <= WS_GT && WS_Y + (size_t)16 * 9 * 256 * 1024 * 2 <= WS_GT && WS_HID + (size_t)16 * 9 * 256 * 2048 * 2 <= WS_X1 && WS_YS + (size_t)NR * 1024 * 2 <= WS_X1, "ws map");

constexpr int CW_BAR = 4096;

constexpr int RING_BYTES = 131072, LDSCTL_OFF = RING_BYTES, MISC_OFF = LDSCTL_OFF + 320, LDS_BYTES = 147456;

#define GAS __attribute__((address_space(1)))
#define LAS __attribute__((address_space(3)))
typedef unsigned short bf16_t;
typedef unsigned v4u __attribute__((ext_vector_type(4)));
typedef unsigned v2u __attribute__((ext_vector_type(2)));
typedef float f32x4 __attribute__((ext_vector_type(4)));
typedef float f32x2 __attribute__((ext_vector_type(2)));
typedef float f32x16 __attribute__((ext_vector_type(16)));
typedef short bf16x8 __attribute__((ext_vector_type(8)));
typedef short s16x4 __attribute__((ext_vector_type(4)));
typedef __bf16 bf16x2_t __attribute__((ext_vector_type(2)));
#define RLX_AGENT __ATOMIC_RELAXED, __HIP_MEMORY_SCOPE_AGENT
#define LDS_WAIT() asm volatile("s_waitcnt lgkmcnt(0)" ::: "memory")
#define VM_WAIT() asm volatile("s_waitcnt vmcnt(0)" ::: "memory")

__device__ __forceinline__ int opaque_tid() { int t = threadIdx.x; asm volatile("" : "+v"(t)); return t; }
__device__ __forceinline__ int opaque_s(int v) { asm volatile("" : "+s"(v)); return v; }
__device__ __forceinline__ unsigned char* opaque_ptr(unsigned char* p) { asm volatile("" : "+s"(p)); return p; }
__device__ __forceinline__ unsigned cvtpk(float lo, float hi) { f32x2 v = {lo, hi}; bf16x2_t b = __builtin_convertvector(v, bf16x2_t); return __builtin_bit_cast(unsigned, b); }
__device__ __forceinline__ float bflo(unsigned w) { return __uint_as_float(w << 16); }
__device__ __forceinline__ float bfhi(unsigned w) { return __uint_as_float(w & 0xffff0000u); }
__device__ __forceinline__ float bf2f(bf16_t h) { return __uint_as_float((unsigned)h << 16); }
__device__ __forceinline__ bf16_t f2bf(float f) { return (bf16_t)(cvtpk(f, 0.f) & 0xffffu); }
__device__ __forceinline__ float sigmoidf_(float x) { return __builtin_amdgcn_rcpf(1.0f + __builtin_amdgcn_exp2f(-x * LOG2E)); }
__device__ __forceinline__ float siluf_(float x) { return x * sigmoidf_(x); }
__device__ __forceinline__ float gelu_tanh(float x) { const float z = 0.7978845608028654f * (x + 0.044715f * x * x * x); return x * __builtin_amdgcn_rcpf(1.0f + __builtin_amdgcn_exp2f(-2.0f * LOG2E * z)); }
template <int CTRL> __device__ __forceinline__ float dpp_f(float v) { return __builtin_bit_cast(float, __builtin_amdgcn_update_dpp(0, __builtin_bit_cast(int, v), CTRL, 0xf, 0xf, true)); }
__device__ __forceinline__ float row16_sum(float v) { v += dpp_f<0xB1>(v); v += dpp_f<0x4E>(v); v += dpp_f<0x141>(v); v += dpp_f<0x140>(v); return v; }
__device__ __forceinline__ float xor16_sum(float v) { auto rr = __builtin_amdgcn_permlane16_swap(__float_as_uint(v), __float_as_uint(v), false, false); return __uint_as_float(rr[0]) + __uint_as_float(rr[1]); }
__device__ __forceinline__ float xor32_sum(float v) { auto rr = __builtin_amdgcn_permlane32_swap(__float_as_uint(v), __float_as_uint(v), false, false); return __uint_as_float(rr[0]) + __uint_as_float(rr[1]); }
__device__ __forceinline__ float half32_sum(float v) { return xor16_sum(row16_sum(v)); }
__device__ __forceinline__ float wave_sum(float v) { return xor32_sum(xor16_sum(row16_sum(v))); }
__device__ __forceinline__ float wave_max(float v) { v = fmaxf(v, dpp_f<0xB1>(v)); v = fmaxf(v, dpp_f<0x4E>(v)); v = fmaxf(v, dpp_f<0x141>(v)); v = fmaxf(v, dpp_f<0x140>(v));
    { auto rr = __builtin_amdgcn_permlane16_swap(__float_as_uint(v), __float_as_uint(v), false, false); v = fmaxf(__uint_as_float(rr[0]), __uint_as_float(rr[1])); }
    { auto rr = __builtin_amdgcn_permlane32_swap(__float_as_uint(v), __float_as_uint(v), false, false); v = fmaxf(__uint_as_float(rr[0]), __uint_as_float(rr[1])); } return v; }
__device__ __forceinline__ unsigned pk8(float a, float b, float c, float d) { unsigned w = 0u; w = __builtin_amdgcn_cvt_pk_fp8_f32(a, b, w, false); w = __builtin_amdgcn_cvt_pk_fp8_f32(c, d, w, true); return w; }
__device__ __forceinline__ void st8(bf16_t* p, const float* v) { v4u w; w.x = cvtpk(v[0], v[1]); w.y = cvtpk(v[2], v[3]); w.z = cvtpk(v[4], v[5]); w.w = cvtpk(v[6], v[7]); *(v4u*)p = w; }

__device__ const float INV16R[16] = {0.15915494309189535f, 0.08949940160889101f, 0.050329212104487035f, 0.0283021958306234f, 0.015915494309189534f, 0.008949940160889102f, 0.005032921210448704f, 0.00283021958306234f,
                                     0.0015915494309189536f, 0.0008949940160889102f, 0.0005032921210448703f, 0.00028302195830623395f, 0.00015915494309189535f, 8.949940160889102e-05f, 5.0329212104487035e-05f, 2.8302195830623396e-05f};
__device__ const float INV8R[8] = {0.15915494309189535f, 0.050329212104487035f, 0.015915494309189534f, 0.005032921210448704f, 0.0015915494309189536f, 0.0005032921210448703f, 0.00015915494309189535f, 5.0329212104487035e-05f};
__device__ __forceinline__ void sincos_rev(float rev, float& s, float& c) { const float f = __builtin_amdgcn_fractf(rev); s = __builtin_amdgcn_sinf(f); c = __builtin_amdgcn_cosf(f); }

namespace pg8 {
#define PG8_LAS __attribute__((address_space(3)))
constexpr int BM = 256, BK = 64, HALF = 128, HTB = HALF * BK * 2, STAGE_BYTES = 8 * HTB, NXCD = 8, WGM = 8;
__host__ __device__ __forceinline__ int lds_byte(int r, int c) { const int st = (r >> 4) * 2 + (c >> 5), rr = r & 15, cc = c & 31, ob = rr * 64 + cc * 2; return st * 1024 + (ob ^ (((ob >> 9) & 1) << 5)); }
__host__ __device__ __forceinline__ void stage_rc(int b, int& R, int& C) { const int st = b / 1024, sb = b % 1024, swz = sb ^ (((sb >> 9) & 1) << 5); R = (st >> 1) * 16 + swz / 64; C = (st & 1) * 32 + (swz % 64) / 2; }
__host__ __device__ __forceinline__ int perm32(int rho) { const int n = rho >> 4, i = rho & 15; return 8 * (i >> 2) + 4 * n + (i & 3); }

struct Unit { int pm, pn; const char* a; const char* b; };
__device__ __forceinline__ const char* uptr(const char* p) { const unsigned long long v = (unsigned long long)p; const unsigned lo = __builtin_amdgcn_readfirstlane((unsigned)v), hi = __builtin_amdgcn_readfirstlane((unsigned)(v >> 32)); return (const char*)(((unsigned long long)hi << 32) | lo); }
__device__ __forceinline__ void uunit(Unit& u) { u.pm = __builtin_amdgcn_readfirstlane(u.pm); u.pn = __builtin_amdgcn_readfirstlane(u.pn); u.a = uptr(u.a); u.b = uptr(u.b); }

typedef int v8i __attribute__((ext_vector_type(8)));
__device__ __forceinline__ void glds16s(const char* sbase, unsigned voff, unsigned lds_dst) { unsigned keep;
    asm volatile("s_mov_b32 %0, m0\n\ts_mov_b32 m0, %3\n\ts_nop 0\n\tglobal_load_lds_dwordx4 %1, %2\n\ts_mov_b32 m0, %0" : "=&s"(keep) : "v"(voff), "s"(sbase), "s"(lds_dst) : "memory"); }
__device__ __forceinline__ void rect_order(int L, int nM, int nN, int& im, int& in) {
    const int nwg = nM * nN; int wgid = L; { const int q = nwg / NXCD, r = nwg % NXCD, xcd = wgid % NXCD, off = wgid / NXCD; wgid = (xcd < r ? xcd * (q + 1) : r * (q + 1) + (xcd - r) * q) + off; }
    const int nig = WGM * nN, gid = wgid / nig, fm = gid * WGM, gsz = (nM - fm) < WGM ? (nM - fm) : WGM;
    im = fm + ((wgid % nig) % gsz); in = (wgid % nig) / gsz;
}

template <class Epi, class Sched>
__device__ __forceinline__ void gemm_phase(PG8_LAS unsigned char* lds, const int K, const int lda, const int ldb, const Sched& S, const Epi& E) {
    const int tid = opaque_tid(), wid = __builtin_amdgcn_readfirstlane(tid >> 6), lane = tid & 63, wr = wid >> 2, wc = wid & 3, fr = lane & 15, fq = lane >> 4;
    const int nt = K / BK;
    unsigned voffA[2], voffB[2];
#pragma unroll
    for (int i = 0; i < 2; ++i) { int R, C; stage_rc(tid * 16 + i * 8192, R, C); const int Rb = Epi::PERM ? ((R & ~31) + perm32(R & 31)) : R;
        voffA[i] = (unsigned)(R * lda + C) * 2u; voffB[i] = (unsigned)(Rb * ldb + C) * 2u; }
    const size_t kstep = (size_t)(BK * 2);
    const size_t hA = (size_t)HALF * lda * 2, hB = (size_t)HALF * ldb * 2;
    const unsigned ldsw = (unsigned)wid * 1024u, ldsbase = (unsigned)(size_t)lds;
    const int aoff = lds_byte(wr * 64 + fr, fq * 8), boff = lds_byte(wc * 32 + fr, fq * 8);
#define PG8_SA(b, h) (((b) * 2 + (h)) * HTB)
#define PG8_SB(b, h) ((4 + (b) * 2 + (h)) * HTB)
#define PG8_STAGE(bufoff, gbase, voff) do { _Pragma("unroll") for (int _i = 0; _i < 2; ++_i) \
        glds16s(uptr((const char*)(gbase)), (voff)[_i], (unsigned)__builtin_amdgcn_readfirstlane(ldsbase + (unsigned)(bufoff) + ldsw + _i * 8192u)); } while (0)
#define PG8_LDA(dst, b, h) do { _Pragma("unroll") for (int m = 0; m < 4; ++m) _Pragma("unroll") for (int k = 0; k < 2; ++k) dst[m][k] = *(const PG8_LAS bf16x8*)(lds + PG8_SA(b, h) + aoff + m * 2048 + k * 1024); } while (0)
#define PG8_LDB(dst, b, h) do { _Pragma("unroll") for (int n = 0; n < 2; ++n) _Pragma("unroll") for (int k = 0; k < 2; ++k) dst[n][k] = *(const PG8_LAS bf16x8*)(lds + PG8_SB(b, h) + boff + n * 2048 + k * 1024); } while (0)
#define PG8_MMA(ai, bj, At, Bt) do { __builtin_amdgcn_s_setprio(1); _Pragma("unroll") for (int m = 0; m < 4; ++m) _Pragma("unroll") for (int n = 0; n < 2; ++n) _Pragma("unroll") for (int k = 0; k < 2; ++k) \
        acc[ai][bj][m][n] = __builtin_amdgcn_mfma_f32_16x16x32_bf16(Bt[n][k], At[m][k], acc[ai][bj][m][n], 0, 0, 0); __builtin_amdgcn_s_setprio(0); } while (0)
#define PG8_WAIT_V(n) asm volatile("s_waitcnt vmcnt(" #n ")" ::: "memory")
#define PG8_WAIT_L(n) asm volatile("s_waitcnt lgkmcnt(" #n ")" ::: "memory")
#define PG8_BAR __builtin_amdgcn_s_barrier()
#define PG8_SCHED __builtin_amdgcn_sched_barrier(0)
    Unit cur, nxt; int ui = 0;
    if (!S.next(0, cur)) return;
    uunit(cur);
    f32x4 acc[2][2][4][2];
#pragma unroll
    for (int a = 0; a < 2; ++a)
#pragma unroll
        for (int b = 0; b < 2; ++b)
#pragma unroll
            for (int m = 0; m < 4; ++m)
#pragma unroll
                for (int n = 0; n < 2; ++n) acc[a][b][m][n] = (f32x4){0.f, 0.f, 0.f, 0.f};
    bf16x8 At[4][2], B0[2][2], B1[2][2];
    const char* cA = cur.a; const char* cB = cur.b;
    PG8_STAGE(PG8_SB(0, 0), cB, voffB); PG8_STAGE(PG8_SB(0, 1), cB + hB, voffB); PG8_STAGE(PG8_SA(0, 0), cA, voffA); PG8_STAGE(PG8_SA(0, 1), cA + hA, voffA);
    if (wr == 1) PG8_BAR;
    PG8_WAIT_V(2); PG8_BAR;
    PG8_STAGE(PG8_SB(1, 0), cB + kstep, voffB); PG8_STAGE(PG8_SA(1, 0), cA + kstep, voffA); PG8_STAGE(PG8_SB(1, 1), cB + hB + kstep, voffB);
    PG8_WAIT_V(6); PG8_BAR;
    for (;;) {
        const bool has_next = S.next(ui + 1, nxt); if (has_next) uunit(nxt);
        const char* nA = has_next ? nxt.a : cA; const char* nB = has_next ? nxt.b : cB;
        for (int t = 0; t < nt; t += 2) {
            const bool last = (t == nt - 2);
            const char* a1 = cA + (size_t)(t + 1) * kstep;
            const char* a2 = last ? nA : cA + (size_t)(t + 2) * kstep; const char* b2 = last ? nB : cB + (size_t)(t + 2) * kstep;
            const char* a3 = a2 + kstep; const char* b3 = b2 + kstep;
            PG8_LDB(B0, 0, 0); PG8_LDB(B1, 0, 1); PG8_SCHED; PG8_LDA(At, 0, 0); PG8_STAGE(PG8_SA(1, 1), a1 + hA, voffA);
            PG8_WAIT_V(8); PG8_WAIT_L(0); PG8_BAR; PG8_MMA(0, 0, At, B0); PG8_MMA(0, 1, At, B1); PG8_BAR; PG8_SCHED;
            PG8_LDA(At, 0, 1); PG8_STAGE(PG8_SB(0, 0), b2, voffB); PG8_STAGE(PG8_SB(0, 1), b2 + hB, voffB); PG8_STAGE(PG8_SA(0, 0), a2, voffA);
            PG8_WAIT_V(8); PG8_WAIT_L(0); PG8_BAR; PG8_MMA(1, 0, At, B0); PG8_MMA(1, 1, At, B1); PG8_BAR; PG8_SCHED;
            PG8_LDB(B0, 1, 0); PG8_LDB(B1, 1, 1); PG8_SCHED; PG8_LDA(At, 1, 0); PG8_STAGE(PG8_SA(0, 1), a2 + hA, voffA);
            PG8_WAIT_V(8); PG8_WAIT_L(0); PG8_BAR; PG8_MMA(0, 0, At, B0); PG8_MMA(0, 1, At, B1); PG8_BAR; PG8_SCHED;
            PG8_LDA(At, 1, 1); PG8_STAGE(PG8_SB(1, 0), b3, voffB); PG8_STAGE(PG8_SB(1, 1), b3 + hB, voffB); PG8_STAGE(PG8_SA(1, 0), a3, voffA);
            PG8_WAIT_V(8); PG8_WAIT_L(0); PG8_BAR; PG8_MMA(1, 0, At, B0); PG8_MMA(1, 1, At, B1); PG8_BAR; PG8_SCHED;
        }
        if (wr == 0) PG8_BAR;
        { const int t2 = opaque_tid(), l2 = t2 & 63; E(acc, cur, wr, wc, l2 & 15, l2 >> 4); }
        if (!has_next) break;
        if (!Epi::keep_acc(cur)) {
#pragma unroll
        for (int a = 0; a < 2; ++a)
#pragma unroll
            for (int b = 0; b < 2; ++b)
#pragma unroll
                for (int m = 0; m < 4; ++m)
#pragma unroll
                    for (int n = 0; n < 2; ++n) acc[a][b][m][n] = (f32x4){0.f, 0.f, 0.f, 0.f};
        }
        cur = nxt; cA = nA; cB = nB; ++ui;
        if (wr == 1) PG8_BAR;
    }
    PG8_WAIT_V(0);
    PG8_BAR;
#undef PG8_SA
#undef PG8_SB
#undef PG8_STAGE
#undef PG8_LDA
#undef PG8_LDB
#undef PG8_MMA
#undef PG8_WAIT_V
#undef PG8_WAIT_L
#undef PG8_BAR
#undef PG8_SCHED
}
template <class Epi, class Sched>
__device__ __forceinline__ void gemm8_phase(PG8_LAS unsigned char* lds, const int K, const int lda, const int ldb, const Sched& S, const Epi& E) {
    const int tid = opaque_tid(), wid = __builtin_amdgcn_readfirstlane(tid >> 6), lane = tid & 63, wr = wid >> 2, wc = wid & 3, fr = lane & 15, fq = lane >> 4;
    const int nt = opaque_s(K / BK);
    unsigned voffA[2], voffB[2];
#pragma unroll
    for (int i = 0; i < 2; ++i) { int R, C; stage_rc(tid * 16 + i * 8192, R, C); const int Rb = Epi::PERM ? ((R & ~31) + perm32(R & 31)) : R;
        voffA[i] = (unsigned)(R * lda + C) * 2u; voffB[i] = (unsigned)(Rb * ldb + C) * 2u; }
    const size_t kstep = (size_t)(BK * 2);
    const size_t hA = (size_t)HALF * lda * 2, hB = (size_t)HALF * ldb * 2;
    const unsigned ldsw = (unsigned)wid * 1024u, ldsbase = (unsigned)(size_t)lds;
    const int fcol = (fq >> 1) * 32 + (fq & 1) * 16;
    const int aoff = lds_byte(wr * 64 + fr, fcol), boff = lds_byte(wc * 32 + fr, fcol);
#define PG8_SA(b, h) (((b) * 2 + (h)) * HTB)
#define PG8_SB(b, h) ((4 + (b) * 2 + (h)) * HTB)
#define PG8_STAGE(bufoff, gbase, voff) do { _Pragma("unroll") for (int _i = 0; _i < 2; ++_i) \
        glds16s(uptr((const char*)(gbase)), (voff)[_i], (unsigned)__builtin_amdgcn_readfirstlane(ldsbase + (unsigned)(bufoff) + ldsw + _i * 8192u)); } while (0)
#define PG8_LDA(dst, b, h) do { _Pragma("unroll") for (int m = 0; m < 4; ++m) { const v4u lo_ = *(const PG8_LAS v4u*)(lds + PG8_SA(b, h) + aoff + m * 2048), hi_ = *(const PG8_LAS v4u*)(lds + PG8_SA(b, h) + aoff + m * 2048 + 16); dst[m] = (v8i){(int)lo_.x, (int)lo_.y, (int)lo_.z, (int)lo_.w, (int)hi_.x, (int)hi_.y, (int)hi_.z, (int)hi_.w}; } } while (0)
#define PG8_LDB(dst, b, h) do { _Pragma("unroll") for (int n = 0; n < 2; ++n) { const v4u lo_ = *(const PG8_LAS v4u*)(lds + PG8_SB(b, h) + boff + n * 2048), hi_ = *(const PG8_LAS v4u*)(lds + PG8_SB(b, h) + boff + n * 2048 + 16); dst[n] = (v8i){(int)lo_.x, (int)lo_.y, (int)lo_.z, (int)lo_.w, (int)hi_.x, (int)hi_.y, (int)hi_.z, (int)hi_.w}; } } while (0)
#define PG8_MMA(ai, bj, At, Bt) do { __builtin_amdgcn_s_setprio(1); _Pragma("unroll") for (int m = 0; m < 4; ++m) _Pragma("unroll") for (int n = 0; n < 2; ++n) \
        acc[ai][bj][m][n] = __builtin_amdgcn_mfma_scale_f32_16x16x128_f8f6f4(Bt[n], At[m], acc[ai][bj][m][n], 0, 0, 0, 0, 0, 0);     __builtin_amdgcn_s_setprio(0); } while (0)
#define PG8_WAIT_V(n) asm volatile("s_waitcnt vmcnt(" #n ")" ::: "memory")
#define PG8_WAIT_L(n) asm volatile("s_waitcnt lgkmcnt(" #n ")" ::: "memory")
#define PG8_BAR __builtin_amdgcn_s_barrier()
#define PG8_SCHED __builtin_amdgcn_sched_barrier(0)
    Unit cur, nxt; int ui = 0;
    if (!S.next(0, cur)) return;
    uunit(cur);
    f32x4 acc[2][2][4][2];
#pragma unroll
    for (int a = 0; a < 2; ++a)
#pragma unroll
        for (int b = 0; b < 2; ++b)
#pragma unroll
            for (int m = 0; m < 4; ++m)
#pragma unroll
                for (int n = 0; n < 2; ++n) acc[a][b][m][n] = (f32x4){0.f, 0.f, 0.f, 0.f};
    v8i At[4], B0[2], B1[2];
    const char* cA = cur.a; const char* cB = cur.b;
    PG8_STAGE(PG8_SB(0, 0), cB, voffB); PG8_STAGE(PG8_SB(0, 1), cB + hB, voffB); PG8_STAGE(PG8_SA(0, 0), cA, voffA); PG8_STAGE(PG8_SA(0, 1), cA + hA, voffA);
    if (wr == 1) PG8_BAR;
    PG8_WAIT_V(2); PG8_BAR;
    PG8_STAGE(PG8_SB(1, 0), cB + kstep, voffB); PG8_STAGE(PG8_SA(1, 0), cA + kstep, voffA); PG8_STAGE(PG8_SB(1, 1), cB + hB + kstep, voffB);
    PG8_WAIT_V(6); PG8_BAR;
    for (;;) {
        const bool has_next = S.next(ui + 1, nxt); if (has_next) uunit(nxt);
        const char* nA = has_next ? nxt.a : cA; const char* nB = has_next ? nxt.b : cB;
#pragma nounroll
        for (int t = 0; t < nt; t += 2) {
            const bool last = (t == nt - 2);
            const char* a1 = cA + (size_t)(t + 1) * kstep;
            const char* a2 = last ? nA : cA + (size_t)(t + 2) * kstep; const char* b2 = last ? nB : cB + (size_t)(t + 2) * kstep;
            const char* a3 = a2 + kstep; const char* b3 = b2 + kstep;
            PG8_LDB(B0, 0, 0); PG8_LDB(B1, 0, 1); PG8_SCHED; PG8_LDA(At, 0, 0); PG8_STAGE(PG8_SA(1, 1), a1 + hA, voffA);
            PG8_WAIT_V(8); PG8_WAIT_L(0); PG8_BAR; PG8_MMA(0, 0, At, B0); PG8_MMA(0, 1, At, B1); PG8_BAR; PG8_SCHED;
            PG8_LDA(At, 0, 1); PG8_STAGE(PG8_SB(0, 0), b2, voffB); PG8_STAGE(PG8_SB(0, 1), b2 + hB, voffB); PG8_STAGE(PG8_SA(0, 0), a2, voffA);
            PG8_WAIT_V(8); PG8_WAIT_L(0); PG8_BAR; PG8_MMA(1, 0, At, B0); PG8_MMA(1, 1, At, B1); PG8_BAR; PG8_SCHED;
            PG8_LDB(B0, 1, 0); PG8_LDB(B1, 1, 1); PG8_SCHED; PG8_LDA(At, 1, 0); PG8_STAGE(PG8_SA(0, 1), a2 + hA, voffA);
            PG8_WAIT_V(8); PG8_WAIT_L(0); PG8_BAR; PG8_MMA(0, 0, At, B0); PG8_MMA(0, 1, At, B1); PG8_BAR; PG8_SCHED;
            PG8_LDA(At, 1, 1); PG8_STAGE(PG8_SB(1, 0), b3, voffB); PG8_STAGE(PG8_SB(1, 1), b3 + hB, voffB); PG8_STAGE(PG8_SA(1, 0), a3, voffA);
            PG8_WAIT_V(8); PG8_WAIT_L(0); PG8_BAR; PG8_MMA(1, 0, At, B0); PG8_MMA(1, 1, At, B1); PG8_BAR; PG8_SCHED;
        }
        if (wr == 0) PG8_BAR;
        { const int t2 = opaque_tid(), l2 = t2 & 63; E(acc, cur, wr, wc, l2 & 15, l2 >> 4); }
        if (!has_next) break;
#pragma unroll
        for (int a = 0; a < 2; ++a)
#pragma unroll
            for (int b = 0; b < 2; ++b)
#pragma unroll
                for (int m = 0; m < 4; ++m)
#pragma unroll
                    for (int n = 0; n < 2; ++n) acc[a][b][m][n] = (f32x4){0.f, 0.f, 0.f, 0.f};
        cur = nxt; cA = nA; cB = nB; ++ui;
        if (wr == 1) PG8_BAR;
    }
    PG8_WAIT_V(0);
    PG8_BAR;
#undef PG8_SA
#undef PG8_SB
#undef PG8_STAGE
#undef PG8_LDA
#undef PG8_LDB
#undef PG8_MMA
#undef PG8_WAIT_V
#undef PG8_WAIT_L
#undef PG8_BAR
#undef PG8_SCHED
}
}

constexpr float W8S = 32.0f, W8I = 1.0f / 32.0f;
struct ModPtrs { const float* mod; };

struct EpiInProj {
    static constexpr bool PERM = true;
    static __device__ __forceinline__ bool keep_acc(const pg8::Unit&) { return false; }
    bf16_t *QKV, *GT;
    const float *q_gain, *k_gain, *gate_b; float* KNB;
    __device__ __forceinline__ void operator()(const f32x4 (&acc)[2][2][4][2], const pg8::Unit& u, int wr, int wc, int fr, int fq) const {
        const int pn = u.pn, pm = u.pm, jt = pm % TPB; const bool isctx = (jt == 0); const int t0 = (jt - 1) * 256;
        const int cb = 64 * wc + 8 * fq;
        const int rit0 = 64 * wr + fr;
        bf16_t* qrow = QKV + ((size_t)pm * 256 + rit0) * PQ;
#define ROWLOOP _Pragma("unroll") for (int ai = 0; ai < 2; ++ai) _Pragma("unroll") for (int m = 0; m < 4; ++m)
#define ROWVARS const int rit = 128 * ai + 16 * m + rit0; bf16_t* orow = qrow + (size_t)(128 * ai + 16 * m) * PQ; \
        float v[2][8]; _Pragma("unroll") for (int bj = 0; bj < 2; ++bj) _Pragma("unroll") for (int n = 0; n < 2; ++n) _Pragma("unroll") for (int j = 0; j < 4; ++j) v[bj][4 * n + j] = acc[ai][bj][m][n][j];
#define ROWEND __builtin_amdgcn_sched_barrier(0);
        if (pn == 0 || pn == 21 || pn == 22 || pn == 24) {
            const int oc = (pn == 0 ? C_QA : pn == 21 ? C_KA : pn == 22 ? C_VA : C_VB) + cb; const float sc = pn == 0 ? C2A : 1.0f;
            float kn2a = 0.f;
            ROWLOOP { ROWVARS
                if (pn == 21) { float ss = 0.f;
#pragma unroll
                    for (int bj = 0; bj < 2; ++bj)
#pragma unroll
                        for (int j = 0; j < 8; ++j) ss += v[bj][j] * v[bj][j];
                    kn2a = fmaxf(kn2a, xor32_sum(xor16_sum(ss))); }
#pragma unroll
                for (int bj = 0; bj < 2; ++bj) {
#pragma unroll
                    for (int j = 0; j < 8; ++j) v[bj][j] *= sc;
                    st8(orow + oc + 32 * bj, v[bj]); }
                ROWEND }
            if (pn == 21) { float mxv = kn2a; mxv = fmaxf(mxv, dpp_f<0xB1>(mxv)); mxv = fmaxf(mxv, dpp_f<0x4E>(mxv)); mxv = fmaxf(mxv, dpp_f<0x141>(mxv)); mxv = fmaxf(mxv, dpp_f<0x140>(mxv));
                if ((fr | fq) == 0) atomicMax((unsigned*)(KNB + 16 + (pm / TPB) * 4 + wc), __float_as_uint(sqrtf(mxv))); }
        } else if (pn == 3 || pn == 4) {
            const int oc = (pn == 3 ? C_GU : C_GV) + cb;
            ROWLOOP { ROWVARS
#pragma unroll
                for (int bj = 0; bj < 2; ++bj) {
#pragma unroll
                    for (int j = 0; j < 8; ++j) v[bj][j] = gelu_tanh(v[bj][j]);
                    st8(orow + oc + 32 * bj, v[bj]); }
                ROWEND }
        } else if (pn == 1 || pn == 23) {
            const int oc = (pn == 1 ? C_QB : C_KB) + 128 * wc + 8 * fq; const float sc = pn == 1 ? C2B : 1.0f;
            const f32x4 inv = *(const f32x4*)(INV8R + 4 * (fq & 1));
            const float zz[8] = {0.f, 0.f, 0.f, 0.f, 0.f, 0.f, 0.f, 0.f};
            float kn2[2] = {0.f, 0.f};
            ROWLOOP { ROWVARS
                if (pn == 23) {
#pragma unroll
                    for (int bj = 0; bj < 2; ++bj) { float ss = 0.f;
#pragma unroll
                        for (int j = 0; j < 8; ++j) ss += v[bj][j] * v[bj][j];
                        kn2[bj] = fmaxf(kn2[bj], xor32_sum(xor16_sum(ss))); } }
                const int t = t0 + rit; const float pos = (float)((fq < 2) ? (t >> 6) : (t & 63));
                float sn[4], cs[4];
#pragma unroll
                for (int p = 0; p < 4; ++p) { if (isctx) { sn[p] = 0.f; cs[p] = 1.f; } else sincos_rev(pos * inv[p], sn[p], cs[p]); }
#pragma unroll
                for (int bj = 0; bj < 2; ++bj) {
                    float o[8];
#pragma unroll
                    for (int p = 0; p < 4; ++p) { const float x0 = v[bj][2 * p], x1 = v[bj][2 * p + 1]; o[2 * p] = (x0 * cs[p] - x1 * sn[p]) * sc; o[2 * p + 1] = (x0 * sn[p] + x1 * cs[p]) * sc; }
                    st8(orow + oc + 64 * bj, o); st8(orow + oc + 64 * bj + 32, zz); }
                ROWEND }
            if (pn == 23) {
#pragma unroll
                for (int bj = 0; bj < 2; ++bj) { float mxv = kn2[bj]; mxv = fmaxf(mxv, dpp_f<0xB1>(mxv)); mxv = fmaxf(mxv, dpp_f<0x4E>(mxv)); mxv = fmaxf(mxv, dpp_f<0x141>(mxv)); mxv = fmaxf(mxv, dpp_f<0x140>(mxv));
                    if ((fr | fq) == 0) atomicMax((unsigned*)(KNB + (pm / TPB) * 8 + 2 * wc + bj), __float_as_uint(sqrtf(mxv))); } }
        } else {
            if (pn == 25 && wc >= 2) {
                const int oc = C_VD + (wc - 2) * 64 + 8 * fq;
                ROWLOOP { ROWVARS
#pragma unroll
                    for (int bj = 0; bj < 2; ++bj) st8(orow + oc + 32 * bj, v[bj]);
                    (void)rit; ROWEND }
            } else {
                const int oc = (pn == 2 ? C_QD : C_KD) + cb; const float sc = pn == 2 ? C2A : 1.0f; const float* gain = pn == 2 ? q_gain : k_gain;
                const f32x4 inv = *(const f32x4*)(INV16R + 4 * fq);
                f32x4 gn[2][2];
#pragma unroll
                for (int bj = 0; bj < 2; ++bj)
#pragma unroll
                    for (int n = 0; n < 2; ++n) gn[bj][n] = *(const f32x4*)(gain + 32 * bj + 8 * fq + 4 * n);
                ROWLOOP { ROWVARS
                    float ss = 0.f;
#pragma unroll
                    for (int bj = 0; bj < 2; ++bj)
#pragma unroll
                        for (int j = 0; j < 8; ++j) ss += v[bj][j] * v[bj][j];
                    ss = xor32_sum(xor16_sum(ss));
                    const float rstd = __builtin_amdgcn_rsqf(ss * (1.0f / 64.0f) + EPS);
                    const int t = t0 + rit;
#pragma unroll
                    for (int bj = 0; bj < 2; ++bj) {
                        const float pos = (float)(bj == 0 ? (t >> 6) : (t & 63));
                        float o[8];
#pragma unroll
                        for (int p = 0; p < 4; ++p) {
                            float sn, cs; if (isctx) { sn = 0.f; cs = 1.f; } else sincos_rev(pos * inv[p], sn, cs);
                            const float x0 = v[bj][2 * p] * rstd * gn[bj][(2 * p) >> 2][(2 * p) & 3], x1 = v[bj][2 * p + 1] * rstd * gn[bj][(2 * p + 1) >> 2][(2 * p + 1) & 3];
                            o[2 * p] = (x0 * cs - x1 * sn) * sc; o[2 * p + 1] = (x0 * sn + x1 * cs) * sc; }
                        st8(orow + oc + 32 * bj, o); }
                    ROWEND }
            }
        }
#undef ROWLOOP
#undef ROWVARS
#undef ROWEND
    }
};

__device__ __forceinline__ unsigned pk_u8x4(float a, float b, float c, float d) { unsigned w = 0u;
    w = __builtin_amdgcn_cvt_pk_u8_f32(__builtin_rintf(a * 255.0f), 0u, w); w = __builtin_amdgcn_cvt_pk_u8_f32(__builtin_rintf(b * 255.0f), 1u, w);
    w = __builtin_amdgcn_cvt_pk_u8_f32(__builtin_rintf(c * 255.0f), 2u, w); w = __builtin_amdgcn_cvt_pk_u8_f32(__builtin_rintf(d * 255.0f), 3u, w); return w; }
__device__ __forceinline__ float u8f(unsigned w, int i) { return (float)((w >> (8 * i)) & 0xffu); }
struct EpiGates {
    static constexpr bool PERM = true;
    unsigned char* GT; const float* gate_b;
    __device__ __forceinline__ void operator()(const f32x4 (&acc)[2][2][4][2], const pg8::Unit& u, int wr, int wc, int fr, int fq) const {
        const int col0 = u.pn * 256 + wc * 32 + 8 * fq;
        f32x4 gb[2][2];
#pragma unroll
        for (int bj = 0; bj < 2; ++bj)
#pragma unroll
            for (int n = 0; n < 2; ++n) gb[bj][n] = *(const f32x4*)(gate_b + col0 + bj * 128 + 4 * n) * (-LOG2E);
#pragma unroll
        for (int ai = 0; ai < 2; ++ai)
#pragma unroll
            for (int m = 0; m < 4; ++m) { unsigned char* rowp = GT + ((size_t)u.pm * 256 + ai * 128 + wr * 64 + m * 16 + fr) * 4096 + col0;
#pragma unroll
                for (int bj = 0; bj < 2; ++bj) { unsigned o[8];
#pragma unroll
                    for (int n = 0; n < 2; ++n)
#pragma unroll
                        for (int j = 0; j < 4; j += 2) { const f32x2 a2 = (f32x2){acc[ai][bj][m][n][j], acc[ai][bj][m][n][j + 1]}, c2 = (f32x2){gb[bj][n][j], gb[bj][n][j + 1]};
                            const f32x2 t2 = __builtin_elementwise_fma(a2, (f32x2){-W8I * LOG2E, -W8I * LOG2E}, c2);
                            const f32x2 e2 = (f32x2){__builtin_amdgcn_exp2f(t2.x), __builtin_amdgcn_exp2f(t2.y)};
                            const f32x2 d2 = __builtin_elementwise_fma(e2, (f32x2){1.0f / 255.0f, 1.0f / 255.0f}, (f32x2){1.0f / 255.0f, 1.0f / 255.0f});
                            const f32x2 v2 = (f32x2){__builtin_amdgcn_rcpf(d2.x), __builtin_amdgcn_rcpf(d2.y)} + (f32x2){8388608.0f, 8388608.0f};
                            o[4 * n + j] = __float_as_uint(v2.x); o[4 * n + j + 1] = __float_as_uint(v2.y); }
                    v2u w; w.x = __builtin_amdgcn_perm(o[1], o[0], 0x0c0c0400u) | __builtin_amdgcn_perm(o[3], o[2], 0x04000c0cu); w.y = __builtin_amdgcn_perm(o[5], o[4], 0x0c0c0400u) | __builtin_amdgcn_perm(o[7], o[6], 0x04000c0cu);
                    *(v2u*)(rowp + bj * 128) = w; } }
    }
};
struct EpiGateAcc {
    static constexpr bool PERM = true;
    const unsigned char* GT; bf16_t* MRG; bf16_t* GPC;
    static __device__ __forceinline__ bool keep_acc(const pg8::Unit& u) { return (u.pn & 3) != 3 && (u.pm % TPB) != 0; }
    __device__ __forceinline__ void operator()(f32x4 (&acc)[2][2][4][2], const pg8::Unit& u, int wr, int wc, int fr, int fq) const {
        const int dt = u.pn >> 2, n = u.pn & 3; const int col0 = dt * 256 + wc * 32 + 8 * fq;
        const bool isctx = (u.pm % TPB) == 0;
        const size_t row0 = (size_t)u.pm * 256 + wr * 64 + fr;
        const unsigned char* gp0 = GT + row0 * 4096 + n * 1024 + col0;
        constexpr float GMIN = 8.673617379884035e-19f;
#define GA_OFF(grp) ((size_t)(((grp) >> 3) * 128 + (((grp) >> 1) & 3) * 16))
        if (!isctx && n < 3) {
            v2u ga[16], gb[16];
#pragma unroll
            for (int grp = 0; grp < 16; ++grp) { const int bj = grp & 1; ga[grp] = *(const v2u*)(gp0 + GA_OFF(grp) * 4096 + bj * 128); gb[grp] = *(const v2u*)(gp0 + 1024 + GA_OFF(grp) * 4096 + bj * 128); }
            __builtin_amdgcn_sched_barrier(0);
#pragma unroll
            for (int grp = 0; grp < 16; ++grp) { const int ai = grp >> 3, m = (grp >> 1) & 3, bj = grp & 1; const v2u g0 = ga[grp], g1 = gb[grp];
                float r[8];
#define GA_R(i, A, B) r[i] = fmaxf(A, GMIN) * __builtin_amdgcn_rcpf(fmaxf(B, GMIN))
                GA_R(0, u8f(g0.x, 0), u8f(g1.x, 0)); GA_R(1, u8f(g0.x, 1), u8f(g1.x, 1)); GA_R(2, u8f(g0.x, 2), u8f(g1.x, 2)); GA_R(3, u8f(g0.x, 3), u8f(g1.x, 3));
                GA_R(4, u8f(g0.y, 0), u8f(g1.y, 0)); GA_R(5, u8f(g0.y, 1), u8f(g1.y, 1)); GA_R(6, u8f(g0.y, 2), u8f(g1.y, 2)); GA_R(7, u8f(g0.y, 3), u8f(g1.y, 3));
#undef GA_R
#pragma unroll
                for (int j = 0; j < 4; ++j) { acc[ai][bj][m][0][j] *= r[j]; acc[ai][bj][m][1][j] *= r[4 + j]; } }
            __builtin_amdgcn_sched_barrier(0);
        } else {
            bf16_t* mp0 = isctx ? GPC + ((size_t)n * 512 + (u.pm / TPB) * 256 + wr * 64 + fr) * 1024 + col0 : MRG + row0 * 1024 + col0;
            const float lo = isctx ? 0.f : GMIN; constexpr float I255 = 1.0f / 255.0f;
            v2u ga[16];
#pragma unroll
            for (int grp = 0; grp < 16; ++grp) { const int bj = grp & 1; ga[grp] = *(const v2u*)(gp0 + GA_OFF(grp) * 4096 + bj * 128); }
            __builtin_amdgcn_sched_barrier(0);
#pragma unroll
            for (int grp = 0; grp < 16; ++grp) { const int ai = grp >> 3, m = (grp >> 1) & 3, bj = grp & 1; const v2u g = ga[grp]; const f32x4 a0 = acc[ai][bj][m][0], a1 = acc[ai][bj][m][1];
                v4u w; w.x = cvtpk(a0[0] * (fmaxf(u8f(g.x, 0), lo) * I255), a0[1] * (fmaxf(u8f(g.x, 1), lo) * I255)); w.y = cvtpk(a0[2] * (fmaxf(u8f(g.x, 2), lo) * I255), a0[3] * (fmaxf(u8f(g.x, 3), lo) * I255));
                w.z = cvtpk(a1[0] * (fmaxf(u8f(g.y, 0), lo) * I255), a1[1] * (fmaxf(u8f(g.y, 1), lo) * I255)); w.w = cvtpk(a1[2] * (fmaxf(u8f(g.y, 2), lo) * I255), a1[3] * (fmaxf(u8f(g.y, 3), lo) * I255));
                *(v4u*)(mp0 + GA_OFF(grp) * 1024 + bj * 128) = w; }
            __builtin_amdgcn_sched_barrier(0);
        }
#undef GA_OFF
    }
};

struct EpiOutRes {
    static constexpr bool PERM = true;
    static __device__ __forceinline__ bool keep_acc(const pg8::Unit&) { return false; }
    const float* x_in; const float* ctx_in; const bf16_t* XR; bf16_t* X1; const float* mod_l; int layer;
    __device__ __forceinline__ void operator()(const f32x4 (&acc)[2][2][4][2], const pg8::Unit& u, int wr, int wc, int fr, int fq) const {
        const int pm = u.pm, b = pm / TPB, jt = pm % TPB; const bool isctx = jt == 0;
        const float* g1 = mod_l + (isctx ? 2 : b) * 6144 + 2048;
        const int col0 = u.pn * 256 + wc * 32 + 8 * fq;
        f32x4 gv[2][2];
#pragma unroll
        for (int bj = 0; bj < 2; ++bj)
#pragma unroll
            for (int n = 0; n < 2; ++n) gv[bj][n] = *(const f32x4*)(g1 + col0 + bj * 128 + n * 4);
        bf16_t* ob = X1 + ((size_t)pm * 256 + wr * 64 + fr) * DM + col0;
        if (layer == 0) {
            const float* base = (isctx ? ctx_in + (size_t)b * CTXL * DM : x_in + ((size_t)b * SEQ + (size_t)(jt - 1) * 256) * DM) + (size_t)(wr * 64 + fr) * DM + col0;
#pragma unroll
            for (int ai = 0; ai < 2; ++ai) { f32x4 rs[4][2][2];
#pragma unroll
                for (int m = 0; m < 4; ++m)
#pragma unroll
                    for (int bj = 0; bj < 2; ++bj)
#pragma unroll
                        for (int n = 0; n < 2; ++n) rs[m][bj][n] = *(const f32x4*)(base + (size_t)(ai * 128 + m * 16) * DM + bj * 128 + n * 4);
                __builtin_amdgcn_sched_barrier(0);
#pragma unroll
                for (int m = 0; m < 4; ++m)
#pragma unroll
                    for (int bj = 0; bj < 2; ++bj) { const f32x4 o0 = rs[m][bj][0] + gv[bj][0] * acc[ai][bj][m][0], o1 = rs[m][bj][1] + gv[bj][1] * acc[ai][bj][m][1];
                        v4u w; w.x = cvtpk(o0[0], o0[1]); w.y = cvtpk(o0[2], o0[3]); w.z = cvtpk(o1[0], o1[1]); w.w = cvtpk(o1[2], o1[3]);
                        *(v4u*)(ob + (size_t)(ai * 128 + m * 16) * DM + bj * 128) = w; }
                __builtin_amdgcn_sched_barrier(0); }
        } else {
            const bf16_t* base = XR + ((size_t)pm * 256 + wr * 64 + fr) * DM + col0;
#pragma unroll
            for (int ai = 0; ai < 2; ++ai) { v4u rb[4][2];
#pragma unroll
                for (int m = 0; m < 4; ++m)
#pragma unroll
                    for (int bj = 0; bj < 2; ++bj) rb[m][bj] = *(const v4u*)(base + (size_t)(ai * 128 + m * 16) * DM + bj * 128);
                __builtin_amdgcn_sched_barrier(0);
#pragma unroll
                for (int m = 0; m < 4; ++m)
#pragma unroll
                    for (int bj = 0; bj < 2; ++bj) { const v4u r = rb[m][bj];
                        const f32x4 r0 = (f32x4){bflo(r.x), bfhi(r.x), bflo(r.y), bfhi(r.y)}, r1 = (f32x4){bflo(r.z), bfhi(r.z), bflo(r.w), bfhi(r.w)};
                        const f32x4 o0 = r0 + gv[bj][0] * acc[ai][bj][m][0], o1 = r1 + gv[bj][1] * acc[ai][bj][m][1];
                        v4u w; w.x = cvtpk(o0[0], o0[1]); w.y = cvtpk(o0[2], o0[3]); w.z = cvtpk(o1[0], o1[1]); w.w = cvtpk(o1[2], o1[3]);
                        *(v4u*)(ob + (size_t)(ai * 128 + m * 16) * DM + bj * 128) = w; }
                __builtin_amdgcn_sched_barrier(0); }
        }
    }
};
struct EpiPart {
    static constexpr bool PERM = false;
    static __device__ __forceinline__ bool keep_acc(const pg8::Unit&) { return false; }
    float* PART;
    __device__ __forceinline__ void operator()(const f32x4 (&acc)[2][2][4][2], const pg8::Unit& u, int wr, int wc, int fr, int fq) const {
        const int ks = u.pn >> 2, ct = u.pn & 3; const int col0 = ct * 256 + wc * 32 + 4 * fq;
#pragma unroll
        for (int ai = 0; ai < 2; ++ai)
#pragma unroll
            for (int m = 0; m < 4; ++m) { float* op = PART + ((size_t)ks * 512 + u.pm * 256 + ai * 128 + wr * 64 + m * 16 + fr) * DM + col0;
#pragma unroll
                for (int bj = 0; bj < 2; ++bj)
#pragma unroll
                    for (int n = 0; n < 2; ++n) *(f32x4*)(op + bj * 128 + n * 16) = acc[ai][bj][m][n]; }
    }
};
struct EpiSwiGLU {
    static constexpr bool PERM = true;
    unsigned char* HID;
    __device__ __forceinline__ void operator()(const f32x4 (&acc)[2][2][4][2], const pg8::Unit& u, int wr, int wc, int fr, int fq) const {
        const int f0 = u.pn * 128 + wc * 32 + 8 * fq;
#pragma unroll
        for (int ai = 0; ai < 2; ++ai)
#pragma unroll
            for (int m = 0; m < 4; ++m) { float o[8];
#pragma unroll
                for (int n = 0; n < 2; ++n)
#pragma unroll
                    for (int j = 0; j < 4; j += 2) { const f32x2 g2 = (f32x2){acc[ai][0][m][n][j], acc[ai][0][m][n][j + 1]}, u2 = (f32x2){acc[ai][1][m][n][j], acc[ai][1][m][n][j + 1]};
                        const f32x2 t2 = g2 * (f32x2){-W8I * LOG2E, -W8I * LOG2E};
                        const f32x2 e2 = (f32x2){__builtin_amdgcn_exp2f(t2.x), __builtin_amdgcn_exp2f(t2.y)};
                        const f32x2 d2 = __builtin_elementwise_fma(e2, (f32x2){1024.0f, 1024.0f}, (f32x2){1024.0f, 1024.0f});
                        const f32x2 r2 = (f32x2){__builtin_amdgcn_rcpf(d2.x), __builtin_amdgcn_rcpf(d2.y)};
                        const f32x2 o2 = (g2 * u2) * r2; o[4 * n + j] = o2.x; o[4 * n + j + 1] = o2.y; }
                v2u w; w.x = pk8(o[0], o[1], o[2], o[3]); w.y = pk8(o[4], o[5], o[6], o[7]);
                *(v2u*)(HID + ((size_t)u.pm * 256 + ai * 128 + wr * 64 + m * 16 + fr) * EH + f0) = w; }
    }
};
struct EpiDown {
    static constexpr bool PERM = true;
    bf16_t* Y; const float* SCORE;
    __device__ __forceinline__ void operator()(const f32x4 (&acc)[2][2][4][2], const pg8::Unit& u, int wr, int wc, int fr, int fq) const {
        const int col0 = u.pn * 256 + wc * 32 + 8 * fq;
        float sc8[2][4];
#pragma unroll
        for (int ai = 0; ai < 2; ++ai)
#pragma unroll
            for (int m = 0; m < 4; ++m) sc8[ai][m] = SCORE[(size_t)u.pm * 256 + ai * 128 + wr * 64 + m * 16 + fr];
        __builtin_amdgcn_sched_barrier(0);
#pragma unroll
        for (int ai = 0; ai < 2; ++ai)
#pragma unroll
            for (int m = 0; m < 4; ++m) { const size_t row = (size_t)u.pm * 256 + ai * 128 + wr * 64 + m * 16 + fr; const float s = sc8[ai][m] * W8I;
#pragma unroll
                for (int bj = 0; bj < 2; ++bj) { float o[8];
#pragma unroll
                    for (int n = 0; n < 2; ++n)
#pragma unroll
                        for (int j = 0; j < 4; ++j) o[4 * n + j] = acc[ai][bj][m][n][j] * s;
                    st8(Y + row * DM + col0 + bj * 128, o); } }
    }
};
struct EpiDownPart {
    static constexpr bool PERM = true;
    bf16_t* YP; const float* SCORE;
    __device__ __forceinline__ void operator()(const f32x4 (&acc)[2][2][4][2], const pg8::Unit& u, int wr, int wc, int fr, int fq) const {
        if (wr != 0) return;
        const int in = u.pn & 3, kq = u.pn >> 2, e = u.pm / 9; const int col0 = in * 256 + wc * 32 + 8 * fq;
        float sc4[4];
#pragma unroll
        for (int m = 0; m < 4; ++m) sc4[m] = SCORE[(size_t)u.pm * 256 + m * 16 + fr];
        __builtin_amdgcn_sched_barrier(0);
#pragma unroll
        for (int m = 0; m < 4; ++m) { const size_t row = ((size_t)(kq * 16 + e) * 256 + m * 16 + fr); const float sc = sc4[m] * W8I;
#pragma unroll
            for (int bj = 0; bj < 2; ++bj) { float o[8];
#pragma unroll
                for (int n = 0; n < 2; ++n)
#pragma unroll
                    for (int j = 0; j < 4; ++j) o[4 * n + j] = acc[0][bj][m][n][j] * sc;
                st8(YP + row * DM + col0 + bj * 128, o); } }
    }
};

namespace attn_body {
using bf16 = __hip_bfloat16;
using u32x4 = __attribute__((ext_vector_type(4))) unsigned;
constexpr int NW = 8, QBLK = 32, QB = QBLK * NW, KVBLK = 64;
__device__ __forceinline__ int crow(int r, int hi) { return (r & 3) + 8 * (r >> 2) + 4 * hi; }
#define SBAR() __builtin_amdgcn_sched_barrier(0)
constexpr int NSLOT = 3, SLOTB = 8192;
constexpr int LDS_K = 0, LDS_V = NSLOT * SLOTB, LDS_WS = 2 * NSLOT * SLOTB, LDS_OST = LDS_WS + NW * 64 * 4, LDS_OST1 = LDS_OST + NW * 4096, LDS_RPB = LDS_OST1 + NW * 4096, LDS_ATT_BYTES = LDS_RPB + 2048;
static_assert(LDS_ATT_BYTES <= RING_BYTES, "attention LDS");
__device__ __forceinline__ void glds16(const void* gsrc, unsigned lds_dst) { unsigned keep;
  asm volatile("s_mov_b32 %0, m0\n\ts_mov_b32 m0, %2\n\ts_nop 0\n\tglobal_load_lds_dwordx4 %1, off\n\ts_mov_b32 m0, %0" : "=&s"(keep) : "v"(gsrc), "s"(lds_dst) : "memory"); }
__device__ __forceinline__ float max3f(float a, float b, float c) { float r; asm("v_max3_f32 %0, %1, %2, %3" : "=v"(r) : "v"(a), "v"(b), "v"(c)); return r; }
__device__ __forceinline__ float max2f(float a, float b) { float r; asm("v_max_f32_e32 %0, %1, %2" : "=v"(r) : "v"(a), "v"(b)); return r; }
__device__ __forceinline__ float fadd_s(float a, float b) { float r; asm("v_add_f32_e32 %0, %1, %2" : "=v"(r) : "v"(a), "v"(b)); return r; }
__device__ __forceinline__ float fsub_s(float a, float b) { float r; asm("v_sub_f32_e32 %0, %1, %2" : "=v"(r) : "v"(a), "v"(b)); return r; }
__device__ __forceinline__ unsigned cvtpk_s(float lo, float hi) { return cvtpk(lo, hi); }
#define WAIT_BAR(N) asm volatile("s_waitcnt vmcnt(" #N ") lgkmcnt(0)\n\ts_barrier" ::: "memory")

typedef __attribute__((address_space(3))) const char* lds_cptr;
typedef short v4i16_t __attribute__((ext_vector_type(4)));
__device__ __forceinline__ void qkt(f32x16& p0, f32x16& p1, lds_cptr Kslot, const bf16x8* qr, const f32x16& negm, int r32, int hi) {
  lds_cptr kb = Kslot + hi * 1024 + r32 * 16;
  #pragma unroll
  for (int d0 = 0; d0 < 4; ++d0) {
    const bf16x8 b0 = *(const __attribute__((address_space(3))) bf16x8*)(kb + d0 * 2048);
    const bf16x8 b1 = *(const __attribute__((address_space(3))) bf16x8*)(kb + d0 * 2048 + 512);
    if (d0 == 0) { p0 = __builtin_amdgcn_mfma_f32_32x32x16_bf16(b0, qr[0], negm, 0, 0, 0); p1 = __builtin_amdgcn_mfma_f32_32x32x16_bf16(b1, qr[0], negm, 0, 0, 0); }
    else { p0 = __builtin_amdgcn_mfma_f32_32x32x16_bf16(b0, qr[d0], p0, 0, 0, 0); p1 = __builtin_amdgcn_mfma_f32_32x32x16_bf16(b1, qr[d0], p1, 0, 0, 0); } }
}
__device__ __forceinline__ void kload8(bf16x8* kf, lds_cptr kp) {
  kf[0] = *(const __attribute__((address_space(3))) bf16x8*)(kp);        kf[1] = *(const __attribute__((address_space(3))) bf16x8*)(kp + 512);
  kf[2] = *(const __attribute__((address_space(3))) bf16x8*)(kp + 2048); kf[3] = *(const __attribute__((address_space(3))) bf16x8*)(kp + 2560);
  kf[4] = *(const __attribute__((address_space(3))) bf16x8*)(kp + 4096); kf[5] = *(const __attribute__((address_space(3))) bf16x8*)(kp + 4608);
  kf[6] = *(const __attribute__((address_space(3))) bf16x8*)(kp + 6144); kf[7] = *(const __attribute__((address_space(3))) bf16x8*)(kp + 6656);
}
__device__ __forceinline__ void kload2(bf16x8* kf, lds_cptr kp, int j) { kf[2 * j] = *(const __attribute__((address_space(3))) bf16x8*)(kp + j * 2048); kf[2 * j + 1] = *(const __attribute__((address_space(3))) bf16x8*)(kp + j * 2048 + 512); }
__device__ __forceinline__ s16x4 vtr(lds_cptr p) { return __builtin_bit_cast(s16x4, __builtin_amdgcn_ds_read_tr16_b64_v4i16((__attribute__((address_space(3))) v4i16_t*)p)); }
__device__ __forceinline__ float rowmax(const f32x16& p0, const f32x16& p1) {
  float a = max3f(p0[0], p0[1], p1[0]), b = max3f(p0[2], p0[3], p1[1]); a = max3f(a, p1[2], p1[3]);
  #pragma unroll
  for (int r = 4; r < 16; r += 4) { a = max3f(a, p0[r], p0[r + 1]); b = max3f(b, p0[r + 2], p0[r + 3]); a = max3f(a, p1[r], p1[r + 1]); b = max3f(b, p1[r + 2], p1[r + 3]); }
  const float m = max2f(a, b);
  auto rr = __builtin_amdgcn_permlane32_swap(__float_as_uint(m), __float_as_uint(m), false, false);
  return max2f(__uint_as_float(rr[0]), __uint_as_float(rr[1]));
}
__device__ __forceinline__ void pv(f32x16* o, int vb, bf16x8 pa0, bf16x8 pa1, bf16x8 pa2, bf16x8 pa3) {
  #pragma unroll
  for (int d0 = 0; d0 < 2; ++d0) { s16x4 lo[4], hi[4];
    #pragma unroll
    for (int ks = 0; ks < 4; ++ks) {
      asm volatile("ds_read_b64_tr_b16 %0,%1 offset:%c2" : "=&v"(lo[ks]) : "v"(vb), "i"(d0 * 4096 + ks * 1024) : "memory");
      asm volatile("ds_read_b64_tr_b16 %0,%1 offset:%c2" : "=&v"(hi[ks]) : "v"(vb), "i"(d0 * 4096 + ks * 1024 + 512) : "memory"); }
    asm volatile("s_waitcnt lgkmcnt(0)" ::: "memory"); SBAR();
    #define PK(k) (bf16x8){lo[k][0], lo[k][1], lo[k][2], lo[k][3], hi[k][0], hi[k][1], hi[k][2], hi[k][3]}
    o[d0] = __builtin_amdgcn_mfma_f32_32x32x16_bf16(pa0, PK(0), o[d0], 0, 0, 0);
    o[d0] = __builtin_amdgcn_mfma_f32_32x32x16_bf16(pa1, PK(1), o[d0], 0, 0, 0);
    o[d0] = __builtin_amdgcn_mfma_f32_32x32x16_bf16(pa2, PK(2), o[d0], 0, 0, 0);
    o[d0] = __builtin_amdgcn_mfma_f32_32x32x16_bf16(pa3, PK(3), o[d0], 0, 0, 0);
    #undef PK
  }
}

struct DiffEpi { float lam, post; const float* subg; };
template <int THRL, int MODE> __device__ __forceinline__ void attn_unit(const bf16* Qu, const bf16* __restrict__ Kh, const bf16* __restrict__ Vh, int NT, bf16* Ou, char* shm, const DiffEpi de, const bool usemax = true, const float* kmaxp = nullptr) {
  constexpr int PK = PQ, PV = PQ, PO = 1024;
  constexpr bool DQ32 = (MODE != 0);
  const int tid = opaque_tid(), lane = tid & 63, r32 = lane & 31, hi = lane >> 5; const int wid = __builtin_amdgcn_readfirstlane(tid >> 6);
  const bf16* Qw = Qu + (long)(wid * QBLK) * PQ;
  const unsigned lds0 = (unsigned)(uintptr_t)shm;
  float* wsf = (float*)(shm + LDS_WS) + wid * 64;
  const bf16* ksrc = Kh + (long)lane * PK + wid * 8;
  const bf16* vsrc = Vh + (long)(16 * (wid & 3) + (lane >> 2)) * PV + (wid >> 2) * 32 + (lane & 3) * 8;
  const unsigned kdst = lds0 + LDS_K + wid * 1024, vdst = lds0 + LDS_V + wid * 1024;
  #define DMA_K(t, slot) glds16(ksrc + (long)(t) * KVBLK * PK, (unsigned)__builtin_amdgcn_readfirstlane(kdst + (slot)))
  #define DMA_V(t, slot) glds16(vsrc + (long)(t) * KVBLK * PV, (unsigned)__builtin_amdgcn_readfirstlane(vdst + (slot)))
  const int vb0 = (int)(lds0 + LDS_V) + ((lane >> 4) & 1) * 32 + (lane & 3) * 8 + (4 * hi + ((lane & 15) >> 2)) * 64;
  bf16x8 kf[8];
  const lds_cptr shm3 = (lds_cptr)shm; const lds_cptr kp0 = shm3 + LDS_K + hi * 1024 + r32 * 16; const lds_cptr vp0 = shm3 + LDS_V + ((lane >> 4) & 1) * 32 + (lane & 3) * 8 + (4 * hi + ((lane & 15) >> 2)) * 64;
  DMA_K(0, 0); DMA_V(0, 0); DMA_K(1, SLOTB);
  bf16x8 qr[4];
  #pragma unroll
  for (int d0 = 0; d0 < 4; ++d0) qr[d0] = *reinterpret_cast<const bf16x8*>(&Qw[(long)r32 * PQ + d0 * 16 + hi * 8]);
  constexpr bool LMF = DQ32;
  bool um = usemax;
  if (MODE != 0) {
    float q2 = 0.f;
    #pragma unroll
    for (int d0 = 0; d0 < 2; ++d0)
      #pragma unroll
      for (int jq = 0; jq < 8; ++jq) { const float v = __uint_as_float((unsigned)(unsigned short)qr[d0][jq] << 16); q2 += v * v; }
    const float bq = sqrtf(xor32_sum(q2)) * (*kmaxp) * 1.02f;
    um = __builtin_amdgcn_readfirstlane((int)(__ballot(bq > 40.0f) != 0ull)) != 0; }
  float mhat = 0.f, l_reg = 0.f; f32x16 o[2]; o[0] = f32x16{}; o[1] = f32x16{}; f32x16 negm = f32x16{}; asm volatile("" : "+v"(negm));
  f32x16 lacc = f32x16{}; bf16x8 ones; { unsigned c0_, c1_, c2_, c3_; asm volatile("v_mov_b32 %0, 0x3f803f80\n\tv_mov_b32 %1, 0x3f803f80\n\tv_mov_b32 %2, 0x3f803f80\n\tv_mov_b32 %3, 0x3f803f80" : "=v"(c0_), "=v"(c1_), "=v"(c2_), "=v"(c3_)); ones = __builtin_bit_cast(bf16x8, (u32x4){c0_, c1_, c2_, c3_}); }
  bool resc = false;
  #define START(P0, P1) do { const float rm = rowmax(P0, P1); resc = false; \
    { const float dl = rm; mhat = fadd_s(mhat, dl); \
      _Pragma("unroll") for (int r = 0; r < 16; ++r) { P0[r] = fsub_s(P0[r], dl); P1[r] = fsub_s(P1[r], dl); } \
      _Pragma("unroll") for (int r = 0; r < 16; ++r) negm[r] = -mhat; asm volatile("" : "+v"(negm)); } \
    _Pragma("unroll") for (int r = 0; r < 16; ++r) P0[r] = __builtin_amdgcn_exp2f(P0[r]); } while (0)
  #define RESC() do { if (resc) { asm volatile("s_waitcnt lgkmcnt(0)" ::: "memory"); \
      _Pragma("unroll") for (int d_ = 0; d_ < 2; ++d_) _Pragma("unroll") for (int r = 0; r < 16; ++r) o[d_][r] *= wsf[crow(r, hi)]; \
      if (LMF) { _Pragma("unroll") for (int r = 0; r < 16; ++r) lacc[r] *= wsf[crow(r, hi)]; } } } while (0)
  f32x16 pA0, pA1, pB0, pB1;
  int sl_prev = 0, sl_cur = 0, sl_next = SLOTB;
  #define ROT() do { sl_prev = sl_cur; sl_cur = sl_next; sl_next = (sl_next == (NSLOT - 1) * SLOTB) ? 0 : sl_next + SLOTB; } while (0)
  DMA_K(2, 2 * SLOTB);
  WAIT_BAR(3);
  qkt(pA0, pA1, shm3 + LDS_K, qr, negm, r32, hi); asm volatile("s_nop 15\n\ts_nop 7" : "+v"(pA0), "+v"(pA1));
  START(pA0, pA1);
  _Pragma("unroll") for (int r = 0; r < 16; ++r) pA1[r] = __builtin_amdgcn_exp2f(pA1[r]);
  WAIT_BAR(0);
  DMA_K(3, 0); DMA_V(1, SLOTB);
  ROT();
  kload8(kf, kp0 + sl_cur);
  WAIT_BAR(2);
  s16x4 vlo[8], vhi[8]; u32x4 pw0, pw1, pw2, pw3;
  #define PKW(P, B) cvtpk_s(P[B], P[B + 1])
  #define PAF(k) __builtin_bit_cast(bf16x8, pw##k)
  #define VFR(i) (bf16x8){vlo[i][0], vlo[i][1], vlo[i][2], vlo[i][3], vhi[i][0], vhi[i][1], vhi[i][2], vhi[i][3]}
  #define PIN(x) asm volatile("" : "+v"(x))
  #define MX3(a, b, c) __builtin_fmaxf(__builtin_fmaxf((a), (b)), (c))
  #define GAPA(MF, A0, A1, A2, A3, W0, W1, PW) do { MF; if (!LMF) { sacc += A0; sacc += A1; sacc += A2; sacc += A3; PIN(sacc); } W0; W1; PIN(PW); SBAR(); } while (0)
  #define LMM(k) lacc = __builtin_amdgcn_mfma_f32_32x32x16_bf16(PAF(k), ones, lacc, 0, 0, 0)
  #define EX(v) __builtin_amdgcn_exp2f(v)
  #define GAPB(MF, X, B) do { MF; X[B] = EX(X[B]); X[B + 1] = EX(X[B + 1]); X[B + 2] = EX(X[B + 2]); X[B + 3] = EX(X[B + 3]); PIN(X); SBAR(); } while (0)
  #define VRD(i) do { vlo[i] = vtr(vp_ + (((i) >> 2) * 4096 + ((i) & 3) * 1024)); vhi[i] = vtr(vp_ + (((i) >> 2) * 4096 + ((i) & 3) * 1024 + 512)); } while (0)
  #define KRD(G, j) do { if (G) { kload2(kf, kp0 + sl_next, j); SBAR(); } } while (0)
  #define STEP(C0, C1, P0, P1, t, GK, GV, GL) do { SBAR(); \
    const lds_cptr vp_ = vp0 + sl_prev; \
    VRD(0); SBAR(); float sacc = (P0[0] + P0[1]); \
    GAPA(C0 = __builtin_amdgcn_mfma_f32_32x32x16_bf16(kf[0], qr[0], negm, 0, 0, 0), P0[2], P0[3], P0[4], P0[5],     pw0[0] = PKW(P0, 0), pw0[1] = PKW(P0, 2), pw0); \
    VRD(4); SBAR(); GAPA(C1 = __builtin_amdgcn_mfma_f32_32x32x16_bf16(kf[1], qr[0], negm, 0, 0, 0), P0[6], P0[7], P0[8], P0[9],     pw0[2] = PKW(P0, 4), pw0[3] = PKW(P0, 6), pw0); \
    VRD(1); SBAR(); GAPA(C0 = __builtin_amdgcn_mfma_f32_32x32x16_bf16(kf[2], qr[1], C0, 0, 0, 0),   P0[10], P0[11], P0[12], P0[13], pw1[0] = PKW(P0, 8), pw1[1] = PKW(P0, 10), pw1); \
    VRD(5); SBAR(); GAPA(C1 = __builtin_amdgcn_mfma_f32_32x32x16_bf16(kf[3], qr[1], C1, 0, 0, 0),   P0[14], P0[15], P1[0], P1[1],   pw1[2] = PKW(P0, 12), pw1[3] = PKW(P0, 14), pw1); \
    VRD(2); SBAR(); GAPA(do { if (!DQ32) { C0 = __builtin_amdgcn_mfma_f32_32x32x16_bf16(kf[4], qr[2], C0, 0, 0, 0); } else if (LMF) { LMM(0); } } while (0),   P1[2], P1[3], P1[4], P1[5],     pw2[0] = PKW(P1, 0), pw2[1] = PKW(P1, 2), pw2); \
    VRD(6); SBAR(); GAPA(do { if (!DQ32) { C1 = __builtin_amdgcn_mfma_f32_32x32x16_bf16(kf[5], qr[2], C1, 0, 0, 0); } else if (LMF) { LMM(1); } } while (0),   P1[6], P1[7], P1[8], P1[9],     pw2[2] = PKW(P1, 4), pw2[3] = PKW(P1, 6), pw2); \
    VRD(3); SBAR(); GAPA(do { if (!DQ32) { C0 = __builtin_amdgcn_mfma_f32_32x32x16_bf16(kf[6], qr[3], C0, 0, 0, 0); } else if (LMF) { LMM(2); } } while (0),   P1[10], P1[11], P1[12], P1[13], pw3[0] = PKW(P1, 8), pw3[1] = PKW(P1, 10), pw3); \
    VRD(7); SBAR(); GAPA(do { if (!DQ32) { C1 = __builtin_amdgcn_mfma_f32_32x32x16_bf16(kf[7], qr[3], C1, 0, 0, 0); } } while (0),   P1[14], P1[15], 0.f, 0.f,       pw3[2] = PKW(P1, 12), pw3[3] = PKW(P1, 14), pw3); \
    if (LMF) { LMM(3); } else { l_reg += sacc; } \
    if (GK) { DMA_K((t) + 3, sl_cur); } if (GV) { DMA_V((t) + 1, sl_next); } \
    if (um) { float a = MX3(C0[0], C0[1], C1[0]), b = MX3(C0[2], C0[3], C1[1]); a = MX3(a, C1[2], C1[3]); \
      _Pragma("unroll") for (int r = 4; r < 16; r += 4) { a = MX3(a, C0[r], C0[r + 1]); b = MX3(b, C0[r + 2], C0[r + 3]); a = MX3(a, C1[r], C1[r + 1]); b = MX3(b, C1[r + 2], C1[r + 3]); } \
      float rm = __builtin_fmaxf(a, b); { auto rr = __builtin_amdgcn_permlane32_swap(__float_as_uint(rm), __float_as_uint(rm), false, false); rm = __builtin_fmaxf(__uint_as_float(rr[0]), __uint_as_float(rr[1])); } \
      resc = false; \
      if (__builtin_expect(__any(rm > (float)THRL), 0)) { const float dl = __builtin_fmaxf(rm, 0.f); mhat += dl; \
        _Pragma("unroll") for (int r = 0; r < 16; ++r) { C0[r] -= dl; C1[r] -= dl; } \
        _Pragma("unroll") for (int r = 0; r < 16; ++r) negm[r] = -mhat; asm volatile("" : "+v"(negm)); \
        const float f = __builtin_amdgcn_exp2f(-dl); if (!LMF) l_reg *= f; if (hi == 0) wsf[r32] = f; resc = true; } } else { resc = false; } \
    SBAR(); \
    GAPB(o[0] = __builtin_amdgcn_mfma_f32_32x32x16_bf16(PAF(0), VFR(0), o[0], 0, 0, 0), C0, 0); \
    GAPB(o[1] = __builtin_amdgcn_mfma_f32_32x32x16_bf16(PAF(0), VFR(4), o[1], 0, 0, 0), C0, 4); \
    KRD(GL, 0); GAPB(o[0] = __builtin_amdgcn_mfma_f32_32x32x16_bf16(PAF(1), VFR(1), o[0], 0, 0, 0), C0, 8); \
    KRD(GL, 1); GAPB(o[1] = __builtin_amdgcn_mfma_f32_32x32x16_bf16(PAF(1), VFR(5), o[1], 0, 0, 0), C0, 12); \
    KRD(GL && !DQ32, 2); GAPB(o[0] = __builtin_amdgcn_mfma_f32_32x32x16_bf16(PAF(2), VFR(2), o[0], 0, 0, 0), C1, 0); \
    KRD(GL && !DQ32, 3); GAPB(o[1] = __builtin_amdgcn_mfma_f32_32x32x16_bf16(PAF(2), VFR(6), o[1], 0, 0, 0), C1, 4); \
    GAPB(o[0] = __builtin_amdgcn_mfma_f32_32x32x16_bf16(PAF(3), VFR(3), o[0], 0, 0, 0), C1, 8); \
    GAPB(o[1] = __builtin_amdgcn_mfma_f32_32x32x16_bf16(PAF(3), VFR(7), o[1], 0, 0, 0), C1, 12); \
    } while (0)
  int t = 1;
  for (; t + 5 < NT; t += 2) {
    STEP(pB0, pB1, pA0, pA1, t, true, true, true);     WAIT_BAR(2); RESC(); ROT();
    STEP(pA0, pA1, pB0, pB1, t + 1, true, true, true); WAIT_BAR(2); RESC(); ROT();
  }
  #define ENDW(tt) do { if ((tt) + 3 < NT) { WAIT_BAR(2); } else if ((tt) + 2 < NT) { WAIT_BAR(1); } else { WAIT_BAR(0); } } while (0)
  for (; t + 1 < NT; t += 2) {
    STEP(pB0, pB1, pA0, pA1, t, (t + 3 < NT), (t + 1 < NT), (t + 1 < NT));       ENDW(t);     RESC(); ROT();
    STEP(pA0, pA1, pB0, pB1, t + 1, (t + 4 < NT), (t + 2 < NT), (t + 2 < NT));   ENDW(t + 1); RESC(); ROT();
  }
  STEP(pB0, pB1, pA0, pA1, NT - 1, false, false, false); RESC();
  { if (!LMF) { float sacc = pB0[0] + pB0[1]; _Pragma("unroll") for (int r = 2; r < 16; ++r) sacc += pB0[r]; _Pragma("unroll") for (int r = 0; r < 16; ++r) sacc += pB1[r]; l_reg += sacc; }
    pw0 = (u32x4){PKW(pB0, 0), PKW(pB0, 2), PKW(pB0, 4), PKW(pB0, 6)}; pw1 = (u32x4){PKW(pB0, 8), PKW(pB0, 10), PKW(pB0, 12), PKW(pB0, 14)}; pw2 = (u32x4){PKW(pB1, 0), PKW(pB1, 2), PKW(pB1, 4), PKW(pB1, 6)}; pw3 = (u32x4){PKW(pB1, 8), PKW(pB1, 10), PKW(pB1, 12), PKW(pB1, 14)};
    SBAR(); if (LMF) { LMM(0); LMM(1); LMM(2); LMM(3); } pv(o, vb0 + sl_cur, PAF(0), PAF(1), PAF(2), PAF(3)); }
  #undef LMM
  #undef PKW
  #undef PAF
  #undef VFR
  #undef PIN
  #undef MX3
  #undef GAPA
  #undef GAPB
  #undef EX
  #undef VRD
  #undef KRD
  #undef STEP
  #undef ENDW
  float rli[16];
  if (LMF) {
    #pragma unroll
    for (int r = 0; r < 16; ++r) rli[r] = __builtin_amdgcn_rcpf(lacc[r]);
  } else {
    { auto rr = __builtin_amdgcn_permlane32_swap(__float_as_uint(l_reg), __float_as_uint(l_reg), false, false); l_reg = __uint_as_float(rr[0]) + __uint_as_float(rr[1]); }
    if (hi == 0) wsf[32 + r32] = l_reg; asm volatile("s_waitcnt lgkmcnt(0)" ::: "memory");
    #pragma unroll
    for (int r = 0; r < 16; ++r) rli[r] = __builtin_amdgcn_rcpf(wsf[32 + crow(r, hi)]);
  }
  bf16_t* stg = (bf16_t*)(shm + LDS_OST) + wid * 2048;
  bf16_t* stg1 = (bf16_t*)(shm + LDS_OST1) + wid * 2048;
  if (MODE == 1) {
    #pragma unroll
    for (int r = 0; r < 16; ++r) { const int orow = crow(r, hi);
      #pragma unroll
      for (int d0 = 0; d0 < 2; ++d0) stg1[orow * 64 + d0 * 32 + r32] = f2bf(o[d0][r] * rli[r]); }
    asm volatile("s_waitcnt lgkmcnt(0)" ::: "memory");
  } else {
    if (MODE == 2) {
      const float g0 = de.subg[r32] * de.post, g1 = de.subg[32 + r32] * de.post;
      #pragma unroll
      for (int r = 0; r < 16; ++r) { const int orow = crow(r, hi);
        const float d0v = bf2f(stg1[orow * 64 + r32]) - de.lam * (o[0][r] * rli[r]), d1v = bf2f(stg1[orow * 64 + 32 + r32]) - de.lam * (o[1][r] * rli[r]);
        float ss = d0v * d0v + d1v * d1v;
        ss = half32_sum(ss);
        const float rstd = __builtin_amdgcn_rsqf(ss * (1.0f / 64.0f) + EPS);
        stg[orow * 64 + r32] = f2bf(d0v * rstd * g0); stg[orow * 64 + 32 + r32] = f2bf(d1v * rstd * g1); }
    } else {
      #pragma unroll
      for (int r = 0; r < 16; ++r) { const int orow = crow(r, hi);
        #pragma unroll
        for (int d0 = 0; d0 < 2; ++d0) stg[orow * 64 + d0 * 32 + r32] = f2bf(o[d0][r] * rli[r]); }
    }
    asm volatile("s_waitcnt lgkmcnt(0)" ::: "memory");
    bf16* Ow = Ou + (long)(wid * QBLK) * PO;
    #pragma unroll
    for (int i = 0; i < 4; ++i) { const int row = i * 8 + (lane >> 3), ch = lane & 7; const u32x4 v = *(const u32x4*)(stg + row * 64 + ch * 8); *(u32x4*)(Ow + (long)row * PO + ch * 8) = v; }
  }
  asm volatile("s_waitcnt lgkmcnt(0)\n\ts_barrier" ::: "memory");
  #undef DMA_K
  #undef DMA_V
  #undef START
  #undef RESC
  #undef ROT
}

__device__ __forceinline__ void na_unit(int b, int h, int g4, const bf16* QKV, bf16* YS, const float* rpb_h, char* shm, const float* kmaxp) {
  const bf16 *QA = QKV + C_QA, *KA = QKV + C_KA, *VA = QKV + C_VA;
  const int tid = opaque_tid(), lane = tid & 63, r32 = lane & 31, hi = lane >> 5; const int wid = __builtin_amdgcn_readfirstlane(tid >> 6);
  const unsigned lds0 = (unsigned)(uintptr_t)shm;
  float* wsf = (float*)(shm + LDS_WS) + wid * 64;
  float* rp = (float*)(shm + LDS_RPB);
  const lds_cptr shm3 = (lds_cptr)shm;
  for (int i = tid; i < 15 * 31; i += 512) rp[i] = rpb_h[i] * LOG2E;
  const int rq = 4 * g4 + (wid >> 1), qc = 32 * (wid & 1) + r32;
  const long rowb = (long)b * RB;
  const bf16* Qw = QA + (rowb + CTXL + rq * 64 + 32 * (wid & 1)) * PQ + h * 64;
  bf16x8 qr[4];
  #pragma unroll
  for (int d0 = 0; d0 < 4; ++d0) qr[d0] = *reinterpret_cast<const bf16x8*>(&Qw[(long)r32 * PQ + d0 * 16 + hi * 8]);
  bool fx; { float q2 = 0.f;
    #pragma unroll
    for (int d0 = 0; d0 < 4; ++d0)
      #pragma unroll
      for (int jq = 0; jq < 8; ++jq) { const float v = __uint_as_float((unsigned)(unsigned short)qr[d0][jq] << 16); q2 += v * v; }
    float bm = 0.f; for (int i = lane; i < 15 * 31; i += 64) bm = fmaxf(bm, fabsf(rpb_h[i]));
    const float bq = sqrtf(xor32_sum(q2)) * (*kmaxp) * 1.02f + wave_max(bm) * LOG2E;
    fx = __builtin_amdgcn_readfirstlane((int)(__ballot(bq > 40.0f) != 0ull)) == 0; }
  const int r0 = min(max(rq - 4, 0), 120);
  const int kr_lo = min(max(4 * g4 - 4, 0), 120), kr_hi = min(max(4 * g4 - 1, 0), 120) + 7;
  const int ntiles = 4 + (kr_hi - kr_lo + 1);
  const int c0 = min(max(qc - 8, 0), 48);
  float mrun = -INFINITY, l_reg = 0.f; f32x16 o[2]; o[0] = f32x16{}; o[1] = f32x16{};
  const unsigned kdst = lds0 + LDS_K + wid * 1024, vdst = lds0 + LDS_V + wid * 1024;
  const int vb0 = (int)(lds0 + LDS_V) + ((lane >> 4) & 1) * 32 + (lane & 3) * 8 + (4 * hi + ((lane & 15) >> 2)) * 64;
  #define NA_DMA(TI) do { const int kr_ = kr_lo + (TI) - 4; const long krow_ = ((TI) < 4) ? rowb + 64 * (TI) : rowb + CTXL + (long)kr_ * 64; const unsigned so_ = ((TI) & 1) * SLOTB; \
      glds16(KA + (krow_ + lane) * PQ + h * 64 + wid * 8, (unsigned)__builtin_amdgcn_readfirstlane(kdst + so_)); \
      glds16(VA + (krow_ + 16 * (wid & 3) + (lane >> 2)) * PQ + h * 64 + (wid >> 2) * 32 + (lane & 3) * 8, (unsigned)__builtin_amdgcn_readfirstlane(vdst + so_)); } while (0)
  asm volatile("s_waitcnt lgkmcnt(0)\n\ts_barrier" ::: "memory");
  NA_DMA(0);
  for (int ti = 0; ti < ntiles; ++ti) {
    const int kr = kr_lo + ti - 4;
    asm volatile("s_waitcnt vmcnt(0) lgkmcnt(0)\n\ts_barrier" ::: "memory");
    if (ti + 1 < ntiles) NA_DMA(ti + 1);
    const unsigned so = (ti & 1) * SLOTB;
    const bool valid = (ti < 4) || (kr >= r0 && kr <= r0 + 7);
    if (valid) {
      f32x16 p0, p1; const f32x16 z = f32x16{};
      qkt(p0, p1, shm3 + LDS_K + so, qr, z, r32, hi);
      if (ti >= 4) {
        const int dr = kr - rq + 7;
        #pragma unroll
        for (int r = 0; r < 16; ++r) { const int k0 = crow(r, hi), k1 = k0 + 32;
          const bool v0 = (k0 >= c0) && (k0 < c0 + 16), v1 = (k1 >= c0) && (k1 < c0 + 16);
          const float b0 = v0 ? rp[dr * 31 + (k0 - qc + 15)] : 0.f, b1 = v1 ? rp[dr * 31 + (k1 - qc + 15)] : 0.f;
          p0[r] = v0 ? p0[r] + b0 : -INFINITY; p1[r] = v1 ? p1[r] + b1 : -INFINITY; }
      }
      if (fx) { float sacc = 0.f;
        #pragma unroll
        for (int r = 0; r < 16; ++r) { p0[r] = __builtin_amdgcn_exp2f(p0[r]); p1[r] = __builtin_amdgcn_exp2f(p1[r]); sacc += p0[r] + p1[r]; }
        l_reg += sacc;
      } else {
      float rm = p0[0];
      #pragma unroll
      for (int r = 1; r < 16; ++r) rm = fmaxf(rm, p0[r]);
      #pragma unroll
      for (int r = 0; r < 16; ++r) rm = fmaxf(rm, p1[r]);
      { auto rr = __builtin_amdgcn_permlane32_swap(__float_as_uint(rm), __float_as_uint(rm), false, false); rm = fmaxf(__uint_as_float(rr[0]), __uint_as_float(rr[1])); }
      const float mnew = fmaxf(mrun, rm); const float f = __builtin_amdgcn_exp2f(mrun - mnew); mrun = mnew;
      float sacc = 0.f;
      #pragma unroll
      for (int r = 0; r < 16; ++r) { p0[r] = __builtin_amdgcn_exp2f(p0[r] - mnew); p1[r] = __builtin_amdgcn_exp2f(p1[r] - mnew); sacc += p0[r] + p1[r]; }
      l_reg = l_reg * f + sacc;
      if (hi == 0) wsf[r32] = f;
      asm volatile("s_waitcnt lgkmcnt(0)" ::: "memory");
      #pragma unroll
      for (int d_ = 0; d_ < 2; ++d_)
        #pragma unroll
        for (int r = 0; r < 16; ++r) o[d_][r] *= wsf[crow(r, hi)];
      }
      u32x4 pw0, pw1, pw2, pw3;
      pw0 = (u32x4){cvtpk(p0[0], p0[1]), cvtpk(p0[2], p0[3]), cvtpk(p0[4], p0[5]), cvtpk(p0[6], p0[7])}; pw1 = (u32x4){cvtpk(p0[8], p0[9]), cvtpk(p0[10], p0[11]), cvtpk(p0[12], p0[13]), cvtpk(p0[14], p0[15])};
      pw2 = (u32x4){cvtpk(p1[0], p1[1]), cvtpk(p1[2], p1[3]), cvtpk(p1[4], p1[5]), cvtpk(p1[6], p1[7])}; pw3 = (u32x4){cvtpk(p1[8], p1[9]), cvtpk(p1[10], p1[11]), cvtpk(p1[12], p1[13]), cvtpk(p1[14], p1[15])};
      asm volatile("s_waitcnt lgkmcnt(0)" ::: "memory");
      pv(o, vb0 + (int)so, __builtin_bit_cast(bf16x8, pw0), __builtin_bit_cast(bf16x8, pw1), __builtin_bit_cast(bf16x8, pw2), __builtin_bit_cast(bf16x8, pw3));
    }
  }
  #undef NA_DMA
  { auto rr = __builtin_amdgcn_permlane32_swap(__float_as_uint(l_reg), __float_as_uint(l_reg), false, false); l_reg = __uint_as_float(rr[0]) + __uint_as_float(rr[1]); }
  if (hi == 0) wsf[32 + r32] = l_reg; asm volatile("s_waitcnt lgkmcnt(0)" ::: "memory");
  bf16_t* stg = (bf16_t*)(shm + LDS_OST) + wid * 2048;
  #pragma unroll
  for (int r = 0; r < 16; ++r) { const int orow = crow(r, hi); const float rl = __builtin_amdgcn_rcpf(wsf[32 + orow]);
    #pragma unroll
    for (int d0 = 0; d0 < 2; ++d0) stg[orow * 64 + d0 * 32 + r32] = f2bf(o[d0][r] * rl); }
  asm volatile("s_waitcnt lgkmcnt(0)" ::: "memory");
  bf16* Ow = YS + (rowb + CTXL + rq * 64 + 32 * (wid & 1)) * 1024 + h * 64;
  #pragma unroll
  for (int i = 0; i < 4; ++i) { const int row = i * 8 + (lane >> 3), ch = lane & 7; const u32x4 v = *(const u32x4*)(stg + row * 64 + ch * 8); *(u32x4*)(Ow + (long)row * 1024 + ch * 8) = v; }
  asm volatile("s_waitcnt lgkmcnt(0)\n\ts_barrier" ::: "memory");
}
#undef SBAR
#undef WAIT_BAR
}

__device__ __forceinline__ void sgu_unit(long rowbase, const bf16_t* GU, const bf16_t* GV, const float* ng, const float* sw, const float* sb, bf16_t* YS, char* shm) {
    using attn_body::crow;
    const int tid = opaque_tid(), lane = tid & 63, wid = __builtin_amdgcn_readfirstlane(tid >> 6), r32 = lane & 31, hi = lane >> 5;
    const unsigned lds0 = (unsigned)(uintptr_t)shm;
    {
        const f32x4 g4 = *(const f32x4*)(ng + 4 * lane);
        const int gl = lane >> 4, d = 4 * (lane & 15);
#pragma unroll
        for (int rb = 0; rb < 4; ++rb) { v2u raw[4];
#pragma unroll
            for (int q4 = 0; q4 < 4; ++q4) raw[q4] = *(const v2u*)(GV + (rowbase + wid * 16 + rb * 4 + q4) * PQ + 4 * lane);
            __builtin_amdgcn_sched_barrier(0);
#pragma unroll
            for (int q4 = 0; q4 < 4; ++q4) { const int q = wid * 16 + rb * 4 + q4;
                f32x4 v = {bflo(raw[q4].x), bfhi(raw[q4].x), bflo(raw[q4].y), bfhi(raw[q4].y)};
                const float mean = wave_sum((v.x + v.y) + (v.z + v.w)) * (1.0f / 256.0f);
                v = v - mean;
                const float var = wave_sum((v.x * v.x + v.y * v.y) + (v.z * v.z + v.w * v.w)) * (1.0f / 256.0f);
                const float rstd = __builtin_amdgcn_rsqf(var + EPS);
                v = v * rstd * g4;
                v2u w; w.x = cvtpk(v.x, v.y); w.y = cvtpk(v.z, v.w);
                const int k = q & 63;
                *(v2u*)(shm + (2 * gl + (q >> 6)) * 8192 + ((d >> 5) * 4 + (k >> 4)) * 1024 + (k & 15) * 64 + (d & 31) * 2) = w; }
            __builtin_amdgcn_sched_barrier(0); }
    }
    __syncthreads();
    const int g = wid & 3, ph = wid >> 2;
    const int vb0 = (int)lds0 + ((lane >> 4) & 1) * 32 + (lane & 3) * 8 + (4 * hi + ((lane & 15) >> 2)) * 64;
    bf16_t* stg = (bf16_t*)(shm + 65536) + wid * 2048;
#pragma unroll
    for (int mt = 0; mt < 2; ++mt) {
        const int p0 = ph * 64 + mt * 32;
        const float* wrow = sw + ((size_t)g * 128 + p0 + r32) * 128 + 4 * hi;
        f32x16 o[2]; o[0] = f32x16{}; o[1] = f32x16{};
#pragma unroll
        for (int sl = 0; sl < 2; ++sl) {
            f32x4 wa[4], wc[4];
#pragma unroll
            for (int s4 = 0; s4 < 4; ++s4) { wa[s4] = *(const f32x4*)(wrow + 64 * sl + 16 * s4); wc[s4] = *(const f32x4*)(wrow + 64 * sl + 16 * s4 + 8); }
            __builtin_amdgcn_sched_barrier(0);
            bf16x8 pa[4];
#pragma unroll
            for (int s4 = 0; s4 < 4; ++s4) { const v4u w = {cvtpk(wa[s4].x, wa[s4].y), cvtpk(wa[s4].z, wa[s4].w), cvtpk(wc[s4].x, wc[s4].y), cvtpk(wc[s4].z, wc[s4].w)}; pa[s4] = __builtin_bit_cast(bf16x8, w); }
            attn_body::pv(o, vb0 + (2 * g + sl) * 8192, pa[0], pa[1], pa[2], pa[3]);
        }
        float bias[16];
#pragma unroll
        for (int r = 0; r < 16; ++r) bias[r] = sb[g * 128 + p0 + crow(r, hi)];
        v4u uu[4];
#pragma unroll
        for (int i = 0; i < 4; ++i) uu[i] = *(const v4u*)(GU + (rowbase + p0 + i * 8 + (lane >> 3)) * PQ + g * 64 + (lane & 7) * 8);
        __builtin_amdgcn_sched_barrier(0);
#pragma unroll
        for (int r = 0; r < 16; ++r) { const int orow = crow(r, hi);
#pragma unroll
            for (int d0 = 0; d0 < 2; ++d0) stg[orow * 64 + d0 * 32 + r32] = f2bf(o[d0][r] + bias[r]); }
        asm volatile("s_waitcnt lgkmcnt(0)" ::: "memory");
#pragma unroll
        for (int i = 0; i < 4; ++i) { const int row = i * 8 + (lane >> 3), ch = lane & 7; const v4u mv = *(const v4u*)(stg + row * 64 + ch * 8); const v4u u4 = uu[i];
            v4u w; w.x = cvtpk(bflo(u4.x) * bflo(mv.x), bfhi(u4.x) * bfhi(mv.x)); w.y = cvtpk(bflo(u4.y) * bflo(mv.y), bfhi(u4.y) * bfhi(mv.y));
            w.z = cvtpk(bflo(u4.z) * bflo(mv.z), bfhi(u4.z) * bfhi(mv.z)); w.w = cvtpk(bflo(u4.w) * bflo(mv.w), bfhi(u4.w) * bfhi(mv.w));
            *(v4u*)(YS + (rowbase + p0 + row) * 1024 + 512 + g * 64 + ch * 8) = w; }
        asm volatile("s_waitcnt lgkmcnt(0)" ::: "memory");
    }
    __syncthreads();
}

typedef GAS unsigned gu32;
#define XB_TMO      128
#define XB_XCNT(j)  (256  + 64 * (j))
#define XB_XSUB(j)  (1280 + 64 * (j))
#define XB_XGEN(j)  (2304 + 64 * (j))
#define XB_TOP      3328
#define XB_TOPGEN   3392
#define XCD_BAR_WORDS 3456
#define XB_SPIN_CAP (1u << 18)
__device__ __forceinline__ unsigned xb_ld(unsigned* p)              { return __hip_atomic_load(p, __ATOMIC_RELAXED, __HIP_MEMORY_SCOPE_AGENT); }
__device__ __forceinline__ unsigned xb_add(unsigned* p, unsigned v) { return __hip_atomic_fetch_add(p, v, __ATOMIC_RELAXED, __HIP_MEMORY_SCOPE_AGENT); }
__device__ __forceinline__ unsigned xb_xcc_id() { return (unsigned)__builtin_amdgcn_s_getreg((3 << 11) | 20) & 0xFu; }
#define XB_SPIN(cond, bar) do { unsigned _sp = 0; while (cond) { __builtin_amdgcn_s_sleep(1); \
    if ((++_sp & 255u) == 0u) { if (xb_ld(&(bar)[XB_TMO])) break; if (_sp > XB_SPIN_CAP) { atomicAdd(&(bar)[XB_TMO], 1u); break; } } } } while (0)
struct XcdBarrier { unsigned* bar; unsigned x; volatile LAS unsigned* st; };
__device__ __forceinline__ XcdBarrier xcd_barrier_post(unsigned* bar, volatile LAS unsigned* st) {
    XcdBarrier b; b.bar = bar; b.x = xb_xcc_id(); b.st = st;
    if (threadIdx.x == 0) (void)xb_add(&bar[XB_XCNT(b.x)], 1u);
    return b;
}
__device__ __forceinline__ void xcd_barrier_complete(unsigned* bar, unsigned x, unsigned& nloc, unsigned& nx) {
    const unsigned G = gridDim.x * gridDim.y * gridDim.z;
    unsigned sum, cnt, mine, sp = 0u;
    for (;;) {
        sum = 0u; cnt = 0u; mine = 0u;
#pragma unroll
        for (unsigned j = 0; j < 16; ++j) { const unsigned c = xb_ld(&bar[XB_XCNT(j)]); sum += c; cnt += (c > 0u) ? 1u : 0u; }
        if (sum == G) break;
        __builtin_amdgcn_s_sleep(1);
        if ((++sp & 255u) == 0u) { if (xb_ld(&bar[XB_TMO])) break; if (sp > XB_SPIN_CAP) { atomicAdd(&bar[XB_TMO], 1u); break; } }
    }
    mine = xb_ld(&bar[XB_XCNT(x)]);
    nloc = mine > 0u ? mine : 1u; nx = cnt > 0u ? cnt : 1u;
}
__device__ __forceinline__ void xcd_barrier(const XcdBarrier& b) {
    asm volatile("s_waitcnt vmcnt(0)" ::: "memory");
    __syncthreads();
    if (threadIdx.x == 0) {
        unsigned* bar = b.bar;
        __builtin_amdgcn_s_waitcnt(0);
        unsigned nloc = b.st[0], nx = b.st[1];
        if (nloc == 0u) { xcd_barrier_complete(bar, b.x, nloc, nx); b.st[0] = nloc; b.st[1] = nx; }
        const unsigned old = xb_add(&bar[XB_XSUB(b.x)], 1u);
        const unsigned gen = old / nloc;
        if (old + 1u == (gen + 1u) * nloc) {
            __builtin_amdgcn_fence(__ATOMIC_RELEASE, "agent");
            asm volatile("s_waitcnt vmcnt(0)" ::: "memory");
            const unsigned og = xb_add(&bar[XB_TOP], 1u);
            const unsigned tg = og / nx;
            if (og + 1u == (tg + 1u) * nx) xb_add(&bar[XB_TOPGEN], 1u);
            else XB_SPIN(xb_ld(&bar[XB_TOPGEN]) == tg, bar);
            __builtin_amdgcn_fence(__ATOMIC_ACQUIRE, "agent");
            xb_add(&bar[XB_XGEN(b.x)], 1u);
            asm volatile("s_waitcnt vmcnt(0)" ::: "memory");
        } else {
            XB_SPIN(xb_ld(&bar[XB_XGEN(b.x)]) == gen, bar);
            __builtin_amdgcn_fence(__ATOMIC_ACQUIRE, "agent");
            asm volatile("s_waitcnt vmcnt(0)" ::: "memory");
        }
    }
    __syncthreads();
}

struct Args { const float* in[28]; float* out; unsigned char* ws; int ph_lo, ph_hi, li, pad; };
typedef const __attribute__((address_space(4))) Args* KArgs;
__device__ __forceinline__ KArgs opaque_kargs() { KArgs p = (KArgs)__builtin_amdgcn_kernarg_segment_ptr(); asm volatile("" : "+s"(p)); return p; }
enum { I_X = 0, I_C, I_CTX, I_CCTX, I_WMOD, I_BMOD, I_N1G, I_N2G, I_WIN, I_QG, I_KG, I_RPB, I_LQ1, I_LK1, I_LQ2, I_LK2, I_SUBG, I_SGUNG, I_SGUW, I_SGUB, I_GATEB, I_WBR, I_WOUT, I_WRT, I_WEG, I_WEU, I_WED, I_FG };

constexpr int CW_WIN = 16 * 26, CW_WB = 4 * 4 * 4, CW_WO = 16 * 4, CW_EG = 16 * 16 * 8, CW_ED = 16 * 32 * 4, CW_LAYER = CW_WIN + CW_WB + CW_WO + 2 * CW_EG + CW_ED;
struct ConvItem { const float* src; unsigned char* dst; int N, dpitch, k0, n0, kind, aux; };
__device__ __forceinline__ ConvItem conv_decode(KArgs A, int it) {
    ConvItem c; const int l = it / CW_LAYER; int r = it % CW_LAYER; unsigned char* wl = A->ws + WS_W0 + (size_t)l * W_LAYER; c.aux = 0;
    if (r < CW_WIN) { const int kb = r / 26, pn = r % 26; c.src = A->in[I_WIN] + (size_t)l * DM * IN_W; c.N = IN_W; c.k0 = 64 * kb; c.n0 = 256 * pn; c.dpitch = DM;
        if (pn >= 5 && pn <= 20) { c.kind = 1; c.dst = wl + WO_WING + (size_t)(c.n0 - 1280) * DM; } else { c.kind = 2; c.dst = wl + WO_WIN + (size_t)256 * (pn < 5 ? pn : pn - 16) * DM * 2; }
        return c; }
    r -= CW_WIN;
    if (r < CW_WB) { const int n = r / 16, q = r % 16, kb = q / 4, nb = q % 4; c.src = A->in[I_WBR] + ((size_t)l * 4 + n) * 256 * DM; c.N = DM; c.k0 = 64 * kb; c.n0 = 256 * nb; c.dpitch = 256; c.kind = 0; c.dst = wl + WO_WB + ((size_t)n * 1024 + c.n0) * 256 * 2; return c; }
    r -= CW_WB;
    if (r < CW_WO) { const int kb = r / 4, nb = r % 4; c.src = A->in[I_WOUT] + (size_t)l * DM * DM; c.N = DM; c.k0 = 64 * kb; c.n0 = 256 * nb; c.dpitch = DM; c.kind = 0; c.dst = wl + WO_WO4 + (size_t)c.n0 * DM * 2; return c; }
    r -= CW_WO;
    if (r < 2 * CW_EG) { const int up = r >= CW_EG; if (up) r -= CW_EG; const int e = r / 128, q = r % 128, kb = q / 8, nb = q % 8; c.src = A->in[up ? I_WEU : I_WEG] + ((size_t)l * NEXP + e) * DM * EH; c.N = EH; c.k0 = 64 * kb; c.n0 = 256 * nb; c.dpitch = DM;
        c.kind = 3; c.aux = up ? 128 : 0; c.dst = wl + WO_WGU + (size_t)e * 4096 * DM; return c; }
    r -= 2 * CW_EG;
    { const int e = r / 128, q = r % 128, kb = q / 4, nb = q % 4; c.src = A->in[I_WED] + ((size_t)l * NEXP + e) * EH * DM; c.N = DM; c.k0 = 64 * kb; c.n0 = 256 * nb; c.dpitch = EH; c.kind = 1; c.dst = wl + WO_WD + ((size_t)e * DM + c.n0) * EH; return c; }
}
constexpr int CW_SMALL = CW_WIN + CW_WB + CW_WO, CW_MOE = 2 * CW_EG + CW_ED;
template <bool SMALL> __device__ __forceinline__ int conv_id(int it) { return SMALL ? (it / CW_SMALL) * CW_LAYER + it % CW_SMALL : it; }
template <bool SMALL> __device__ __forceinline__ void conv_load(KArgs A, int it, int NIT, f32x4 (&rg)[8], int wv, int lane) {
    if (it < NIT) { const ConvItem c = conv_decode(A, conv_id<SMALL>(it)); const float* p = c.src + (size_t)(c.k0 + wv * 8) * c.N + c.n0 + 4 * lane;
#pragma unroll
        for (int i = 0; i < 8; ++i) rg[i] = *(const f32x4*)(p + (size_t)i * c.N); }
}
template <bool SMALL> __device__ __forceinline__ void conv_out(KArgs A, int it, const f32x4 (&rg)[8], LAS float* T, int tid, int wv, int lane) {
    constexpr int TP = 256;
#pragma unroll
    for (int i = 0; i < 8; ++i) *(LAS f32x4*)(T + (wv * 8 + i) * TP + 4 * (lane ^ wv)) = rg[i];
    asm volatile("s_waitcnt lgkmcnt(0)" ::: "memory"); __builtin_amdgcn_s_barrier(); asm volatile("" ::: "memory");
    const ConvItem c = conv_decode(A, conv_id<SMALL>(it));
#pragma unroll
    for (int jj = 0; jj < 4; ++jj) { const int q = tid + 512 * jj, ch = q & 7, n = q >> 3; const LAS float* t = T + (8 * ch) * TP + (n ^ (4 * ch));
        float v[8];
#pragma unroll
        for (int i = 0; i < 8; ++i) v[i] = t[i * TP];
        if (c.kind == 1) { v2u o; o.x = pk8(v[0] * W8S, v[1] * W8S, v[2] * W8S, v[3] * W8S); o.y = pk8(v[4] * W8S, v[5] * W8S, v[6] * W8S, v[7] * W8S); *(v2u*)(c.dst + (size_t)n * c.dpitch + c.k0 + 8 * ch) = o; }
        else if (c.kind == 3) { const int f = c.n0 + n; v2u o; o.x = pk8(v[0] * W8S, v[1] * W8S, v[2] * W8S, v[3] * W8S); o.y = pk8(v[4] * W8S, v[5] * W8S, v[6] * W8S, v[7] * W8S); *(v2u*)(c.dst + (size_t)(256 * (f >> 7) + (f & 127) + c.aux) * c.dpitch + c.k0 + 8 * ch) = o; }
        else { const int g = n >> 5, row = c.kind == 2 ? 32 * (4 * (g & 1) + (g >> 1)) + (n & 31) : n; st8((bf16_t*)c.dst + (size_t)row * c.dpitch + c.k0 + 8 * ch, v); } }
    asm volatile("s_waitcnt lgkmcnt(0)" ::: "memory"); __builtin_amdgcn_s_barrier(); asm volatile("" ::: "memory");
}
template <bool SMALL = false> __device__ __forceinline__ void conv_run(KArgs A, int first, int stride, int end, LAS unsigned char* lds, int tid) {
    const int lane = tid & 63, wv = tid >> 6; LAS float* T = (LAS float*)lds;
    f32x4 rg[4][8];
#pragma unroll
    for (int d = 0; d < 4; ++d) conv_load<SMALL>(A, first + d * stride, end, rg[d], wv, lane);
    for (int it = first; it < end; it += 4 * stride) {
#pragma unroll
        for (int d = 0; d < 4; ++d) if (it + d * stride < end) {
            f32x4 t0[8];
#pragma unroll
            for (int i = 0; i < 8; ++i) t0[i] = rg[d][i];
            conv_load<SMALL>(A, it + (4 + d) * stride, end, rg[d], wv, lane);
            conv_out<SMALL>(A, it + d * stride, t0, T, tid, wv, lane);
        }
    }
}
__device__ __forceinline__ void mod_item(KArgs A, int item, LAS unsigned char* lds, int tid) {
    const int lane = tid & 63, wid = tid >> 6, l = item / 96, col0 = 64 * (item % 96);
    LAS float* sil = (LAS float*)lds;
    LAS float* part = sil + 3 * 1024;
    for (int i = tid; i < 3 * 1024; i += 512) { const int r = i >> 10, k = i & 1023; const float cv = r < 2 ? A->in[I_C][r * DM + k] : A->in[I_CCTX][k]; sil[i] = siluf_(cv); }
    __syncthreads();
    const float* W = A->in[I_WMOD] + (size_t)l * DM * 6144 + col0 + lane;
    float a0 = 0.f, a1 = 0.f, a2 = 0.f;
    for (int kb = 0; kb < 4; ++kb) { float w[32];
#pragma unroll
        for (int q = 0; q < 32; ++q) w[q] = W[(size_t)(wid * 128 + kb * 32 + q) * 6144];
        __builtin_amdgcn_sched_barrier(0);
#pragma unroll
        for (int q = 0; q < 32; ++q) { const int k = wid * 128 + kb * 32 + q; a0 += sil[k] * w[q]; a1 += sil[1024 + k] * w[q]; a2 += sil[2048 + k] * w[q]; }
        __builtin_amdgcn_sched_barrier(0); }
    part[(wid * 3 + 0) * 64 + lane] = a0; part[(wid * 3 + 1) * 64 + lane] = a1; part[(wid * 3 + 2) * 64 + lane] = a2;
    __syncthreads();
    if (tid < 192) { const int r = tid >> 6, cl = tid & 63; float s = A->in[I_BMOD][(size_t)l * 6144 + col0 + cl];
#pragma unroll
        for (int w = 0; w < 8; ++w) s += part[(w * 3 + r) * 64 + cl];
        ((float*)(A->ws + WS_MOD))[((size_t)l * 3 + r) * 6144 + col0 + cl] = s; }
    __syncthreads();
}

struct Row { f32x4 v[4]; };
__device__ __forceinline__ Row row_load(const float* p, int lane) { Row r; const f32x4* q = (const f32x4*)p + lane;
#pragma unroll
    for (int j = 0; j < 4; ++j) r.v[j] = q[64 * j]; return r; }
__device__ __forceinline__ Row row_load_bf16(const bf16_t* p, int lane) { Row r; const v2u* q = (const v2u*)p + lane; v2u t[4];
#pragma unroll
    for (int j = 0; j < 4; ++j) t[j] = q[64 * j];
#pragma unroll
    for (int j = 0; j < 4; ++j) r.v[j] = (f32x4){bflo(t[j].x), bfhi(t[j].x), bflo(t[j].y), bfhi(t[j].y)};
    return r; }
__device__ __forceinline__ void row_store(float* p, const Row& r, int lane) { f32x4* q = (f32x4*)p + lane;
#pragma unroll
    for (int j = 0; j < 4; ++j) q[64 * j] = r.v[j]; }
__device__ __forceinline__ float row_rstd(const Row& r) { float s = 0.f;
#pragma unroll
    for (int j = 0; j < 4; ++j) s += (r.v[j].x * r.v[j].x + r.v[j].y * r.v[j].y) + (r.v[j].z * r.v[j].z + r.v[j].w * r.v[j].w);
    return __builtin_amdgcn_rsqf(wave_sum(s) * (1.0f / DM) + EPS); }
__device__ __forceinline__ Row row_normmod(const Row& x, float rstd, const float* g, const float* sh, const float* sc, int lane) { Row y; f32x4 gg[4], ss[4], hh[4];
#pragma unroll
    for (int j = 0; j < 4; ++j) { gg[j] = ((const f32x4*)g)[lane + 64 * j]; ss[j] = ((const f32x4*)sc)[lane + 64 * j]; hh[j] = ((const f32x4*)sh)[lane + 64 * j]; }
    __builtin_amdgcn_sched_barrier(0);
#pragma unroll
    for (int j = 0; j < 4; ++j) y.v[j] = x.v[j] * rstd * gg[j] * (ss[j] + 1.0f) + hh[j];
    return y; }
struct NormP { f32x4 a[4], h[4]; };
__device__ __forceinline__ NormP normp_load(const float* g, const float* sh, const float* sc, int lane) { NormP p; f32x4 gg[4], ss[4];
#pragma unroll
    for (int j = 0; j < 4; ++j) { gg[j] = ((const f32x4*)g)[lane + 64 * j]; ss[j] = ((const f32x4*)sc)[lane + 64 * j]; p.h[j] = ((const f32x4*)sh)[lane + 64 * j]; }
    __builtin_amdgcn_sched_barrier(0);
#pragma unroll
    for (int j = 0; j < 4; ++j) p.a[j] = gg[j] * (ss[j] + 1.0f);
    return p; }
__device__ __forceinline__ Row row_normmod_p(const Row& x, float rstd, const NormP& p) { Row y;
#pragma unroll
    for (int j = 0; j < 4; ++j) y.v[j] = x.v[j] * rstd * p.a[j] + p.h[j];
    return y; }
__device__ __forceinline__ void row_store_bf16(bf16_t* p, const Row& r, int lane) { v2u* q = (v2u*)p + lane;
#pragma unroll
    for (int j = 0; j < 4; ++j) { v2u w; w.x = cvtpk(r.v[j].x, r.v[j].y); w.y = cvtpk(r.v[j].z, r.v[j].w); q[64 * j] = w; } }
__device__ __forceinline__ void row_store_fp8(unsigned char* p, const Row& r, int lane) { unsigned* q = (unsigned*)p + lane;
#pragma unroll
    for (int j = 0; j < 4; ++j) q[64 * j] = pk8(r.v[j].x, r.v[j].y, r.v[j].z, r.v[j].w); }
__device__ __forceinline__ const float* in_row(KArgs A, int R) { const int b = R / RB, r = R % RB; return r < CTXL ? A->in[I_CTX] + ((size_t)b * CTXL + r) * DM : A->in[I_X] + ((size_t)b * SEQ + (r - CTXL)) * DM; }
__device__ __forceinline__ int mod_row(int R) { const int b = R / RB, r = R % RB; return r < CTXL ? 2 : b; }

__device__ __forceinline__ int lat_tile(int im) { return (im >> 5) * TPB + 1 + (im & 31); }
struct SchedP1 { const char* HN; const char* W; int layer, G, c;
    __device__ __forceinline__ bool next(int i, pg8::Unit& u) const {
        const int nmain = 64 * 10, nextra = layer == 0 ? 2 * 10 : 2 * 5; const int L = i * G + c; if (L >= nmain + nextra) return false;
        int pm, pq;
        if (L < nmain) { int im, in; pg8::rect_order(L, 64, 10, im, in); pm = lat_tile(im); pq = in; }
        else { const int x = L - nmain; if (layer == 0) { pm = (x / 10) * TPB; pq = x % 10; } else { pm = (x / 5) * TPB; pq = 5 + x % 5; } }
        u.pm = pm; u.pn = pq < 5 ? pq : pq + 16; u.a = HN + (size_t)pm * 256 * DM * 2; u.b = W + (size_t)pq * 256 * DM * 2; return true; } };
struct SchedP1g { const char* HN8; const char* W8; int layer, G, c;
    __device__ __forceinline__ bool next(int i, pg8::Unit& u) const {
        const int nmain = 64 * 16, nextra = layer == 0 ? 2 * 16 : 0; const int L = i * G + (G - 1 - c); if (L >= nmain + nextra) return false;
        int pm, pn;
        if (L < nmain) { int im; pg8::rect_order(L, 64, 16, im, pn); pm = lat_tile(im); }
        else { const int x = L - nmain; pm = (x >> 4) * TPB; pn = x & 15; }
        u.pm = pm; u.pn = pn; u.a = HN8 + (size_t)pm * 256 * DM; u.b = W8 + (size_t)pn * 256 * DM; return true; } };
struct SchedP3a { const char* YS; const char* WB; int layer, G, c;
    __device__ __forceinline__ bool next(int i, pg8::Unit& u) const {
        int pm, dt, n;
        if (i < 4) { if (c >= 256) return false; int im; pg8::rect_order(c, 64, 4, im, dt); pm = lat_tile(im); n = i; }
        else { if (i > 4 || layer != 0 || c >= 32) return false; pm = (c >> 4) * TPB; dt = (c >> 2) & 3; n = c & 3; }
        u.pm = pm; u.pn = dt * 4 + n; u.a = YS + ((size_t)pm * 256 * DM + 256 * n) * 2; u.b = WB + ((size_t)n * 1024 + dt * 256) * 256 * 2; return true; } };
struct SchedP3b { const char* MRG; const char* WO; int G, c;
    __device__ __forceinline__ bool next(int i, pg8::Unit& u) const {
        const int L = i * G + c; if (L >= 64 * 4) return false;
        int im, in; pg8::rect_order(L, 64, 4, im, in); const int pm = lat_tile(im);
        u.pm = pm; u.pn = in; u.a = MRG + (size_t)pm * 256 * DM * 2; u.b = WO + (size_t)in * 256 * DM * 2; return true; } };
struct SchedP3c { const char* GPC; const char* WO; int G, c;
    __device__ __forceinline__ bool next(int i, pg8::Unit& u) const {
        const int L = i * G + c; if (L >= 128) return false;
        const int pm = L >> 6, ks = (L >> 2) & 15, ct = L & 3, n = ks >> 2, kq = ks & 3;
        u.pm = pm; u.pn = ks * 4 + ct; u.a = GPC + (((size_t)n * 512 + pm * 256) * DM + kq * 256) * 2; u.b = WO + ((size_t)ct * 256 * DM + kq * 256) * 2; return true; } };
struct SchedP6 { const char* XG; const char* WGU; int RT, G, c;
    __device__ __forceinline__ bool next(int i, pg8::Unit& u) const {
        const int nM = 16 * RT; const int L = i * G + c; if (L >= nM * 16) return false;
        int im, in; pg8::rect_order(L, nM, 16, im, in); const int e = im / RT;
        u.pm = im; u.pn = in; u.a = XG + (size_t)im * 256 * DM; u.b = WGU + ((size_t)e * 4096 + in * 256) * DM; return true; } };
struct SchedP7 { const char* HID; const char* WD; int RT, G, c;
    __device__ __forceinline__ bool next(int i, pg8::Unit& u) const {
        const int nM = 16 * 8; const int L = i * G + c; if (L >= nM * 4) return false;
        int im8, in; pg8::rect_order(L, nM, 4, im8, in); const int e = im8 >> 3, im = e * RT + (im8 & 7);
        u.pm = im; u.pn = in; u.a = HID + (size_t)im * 256 * EH; u.b = WD + ((size_t)e * DM + in * 256) * EH; return true; } };
struct SchedP7c { const char* HID; const char* WD; int G, c;
    __device__ __forceinline__ bool next(int i, pg8::Unit& u) const {
        const int L = i * G + c; if (L >= 256) return false;
        const int e = L >> 4, in = (L >> 2) & 3, kq = L & 3, im = e * 9 + 8;
        u.pm = im; u.pn = in + 4 * kq; u.a = HID + (size_t)im * 256 * EH + kq * 512; u.b = WD + ((size_t)e * DM + in * 256) * EH + kq * 512; return true; } };

__device__ __forceinline__ unsigned block_excl_scan(unsigned v, LAS unsigned* wtot, int lane, int wid) {
    unsigned inc = v;
#pragma unroll
    for (int o = 1; o < 64; o <<= 1) { const unsigned t = (unsigned)__builtin_amdgcn_ds_bpermute(((lane - o) & 63) << 2, (int)inc); if (lane >= o) inc += t; }
    if (lane == 63) wtot[wid] = inc;
    __syncthreads();
    unsigned base = 0;
#pragma unroll
    for (int w = 0; w < 8; ++w) base += (w < wid) ? wtot[w] : 0u;
    __syncthreads();
    return base + inc - v;
}
__device__ __forceinline__ void topk_unit(KArgs A, int RT, bool isctx, int b, int e, LAS unsigned char* lds, int tid) {
    const int lane = tid & 63, wid = tid >> 6;
    LAS unsigned* hist = (LAS unsigned*)lds; LAS unsigned* wtot = hist + 256; LAS unsigned* sel = wtot + 16;
    const int cap = isctx ? 32 : 1024;
    const float* aff = isctx ? (const float*)(A->ws + WS_AFFC) + ((size_t)b * 16 + e) * 256 : (const float*)(A->ws + WS_AFFL) + ((size_t)b * 16 + e) * 8192;
    unsigned key[16];
    if (isctx) {
#pragma unroll
        for (int j = 0; j < 16; ++j) key[j] = 0u;
        if (tid < 256) key[0] = __float_as_uint(aff[tid]);
    } else {
#pragma unroll
        for (int q = 0; q < 4; ++q) { const f32x4 t = *(const f32x4*)(aff + tid * 16 + 4 * q); key[4 * q] = __float_as_uint(t.x); key[4 * q + 1] = __float_as_uint(t.y); key[4 * q + 2] = __float_as_uint(t.z); key[4 * q + 3] = __float_as_uint(t.w); }
    }
#define TK_VALID(j) (isctx ? ((j) == 0 && tid < 256) : true)
    unsigned pfx = 0u, need = (unsigned)cap;
    for (int pass = 0; pass < 4; ++pass) { const int shift = 24 - 8 * pass;
        for (int i = tid; i < 256; i += 512) hist[i] = 0u;
        __syncthreads();
#pragma unroll
        for (int j = 0; j < 16; ++j) if (TK_VALID(j) && (pass == 0 || (key[j] >> (shift + 8)) == pfx)) __hip_atomic_fetch_add(&hist[(key[j] >> shift) & 255u], 1u, __ATOMIC_RELAXED, __HIP_MEMORY_SCOPE_WORKGROUP);
        __syncthreads();
        if (wid == 0) {
            const unsigned h0 = hist[4 * lane], h1 = hist[4 * lane + 1], h2 = hist[4 * lane + 2], h3 = hist[4 * lane + 3], s = h0 + h1 + h2 + h3;
            unsigned incl = s;
#pragma unroll
            for (int o = 1; o < 64; o <<= 1) { const unsigned t = (unsigned)__builtin_amdgcn_ds_bpermute(((lane + o) & 63) << 2, (int)incl); if (lane + o < 64) incl += t; }
            const unsigned excl = incl - s;
            if (excl < need && need <= incl) { unsigned c = excl; int bin;
                if (c + h3 >= need) bin = 3; else { c += h3; if (c + h2 >= need) bin = 2; else { c += h2; if (c + h1 >= need) bin = 1; else { c += h1; bin = 0; } } }
                sel[0] = (unsigned)(4 * lane + bin); sel[1] = need - c; }
        }
        __syncthreads();
        pfx = (pfx << 8) | sel[0]; need = sel[1];
        __syncthreads();
    }
    const unsigned T = pfx;
    unsigned ce = 0u;
#pragma unroll
    for (int j = 0; j < 16; ++j) ce += (TK_VALID(j) && key[j] == T) ? 1u : 0u;
    unsigned re = block_excl_scan(ce, wtot, lane, wid);
    unsigned selmask = 0u, cs = 0u;
#pragma unroll
    for (int j = 0; j < 16; ++j) if (TK_VALID(j)) { bool s = key[j] > T; if (key[j] == T) { s = re < need; ++re; } if (s) { selmask |= 1u << j; ++cs; } }
    unsigned slot = block_excl_scan(cs, wtot, lane, wid);
    int* IDXROW = (int*)(A->ws + WS_IDXROW); float* SCORE = (float*)(A->ws + WS_SCORE); int* INV = (int*)(A->ws + WS_INV);
    const int ybase = e * RT * 256 + (isctx ? 2048 + b * 32 : b * 1024);
#pragma unroll
    for (int j = 0; j < 16; ++j) if (TK_VALID(j)) { const int idx = isctx ? tid : tid * 16 + j; const int R = b * RB + (isctx ? idx : CTXL + idx);
        if (selmask & (1u << j)) { const int yrow = ybase + (int)slot; IDXROW[yrow] = R; SCORE[yrow] = __uint_as_float(key[j]); INV[((size_t)b * 16 + e) * RB + (R - b * RB)] = yrow; ++slot; }
        else INV[((size_t)b * 16 + e) * RB + (R - b * RB)] = -1; }
    if (isctx && b == 0 && tid < 192) IDXROW[e * RT * 256 + 2048 + 64 + tid] = -1;
#undef TK_VALID
    __syncthreads();
}

struct AJob { const attn_body::bf16 *Q, *K, *V; attn_body::bf16* O; int nt, mode, normed; const float* kmax; };
__device__ __forceinline__ bool mixer_job(unsigned char* ws, int l, int vcu, int i, AJob& j) {
    using attn_body::bf16;
    const bf16* QKV = (const bf16*)(ws + WS_QKV); bf16* YS = (bf16*)(ws + WS_YS); j.normed = 0; j.kmax = nullptr; const float* KNB = (const float*)(ws + WS_KNB) + l * 32;
    if (i < 3) { const int b = vcu >> 7, h = (vcu >> 5) & 3, qb = vcu & 31; const long q0 = (long)b * RB + CTXL + qb * 256, k0 = (long)b * RB;
        if (i < 2) { const int vh = 2 * h + i; j.Q = QKV + q0 * PQ + C_QB + vh * 64; j.K = QKV + k0 * PQ + C_KB + vh * 64; j.V = QKV + k0 * PQ + C_VB + h * 64; j.O = YS + q0 * 1024 + 256 + h * 64; j.nt = 132; j.mode = 1 + i; j.kmax = KNB + b * 8 + vh; }
        else { j.Q = QKV + q0 * PQ + C_QD + h * 64; j.K = QKV + k0 * PQ + C_KD + (h >> 1) * 64; j.V = QKV + k0 * PQ + C_VD + (h >> 1) * 64; j.O = YS + q0 * 1024 + 768 + h * 64; j.nt = 132; j.mode = 0; j.normed = 1; }
        return true; }
    if (l != 0) return false;
    const int uc = (vcu + 256 - 132) & 255; if (uc >= 24) return false;
    const int type = uc >> 3, b = (uc >> 2) & 1, h = uc & 3, k = i - 3; const long q0 = (long)b * RB;
    j.nt = 4;
    if (type == 0) { if (k > 0) return false; j.Q = QKV + q0 * PQ + C_QA + h * 64; j.K = QKV + q0 * PQ + C_KA + h * 64; j.V = QKV + q0 * PQ + C_VA + h * 64; j.O = YS + q0 * 1024 + h * 64; j.mode = 0; return true; }
    if (type == 1) { if (k > 1) return false; const int vh = 2 * h + k; j.Q = QKV + q0 * PQ + C_QB + vh * 64; j.K = QKV + q0 * PQ + C_KB + vh * 64; j.V = QKV + q0 * PQ + C_VB + h * 64; j.O = YS + q0 * 1024 + 256 + h * 64; j.mode = 1 + k; j.kmax = KNB + b * 8 + vh; return true; }
    if (k > 0) return false; j.Q = QKV + q0 * PQ + C_QD + h * 64; j.K = QKV + q0 * PQ + C_KD + (h >> 1) * 64; j.V = QKV + q0 * PQ + C_VD + (h >> 1) * 64; j.O = YS + q0 * 1024 + 768 + h * 64; j.mode = 0; j.normed = 1; return true;
}

__global__ void __launch_bounds__(512, 2) fwd_kernel(Args A_) {
    extern __shared__ __attribute__((aligned(16))) unsigned char lds[];
    LAS unsigned char* L = (LAS unsigned char*)lds;
    const int tid0 = threadIdx.x;
    const int G0 = gridDim.x, bx0 = blockIdx.x;
    unsigned char* ws = A_.ws;
    for (int u = tid0; u < (LDS_BYTES - LDSCTL_OFF) / 4; u += 512) ((LAS unsigned*)(L + LDSCTL_OFF))[u] = 0u;
    __syncthreads();
    XcdBarrier bar; bar.bar = (unsigned*)(ws + WS_CTL) + CW_BAR + A_.li * XCD_BAR_WORDS; bar.x = 0; bar.st = nullptr;
    if (!MK_PER_PHASE) bar = xcd_barrier_post((unsigned*)(ws + WS_CTL) + CW_BAR + A_.li * XCD_BAR_WORDS, (volatile LAS unsigned*)(L + MISC_OFF) + 8);
#define PHASE_PTRS KArgs A = opaque_kargs(); unsigned char* ws = A->ws; const int G = opaque_s(G0), bx = opaque_s(bx0), vcu = (bx % 8) * (G / 8) + bx / 8, wave = __builtin_amdgcn_readfirstlane(opaque_tid() >> 6), gw = vcu * 8 + wave, NGW = G * 8; (void)gw; (void)NGW; (void)vcu; const float* MOD = (const float*)(ws + WS_MOD); bf16_t* HN = (bf16_t*)(ws + WS_HN); bf16_t* H2 = (bf16_t*)(ws + WS_H2); bf16_t* YS = (bf16_t*)(ws + WS_YS); \
    bf16_t* GT = (bf16_t*)(ws + WS_GT); bf16_t* X1 = (bf16_t*)(ws + WS_X1); bf16_t* XR = (bf16_t*)(ws + WS_XR); float* PART = (float*)(ws + WS_PART); \
    (void)MOD; (void)HN; (void)H2; (void)YS; (void)GT; (void)X1; (void)XR; (void)PART;
    const int lo = A_.ph_lo, hi = A_.ph_hi;
#ifndef DBG_MASK
#define DBG_MASK 0xffffffffu
#endif
#define PHON(k) ((DBG_MASK >> ((k) < 2 ? (k) : 2 + ((k) - 2) % 10)) & 1u)
#define IN(k) (PHON(k) && lo <= (k) && (k) < hi)
#define SEAM(k) do { if (!MK_PER_PHASE && (k) + 1 < hi) { XcdBarrier b2_ = bar; b2_.bar = (unsigned*)opaque_ptr((unsigned char*)bar.bar); xcd_barrier(b2_); } } while (0)

    if (IN(0)) { PHASE_PTRS
        const int tid = opaque_tid(), lane = tid & 63; (void)tid; (void)lane;
        for (int item = bx; item < 192; item += G) mod_item(A, item, L, tid);
        __syncthreads();
        SEAM(0);
    }
    if (IN(1)) { PHASE_PTRS
        const int tid = opaque_tid(), lane = tid & 63; (void)tid; (void)lane;
        { const int Ra = gw * 9, Rb = min(Ra + 9, NR);
          Row xn = row_load(in_row(A, min(Ra, NR - 1)), lane), xn2 = row_load(in_row(A, min(Ra + 1, NR - 1)), lane), xn3 = row_load(in_row(A, min(Ra + 2, NR - 1)), lane);
          int cur = mod_row(min(Ra, NR - 1)); NormP np; { const float* m = MOD + (size_t)cur * 6144; np = normp_load(A->in[I_N1G], m, m + 1024, lane); }
          for (int R = Ra; R < Rb; ++R) { const Row x = xn; xn = xn2; xn2 = xn3; if (R + 3 < Rb) xn3 = row_load(in_row(A, R + 3), lane);
            const int mr = mod_row(R); if (mr != cur) { const float* m = MOD + (size_t)mr * 6144; np = normp_load(A->in[I_N1G], m, m + 1024, lane); cur = mr; }
            const Row y = row_normmod_p(x, row_rstd(x), np); row_store_bf16(HN + (size_t)R * DM, y, lane); row_store_fp8(ws + WS_HN8 + (size_t)R * DM, y, lane); } }
        __syncthreads();
        conv_run<true>(A, vcu, G, DEPTH * CW_SMALL, L, tid);
        SEAM(1);
    }
    for (int l = 0; l < DEPTH; ++l) {
        const int P = 2 + 10 * l; const int RT = l == 0 ? 9 : 8;
#define LAYER_PTRS PHASE_PTRS unsigned char* wl = ws + WS_W0 + (size_t)l * W_LAYER; const float* MODL = MOD + (size_t)l * 3 * 6144; (void)wl; (void)MODL;
        if (IN(P + 0)) { LAYER_PTRS
            { SchedP1 S{(const char*)HN, (const char*)(wl + WO_WIN), l, G, bx};
              EpiInProj E{(bf16_t*)(ws + WS_QKV), GT, A->in[I_QG] + l * 64, A->in[I_KG] + l * 64, A->in[I_GATEB] + (size_t)l * 4096, (float*)(ws + WS_KNB) + l * 32};
              pg8::gemm_phase<EpiInProj, SchedP1>(L, DM, DM, DM, S, E); }
            { SchedP1g S{(const char*)(ws + WS_HN8), (const char*)(wl + WO_WING), l, G, bx}; EpiGates E{(unsigned char*)GT, A->in[I_GATEB] + (size_t)l * 4096};
              pg8::gemm8_phase<EpiGates, SchedP1g>(L, DM / 2, DM / 2, DM / 2, S, E); }
            SEAM(P + 0);
        }
        if (IN(P + 1)) { LAYER_PTRS
            const int tid = opaque_tid(), lane = tid & 63; (void)tid; (void)lane;
            float s1 = lane < 32 ? A->in[I_LQ1][l * 32 + lane] * A->in[I_LK1][l * 32 + lane] : 0.f, s2 = lane < 32 ? A->in[I_LQ2][l * 32 + lane] * A->in[I_LK2][l * 32 + lane] : 0.f;
            const float lam_init = l == 0 ? 0.2f : 0.35550906759096934f;
            const float lam = expf(wave_sum(s1)) - expf(wave_sum(s2)) + lam_init;
            const attn_body::DiffEpi de{lam, 1.0f - lam_init, A->in[I_SUBG] + l * 64};
            const float gqm = wave_max(fabsf(A->in[I_QG][l * 64 + lane])), gkm = wave_max(fabsf(A->in[I_KG][l * 64 + lane]));
            const bool gqa_nomax = __builtin_amdgcn_readfirstlane((int)(64.0f * gqm * gkm * C2A * 1.05f <= 40.0f)) != 0;
            const int cslot = vcu & 3, cbase = l * CW_LAYER + CW_SMALL + vcu * (CW_MOE / 256);
#define CONV_SEAM(k) do { if (cslot == (k)) conv_run(A, cbase, 1, cbase + CW_MOE / 256, L, opaque_tid()); } while (0)
            static_assert(CW_MOE % 256 == 0, "expert-weight items split evenly over 256 CUs");
            CONV_SEAM(0);
            AJob j;
            for (int i = 0; mixer_job(ws, l, vcu, i, j); ++i) {
                if (i == 2) CONV_SEAM(1);
                if (i == 3) CONV_SEAM(2);
                if (j.mode == 0) attn_body::attn_unit<8, 0>(j.Q, j.K, j.V, j.nt, j.O, (char*)lds, de, !(j.normed && gqa_nomax));
                else if (j.mode == 1) attn_body::attn_unit<8, 1>(j.Q, j.K, j.V, j.nt, j.O, (char*)lds, de, true, j.kmax);
                else attn_body::attn_unit<8, 2>(j.Q, j.K, j.V, j.nt, j.O, (char*)lds, de, true, j.kmax);
            }
            if (l != 0 || ((vcu + 256 - 132) & 255) >= 24) CONV_SEAM(2);
            { const int b = vcu >> 7, h = (vcu >> 5) & 3, g4 = vcu & 31;
              attn_body::na_unit(b, h, g4, (const attn_body::bf16*)(ws + WS_QKV), (attn_body::bf16*)YS, A->in[I_RPB] + ((size_t)l * 4 + h) * 465, (char*)lds, (const float*)(ws + WS_KNB) + l * 32 + 16 + b * 4 + h); }
            CONV_SEAM(3);
            const int nsgu = 128 + (l == 0 ? 4 : 0);
            if (vcu < nsgu) { const long rowbase = vcu < 128 ? (long)(vcu >> 6) * RB + CTXL + (vcu & 63) * 128 : (long)((vcu - 128) >> 1) * RB + ((vcu - 128) & 1) * 128;
                sgu_unit(rowbase, (const bf16_t*)(ws + WS_QKV) + C_GU, (const bf16_t*)(ws + WS_QKV) + C_GV, A->in[I_SGUNG] + l * 256, A->in[I_SGUW] + (size_t)l * 4 * 128 * 128, A->in[I_SGUB] + l * 4 * 128, YS, (char*)lds); }
            SEAM(P + 1);
        }
        if (IN(P + 2)) { LAYER_PTRS
            SchedP3a S{(const char*)YS, (const char*)(wl + WO_WB), l, G, bx}; EpiGateAcc E{(const unsigned char*)GT, (bf16_t*)(ws + WS_MRG), (bf16_t*)(ws + WS_GPC)};
            pg8::gemm_phase<EpiGateAcc, SchedP3a>(L, 256, DM, 256, S, E);
            SEAM(P + 2);
        }
        if (IN(P + 3)) { LAYER_PTRS
            { SchedP3b S{(const char*)(ws + WS_MRG), (const char*)(wl + WO_WO4), G, bx}; EpiOutRes E{A->in[I_X], A->in[I_CTX], XR, X1, MODL, l};
              pg8::gemm_phase<EpiOutRes, SchedP3b>(L, DM, DM, DM, S, E); }
            if (l == 0) { SchedP3c S{(const char*)(ws + WS_GPC), (const char*)(wl + WO_WO4), G, bx}; EpiPart E{PART};
              pg8::gemm_phase<EpiPart, SchedP3c>(L, 256, DM, DM, S, E); }
            SEAM(P + 3);
        }
        if (IN(P + 4)) { LAYER_PTRS
            const int tid = opaque_tid(), lane = tid & 63; (void)tid; (void)lane;
            LAS float* wrT = (LAS float*)L;
            const float* wr = A->in[I_WRT] + (size_t)l * DM * 16;
            { f32x4 wv[8];
#pragma unroll
              for (int q = 0; q < 8; ++q) wv[q] = ((const f32x4*)wr)[tid + 512 * q];
              __builtin_amdgcn_sched_barrier(0);
#pragma unroll
              for (int q = 0; q < 8; ++q) { const int i4 = tid + 512 * q, k = i4 >> 2, e0 = (i4 & 3) * 4;
#pragma unroll
                  for (int j = 0; j < 4; ++j) wrT[(e0 + j) * DM + k] = wv[q][j]; } }
            __syncthreads();
            const int nit = 8 + ((l == 0 && gw < 512) ? 1 : 0);
            Row xn; { const int i0 = gw * 8; xn = row_load_bf16(X1 + ((size_t)(i0 >> 13) * RB + CTXL + (i0 & 8191)) * DM, lane); }
            NormP np; { const float* m0 = MODL + (size_t)((gw * 8) >> 13) * 6144; np = normp_load(A->in[I_N2G] + l * DM, m0 + 3072, m0 + 4096, lane); }
            for (int it = 0; it < nit; ++it) { const int i = it < 8 ? gw * 8 + it : 16384 + gw; const bool isctx = i >= 16384; const int b = isctx ? (i - 16384) >> 8 : i >> 13, r = isctx ? (i - 16384) & 255 : CTXL + (i & 8191); const int R = b * RB + r;
                const float* m = MODL + (size_t)(isctx ? 2 : b) * 6144;
                Row x = xn;
                if (it + 1 < 8) { const int in = i + 1; xn = row_load_bf16(X1 + ((size_t)(in >> 13) * RB + CTXL + (in & 8191)) * DM, lane); }
                if (isctx) { x = row_load(in_row(A, R), lane); Row s;
#pragma unroll
                    for (int j = 0; j < 4; ++j) s.v[j] = (f32x4){0.f, 0.f, 0.f, 0.f};
                    for (int ks = 0; ks < 16; ks += 4) { Row p[4];
#pragma unroll
                        for (int q = 0; q < 4; ++q) p[q] = row_load(PART + ((size_t)(ks + q) * 512 + b * 256 + r) * DM, lane);
                        __builtin_amdgcn_sched_barrier(0);
#pragma unroll
                        for (int q = 0; q < 4; ++q)
#pragma unroll
                            for (int j = 0; j < 4; ++j) s.v[j] += p[q].v[j]; }
#pragma unroll
                    for (int j = 0; j < 4; ++j) x.v[j] += ((const f32x4*)(m + 2048))[lane + 64 * j] * s.v[j];
                    row_store_bf16(X1 + (size_t)R * DM, x, lane);
                }
                if (isctx) np = normp_load(A->in[I_N2G] + l * DM, m + 3072, m + 4096, lane);
                const Row h = row_normmod_p(x, row_rstd(x), np);
                { unsigned* hq = (unsigned*)((unsigned char*)H2 + (size_t)R * DM) + lane;
#pragma unroll
                  for (int j = 0; j < 4; ++j) hq[64 * j] = pk8(h.v[j].x, h.v[j].y, h.v[j].z, h.v[j].w); }
                float lg[16];
#pragma unroll
                for (int e = 0; e < 16; ++e) { f32x2 a2 = (f32x2){0.f, 0.f};
#pragma unroll
                    for (int j = 0; j < 4; ++j) { const f32x4 w = *(const LAS f32x4*)(wrT + e * DM + 4 * lane + 256 * j);
                        a2 = __builtin_elementwise_fma((f32x2){h.v[j].x, h.v[j].y}, (f32x2){w.x, w.y}, a2); a2 = __builtin_elementwise_fma((f32x2){h.v[j].z, h.v[j].w}, (f32x2){w.z, w.w}, a2); }
                    lg[e] = a2.x + a2.y; if ((e & 3) == 3) __builtin_amdgcn_sched_barrier(0); }
                float c8[8], d[4];
#pragma unroll
                for (int i = 0; i < 8; ++i) { auto rr = __builtin_amdgcn_permlane32_swap(__float_as_uint(lg[i]), __float_as_uint(lg[i + 8]), false, false); c8[i] = __uint_as_float(rr[0]) + __uint_as_float(rr[1]); }
#pragma unroll
                for (int i = 0; i < 4; ++i) { auto rr = __builtin_amdgcn_permlane16_swap(__float_as_uint(c8[i]), __float_as_uint(c8[i + 4]), false, false); d[i] = row16_sum(__uint_as_float(rr[0]) + __uint_as_float(rr[1])); }
                float mx = fmaxf(fmaxf(d[0], d[1]), fmaxf(d[2], d[3]));
                { auto rr = __builtin_amdgcn_permlane16_swap(__float_as_uint(mx), __float_as_uint(mx), false, false); mx = fmaxf(__uint_as_float(rr[0]), __uint_as_float(rr[1])); }
                { auto rr = __builtin_amdgcn_permlane32_swap(__float_as_uint(mx), __float_as_uint(mx), false, false); mx = fmaxf(__uint_as_float(rr[0]), __uint_as_float(rr[1])); }
#pragma unroll
                for (int i = 0; i < 4; ++i) d[i] = __expf(d[i] - mx);
                const float sum = xor32_sum(xor16_sum((d[0] + d[1]) + (d[2] + d[3])));
                const int li = lane & 15, ex = 4 * (lane >> 4) + li;
                float mine = li == 0 ? d[0] : li == 1 ? d[1] : li == 2 ? d[2] : d[3];
                mine = mine / sum;
                if (li < 4) { if (isctx) ((float*)(ws + WS_AFFC))[((size_t)b * 16 + ex) * 256 + r] = mine; else ((float*)(ws + WS_AFFL))[((size_t)b * 16 + ex) * 8192 + (r - CTXL)] = mine; }
            }
            SEAM(P + 4);
        }
        if (IN(P + 5)) { LAYER_PTRS
            const int tid = opaque_tid(), lane = tid & 63; (void)tid; (void)lane;
            const int nun = l == 0 ? 64 : 32;
            for (int u = vcu; u < nun; u += G) topk_unit(A, RT, u >= 32, (u >> 4) & 1, u & 15, L, tid);
            SEAM(P + 5);
        }
        if (IN(P + 6)) { LAYER_PTRS
            const int tid = opaque_tid(), lane = tid & 63; (void)tid; (void)lane;
            const int* IDXROW = (const int*)(ws + WS_IDXROW); unsigned char* XG = ws + WS_XG;
            const int nyr = 16 * RT * 256;
            for (int y0 = gw; y0 < nyr; y0 += 9 * NGW) { int src[9]; v4u a[9];
#pragma unroll
                for (int q = 0; q < 9; ++q) { const int y = y0 + q * NGW; src[q] = y < nyr ? IDXROW[y] : -1; }
                __builtin_amdgcn_sched_barrier(0);
#pragma unroll
                for (int q = 0; q < 9; ++q) { a[q] = (v4u){0u, 0u, 0u, 0u}; if (src[q] >= 0) a[q] = ((const v4u*)((const unsigned char*)H2 + (size_t)src[q] * DM))[lane]; }
                __builtin_amdgcn_sched_barrier(0);
#pragma unroll
                for (int q = 0; q < 9; ++q) { const int y = y0 + q * NGW; if (y < nyr) ((v4u*)(XG + (size_t)y * DM))[lane] = a[q]; } }
            SEAM(P + 6);
        }
        if (IN(P + 7)) { LAYER_PTRS
            SchedP6 S{(const char*)(ws + WS_XG), (const char*)(wl + WO_WGU), RT, G, bx}; EpiSwiGLU E{ws + WS_HID};
            pg8::gemm8_phase<EpiSwiGLU, SchedP6>(L, DM / 2, DM / 2, DM / 2, S, E);
            SEAM(P + 7);
        }
        if (IN(P + 8)) { LAYER_PTRS
            SchedP7 S{(const char*)(ws + WS_HID), (const char*)(wl + WO_WD), RT, G, bx}; EpiDown E{(bf16_t*)(ws + WS_Y), (const float*)(ws + WS_SCORE)};
            pg8::gemm8_phase<EpiDown, SchedP7>(L, EH / 2, EH / 2, EH / 2, S, E);
            if (l == 0) { SchedP7c S2{(const char*)(ws + WS_HID), (const char*)(wl + WO_WD), G, bx}; EpiDownPart E2{(bf16_t*)(ws + WS_XG), (const float*)(ws + WS_SCORE)};
              pg8::gemm8_phase<EpiDownPart, SchedP7c>(L, 256, EH / 2, EH / 2, S2, E2); }
            SEAM(P + 8);
        }
        if (IN(P + 9)) { LAYER_PTRS
            const int tid = opaque_tid(), lane = tid & 63; (void)tid; (void)lane;
            const int* INV = (const int*)(ws + WS_INV); const bf16_t* Y = (const bf16_t*)(ws + WS_Y);
#define P8_INV(R_) (lane < 16 ? INV[((size_t)((R_) / RB) * 16 + lane) * RB + (R_) % RB] : -1)
#define P8_YISSUE(INVV, W, KEEP, REST) do { unsigned mk_ = (unsigned)(__ballot((INVV) >= 0) & 0xffffull); \
                _Pragma("unroll") for (int k = 0; k < 4; ++k) { const bool have = mk_ != 0u; const int e = have ? __builtin_ctz(mk_) : 0; mk_ &= mk_ - 1u; \
                    const int yr = have ? __builtin_amdgcn_readlane((INVV), e) : 0; const v2u* yp = (const v2u*)(Y + (size_t)yr * DM) + lane; KEEP[k] = have ? 0xffffffffu : 0u;     \
                    _Pragma("unroll") for (int j = 0; j < 4; ++j) W[k][j] = yp[64 * j]; } REST = mk_; } while (0)
            Row xn; int invn, invf; v2u wn[4][4]; unsigned kn[4], restn;
#define P8_ROW(k) ((k) < 8 ? (((gw * 8 + (k)) >> 13) * RB + CTXL + ((gw * 8 + (k)) & 8191)) : ((gw >> 8) * RB + (gw & 255)))
            const int nit = 8 + ((l == 0 && gw < 512) ? 1 : 0);
            { const int R0 = P8_ROW(0); xn = row_load_bf16(X1 + (size_t)R0 * DM, lane); invn = P8_INV(R0); P8_YISSUE(invn, wn, kn, restn); const int R1 = P8_ROW(1); invf = P8_INV(R1); }
            int curm; NormP np; f32x4 g2v[4];
#define P8_PARAMS(mr_) do { const float* m_ = MODL + (size_t)(mr_) * 6144; \
                _Pragma("unroll") for (int j = 0; j < 4; ++j) g2v[j] = ((const f32x4*)(m_ + 5120))[lane + 64 * j]; \
                if (l + 1 < DEPTH) { const float* m1 = MOD + ((size_t)(l + 1) * 3 + (mr_)) * 6144; np = normp_load(A->in[I_N1G] + (l + 1) * DM, m1, m1 + 1024, lane); } \
                else { _Pragma("unroll") for (int j = 0; j < 4; ++j) { np.a[j] = ((const f32x4*)A->in[I_FG])[lane + 64 * j]; np.h[j] = np.a[j]; } } \
                __builtin_amdgcn_sched_barrier(0); } while (0)
            { curm = (gw * 8) >> 13; P8_PARAMS(curm); }
            for (int k9 = 0; k9 < nit; ++k9) { const int R = P8_ROW(k9); const int b = R / RB, r = R % RB; const bool isctx = r < CTXL;
                Row x = xn; const int myinv = invn; v2u w0[4][4]; unsigned k0[4]; unsigned msk = restn;
#pragma unroll
                for (int k = 0; k < 4; ++k) { k0[k] = kn[k];
#pragma unroll
                    for (int j = 0; j < 4; ++j) w0[k][j] = wn[k][j]; }
                if (k9 + 1 < nit) { const int Rn = P8_ROW(k9 + 1); xn = row_load_bf16(X1 + (size_t)Rn * DM, lane); invn = invf; P8_YISSUE(invn, wn, kn, restn); const int Rf = P8_ROW(min(k9 + 2, nit - 1)); invf = P8_INV(Rf); }
                if (l == 1 && isctx) continue;
                const float* m = MODL + (size_t)(isctx ? 2 : b) * 6144;
                Row s;
#pragma unroll
                for (int j = 0; j < 4; ++j) s.v[j] = (f32x4){0.f, 0.f, 0.f, 0.f};
#pragma unroll
                for (int k = 0; k < 4; ++k)
#pragma unroll
                    for (int j = 0; j < 4; ++j) s.v[j] += (f32x4){bflo(w0[k][j].x & k0[k]), bfhi(w0[k][j].x & k0[k]), bflo(w0[k][j].y & k0[k]), bfhi(w0[k][j].y & k0[k])};
                if (isctx) {
#pragma unroll
                    for (int j = 0; j < 4; ++j) s.v[j] = (f32x4){0.f, 0.f, 0.f, 0.f};
                    msk = 0u; unsigned mk = (unsigned)(__ballot(myinv >= 0) & 0xffffull); const bf16_t* YP = (const bf16_t*)(ws + WS_XG);
                    while (mk) { const int e = __builtin_ctz(mk); mk &= mk - 1u; const int yr = __builtin_amdgcn_readlane(myinv, e); const int ex = yr / 2304, rr = yr % 2304 - 2048;
                        v2u t[4][4];
#pragma unroll
                        for (int kq = 0; kq < 4; ++kq) { const v2u* yp = (const v2u*)(YP + ((size_t)(kq * 16 + ex) * 256 + rr) * DM) + lane;
#pragma unroll
                            for (int j = 0; j < 4; ++j) t[kq][j] = yp[64 * j]; }
                        __builtin_amdgcn_sched_barrier(0);
#pragma unroll
                        for (int kq = 0; kq < 4; ++kq)
#pragma unroll
                            for (int j = 0; j < 4; ++j) s.v[j] += (f32x4){bflo(t[kq][j].x), bfhi(t[kq][j].x), bflo(t[kq][j].y), bfhi(t[kq][j].y)}; } }
                while (msk) {
                    v2u w[4][4];
#pragma unroll
                    for (int k = 0; k < 4; ++k) { const bool have = msk != 0u; const int e = have ? __builtin_ctz(msk) : 0; msk &= msk - 1u; if (!have) msk = 0u;
                        const int yr = have ? __builtin_amdgcn_readlane(myinv, e) : 0;
                        const v2u* yp = (const v2u*)(Y + (size_t)yr * DM) + lane; const unsigned keep = have ? 0xffffffffu : 0u;
#pragma unroll
                        for (int j = 0; j < 4; ++j) { v2u t = yp[64 * j]; t.x &= keep; t.y &= keep; w[k][j] = t; } }
#pragma unroll
                    for (int k = 0; k < 4; ++k)
#pragma unroll
                        for (int j = 0; j < 4; ++j) s.v[j] += (f32x4){bflo(w[k][j].x), bfhi(w[k][j].x), bflo(w[k][j].y), bfhi(w[k][j].y)};
                }
                { const int mr = isctx ? 2 : b; if (mr != curm) { curm = mr; P8_PARAMS(mr); } }
#pragma unroll
                for (int j = 0; j < 4; ++j) x.v[j] += g2v[j] * s.v[j];
                const float rstd = row_rstd(x);
                if (l + 1 < DEPTH) { row_store_bf16(XR + (size_t)R * DM, x, lane);
                    const Row y = row_normmod_p(x, rstd, np); row_store_bf16(HN + (size_t)R * DM, y, lane); if (!isctx) row_store_fp8(ws + WS_HN8 + (size_t)R * DM, y, lane); }
                else { Row y;
#pragma unroll
                    for (int j = 0; j < 4; ++j) y.v[j] = x.v[j] * rstd * np.a[j];
                    row_store(A->out + ((size_t)b * SEQ + (r - CTXL)) * DM, y, lane); }
            }
            SEAM(P + 9);
        }
    }
#undef IN
#undef SEAM
}

extern "C" void kernel_launch(void* const* d_in, const int* in_sizes, int n_in, void* d_out, int out_size, void* d_ws, size_t ws_size, hipStream_t stream) {
    static int grid = 0;
    if (grid == 0) {
        if (n_in != 28 || out_size != NB * SEQ * DM || ws_size < WS_END) { fprintf(stderr, "kernel_launch: unexpected shapes (n_in %d, out %d, ws %zu < %zu)\n", n_in, out_size, ws_size, (size_t)WS_END); grid = -1; return; }
        int dev = 0, cus = 0, per_cu = 0;
        if (hipGetDevice(&dev) != hipSuccess || hipDeviceGetAttribute(&cus, hipDeviceAttributeMultiprocessorCount, dev) != hipSuccess) { grid = -1; return; }
        if (hipFuncSetAttribute((const void*)fwd_kernel, hipFuncAttributeMaxDynamicSharedMemorySize, LDS_BYTES) != hipSuccess) { fprintf(stderr, "kernel_launch: hipFuncSetAttribute failed\n"); grid = -1; return; }
        if (hipOccupancyMaxActiveBlocksPerMultiprocessor(&per_cu, (const void*)fwd_kernel, 512, LDS_BYTES) != hipSuccess || per_cu < 1) fprintf(stderr, "kernel_launch: occupancy query reports %d blocks/CU\n", per_cu);
        (void)hipGetLastError();
        if (cus != 256) { fprintf(stderr, "kernel_launch: built for 256 CUs, device has %d\n", cus); grid = -1; return; }
        grid = 256;
    }
    if (grid < 0) return;
    (void)hipMemsetAsync((char*)d_ws + WS_CTL, 0, CTL_ZERO_BYTES, stream);
    Args a{};
    for (int i = 0; i < 28; ++i) a.in[i] = (const float*)d_in[i];
    a.out = (float*)d_out; a.ws = (unsigned char*)d_ws;
#if MK_PER_PHASE
    for (int p = 0; p < NPHASE; ++p) { a.ph_lo = p; a.ph_hi = p + 1; hipLaunchKernelGGL(fwd_kernel, dim3(grid), dim3(512), LDS_BYTES, stream, a); }
#elif defined(PROBE_REPEAT)
    { const int reps[] = {PROBE_REPEAT}; const int nr = sizeof(reps) / sizeof(int); int lo = 0;
      for (int i = 0; i <= nr; ++i) { a.ph_lo = lo; a.ph_hi = i < nr ? reps[i] + 1 : NPHASE; a.li = i; hipLaunchKernelGGL(fwd_kernel, dim3(grid), dim3(512), LDS_BYTES, stream, a); if (i < nr) lo = reps[i]; } }
#else
    a.ph_lo = 0; a.ph_hi = NPHASE; hipLaunchKernelGGL(fwd_kernel, dim3(grid), dim3(512), LDS_BYTES, stream, a);
#endif
}
```

```cpp
#include <hip/hip_runtime.h>
#include <hip/hip_bf16.h>
#include <cstdio>
#include <cstdint>
#include <cmath>

#ifndef MK_PER_PHASE
#define MK_PER_PHASE 0
#endif

constexpr int DM = 1024, NB = 2, SEQ = 8192, CTXL = 256, RB = SEQ + CTXL, NR = NB * RB, DEPTH = 2;
constexpr int IN_W = 6656, NEXP = 16, EH = 2048, TPB = RB / 256  ;
constexpr float EPS = 1e-6f, LOG2E = 1.4426950408889634f;
constexpr float C2A = 0.125f * LOG2E;
constexpr float C2B = 0.17677669529663687f * LOG2E;
constexpr int NPHASE = 2 + 10 * DEPTH;

constexpr size_t MiB = 1u << 20, KiB128 = 131072;
constexpr size_t WS_CTL = 0, CTL_ZERO_BYTES = 1 * MiB;
constexpr size_t WS_MOD = 1 * MiB;
constexpr size_t WS_AFFL = 2 * MiB, WS_AFFC = 3 * MiB;
constexpr size_t WS_IDXROW = 4 * MiB, WS_SCORE = 4 * MiB + 512 * 1024, WS_INV = 5 * MiB;
constexpr size_t WS_GPC = 8 * MiB;
constexpr size_t WS_W0 = 24 * MiB, W_LAYER = 215 * MiB;
constexpr size_t WO_WING = 8 * MiB  , WO_WIN = 0  , WO_WB = 13 * MiB, WO_WO4 = 15 * MiB, WO_WGU = 23 * MiB, WO_WD = 151 * MiB;
constexpr size_t WS_HN = 454 * MiB;
constexpr size_t WS_QKV = 487 * MiB;
constexpr int PQ = 3136;
constexpr int C_QA = 0, C_KA = 256, C_VA = 512, C_QB = 768, C_KB = 1280, C_VB = 1792, C_QD = 2048, C_KD = 2304, C_VD = 2432, C_GU = 2560, C_GV = 2816;
constexpr size_t WS_Y = WS_QKV;
constexpr size_t WS_KNB = 512 * 1024;
constexpr size_t WS_GT = 589 * MiB;
constexpr size_t WS_YS = 721 * MiB;
constexpr size_t WS_HID = WS_GT;
constexpr size_t WS_X1 = 754 * MiB, WS_XR = 820 * MiB, WS_H2 = 886 * MiB, WS_XG = 919 * MiB, WS_MRG = WS_H2, WS_PART = WS_XG  , WS_HN8 = 991 * MiB  , WS_END = 1008 * MiB;
static_assert(WS_QKV + (size_t)NR * PQ * 2 <= WS_GT && WS_Y + (size_t)16 * 9 * 256 * 1024 * 2 <= WS_GT && WS_HID + (size_t)16 * 9 * 256 * 2048 * 2 <= WS_X1 && WS_YS + (size_t)NR * 1024 * 2 <= WS_X1, "ws map");

constexpr int CW_BAR = 4096;

constexpr int RING_BYTES = 131072, LDSCTL_OFF = RING_BYTES, MISC_OFF = LDSCTL_OFF + 320, LDS_BYTES = 147456;

#define GAS __attribute__((address_space(1)))
#define LAS __attribute__((address_space(3)))
typedef unsigned short bf16_t;
typedef unsigned v4u __attribute__((ext_vector_type(4)));
typedef unsigned v2u __attribute__((ext_vector_type(2)));
typedef float f32x4 __attribute__((ext_vector_type(4)));
typedef float f32x2 __attribute__((ext_vector_type(2)));
typedef float f32x16 __attribute__((ext_vector_type(16)));
typedef short bf16x8 __attribute__((ext_vector_type(8)));
typedef short s16x4 __attribute__((ext_vector_type(4)));
typedef __bf16 bf16x2_t __attribute__((ext_vector_type(2)));
#define RLX_AGENT __ATOMIC_RELAXED, __HIP_MEMORY_SCOPE_AGENT
#define LDS_WAIT() asm volatile("s_waitcnt lgkmcnt(0)" ::: "memory")
#define VM_WAIT() asm volatile("s_waitcnt vmcnt(0)" ::: "memory")

__device__ __forceinline__ int opaque_tid() { int t = threadIdx.x; asm volatile("" : "+v"(t)); return t; }
__device__ __forceinline__ int opaque_s(int v) { asm volatile("" : "+s"(v)); return v; }
__device__ __forceinline__ unsigned char* opaque_ptr(unsigned char* p) { asm volatile("" : "+s"(p)); return p; }
__device__ __forceinline__ unsigned cvtpk(float lo, float hi) { f32x2 v = {lo, hi}; bf16x2_t b = __builtin_convertvector(v, bf16x2_t); return __builtin_bit_cast(unsigned, b); }
__device__ __forceinline__ float bflo(unsigned w) { return __uint_as_float(w << 16); }
__device__ __forceinline__ float bfhi(unsigned w) { return __uint_as_float(w & 0xffff0000u); }
__device__ __forceinline__ float bf2f(bf16_t h) { return __uint_as_float((unsigned)h << 16); }
__device__ __forceinline__ bf16_t f2bf(float f) { return (bf16_t)(cvtpk(f, 0.f) & 0xffffu); }
__device__ __forceinline__ float sigmoidf_(float x) { return __builtin_amdgcn_rcpf(1.0f + __builtin_amdgcn_exp2f(-x * LOG2E)); }
__device__ __forceinline__ float siluf_(float x) { return x * sigmoidf_(x); }
__device__ __forceinline__ float gelu_tanh(float x) { const float z = 0.7978845608028654f * (x + 0.044715f * x * x * x); return x * __builtin_amdgcn_rcpf(1.0f + __builtin_amdgcn_exp2f(-2.0f * LOG2E * z)); }
template <int CTRL> __device__ __forceinline__ float dpp_f(float v) { return __builtin_bit_cast(float, __builtin_amdgcn_update_dpp(0, __builtin_bit_cast(int, v), CTRL, 0xf, 0xf, true)); }
__device__ __forceinline__ float row16_sum(float v) { v += dpp_f<0xB1>(v); v += dpp_f<0x4E>(v); v += dpp_f<0x141>(v); v += dpp_f<0x140>(v); return v; }
__device__ __forceinline__ float xor16_sum(float v) { auto rr = __builtin_amdgcn_permlane16_swap(__float_as_uint(v), __float_as_uint(v), false, false); return __uint_as_float(rr[0]) + __uint_as_float(rr[1]); }
__device__ __forceinline__ float xor32_sum(float v) { auto rr = __builtin_amdgcn_permlane32_swap(__float_as_uint(v), __float_as_uint(v), false, false); return __uint_as_float(rr[0]) + __uint_as_float(rr[1]); }
__device__ __forceinline__ float half32_sum(float v) { return xor16_sum(row16_sum(v)); }
__device__ __forceinline__ float wave_sum(float v) { return xor32_sum(xor16_sum(row16_sum(v))); }
__device__ __forceinline__ float wave_max(float v) { v = fmaxf(v, dpp_f<0xB1>(v)); v = fmaxf(v, dpp_f<0x4E>(v)); v = fmaxf(v, dpp_f<0x141>(v)); v = fmaxf(v, dpp_f<0x140>(v));
    { auto rr = __builtin_amdgcn_permlane16_swap(__float_as_uint(v), __float_as_uint(v), false, false); v = fmaxf(__uint_as_float(rr[0]), __uint_as_float(rr[1])); }
    { auto rr = __builtin_amdgcn_permlane32_swap(__float_as_uint(v), __float_as_uint(v), false, false); v = fmaxf(__uint_as_float(rr[0]), __uint_as_float(rr[1])); } return v; }
__device__ __forceinline__ unsigned pk8(float a, float b, float c, float d) { unsigned w = 0u; w = __builtin_amdgcn_cvt_pk_fp8_f32(a, b, w, false); w = __builtin_amdgcn_cvt_pk_fp8_f32(c, d, w, true); return w; }
__device__ __forceinline__ void st8(bf16_t* p, const float* v) { v4u w; w.x = cvtpk(v[0], v[1]); w.y = cvtpk(v[2], v[3]); w.z = cvtpk(v[4], v[5]); w.w = cvtpk(v[6], v[7]); *(v4u*)p = w; }

__device__ const float INV16R[16] = {0.15915494309189535f, 0.08949940160889101f, 0.050329212104487035f, 0.0283021958306234f, 0.015915494309189534f, 0.008949940160889102f, 0.005032921210448704f, 0.00283021958306234f,
                                     0.0015915494309189536f, 0.0008949940160889102f, 0.0005032921210448703f, 0.00028302195830623395f, 0.00015915494309189535f, 8.949940160889102e-05f, 5.0329212104487035e-05f, 2.8302195830623396e-05f};
__device__ const float INV8R[8] = {0.15915494309189535f, 0.050329212104487035f, 0.015915494309189534f, 0.005032921210448704f, 0.0015915494309189536f, 0.0005032921210448703f, 0.00015915494309189535f, 5.0329212104487035e-05f};
__device__ __forceinline__ void sincos_rev(float rev, float& s, float& c) { const float f = __builtin_amdgcn_fractf(rev); s = __builtin_amdgcn_sinf(f); c = __builtin_amdgcn_cosf(f); }

namespace pg8 {
#define PG8_LAS __attribute__((address_space(3)))
constexpr int BM = 256, BK = 64, HALF = 128, HTB = HALF * BK * 2, STAGE_BYTES = 8 * HTB, NXCD = 8, WGM = 8;
__host__ __device__ __forceinline__ int lds_byte(int r, int c) { const int st = (r >> 4) * 2 + (c >> 5), rr = r & 15, cc = c & 31, ob = rr * 64 + cc * 2; return st * 1024 + (ob ^ (((ob >> 9) & 1) << 5)); }
__host__ __device__ __forceinline__ void stage_rc(int b, int& R, int& C) { const int st = b / 1024, sb = b % 1024, swz = sb ^ (((sb >> 9) & 1) << 5); R = (st >> 1) * 16 + swz / 64; C = (st & 1) * 32 + (swz % 64) / 2; }
__host__ __device__ __forceinline__ int perm32(int rho) { const int n = rho >> 4, i = rho & 15; return 8 * (i >> 2) + 4 * n + (i & 3); }

struct Unit { int pm, pn; const char* a; const char* b; };
__device__ __forceinline__ const char* uptr(const char* p) { const unsigned long long v = (unsigned long long)p; const unsigned lo = __builtin_amdgcn_readfirstlane((unsigned)v), hi = __builtin_amdgcn_readfirstlane((unsigned)(v >> 32)); return (const char*)(((unsigned long long)hi << 32) | lo); }
__device__ __forceinline__ void uunit(Unit& u) { u.pm = __builtin_amdgcn_readfirstlane(u.pm); u.pn = __builtin_amdgcn_readfirstlane(u.pn); u.a = uptr(u.a); u.b = uptr(u.b); }

typedef int v8i __attribute__((ext_vector_type(8)));
__device__ __forceinline__ void glds16s(const char* sbase, unsigned voff, unsigned lds_dst) { unsigned keep;
    asm volatile("s_mov_b32 %0, m0\n\ts_mov_b32 m0, %3\n\ts_nop 0\n\tglobal_load_lds_dwordx4 %1, %2\n\ts_mov_b32 m0, %0" : "=&s"(keep) : "v"(voff), "s"(sbase), "s"(lds_dst) : "memory"); }
__device__ __forceinline__ void rect_order(int L, int nM, int nN, int& im, int& in) {
    const int nwg = nM * nN; int wgid = L; { const int q = nwg / NXCD, r = nwg % NXCD, xcd = wgid % NXCD, off = wgid / NXCD; wgid = (xcd < r ? xcd * (q + 1) : r * (q + 1) + (xcd - r) * q) + off; }
    const int nig = WGM * nN, gid = wgid / nig, fm = gid * WGM, gsz = (nM - fm) < WGM ? (nM - fm) : WGM;
    im = fm + ((wgid % nig) % gsz); in = (wgid % nig) / gsz;
}

template <class Epi, class Sched>
__device__ __forceinline__ void gemm_phase(PG8_LAS unsigned char* lds, const int K, const int lda, const int ldb, const Sched& S, const Epi& E) {
    const int tid = opaque_tid(), wid = __builtin_amdgcn_readfirstlane(tid >> 6), lane = tid & 63, wr = wid >> 2, wc = wid & 3, fr = lane & 15, fq = lane >> 4;
    const int nt = K / BK;
    unsigned voffA[2], voffB[2];
#pragma unroll
    for (int i = 0; i < 2; ++i) { int R, C; stage_rc(tid * 16 + i * 8192, R, C); const int Rb = Epi::PERM ? ((R & ~31) + perm32(R & 31)) : R;
        voffA[i] = (unsigned)(R * lda + C) * 2u; voffB[i] = (unsigned)(Rb * ldb + C) * 2u; }
    const size_t kstep = (size_t)(BK * 2);
    const size_t hA = (size_t)HALF * lda * 2, hB = (size_t)HALF * ldb * 2;
    const unsigned ldsw = (unsigned)wid * 1024u, ldsbase = (unsigned)(size_t)lds;
    const int aoff = lds_byte(wr * 64 + fr, fq * 8), boff = lds_byte(wc * 32 + fr, fq * 8);
#define PG8_SA(b, h) (((b) * 2 + (h)) * HTB)
#define PG8_SB(b, h) ((4 + (b) * 2 + (h)) * HTB)
#define PG8_STAGE(bufoff, gbase, voff) do { _Pragma("unroll") for (int _i = 0; _i < 2; ++_i) \
        glds16s(uptr((const char*)(gbase)), (voff)[_i], (unsigned)__builtin_amdgcn_readfirstlane(ldsbase + (unsigned)(bufoff) + ldsw + _i * 8192u)); } while (0)
#define PG8_LDA(dst, b, h) do { _Pragma("unroll") for (int m = 0; m < 4; ++m) _Pragma("unroll") for (int k = 0; k < 2; ++k) dst[m][k] = *(const PG8_LAS bf16x8*)(lds + PG8_SA(b, h) + aoff + m * 2048 + k * 1024); } while (0)
#define PG8_LDB(dst, b, h) do { _Pragma("unroll") for (int n = 0; n < 2; ++n) _Pragma("unroll") for (int k = 0; k < 2; ++k) dst[n][k] = *(const PG8_LAS bf16x8*)(lds + PG8_SB(b, h) + boff + n * 2048 + k * 1024); } while (0)
#define PG8_MMA(ai, bj, At, Bt) do { __builtin_amdgcn_s_setprio(1); _Pragma("unroll") for (int m = 0; m < 4; ++m) _Pragma("unroll") for (int n = 0; n < 2; ++n) _Pragma("unroll") for (int k = 0; k < 2; ++k) \
        acc[ai][bj][m][n] = __builtin_amdgcn_mfma_f32_16x16x32_bf16(Bt[n][k], At[m][k], acc[ai][bj][m][n], 0, 0, 0); __builtin_amdgcn_s_setprio(0); } while (0)
#define PG8_WAIT_V(n) asm volatile("s_waitcnt vmcnt(" #n ")" ::: "memory")
#define PG8_WAIT_L(n) asm volatile("s_waitcnt lgkmcnt(" #n ")" ::: "memory")
#define PG8_BAR __builtin_amdgcn_s_barrier()
#define PG8_SCHED __builtin_amdgcn_sched_barrier(0)
    Unit cur, nxt; int ui = 0;
    if (!S.next(0, cur)) return;
    uunit(cur);
    f32x4 acc[2][2][4][2];
#pragma unroll
    for (int a = 0; a < 2; ++a)
#pragma unroll
        for (int b = 0; b < 2; ++b)
#pragma unroll
            for (int m = 0; m < 4; ++m)
#pragma unroll
                for (int n = 0; n < 2; ++n) acc[a][b][m][n] = (f32x4){0.f, 0.f, 0.f, 0.f};
    bf16x8 At[4][2], B0[2][2], B1[2][2];
    const char* cA = cur.a; const char* cB = cur.b;
    PG8_STAGE(PG8_SB(0, 0), cB, voffB); PG8_STAGE(PG8_SB(0, 1), cB + hB, voffB); PG8_STAGE(PG8_SA(0, 0), cA, voffA); PG8_STAGE(PG8_SA(0, 1), cA + hA, voffA);
    if (wr == 1) PG8_BAR;
    PG8_WAIT_V(2); PG8_BAR;
    PG8_STAGE(PG8_SB(1, 0), cB + kstep, voffB); PG8_STAGE(PG8_SA(1, 0), cA + kstep, voffA); PG8_STAGE(PG8_SB(1, 1), cB + hB + kstep, voffB);
    PG8_WAIT_V(6); PG8_BAR;
    for (;;) {
        const bool has_next = S.next(ui + 1, nxt); if (has_next) uunit(nxt);
        const char* nA = has_next ? nxt.a : cA; const char* nB = has_next ? nxt.b : cB;
        for (int t = 0; t < nt; t += 2) {
            const bool last = (t == nt - 2);
            const char* a1 = cA + (size_t)(t + 1) * kstep;
            const char* a2 = last ? nA : cA + (size_t)(t + 2) * kstep; const char* b2 = last ? nB : cB + (size_t)(t + 2) * kstep;
            const char* a3 = a2 + kstep; const char* b3 = b2 + kstep;
            PG8_LDB(B0, 0, 0); PG8_LDB(B1, 0, 1); PG8_SCHED; PG8_LDA(At, 0, 0); PG8_STAGE(PG8_SA(1, 1), a1 + hA, voffA);
            PG8_WAIT_V(8); PG8_WAIT_L(0); PG8_BAR; PG8_MMA(0, 0, At, B0); PG8_MMA(0, 1, At, B1); PG8_BAR; PG8_SCHED;
            PG8_LDA(At, 0, 1); PG8_STAGE(PG8_SB(0, 0), b2, voffB); PG8_STAGE(PG8_SB(0, 1), b2 + hB, voffB); PG8_STAGE(PG8_SA(0, 0), a2, voffA);
            PG8_WAIT_V(8); PG8_WAIT_L(0); PG8_BAR; PG8_MMA(1, 0, At, B0); PG8_MMA(1, 1, At, B1); PG8_BAR; PG8_SCHED;
            PG8_LDB(B0, 1, 0); PG8_LDB(B1, 1, 1); PG8_SCHED; PG8_LDA(At, 1, 0); PG8_STAGE(PG8_SA(0, 1), a2 + hA, voffA);
            PG8_WAIT_V(8); PG8_WAIT_L(0); PG8_BAR; PG8_MMA(0, 0, At, B0); PG8_MMA(0, 1, At, B1); PG8_BAR; PG8_SCHED;
            PG8_LDA(At, 1, 1); PG8_STAGE(PG8_SB(1, 0), b3, voffB); PG8_STAGE(PG8_SB(1, 1), b3 + hB, voffB); PG8_STAGE(PG8_SA(1, 0), a3, voffA);
            PG8_WAIT_V(8); PG8_WAIT_L(0); PG8_BAR; PG8_MMA(1, 0, At, B0); PG8_MMA(1, 1, At, B1); PG8_BAR; PG8_SCHED;
        }
        if (wr == 0) PG8_BAR;
        { const int t2 = opaque_tid(), l2 = t2 & 63; E(acc, cur, wr, wc, l2 & 15, l2 >> 4); }
        if (!has_next) break;
        if (!Epi::keep_acc(cur)) {
#pragma unroll
        for (int a = 0; a < 2; ++a)
#pragma unroll
            for (int b = 0; b < 2; ++b)
#pragma unroll
                for (int m = 0; m < 4; ++m)
#pragma unroll
                    for (int n = 0; n < 2; ++n) acc[a][b][m][n] = (f32x4){0.f, 0.f, 0.f, 0.f};
        }
        cur = nxt; cA = nA; cB = nB; ++ui;
        if (wr == 1) PG8_BAR;
    }
    PG8_WAIT_V(0);
    PG8_BAR;
#undef PG8_SA
#undef PG8_SB
#undef PG8_STAGE
#undef PG8_LDA
#undef PG8_LDB
#undef PG8_MMA
#undef PG8_WAIT_V
#undef PG8_WAIT_L
#undef PG8_BAR
#undef PG8_SCHED
}
template <class Epi, class Sched>
__device__ __forceinline__ void gemm8_phase(PG8_LAS unsigned char* lds, const int K, const int lda, const int ldb, const Sched& S, const Epi& E) {
    const int tid = opaque_tid(), wid = __builtin_amdgcn_readfirstlane(tid >> 6), lane = tid & 63, wr = wid >> 2, wc = wid & 3, fr = lane & 15, fq = lane >> 4;
    const int nt = opaque_s(K / BK);
    unsigned voffA[2], voffB[2];
#pragma unroll
    for (int i = 0; i < 2; ++i) { int R, C; stage_rc(tid * 16 + i * 8192, R, C); const int Rb = Epi::PERM ? ((R & ~31) + perm32(R & 31)) : R;
        voffA[i] = (unsigned)(R * lda + C) * 2u; voffB[i] = (unsigned)(Rb * ldb + C) * 2u; }
    const size_t kstep = (size_t)(BK * 2);
    const size_t hA = (size_t)HALF * lda * 2, hB = (size_t)HALF * ldb * 2;
    const unsigned ldsw = (unsigned)wid * 1024u, ldsbase = (unsigned)(size_t)lds;
    const int fcol = (fq >> 1) * 32 + (fq & 1) * 16;
    const int aoff = lds_byte(wr * 64 + fr, fcol), boff = lds_byte(wc * 32 + fr, fcol);
#define PG8_SA(b, h) (((b) * 2 + (h)) * HTB)
#define PG8_SB(b, h) ((4 + (b) * 2 + (h)) * HTB)
#define PG8_STAGE(bufoff, gbase, voff) do { _Pragma("unroll") for (int _i = 0; _i < 2; ++_i) \
        glds16s(uptr((const char*)(gbase)), (voff)[_i], (unsigned)__builtin_amdgcn_readfirstlane(ldsbase + (unsigned)(bufoff) + ldsw + _i * 8192u)); } while (0)
#define PG8_LDA(dst, b, h) do { _Pragma("unroll") for (int m = 0; m < 4; ++m) { const v4u lo_ = *(const PG8_LAS v4u*)(lds + PG8_SA(b, h) + aoff + m * 2048), hi_ = *(const PG8_LAS v4u*)(lds + PG8_SA(b, h) + aoff + m * 2048 + 16); dst[m] = (v8i){(int)lo_.x, (int)lo_.y, (int)lo_.z, (int)lo_.w, (int)hi_.x, (int)hi_.y, (int)hi_.z, (int)hi_.w}; } } while (0)
#define PG8_LDB(dst, b, h) do { _Pragma("unroll") for (int n = 0; n < 2; ++n) { const v4u lo_ = *(const PG8_LAS v4u*)(lds + PG8_SB(b, h) + boff + n * 2048), hi_ = *(const PG8_LAS v4u*)(lds + PG8_SB(b, h) + boff + n * 2048 + 16); dst[n] = (v8i){(int)lo_.x, (int)lo_.y, (int)lo_.z, (int)lo_.w, (int)hi_.x, (int)hi_.y, (int)hi_.z, (int)hi_.w}; } } while (0)
#define PG8_MMA(ai, bj, At, Bt) do { __builtin_amdgcn_s_setprio(1); _Pragma("unroll") for (int m = 0; m < 4; ++m) _Pragma("unroll") for (int n = 0; n < 2; ++n) \
        acc[ai][bj][m][n] = __builtin_amdgcn_mfma_scale_f32_16x16x128_f8f6f4(Bt[n], At[m], acc[ai][bj][m][n], 0, 0, 0, 0, 0, 0);     __builtin_amdgcn_s_setprio(0); } while (0)
#define PG8_WAIT_V(n) asm volatile("s_waitcnt vmcnt(" #n ")" ::: "memory")
#define PG8_WAIT_L(n) asm volatile("s_waitcnt lgkmcnt(" #n ")" ::: "memory")
#define PG8_BAR __builtin_amdgcn_s_barrier()
#define PG8_SCHED __builtin_amdgcn_sched_barrier(0)
    Unit cur, nxt; int ui = 0;
    if (!S.next(0, cur)) return;
    uunit(cur);
    f32x4 acc[2][2][4][2];
#pragma unroll
    for (int a = 0; a < 2; ++a)
#pragma unroll
        for (int b = 0; b < 2; ++b)
#pragma unroll
            for (int m = 0; m < 4; ++m)
#pragma unroll
                for (int n = 0; n < 2; ++n) acc[a][b][m][n] = (f32x4){0.f, 0.f, 0.f, 0.f};
    v8i At[4], B0[2], B1[2];
    const char* cA = cur.a; const char* cB = cur.b;
    PG8_STAGE(PG8_SB(0, 0), cB, voffB); PG8_STAGE(PG8_SB(0, 1), cB + hB, voffB); PG8_STAGE(PG8_SA(0, 0), cA, voffA); PG8_STAGE(PG8_SA(0, 1), cA + hA, voffA);
    if (wr == 1) PG8_BAR;
    PG8_WAIT_V(2); PG8_BAR;
    PG8_STAGE(PG8_SB(1, 0), cB + kstep, voffB); PG8_STAGE(PG8_SA(1, 0), cA + kstep, voffA); PG8_STAGE(PG8_SB(1, 1), cB + hB + kstep, voffB);
    PG8_WAIT_V(6); PG8_BAR;
    for (;;) {
        const bool has_next = S.next(ui + 1, nxt); if (has_next) uunit(nxt);
        const char* nA = has_next ? nxt.a : cA; const char* nB = has_next ? nxt.b : cB;
#pragma nounroll
        for (int t = 0; t < nt; t += 2) {
            const bool last = (t == nt - 2);
            const char* a1 = cA + (size_t)(t + 1) * kstep;
            const char* a2 = last ? nA : cA + (size_t)(t + 2) * kstep; const char* b2 = last ? nB : cB + (size_t)(t + 2) * kstep;
            const char* a3 = a2 + kstep; const char* b3 = b2 + kstep;
            PG8_LDB(B0, 0, 0); PG8_LDB(B1, 0, 1); PG8_SCHED; PG8_LDA(At, 0, 0); PG8_STAGE(PG8_SA(1, 1), a1 + hA, voffA);
            PG8_WAIT_V(8); PG8_WAIT_L(0); PG8_BAR; PG8_MMA(0, 0, At, B0); PG8_MMA(0, 1, At, B1); PG8_BAR; PG8_SCHED;
            PG8_LDA(At, 0, 1); PG8_STAGE(PG8_SB(0, 0), b2, voffB); PG8_STAGE(PG8_SB(0, 1), b2 + hB, voffB); PG8_STAGE(PG8_SA(0, 0), a2, voffA);
            PG8_WAIT_V(8); PG8_WAIT_L(0); PG8_BAR; PG8_MMA(1, 0, At, B0); PG8_MMA(1, 1, At, B1); PG8_BAR; PG8_SCHED;
            PG8_LDB(B0, 1, 0); PG8_LDB(B1, 1, 1); PG8_SCHED; PG8_LDA(At, 1, 0); PG8_STAGE(PG8_SA(0, 1), a2 + hA, voffA);
            PG8_WAIT_V(8); PG8_WAIT_L(0); PG8_BAR; PG8_MMA(0, 0, At, B0); PG8_MMA(0, 1, At, B1); PG8_BAR; PG8_SCHED;
            PG8_LDA(At, 1, 1); PG8_STAGE(PG8_SB(1, 0), b3, voffB); PG8_STAGE(PG8_SB(1, 1), b3 + hB, voffB); PG8_STAGE(PG8_SA(1, 0), a3, voffA);
            PG8_WAIT_V(8); PG8_WAIT_L(0); PG8_BAR; PG8_MMA(1, 0, At, B0); PG8_MMA(1, 1, At, B1); PG8_BAR; PG8_SCHED;
        }
        if (wr == 0) PG8_BAR;
        { const int t2 = opaque_tid(), l2 = t2 & 63; E(acc, cur, wr, wc, l2 & 15, l2 >> 4); }
        if (!has_next) break;
#pragma unroll
        for (int a = 0; a < 2; ++a)
#pragma unroll
            for (int b = 0; b < 2; ++b)
#pragma unroll
                for (int m = 0; m < 4; ++m)
#pragma unroll
                    for (int n = 0; n < 2; ++n) acc[a][b][m][n] = (f32x4){0.f, 0.f, 0.f, 0.f};
        cur = nxt; cA = nA; cB = nB; ++ui;
        if (wr == 1) PG8_BAR;
    }
    PG8_WAIT_V(0);
    PG8_BAR;
#undef PG8_SA
#undef PG8_SB
#undef PG8_STAGE
#undef PG8_LDA
#undef PG8_LDB
#undef PG8_MMA
#undef PG8_WAIT_V
#undef PG8_WAIT_L
#undef PG8_BAR
#undef PG8_SCHED
}
}

constexpr float W8S = 32.0f, W8I = 1.0f / 32.0f;
struct ModPtrs { const float* mod; };

struct EpiInProj {
    static constexpr bool PERM = true;
    static __device__ __forceinline__ bool keep_acc(const pg8::Unit&) { return false; }
    bf16_t *QKV, *GT;
    const float *q_gain, *k_gain, *gate_b; float* KNB;
    __device__ __forceinline__ void operator()(const f32x4 (&acc)[2][2][4][2], const pg8::Unit& u, int wr, int wc, int fr, int fq) const {
        const int pn = u.pn, pm = u.pm, jt = pm % TPB; const bool isctx = (jt == 0); const int t0 = (jt - 1) * 256;
        const int cb = 64 * wc + 8 * fq;
        const int rit0 = 64 * wr + fr;
        bf16_t* qrow = QKV + ((size_t)pm * 256 + rit0) * PQ;
#define ROWLOOP _Pragma("unroll") for (int ai = 0; ai < 2; ++ai) _Pragma("unroll") for (int m = 0; m < 4; ++m)
#define ROWVARS const int rit = 128 * ai + 16 * m + rit0; bf16_t* orow = qrow + (size_t)(128 * ai + 16 * m) * PQ; \
        float v[2][8]; _Pragma("unroll") for (int bj = 0; bj < 2; ++bj) _Pragma("unroll") for (int n = 0; n < 2; ++n) _Pragma("unroll") for (int j = 0; j < 4; ++j) v[bj][4 * n + j] = acc[ai][bj][m][n][j];
#define ROWEND __builtin_amdgcn_sched_barrier(0);
        if (pn == 0 || pn == 21 || pn == 22 || pn == 24) {
            const int oc = (pn == 0 ? C_QA : pn == 21 ? C_KA : pn == 22 ? C_VA : C_VB) + cb; const float sc = pn == 0 ? C2A : 1.0f;
            float kn2a = 0.f;
            ROWLOOP { ROWVARS
                if (pn == 21) { float ss = 0.f;
#pragma unroll
                    for (int bj = 0; bj < 2; ++bj)
#pragma unroll
                        for (int j = 0; j < 8; ++j) ss += v[bj][j] * v[bj][j];
                    kn2a = fmaxf(kn2a, xor32_sum(xor16_sum(ss))); }
#pragma unroll
                for (int bj = 0; bj < 2; ++bj) {
#pragma unroll
                    for (int j = 0; j < 8; ++j) v[bj][j] *= sc;
                    st8(orow + oc + 32 * bj, v[bj]); }
                ROWEND }
            if (pn == 21) { float mxv = kn2a; mxv = fmaxf(mxv, dpp_f<0xB1>(mxv)); mxv = fmaxf(mxv, dpp_f<0x4E>(mxv)); mxv = fmaxf(mxv, dpp_f<0x141>(mxv)); mxv = fmaxf(mxv, dpp_f<0x140>(mxv));
                if ((fr | fq) == 0) atomicMax((unsigned*)(KNB + 16 + (pm / TPB) * 4 + wc), __float_as_uint(sqrtf(mxv))); }
        } else if (pn == 3 || pn == 4) {
            const int oc = (pn == 3 ? C_GU : C_GV) + cb;
            ROWLOOP { ROWVARS
#pragma unroll
                for (int bj = 0; bj < 2; ++bj) {
#pragma unroll
                    for (int j = 0; j < 8; ++j) v[bj][j] = gelu_tanh(v[bj][j]);
                    st8(orow + oc + 32 * bj, v[bj]); }
                ROWEND }
        } else if (pn == 1 || pn == 23) {
            const int oc = (pn == 1 ? C_QB : C_KB) + 128 * wc + 8 * fq; const float sc = pn == 1 ? C2B : 1.0f;
            const f32x4 inv = *(const f32x4*)(INV8R + 4 * (fq & 1));
            const float zz[8] = {0.f, 0.f, 0.f, 0.f, 0.f, 0.f, 0.f, 0.f};
            float kn2[2] = {0.f, 0.f};
            ROWLOOP { ROWVARS
                if (pn == 23) {
#pragma unroll
                    for (int bj = 0; bj < 2; ++bj) { float ss = 0.f;
#pragma unroll
                        for (int j = 0; j < 8; ++j) ss += v[bj][j] * v[bj][j];
                        kn2[bj] = fmaxf(kn2[bj], xor32_sum(xor16_sum(ss))); } }
                const int t = t0 + rit; const float pos = (float)((fq < 2) ? (t >> 6) : (t & 63));
                float sn[4], cs[4];
#pragma unroll
                for (int p = 0; p < 4; ++p) { if (isctx) { sn[p] = 0.f; cs[p] = 1.f; } else sincos_rev(pos * inv[p], sn[p], cs[p]); }
#pragma unroll
                for (int bj = 0; bj < 2; ++bj) {
                    float o[8];
#pragma unroll
                    for (int p = 0; p < 4; ++p) { const float x0 = v[bj][2 * p], x1 = v[bj][2 * p + 1]; o[2 * p] = (x0 * cs[p] - x1 * sn[p]) * sc; o[2 * p + 1] = (x0 * sn[p] + x1 * cs[p]) * sc; }
                    st8(orow + oc + 64 * bj, o); st8(orow + oc + 64 * bj + 32, zz); }
                ROWEND }
            if (pn == 23) {
#pragma unroll
                for (int bj = 0; bj < 2; ++bj) { float mxv = kn2[bj]; mxv = fmaxf(mxv, dpp_f<0xB1>(mxv)); mxv = fmaxf(mxv, dpp_f<0x4E>(mxv)); mxv = fmaxf(mxv, dpp_f<0x141>(mxv)); mxv = fmaxf(mxv, dpp_f<0x140>(mxv));
                    if ((fr | fq) == 0) atomicMax((unsigned*)(KNB + (pm / TPB) * 8 + 2 * wc + bj), __float_as_uint(sqrtf(mxv))); } }
        } else {
            if (pn == 25 && wc >= 2) {
                const int oc = C_VD + (wc - 2) * 64 + 8 * fq;
                ROWLOOP { ROWVARS
#pragma unroll
                    for (int bj = 0; bj < 2; ++bj) st8(orow + oc + 32 * bj, v[bj]);
                    (void)rit; ROWEND }
            } else {
                const int oc = (pn == 2 ? C_QD : C_KD) + cb; const float sc = pn == 2 ? C2A : 1.0f; const float* gain = pn == 2 ? q_gain : k_gain;
                const f32x4 inv = *(const f32x4*)(INV16R + 4 * fq);
                f32x4 gn[2][2];
#pragma unroll
                for (int bj = 0; bj < 2; ++bj)
#pragma unroll
                    for (int n = 0; n < 2; ++n) gn[bj][n] = *(const f32x4*)(gain + 32 * bj + 8 * fq + 4 * n);
                ROWLOOP { ROWVARS
                    float ss = 0.f;
#pragma unroll
                    for (int bj = 0; bj < 2; ++bj)
#pragma unroll
                        for (int j = 0; j < 8; ++j) ss += v[bj][j] * v[bj][j];
                    ss = xor32_sum(xor16_sum(ss));
                    const float rstd = __builtin_amdgcn_rsqf(ss * (1.0f / 64.0f) + EPS);
                    const int t = t0 + rit;
#pragma unroll
                    for (int bj = 0; bj < 2; ++bj) {
                        const float pos = (float)(bj == 0 ? (t >> 6) : (t & 63));
                        float o[8];
#pragma unroll
                        for (int p = 0; p < 4; ++p) {
                            float sn, cs; if (isctx) { sn = 0.f; cs = 1.f; } else sincos_rev(pos * inv[p], sn, cs);
                            const float x0 = v[bj][2 * p] * rstd * gn[bj][(2 * p) >> 2][(2 * p) & 3], x1 = v[bj][2 * p + 1] * rstd * gn[bj][(2 * p + 1) >> 2][(2 * p + 1) & 3];
                            o[2 * p] = (x0 * cs - x1 * sn) * sc; o[2 * p + 1] = (x0 * sn + x1 * cs) * sc; }
                        st8(orow + oc + 32 * bj, o); }
                    ROWEND }
            }
        }
#undef ROWLOOP
#undef ROWVARS
#undef ROWEND
    }
};

__device__ __forceinline__ unsigned pk_u8x4(float a, float b, float c, float d) { unsigned w = 0u;
    w = __builtin_amdgcn_cvt_pk_u8_f32(__builtin_rintf(a * 255.0f), 0u, w); w = __builtin_amdgcn_cvt_pk_u8_f32(__builtin_rintf(b * 255.0f), 1u, w);
    w = __builtin_amdgcn_cvt_pk_u8_f32(__builtin_rintf(c * 255.0f), 2u, w); w = __builtin_amdgcn_cvt_pk_u8_f32(__builtin_rintf(d * 255.0f), 3u, w); return w; }
__device__ __forceinline__ float u8f(unsigned w, int i) { return (float)((w >> (8 * i)) & 0xffu); }
struct EpiGates {
    static constexpr bool PERM = true;
    unsigned char* GT; const float* gate_b;
    __device__ __forceinline__ void operator()(const f32x4 (&acc)[2][2][4][2], const pg8::Unit& u, int wr, int wc, int fr, int fq) const {
        const int col0 = u.pn * 256 + wc * 32 + 8 * fq;
        f32x4 gb[2][2];
#pragma unroll
        for (int bj = 0; bj < 2; ++bj)
#pragma unroll
            for (int n = 0; n < 2; ++n) gb[bj][n] = *(const f32x4*)(gate_b + col0 + bj * 128 + 4 * n) * (-LOG2E);
#pragma unroll
        for (int ai = 0; ai < 2; ++ai)
#pragma unroll
            for (int m = 0; m < 4; ++m) { unsigned char* rowp = GT + ((size_t)u.pm * 256 + ai * 128 + wr * 64 + m * 16 + fr) * 4096 + col0;
#pragma unroll
                for (int bj = 0; bj < 2; ++bj) { unsigned o[8];
#pragma unroll
                    for (int n = 0; n < 2; ++n)
#pragma unroll
                        for (int j = 0; j < 4; j += 2) { const f32x2 a2 = (f32x2){acc[ai][bj][m][n][j], acc[ai][bj][m][n][j + 1]}, c2 = (f32x2){gb[bj][n][j], gb[bj][n][j + 1]};
                            const f32x2 t2 = __builtin_elementwise_fma(a2, (f32x2){-W8I * LOG2E, -W8I * LOG2E}, c2);
                            const f32x2 e2 = (f32x2){__builtin_amdgcn_exp2f(t2.x), __builtin_amdgcn_exp2f(t2.y)};
                            const f32x2 d2 = __builtin_elementwise_fma(e2, (f32x2){1.0f / 255.0f, 1.0f / 255.0f}, (f32x2){1.0f / 255.0f, 1.0f / 255.0f});
                            const f32x2 v2 = (f32x2){__builtin_amdgcn_rcpf(d2.x), __builtin_amdgcn_rcpf(d2.y)} + (f32x2){8388608.0f, 8388608.0f};
                            o[4 * n + j] = __float_as_uint(v2.x); o[4 * n + j + 1] = __float_as_uint(v2.y); }
                    v2u w; w.x = __builtin_amdgcn_perm(o[1], o[0], 0x0c0c0400u) | __builtin_amdgcn_perm(o[3], o[2], 0x04000c0cu); w.y = __builtin_amdgcn_perm(o[5], o[4], 0x0c0c0400u) | __builtin_amdgcn_perm(o[7], o[6], 0x04000c0cu);
                    *(v2u*)(rowp + bj * 128) = w; } }
    }
};
struct EpiGateAcc {
    static constexpr bool PERM = true;
    const unsigned char* GT; bf16_t* MRG; bf16_t* GPC;
    static __device__ __forceinline__ bool keep_acc(const pg8::Unit& u) { return (u.pn & 3) != 3 && (u.pm % TPB) != 0; }
    __device__ __forceinline__ void operator()(f32x4 (&acc)[2][2][4][2], const pg8::Unit& u, int wr, int wc, int fr, int fq) const {
        const int dt = u.pn >> 2, n = u.pn & 3; const int col0 = dt * 256 + wc * 32 + 8 * fq;
        const bool isctx = (u.pm % TPB) == 0;
        const size_t row0 = (size_t)u.pm * 256 + wr * 64 + fr;
        const unsigned char* gp0 = GT + row0 * 4096 + n * 1024 + col0;
        constexpr float GMIN = 8.673617379884035e-19f;
#define GA_OFF(grp) ((size_t)(((grp) >> 3) * 128 + (((grp) >> 1) & 3) * 16))
        if (!isctx && n < 3) {
            v2u ga[16], gb[16];
#pragma unroll
            for (int grp = 0; grp < 16; ++grp) { const int bj = grp & 1; ga[grp] = *(const v2u*)(gp0 + GA_OFF(grp) * 4096 + bj * 128); gb[grp] = *(const v2u*)(gp0 + 1024 + GA_OFF(grp) * 4096 + bj * 128); }
            __builtin_amdgcn_sched_barrier(0);
#pragma unroll
            for (int grp = 0; grp < 16; ++grp) { const int ai = grp >> 3, m = (grp >> 1) & 3, bj = grp & 1; const v2u g0 = ga[grp], g1 = gb[grp];
                float r[8];
#define GA_R(i, A, B) r[i] = fmaxf(A, GMIN) * __builtin_amdgcn_rcpf(fmaxf(B, GMIN))
                GA_R(0, u8f(g0.x, 0), u8f(g1.x, 0)); GA_R(1, u8f(g0.x, 1), u8f(g1.x, 1)); GA_R(2, u8f(g0.x, 2), u8f(g1.x, 2)); GA_R(3, u8f(g0.x, 3), u8f(g1.x, 3));
                GA_R(4, u8f(g0.y, 0), u8f(g1.y, 0)); GA_R(5, u8f(g0.y, 1), u8f(g1.y, 1)); GA_R(6, u8f(g0.y, 2), u8f(g1.y, 2)); GA_R(7, u8f(g0.y, 3), u8f(g1.y, 3));
#undef GA_R
#pragma unroll
                for (int j = 0; j < 4; ++j) { acc[ai][bj][m][0][j] *= r[j]; acc[ai][bj][m][1][j] *= r[4 + j]; } }
            __builtin_amdgcn_sched_barrier(0);
        } else {
            bf16_t* mp0 = isctx ? GPC + ((size_t)n * 512 + (u.pm / TPB) * 256 + wr * 64 + fr) * 1024 + col0 : MRG + row0 * 1024 + col0;
            const float lo = isctx ? 0.f : GMIN; constexpr float I255 = 1.0f / 255.0f;
            v2u ga[16];
#pragma unroll
            for (int grp = 0; grp < 16; ++grp) { const int bj = grp & 1; ga[grp] = *(const v2u*)(gp0 + GA_OFF(grp) * 4096 + bj * 128); }
            __builtin_amdgcn_sched_barrier(0);
#pragma unroll
            for (int grp = 0; grp < 16; ++grp) { const int ai = grp >> 3, m = (grp >> 1) & 3, bj = grp & 1; const v2u g = ga[grp]; const f32x4 a0 = acc[ai][bj][m][0], a1 = acc[ai][bj][m][1];
                v4u w; w.x = cvtpk(a0[0] * (fmaxf(u8f(g.x, 0), lo) * I255), a0[1] * (fmaxf(u8f(g.x, 1), lo) * I255)); w.y = cvtpk(a0[2] * (fmaxf(u8f(g.x, 2), lo) * I255), a0[3] * (fmaxf(u8f(g.x, 3), lo) * I255));
                w.z = cvtpk(a1[0] * (fmaxf(u8f(g.y, 0), lo) * I255), a1[1] * (fmaxf(u8f(g.y, 1), lo) * I255)); w.w = cvtpk(a1[2] * (fmaxf(u8f(g.y, 2), lo) * I255), a1[3] * (fmaxf(u8f(g.y, 3), lo) * I255));
                *(v4u*)(mp0 + GA_OFF(grp) * 1024 + bj * 128) = w; }
            __builtin_amdgcn_sched_barrier(0);
        }
#undef GA_OFF
    }
};

struct EpiOutRes {
    static constexpr bool PERM = true;
    static __device__ __forceinline__ bool keep_acc(const pg8::Unit&) { return false; }
    const float* x_in; const float* ctx_in; const bf16_t* XR; bf16_t* X1; const float* mod_l; int layer;
    __device__ __forceinline__ void operator()(const f32x4 (&acc)[2][2][4][2], const pg8::Unit& u, int wr, int wc, int fr, int fq) const {
        const int pm = u.pm, b = pm / TPB, jt = pm % TPB; const bool isctx = jt == 0;
        const float* g1 = mod_l + (isctx ? 2 : b) * 6144 + 2048;
        const int col0 = u.pn * 256 + wc * 32 + 8 * fq;
        f32x4 gv[2][2];
#pragma unroll
        for (int bj = 0; bj < 2; ++bj)
#pragma unroll
            for (int n = 0; n < 2; ++n) gv[bj][n] = *(const f32x4*)(g1 + col0 + bj * 128 + n * 4);
        bf16_t* ob = X1 + ((size_t)pm * 256 + wr * 64 + fr) * DM + col0;
        if (layer == 0) {
            const float* base = (isctx ? ctx_in + (size_t)b * CTXL * DM : x_in + ((size_t)b * SEQ + (size_t)(jt - 1) * 256) * DM) + (size_t)(wr * 64 + fr) * DM + col0;
#pragma unroll
            for (int ai = 0; ai < 2; ++ai) { f32x4 rs[4][2][2];
#pragma unroll
                for (int m = 0; m < 4; ++m)
#pragma unroll
                    for (int bj = 0; bj < 2; ++bj)
#pragma unroll
                        for (int n = 0; n < 2; ++n) rs[m][bj][n] = *(const f32x4*)(base + (size_t)(ai * 128 + m * 16) * DM + bj * 128 + n * 4);
                __builtin_amdgcn_sched_barrier(0);
#pragma unroll
                for (int m = 0; m < 4; ++m)
#pragma unroll
                    for (int bj = 0; bj < 2; ++bj) { const f32x4 o0 = rs[m][bj][0] + gv[bj][0] * acc[ai][bj][m][0], o1 = rs[m][bj][1] + gv[bj][1] * acc[ai][bj][m][1];
                        v4u w; w.x = cvtpk(o0[0], o0[1]); w.y = cvtpk(o0[2], o0[3]); w.z = cvtpk(o1[0], o1[1]); w.w = cvtpk(o1[2], o1[3]);
                        *(v4u*)(ob + (size_t)(ai * 128 + m * 16) * DM + bj * 128) = w; }
                __builtin_amdgcn_sched_barrier(0); }
        } else {
            const bf16_t* base = XR + ((size_t)pm * 256 + wr * 64 + fr) * DM + col0;
#pragma unroll
            for (int ai = 0; ai < 2; ++ai) { v4u rb[4][2];
#pragma unroll
                for (int m = 0; m < 4; ++m)
#pragma unroll
                    for (int bj = 0; bj < 2; ++bj) rb[m][bj] = *(const v4u*)(base + (size_t)(ai * 128 + m * 16) * DM + bj * 128);
                __builtin_amdgcn_sched_barrier(0);
#pragma unroll
                for (int m = 0; m < 4; ++m)
#pragma unroll
                    for (int bj = 0; bj < 2; ++bj) { const v4u r = rb[m][bj];
                        const f32x4 r0 = (f32x4){bflo(r.x), bfhi(r.x), bflo(r.y), bfhi(r.y)}, r1 = (f32x4){bflo(r.z), bfhi(r.z), bflo(r.w), bfhi(r.w)};
                        const f32x4 o0 = r0 + gv[bj][0] * acc[ai][bj][m][0], o1 = r1 + gv[bj][1] * acc[ai][bj][m][1];
                        v4u w; w.x = cvtpk(o0[0], o0[1]); w.y = cvtpk(o0[2], o0[3]); w.z = cvtpk(o1[0], o1[1]); w.w = cvtpk(o1[2], o1[3]);
                        *(v4u*)(ob + (size_t)(ai * 128 + m * 16) * DM + bj * 128) = w; }
                __builtin_amdgcn_sched_barrier(0); }
        }
    }
};
struct EpiPart {
    static constexpr bool PERM = false;
    static __device__ __forceinline__ bool keep_acc(const pg8::Unit&) { return false; }
    float* PART;
    __device__ __forceinline__ void operator()(const f32x4 (&acc)[2][2][4][2], const pg8::Unit& u, int wr, int wc, int fr, int fq) const {
        const int ks = u.pn >> 2, ct = u.pn & 3; const int col0 = ct * 256 + wc * 32 + 4 * fq;
#pragma unroll
        for (int ai = 0; ai < 2; ++ai)
#pragma unroll
            for (int m = 0; m < 4; ++m) { float* op = PART + ((size_t)ks * 512 + u.pm * 256 + ai * 128 + wr * 64 + m * 16 + fr) * DM + col0;
#pragma unroll
                for (int bj = 0; bj < 2; ++bj)
#pragma unroll
                    for (int n = 0; n < 2; ++n) *(f32x4*)(op + bj * 128 + n * 16) = acc[ai][bj][m][n]; }
    }
};
struct EpiSwiGLU {
    static constexpr bool PERM = true;
    unsigned char* HID;
    __device__ __forceinline__ void operator()(const f32x4 (&acc)[2][2][4][2], const pg8::Unit& u, int wr, int wc, int fr, int fq) const {
        const int f0 = u.pn * 128 + wc * 32 + 8 * fq;
#pragma unroll
        for (int ai = 0; ai < 2; ++ai)
#pragma unroll
            for (int m = 0; m < 4; ++m) { float o[8];
#pragma unroll
                for (int n = 0; n < 2; ++n)
#pragma unroll
                    for (int j = 0; j < 4; j += 2) { const f32x2 g2 = (f32x2){acc[ai][0][m][n][j], acc[ai][0][m][n][j + 1]}, u2 = (f32x2){acc[ai][1][m][n][j], acc[ai][1][m][n][j + 1]};
                        const f32x2 t2 = g2 * (f32x2){-W8I * LOG2E, -W8I * LOG2E};
                        const f32x2 e2 = (f32x2){__builtin_amdgcn_exp2f(t2.x), __builtin_amdgcn_exp2f(t2.y)};
                        const f32x2 d2 = __builtin_elementwise_fma(e2, (f32x2){1024.0f, 1024.0f}, (f32x2){1024.0f, 1024.0f});
                        const f32x2 r2 = (f32x2){__builtin_amdgcn_rcpf(d2.x), __builtin_amdgcn_rcpf(d2.y)};
                        const f32x2 o2 = (g2 * u2) * r2; o[4 * n + j] = o2.x; o[4 * n + j + 1] = o2.y; }
                v2u w; w.x = pk8(o[0], o[1], o[2], o[3]); w.y = pk8(o[4], o[5], o[6], o[7]);
                *(v2u*)(HID + ((size_t)u.pm * 256 + ai * 128 + wr * 64 + m * 16 + fr) * EH + f0) = w; }
    }
};
struct EpiDown {
    static constexpr bool PERM = true;
    bf16_t* Y; const float* SCORE;
    __device__ __forceinline__ void operator()(const f32x4 (&acc)[2][2][4][2], const pg8::Unit& u, int wr, int wc, int fr, int fq) const {
        const int col0 = u.pn * 256 + wc * 32 + 8 * fq;
        float sc8[2][4];
#pragma unroll
        for (int ai = 0; ai < 2; ++ai)
#pragma unroll
            for (int m = 0; m < 4; ++m) sc8[ai][m] = SCORE[(size_t)u.pm * 256 + ai * 128 + wr * 64 + m * 16 + fr];
        __builtin_amdgcn_sched_barrier(0);
#pragma unroll
        for (int ai = 0; ai < 2; ++ai)
#pragma unroll
            for (int m = 0; m < 4; ++m) { const size_t row = (size_t)u.pm * 256 + ai * 128 + wr * 64 + m * 16 + fr; const float s = sc8[ai][m] * W8I;
#pragma unroll
                for (int bj = 0; bj < 2; ++bj) { float o[8];
#pragma unroll
                    for (int n = 0; n < 2; ++n)
#pragma unroll
                        for (int j = 0; j < 4; ++j) o[4 * n + j] = acc[ai][bj][m][n][j] * s;
                    st8(Y + row * DM + col0 + bj * 128, o); } }
    }
};
struct EpiDownPart {
    static constexpr bool PERM = true;
    bf16_t* YP; const float* SCORE;
    __device__ __forceinline__ void operator()(const f32x4 (&acc)[2][2][4][2], const pg8::Unit& u, int wr, int wc, int fr, int fq) const {
        if (wr != 0) return;
        const int in = u.pn & 3, kq = u.pn >> 2, e = u.pm / 9; const int col0 = in * 256 + wc * 32 + 8 * fq;
        float sc4[4];
#pragma unroll
        for (int m = 0; m < 4; ++m) sc4[m] = SCORE[(size_t)u.pm * 256 + m * 16 + fr];
        __builtin_amdgcn_sched_barrier(0);
#pragma unroll
        for (int m = 0; m < 4; ++m) { const size_t row = ((size_t)(kq * 16 + e) * 256 + m * 16 + fr); const float sc = sc4[m] * W8I;
#pragma unroll
            for (int bj = 0; bj < 2; ++bj) { float o[8];
#pragma unroll
                for (int n = 0; n < 2; ++n)
#pragma unroll
                    for (int j = 0; j < 4; ++j) o[4 * n + j] = acc[0][bj][m][n][j] * sc;
                st8(YP + row * DM + col0 + bj * 128, o); } }
    }
};

namespace attn_body {
using bf16 = __hip_bfloat16;
using u32x4 = __attribute__((ext_vector_type(4))) unsigned;
constexpr int NW = 8, QBLK = 32, QB = QBLK * NW, KVBLK = 64;
__device__ __forceinline__ int crow(int r, int hi) { return (r & 3) + 8 * (r >> 2) + 4 * hi; }
#define SBAR() __builtin_amdgcn_sched_barrier(0)
constexpr int NSLOT = 3, SLOTB = 8192;
constexpr int LDS_K = 0, LDS_V = NSLOT * SLOTB, LDS_WS = 2 * NSLOT * SLOTB, LDS_OST = LDS_WS + NW * 64 * 4, LDS_OST1 = LDS_OST + NW * 4096, LDS_RPB = LDS_OST1 + NW * 4096, LDS_ATT_BYTES = LDS_RPB + 2048;
static_assert(LDS_ATT_BYTES <= RING_BYTES, "attention LDS");
__device__ __forceinline__ void glds16(const void* gsrc, unsigned lds_dst) { unsigned keep;
  asm volatile("s_mov_b32 %0, m0\n\ts_mov_b32 m0, %2\n\ts_nop 0\n\tglobal_load_lds_dwordx4 %1, off\n\ts_mov_b32 m0, %0" : "=&s"(keep) : "v"(gsrc), "s"(lds_dst) : "memory"); }
__device__ __forceinline__ float max3f(float a, float b, float c) { float r; asm("v_max3_f32 %0, %1, %2, %3" : "=v"(r) : "v"(a), "v"(b), "v"(c)); return r; }
__device__ __forceinline__ float max2f(float a, float b) { float r; asm("v_max_f32_e32 %0, %1, %2" : "=v"(r) : "v"(a), "v"(b)); return r; }
__device__ __forceinline__ float fadd_s(float a, float b) { float r; asm("v_add_f32_e32 %0, %1, %2" : "=v"(r) : "v"(a), "v"(b)); return r; }
__device__ __forceinline__ float fsub_s(float a, float b) { float r; asm("v_sub_f32_e32 %0, %1, %2" : "=v"(r) : "v"(a), "v"(b)); return r; }
__device__ __forceinline__ unsigned cvtpk_s(float lo, float hi) { return cvtpk(lo, hi); }
#define WAIT_BAR(N) asm volatile("s_waitcnt vmcnt(" #N ") lgkmcnt(0)\n\ts_barrier" ::: "memory")

typedef __attribute__((address_space(3))) const char* lds_cptr;
typedef short v4i16_t __attribute__((ext_vector_type(4)));
__device__ __forceinline__ void qkt(f32x16& p0, f32x16& p1, lds_cptr Kslot, const bf16x8* qr, const f32x16& negm, int r32, int hi) {
  lds_cptr kb = Kslot + hi * 1024 + r32 * 16;
  #pragma unroll
  for (int d0 = 0; d0 < 4; ++d0) {
    const bf16x8 b0 = *(const __attribute__((address_space(3))) bf16x8*)(kb + d0 * 2048);
    const bf16x8 b1 = *(const __attribute__((address_space(3))) bf16x8*)(kb + d0 * 2048 + 512);
    if (d0 == 0) { p0 = __builtin_amdgcn_mfma_f32_32x32x16_bf16(b0, qr[0], negm, 0, 0, 0); p1 = __builtin_amdgcn_mfma_f32_32x32x16_bf16(b1, qr[0], negm, 0, 0, 0); }
    else { p0 = __builtin_amdgcn_mfma_f32_32x32x16_bf16(b0, qr[d0], p0, 0, 0, 0); p1 = __builtin_amdgcn_mfma_f32_32x32x16_bf16(b1, qr[d0], p1, 0, 0, 0); } }
}
__device__ __forceinline__ void kload8(bf16x8* kf, lds_cptr kp) {
  kf[0] = *(const __attribute__((address_space(3))) bf16x8*)(kp);        kf[1] = *(const __attribute__((address_space(3))) bf16x8*)(kp + 512);
  kf[2] = *(const __attribute__((address_space(3))) bf16x8*)(kp + 2048); kf[3] = *(const __attribute__((address_space(3))) bf16x8*)(kp + 2560);
  kf[4] = *(const __attribute__((address_space(3))) bf16x8*)(kp + 4096); kf[5] = *(const __attribute__((address_space(3))) bf16x8*)(kp + 4608);
  kf[6] = *(const __attribute__((address_space(3))) bf16x8*)(kp + 6144); kf[7] = *(const __attribute__((address_space(3))) bf16x8*)(kp + 6656);
}
__device__ __forceinline__ void kload2(bf16x8* kf, lds_cptr kp, int j) { kf[2 * j] = *(const __attribute__((address_space(3))) bf16x8*)(kp + j * 2048); kf[2 * j + 1] = *(const __attribute__((address_space(3))) bf16x8*)(kp + j * 2048 + 512); }
__device__ __forceinline__ s16x4 vtr(lds_cptr p) { return __builtin_bit_cast(s16x4, __builtin_amdgcn_ds_read_tr16_b64_v4i16((__attribute__((address_space(3))) v4i16_t*)p)); }
__device__ __forceinline__ float rowmax(const f32x16& p0, const f32x16& p1) {
  float a = max3f(p0[0], p0[1], p1[0]), b = max3f(p0[2], p0[3], p1[1]); a = max3f(a, p1[2], p1[3]);
  #pragma unroll
  for (int r = 4; r < 16; r += 4) { a = max3f(a, p0[r], p0[r + 1]); b = max3f(b, p0[r + 2], p0[r + 3]); a = max3f(a, p1[r], p1[r + 1]); b = max3f(b, p1[r + 2], p1[r + 3]); }
  const float m = max2f(a, b);
  auto rr = __builtin_amdgcn_permlane32_swap(__float_as_uint(m), __float_as_uint(m), false, false);
  return max2f(__uint_as_float(rr[0]), __uint_as_float(rr[1]));
}
__device__ __forceinline__ void pv(f32x16* o, int vb, bf16x8 pa0, bf16x8 pa1, bf16x8 pa2, bf16x8 pa3) {
  #pragma unroll
  for (int d0 = 0; d0 < 2; ++d0) { s16x4 lo[4], hi[4];
    #pragma unroll
    for (int ks = 0; ks < 4; ++ks) {
      asm volatile("ds_read_b64_tr_b16 %0,%1 offset:%c2" : "=&v"(lo[ks]) : "v"(vb), "i"(d0 * 4096 + ks * 1024) : "memory");
      asm volatile("ds_read_b64_tr_b16 %0,%1 offset:%c2" : "=&v"(hi[ks]) : "v"(vb), "i"(d0 * 4096 + ks * 1024 + 512) : "memory"); }
    asm volatile("s_waitcnt lgkmcnt(0)" ::: "memory"); SBAR();
    #define PK(k) (bf16x8){lo[k][0], lo[k][1], lo[k][2], lo[k][3], hi[k][0], hi[k][1], hi[k][2], hi[k][3]}
    o[d0] = __builtin_amdgcn_mfma_f32_32x32x16_bf16(pa0, PK(0), o[d0], 0, 0, 0);
    o[d0] = __builtin_amdgcn_mfma_f32_32x32x16_bf16(pa1, PK(1), o[d0], 0, 0, 0);
    o[d0] = __builtin_amdgcn_mfma_f32_32x32x16_bf16(pa2, PK(2), o[d0], 0, 0, 0);
    o[d0] = __builtin_amdgcn_mfma_f32_32x32x16_bf16(pa3, PK(3), o[d0], 0, 0, 0);
    #undef PK
  }
}

struct DiffEpi { float lam, post; const float* subg; };
template <int THRL, int MODE> __device__ __forceinline__ void attn_unit(const bf16* Qu, const bf16* __restrict__ Kh, const bf16* __restrict__ Vh, int NT, bf16* Ou, char* shm, const DiffEpi de, const bool usemax = true, const float* kmaxp = nullptr) {
  constexpr int PK = PQ, PV = PQ, PO = 1024;
  constexpr bool DQ32 = (MODE != 0);
  const int tid = opaque_tid(), lane = tid & 63, r32 = lane & 31, hi = lane >> 5; const int wid = __builtin_amdgcn_readfirstlane(tid >> 6);
  const bf16* Qw = Qu + (long)(wid * QBLK) * PQ;
  const unsigned lds0 = (unsigned)(uintptr_t)shm;
  float* wsf = (float*)(shm + LDS_WS) + wid * 64;
  const bf16* ksrc = Kh + (long)lane * PK + wid * 8;
  const bf16* vsrc = Vh + (long)(16 * (wid & 3) + (lane >> 2)) * PV + (wid >> 2) * 32 + (lane & 3) * 8;
  const unsigned kdst = lds0 + LDS_K + wid * 1024, vdst = lds0 + LDS_V + wid * 1024;
  #define DMA_K(t, slot) glds16(ksrc + (long)(t) * KVBLK * PK, (unsigned)__builtin_amdgcn_readfirstlane(kdst + (slot)))
  #define DMA_V(t, slot) glds16(vsrc + (long)(t) * KVBLK * PV, (unsigned)__builtin_amdgcn_readfirstlane(vdst + (slot)))
  const int vb0 = (int)(lds0 + LDS_V) + ((lane >> 4) & 1) * 32 + (lane & 3) * 8 + (4 * hi + ((lane & 15) >> 2)) * 64;
  bf16x8 kf[8];
  const lds_cptr shm3 = (lds_cptr)shm; const lds_cptr kp0 = shm3 + LDS_K + hi * 1024 + r32 * 16; const lds_cptr vp0 = shm3 + LDS_V + ((lane >> 4) & 1) * 32 + (lane & 3) * 8 + (4 * hi + ((lane & 15) >> 2)) * 64;
  DMA_K(0, 0); DMA_V(0, 0); DMA_K(1, SLOTB);
  bf16x8 qr[4];
  #pragma unroll
  for (int d0 = 0; d0 < 4; ++d0) qr[d0] = *reinterpret_cast<const bf16x8*>(&Qw[(long)r32 * PQ + d0 * 16 + hi * 8]);
  constexpr bool LMF = DQ32;
  bool um = usemax;
  if (MODE != 0) {
    float q2 = 0.f;
    #pragma unroll
    for (int d0 = 0; d0 < 2; ++d0)
      #pragma unroll
      for (int jq = 0; jq < 8; ++jq) { const float v = __uint_as_float((unsigned)(unsigned short)qr[d0][jq] << 16); q2 += v * v; }
    const float bq = sqrtf(xor32_sum(q2)) * (*kmaxp) * 1.02f;
    um = __builtin_amdgcn_readfirstlane((int)(__ballot(bq > 40.0f) != 0ull)) != 0; }
  float mhat = 0.f, l_reg = 0.f; f32x16 o[2]; o[0] = f32x16{}; o[1] = f32x16{}; f32x16 negm = f32x16{}; asm volatile("" : "+v"(negm));
  f32x16 lacc = f32x16{}; bf16x8 ones; { unsigned c0_, c1_, c2_, c3_; asm volatile("v_mov_b32 %0, 0x3f803f80\n\tv_mov_b32 %1, 0x3f803f80\n\tv_mov_b32 %2, 0x3f803f80\n\tv_mov_b32 %3, 0x3f803f80" : "=v"(c0_), "=v"(c1_), "=v"(c2_), "=v"(c3_)); ones = __builtin_bit_cast(bf16x8, (u32x4){c0_, c1_, c2_, c3_}); }
  bool resc = false;
  #define START(P0, P1) do { const float rm = rowmax(P0, P1); resc = false; \
    { const float dl = rm; mhat = fadd_s(mhat, dl); \
      _Pragma("unroll") for (int r = 0; r < 16; ++r) { P0[r] = fsub_s(P0[r], dl); P1[r] = fsub_s(P1[r], dl); } \
      _Pragma("unroll") for (int r = 0; r < 16; ++r) negm[r] = -mhat; asm volatile("" : "+v"(negm)); } \
    _Pragma("unroll") for (int r = 0; r < 16; ++r) P0[r] = __builtin_amdgcn_exp2f(P0[r]); } while (0)
  #define RESC() do { if (resc) { asm volatile("s_waitcnt lgkmcnt(0)" ::: "memory"); \
      _Pragma("unroll") for (int d_ = 0; d_ < 2; ++d_) _Pragma("unroll") for (int r = 0; r < 16; ++r) o[d_][r] *= wsf[crow(r, hi)]; \
      if (LMF) { _Pragma("unroll") for (int r = 0; r < 16; ++r) lacc[r] *= wsf[crow(r, hi)]; } } } while (0)
  f32x16 pA0, pA1, pB0, pB1;
  int sl_prev = 0, sl_cur = 0, sl_next = SLOTB;
  #define ROT() do { sl_prev = sl_cur; sl_cur = sl_next; sl_next = (sl_next == (NSLOT - 1) * SLOTB) ? 0 : sl_next + SLOTB; } while (0)
  DMA_K(2, 2 * SLOTB);
  WAIT_BAR(3);
  qkt(pA0, pA1, shm3 + LDS_K, qr, negm, r32, hi); asm volatile("s_nop 15\n\ts_nop 7" : "+v"(pA0), "+v"(pA1));
  START(pA0, pA1);
  _Pragma("unroll") for (int r = 0; r < 16; ++r) pA1[r] = __builtin_amdgcn_exp2f(pA1[r]);
  WAIT_BAR(0);
  DMA_K(3, 0); DMA_V(1, SLOTB);
  ROT();
  kload8(kf, kp0 + sl_cur);
  WAIT_BAR(2);
  s16x4 vlo[8], vhi[8]; u32x4 pw0, pw1, pw2, pw3;
  #define PKW(P, B) cvtpk_s(P[B], P[B + 1])
  #define PAF(k) __builtin_bit_cast(bf16x8, pw##k)
  #define VFR(i) (bf16x8){vlo[i][0], vlo[i][1], vlo[i][2], vlo[i][3], vhi[i][0], vhi[i][1], vhi[i][2], vhi[i][3]}
  #define PIN(x) asm volatile("" : "+v"(x))
  #define MX3(a, b, c) __builtin_fmaxf(__builtin_fmaxf((a), (b)), (c))
  #define GAPA(MF, A0, A1, A2, A3, W0, W1, PW) do { MF; if (!LMF) { sacc += A0; sacc += A1; sacc += A2; sacc += A3; PIN(sacc); } W0; W1; PIN(PW); SBAR(); } while (0)
  #define LMM(k) lacc = __builtin_amdgcn_mfma_f32_32x32x16_bf16(PAF(k), ones, lacc, 0, 0, 0)
  #define EX(v) __builtin_amdgcn_exp2f(v)
  #define GAPB(MF, X, B) do { MF; X[B] = EX(X[B]); X[B + 1] = EX(X[B + 1]); X[B + 2] = EX(X[B + 2]); X[B + 3] = EX(X[B + 3]); PIN(X); SBAR(); } while (0)
  #define VRD(i) do { vlo[i] = vtr(vp_ + (((i) >> 2) * 4096 + ((i) & 3) * 1024)); vhi[i] = vtr(vp_ + (((i) >> 2) * 4096 + ((i) & 3) * 1024 + 512)); } while (0)
  #define KRD(G, j) do { if (G) { kload2(kf, kp0 + sl_next, j); SBAR(); } } while (0)
  #define STEP(C0, C1, P0, P1, t, GK, GV, GL) do { SBAR(); \
    const lds_cptr vp_ = vp0 + sl_prev; \
    VRD(0); SBAR(); float sacc = (P0[0] + P0[1]); \
    GAPA(C0 = __builtin_amdgcn_mfma_f32_32x32x16_bf16(kf[0], qr[0], negm, 0, 0, 0), P0[2], P0[3], P0[4], P0[5],     pw0[0] = PKW(P0, 0), pw0[1] = PKW(P0, 2), pw0); \
    VRD(4); SBAR(); GAPA(C1 = __builtin_amdgcn_mfma_f32_32x32x16_bf16(kf[1], qr[0], negm, 0, 0, 0), P0[6], P0[7], P0[8], P0[9],     pw0[2] = PKW(P0, 4), pw0[3] = PKW(P0, 6), pw0); \
    VRD(1); SBAR(); GAPA(C0 = __builtin_amdgcn_mfma_f32_32x32x16_bf16(kf[2], qr[1], C0, 0, 0, 0),   P0[10], P0[11], P0[12], P0[13], pw1[0] = PKW(P0, 8), pw1[1] = PKW(P0, 10), pw1); \
    VRD(5); SBAR(); GAPA(C1 = __builtin_amdgcn_mfma_f32_32x32x16_bf16(kf[3], qr[1], C1, 0, 0, 0),   P0[14], P0[15], P1[0], P1[1],   pw1[2] = PKW(P0, 12), pw1[3] = PKW(P0, 14), pw1); \
    VRD(2); SBAR(); GAPA(do { if (!DQ32) { C0 = __builtin_amdgcn_mfma_f32_32x32x16_bf16(kf[4], qr[2], C0, 0, 0, 0); } else if (LMF) { LMM(0); } } while (0),   P1[2], P1[3], P1[4], P1[5],     pw2[0] = PKW(P1, 0), pw2[1] = PKW(P1, 2), pw2); \
    VRD(6); SBAR(); GAPA(do { if (!DQ32) { C1 = __builtin_amdgcn_mfma_f32_32x32x16_bf16(kf[5], qr[2], C1, 0, 0, 0); } else if (LMF) { LMM(1); } } while (0),   P1[6], P1[7], P1[8], P1[9],     pw2[2] = PKW(P1, 4), pw2[3] = PKW(P1, 6), pw2); \
    VRD(3); SBAR(); GAPA(do { if (!DQ32) { C0 = __builtin_amdgcn_mfma_f32_32x32x16_bf16(kf[6], qr[3], C0, 0, 0, 0); } else if (LMF) { LMM(2); } } while (0),   P1[10], P1[11], P1[12], P1[13], pw3[0] = PKW(P1, 8), pw3[1] = PKW(P1, 10), pw3); \
    VRD(7); SBAR(); GAPA(do { if (!DQ32) { C1 = __builtin_amdgcn_mfma_f32_32x32x16_bf16(kf[7], qr[3], C1, 0, 0, 0); } } while (0),   P1[14], P1[15], 0.f, 0.f,       pw3[2] = PKW(P1, 12), pw3[3] = PKW(P1, 14), pw3); \
    if (LMF) { LMM(3); } else { l_reg += sacc; } \
    if (GK) { DMA_K((t) + 3, sl_cur); } if (GV) { DMA_V((t) + 1, sl_next); } \
    if (um) { float a = MX3(C0[0], C0[1], C1[0]), b = MX3(C0[2], C0[3], C1[1]); a = MX3(a, C1[2], C1[3]); \
      _Pragma("unroll") for (int r = 4; r < 16; r += 4) { a = MX3(a, C0[r], C0[r + 1]); b = MX3(b, C0[r + 2], C0[r + 3]); a = MX3(a, C1[r], C1[r + 1]); b = MX3(b, C1[r + 2], C1[r + 3]); } \
      float rm = __builtin_fmaxf(a, b); { auto rr = __builtin_amdgcn_permlane32_swap(__float_as_uint(rm), __float_as_uint(rm), false, false); rm = __builtin_fmaxf(__uint_as_float(rr[0]), __uint_as_float(rr[1])); } \
      resc = false; \
      if (__builtin_expect(__any(rm > (float)THRL), 0)) { const float dl = __builtin_fmaxf(rm, 0.f); mhat += dl; \
        _Pragma("unroll") for (int r = 0; r < 16; ++r) { C0[r] -= dl; C1[r] -= dl; } \
        _Pragma("unroll") for (int r = 0; r < 16; ++r) negm[r] = -mhat; asm volatile("" : "+v"(negm)); \
        const float f = __builtin_amdgcn_exp2f(-dl); if (!LMF) l_reg *= f; if (hi == 0) wsf[r32] = f; resc = true; } } else { resc = false; } \
    SBAR(); \
    GAPB(o[0] = __builtin_amdgcn_mfma_f32_32x32x16_bf16(PAF(0), VFR(0), o[0], 0, 0, 0), C0, 0); \
    GAPB(o[1] = __builtin_amdgcn_mfma_f32_32x32x16_bf16(PAF(0), VFR(4), o[1], 0, 0, 0), C0, 4); \
    KRD(GL, 0); GAPB(o[0] = __builtin_amdgcn_mfma_f32_32x32x16_bf16(PAF(1), VFR(1), o[0], 0, 0, 0), C0, 8); \
    KRD(GL, 1); GAPB(o[1] = __builtin_amdgcn_mfma_f32_32x32x16_bf16(PAF(1), VFR(5), o[1], 0, 0, 0), C0, 12); \
    KRD(GL && !DQ32, 2); GAPB(o[0] = __builtin_amdgcn_mfma_f32_32x32x16_bf16(PAF(2), VFR(2), o[0], 0, 0, 0), C1, 0); \
    KRD(GL && !DQ32, 3); GAPB(o[1] = __builtin_amdgcn_mfma_f32_32x32x16_bf16(PAF(2), VFR(6), o[1], 0, 0, 0), C1, 4); \
    GAPB(o[0] = __builtin_amdgcn_mfma_f32_32x32x16_bf16(PAF(3), VFR(3), o[0], 0, 0, 0), C1, 8); \
    GAPB(o[1] = __builtin_amdgcn_mfma_f32_32x32x16_bf16(PAF(3), VFR(7), o[1], 0, 0, 0), C1, 12); \
    } while (0)
  int t = 1;
  for (; t + 5 < NT; t += 2) {
    STEP(pB0, pB1, pA0, pA1, t, true, true, true);     WAIT_BAR(2); RESC(); ROT();
    STEP(pA0, pA1, pB0, pB1, t + 1, true, true, true); WAIT_BAR(2); RESC(); ROT();
  }
  #define ENDW(tt) do { if ((tt) + 3 < NT) { WAIT_BAR(2); } else if ((tt) + 2 < NT) { WAIT_BAR(1); } else { WAIT_BAR(0); } } while (0)
  for (; t + 1 < NT; t += 2) {
    STEP(pB0, pB1, pA0, pA1, t, (t + 3 < NT), (t + 1 < NT), (t + 1 < NT));       ENDW(t);     RESC(); ROT();
    STEP(pA0, pA1, pB0, pB1, t + 1, (t + 4 < NT), (t + 2 < NT), (t + 2 < NT));   ENDW(t + 1); RESC(); ROT();
  }
  STEP(pB0, pB1, pA0, pA1, NT - 1, false, false, false); RESC();
  { if (!LMF) { float sacc = pB0[0] + pB0[1]; _Pragma("unroll") for (int r = 2; r < 16; ++r) sacc += pB0[r]; _Pragma("unroll") for (int r = 0; r < 16; ++r) sacc += pB1[r]; l_reg += sacc; }
    pw0 = (u32x4){PKW(pB0, 0), PKW(pB0, 2), PKW(pB0, 4), PKW(pB0, 6)}; pw1 = (u32x4){PKW(pB0, 8), PKW(pB0, 10), PKW(pB0, 12), PKW(pB0, 14)}; pw2 = (u32x4){PKW(pB1, 0), PKW(pB1, 2), PKW(pB1, 4), PKW(pB1, 6)}; pw3 = (u32x4){PKW(pB1, 8), PKW(pB1, 10), PKW(pB1, 12), PKW(pB1, 14)};
    SBAR(); if (LMF) { LMM(0); LMM(1); LMM(2); LMM(3); } pv(o, vb0 + sl_cur, PAF(0), PAF(1), PAF(2), PAF(3)); }
  #undef LMM
  #undef PKW
  #undef PAF
  #undef VFR
  #undef PIN
  #undef MX3
  #undef GAPA
  #undef GAPB
  #undef EX
  #undef VRD
  #undef KRD
  #undef STEP
  #undef ENDW
  float rli[16];
  if (LMF) {
    #pragma unroll
    for (int r = 0; r < 16; ++r) rli[r] = __builtin_amdgcn_rcpf(lacc[r]);
  } else {
    { auto rr = __builtin_amdgcn_permlane32_swap(__float_as_uint(l_reg), __float_as_uint(l_reg), false, false); l_reg = __uint_as_float(rr[0]) + __uint_as_float(rr[1]); }
    if (hi == 0) wsf[32 + r32] = l_reg; asm volatile("s_waitcnt lgkmcnt(0)" ::: "memory");
    #pragma unroll
    for (int r = 0; r < 16; ++r) rli[r] = __builtin_amdgcn_rcpf(wsf[32 + crow(r, hi)]);
  }
  bf16_t* stg = (bf16_t*)(shm + LDS_OST) + wid * 2048;
  bf16_t* stg1 = (bf16_t*)(shm + LDS_OST1) + wid * 2048;
  if (MODE == 1) {
    #pragma unroll
    for (int r = 0; r < 16; ++r) { const int orow = crow(r, hi);
      #pragma unroll
      for (int d0 = 0; d0 < 2; ++d0) stg1[orow * 64 + d0 * 32 + r32] = f2bf(o[d0][r] * rli[r]); }
    asm volatile("s_waitcnt lgkmcnt(0)" ::: "memory");
  } else {
    if (MODE == 2) {
      const float g0 = de.subg[r32] * de.post, g1 = de.subg[32 + r32] * de.post;
      #pragma unroll
      for (int r = 0; r < 16; ++r) { const int orow = crow(r, hi);
        const float d0v = bf2f(stg1[orow * 64 + r32]) - de.lam * (o[0][r] * rli[r]), d1v = bf2f(stg1[orow * 64 + 32 + r32]) - de.lam * (o[1][r] * rli[r]);
        float ss = d0v * d0v + d1v * d1v;
        ss = half32_sum(ss);
        const float rstd = __builtin_amdgcn_rsqf(ss * (1.0f / 64.0f) + EPS);
        stg[orow * 64 + r32] = f2bf(d0v * rstd * g0); stg[orow * 64 + 32 + r32] = f2bf(d1v * rstd * g1); }
    } else {
      #pragma unroll
      for (int r = 0; r < 16; ++r) { const int orow = crow(r, hi);
        #pragma unroll
        for (int d0 = 0; d0 < 2; ++d0) stg[orow * 64 + d0 * 32 + r32] = f2bf(o[d0][r] * rli[r]); }
    }
    asm volatile("s_waitcnt lgkmcnt(0)" ::: "memory");
    bf16* Ow = Ou + (long)(wid * QBLK) * PO;
    #pragma unroll
    for (int i = 0; i < 4; ++i) { const int row = i * 8 + (lane >> 3), ch = lane & 7; const u32x4 v = *(const u32x4*)(stg + row * 64 + ch * 8); *(u32x4*)(Ow + (long)row * PO + ch * 8) = v; }
  }
  asm volatile("s_waitcnt lgkmcnt(0)\n\ts_barrier" ::: "memory");
  #undef DMA_K
  #undef DMA_V
  #undef START
  #undef RESC
  #undef ROT
}

__device__ __forceinline__ void na_unit(int b, int h, int g4, const bf16* QKV, bf16* YS, const float* rpb_h, char* shm, const float* kmaxp) {
  const bf16 *QA = QKV + C_QA, *KA = QKV + C_KA, *VA = QKV + C_VA;
  const int tid = opaque_tid(), lane = tid & 63, r32 = lane & 31, hi = lane >> 5; const int wid = __builtin_amdgcn_readfirstlane(tid >> 6);
  const unsigned lds0 = (unsigned)(uintptr_t)shm;
  float* wsf = (float*)(shm + LDS_WS) + wid * 64;
  float* rp = (float*)(shm + LDS_RPB);
  const lds_cptr shm3 = (lds_cptr)shm;
  for (int i = tid; i < 15 * 31; i += 512) rp[i] = rpb_h[i] * LOG2E;
  const int rq = 4 * g4 + (wid >> 1), qc = 32 * (wid & 1) + r32;
  const long rowb = (long)b * RB;
  const bf16* Qw = QA + (rowb + CTXL + rq * 64 + 32 * (wid & 1)) * PQ + h * 64;
  bf16x8 qr[4];
  #pragma unroll
  for (int d0 = 0; d0 < 4; ++d0) qr[d0] = *reinterpret_cast<const bf16x8*>(&Qw[(long)r32 * PQ + d0 * 16 + hi * 8]);
  bool fx; { float q2 = 0.f;
    #pragma unroll
    for (int d0 = 0; d0 < 4; ++d0)
      #pragma unroll
      for (int jq = 0; jq < 8; ++jq) { const float v = __uint_as_float((unsigned)(unsigned short)qr[d0][jq] << 16); q2 += v * v; }
    float bm = 0.f; for (int i = lane; i < 15 * 31; i += 64) bm = fmaxf(bm, fabsf(rpb_h[i]));
    const float bq = sqrtf(xor32_sum(q2)) * (*kmaxp) * 1.02f + wave_max(bm) * LOG2E;
    fx = __builtin_amdgcn_readfirstlane((int)(__ballot(bq > 40.0f) != 0ull)) == 0; }
  const int r0 = min(max(rq - 4, 0), 120);
  const int kr_lo = min(max(4 * g4 - 4, 0), 120), kr_hi = min(max(4 * g4 - 1, 0), 120) + 7;
  const int ntiles = 4 + (kr_hi - kr_lo + 1);
  const int c0 = min(max(qc - 8, 0), 48);
  float mrun = -INFINITY, l_reg = 0.f; f32x16 o[2]; o[0] = f32x16{}; o[1] = f32x16{};
  const unsigned kdst = lds0 + LDS_K + wid * 1024, vdst = lds0 + LDS_V + wid * 1024;
  const int vb0 = (int)(lds0 + LDS_V) + ((lane >> 4) & 1) * 32 + (lane & 3) * 8 + (4 * hi + ((lane & 15) >> 2)) * 64;
  #define NA_DMA(TI) do { const int kr_ = kr_lo + (TI) - 4; const long krow_ = ((TI) < 4) ? rowb + 64 * (TI) : rowb + CTXL + (long)kr_ * 64; const unsigned so_ = ((TI) & 1) * SLOTB; \
      glds16(KA + (krow_ + lane) * PQ + h * 64 + wid * 8, (unsigned)__builtin_amdgcn_readfirstlane(kdst + so_)); \
      glds16(VA + (krow_ + 16 * (wid & 3) + (lane >> 2)) * PQ + h * 64 + (wid >> 2) * 32 + (lane & 3) * 8, (unsigned)__builtin_amdgcn_readfirstlane(vdst + so_)); } while (0)
  asm volatile("s_waitcnt lgkmcnt(0)\n\ts_barrier" ::: "memory");
  NA_DMA(0);
  for (int ti = 0; ti < ntiles; ++ti) {
    const int kr = kr_lo + ti - 4;
    asm volatile("s_waitcnt vmcnt(0) lgkmcnt(0)\n\ts_barrier" ::: "memory");
    if (ti + 1 < ntiles) NA_DMA(ti + 1);
    const unsigned so = (ti & 1) * SLOTB;
    const bool valid = (ti < 4) || (kr >= r0 && kr <= r0 + 7);
    if (valid) {
      f32x16 p0, p1; const f32x16 z = f32x16{};
      qkt(p0, p1, shm3 + LDS_K + so, qr, z, r32, hi);
      if (ti >= 4) {
        const int dr = kr - rq + 7;
        #pragma unroll
        for (int r = 0; r < 16; ++r) { const int k0 = crow(r, hi), k1 = k0 + 32;
          const bool v0 = (k0 >= c0) && (k0 < c0 + 16), v1 = (k1 >= c0) && (k1 < c0 + 16);
          const float b0 = v0 ? rp[dr * 31 + (k0 - qc + 15)] : 0.f, b1 = v1 ? rp[dr * 31 + (k1 - qc + 15)] : 0.f;
          p0[r] = v0 ? p0[r] + b0 : -INFINITY; p1[r] = v1 ? p1[r] + b1 : -INFINITY; }
      }
      if (fx) { float sacc = 0.f;
        #pragma unroll
        for (int r = 0; r < 16; ++r) { p0[r] = __builtin_amdgcn_exp2f(p0[r]); p1[r] = __builtin_amdgcn_exp2f(p1[r]); sacc += p0[r] + p1[r]; }
        l_reg += sacc;
      } else {
      float rm = p0[0];
      #pragma unroll
      for (int r = 1; r < 16; ++r) rm = fmaxf(rm, p0[r]);
      #pragma unroll
      for (int r = 0; r < 16; ++r) rm = fmaxf(rm, p1[r]);
      { auto rr = __builtin_amdgcn_permlane32_swap(__float_as_uint(rm), __float_as_uint(rm), false, false); rm = fmaxf(__uint_as_float(rr[0]), __uint_as_float(rr[1])); }
      const float mnew = fmaxf(mrun, rm); const float f = __builtin_amdgcn_exp2f(mrun - mnew); mrun = mnew;
      float sacc = 0.f;
      #pragma unroll
      for (int r = 0; r < 16; ++r) { p0[r] = __builtin_amdgcn_exp2f(p0[r] - mnew); p1[r] = __builtin_amdgcn_exp2f(p1[r] - mnew); sacc += p0[r] + p1[r]; }
      l_reg = l_reg * f + sacc;
      if (hi == 0) wsf[r32] = f;
      asm volatile("s_waitcnt lgkmcnt(0)" ::: "memory");
      #pragma unroll
      for (int d_ = 0; d_ < 2; ++d_)
        #pragma unroll
        for (int r = 0; r < 16; ++r) o[d_][r] *= wsf[crow(r, hi)];
      }
      u32x4 pw0, pw1, pw2, pw3;
      pw0 = (u32x4){cvtpk(p0[0], p0[1]), cvtpk(p0[2], p0[3]), cvtpk(p0[4], p0[5]), cvtpk(p0[6], p0[7])}; pw1 = (u32x4){cvtpk(p0[8], p0[9]), cvtpk(p0[10], p0[11]), cvtpk(p0[12], p0[13]), cvtpk(p0[14], p0[15])};
      pw2 = (u32x4){cvtpk(p1[0], p1[1]), cvtpk(p1[2], p1[3]), cvtpk(p1[4], p1[5]), cvtpk(p1[6], p1[7])}; pw3 = (u32x4){cvtpk(p1[8], p1[9]), cvtpk(p1[10], p1[11]), cvtpk(p1[12], p1[13]), cvtpk(p1[14], p1[15])};
      asm volatile("s_waitcnt lgkmcnt(0)" ::: "memory");
      pv(o, vb0 + (int)so, __builtin_bit_cast(bf16x8, pw0), __builtin_bit_cast(bf16x8, pw1), __builtin_bit_cast(bf16x8, pw2), __builtin_bit_cast(bf16x8, pw3));
    }
  }
  #undef NA_DMA
  { auto rr = __builtin_amdgcn_permlane32_swap(__float_as_uint(l_reg), __float_as_uint(l_reg), false, false); l_reg = __uint_as_float(rr[0]) + __uint_as_float(rr[1]); }
  if (hi == 0) wsf[32 + r32] = l_reg; asm volatile("s_waitcnt lgkmcnt(0)" ::: "memory");
  bf16_t* stg = (bf16_t*)(shm + LDS_OST) + wid * 2048;
  #pragma unroll
  for (int r = 0; r < 16; ++r) { const int orow = crow(r, hi); const float rl = __builtin_amdgcn_rcpf(wsf[32 + orow]);
    #pragma unroll
    for (int d0 = 0; d0 < 2; ++d0) stg[orow * 64 + d0 * 32 + r32] = f2bf(o[d0][r] * rl); }
  asm volatile("s_waitcnt lgkmcnt(0)" ::: "memory");
  bf16* Ow = YS + (rowb + CTXL + rq * 64 + 32 * (wid & 1)) * 1024 + h * 64;
  #pragma unroll
  for (int i = 0; i < 4; ++i) { const int row = i * 8 + (lane >> 3), ch = lane & 7; const u32x4 v = *(const u32x4*)(stg + row * 64 + ch * 8); *(u32x4*)(Ow + (long)row * 1024 + ch * 8) = v; }
  asm volatile("s_waitcnt lgkmcnt(0)\n\ts_barrier" ::: "memory");
}
#undef SBAR
#undef WAIT_BAR
}

__device__ __forceinline__ void sgu_unit(long rowbase, const bf16_t* GU, const bf16_t* GV, const float* ng, const float* sw, const float* sb, bf16_t* YS, char* shm) {
    using attn_body::crow;
    const int tid = opaque_tid(), lane = tid & 63, wid = __builtin_amdgcn_readfirstlane(tid >> 6), r32 = lane & 31, hi = lane >> 5;
    const unsigned lds0 = (unsigned)(uintptr_t)shm;
    {
        const f32x4 g4 = *(const f32x4*)(ng + 4 * lane);
        const int gl = lane >> 4, d = 4 * (lane & 15);
#pragma unroll
        for (int rb = 0; rb < 4; ++rb) { v2u raw[4];
#pragma unroll
            for (int q4 = 0; q4 < 4; ++q4) raw[q4] = *(const v2u*)(GV + (rowbase + wid * 16 + rb * 4 + q4) * PQ + 4 * lane);
            __builtin_amdgcn_sched_barrier(0);
#pragma unroll
            for (int q4 = 0; q4 < 4; ++q4) { const int q = wid * 16 + rb * 4 + q4;
                f32x4 v = {bflo(raw[q4].x), bfhi(raw[q4].x), bflo(raw[q4].y), bfhi(raw[q4].y)};
                const float mean = wave_sum((v.x + v.y) + (v.z + v.w)) * (1.0f / 256.0f);
                v = v - mean;
                const float var = wave_sum((v.x * v.x + v.y * v.y) + (v.z * v.z + v.w * v.w)) * (1.0f / 256.0f);
                const float rstd = __builtin_amdgcn_rsqf(var + EPS);
                v = v * rstd * g4;
                v2u w; w.x = cvtpk(v.x, v.y); w.y = cvtpk(v.z, v.w);
                const int k = q & 63;
                *(v2u*)(shm + (2 * gl + (q >> 6)) * 8192 + ((d >> 5) * 4 + (k >> 4)) * 1024 + (k & 15) * 64 + (d & 31) * 2) = w; }
            __builtin_amdgcn_sched_barrier(0); }
    }
    __syncthreads();
    const int g = wid & 3, ph = wid >> 2;
    const int vb0 = (int)lds0 + ((lane >> 4) & 1) * 32 + (lane & 3) * 8 + (4 * hi + ((lane & 15) >> 2)) * 64;
    bf16_t* stg = (bf16_t*)(shm + 65536) + wid * 2048;
#pragma unroll
    for (int mt = 0; mt < 2; ++mt) {
        const int p0 = ph * 64 + mt * 32;
        const float* wrow = sw + ((size_t)g * 128 + p0 + r32) * 128 + 4 * hi;
        f32x16 o[2]; o[0] = f32x16{}; o[1] = f32x16{};
#pragma unroll
        for (int sl = 0; sl < 2; ++sl) {
            f32x4 wa[4], wc[4];
#pragma unroll
            for (int s4 = 0; s4 < 4; ++s4) { wa[s4] = *(const f32x4*)(wrow + 64 * sl + 16 * s4); wc[s4] = *(const f32x4*)(wrow + 64 * sl + 16 * s4 + 8); }
            __builtin_amdgcn_sched_barrier(0);
            bf16x8 pa[4];
#pragma unroll
            for (int s4 = 0; s4 < 4; ++s4) { const v4u w = {cvtpk(wa[s4].x, wa[s4].y), cvtpk(wa[s4].z, wa[s4].w), cvtpk(wc[s4].x, wc[s4].y), cvtpk(wc[s4].z, wc[s4].w)}; pa[s4] = __builtin_bit_cast(bf16x8, w); }
            attn_body::pv(o, vb0 + (2 * g + sl) * 8192, pa[0], pa[1], pa[2], pa[3]);
        }
        float bias[16];
#pragma unroll
        for (int r = 0; r < 16; ++r) bias[r] = sb[g * 128 + p0 + crow(r, hi)];
        v4u uu[4];
#pragma unroll
        for (int i = 0; i < 4; ++i) uu[i] = *(const v4u*)(GU + (rowbase + p0 + i * 8 + (lane >> 3)) * PQ + g * 64 + (lane & 7) * 8);
        __builtin_amdgcn_sched_barrier(0);
#pragma unroll
        for (int r = 0; r < 16; ++r) { const int orow = crow(r, hi);
#pragma unroll
            for (int d0 = 0; d0 < 2; ++d0) stg[orow * 64 + d0 * 32 + r32] = f2bf(o[d0][r] + bias[r]); }
        asm volatile("s_waitcnt lgkmcnt(0)" ::: "memory");
#pragma unroll
        for (int i = 0; i < 4; ++i) { const int row = i * 8 + (lane >> 3), ch = lane & 7; const v4u mv = *(const v4u*)(stg + row * 64 + ch * 8); const v4u u4 = uu[i];
            v4u w; w.x = cvtpk(bflo(u4.x) * bflo(mv.x), bfhi(u4.x) * bfhi(mv.x)); w.y = cvtpk(bflo(u4.y) * bflo(mv.y), bfhi(u4.y) * bfhi(mv.y));
            w.z = cvtpk(bflo(u4.z) * bflo(mv.z), bfhi(u4.z) * bfhi(mv.z)); w.w = cvtpk(bflo(u4.w) * bflo(mv.w), bfhi(u4.w) * bfhi(mv.w));
            *(v4u*)(YS + (rowbase + p0 + row) * 1024 + 512 + g * 64 + ch * 8) = w; }
        asm volatile("s_waitcnt lgkmcnt(0)" ::: "memory");
    }
    __syncthreads();
}

typedef GAS unsigned gu32;
#define XB_TMO      128
#define XB_XCNT(j)  (256  + 64 * (j))
#define XB_XSUB(j)  (1280 + 64 * (j))
#define XB_XGEN(j)  (2304 + 64 * (j))
#define XB_TOP      3328
#define XB_TOPGEN   3392
#define XCD_BAR_WORDS 3456
#define XB_SPIN_CAP (1u << 18)
__device__ __forceinline__ unsigned xb_ld(unsigned* p)              { return __hip_atomic_load(p, __ATOMIC_RELAXED, __HIP_MEMORY_SCOPE_AGENT); }
__device__ __forceinline__ unsigned xb_add(unsigned* p, unsigned v) { return __hip_atomic_fetch_add(p, v, __ATOMIC_RELAXED, __HIP_MEMORY_SCOPE_AGENT); }
__device__ __forceinline__ unsigned xb_xcc_id() { return (unsigned)__builtin_amdgcn_s_getreg((3 << 11) | 20) & 0xFu; }
#define XB_SPIN(cond, bar) do { unsigned _sp = 0; while (cond) { __builtin_amdgcn_s_sleep(1); \
    if ((++_sp & 255u) == 0u) { if (xb_ld(&(bar)[XB_TMO])) break; if (_sp > XB_SPIN_CAP) { atomicAdd(&(bar)[XB_TMO], 1u); break; } } } } while (0)
struct XcdBarrier { unsigned* bar; unsigned x; volatile LAS unsigned* st; };
__device__ __forceinline__ XcdBarrier xcd_barrier_post(unsigned* bar, volatile LAS unsigned* st) {
    XcdBarrier b; b.bar = bar; b.x = xb_xcc_id(); b.st = st;
    if (threadIdx.x == 0) (void)xb_add(&bar[XB_XCNT(b.x)], 1u);
    return b;
}
__device__ __forceinline__ void xcd_barrier_complete(unsigned* bar, unsigned x, unsigned& nloc, unsigned& nx) {
    const unsigned G = gridDim.x * gridDim.y * gridDim.z;
    unsigned sum, cnt, mine, sp = 0u;
    for (;;) {
        sum = 0u; cnt = 0u; mine = 0u;
#pragma unroll
        for (unsigned j = 0; j < 16; ++j) { const unsigned c = xb_ld(&bar[XB_XCNT(j)]); sum += c; cnt += (c > 0u) ? 1u : 0u; }
        if (sum == G) break;
        __builtin_amdgcn_s_sleep(1);
        if ((++sp & 255u) == 0u) { if (xb_ld(&bar[XB_TMO])) break; if (sp > XB_SPIN_CAP) { atomicAdd(&bar[XB_TMO], 1u); break; } }
    }
    mine = xb_ld(&bar[XB_XCNT(x)]);
    nloc = mine > 0u ? mine : 1u; nx = cnt > 0u ? cnt : 1u;
}
__device__ __forceinline__ void xcd_barrier(const XcdBarrier& b) {
    asm volatile("s_waitcnt vmcnt(0)" ::: "memory");
    __syncthreads();
    if (threadIdx.x == 0) {
        unsigned* bar = b.bar;
        __builtin_amdgcn_s_waitcnt(0);
        unsigned nloc = b.st[0], nx = b.st[1];
        if (nloc == 0u) { xcd_barrier_complete(bar, b.x, nloc, nx); b.st[0] = nloc; b.st[1] = nx; }
        const unsigned old = xb_add(&bar[XB_XSUB(b.x)], 1u);
        const unsigned gen = old / nloc;
        if (old + 1u == (gen + 1u) * nloc) {
            __builtin_amdgcn_fence(__ATOMIC_RELEASE, "agent");
            asm volatile("s_waitcnt vmcnt(0)" ::: "memory");
            const unsigned og = xb_add(&bar[XB_TOP], 1u);
            const unsigned tg = og / nx;
            if (og + 1u == (tg + 1u) * nx) xb_add(&bar[XB_TOPGEN], 1u);
            else XB_SPIN(xb_ld(&bar[XB_TOPGEN]) == tg, bar);
            __builtin_amdgcn_fence(__ATOMIC_ACQUIRE, "agent");
            xb_add(&bar[XB_XGEN(b.x)], 1u);
            asm volatile("s_waitcnt vmcnt(0)" ::: "memory");
        } else {
            XB_SPIN(xb_ld(&bar[XB_XGEN(b.x)]) == gen, bar);
            __builtin_amdgcn_fence(__ATOMIC_ACQUIRE, "agent");
            asm volatile("s_waitcnt vmcnt(0)" ::: "memory");
        }
    }
    __syncthreads();
}

struct Args { const float* in[28]; float* out; unsigned char* ws; int ph_lo, ph_hi, li, pad; };
typedef const __attribute__((address_space(4))) Args* KArgs;
__device__ __forceinline__ KArgs opaque_kargs() { KArgs p = (KArgs)__builtin_amdgcn_kernarg_segment_ptr(); asm volatile("" : "+s"(p)); return p; }
enum { I_X = 0, I_C, I_CTX, I_CCTX, I_WMOD, I_BMOD, I_N1G, I_N2G, I_WIN, I_QG, I_KG, I_RPB, I_LQ1, I_LK1, I_LQ2, I_LK2, I_SUBG, I_SGUNG, I_SGUW, I_SGUB, I_GATEB, I_WBR, I_WOUT, I_WRT, I_WEG, I_WEU, I_WED, I_FG };

constexpr int CW_WIN = 16 * 26, CW_WB = 4 * 4 * 4, CW_WO = 16 * 4, CW_EG = 16 * 16 * 8, CW_ED = 16 * 32 * 4, CW_LAYER = CW_WIN + CW_WB + CW_WO + 2 * CW_EG + CW_ED;
struct ConvItem { const float* src; unsigned char* dst; int N, dpitch, k0, n0, kind, aux; };
__device__ __forceinline__ ConvItem conv_decode(KArgs A, int it) {
    ConvItem c; const int l = it / CW_LAYER; int r = it % CW_LAYER; unsigned char* wl = A->ws + WS_W0 + (size_t)l * W_LAYER; c.aux = 0;
    if (r < CW_WIN) { const int kb = r / 26, pn = r % 26; c.src = A->in[I_WIN] + (size_t)l * DM * IN_W; c.N = IN_W; c.k0 = 64 * kb; c.n0 = 256 * pn; c.dpitch = DM;
        if (pn >= 5 && pn <= 20) { c.kind = 1; c.dst = wl + WO_WING + (size_t)(c.n0 - 1280) * DM; } else { c.kind = 2; c.dst = wl + WO_WIN + (size_t)256 * (pn < 5 ? pn : pn - 16) * DM * 2; }
        return c; }
    r -= CW_WIN;
    if (r < CW_WB) { const int n = r / 16, q = r % 16, kb = q / 4, nb = q % 4; c.src = A->in[I_WBR] + ((size_t)l * 4 + n) * 256 * DM; c.N = DM; c.k0 = 64 * kb; c.n0 = 256 * nb; c.dpitch = 256; c.kind = 0; c.dst = wl + WO_WB + ((size_t)n * 1024 + c.n0) * 256 * 2; return c; }
    r -= CW_WB;
    if (r < CW_WO) { const int kb = r / 4, nb = r % 4; c.src = A->in[I_WOUT] + (size_t)l * DM * DM; c.N = DM; c.k0 = 64 * kb; c.n0 = 256 * nb; c.dpitch = DM; c.kind = 0; c.dst = wl + WO_WO4 + (size_t)c.n0 * DM * 2; return c; }
    r -= CW_WO;
    if (r < 2 * CW_EG) { const int up = r >= CW_EG; if (up) r -= CW_EG; const int e = r / 128, q = r % 128, kb = q / 8, nb = q % 8; c.src = A->in[up ? I_WEU : I_WEG] + ((size_t)l * NEXP + e) * DM * EH; c.N = EH; c.k0 = 64 * kb; c.n0 = 256 * nb; c.dpitch = DM;
        c.kind = 3; c.aux = up ? 128 : 0; c.dst = wl + WO_WGU + (size_t)e * 4096 * DM; return c; }
    r -= 2 * CW_EG;
    { const int e = r / 128, q = r % 128, kb = q / 4, nb = q % 4; c.src = A->in[I_WED] + ((size_t)l * NEXP + e) * EH * DM; c.N = DM; c.k0 = 64 * kb; c.n0 = 256 * nb; c.dpitch = EH; c.kind = 1; c.dst = wl + WO_WD + ((size_t)e * DM + c.n0) * EH; return c; }
}
constexpr int CW_SMALL = CW_WIN + CW_WB + CW_WO, CW_MOE = 2 * CW_EG + CW_ED;
template <bool SMALL> __device__ __forceinline__ int conv_id(int it) { return SMALL ? (it / CW_SMALL) * CW_LAYER + it % CW_SMALL : it; }
template <bool SMALL> __device__ __forceinline__ void conv_load(KArgs A, int it, int NIT, f32x4 (&rg)[8], int wv, int lane) {
    if (it < NIT) { const ConvItem c = conv_decode(A, conv_id<SMALL>(it)); const float* p = c.src + (size_t)(c.k0 + wv * 8) * c.N + c.n0 + 4 * lane;
#pragma unroll
        for (int i = 0; i < 8; ++i) rg[i] = *(const f32x4*)(p + (size_t)i * c.N); }
}
constexpr int C8_WP = 2208, C8_JP = 528, C8_BYTES = 8 * C8_WP;
__device__ __forceinline__ void conv_out8(const ConvItem c, const f32x4 (&rg)[8], LAS unsigned char* T8, int tid, int wv, int lane) {
#pragma unroll
    for (int j = 0; j < 4; ++j) { v2u o; o.x = pk8(rg[0][j] * W8S, rg[1][j] * W8S, rg[2][j] * W8S, rg[3][j] * W8S); o.y = pk8(rg[4][j] * W8S, rg[5][j] * W8S, rg[6][j] * W8S, rg[7][j] * W8S);
        *(LAS v2u*)(T8 + wv * C8_WP + j * C8_JP + lane * 8) = o; }
    asm volatile("s_waitcnt lgkmcnt(0)" ::: "memory"); __builtin_amdgcn_s_barrier(); asm volatile("" ::: "memory");
#pragma unroll
    for (int jj = 0; jj < 2; ++jj) { const int q = tid + 512 * jj, cq = q & 3, n = q >> 2; const LAS unsigned char* t = T8 + (2 * cq) * C8_WP + (n & 3) * C8_JP + (n >> 2) * 8;
        const v2u a = *(const LAS v2u*)t, b = *(const LAS v2u*)(t + C8_WP); const int f = c.n0 + n;
        const int row = c.kind == 3 ? 256 * (f >> 7) + (f & 127) + c.aux : n;
        *(v4u*)(c.dst + (size_t)row * c.dpitch + c.k0 + 16 * cq) = (v4u){a.x, a.y, b.x, b.y}; }
}
template <bool SMALL> __device__ __forceinline__ void conv_out(KArgs A, int it, const f32x4 (&rg)[8], LAS float* T, int par, int tid, int wv, int lane) {
    { const ConvItem c8 = conv_decode(A, conv_id<SMALL>(it));
      if (!SMALL || c8.kind == 1 || c8.kind == 3) { conv_out8(c8, rg, (LAS unsigned char*)T + (SMALL ? 65536 : 0) + par * C8_BYTES, tid, wv, lane); return; } }
    constexpr int TP = 256;
#pragma unroll
    for (int i = 0; i < 8; ++i) *(LAS f32x4*)(T + (wv * 8 + i) * TP + 4 * (lane ^ wv)) = rg[i];
    asm volatile("s_waitcnt lgkmcnt(0)" ::: "memory"); __builtin_amdgcn_s_barrier(); asm volatile("" ::: "memory");
    const ConvItem c = conv_decode(A, conv_id<SMALL>(it));
#pragma unroll
    for (int jj = 0; jj < 4; ++jj) { const int q = tid + 512 * jj, ch = q & 7, n = q >> 3; const LAS float* t = T + (8 * ch) * TP + (n ^ (4 * ch));
        float v[8];
#pragma unroll
        for (int i = 0; i < 8; ++i) v[i] = t[i * TP];
        if (c.kind == 1) { v2u o; o.x = pk8(v[0] * W8S, v[1] * W8S, v[2] * W8S, v[3] * W8S); o.y = pk8(v[4] * W8S, v[5] * W8S, v[6] * W8S, v[7] * W8S); *(v2u*)(c.dst + (size_t)n * c.dpitch + c.k0 + 8 * ch) = o; }
        else if (c.kind == 3) { const int f = c.n0 + n; v2u o; o.x = pk8(v[0] * W8S, v[1] * W8S, v[2] * W8S, v[3] * W8S); o.y = pk8(v[4] * W8S, v[5] * W8S, v[6] * W8S, v[7] * W8S); *(v2u*)(c.dst + (size_t)(256 * (f >> 7) + (f & 127) + c.aux) * c.dpitch + c.k0 + 8 * ch) = o; }
        else { const int g = n >> 5, row = c.kind == 2 ? 32 * (4 * (g & 1) + (g >> 1)) + (n & 31) : n; st8((bf16_t*)c.dst + (size_t)row * c.dpitch + c.k0 + 8 * ch, v); } }
    asm volatile("s_waitcnt lgkmcnt(0)" ::: "memory"); __builtin_amdgcn_s_barrier(); asm volatile("" ::: "memory");
}
template <bool SMALL = false> __device__ __forceinline__ void conv_run(KArgs A, int first, int stride, int end, LAS unsigned char* lds, int tid) {
    const int lane = tid & 63, wv = tid >> 6; LAS float* T = (LAS float*)lds;
    f32x4 rg[4][8];
#pragma unroll
    for (int d = 0; d < 4; ++d) conv_load<SMALL>(A, first + d * stride, end, rg[d], wv, lane);
    for (int it = first; it < end; it += 4 * stride) {
#pragma unroll
        for (int d = 0; d < 4; ++d) if (it + d * stride < end) {
            f32x4 t0[8];
#pragma unroll
            for (int i = 0; i < 8; ++i) t0[i] = rg[d][i];
            conv_load<SMALL>(A, it + (4 + d) * stride, end, rg[d], wv, lane);
            conv_out<SMALL>(A, it + d * stride, t0, T, d & 1, tid, wv, lane);
        }
    }
    asm volatile("s_waitcnt lgkmcnt(0)" ::: "memory"); __builtin_amdgcn_s_barrier(); asm volatile("" ::: "memory");
}
__device__ __forceinline__ void mod_item(KArgs A, int item, LAS unsigned char* lds, int tid) {
    const int lane = tid & 63, wid = tid >> 6, l = item / 96, col0 = 64 * (item % 96);
    LAS float* sil = (LAS float*)lds;
    LAS float* part = sil + 3 * 1024;
    for (int i = tid; i < 3 * 1024; i += 512) { const int r = i >> 10, k = i & 1023; const float cv = r < 2 ? A->in[I_C][r * DM + k] : A->in[I_CCTX][k]; sil[i] = siluf_(cv); }
    __syncthreads();
    const float* W = A->in[I_WMOD] + (size_t)l * DM * 6144 + col0 + lane;
    float a0 = 0.f, a1 = 0.f, a2 = 0.f;
    for (int kb = 0; kb < 4; ++kb) { float w[32];
#pragma unroll
        for (int q = 0; q < 32; ++q) w[q] = W[(size_t)(wid * 128 + kb * 32 + q) * 6144];
        __builtin_amdgcn_sched_barrier(0);
#pragma unroll
        for (int q = 0; q < 32; ++q) { const int k = wid * 128 + kb * 32 + q; a0 += sil[k] * w[q]; a1 += sil[1024 + k] * w[q]; a2 += sil[2048 + k] * w[q]; }
        __builtin_amdgcn_sched_barrier(0); }
    part[(wid * 3 + 0) * 64 + lane] = a0; part[(wid * 3 + 1) * 64 + lane] = a1; part[(wid * 3 + 2) * 64 + lane] = a2;
    __syncthreads();
    if (tid < 192) { const int r = tid >> 6, cl = tid & 63; float s = A->in[I_BMOD][(size_t)l * 6144 + col0 + cl];
#pragma unroll
        for (int w = 0; w < 8; ++w) s += part[(w * 3 + r) * 64 + cl];
        ((float*)(A->ws + WS_MOD))[((size_t)l * 3 + r) * 6144 + col0 + cl] = s; }
    __syncthreads();
}

struct Row { f32x4 v[4]; };
__device__ __forceinline__ Row row_load(const float* p, int lane) { Row r; const f32x4* q = (const f32x4*)p + lane;
#pragma unroll
    for (int j = 0; j < 4; ++j) r.v[j] = q[64 * j]; return r; }
__device__ __forceinline__ Row row_load_bf16(const bf16_t* p, int lane) { Row r; const v2u* q = (const v2u*)p + lane; v2u t[4];
#pragma unroll
    for (int j = 0; j < 4; ++j) t[j] = q[64 * j];
#pragma unroll
    for (int j = 0; j < 4; ++j) r.v[j] = (f32x4){bflo(t[j].x), bfhi(t[j].x), bflo(t[j].y), bfhi(t[j].y)};
    return r; }
__device__ __forceinline__ void row_store(float* p, const Row& r, int lane) { f32x4* q = (f32x4*)p + lane;
#pragma unroll
    for (int j = 0; j < 4; ++j) q[64 * j] = r.v[j]; }
__device__ __forceinline__ float row_rstd(const Row& r) { float s = 0.f;
#pragma unroll
    for (int j = 0; j < 4; ++j) s += (r.v[j].x * r.v[j].x + r.v[j].y * r.v[j].y) + (r.v[j].z * r.v[j].z + r.v[j].w * r.v[j].w);
    return __builtin_amdgcn_rsqf(wave_sum(s) * (1.0f / DM) + EPS); }
__device__ __forceinline__ Row row_normmod(const Row& x, float rstd, const float* g, const float* sh, const float* sc, int lane) { Row y; f32x4 gg[4], ss[4], hh[4];
#pragma unroll
    for (int j = 0; j < 4; ++j) { gg[j] = ((const f32x4*)g)[lane + 64 * j]; ss[j] = ((const f32x4*)sc)[lane + 64 * j]; hh[j] = ((const f32x4*)sh)[lane + 64 * j]; }
    __builtin_amdgcn_sched_barrier(0);
#pragma unroll
    for (int j = 0; j < 4; ++j) y.v[j] = x.v[j] * rstd * gg[j] * (ss[j] + 1.0f) + hh[j];
    return y; }
struct NormP { f32x4 a[4], h[4]; };
__device__ __forceinline__ NormP normp_load(const float* g, const float* sh, const float* sc, int lane) { NormP p; f32x4 gg[4], ss[4];
#pragma unroll
    for (int j = 0; j < 4; ++j) { gg[j] = ((const f32x4*)g)[lane + 64 * j]; ss[j] = ((const f32x4*)sc)[lane + 64 * j]; p.h[j] = ((const f32x4*)sh)[lane + 64 * j]; }
    __builtin_amdgcn_sched_barrier(0);
#pragma unroll
    for (int j = 0; j < 4; ++j) p.a[j] = gg[j] * (ss[j] + 1.0f);
    return p; }
__device__ __forceinline__ Row row_normmod_p(const Row& x, float rstd, const NormP& p) { Row y;
#pragma unroll
    for (int j = 0; j < 4; ++j) y.v[j] = x.v[j] * rstd * p.a[j] + p.h[j];
    return y; }
__device__ __forceinline__ void row_store_bf16(bf16_t* p, const Row& r, int lane) { v2u* q = (v2u*)p + lane;
#pragma unroll
    for (int j = 0; j < 4; ++j) { v2u w; w.x = cvtpk(r.v[j].x, r.v[j].y); w.y = cvtpk(r.v[j].z, r.v[j].w); q[64 * j] = w; } }
__device__ __forceinline__ void row_store_fp8(unsigned char* p, const Row& r, int lane) { unsigned* q = (unsigned*)p + lane;
#pragma unroll
    for (int j = 0; j < 4; ++j) q[64 * j] = pk8(r.v[j].x, r.v[j].y, r.v[j].z, r.v[j].w); }
__device__ __forceinline__ const float* in_row(KArgs A, int R) { const int b = R / RB, r = R % RB; return r < CTXL ? A->in[I_CTX] + ((size_t)b * CTXL + r) * DM : A->in[I_X] + ((size_t)b * SEQ + (r - CTXL)) * DM; }
__device__ __forceinline__ int mod_row(int R) { const int b = R / RB, r = R % RB; return r < CTXL ? 2 : b; }

__device__ __forceinline__ int lat_tile(int im) { return (im >> 5) * TPB + 1 + (im & 31); }
struct SchedP1 { const char* HN; const char* W; int layer, G, c;
    __device__ __forceinline__ bool next(int i, pg8::Unit& u) const {
        const int nmain = 64 * 10, nextra = layer == 0 ? 2 * 10 : 2 * 5; const int L = i * G + c; if (L >= nmain + nextra) return false;
        int pm, pq;
        if (L < nmain) { int im, in; pg8::rect_order(L, 64, 10, im, in); pm = lat_tile(im); pq = in; }
        else { const int x = L - nmain; if (layer == 0) { pm = (x / 10) * TPB; pq = x % 10; } else { pm = (x / 5) * TPB; pq = 5 + x % 5; } }
        u.pm = pm; u.pn = pq < 5 ? pq : pq + 16; u.a = HN + (size_t)pm * 256 * DM * 2; u.b = W + (size_t)pq * 256 * DM * 2; return true; } };
struct SchedP1g { const char* HN8; const char* W8; int layer, G, c;
    __device__ __forceinline__ bool next(int i, pg8::Unit& u) const {
        const int nmain = 64 * 16, nextra = layer == 0 ? 2 * 16 : 0; const int L = i * G + (G - 1 - c); if (L >= nmain + nextra) return false;
        int pm, pn;
        if (L < nmain) { int im; pg8::rect_order(L, 64, 16, im, pn); pm = lat_tile(im); }
        else { const int x = L - nmain; pm = (x >> 4) * TPB; pn = x & 15; }
        u.pm = pm; u.pn = pn; u.a = HN8 + (size_t)pm * 256 * DM; u.b = W8 + (size_t)pn * 256 * DM; return true; } };
struct SchedP3a { const char* YS; const char* WB; int layer, G, c;
    __device__ __forceinline__ bool next(int i, pg8::Unit& u) const {
        int pm, dt, n;
        if (i < 4) { if (c >= 256) return false; int im; pg8::rect_order(c, 64, 4, im, dt); pm = lat_tile(im); n = i; }
        else { if (i > 4 || layer != 0 || c >= 32) return false; pm = (c >> 4) * TPB; dt = (c >> 2) & 3; n = c & 3; }
        u.pm = pm; u.pn = dt * 4 + n; u.a = YS + ((size_t)pm * 256 * DM + 256 * n) * 2; u.b = WB + ((size_t)n * 1024 + dt * 256) * 256 * 2; return true; } };
struct SchedP3b { const char* MRG; const char* WO; int G, c;
    __device__ __forceinline__ bool next(int i, pg8::Unit& u) const {
        const int L = i * G + c; if (L >= 64 * 4) return false;
        int im, in; pg8::rect_order(L, 64, 4, im, in); const int pm = lat_tile(im);
        u.pm = pm; u.pn = in; u.a = MRG + (size_t)pm * 256 * DM * 2; u.b = WO + (size_t)in * 256 * DM * 2; return true; } };
struct SchedP3c { const char* GPC; const char* WO; int G, c;
    __device__ __forceinline__ bool next(int i, pg8::Unit& u) const {
        const int L = i * G + c; if (L >= 128) return false;
        const int pm = L >> 6, ks = (L >> 2) & 15, ct = L & 3, n = ks >> 2, kq = ks & 3;
        u.pm = pm; u.pn = ks * 4 + ct; u.a = GPC + (((size_t)n * 512 + pm * 256) * DM + kq * 256) * 2; u.b = WO + ((size_t)ct * 256 * DM + kq * 256) * 2; return true; } };
struct SchedP6 { const char* XG; const char* WGU; int RT, G, c;
    __device__ __forceinline__ bool next(int i, pg8::Unit& u) const {
        const int nM = 16 * RT; const int L = i * G + c; if (L >= nM * 16) return false;
        int im, in; pg8::rect_order(L, nM, 16, im, in); const int e = im / RT;
        u.pm = im; u.pn = in; u.a = XG + (size_t)im * 256 * DM; u.b = WGU + ((size_t)e * 4096 + in * 256) * DM; return true; } };
struct SchedP7 { const char* HID; const char* WD; int RT, G, c;
    __device__ __forceinline__ bool next(int i, pg8::Unit& u) const {
        const int nM = 16 * 8; const int L = i * G + c; if (L >= nM * 4) return false;
        int im8, in; pg8::rect_order(L, nM, 4, im8, in); const int e = im8 >> 3, im = e * RT + (im8 & 7);
        u.pm = im; u.pn = in; u.a = HID + (size_t)im * 256 * EH; u.b = WD + ((size_t)e * DM + in * 256) * EH; return true; } };
struct SchedP7c { const char* HID; const char* WD; int G, c;
    __device__ __forceinline__ bool next(int i, pg8::Unit& u) const {
        const int L = i * G + c; if (L >= 256) return false;
        const int e = L >> 4, in = (L >> 2) & 3, kq = L & 3, im = e * 9 + 8;
        u.pm = im; u.pn = in + 4 * kq; u.a = HID + (size_t)im * 256 * EH + kq * 512; u.b = WD + ((size_t)e * DM + in * 256) * EH + kq * 512; return true; } };

__device__ __forceinline__ unsigned block_excl_scan(unsigned v, LAS unsigned* wtot, int lane, int wid) {
    unsigned inc = v;
#pragma unroll
    for (int o = 1; o < 64; o <<= 1) { const unsigned t = (unsigned)__builtin_amdgcn_ds_bpermute(((lane - o) & 63) << 2, (int)inc); if (lane >= o) inc += t; }
    if (lane == 63) wtot[wid] = inc;
    __syncthreads();
    unsigned base = 0;
#pragma unroll
    for (int w = 0; w < 8; ++w) base += (w < wid) ? wtot[w] : 0u;
    __syncthreads();
    return base + inc - v;
}
__device__ __forceinline__ void topk_unit(KArgs A, int RT, bool isctx, int b, int e, LAS unsigned char* lds, int tid) {
    const int lane = tid & 63, wid = tid >> 6;
    LAS unsigned* hist = (LAS unsigned*)lds; LAS unsigned* wtot = hist + 256; LAS unsigned* sel = wtot + 16;
    const int cap = isctx ? 32 : 1024;
    const float* aff = isctx ? (const float*)(A->ws + WS_AFFC) + ((size_t)b * 16 + e) * 256 : (const float*)(A->ws + WS_AFFL) + ((size_t)b * 16 + e) * 8192;
    unsigned key[16];
    if (isctx) {
#pragma unroll
        for (int j = 0; j < 16; ++j) key[j] = 0u;
        if (tid < 256) key[0] = __float_as_uint(aff[tid]);
    } else {
#pragma unroll
        for (int q = 0; q < 4; ++q) { const f32x4 t = *(const f32x4*)(aff + tid * 16 + 4 * q); key[4 * q] = __float_as_uint(t.x); key[4 * q + 1] = __float_as_uint(t.y); key[4 * q + 2] = __float_as_uint(t.z); key[4 * q + 3] = __float_as_uint(t.w); }
    }
#define TK_VALID(j) (isctx ? ((j) == 0 && tid < 256) : true)
    unsigned pfx = 0u, need = (unsigned)cap;
    for (int pass = 0; pass < 4; ++pass) { const int shift = 24 - 8 * pass;
        for (int i = tid; i < 256; i += 512) hist[i] = 0u;
        __syncthreads();
#pragma unroll
        for (int j = 0; j < 16; ++j) if (TK_VALID(j) && (pass == 0 || (key[j] >> (shift + 8)) == pfx)) __hip_atomic_fetch_add(&hist[(key[j] >> shift) & 255u], 1u, __ATOMIC_RELAXED, __HIP_MEMORY_SCOPE_WORKGROUP);
        __syncthreads();
        if (wid == 0) {
            const unsigned h0 = hist[4 * lane], h1 = hist[4 * lane + 1], h2 = hist[4 * lane + 2], h3 = hist[4 * lane + 3], s = h0 + h1 + h2 + h3;
            unsigned incl = s;
#pragma unroll
            for (int o = 1; o < 64; o <<= 1) { const unsigned t = (unsigned)__builtin_amdgcn_ds_bpermute(((lane + o) & 63) << 2, (int)incl); if (lane + o < 64) incl += t; }
            const unsigned excl = incl - s;
            if (excl < need && need <= incl) { unsigned c = excl; int bin;
                if (c + h3 >= need) bin = 3; else { c += h3; if (c + h2 >= need) bin = 2; else { c += h2; if (c + h1 >= need) bin = 1; else { c += h1; bin = 0; } } }
                sel[0] = (unsigned)(4 * lane + bin); sel[1] = need - c; }
        }
        __syncthreads();
        pfx = (pfx << 8) | sel[0]; need = sel[1];
        __syncthreads();
    }
    const unsigned T = pfx;
    unsigned ce = 0u;
#pragma unroll
    for (int j = 0; j < 16; ++j) ce += (TK_VALID(j) && key[j] == T) ? 1u : 0u;
    unsigned re = block_excl_scan(ce, wtot, lane, wid);
    unsigned selmask = 0u, cs = 0u;
#pragma unroll
    for (int j = 0; j < 16; ++j) if (TK_VALID(j)) { bool s = key[j] > T; if (key[j] == T) { s = re < need; ++re; } if (s) { selmask |= 1u << j; ++cs; } }
    unsigned slot = block_excl_scan(cs, wtot, lane, wid);
    int* IDXROW = (int*)(A->ws + WS_IDXROW); float* SCORE = (float*)(A->ws + WS_SCORE); int* INV = (int*)(A->ws + WS_INV);
    const int ybase = e * RT * 256 + (isctx ? 2048 + b * 32 : b * 1024);
#pragma unroll
    for (int j = 0; j < 16; ++j) if (TK_VALID(j)) { const int idx = isctx ? tid : tid * 16 + j; const int R = b * RB + (isctx ? idx : CTXL + idx);
        if (selmask & (1u << j)) { const int yrow = ybase + (int)slot; IDXROW[yrow] = R; SCORE[yrow] = __uint_as_float(key[j]); INV[((size_t)b * 16 + e) * RB + (R - b * RB)] = yrow; ++slot; }
        else INV[((size_t)b * 16 + e) * RB + (R - b * RB)] = -1; }
    if (isctx && b == 0 && tid < 192) IDXROW[e * RT * 256 + 2048 + 64 + tid] = -1;
#undef TK_VALID
    __syncthreads();
}

struct AJob { const attn_body::bf16 *Q, *K, *V; attn_body::bf16* O; int nt, mode, normed; const float* kmax; };
__device__ __forceinline__ bool mixer_job(unsigned char* ws, int l, int vcu, int i, AJob& j) {
    using attn_body::bf16;
    const bf16* QKV = (const bf16*)(ws + WS_QKV); bf16* YS = (bf16*)(ws + WS_YS); j.normed = 0; j.kmax = nullptr; const float* KNB = (const float*)(ws + WS_KNB) + l * 32;
    if (i < 3) { const int b = vcu >> 7, h = (vcu >> 5) & 3, qb = vcu & 31; const long q0 = (long)b * RB + CTXL + qb * 256, k0 = (long)b * RB;
        if (i < 2) { const int vh = 2 * h + i; j.Q = QKV + q0 * PQ + C_QB + vh * 64; j.K = QKV + k0 * PQ + C_KB + vh * 64; j.V = QKV + k0 * PQ + C_VB + h * 64; j.O = YS + q0 * 1024 + 256 + h * 64; j.nt = 132; j.mode = 1 + i; j.kmax = KNB + b * 8 + vh; }
        else { j.Q = QKV + q0 * PQ + C_QD + h * 64; j.K = QKV + k0 * PQ + C_KD + (h >> 1) * 64; j.V = QKV + k0 * PQ + C_VD + (h >> 1) * 64; j.O = YS + q0 * 1024 + 768 + h * 64; j.nt = 132; j.mode = 0; j.normed = 1; }
        return true; }
    if (l != 0) return false;
    const int uc = (vcu + 256 - 132) & 255; if (uc >= 24) return false;
    const int type = uc >> 3, b = (uc >> 2) & 1, h = uc & 3, k = i - 3; const long q0 = (long)b * RB;
    j.nt = 4;
    if (type == 0) { if (k > 0) return false; j.Q = QKV + q0 * PQ + C_QA + h * 64; j.K = QKV + q0 * PQ + C_KA + h * 64; j.V = QKV + q0 * PQ + C_VA + h * 64; j.O = YS + q0 * 1024 + h * 64; j.mode = 0; return true; }
    if (type == 1) { if (k > 1) return false; const int vh = 2 * h + k; j.Q = QKV + q0 * PQ + C_QB + vh * 64; j.K = QKV + q0 * PQ + C_KB + vh * 64; j.V = QKV + q0 * PQ + C_VB + h * 64; j.O = YS + q0 * 1024 + 256 + h * 64; j.mode = 1 + k; j.kmax = KNB + b * 8 + vh; return true; }
    if (k > 0) return false; j.Q = QKV + q0 * PQ + C_QD + h * 64; j.K = QKV + q0 * PQ + C_KD + (h >> 1) * 64; j.V = QKV + q0 * PQ + C_VD + (h >> 1) * 64; j.O = YS + q0 * 1024 + 768 + h * 64; j.mode = 0; j.normed = 1; return true;
}

__global__ void __launch_bounds__(512, 2) fwd_kernel(Args A_) {
    extern __shared__ __attribute__((aligned(16))) unsigned char lds[];
    LAS unsigned char* L = (LAS unsigned char*)lds;
    const int tid0 = threadIdx.x;
    const int G0 = gridDim.x, bx0 = blockIdx.x;
    unsigned char* ws = A_.ws;
    for (int u = tid0; u < (LDS_BYTES - LDSCTL_OFF) / 4; u += 512) ((LAS unsigned*)(L + LDSCTL_OFF))[u] = 0u;
    __syncthreads();
    XcdBarrier bar; bar.bar = (unsigned*)(ws + WS_CTL) + CW_BAR + A_.li * XCD_BAR_WORDS; bar.x = 0; bar.st = nullptr;
    if (!MK_PER_PHASE) bar = xcd_barrier_post((unsigned*)(ws + WS_CTL) + CW_BAR + A_.li * XCD_BAR_WORDS, (volatile LAS unsigned*)(L + MISC_OFF) + 8);
#define PHASE_PTRS KArgs A = opaque_kargs(); unsigned char* ws = A->ws; const int G = opaque_s(G0), bx = opaque_s(bx0), vcu = (bx % 8) * (G / 8) + bx / 8, wave = __builtin_amdgcn_readfirstlane(opaque_tid() >> 6), gw = vcu * 8 + wave, NGW = G * 8; (void)gw; (void)NGW; (void)vcu; const float* MOD = (const float*)(ws + WS_MOD); bf16_t* HN = (bf16_t*)(ws + WS_HN); bf16_t* H2 = (bf16_t*)(ws + WS_H2); bf16_t* YS = (bf16_t*)(ws + WS_YS); \
    bf16_t* GT = (bf16_t*)(ws + WS_GT); bf16_t* X1 = (bf16_t*)(ws + WS_X1); bf16_t* XR = (bf16_t*)(ws + WS_XR); float* PART = (float*)(ws + WS_PART); \
    (void)MOD; (void)HN; (void)H2; (void)YS; (void)GT; (void)X1; (void)XR; (void)PART;
    const int lo = A_.ph_lo, hi = A_.ph_hi;
#ifndef DBG_MASK
#define DBG_MASK 0xffffffffu
#endif
#define PHON(k) ((DBG_MASK >> ((k) < 2 ? (k) : 2 + ((k) - 2) % 10)) & 1u)
#define IN(k) (PHON(k) && lo <= (k) && (k) < hi)
#define SEAM(k) do { if (!MK_PER_PHASE && (k) + 1 < hi) { XcdBarrier b2_ = bar; b2_.bar = (unsigned*)opaque_ptr((unsigned char*)bar.bar); xcd_barrier(b2_); } } while (0)

    if (IN(0)) { PHASE_PTRS
        const int tid = opaque_tid(), lane = tid & 63; (void)tid; (void)lane;
        for (int item = bx; item < 192; item += G) mod_item(A, item, L, tid);
        __syncthreads();
        SEAM(0);
    }
    if (IN(1)) { PHASE_PTRS
        const int tid = opaque_tid(), lane = tid & 63; (void)tid; (void)lane;
        { const int Ra = gw * 9, Rb = min(Ra + 9, NR);
          Row xn = row_load(in_row(A, min(Ra, NR - 1)), lane), xn2 = row_load(in_row(A, min(Ra + 1, NR - 1)), lane), xn3 = row_load(in_row(A, min(Ra + 2, NR - 1)), lane);
          int cur = mod_row(min(Ra, NR - 1)); NormP np; { const float* m = MOD + (size_t)cur * 6144; np = normp_load(A->in[I_N1G], m, m + 1024, lane); }
          for (int R = Ra; R < Rb; ++R) { const Row x = xn; xn = xn2; xn2 = xn3; if (R + 3 < Rb) xn3 = row_load(in_row(A, R + 3), lane);
            const int mr = mod_row(R); if (mr != cur) { const float* m = MOD + (size_t)mr * 6144; np = normp_load(A->in[I_N1G], m, m + 1024, lane); cur = mr; }
            const Row y = row_normmod_p(x, row_rstd(x), np); row_store_bf16(HN + (size_t)R * DM, y, lane); row_store_fp8(ws + WS_HN8 + (size_t)R * DM, y, lane); } }
        __syncthreads();
        conv_run<true>(A, vcu, G, DEPTH * CW_SMALL, L, tid);
        SEAM(1);
    }
    for (int l = 0; l < DEPTH; ++l) {
        const int P = 2 + 10 * l; const int RT = l == 0 ? 9 : 8;
#define LAYER_PTRS PHASE_PTRS unsigned char* wl = ws + WS_W0 + (size_t)l * W_LAYER; const float* MODL = MOD + (size_t)l * 3 * 6144; (void)wl; (void)MODL;
        if (IN(P + 0)) { LAYER_PTRS
            { SchedP1 S{(const char*)HN, (const char*)(wl + WO_WIN), l, G, bx};
              EpiInProj E{(bf16_t*)(ws + WS_QKV), GT, A->in[I_QG] + l * 64, A->in[I_KG] + l * 64, A->in[I_GATEB] + (size_t)l * 4096, (float*)(ws + WS_KNB) + l * 32};
              pg8::gemm_phase<EpiInProj, SchedP1>(L, DM, DM, DM, S, E); }
            { SchedP1g S{(const char*)(ws + WS_HN8), (const char*)(wl + WO_WING), l, G, bx}; EpiGates E{(unsigned char*)GT, A->in[I_GATEB] + (size_t)l * 4096};
              pg8::gemm8_phase<EpiGates, SchedP1g>(L, DM / 2, DM / 2, DM / 2, S, E); }
            SEAM(P + 0);
        }
        if (IN(P + 1)) { LAYER_PTRS
            const int tid = opaque_tid(), lane = tid & 63; (void)tid; (void)lane;
            float s1 = lane < 32 ? A->in[I_LQ1][l * 32 + lane] * A->in[I_LK1][l * 32 + lane] : 0.f, s2 = lane < 32 ? A->in[I_LQ2][l * 32 + lane] * A->in[I_LK2][l * 32 + lane] : 0.f;
            const float lam_init = l == 0 ? 0.2f : 0.35550906759096934f;
            const float lam = expf(wave_sum(s1)) - expf(wave_sum(s2)) + lam_init;
            const attn_body::DiffEpi de{lam, 1.0f - lam_init, A->in[I_SUBG] + l * 64};
            const float gqm = wave_max(fabsf(A->in[I_QG][l * 64 + lane])), gkm = wave_max(fabsf(A->in[I_KG][l * 64 + lane]));
            const bool gqa_nomax = __builtin_amdgcn_readfirstlane((int)(64.0f * gqm * gkm * C2A * 1.05f <= 40.0f)) != 0;
            const int cslot = vcu & 3, cbase = l * CW_LAYER + CW_SMALL + vcu * (CW_MOE / 256);
#define CONV_SEAM(k) do { if (cslot == (k)) conv_run(A, cbase, 1, cbase + CW_MOE / 256, L, opaque_tid()); } while (0)
            static_assert(CW_MOE % 256 == 0, "expert-weight items split evenly over 256 CUs");
            CONV_SEAM(0);
            AJob j;
            for (int i = 0; mixer_job(ws, l, vcu, i, j); ++i) {
                if (i == 2) CONV_SEAM(1);
                if (i == 3) CONV_SEAM(2);
                if (j.mode == 0) attn_body::attn_unit<8, 0>(j.Q, j.K, j.V, j.nt, j.O, (char*)lds, de, !(j.normed && gqa_nomax));
                else if (j.mode == 1) attn_body::attn_unit<8, 1>(j.Q, j.K, j.V, j.nt, j.O, (char*)lds, de, true, j.kmax);
                else attn_body::attn_unit<8, 2>(j.Q, j.K, j.V, j.nt, j.O, (char*)lds, de, true, j.kmax);
            }
            if (l != 0 || ((vcu + 256 - 132) & 255) >= 24) CONV_SEAM(2);
            { const int b = vcu >> 7, h = (vcu >> 5) & 3, g4 = vcu & 31;
              attn_body::na_unit(b, h, g4, (const attn_body::bf16*)(ws + WS_QKV), (attn_body::bf16*)YS, A->in[I_RPB] + ((size_t)l * 4 + h) * 465, (char*)lds, (const float*)(ws + WS_KNB) + l * 32 + 16 + b * 4 + h); }
            CONV_SEAM(3);
            const int nsgu = 128 + (l == 0 ? 4 : 0);
            if (vcu < nsgu) { const long rowbase = vcu < 128 ? (long)(vcu >> 6) * RB + CTXL + (vcu & 63) * 128 : (long)((vcu - 128) >> 1) * RB + ((vcu - 128) & 1) * 128;
                sgu_unit(rowbase, (const bf16_t*)(ws + WS_QKV) + C_GU, (const bf16_t*)(ws + WS_QKV) + C_GV, A->in[I_SGUNG] + l * 256, A->in[I_SGUW] + (size_t)l * 4 * 128 * 128, A->in[I_SGUB] + l * 4 * 128, YS, (char*)lds); }
            SEAM(P + 1);
        }
        if (IN(P + 2)) { LAYER_PTRS
            SchedP3a S{(const char*)YS, (const char*)(wl + WO_WB), l, G, bx}; EpiGateAcc E{(const unsigned char*)GT, (bf16_t*)(ws + WS_MRG), (bf16_t*)(ws + WS_GPC)};
            pg8::gemm_phase<EpiGateAcc, SchedP3a>(L, 256, DM, 256, S, E);
            SEAM(P + 2);
        }
        if (IN(P + 3)) { LAYER_PTRS
            { SchedP3b S{(const char*)(ws + WS_MRG), (const char*)(wl + WO_WO4), G, bx}; EpiOutRes E{A->in[I_X], A->in[I_CTX], XR, X1, MODL, l};
              pg8::gemm_phase<EpiOutRes, SchedP3b>(L, DM, DM, DM, S, E); }
            if (l == 0) { SchedP3c S{(const char*)(ws + WS_GPC), (const char*)(wl + WO_WO4), G, bx}; EpiPart E{PART};
              pg8::gemm_phase<EpiPart, SchedP3c>(L, 256, DM, DM, S, E); }
            SEAM(P + 3);
        }
        if (IN(P + 4)) { LAYER_PTRS
            const int tid = opaque_tid(), lane = tid & 63; (void)tid; (void)lane;
            LAS float* wrT = (LAS float*)L;
            const float* wr = A->in[I_WRT] + (size_t)l * DM * 16;
            { f32x4 wv[8];
#pragma unroll
              for (int q = 0; q < 8; ++q) wv[q] = ((const f32x4*)wr)[tid + 512 * q];
              __builtin_amdgcn_sched_barrier(0);
#pragma unroll
              for (int q = 0; q < 8; ++q) { const int i4 = tid + 512 * q, k = i4 >> 2, e0 = (i4 & 3) * 4;
#pragma unroll
                  for (int j = 0; j < 4; ++j) wrT[(e0 + j) * DM + k] = wv[q][j]; } }
            __syncthreads();
            const int nit = 8 + ((l == 0 && gw < 512) ? 1 : 0);
            Row xn; { const int i0 = gw * 8; xn = row_load_bf16(X1 + ((size_t)(i0 >> 13) * RB + CTXL + (i0 & 8191)) * DM, lane); }
            NormP np; { const float* m0 = MODL + (size_t)((gw * 8) >> 13) * 6144; np = normp_load(A->in[I_N2G] + l * DM, m0 + 3072, m0 + 4096, lane); }
            for (int it = 0; it < nit; ++it) { const int i = it < 8 ? gw * 8 + it : 16384 + gw; const bool isctx = i >= 16384; const int b = isctx ? (i - 16384) >> 8 : i >> 13, r = isctx ? (i - 16384) & 255 : CTXL + (i & 8191); const int R = b * RB + r;
                const float* m = MODL + (size_t)(isctx ? 2 : b) * 6144;
                Row x = xn;
                if (it + 1 < 8) { const int in = i + 1; xn = row_load_bf16(X1 + ((size_t)(in >> 13) * RB + CTXL + (in & 8191)) * DM, lane); }
                if (isctx) { x = row_load(in_row(A, R), lane); Row s;
#pragma unroll
                    for (int j = 0; j < 4; ++j) s.v[j] = (f32x4){0.f, 0.f, 0.f, 0.f};
                    for (int ks = 0; ks < 16; ks += 4) { Row p[4];
#pragma unroll
                        for (int q = 0; q < 4; ++q) p[q] = row_load(PART + ((size_t)(ks + q) * 512 + b * 256 + r) * DM, lane);
                        __builtin_amdgcn_sched_barrier(0);
#pragma unroll
                        for (int q = 0; q < 4; ++q)
#pragma unroll
                            for (int j = 0; j < 4; ++j) s.v[j] += p[q].v[j]; }
#pragma unroll
                    for (int j = 0; j < 4; ++j) x.v[j] += ((const f32x4*)(m + 2048))[lane + 64 * j] * s.v[j];
                    row_store_bf16(X1 + (size_t)R * DM, x, lane);
                }
                if (isctx) np = normp_load(A->in[I_N2G] + l * DM, m + 3072, m + 4096, lane);
                const Row h = row_normmod_p(x, row_rstd(x), np);
                { unsigned* hq = (unsigned*)((unsigned char*)H2 + (size_t)R * DM) + lane;
#pragma unroll
                  for (int j = 0; j < 4; ++j) hq[64 * j] = pk8(h.v[j].x, h.v[j].y, h.v[j].z, h.v[j].w); }
                float lg[16];
#pragma unroll
                for (int e = 0; e < 16; ++e) { f32x2 a2 = (f32x2){0.f, 0.f};
#pragma unroll
                    for (int j = 0; j < 4; ++j) { const f32x4 w = *(const LAS f32x4*)(wrT + e * DM + 4 * lane + 256 * j);
                        a2 = __builtin_elementwise_fma((f32x2){h.v[j].x, h.v[j].y}, (f32x2){w.x, w.y}, a2); a2 = __builtin_elementwise_fma((f32x2){h.v[j].z, h.v[j].w}, (f32x2){w.z, w.w}, a2); }
                    lg[e] = a2.x + a2.y; if ((e & 3) == 3) __builtin_amdgcn_sched_barrier(0); }
                float c8[8], d[4];
#pragma unroll
                for (int i = 0; i < 8; ++i) { auto rr = __builtin_amdgcn_permlane32_swap(__float_as_uint(lg[i]), __float_as_uint(lg[i + 8]), false, false); c8[i] = __uint_as_float(rr[0]) + __uint_as_float(rr[1]); }
#pragma unroll
                for (int i = 0; i < 4; ++i) { auto rr = __builtin_amdgcn_permlane16_swap(__float_as_uint(c8[i]), __float_as_uint(c8[i + 4]), false, false); d[i] = row16_sum(__uint_as_float(rr[0]) + __uint_as_float(rr[1])); }
                float mx = fmaxf(fmaxf(d[0], d[1]), fmaxf(d[2], d[3]));
                { auto rr = __builtin_amdgcn_permlane16_swap(__float_as_uint(mx), __float_as_uint(mx), false, false); mx = fmaxf(__uint_as_float(rr[0]), __uint_as_float(rr[1])); }
                { auto rr = __builtin_amdgcn_permlane32_swap(__float_as_uint(mx), __float_as_uint(mx), false, false); mx = fmaxf(__uint_as_float(rr[0]), __uint_as_float(rr[1])); }
#pragma unroll
                for (int i = 0; i < 4; ++i) d[i] = __expf(d[i] - mx);
                const float sum = xor32_sum(xor16_sum((d[0] + d[1]) + (d[2] + d[3])));
                const int li = lane & 15, ex = 4 * (lane >> 4) + li;
                float mine = li == 0 ? d[0] : li == 1 ? d[1] : li == 2 ? d[2] : d[3];
                mine = mine / sum;
                if (li < 4) { if (isctx) ((float*)(ws + WS_AFFC))[((size_t)b * 16 + ex) * 256 + r] = mine; else ((float*)(ws + WS_AFFL))[((size_t)b * 16 + ex) * 8192 + (r - CTXL)] = mine; }
            }
            SEAM(P + 4);
        }
        if (IN(P + 5)) { LAYER_PTRS
            const int tid = opaque_tid(), lane = tid & 63; (void)tid; (void)lane;
            const int nun = l == 0 ? 64 : 32;
            for (int u = vcu; u < nun; u += G) topk_unit(A, RT, u >= 32, (u >> 4) & 1, u & 15, L, tid);
            SEAM(P + 5);
        }
        if (IN(P + 6)) { LAYER_PTRS
            const int tid = opaque_tid(), lane = tid & 63; (void)tid; (void)lane;
            const int* IDXROW = (const int*)(ws + WS_IDXROW); unsigned char* XG = ws + WS_XG;
            const int nyr = 16 * RT * 256;
            for (int y0 = gw; y0 < nyr; y0 += 9 * NGW) { int src[9]; v4u a[9];
#pragma unroll
                for (int q = 0; q < 9; ++q) { const int y = y0 + q * NGW; src[q] = y < nyr ? IDXROW[y] : -1; }
                __builtin_amdgcn_sched_barrier(0);
#pragma unroll
                for (int q = 0; q < 9; ++q) { a[q] = (v4u){0u, 0u, 0u, 0u}; if (src[q] >= 0) a[q] = ((const v4u*)((const unsigned char*)H2 + (size_t)src[q] * DM))[lane]; }
                __builtin_amdgcn_sched_barrier(0);
#pragma unroll
                for (int q = 0; q < 9; ++q) { const int y = y0 + q * NGW; if (y < nyr) ((v4u*)(XG + (size_t)y * DM))[lane] = a[q]; } }
            SEAM(P + 6);
        }
        if (IN(P + 7)) { LAYER_PTRS
            SchedP6 S{(const char*)(ws + WS_XG), (const char*)(wl + WO_WGU), RT, G, bx}; EpiSwiGLU E{ws + WS_HID};
            pg8::gemm8_phase<EpiSwiGLU, SchedP6>(L, DM / 2, DM / 2, DM / 2, S, E);
            SEAM(P + 7);
        }
        if (IN(P + 8)) { LAYER_PTRS
            SchedP7 S{(const char*)(ws + WS_HID), (const char*)(wl + WO_WD), RT, G, bx}; EpiDown E{(bf16_t*)(ws + WS_Y), (const float*)(ws + WS_SCORE)};
            pg8::gemm8_phase<EpiDown, SchedP7>(L, EH / 2, EH / 2, EH / 2, S, E);
            if (l == 0) { SchedP7c S2{(const char*)(ws + WS_HID), (const char*)(wl + WO_WD), G, bx}; EpiDownPart E2{(bf16_t*)(ws + WS_XG), (const float*)(ws + WS_SCORE)};
              pg8::gemm8_phase<EpiDownPart, SchedP7c>(L, 256, EH / 2, EH / 2, S2, E2); }
            SEAM(P + 8);
        }
        if (IN(P + 9)) { LAYER_PTRS
            const int tid = opaque_tid(), lane = tid & 63; (void)tid; (void)lane;
            const int* INV = (const int*)(ws + WS_INV); const bf16_t* Y = (const bf16_t*)(ws + WS_Y);
#define P8_INV(R_) (lane < 16 ? INV[((size_t)((R_) / RB) * 16 + lane) * RB + (R_) % RB] : -1)
#define P8_YISSUE(INVV, W, KEEP, REST) do { unsigned mk_ = (unsigned)(__ballot((INVV) >= 0) & 0xffffull); \
                _Pragma("unroll") for (int k = 0; k < 4; ++k) { const bool have = mk_ != 0u; const int e = have ? __builtin_ctz(mk_) : 0; mk_ &= mk_ - 1u; \
                    const int yr = have ? __builtin_amdgcn_readlane((INVV), e) : 0; const v2u* yp = (const v2u*)(Y + (size_t)yr * DM) + lane; KEEP[k] = have ? 0xffffffffu : 0u;     \
                    _Pragma("unroll") for (int j = 0; j < 4; ++j) W[k][j] = yp[64 * j]; } REST = mk_; } while (0)
            Row xn; int invn, invf; v2u wn[4][4]; unsigned kn[4], restn;
#define P8_ROW(k) ((k) < 8 ? (((gw * 8 + (k)) >> 13) * RB + CTXL + ((gw * 8 + (k)) & 8191)) : ((gw >> 8) * RB + (gw & 255)))
            const int nit = 8 + ((l == 0 && gw < 512) ? 1 : 0);
            { const int R0 = P8_ROW(0); xn = row_load_bf16(X1 + (size_t)R0 * DM, lane); invn = P8_INV(R0); P8_YISSUE(invn, wn, kn, restn); const int R1 = P8_ROW(1); invf = P8_INV(R1); }
            int curm; NormP np; f32x4 g2v[4];
#define P8_PARAMS(mr_) do { const float* m_ = MODL + (size_t)(mr_) * 6144; \
                _Pragma("unroll") for (int j = 0; j < 4; ++j) g2v[j] = ((const f32x4*)(m_ + 5120))[lane + 64 * j]; \
                if (l + 1 < DEPTH) { const float* m1 = MOD + ((size_t)(l + 1) * 3 + (mr_)) * 6144; np = normp_load(A->in[I_N1G] + (l + 1) * DM, m1, m1 + 1024, lane); } \
                else { _Pragma("unroll") for (int j = 0; j < 4; ++j) { np.a[j] = ((const f32x4*)A->in[I_FG])[lane + 64 * j]; np.h[j] = np.a[j]; } } \
                __builtin_amdgcn_sched_barrier(0); } while (0)
            { curm = (gw * 8) >> 13; P8_PARAMS(curm); }
            for (int k9 = 0; k9 < nit; ++k9) { const int R = P8_ROW(k9); const int b = R / RB, r = R % RB; const bool isctx = r < CTXL;
                Row x = xn; const int myinv = invn; v2u w0[4][4]; unsigned k0[4]; unsigned msk = restn;
#pragma unroll
                for (int k = 0; k < 4; ++k) { k0[k] = kn[k];
#pragma unroll
                    for (int j = 0; j < 4; ++j) w0[k][j] = wn[k][j]; }
                if (k9 + 1 < nit) { const int Rn = P8_ROW(k9 + 1); xn = row_load_bf16(X1 + (size_t)Rn * DM, lane); invn = invf; P8_YISSUE(invn, wn, kn, restn); const int Rf = P8_ROW(min(k9 + 2, nit - 1)); invf = P8_INV(Rf); }
                if (l == 1 && isctx) continue;
                const float* m = MODL + (size_t)(isctx ? 2 : b) * 6144;
                Row s;
#pragma unroll
                for (int j = 0; j < 4; ++j) s.v[j] = (f32x4){0.f, 0.f, 0.f, 0.f};
#pragma unroll
                for (int k = 0; k < 4; ++k)
#pragma unroll
                    for (int j = 0; j < 4; ++j) s.v[j] += (f32x4){bflo(w0[k][j].x & k0[k]), bfhi(w0[k][j].x & k0[k]), bflo(w0[k][j].y & k0[k]), bfhi(w0[k][j].y & k0[k])};
                if (isctx) {
#pragma unroll
                    for (int j = 0; j < 4; ++j) s.v[j] = (f32x4){0.f, 0.f, 0.f, 0.f};
                    msk = 0u; unsigned mk = (unsigned)(__ballot(myinv >= 0) & 0xffffull); const bf16_t* YP = (const bf16_t*)(ws + WS_XG);
                    while (mk) { const int e = __builtin_ctz(mk); mk &= mk - 1u; const int yr = __builtin_amdgcn_readlane(myinv, e); const int ex = yr / 2304, rr = yr % 2304 - 2048;
                        v2u t[4][4];
#pragma unroll
                        for (int kq = 0; kq < 4; ++kq) { const v2u* yp = (const v2u*)(YP + ((size_t)(kq * 16 + ex) * 256 + rr) * DM) + lane;
#pragma unroll
                            for (int j = 0; j < 4; ++j) t[kq][j] = yp[64 * j]; }
                        __builtin_amdgcn_sched_barrier(0);
#pragma unroll
                        for (int kq = 0; kq < 4; ++kq)
#pragma unroll
                            for (int j = 0; j < 4; ++j) s.v[j] += (f32x4){bflo(t[kq][j].x), bfhi(t[kq][j].x), bflo(t[kq][j].y), bfhi(t[kq][j].y)}; } }
                while (msk) {
                    v2u w[4][4];
#pragma unroll
                    for (int k = 0; k < 4; ++k) { const bool have = msk != 0u; const int e = have ? __builtin_ctz(msk) : 0; msk &= msk - 1u; if (!have) msk = 0u;
                        const int yr = have ? __builtin_amdgcn_readlane(myinv, e) : 0;
                        const v2u* yp = (const v2u*)(Y + (size_t)yr * DM) + lane; const unsigned keep = have ? 0xffffffffu : 0u;
#pragma unroll
                        for (int j = 0; j < 4; ++j) { v2u t = yp[64 * j]; t.x &= keep; t.y &= keep; w[k][j] = t; } }
#pragma unroll
                    for (int k = 0; k < 4; ++k)
#pragma unroll
                        for (int j = 0; j < 4; ++j) s.v[j] += (f32x4){bflo(w[k][j].x), bfhi(w[k][j].x), bflo(w[k][j].y), bfhi(w[k][j].y)};
                }
                { const int mr = isctx ? 2 : b; if (mr != curm) { curm = mr; P8_PARAMS(mr); } }
#pragma unroll
                for (int j = 0; j < 4; ++j) x.v[j] += g2v[j] * s.v[j];
                const float rstd = row_rstd(x);
                if (l + 1 < DEPTH) { row_store_bf16(XR + (size_t)R * DM, x, lane);
                    const Row y = row_normmod_p(x, rstd, np); row_store_bf16(HN + (size_t)R * DM, y, lane); if (!isctx) row_store_fp8(ws + WS_HN8 + (size_t)R * DM, y, lane); }
                else { Row y;
#pragma unroll
                    for (int j = 0; j < 4; ++j) y.v[j] = x.v[j] * rstd * np.a[j];
                    row_store(A->out + ((size_t)b * SEQ + (r - CTXL)) * DM, y, lane); }
            }
            SEAM(P + 9);
        }
    }
#undef IN
#undef SEAM
}

extern "C" void kernel_launch(void* const* d_in, const int* in_sizes, int n_in, void* d_out, int out_size, void* d_ws, size_t ws_size, hipStream_t stream) {
    static int grid = 0;
    if (grid == 0) {
        if (n_in != 28 || out_size != NB * SEQ * DM || ws_size < WS_END) { fprintf(stderr, "kernel_launch: unexpected shapes (n_in %d, out %d, ws %zu < %zu)\n", n_in, out_size, ws_size, (size_t)WS_END); grid = -1; return; }
        int dev = 0, cus = 0, per_cu = 0;
        if (hipGetDevice(&dev) != hipSuccess || hipDeviceGetAttribute(&cus, hipDeviceAttributeMultiprocessorCount, dev) != hipSuccess) { grid = -1; return; }
        if (hipFuncSetAttribute((const void*)fwd_kernel, hipFuncAttributeMaxDynamicSharedMemorySize, LDS_BYTES) != hipSuccess) { fprintf(stderr, "kernel_launch: hipFuncSetAttribute failed\n"); grid = -1; return; }
        if (hipOccupancyMaxActiveBlocksPerMultiprocessor(&per_cu, (const void*)fwd_kernel, 512, LDS_BYTES) != hipSuccess || per_cu < 1) fprintf(stderr, "kernel_launch: occupancy query reports %d blocks/CU\n", per_cu);
        (void)hipGetLastError();
        if (cus != 256) { fprintf(stderr, "kernel_launch: built for 256 CUs, device has %d\n", cus); grid = -1; return; }
        grid = 256;
    }
    if (grid < 0) return;
    (void)hipMemsetAsync((char*)d_ws + WS_CTL, 0, CTL_ZERO_BYTES, stream);
    Args a{};
    for (int i = 0; i < 28; ++i) a.in[i] = (const float*)d_in[i];
    a.out = (float*)d_out; a.ws = (unsigned char*)d_ws;
#if MK_PER_PHASE
    for (int p = 0; p < NPHASE; ++p) { a.ph_lo = p; a.ph_hi = p + 1; hipLaunchKernelGGL(fwd_kernel, dim3(grid), dim3(512), LDS_BYTES, stream, a); }
#elif defined(PROBE_REPEAT)
    { const int reps[] = {PROBE_REPEAT}; const int nr = sizeof(reps) / sizeof(int); int lo = 0;
      for (int i = 0; i <= nr; ++i) { a.ph_lo = lo; a.ph_hi = i < nr ? reps[i] + 1 : NPHASE; a.li = i; hipLaunchKernelGGL(fwd_kernel, dim3(grid), dim3(512), LDS_BYTES, stream, a); if (i < nr) lo = reps[i]; } }
#else
    a.ph_lo = 0; a.ph_hi = NPHASE; hipLaunchKernelGGL(fwd_kernel, dim3(grid), dim3(512), LDS_BYTES, stream, a);
#endif
}
```

```cpp
#include <hip/hip_runtime.h>
#include <hip/hip_bf16.h>
#include <cstdio>
#include <cstdint>
#include <cmath>

#ifndef MK_PER_PHASE
#define MK_PER_PHASE 0
#endif

constexpr int DM = 1024, NB = 2, SEQ = 8192, CTXL = 256, RB = SEQ + CTXL, NR = NB * RB, DEPTH = 2;
constexpr int IN_W = 6656, NEXP = 16, EH = 2048, TPB = RB / 256  ;
constexpr float EPS = 1e-6f, LOG2E = 1.4426950408889634f;
constexpr float C2A = 0.125f * LOG2E;
constexpr float C2B = 0.17677669529663687f * LOG2E;
constexpr int NPHASE = 2 + 10 * DEPTH;

constexpr size_t MiB = 1u << 20, KiB128 = 131072;
constexpr size_t WS_CTL = 0, CTL_ZERO_BYTES = 1 * MiB;
constexpr size_t WS_MOD = 1 * MiB;
constexpr size_t WS_AFFL = 2 * MiB, WS_AFFC = 3 * MiB;
constexpr size_t WS_IDXROW = 4 * MiB, WS_SCORE = 4 * MiB + 512 * 1024, WS_INV = 5 * MiB;
constexpr size_t WS_GPC = 8 * MiB;
constexpr size_t WS_W0 = 24 * MiB, W_LAYER = 215 * MiB;
constexpr size_t WO_WING = 8 * MiB  , WO_WIN = 0  , WO_WB = 13 * MiB, WO_WO4 = 15 * MiB, WO_WGU = 23 * MiB, WO_WD = 151 * MiB;
constexpr size_t WS_HN = 454 * MiB;
constexpr size_t WS_QKV = 487 * MiB;
constexpr int PQ = 3136;
constexpr int C_QA = 0, C_KA = 256, C_VA = 512, C_QB = 768, C_KB = 1280, C_VB = 1792, C_QD = 2048, C_KD = 2304, C_VD = 2432, C_GU = 2560, C_GV = 2816;
constexpr size_t WS_Y = WS_QKV;
constexpr size_t WS_KNB = 512 * 1024;
constexpr size_t WS_GT = 589 * MiB;
constexpr size_t WS_YS = 721 * MiB;
constexpr size_t WS_HID = WS_GT;
constexpr size_t WS_X1 = 754 * MiB, WS_XR = 820 * MiB, WS_H2 = 886 * MiB, WS_XG = 919 * MiB, WS_MRG = WS_H2, WS_PART = WS_XG  , WS_HN8 = 991 * MiB  , WS_END = 1008 * MiB;
static_assert(WS_QKV + (size_t)NR * PQ * 2 <= WS_GT && WS_Y + (size_t)16 * 9 * 256 * 1024 * 2 <= WS_GT && WS_HID + (size_t)16 * 9 * 256 * 2048 * 2 <= WS_X1 && WS_YS + (size_t)NR * 1024 * 2 <= WS_X1, "ws map");

constexpr int CW_BAR = 4096;

constexpr int RING_BYTES = 131072, LDSCTL_OFF = RING_BYTES, MISC_OFF = LDSCTL_OFF + 320, LDS_BYTES = 147456;

#define GAS __attribute__((address_space(1)))
#define LAS __attribute__((address_space(3)))
typedef unsigned short bf16_t;
typedef unsigned v4u __attribute__((ext_vector_type(4)));
typedef unsigned v2u __attribute__((ext_vector_type(2)));
typedef float f32x4 __attribute__((ext_vector_type(4)));
typedef float f32x2 __attribute__((ext_vector_type(2)));
typedef float f32x16 __attribute__((ext_vector_type(16)));
typedef short bf16x8 __attribute__((ext_vector_type(8)));
typedef short s16x4 __attribute__((ext_vector_type(4)));
typedef __bf16 bf16x2_t __attribute__((ext_vector_type(2)));
#define RLX_AGENT __ATOMIC_RELAXED, __HIP_MEMORY_SCOPE_AGENT
#define LDS_WAIT() asm volatile("s_waitcnt lgkmcnt(0)" ::: "memory")
#define VM_WAIT() asm volatile("s_waitcnt vmcnt(0)" ::: "memory")

__device__ __forceinline__ int opaque_tid() { int t = threadIdx.x; asm volatile("" : "+v"(t)); return t; }
__device__ __forceinline__ int opaque_s(int v) { asm volatile("" : "+s"(v)); return v; }
__device__ __forceinline__ unsigned char* opaque_ptr(unsigned char* p) { asm volatile("" : "+s"(p)); return p; }
__device__ __forceinline__ unsigned cvtpk(float lo, float hi) { f32x2 v = {lo, hi}; bf16x2_t b = __builtin_convertvector(v, bf16x2_t); return __builtin_bit_cast(unsigned, b); }
__device__ __forceinline__ float bflo(unsigned w) { return __uint_as_float(w << 16); }
__device__ __forceinline__ float bfhi(unsigned w) { return __uint_as_float(w & 0xffff0000u); }
__device__ __forceinline__ float bf2f(bf16_t h) { return __uint_as_float((unsigned)h << 16); }
__device__ __forceinline__ bf16_t f2bf(float f) { return (bf16_t)(cvtpk(f, 0.f) & 0xffffu); }
__device__ __forceinline__ float sigmoidf_(float x) { return __builtin_amdgcn_rcpf(1.0f + __builtin_amdgcn_exp2f(-x * LOG2E)); }
__device__ __forceinline__ float siluf_(float x) { return x * sigmoidf_(x); }
__device__ __forceinline__ float gelu_tanh(float x) { const float z = 0.7978845608028654f * (x + 0.044715f * x * x * x); return x * __builtin_amdgcn_rcpf(1.0f + __builtin_amdgcn_exp2f(-2.0f * LOG2E * z)); }
template <int CTRL> __device__ __forceinline__ float dpp_f(float v) { return __builtin_bit_cast(float, __builtin_amdgcn_update_dpp(0, __builtin_bit_cast(int, v), CTRL, 0xf, 0xf, true)); }
__device__ __forceinline__ float row16_sum(float v) { v += dpp_f<0xB1>(v); v += dpp_f<0x4E>(v); v += dpp_f<0x141>(v); v += dpp_f<0x140>(v); return v; }
__device__ __forceinline__ float xor16_sum(float v) { auto rr = __builtin_amdgcn_permlane16_swap(__float_as_uint(v), __float_as_uint(v), false, false); return __uint_as_float(rr[0]) + __uint_as_float(rr[1]); }
__device__ __forceinline__ float xor32_sum(float v) { auto rr = __builtin_amdgcn_permlane32_swap(__float_as_uint(v), __float_as_uint(v), false, false); return __uint_as_float(rr[0]) + __uint_as_float(rr[1]); }
__device__ __forceinline__ float half32_sum(float v) { return xor16_sum(row16_sum(v)); }
__device__ __forceinline__ float wave_sum(float v) { return xor32_sum(xor16_sum(row16_sum(v))); }
__device__ __forceinline__ float wave_max(float v) { v = fmaxf(v, dpp_f<0xB1>(v)); v = fmaxf(v, dpp_f<0x4E>(v)); v = fmaxf(v, dpp_f<0x141>(v)); v = fmaxf(v, dpp_f<0x140>(v));
    { auto rr = __builtin_amdgcn_permlane16_swap(__float_as_uint(v), __float_as_uint(v), false, false); v = fmaxf(__uint_as_float(rr[0]), __uint_as_float(rr[1])); }
    { auto rr = __builtin_amdgcn_permlane32_swap(__float_as_uint(v), __float_as_uint(v), false, false); v = fmaxf(__uint_as_float(rr[0]), __uint_as_float(rr[1])); } return v; }
__device__ __forceinline__ unsigned pk8(float a, float b, float c, float d) { unsigned w = 0u; w = __builtin_amdgcn_cvt_pk_fp8_f32(a, b, w, false); w = __builtin_amdgcn_cvt_pk_fp8_f32(c, d, w, true); return w; }
__device__ __forceinline__ void st8(bf16_t* p, const float* v) { v4u w; w.x = cvtpk(v[0], v[1]); w.y = cvtpk(v[2], v[3]); w.z = cvtpk(v[4], v[5]); w.w = cvtpk(v[6], v[7]); *(v4u*)p = w; }

__device__ const float INV16R[16] = {0.15915494309189535f, 0.08949940160889101f, 0.050329212104487035f, 0.0283021958306234f, 0.015915494309189534f, 0.008949940160889102f, 0.005032921210448704f, 0.00283021958306234f,
                                     0.0015915494309189536f, 0.0008949940160889102f, 0.0005032921210448703f, 0.00028302195830623395f, 0.00015915494309189535f, 8.949940160889102e-05f, 5.0329212104487035e-05f, 2.8302195830623396e-05f};
__device__ const float INV8R[8] = {0.15915494309189535f, 0.050329212104487035f, 0.015915494309189534f, 0.005032921210448704f, 0.0015915494309189536f, 0.0005032921210448703f, 0.00015915494309189535f, 5.0329212104487035e-05f};
__device__ __forceinline__ void sincos_rev(float rev, float& s, float& c) { const float f = __builtin_amdgcn_fractf(rev); s = __builtin_amdgcn_sinf(f); c = __builtin_amdgcn_cosf(f); }

namespace pg8 {
#define PG8_LAS __attribute__((address_space(3)))
constexpr int BM = 256, BK = 64, HALF = 128, HTB = HALF * BK * 2, STAGE_BYTES = 8 * HTB, NXCD = 8, WGM = 8;
__host__ __device__ __forceinline__ int lds_byte(int r, int c) { const int st = (r >> 4) * 2 + (c >> 5), rr = r & 15, cc = c & 31, ob = rr * 64 + cc * 2; return st * 1024 + (ob ^ (((ob >> 9) & 1) << 5)); }
__host__ __device__ __forceinline__ void stage_rc(int b, int& R, int& C) { const int st = b / 1024, sb = b % 1024, swz = sb ^ (((sb >> 9) & 1) << 5); R = (st >> 1) * 16 + swz / 64; C = (st & 1) * 32 + (swz % 64) / 2; }
__host__ __device__ __forceinline__ int perm32(int rho) { const int n = rho >> 4, i = rho & 15; return 8 * (i >> 2) + 4 * n + (i & 3); }

struct Unit { int pm, pn; const char* a; const char* b; };
__device__ __forceinline__ const char* uptr(const char* p) { const unsigned long long v = (unsigned long long)p; const unsigned lo = __builtin_amdgcn_readfirstlane((unsigned)v), hi = __builtin_amdgcn_readfirstlane((unsigned)(v >> 32)); return (const char*)(((unsigned long long)hi << 32) | lo); }
__device__ __forceinline__ void uunit(Unit& u) { u.pm = __builtin_amdgcn_readfirstlane(u.pm); u.pn = __builtin_amdgcn_readfirstlane(u.pn); u.a = uptr(u.a); u.b = uptr(u.b); }

typedef int v8i __attribute__((ext_vector_type(8)));
__device__ __forceinline__ void glds16s(const char* sbase, unsigned voff, unsigned lds_dst) { unsigned keep;
    asm volatile("s_mov_b32 %0, m0\n\ts_mov_b32 m0, %3\n\ts_nop 0\n\tglobal_load_lds_dwordx4 %1, %2\n\ts_mov_b32 m0, %0" : "=&s"(keep) : "v"(voff), "s"(sbase), "s"(lds_dst) : "memory"); }
__device__ __forceinline__ void rect_order(int L, int nM, int nN, int& im, int& in) {
    const int nwg = nM * nN; int wgid = L; { const int q = nwg / NXCD, r = nwg % NXCD, xcd = wgid % NXCD, off = wgid / NXCD; wgid = (xcd < r ? xcd * (q + 1) : r * (q + 1) + (xcd - r) * q) + off; }
    const int nig = WGM * nN, gid = wgid / nig, fm = gid * WGM, gsz = (nM - fm) < WGM ? (nM - fm) : WGM;
    im = fm + ((wgid % nig) % gsz); in = (wgid % nig) / gsz;
}

template <class Epi, class Sched>
__device__ __forceinline__ void gemm_phase(PG8_LAS unsigned char* lds, const int K, const int lda, const int ldb, const Sched& S, const Epi& E) {
    const int tid = opaque_tid(), wid = __builtin_amdgcn_readfirstlane(tid >> 6), lane = tid & 63, wr = wid >> 2, wc = wid & 3, fr = lane & 15, fq = lane >> 4;
    const int nt = K / BK;
    unsigned voffA[2], voffB[2];
#pragma unroll
    for (int i = 0; i < 2; ++i) { int R, C; stage_rc(tid * 16 + i * 8192, R, C); const int Rb = Epi::PERM ? ((R & ~31) + perm32(R & 31)) : R;
        voffA[i] = (unsigned)(R * lda + C) * 2u; voffB[i] = (unsigned)(Rb * ldb + C) * 2u; }
    const size_t kstep = (size_t)(BK * 2);
    const size_t hA = (size_t)HALF * lda * 2, hB = (size_t)HALF * ldb * 2;
    const unsigned ldsw = (unsigned)wid * 1024u, ldsbase = (unsigned)(size_t)lds;
    const int aoff = lds_byte(wr * 64 + fr, fq * 8), boff = lds_byte(wc * 32 + fr, fq * 8);
#define PG8_SA(b, h) (((b) * 2 + (h)) * HTB)
#define PG8_SB(b, h) ((4 + (b) * 2 + (h)) * HTB)
#define PG8_STAGE(bufoff, gbase, voff) do { _Pragma("unroll") for (int _i = 0; _i < 2; ++_i) \
        glds16s(uptr((const char*)(gbase)), (voff)[_i], (unsigned)__builtin_amdgcn_readfirstlane(ldsbase + (unsigned)(bufoff) + ldsw + _i * 8192u)); } while (0)
#define PG8_LDA(dst, b, h) do { _Pragma("unroll") for (int m = 0; m < 4; ++m) _Pragma("unroll") for (int k = 0; k < 2; ++k) dst[m][k] = *(const PG8_LAS bf16x8*)(lds + PG8_SA(b, h) + aoff + m * 2048 + k * 1024); } while (0)
#define PG8_LDB(dst, b, h) do { _Pragma("unroll") for (int n = 0; n < 2; ++n) _Pragma("unroll") for (int k = 0; k < 2; ++k) dst[n][k] = *(const PG8_LAS bf16x8*)(lds + PG8_SB(b, h) + boff + n * 2048 + k * 1024); } while (0)
#define PG8_MMA(ai, bj, At, Bt) do { __builtin_amdgcn_s_setprio(1); _Pragma("unroll") for (int m = 0; m < 4; ++m) _Pragma("unroll") for (int n = 0; n < 2; ++n) _Pragma("unroll") for (int k = 0; k < 2; ++k) \
        acc[ai][bj][m][n] = __builtin_amdgcn_mfma_f32_16x16x32_bf16(Bt[n][k], At[m][k], acc[ai][bj][m][n], 0, 0, 0); __builtin_amdgcn_s_setprio(0); } while (0)
#define PG8_WAIT_V(n) asm volatile("s_waitcnt vmcnt(" #n ")" ::: "memory")
#define PG8_WAIT_L(n) asm volatile("s_waitcnt lgkmcnt(" #n ")" ::: "memory")
#define PG8_BAR __builtin_amdgcn_s_barrier()
#define PG8_SCHED __builtin_amdgcn_sched_barrier(0)
    Unit cur, nxt; int ui = 0;
    if (!S.next(0, cur)) return;
    uunit(cur);
    f32x4 acc[2][2][4][2];
#pragma unroll
    for (int a = 0; a < 2; ++a)
#pragma unroll
        for (int b = 0; b < 2; ++b)
#pragma unroll
            for (int m = 0; m < 4; ++m)
#pragma unroll
                for (int n = 0; n < 2; ++n) acc[a][b][m][n] = (f32x4){0.f, 0.f, 0.f, 0.f};
    bf16x8 At[4][2], B0[2][2], B1[2][2];
    const char* cA = cur.a; const char* cB = cur.b;
    PG8_STAGE(PG8_SB(0, 0), cB, voffB); PG8_STAGE(PG8_SB(0, 1), cB + hB, voffB); PG8_STAGE(PG8_SA(0, 0), cA, voffA); PG8_STAGE(PG8_SA(0, 1), cA + hA, voffA);
    if (wr == 1) PG8_BAR;
    PG8_WAIT_V(2); PG8_BAR;
    PG8_STAGE(PG8_SB(1, 0), cB + kstep, voffB); PG8_STAGE(PG8_SA(1, 0), cA + kstep, voffA); PG8_STAGE(PG8_SB(1, 1), cB + hB + kstep, voffB);
    PG8_WAIT_V(6); PG8_BAR;
    for (;;) {
        const bool has_next = S.next(ui + 1, nxt); if (has_next) uunit(nxt);
        const char* nA = has_next ? nxt.a : cA; const char* nB = has_next ? nxt.b : cB;
        for (int t = 0; t < nt; t += 2) {
            const bool last = (t == nt - 2);
            const char* a1 = cA + (size_t)(t + 1) * kstep;
            const char* a2 = last ? nA : cA + (size_t)(t + 2) * kstep; const char* b2 = last ? nB : cB + (size_t)(t + 2) * kstep;
            const char* a3 = a2 + kstep; const char* b3 = b2 + kstep;
            PG8_LDB(B0, 0, 0); PG8_LDB(B1, 0, 1); PG8_SCHED; PG8_LDA(At, 0, 0); PG8_STAGE(PG8_SA(1, 1), a1 + hA, voffA);
            PG8_WAIT_V(8); PG8_WAIT_L(0); PG8_BAR; PG8_MMA(0, 0, At, B0); PG8_MMA(0, 1, At, B1); PG8_BAR; PG8_SCHED;
            PG8_LDA(At, 0, 1); PG8_STAGE(PG8_SB(0, 0), b2, voffB); PG8_STAGE(PG8_SB(0, 1), b2 + hB, voffB); PG8_STAGE(PG8_SA(0, 0), a2, voffA);
            PG8_WAIT_V(8); PG8_WAIT_L(0); PG8_BAR; PG8_MMA(1, 0, At, B0); PG8_MMA(1, 1, At, B1); PG8_BAR; PG8_SCHED;
            PG8_LDB(B0, 1, 0); PG8_LDB(B1, 1, 1); PG8_SCHED; PG8_LDA(At, 1, 0); PG8_STAGE(PG8_SA(0, 1), a2 + hA, voffA);
            PG8_WAIT_V(8); PG8_WAIT_L(0); PG8_BAR; PG8_MMA(0, 0, At, B0); PG8_MMA(0, 1, At, B1); PG8_BAR; PG8_SCHED;
            PG8_LDA(At, 1, 1); PG8_STAGE(PG8_SB(1, 0), b3, voffB); PG8_STAGE(PG8_SB(1, 1), b3 + hB, voffB); PG8_STAGE(PG8_SA(1, 0), a3, voffA);
            PG8_WAIT_V(8); PG8_WAIT_L(0); PG8_BAR; PG8_MMA(1, 0, At, B0); PG8_MMA(1, 1, At, B1); PG8_BAR; PG8_SCHED;
        }
        if (wr == 0) PG8_BAR;
        { const int t2 = opaque_tid(), l2 = t2 & 63; E(acc, cur, wr, wc, l2 & 15, l2 >> 4); }
        if (!has_next) break;
        if (!Epi::keep_acc(cur)) {
#pragma unroll
        for (int a = 0; a < 2; ++a)
#pragma unroll
            for (int b = 0; b < 2; ++b)
#pragma unroll
                for (int m = 0; m < 4; ++m)
#pragma unroll
                    for (int n = 0; n < 2; ++n) acc[a][b][m][n] = (f32x4){0.f, 0.f, 0.f, 0.f};
        }
        cur = nxt; cA = nA; cB = nB; ++ui;
        if (wr == 1) PG8_BAR;
    }
    PG8_WAIT_V(0);
    PG8_BAR;
#undef PG8_SA
#undef PG8_SB
#undef PG8_STAGE
#undef PG8_LDA
#undef PG8_LDB
#undef PG8_MMA
#undef PG8_WAIT_V
#undef PG8_WAIT_L
#undef PG8_BAR
#undef PG8_SCHED
}
template <class Epi, class Sched>
__device__ __forceinline__ void gemm8_phase(PG8_LAS unsigned char* lds, const int K, const int lda, const int ldb, const Sched& S, const Epi& E) {
    const int tid = opaque_tid(), wid = __builtin_amdgcn_readfirstlane(tid >> 6), lane = tid & 63, wr = wid >> 2, wc = wid & 3, fr = lane & 15, fq = lane >> 4;
    const int nt = opaque_s(K / BK);
    unsigned voffA[2], voffB[2];
#pragma unroll
    for (int i = 0; i < 2; ++i) { int R, C; stage_rc(tid * 16 + i * 8192, R, C); const int Rb = Epi::PERM ? ((R & ~31) + perm32(R & 31)) : R;
        voffA[i] = (unsigned)(R * lda + C) * 2u; voffB[i] = (unsigned)(Rb * ldb + C) * 2u; }
    const size_t kstep = (size_t)(BK * 2);
    const size_t hA = (size_t)HALF * lda * 2, hB = (size_t)HALF * ldb * 2;
    const unsigned ldsw = (unsigned)wid * 1024u, ldsbase = (unsigned)(size_t)lds;
    const int fcol = (fq >> 1) * 32 + (fq & 1) * 16;
    const int aoff = lds_byte(wr * 64 + fr, fcol), boff = lds_byte(wc * 32 + fr, fcol);
#define PG8_SA(b, h) (((b) * 2 + (h)) * HTB)
#define PG8_SB(b, h) ((4 + (b) * 2 + (h)) * HTB)
#define PG8_STAGE(bufoff, gbase, voff) do { _Pragma("unroll") for (int _i = 0; _i < 2; ++_i) \
        glds16s(uptr((const char*)(gbase)), (voff)[_i], (unsigned)__builtin_amdgcn_readfirstlane(ldsbase + (unsigned)(bufoff) + ldsw + _i * 8192u)); } while (0)
#define PG8_LDA(dst, b, h) do { _Pragma("unroll") for (int m = 0; m < 4; ++m) { const v4u lo_ = *(const PG8_LAS v4u*)(lds + PG8_SA(b, h) + aoff + m * 2048), hi_ = *(const PG8_LAS v4u*)(lds + PG8_SA(b, h) + aoff + m * 2048 + 16); dst[m] = (v8i){(int)lo_.x, (int)lo_.y, (int)lo_.z, (int)lo_.w, (int)hi_.x, (int)hi_.y, (int)hi_.z, (int)hi_.w}; } } while (0)
#define PG8_LDB(dst, b, h) do { _Pragma("unroll") for (int n = 0; n < 2; ++n) { const v4u lo_ = *(const PG8_LAS v4u*)(lds + PG8_SB(b, h) + boff + n * 2048), hi_ = *(const PG8_LAS v4u*)(lds + PG8_SB(b, h) + boff + n * 2048 + 16); dst[n] = (v8i){(int)lo_.x, (int)lo_.y, (int)lo_.z, (int)lo_.w, (int)hi_.x, (int)hi_.y, (int)hi_.z, (int)hi_.w}; } } while (0)
#define PG8_MMA(ai, bj, At, Bt) do { __builtin_amdgcn_s_setprio(1); _Pragma("unroll") for (int m = 0; m < 4; ++m) _Pragma("unroll") for (int n = 0; n < 2; ++n) \
        acc[ai][bj][m][n] = __builtin_amdgcn_mfma_scale_f32_16x16x128_f8f6f4(Bt[n], At[m], acc[ai][bj][m][n], 0, 0, 0, 0, 0, 0);     __builtin_amdgcn_s_setprio(0); } while (0)
#define PG8_WAIT_V(n) asm volatile("s_waitcnt vmcnt(" #n ")" ::: "memory")
#define PG8_WAIT_L(n) asm volatile("s_waitcnt lgkmcnt(" #n ")" ::: "memory")
#define PG8_BAR __builtin_amdgcn_s_barrier()
#define PG8_SCHED __builtin_amdgcn_sched_barrier(0)
    Unit cur, nxt; int ui = 0;
    if (!S.next(0, cur)) return;
    uunit(cur);
    f32x4 acc[2][2][4][2];
#pragma unroll
    for (int a = 0; a < 2; ++a)
#pragma unroll
        for (int b = 0; b < 2; ++b)
#pragma unroll
            for (int m = 0; m < 4; ++m)
#pragma unroll
                for (int n = 0; n < 2; ++n) acc[a][b][m][n] = (f32x4){0.f, 0.f, 0.f, 0.f};
    v8i At[4], B0[2], B1[2];
    const char* cA = cur.a; const char* cB = cur.b;
    PG8_STAGE(PG8_SB(0, 0), cB, voffB); PG8_STAGE(PG8_SB(0, 1), cB + hB, voffB); PG8_STAGE(PG8_SA(0, 0), cA, voffA); PG8_STAGE(PG8_SA(0, 1), cA + hA, voffA);
    if (wr == 1) PG8_BAR;
    PG8_WAIT_V(2); PG8_BAR;
    PG8_STAGE(PG8_SB(1, 0), cB + kstep, voffB); PG8_STAGE(PG8_SA(1, 0), cA + kstep, voffA); PG8_STAGE(PG8_SB(1, 1), cB + hB + kstep, voffB);
    PG8_WAIT_V(6); PG8_BAR;
    for (;;) {
        const bool has_next = S.next(ui + 1, nxt); if (has_next) uunit(nxt);
        const char* nA = has_next ? nxt.a : cA; const char* nB = has_next ? nxt.b : cB;
#pragma nounroll
        for (int t = 0; t < nt; t += 2) {
            const bool last = (t == nt - 2);
            const char* a1 = cA + (size_t)(t + 1) * kstep;
            const char* a2 = last ? nA : cA + (size_t)(t + 2) * kstep; const char* b2 = last ? nB : cB + (size_t)(t + 2) * kstep;
            const char* a3 = a2 + kstep; const char* b3 = b2 + kstep;
            PG8_LDB(B0, 0, 0); PG8_LDB(B1, 0, 1); PG8_SCHED; PG8_LDA(At, 0, 0); PG8_STAGE(PG8_SA(1, 1), a1 + hA, voffA);
            PG8_WAIT_V(8); PG8_WAIT_L(0); PG8_BAR; PG8_MMA(0, 0, At, B0); PG8_MMA(0, 1, At, B1); PG8_BAR; PG8_SCHED;
            PG8_LDA(At, 0, 1); PG8_STAGE(PG8_SB(0, 0), b2, voffB); PG8_STAGE(PG8_SB(0, 1), b2 + hB, voffB); PG8_STAGE(PG8_SA(0, 0), a2, voffA);
            PG8_WAIT_V(8); PG8_WAIT_L(0); PG8_BAR; PG8_MMA(1, 0, At, B0); PG8_MMA(1, 1, At, B1); PG8_BAR; PG8_SCHED;
            PG8_LDB(B0, 1, 0); PG8_LDB(B1, 1, 1); PG8_SCHED; PG8_LDA(At, 1, 0); PG8_STAGE(PG8_SA(0, 1), a2 + hA, voffA);
            PG8_WAIT_V(8); PG8_WAIT_L(0); PG8_BAR; PG8_MMA(0, 0, At, B0); PG8_MMA(0, 1, At, B1); PG8_BAR; PG8_SCHED;
            PG8_LDA(At, 1, 1); PG8_STAGE(PG8_SB(1, 0), b3, voffB); PG8_STAGE(PG8_SB(1, 1), b3 + hB, voffB); PG8_STAGE(PG8_SA(1, 0), a3, voffA);
            PG8_WAIT_V(8); PG8_WAIT_L(0); PG8_BAR; PG8_MMA(1, 0, At, B0); PG8_MMA(1, 1, At, B1); PG8_BAR; PG8_SCHED;
        }
        if (wr == 0) PG8_BAR;
        { const int t2 = opaque_tid(), l2 = t2 & 63; E(acc, cur, wr, wc, l2 & 15, l2 >> 4); }
        if (!has_next) break;
#pragma unroll
        for (int a = 0; a < 2; ++a)
#pragma unroll
            for (int b = 0; b < 2; ++b)
#pragma unroll
                for (int m = 0; m < 4; ++m)
#pragma unroll
                    for (int n = 0; n < 2; ++n) acc[a][b][m][n] = (f32x4){0.f, 0.f, 0.f, 0.f};
        cur = nxt; cA = nA; cB = nB; ++ui;
        if (wr == 1) PG8_BAR;
    }
    PG8_WAIT_V(0);
    PG8_BAR;
#undef PG8_SA
#undef PG8_SB
#undef PG8_STAGE
#undef PG8_LDA
#undef PG8_LDB
#undef PG8_MMA
#undef PG8_WAIT_V
#undef PG8_WAIT_L
#undef PG8_BAR
#undef PG8_SCHED
}
}

constexpr float W8S = 32.0f, W8I = 1.0f / 32.0f;
struct ModPtrs { const float* mod; };

struct EpiInProj {
    static constexpr bool PERM = true;
    static __device__ __forceinline__ bool keep_acc(const pg8::Unit&) { return false; }
    bf16_t *QKV, *GT;
    const float *q_gain, *k_gain, *gate_b; float* KNB;
    __device__ __forceinline__ void operator()(const f32x4 (&acc)[2][2][4][2], const pg8::Unit& u, int wr, int wc, int fr, int fq) const {
        const int pn = u.pn, pm = u.pm, jt = pm % TPB; const bool isctx = (jt == 0); const int t0 = (jt - 1) * 256;
        const int cb = 64 * wc + 8 * fq;
        const int rit0 = 64 * wr + fr;
        bf16_t* qrow = QKV + ((size_t)pm * 256 + rit0) * PQ;
#define ROWLOOP _Pragma("unroll") for (int ai = 0; ai < 2; ++ai) _Pragma("unroll") for (int m = 0; m < 4; ++m)
#define ROWVARS const int rit = 128 * ai + 16 * m + rit0; bf16_t* orow = qrow + (size_t)(128 * ai + 16 * m) * PQ; \
        float v[2][8]; _Pragma("unroll") for (int bj = 0; bj < 2; ++bj) _Pragma("unroll") for (int n = 0; n < 2; ++n) _Pragma("unroll") for (int j = 0; j < 4; ++j) v[bj][4 * n + j] = acc[ai][bj][m][n][j];
#define ROWEND __builtin_amdgcn_sched_barrier(0);
        if (pn == 0 || pn == 21 || pn == 22 || pn == 24) {
            const int oc = (pn == 0 ? C_QA : pn == 21 ? C_KA : pn == 22 ? C_VA : C_VB) + cb; const float sc = pn == 0 ? C2A : 1.0f;
            float kn2a = 0.f;
            ROWLOOP { ROWVARS
                if (pn == 21) { float ss = 0.f;
#pragma unroll
                    for (int bj = 0; bj < 2; ++bj)
#pragma unroll
                        for (int j = 0; j < 8; ++j) ss += v[bj][j] * v[bj][j];
                    kn2a = fmaxf(kn2a, xor32_sum(xor16_sum(ss))); }
#pragma unroll
                for (int bj = 0; bj < 2; ++bj) {
#pragma unroll
                    for (int j = 0; j < 8; ++j) v[bj][j] *= sc;
                    st8(orow + oc + 32 * bj, v[bj]); }
                ROWEND }
            if (pn == 21) { float mxv = kn2a; mxv = fmaxf(mxv, dpp_f<0xB1>(mxv)); mxv = fmaxf(mxv, dpp_f<0x4E>(mxv)); mxv = fmaxf(mxv, dpp_f<0x141>(mxv)); mxv = fmaxf(mxv, dpp_f<0x140>(mxv));
                if ((fr | fq) == 0) atomicMax((unsigned*)(KNB + 16 + (pm / TPB) * 4 + wc), __float_as_uint(sqrtf(mxv))); }
        } else if (pn == 3 || pn == 4) {
            const int oc = (pn == 3 ? C_GU : C_GV) + cb;
            ROWLOOP { ROWVARS
#pragma unroll
                for (int bj = 0; bj < 2; ++bj) {
#pragma unroll
                    for (int j = 0; j < 8; ++j) v[bj][j] = gelu_tanh(v[bj][j]);
                    st8(orow + oc + 32 * bj, v[bj]); }
                ROWEND }
        } else if (pn == 1 || pn == 23) {
            const int oc = (pn == 1 ? C_QB : C_KB) + 128 * wc + 8 * fq; const float sc = pn == 1 ? C2B : 1.0f;
            const f32x4 inv = *(const f32x4*)(INV8R + 4 * (fq & 1));
            const float zz[8] = {0.f, 0.f, 0.f, 0.f, 0.f, 0.f, 0.f, 0.f};
            float kn2[2] = {0.f, 0.f};
            ROWLOOP { ROWVARS
                if (pn == 23) {
#pragma unroll
                    for (int bj = 0; bj < 2; ++bj) { float ss = 0.f;
#pragma unroll
                        for (int j = 0; j < 8; ++j) ss += v[bj][j] * v[bj][j];
                        kn2[bj] = fmaxf(kn2[bj], xor32_sum(xor16_sum(ss))); } }
                const int t = t0 + rit; const float pos = (float)((fq < 2) ? (t >> 6) : (t & 63));
                float sn[4], cs[4];
#pragma unroll
                for (int p = 0; p < 4; ++p) { if (isctx) { sn[p] = 0.f; cs[p] = 1.f; } else sincos_rev(pos * inv[p], sn[p], cs[p]); }
#pragma unroll
                for (int bj = 0; bj < 2; ++bj) {
                    float o[8];
#pragma unroll
                    for (int p = 0; p < 4; ++p) { const float x0 = v[bj][2 * p], x1 = v[bj][2 * p + 1]; o[2 * p] = (x0 * cs[p] - x1 * sn[p]) * sc; o[2 * p + 1] = (x0 * sn[p] + x1 * cs[p]) * sc; }
                    st8(orow + oc + 64 * bj, o); st8(orow + oc + 64 * bj + 32, zz); }
                ROWEND }
            if (pn == 23) {
#pragma unroll
                for (int bj = 0; bj < 2; ++bj) { float mxv = kn2[bj]; mxv = fmaxf(mxv, dpp_f<0xB1>(mxv)); mxv = fmaxf(mxv, dpp_f<0x4E>(mxv)); mxv = fmaxf(mxv, dpp_f<0x141>(mxv)); mxv = fmaxf(mxv, dpp_f<0x140>(mxv));
                    if ((fr | fq) == 0) atomicMax((unsigned*)(KNB + (pm / TPB) * 8 + 2 * wc + bj), __float_as_uint(sqrtf(mxv))); } }
        } else {
            if (pn == 25 && wc >= 2) {
                const int oc = C_VD + (wc - 2) * 64 + 8 * fq;
                ROWLOOP { ROWVARS
#pragma unroll
                    for (int bj = 0; bj < 2; ++bj) st8(orow + oc + 32 * bj, v[bj]);
                    (void)rit; ROWEND }
            } else {
                const int oc = (pn == 2 ? C_QD : C_KD) + cb; const float sc = pn == 2 ? C2A : 1.0f; const float* gain = pn == 2 ? q_gain : k_gain;
                const f32x4 inv = *(const f32x4*)(INV16R + 4 * fq);
                f32x4 gn[2][2];
#pragma unroll
                for (int bj = 0; bj < 2; ++bj)
#pragma unroll
                    for (int n = 0; n < 2; ++n) gn[bj][n] = *(const f32x4*)(gain + 32 * bj + 8 * fq + 4 * n);
                ROWLOOP { ROWVARS
                    float ss = 0.f;
#pragma unroll
                    for (int bj = 0; bj < 2; ++bj)
#pragma unroll
                        for (int j = 0; j < 8; ++j) ss += v[bj][j] * v[bj][j];
                    ss = xor32_sum(xor16_sum(ss));
                    const float rstd = __builtin_amdgcn_rsqf(ss * (1.0f / 64.0f) + EPS);
                    const int t = t0 + rit;
#pragma unroll
                    for (int bj = 0; bj < 2; ++bj) {
                        const float pos = (float)(bj == 0 ? (t >> 6) : (t & 63));
                        float o[8];
#pragma unroll
                        for (int p = 0; p < 4; ++p) {
                            float sn, cs; if (isctx) { sn = 0.f; cs = 1.f; } else sincos_rev(pos * inv[p], sn, cs);
                            const float x0 = v[bj][2 * p] * rstd * gn[bj][(2 * p) >> 2][(2 * p) & 3], x1 = v[bj][2 * p + 1] * rstd * gn[bj][(2 * p + 1) >> 2][(2 * p + 1) & 3];
                            o[2 * p] = (x0 * cs - x1 * sn) * sc; o[2 * p + 1] = (x0 * sn + x1 * cs) * sc; }
                        st8(orow + oc + 32 * bj, o); }
                    ROWEND }
            }
        }
#undef ROWLOOP
#undef ROWVARS
#undef ROWEND
    }
};

__device__ __forceinline__ unsigned pk_u8x4(float a, float b, float c, float d) { unsigned w = 0u;
    w = __builtin_amdgcn_cvt_pk_u8_f32(__builtin_rintf(a * 255.0f), 0u, w); w = __builtin_amdgcn_cvt_pk_u8_f32(__builtin_rintf(b * 255.0f), 1u, w);
    w = __builtin_amdgcn_cvt_pk_u8_f32(__builtin_rintf(c * 255.0f), 2u, w); w = __builtin_amdgcn_cvt_pk_u8_f32(__builtin_rintf(d * 255.0f), 3u, w); return w; }
__device__ __forceinline__ float u8f(unsigned w, int i) { return (float)((w >> (8 * i)) & 0xffu); }
struct EpiGates {
    static constexpr bool PERM = true;
    unsigned char* GT; const float* gate_b;
    __device__ __forceinline__ void operator()(const f32x4 (&acc)[2][2][4][2], const pg8::Unit& u, int wr, int wc, int fr, int fq) const {
        const int col0 = u.pn * 256 + wc * 32 + 8 * fq;
        f32x4 gb[2][2];
#pragma unroll
        for (int bj = 0; bj < 2; ++bj)
#pragma unroll
            for (int n = 0; n < 2; ++n) gb[bj][n] = *(const f32x4*)(gate_b + col0 + bj * 128 + 4 * n) * (-LOG2E);
#pragma unroll
        for (int ai = 0; ai < 2; ++ai)
#pragma unroll
            for (int m = 0; m < 4; ++m) { unsigned char* rowp = GT + ((size_t)u.pm * 256 + ai * 128 + wr * 64 + m * 16 + fr) * 4096 + u.pn * 256 + (wc * 4 + fq) * 16;
                v4u w4;
#pragma unroll
                for (int bj = 0; bj < 2; ++bj) { unsigned o[8];
#pragma unroll
                    for (int n = 0; n < 2; ++n)
#pragma unroll
                        for (int j = 0; j < 4; j += 2) { const f32x2 a2 = (f32x2){acc[ai][bj][m][n][j], acc[ai][bj][m][n][j + 1]}, c2 = (f32x2){gb[bj][n][j], gb[bj][n][j + 1]};
                            const f32x2 t2 = __builtin_elementwise_fma(a2, (f32x2){-W8I * LOG2E, -W8I * LOG2E}, c2);
                            const f32x2 e2 = (f32x2){__builtin_amdgcn_exp2f(t2.x), __builtin_amdgcn_exp2f(t2.y)};
                            const f32x2 d2 = __builtin_elementwise_fma(e2, (f32x2){1.0f / 255.0f, 1.0f / 255.0f}, (f32x2){1.0f / 255.0f, 1.0f / 255.0f});
                            const f32x2 v2 = (f32x2){__builtin_amdgcn_rcpf(d2.x), __builtin_amdgcn_rcpf(d2.y)} + (f32x2){8388608.0f, 8388608.0f};
                            o[4 * n + j] = __float_as_uint(v2.x); o[4 * n + j + 1] = __float_as_uint(v2.y); }
                    v2u w; w.x = __builtin_amdgcn_perm(o[1], o[0], 0x0c0c0400u) | __builtin_amdgcn_perm(o[3], o[2], 0x04000c0cu); w.y = __builtin_amdgcn_perm(o[5], o[4], 0x0c0c0400u) | __builtin_amdgcn_perm(o[7], o[6], 0x04000c0cu);
                    if (bj == 0) { w4.x = w.x; w4.y = w.y; } else { w4.z = w.x; w4.w = w.y; } }
                *(v4u*)rowp = w4; }
    }
};
struct EpiGateAcc {
    static constexpr bool PERM = true;
    const unsigned char* GT; bf16_t* MRG; bf16_t* GPC;
    static __device__ __forceinline__ bool keep_acc(const pg8::Unit& u) { return (u.pn & 3) != 3 && (u.pm % TPB) != 0; }
    __device__ __forceinline__ void operator()(f32x4 (&acc)[2][2][4][2], const pg8::Unit& u, int wr, int wc, int fr, int fq) const {
        const int dt = u.pn >> 2, n = u.pn & 3; const int col0 = dt * 256 + wc * 32 + 8 * fq;
        const bool isctx = (u.pm % TPB) == 0;
        const size_t row0 = (size_t)u.pm * 256 + wr * 64 + fr;
        const unsigned char* gp0 = GT + row0 * 4096 + n * 1024 + dt * 256 + (wc * 4 + fq) * 16;
        constexpr float GMIN = 8.673617379884035e-19f;
#define GA_OFF(grp) ((size_t)(((grp) >> 3) * 128 + (((grp) >> 1) & 3) * 16))
        if (!isctx && n < 3) {
            v4u ga4[8], gb4[8];
#pragma unroll
            for (int am = 0; am < 8; ++am) { ga4[am] = *(const v4u*)(gp0 + GA_OFF(2 * am) * 4096); gb4[am] = *(const v4u*)(gp0 + 1024 + GA_OFF(2 * am) * 4096); }
            __builtin_amdgcn_sched_barrier(0);
#pragma unroll
            for (int grp = 0; grp < 16; ++grp) { const int ai = grp >> 3, m = (grp >> 1) & 3, bj = grp & 1; const v2u g0 = bj ? (v2u){ga4[grp >> 1].z, ga4[grp >> 1].w} : (v2u){ga4[grp >> 1].x, ga4[grp >> 1].y}, g1 = bj ? (v2u){gb4[grp >> 1].z, gb4[grp >> 1].w} : (v2u){gb4[grp >> 1].x, gb4[grp >> 1].y};
                float r[8];
#define GA_R(i, A, B) r[i] = fmaxf(A, GMIN) * __builtin_amdgcn_rcpf(fmaxf(B, GMIN))
                GA_R(0, u8f(g0.x, 0), u8f(g1.x, 0)); GA_R(1, u8f(g0.x, 1), u8f(g1.x, 1)); GA_R(2, u8f(g0.x, 2), u8f(g1.x, 2)); GA_R(3, u8f(g0.x, 3), u8f(g1.x, 3));
                GA_R(4, u8f(g0.y, 0), u8f(g1.y, 0)); GA_R(5, u8f(g0.y, 1), u8f(g1.y, 1)); GA_R(6, u8f(g0.y, 2), u8f(g1.y, 2)); GA_R(7, u8f(g0.y, 3), u8f(g1.y, 3));
#undef GA_R
#pragma unroll
                for (int j = 0; j < 4; ++j) { acc[ai][bj][m][0][j] *= r[j]; acc[ai][bj][m][1][j] *= r[4 + j]; } }
            __builtin_amdgcn_sched_barrier(0);
        } else {
            bf16_t* mp0 = isctx ? GPC + ((size_t)n * 512 + (u.pm / TPB) * 256 + wr * 64 + fr) * 1024 + col0 : MRG + row0 * 1024 + col0;
            const float lo = isctx ? 0.f : GMIN; constexpr float I255 = 1.0f / 255.0f;
            v4u ga4[8];
#pragma unroll
            for (int am = 0; am < 8; ++am) ga4[am] = *(const v4u*)(gp0 + GA_OFF(2 * am) * 4096);
            __builtin_amdgcn_sched_barrier(0);
#pragma unroll
            for (int grp = 0; grp < 16; ++grp) { const int ai = grp >> 3, m = (grp >> 1) & 3, bj = grp & 1; const v2u g = bj ? (v2u){ga4[grp >> 1].z, ga4[grp >> 1].w} : (v2u){ga4[grp >> 1].x, ga4[grp >> 1].y}; const f32x4 a0 = acc[ai][bj][m][0], a1 = acc[ai][bj][m][1];
                v4u w; w.x = cvtpk(a0[0] * (fmaxf(u8f(g.x, 0), lo) * I255), a0[1] * (fmaxf(u8f(g.x, 1), lo) * I255)); w.y = cvtpk(a0[2] * (fmaxf(u8f(g.x, 2), lo) * I255), a0[3] * (fmaxf(u8f(g.x, 3), lo) * I255));
                w.z = cvtpk(a1[0] * (fmaxf(u8f(g.y, 0), lo) * I255), a1[1] * (fmaxf(u8f(g.y, 1), lo) * I255)); w.w = cvtpk(a1[2] * (fmaxf(u8f(g.y, 2), lo) * I255), a1[3] * (fmaxf(u8f(g.y, 3), lo) * I255));
                *(v4u*)(mp0 + GA_OFF(grp) * 1024 + bj * 128) = w; }
            __builtin_amdgcn_sched_barrier(0);
        }
#undef GA_OFF
    }
};

struct EpiOutRes {
    static constexpr bool PERM = true;
    static __device__ __forceinline__ bool keep_acc(const pg8::Unit&) { return false; }
    const float* x_in; const float* ctx_in; const bf16_t* XR; bf16_t* X1; const float* mod_l; int layer;
    __device__ __forceinline__ void operator()(const f32x4 (&acc)[2][2][4][2], const pg8::Unit& u, int wr, int wc, int fr, int fq) const {
        const int pm = u.pm, b = pm / TPB, jt = pm % TPB; const bool isctx = jt == 0;
        const float* g1 = mod_l + (isctx ? 2 : b) * 6144 + 2048;
        const int col0 = u.pn * 256 + wc * 32 + 8 * fq;
        f32x4 gv[2][2];
#pragma unroll
        for (int bj = 0; bj < 2; ++bj)
#pragma unroll
            for (int n = 0; n < 2; ++n) gv[bj][n] = *(const f32x4*)(g1 + col0 + bj * 128 + n * 4);
        bf16_t* ob = X1 + ((size_t)pm * 256 + wr * 64 + fr) * DM + col0;
        if (layer == 0) {
            const float* base = (isctx ? ctx_in + (size_t)b * CTXL * DM : x_in + ((size_t)b * SEQ + (size_t)(jt - 1) * 256) * DM) + (size_t)(wr * 64 + fr) * DM + col0;
#pragma unroll
            for (int ai = 0; ai < 2; ++ai) { f32x4 rs[4][2][2];
#pragma unroll
                for (int m = 0; m < 4; ++m)
#pragma unroll
                    for (int bj = 0; bj < 2; ++bj)
#pragma unroll
                        for (int n = 0; n < 2; ++n) rs[m][bj][n] = *(const f32x4*)(base + (size_t)(ai * 128 + m * 16) * DM + bj * 128 + n * 4);
                __builtin_amdgcn_sched_barrier(0);
#pragma unroll
                for (int m = 0; m < 4; ++m)
#pragma unroll
                    for (int bj = 0; bj < 2; ++bj) { const f32x4 o0 = rs[m][bj][0] + gv[bj][0] * acc[ai][bj][m][0], o1 = rs[m][bj][1] + gv[bj][1] * acc[ai][bj][m][1];
                        v4u w; w.x = cvtpk(o0[0], o0[1]); w.y = cvtpk(o0[2], o0[3]); w.z = cvtpk(o1[0], o1[1]); w.w = cvtpk(o1[2], o1[3]);
                        *(v4u*)(ob + (size_t)(ai * 128 + m * 16) * DM + bj * 128) = w; }
                __builtin_amdgcn_sched_barrier(0); }
        } else {
            const bf16_t* base = XR + ((size_t)pm * 256 + wr * 64 + fr) * DM + col0;
#pragma unroll
            for (int ai = 0; ai < 2; ++ai) { v4u rb[4][2];
#pragma unroll
                for (int m = 0; m < 4; ++m)
#pragma unroll
                    for (int bj = 0; bj < 2; ++bj) rb[m][bj] = *(const v4u*)(base + (size_t)(ai * 128 + m * 16) * DM + bj * 128);
                __builtin_amdgcn_sched_barrier(0);
#pragma unroll
                for (int m = 0; m < 4; ++m)
#pragma unroll
                    for (int bj = 0; bj < 2; ++bj) { const v4u r = rb[m][bj];
                        const f32x4 r0 = (f32x4){bflo(r.x), bfhi(r.x), bflo(r.y), bfhi(r.y)}, r1 = (f32x4){bflo(r.z), bfhi(r.z), bflo(r.w), bfhi(r.w)};
                        const f32x4 o0 = r0 + gv[bj][0] * acc[ai][bj][m][0], o1 = r1 + gv[bj][1] * acc[ai][bj][m][1];
                        v4u w; w.x = cvtpk(o0[0], o0[1]); w.y = cvtpk(o0[2], o0[3]); w.z = cvtpk(o1[0], o1[1]); w.w = cvtpk(o1[2], o1[3]);
                        *(v4u*)(ob + (size_t)(ai * 128 + m * 16) * DM + bj * 128) = w; }
                __builtin_amdgcn_sched_barrier(0); }
        }
    }
};
struct EpiPart {
    static constexpr bool PERM = false;
    static __device__ __forceinline__ bool keep_acc(const pg8::Unit&) { return false; }
    float* PART;
    __device__ __forceinline__ void operator()(const f32x4 (&acc)[2][2][4][2], const pg8::Unit& u, int wr, int wc, int fr, int fq) const {
        const int ks = u.pn >> 2, ct = u.pn & 3; const int col0 = ct * 256 + wc * 32 + 4 * fq;
#pragma unroll
        for (int ai = 0; ai < 2; ++ai)
#pragma unroll
            for (int m = 0; m < 4; ++m) { float* op = PART + ((size_t)ks * 512 + u.pm * 256 + ai * 128 + wr * 64 + m * 16 + fr) * DM + col0;
#pragma unroll
                for (int bj = 0; bj < 2; ++bj)
#pragma unroll
                    for (int n = 0; n < 2; ++n) *(f32x4*)(op + bj * 128 + n * 16) = acc[ai][bj][m][n]; }
    }
};
struct EpiSwiGLU {
    static constexpr bool PERM = true;
    unsigned char* HID;
    __device__ __forceinline__ void operator()(const f32x4 (&acc)[2][2][4][2], const pg8::Unit& u, int wr, int wc, int fr, int fq) const {
        const int f0 = u.pn * 128 + wc * 32 + 8 * fq;
#pragma unroll
        for (int ai = 0; ai < 2; ++ai)
#pragma unroll
            for (int m = 0; m < 4; ++m) { float o[8];
#pragma unroll
                for (int n = 0; n < 2; ++n)
#pragma unroll
                    for (int j = 0; j < 4; j += 2) { const f32x2 g2 = (f32x2){acc[ai][0][m][n][j], acc[ai][0][m][n][j + 1]}, u2 = (f32x2){acc[ai][1][m][n][j], acc[ai][1][m][n][j + 1]};
                        const f32x2 t2 = g2 * (f32x2){-W8I * LOG2E, -W8I * LOG2E};
                        const f32x2 e2 = (f32x2){__builtin_amdgcn_exp2f(t2.x), __builtin_amdgcn_exp2f(t2.y)};
                        const f32x2 d2 = __builtin_elementwise_fma(e2, (f32x2){1024.0f, 1024.0f}, (f32x2){1024.0f, 1024.0f});
                        const f32x2 r2 = (f32x2){__builtin_amdgcn_rcpf(d2.x), __builtin_amdgcn_rcpf(d2.y)};
                        const f32x2 o2 = (g2 * u2) * r2; o[4 * n + j] = o2.x; o[4 * n + j + 1] = o2.y; }
                v2u w; w.x = pk8(o[0], o[1], o[2], o[3]); w.y = pk8(o[4], o[5], o[6], o[7]);
                *(v2u*)(HID + ((size_t)u.pm * 256 + ai * 128 + wr * 64 + m * 16 + fr) * EH + f0) = w; }
    }
};
struct EpiDown {
    static constexpr bool PERM = true;
    bf16_t* Y; const float* SCORE;
    __device__ __forceinline__ void operator()(const f32x4 (&acc)[2][2][4][2], const pg8::Unit& u, int wr, int wc, int fr, int fq) const {
        const int col0 = u.pn * 256 + wc * 32 + 8 * fq;
        float sc8[2][4];
#pragma unroll
        for (int ai = 0; ai < 2; ++ai)
#pragma unroll
            for (int m = 0; m < 4; ++m) sc8[ai][m] = SCORE[(size_t)u.pm * 256 + ai * 128 + wr * 64 + m * 16 + fr];
        __builtin_amdgcn_sched_barrier(0);
#pragma unroll
        for (int ai = 0; ai < 2; ++ai)
#pragma unroll
            for (int m = 0; m < 4; ++m) { const size_t row = (size_t)u.pm * 256 + ai * 128 + wr * 64 + m * 16 + fr; const float s = sc8[ai][m] * W8I;
#pragma unroll
                for (int bj = 0; bj < 2; ++bj) { float o[8];
#pragma unroll
                    for (int n = 0; n < 2; ++n)
#pragma unroll
                        for (int j = 0; j < 4; ++j) o[4 * n + j] = acc[ai][bj][m][n][j] * s;
                    st8(Y + row * DM + col0 + bj * 128, o); } }
    }
};
struct EpiDownPart {
    static constexpr bool PERM = true;
    bf16_t* YP; const float* SCORE;
    __device__ __forceinline__ void operator()(const f32x4 (&acc)[2][2][4][2], const pg8::Unit& u, int wr, int wc, int fr, int fq) const {
        if (wr != 0) return;
        const int in = u.pn & 3, kq = u.pn >> 2, e = u.pm / 9; const int col0 = in * 256 + wc * 32 + 8 * fq;
        float sc4[4];
#pragma unroll
        for (int m = 0; m < 4; ++m) sc4[m] = SCORE[(size_t)u.pm * 256 + m * 16 + fr];
        __builtin_amdgcn_sched_barrier(0);
#pragma unroll
        for (int m = 0; m < 4; ++m) { const size_t row = ((size_t)(kq * 16 + e) * 256 + m * 16 + fr); const float sc = sc4[m] * W8I;
#pragma unroll
            for (int bj = 0; bj < 2; ++bj) { float o[8];
#pragma unroll
                for (int n = 0; n < 2; ++n)
#pragma unroll
                    for (int j = 0; j < 4; ++j) o[4 * n + j] = acc[0][bj][m][n][j] * sc;
                st8(YP + row * DM + col0 + bj * 128, o); } }
    }
};

namespace attn_body {
using bf16 = __hip_bfloat16;
using u32x4 = __attribute__((ext_vector_type(4))) unsigned;
constexpr int NW = 8, QBLK = 32, QB = QBLK * NW, KVBLK = 64;
__device__ __forceinline__ int crow(int r, int hi) { return (r & 3) + 8 * (r >> 2) + 4 * hi; }
#define SBAR() __builtin_amdgcn_sched_barrier(0)
constexpr int NSLOT = 3, SLOTB = 8192;
constexpr int LDS_K = 0, LDS_V = NSLOT * SLOTB, LDS_WS = 2 * NSLOT * SLOTB, LDS_OST = LDS_WS + NW * 64 * 4, LDS_OST1 = LDS_OST + NW * 4096, LDS_RPB = LDS_OST1 + NW * 4096, LDS_ATT_BYTES = LDS_RPB + 2048;
static_assert(LDS_ATT_BYTES <= RING_BYTES, "attention LDS");
__device__ __forceinline__ void glds16(const void* gsrc, unsigned lds_dst) { unsigned keep;
  asm volatile("s_mov_b32 %0, m0\n\ts_mov_b32 m0, %2\n\ts_nop 0\n\tglobal_load_lds_dwordx4 %1, off\n\ts_mov_b32 m0, %0" : "=&s"(keep) : "v"(gsrc), "s"(lds_dst) : "memory"); }
__device__ __forceinline__ float max3f(float a, float b, float c) { float r; asm("v_max3_f32 %0, %1, %2, %3" : "=v"(r) : "v"(a), "v"(b), "v"(c)); return r; }
__device__ __forceinline__ float max2f(float a, float b) { float r; asm("v_max_f32_e32 %0, %1, %2" : "=v"(r) : "v"(a), "v"(b)); return r; }
__device__ __forceinline__ float fadd_s(float a, float b) { float r; asm("v_add_f32_e32 %0, %1, %2" : "=v"(r) : "v"(a), "v"(b)); return r; }
__device__ __forceinline__ float fsub_s(float a, float b) { float r; asm("v_sub_f32_e32 %0, %1, %2" : "=v"(r) : "v"(a), "v"(b)); return r; }
__device__ __forceinline__ unsigned cvtpk_s(float lo, float hi) { return cvtpk(lo, hi); }
#define WAIT_BAR(N) asm volatile("s_waitcnt vmcnt(" #N ") lgkmcnt(0)\n\ts_barrier" ::: "memory")

typedef __attribute__((address_space(3))) const char* lds_cptr;
typedef short v4i16_t __attribute__((ext_vector_type(4)));
__device__ __forceinline__ void qkt(f32x16& p0, f32x16& p1, lds_cptr Kslot, const bf16x8* qr, const f32x16& negm, int r32, int hi) {
  lds_cptr kb = Kslot + hi * 1024 + r32 * 16;
  #pragma unroll
  for (int d0 = 0; d0 < 4; ++d0) {
    const bf16x8 b0 = *(const __attribute__((address_space(3))) bf16x8*)(kb + d0 * 2048);
    const bf16x8 b1 = *(const __attribute__((address_space(3))) bf16x8*)(kb + d0 * 2048 + 512);
    if (d0 == 0) { p0 = __builtin_amdgcn_mfma_f32_32x32x16_bf16(b0, qr[0], negm, 0, 0, 0); p1 = __builtin_amdgcn_mfma_f32_32x32x16_bf16(b1, qr[0], negm, 0, 0, 0); }
    else { p0 = __builtin_amdgcn_mfma_f32_32x32x16_bf16(b0, qr[d0], p0, 0, 0, 0); p1 = __builtin_amdgcn_mfma_f32_32x32x16_bf16(b1, qr[d0], p1, 0, 0, 0); } }
}
__device__ __forceinline__ void kload8(bf16x8* kf, lds_cptr kp) {
  kf[0] = *(const __attribute__((address_space(3))) bf16x8*)(kp);        kf[1] = *(const __attribute__((address_space(3))) bf16x8*)(kp + 512);
  kf[2] = *(const __attribute__((address_space(3))) bf16x8*)(kp + 2048); kf[3] = *(const __attribute__((address_space(3))) bf16x8*)(kp + 2560);
  kf[4] = *(const __attribute__((address_space(3))) bf16x8*)(kp + 4096); kf[5] = *(const __attribute__((address_space(3))) bf16x8*)(kp + 4608);
  kf[6] = *(const __attribute__((address_space(3))) bf16x8*)(kp + 6144); kf[7] = *(const __attribute__((address_space(3))) bf16x8*)(kp + 6656);
}
__device__ __forceinline__ void kload2(bf16x8* kf, lds_cptr kp, int j) { kf[2 * j] = *(const __attribute__((address_space(3))) bf16x8*)(kp + j * 2048); kf[2 * j + 1] = *(const __attribute__((address_space(3))) bf16x8*)(kp + j * 2048 + 512); }
__device__ __forceinline__ s16x4 vtr(lds_cptr p) { return __builtin_bit_cast(s16x4, __builtin_amdgcn_ds_read_tr16_b64_v4i16((__attribute__((address_space(3))) v4i16_t*)p)); }
__device__ __forceinline__ float rowmax(const f32x16& p0, const f32x16& p1) {
  float a = max3f(p0[0], p0[1], p1[0]), b = max3f(p0[2], p0[3], p1[1]); a = max3f(a, p1[2], p1[3]);
  #pragma unroll
  for (int r = 4; r < 16; r += 4) { a = max3f(a, p0[r], p0[r + 1]); b = max3f(b, p0[r + 2], p0[r + 3]); a = max3f(a, p1[r], p1[r + 1]); b = max3f(b, p1[r + 2], p1[r + 3]); }
  const float m = max2f(a, b);
  auto rr = __builtin_amdgcn_permlane32_swap(__float_as_uint(m), __float_as_uint(m), false, false);
  return max2f(__uint_as_float(rr[0]), __uint_as_float(rr[1]));
}
__device__ __forceinline__ void pv(f32x16* o, int vb, bf16x8 pa0, bf16x8 pa1, bf16x8 pa2, bf16x8 pa3) {
  #pragma unroll
  for (int d0 = 0; d0 < 2; ++d0) { s16x4 lo[4], hi[4];
    #pragma unroll
    for (int ks = 0; ks < 4; ++ks) {
      asm volatile("ds_read_b64_tr_b16 %0,%1 offset:%c2" : "=&v"(lo[ks]) : "v"(vb), "i"(d0 * 4096 + ks * 1024) : "memory");
      asm volatile("ds_read_b64_tr_b16 %0,%1 offset:%c2" : "=&v"(hi[ks]) : "v"(vb), "i"(d0 * 4096 + ks * 1024 + 512) : "memory"); }
    asm volatile("s_waitcnt lgkmcnt(0)" ::: "memory"); SBAR();
    #define PK(k) (bf16x8){lo[k][0], lo[k][1], lo[k][2], lo[k][3], hi[k][0], hi[k][1], hi[k][2], hi[k][3]}
    o[d0] = __builtin_amdgcn_mfma_f32_32x32x16_bf16(pa0, PK(0), o[d0], 0, 0, 0);
    o[d0] = __builtin_amdgcn_mfma_f32_32x32x16_bf16(pa1, PK(1), o[d0], 0, 0, 0);
    o[d0] = __builtin_amdgcn_mfma_f32_32x32x16_bf16(pa2, PK(2), o[d0], 0, 0, 0);
    o[d0] = __builtin_amdgcn_mfma_f32_32x32x16_bf16(pa3, PK(3), o[d0], 0, 0, 0);
    #undef PK
  }
}

struct DiffEpi { float lam, post; const float* subg; };
template <int THRL, int MODE> __device__ __forceinline__ void attn_unit(const bf16* Qu, const bf16* __restrict__ Kh, const bf16* __restrict__ Vh, int NT, bf16* Ou, char* shm, const DiffEpi de, const bool usemax = true, const float* kmaxp = nullptr) {
  constexpr int PK = PQ, PV = PQ, PO = 1024;
  constexpr bool DQ32 = (MODE != 0);
  const int tid = opaque_tid(), lane = tid & 63, r32 = lane & 31, hi = lane >> 5; const int wid = __builtin_amdgcn_readfirstlane(tid >> 6);
  const bf16* Qw = Qu + (long)(wid * QBLK) * PQ;
  const unsigned lds0 = (unsigned)(uintptr_t)shm;
  float* wsf = (float*)(shm + LDS_WS) + wid * 64;
  const bf16* ksrc = Kh + (long)lane * PK + wid * 8;
  const bf16* vsrc = Vh + (long)(16 * (wid & 3) + (lane >> 2)) * PV + (wid >> 2) * 32 + (lane & 3) * 8;
  const unsigned kdst = lds0 + LDS_K + wid * 1024, vdst = lds0 + LDS_V + wid * 1024;
  #define DMA_K(t, slot) glds16(ksrc + (long)(t) * KVBLK * PK, (unsigned)__builtin_amdgcn_readfirstlane(kdst + (slot)))
  #define DMA_V(t, slot) glds16(vsrc + (long)(t) * KVBLK * PV, (unsigned)__builtin_amdgcn_readfirstlane(vdst + (slot)))
  const int vb0 = (int)(lds0 + LDS_V) + ((lane >> 4) & 1) * 32 + (lane & 3) * 8 + (4 * hi + ((lane & 15) >> 2)) * 64;
  bf16x8 kf[8];
  const lds_cptr shm3 = (lds_cptr)shm; const lds_cptr kp0 = shm3 + LDS_K + hi * 1024 + r32 * 16; const lds_cptr vp0 = shm3 + LDS_V + ((lane >> 4) & 1) * 32 + (lane & 3) * 8 + (4 * hi + ((lane & 15) >> 2)) * 64;
  DMA_K(0, 0); DMA_V(0, 0); DMA_K(1, SLOTB);
  bf16x8 qr[4];
  #pragma unroll
  for (int d0 = 0; d0 < 4; ++d0) qr[d0] = *reinterpret_cast<const bf16x8*>(&Qw[(long)r32 * PQ + d0 * 16 + hi * 8]);
  constexpr bool LMF = DQ32;
  bool um = usemax;
  if (MODE != 0) {
    float q2 = 0.f;
    #pragma unroll
    for (int d0 = 0; d0 < 2; ++d0)
      #pragma unroll
      for (int jq = 0; jq < 8; ++jq) { const float v = __uint_as_float((unsigned)(unsigned short)qr[d0][jq] << 16); q2 += v * v; }
    const float bq = sqrtf(xor32_sum(q2)) * (*kmaxp) * 1.02f;
    um = __builtin_amdgcn_readfirstlane((int)(__ballot(bq > 40.0f) != 0ull)) != 0; }
  float mhat = 0.f, l_reg = 0.f; f32x16 o[2]; o[0] = f32x16{}; o[1] = f32x16{}; f32x16 negm = f32x16{}; asm volatile("" : "+v"(negm));
  f32x16 lacc = f32x16{}; bf16x8 ones; { unsigned c0_, c1_, c2_, c3_; asm volatile("v_mov_b32 %0, 0x3f803f80\n\tv_mov_b32 %1, 0x3f803f80\n\tv_mov_b32 %2, 0x3f803f80\n\tv_mov_b32 %3, 0x3f803f80" : "=v"(c0_), "=v"(c1_), "=v"(c2_), "=v"(c3_)); ones = __builtin_bit_cast(bf16x8, (u32x4){c0_, c1_, c2_, c3_}); }
  bool resc = false;
  #define START(P0, P1) do { const float rm = rowmax(P0, P1); resc = false; \
    { const float dl = rm; mhat = fadd_s(mhat, dl); \
      _Pragma("unroll") for (int r = 0; r < 16; ++r) { P0[r] = fsub_s(P0[r], dl); P1[r] = fsub_s(P1[r], dl); } \
      _Pragma("unroll") for (int r = 0; r < 16; ++r) negm[r] = -mhat; asm volatile("" : "+v"(negm)); } \
    _Pragma("unroll") for (int r = 0; r < 16; ++r) P0[r] = __builtin_amdgcn_exp2f(P0[r]); } while (0)
  #define RESC() do { if (resc) { asm volatile("s_waitcnt lgkmcnt(0)" ::: "memory"); \
      _Pragma("unroll") for (int d_ = 0; d_ < 2; ++d_) _Pragma("unroll") for (int r = 0; r < 16; ++r) o[d_][r] *= wsf[crow(r, hi)]; \
      if (LMF) { _Pragma("unroll") for (int r = 0; r < 16; ++r) lacc[r] *= wsf[crow(r, hi)]; } } } while (0)
  f32x16 pA0, pA1, pB0, pB1;
  int sl_prev = 0, sl_cur = 0, sl_next = SLOTB;
  #define ROT() do { sl_prev = sl_cur; sl_cur = sl_next; sl_next = (sl_next == (NSLOT - 1) * SLOTB) ? 0 : sl_next + SLOTB; } while (0)
  DMA_K(2, 2 * SLOTB);
  WAIT_BAR(3);
  qkt(pA0, pA1, shm3 + LDS_K, qr, negm, r32, hi); asm volatile("s_nop 15\n\ts_nop 7" : "+v"(pA0), "+v"(pA1));
  START(pA0, pA1);
  _Pragma("unroll") for (int r = 0; r < 16; ++r) pA1[r] = __builtin_amdgcn_exp2f(pA1[r]);
  WAIT_BAR(0);
  DMA_K(3, 0); DMA_V(1, SLOTB);
  ROT();
  kload8(kf, kp0 + sl_cur);
  WAIT_BAR(2);
  s16x4 vlo[8], vhi[8]; u32x4 pw0, pw1, pw2, pw3;
  #define PKW(P, B) cvtpk_s(P[B], P[B + 1])
  #define PAF(k) __builtin_bit_cast(bf16x8, pw##k)
  #define VFR(i) (bf16x8){vlo[i][0], vlo[i][1], vlo[i][2], vlo[i][3], vhi[i][0], vhi[i][1], vhi[i][2], vhi[i][3]}
  #define PIN(x) asm volatile("" : "+v"(x))
  #define MX3(a, b, c) __builtin_fmaxf(__builtin_fmaxf((a), (b)), (c))
  #define GAPA(MF, A0, A1, A2, A3, W0, W1, PW) do { MF; if (!LMF) { sacc += A0; sacc += A1; sacc += A2; sacc += A3; PIN(sacc); } W0; W1; PIN(PW); SBAR(); } while (0)
  #define LMM(k) lacc = __builtin_amdgcn_mfma_f32_32x32x16_bf16(PAF(k), ones, lacc, 0, 0, 0)
  #define EX(v) __builtin_amdgcn_exp2f(v)
  #define GAPB(MF, X, B) do { MF; X[B] = EX(X[B]); X[B + 1] = EX(X[B + 1]); X[B + 2] = EX(X[B + 2]); X[B + 3] = EX(X[B + 3]); PIN(X); SBAR(); } while (0)
  #define VRD(i) do { vlo[i] = vtr(vp_ + (((i) >> 2) * 4096 + ((i) & 3) * 1024)); vhi[i] = vtr(vp_ + (((i) >> 2) * 4096 + ((i) & 3) * 1024 + 512)); } while (0)
  #define KRD(G, j) do { if (G) { kload2(kf, kp0 + sl_next, j); SBAR(); } } while (0)
  #define STEP(C0, C1, P0, P1, t, GK, GV, GL) do { SBAR(); \
    const lds_cptr vp_ = vp0 + sl_prev; \
    VRD(0); SBAR(); float sacc = (P0[0] + P0[1]); \
    GAPA(C0 = __builtin_amdgcn_mfma_f32_32x32x16_bf16(kf[0], qr[0], negm, 0, 0, 0), P0[2], P0[3], P0[4], P0[5],     pw0[0] = PKW(P0, 0), pw0[1] = PKW(P0, 2), pw0); \
    VRD(4); SBAR(); GAPA(C1 = __builtin_amdgcn_mfma_f32_32x32x16_bf16(kf[1], qr[0], negm, 0, 0, 0), P0[6], P0[7], P0[8], P0[9],     pw0[2] = PKW(P0, 4), pw0[3] = PKW(P0, 6), pw0); \
    VRD(1); SBAR(); GAPA(C0 = __builtin_amdgcn_mfma_f32_32x32x16_bf16(kf[2], qr[1], C0, 0, 0, 0),   P0[10], P0[11], P0[12], P0[13], pw1[0] = PKW(P0, 8), pw1[1] = PKW(P0, 10), pw1); \
    VRD(5); SBAR(); GAPA(C1 = __builtin_amdgcn_mfma_f32_32x32x16_bf16(kf[3], qr[1], C1, 0, 0, 0),   P0[14], P0[15], P1[0], P1[1],   pw1[2] = PKW(P0, 12), pw1[3] = PKW(P0, 14), pw1); \
    VRD(2); SBAR(); GAPA(do { if (!DQ32) { C0 = __builtin_amdgcn_mfma_f32_32x32x16_bf16(kf[4], qr[2], C0, 0, 0, 0); } else if (LMF) { LMM(0); } } while (0),   P1[2], P1[3], P1[4], P1[5],     pw2[0] = PKW(P1, 0), pw2[1] = PKW(P1, 2), pw2); \
    VRD(6); SBAR(); GAPA(do { if (!DQ32) { C1 = __builtin_amdgcn_mfma_f32_32x32x16_bf16(kf[5], qr[2], C1, 0, 0, 0); } else if (LMF) { LMM(1); } } while (0),   P1[6], P1[7], P1[8], P1[9],     pw2[2] = PKW(P1, 4), pw2[3] = PKW(P1, 6), pw2); \
    VRD(3); SBAR(); GAPA(do { if (!DQ32) { C0 = __builtin_amdgcn_mfma_f32_32x32x16_bf16(kf[6], qr[3], C0, 0, 0, 0); } else if (LMF) { LMM(2); } } while (0),   P1[10], P1[11], P1[12], P1[13], pw3[0] = PKW(P1, 8), pw3[1] = PKW(P1, 10), pw3); \
    VRD(7); SBAR(); GAPA(do { if (!DQ32) { C1 = __builtin_amdgcn_mfma_f32_32x32x16_bf16(kf[7], qr[3], C1, 0, 0, 0); } } while (0),   P1[14], P1[15], 0.f, 0.f,       pw3[2] = PKW(P1, 12), pw3[3] = PKW(P1, 14), pw3); \
    if (LMF) { LMM(3); } else { l_reg += sacc; } \
    if (GK) { DMA_K((t) + 3, sl_cur); } if (GV) { DMA_V((t) + 1, sl_next); } \
    if (um) { float a = MX3(C0[0], C0[1], C1[0]), b = MX3(C0[2], C0[3], C1[1]); a = MX3(a, C1[2], C1[3]); \
      _Pragma("unroll") for (int r = 4; r < 16; r += 4) { a = MX3(a, C0[r], C0[r + 1]); b = MX3(b, C0[r + 2], C0[r + 3]); a = MX3(a, C1[r], C1[r + 1]); b = MX3(b, C1[r + 2], C1[r + 3]); } \
      float rm = __builtin_fmaxf(a, b); { auto rr = __builtin_amdgcn_permlane32_swap(__float_as_uint(rm), __float_as_uint(rm), false, false); rm = __builtin_fmaxf(__uint_as_float(rr[0]), __uint_as_float(rr[1])); } \
      resc = false; \
      if (__builtin_expect(__any(rm > (float)THRL), 0)) { const float dl = __builtin_fmaxf(rm, 0.f); mhat += dl; \
        _Pragma("unroll") for (int r = 0; r < 16; ++r) { C0[r] -= dl; C1[r] -= dl; } \
        _Pragma("unroll") for (int r = 0; r < 16; ++r) negm[r] = -mhat; asm volatile("" : "+v"(negm)); \
        const float f = __builtin_amdgcn_exp2f(-dl); if (!LMF) l_reg *= f; if (hi == 0) wsf[r32] = f; resc = true; } } else { resc = false; } \
    SBAR(); \
    GAPB(o[0] = __builtin_amdgcn_mfma_f32_32x32x16_bf16(PAF(0), VFR(0), o[0], 0, 0, 0), C0, 0); \
    GAPB(o[1] = __builtin_amdgcn_mfma_f32_32x32x16_bf16(PAF(0), VFR(4), o[1], 0, 0, 0), C0, 4); \
    KRD(GL, 0); GAPB(o[0] = __builtin_amdgcn_mfma_f32_32x32x16_bf16(PAF(1), VFR(1), o[0], 0, 0, 0), C0, 8); \
    KRD(GL, 1); GAPB(o[1] = __builtin_amdgcn_mfma_f32_32x32x16_bf16(PAF(1), VFR(5), o[1], 0, 0, 0), C0, 12); \
    KRD(GL && !DQ32, 2); GAPB(o[0] = __builtin_amdgcn_mfma_f32_32x32x16_bf16(PAF(2), VFR(2), o[0], 0, 0, 0), C1, 0); \
    KRD(GL && !DQ32, 3); GAPB(o[1] = __builtin_amdgcn_mfma_f32_32x32x16_bf16(PAF(2), VFR(6), o[1], 0, 0, 0), C1, 4); \
    GAPB(o[0] = __builtin_amdgcn_mfma_f32_32x32x16_bf16(PAF(3), VFR(3), o[0], 0, 0, 0), C1, 8); \
    GAPB(o[1] = __builtin_amdgcn_mfma_f32_32x32x16_bf16(PAF(3), VFR(7), o[1], 0, 0, 0), C1, 12); \
    } while (0)
  int t = 1;
  for (; t + 5 < NT; t += 2) {
    STEP(pB0, pB1, pA0, pA1, t, true, true, true);     WAIT_BAR(2); RESC(); ROT();
    STEP(pA0, pA1, pB0, pB1, t + 1, true, true, true); WAIT_BAR(2); RESC(); ROT();
  }
  #define ENDW(tt) do { if ((tt) + 3 < NT) { WAIT_BAR(2); } else if ((tt) + 2 < NT) { WAIT_BAR(1); } else { WAIT_BAR(0); } } while (0)
  for (; t + 1 < NT; t += 2) {
    STEP(pB0, pB1, pA0, pA1, t, (t + 3 < NT), (t + 1 < NT), (t + 1 < NT));       ENDW(t);     RESC(); ROT();
    STEP(pA0, pA1, pB0, pB1, t + 1, (t + 4 < NT), (t + 2 < NT), (t + 2 < NT));   ENDW(t + 1); RESC(); ROT();
  }
  STEP(pB0, pB1, pA0, pA1, NT - 1, false, false, false); RESC();
  { if (!LMF) { float sacc = pB0[0] + pB0[1]; _Pragma("unroll") for (int r = 2; r < 16; ++r) sacc += pB0[r]; _Pragma("unroll") for (int r = 0; r < 16; ++r) sacc += pB1[r]; l_reg += sacc; }
    pw0 = (u32x4){PKW(pB0, 0), PKW(pB0, 2), PKW(pB0, 4), PKW(pB0, 6)}; pw1 = (u32x4){PKW(pB0, 8), PKW(pB0, 10), PKW(pB0, 12), PKW(pB0, 14)}; pw2 = (u32x4){PKW(pB1, 0), PKW(pB1, 2), PKW(pB1, 4), PKW(pB1, 6)}; pw3 = (u32x4){PKW(pB1, 8), PKW(pB1, 10), PKW(pB1, 12), PKW(pB1, 14)};
    SBAR(); if (LMF) { LMM(0); LMM(1); LMM(2); LMM(3); } pv(o, vb0 + sl_cur, PAF(0), PAF(1), PAF(2), PAF(3)); }
  #undef LMM
  #undef PKW
  #undef PAF
  #undef VFR
  #undef PIN
  #undef MX3
  #undef GAPA
  #undef GAPB
  #undef EX
  #undef VRD
  #undef KRD
  #undef STEP
  #undef ENDW
  float rli[16];
  if (LMF) {
    #pragma unroll
    for (int r = 0; r < 16; ++r) rli[r] = __builtin_amdgcn_rcpf(lacc[r]);
  } else {
    { auto rr = __builtin_amdgcn_permlane32_swap(__float_as_uint(l_reg), __float_as_uint(l_reg), false, false); l_reg = __uint_as_float(rr[0]) + __uint_as_float(rr[1]); }
    if (hi == 0) wsf[32 + r32] = l_reg; asm volatile("s_waitcnt lgkmcnt(0)" ::: "memory");
    #pragma unroll
    for (int r = 0; r < 16; ++r) rli[r] = __builtin_amdgcn_rcpf(wsf[32 + crow(r, hi)]);
  }
  bf16_t* stg = (bf16_t*)(shm + LDS_OST) + wid * 2048;
  bf16_t* stg1 = (bf16_t*)(shm + LDS_OST1) + wid * 2048;
  if (MODE == 1) {
    #pragma unroll
    for (int r = 0; r < 16; ++r) { const int orow = crow(r, hi);
      #pragma unroll
      for (int d0 = 0; d0 < 2; ++d0) stg1[orow * 64 + d0 * 32 + r32] = f2bf(o[d0][r] * rli[r]); }
    asm volatile("s_waitcnt lgkmcnt(0)" ::: "memory");
  } else {
    if (MODE == 2) {
      const float g0 = de.subg[r32] * de.post, g1 = de.subg[32 + r32] * de.post;
      #pragma unroll
      for (int r = 0; r < 16; ++r) { const int orow = crow(r, hi);
        const float d0v = bf2f(stg1[orow * 64 + r32]) - de.lam * (o[0][r] * rli[r]), d1v = bf2f(stg1[orow * 64 + 32 + r32]) - de.lam * (o[1][r] * rli[r]);
        float ss = d0v * d0v + d1v * d1v;
        ss = half32_sum(ss);
        const float rstd = __builtin_amdgcn_rsqf(ss * (1.0f / 64.0f) + EPS);
        stg[orow * 64 + r32] = f2bf(d0v * rstd * g0); stg[orow * 64 + 32 + r32] = f2bf(d1v * rstd * g1); }
    } else {
      #pragma unroll
      for (int r = 0; r < 16; ++r) { const int orow = crow(r, hi);
        #pragma unroll
        for (int d0 = 0; d0 < 2; ++d0) stg[orow * 64 + d0 * 32 + r32] = f2bf(o[d0][r] * rli[r]); }
    }
    asm volatile("s_waitcnt lgkmcnt(0)" ::: "memory");
    bf16* Ow = Ou + (long)(wid * QBLK) * PO;
    #pragma unroll
    for (int i = 0; i < 4; ++i) { const int row = i * 8 + (lane >> 3), ch = lane & 7; const u32x4 v = *(const u32x4*)(stg + row * 64 + ch * 8); *(u32x4*)(Ow + (long)row * PO + ch * 8) = v; }
  }
  asm volatile("s_waitcnt lgkmcnt(0)\n\ts_barrier" ::: "memory");
  #undef DMA_K
  #undef DMA_V
  #undef START
  #undef RESC
  #undef ROT
}

__device__ __forceinline__ void na_unit(int b, int h, int g4, const bf16* QKV, bf16* YS, const float* rpb_h, char* shm, const float* kmaxp) {
  const bf16 *QA = QKV + C_QA, *KA = QKV + C_KA, *VA = QKV + C_VA;
  const int tid = opaque_tid(), lane = tid & 63, r32 = lane & 31, hi = lane >> 5; const int wid = __builtin_amdgcn_readfirstlane(tid >> 6);
  const unsigned lds0 = (unsigned)(uintptr_t)shm;
  float* wsf = (float*)(shm + LDS_WS) + wid * 64;
  float* rp = (float*)(shm + LDS_RPB);
  const lds_cptr shm3 = (lds_cptr)shm;
  for (int i = tid; i < 15 * 31; i += 512) rp[i] = rpb_h[i] * LOG2E;
  const int rq = 4 * g4 + (wid >> 1), qc = 32 * (wid & 1) + r32;
  const long rowb = (long)b * RB;
  const bf16* Qw = QA + (rowb + CTXL + rq * 64 + 32 * (wid & 1)) * PQ + h * 64;
  bf16x8 qr[4];
  #pragma unroll
  for (int d0 = 0; d0 < 4; ++d0) qr[d0] = *reinterpret_cast<const bf16x8*>(&Qw[(long)r32 * PQ + d0 * 16 + hi * 8]);
  bool fx; { float q2 = 0.f;
    #pragma unroll
    for (int d0 = 0; d0 < 4; ++d0)
      #pragma unroll
      for (int jq = 0; jq < 8; ++jq) { const float v = __uint_as_float((unsigned)(unsigned short)qr[d0][jq] << 16); q2 += v * v; }
    float bm = 0.f; for (int i = lane; i < 15 * 31; i += 64) bm = fmaxf(bm, fabsf(rpb_h[i]));
    const float bq = sqrtf(xor32_sum(q2)) * (*kmaxp) * 1.02f + wave_max(bm) * LOG2E;
    fx = __builtin_amdgcn_readfirstlane((int)(__ballot(bq > 40.0f) != 0ull)) == 0; }
  const int r0 = min(max(rq - 4, 0), 120);
  const int kr_lo = min(max(4 * g4 - 4, 0), 120), kr_hi = min(max(4 * g4 - 1, 0), 120) + 7;
  const int ntiles = 4 + (kr_hi - kr_lo + 1);
  const int c0 = min(max(qc - 8, 0), 48);
  float mrun = -INFINITY, l_reg = 0.f; f32x16 o[2]; o[0] = f32x16{}; o[1] = f32x16{};
  const unsigned kdst = lds0 + LDS_K + wid * 1024, vdst = lds0 + LDS_V + wid * 1024;
  const int vb0 = (int)(lds0 + LDS_V) + ((lane >> 4) & 1) * 32 + (lane & 3) * 8 + (4 * hi + ((lane & 15) >> 2)) * 64;
  #define NA_DMA(TI) do { const int kr_ = kr_lo + (TI) - 4; const long krow_ = ((TI) < 4) ? rowb + 64 * (TI) : rowb + CTXL + (long)kr_ * 64; const unsigned so_ = ((TI) & 1) * SLOTB; \
      glds16(KA + (krow_ + lane) * PQ + h * 64 + wid * 8, (unsigned)__builtin_amdgcn_readfirstlane(kdst + so_)); \
      glds16(VA + (krow_ + 16 * (wid & 3) + (lane >> 2)) * PQ + h * 64 + (wid >> 2) * 32 + (lane & 3) * 8, (unsigned)__builtin_amdgcn_readfirstlane(vdst + so_)); } while (0)
  asm volatile("s_waitcnt lgkmcnt(0)\n\ts_barrier" ::: "memory");
  NA_DMA(0);
  for (int ti = 0; ti < ntiles; ++ti) {
    const int kr = kr_lo + ti - 4;
    asm volatile("s_waitcnt vmcnt(0) lgkmcnt(0)\n\ts_barrier" ::: "memory");
    if (ti + 1 < ntiles) NA_DMA(ti + 1);
    const unsigned so = (ti & 1) * SLOTB;
    const bool valid = (ti < 4) || (kr >= r0 && kr <= r0 + 7);
    if (valid) {
      f32x16 p0, p1; const f32x16 z = f32x16{};
      qkt(p0, p1, shm3 + LDS_K + so, qr, z, r32, hi);
      if (ti >= 4) {
        const int dr = kr - rq + 7;
        #pragma unroll
        for (int r = 0; r < 16; ++r) { const int k0 = crow(r, hi), k1 = k0 + 32;
          const bool v0 = (k0 >= c0) && (k0 < c0 + 16), v1 = (k1 >= c0) && (k1 < c0 + 16);
          const float b0 = v0 ? rp[dr * 31 + (k0 - qc + 15)] : 0.f, b1 = v1 ? rp[dr * 31 + (k1 - qc + 15)] : 0.f;
          p0[r] = v0 ? p0[r] + b0 : -INFINITY; p1[r] = v1 ? p1[r] + b1 : -INFINITY; }
      }
      if (fx) { float sacc = 0.f;
        #pragma unroll
        for (int r = 0; r < 16; ++r) { p0[r] = __builtin_amdgcn_exp2f(p0[r]); p1[r] = __builtin_amdgcn_exp2f(p1[r]); sacc += p0[r] + p1[r]; }
        l_reg += sacc;
      } else {
      float rm = p0[0];
      #pragma unroll
      for (int r = 1; r < 16; ++r) rm = fmaxf(rm, p0[r]);
      #pragma unroll
      for (int r = 0; r < 16; ++r) rm = fmaxf(rm, p1[r]);
      { auto rr = __builtin_amdgcn_permlane32_swap(__float_as_uint(rm), __float_as_uint(rm), false, false); rm = fmaxf(__uint_as_float(rr[0]), __uint_as_float(rr[1])); }
      const float mnew = fmaxf(mrun, rm); const float f = __builtin_amdgcn_exp2f(mrun - mnew); mrun = mnew;
      float sacc = 0.f;
      #pragma unroll
      for (int r = 0; r < 16; ++r) { p0[r] = __builtin_amdgcn_exp2f(p0[r] - mnew); p1[r] = __builtin_amdgcn_exp2f(p1[r] - mnew); sacc += p0[r] + p1[r]; }
      l_reg = l_reg * f + sacc;
      if (hi == 0) wsf[r32] = f;
      asm volatile("s_waitcnt lgkmcnt(0)" ::: "memory");
      #pragma unroll
      for (int d_ = 0; d_ < 2; ++d_)
        #pragma unroll
        for (int r = 0; r < 16; ++r) o[d_][r] *= wsf[crow(r, hi)];
      }
      u32x4 pw0, pw1, pw2, pw3;
      pw0 = (u32x4){cvtpk(p0[0], p0[1]), cvtpk(p0[2], p0[3]), cvtpk(p0[4], p0[5]), cvtpk(p0[6], p0[7])}; pw1 = (u32x4){cvtpk(p0[8], p0[9]), cvtpk(p0[10], p0[11]), cvtpk(p0[12], p0[13]), cvtpk(p0[14], p0[15])};
      pw2 = (u32x4){cvtpk(p1[0], p1[1]), cvtpk(p1[2], p1[3]), cvtpk(p1[4], p1[5]), cvtpk(p1[6], p1[7])}; pw3 = (u32x4){cvtpk(p1[8], p1[9]), cvtpk(p1[10], p1[11]), cvtpk(p1[12], p1[13]), cvtpk(p1[14], p1[15])};
      asm volatile("s_waitcnt lgkmcnt(0)" ::: "memory");
      pv(o, vb0 + (int)so, __builtin_bit_cast(bf16x8, pw0), __builtin_bit_cast(bf16x8, pw1), __builtin_bit_cast(bf16x8, pw2), __builtin_bit_cast(bf16x8, pw3));
    }
  }
  #undef NA_DMA
  { auto rr = __builtin_amdgcn_permlane32_swap(__float_as_uint(l_reg), __float_as_uint(l_reg), false, false); l_reg = __uint_as_float(rr[0]) + __uint_as_float(rr[1]); }
  if (hi == 0) wsf[32 + r32] = l_reg; asm volatile("s_waitcnt lgkmcnt(0)" ::: "memory");
  bf16_t* stg = (bf16_t*)(shm + LDS_OST) + wid * 2048;
  #pragma unroll
  for (int r = 0; r < 16; ++r) { const int orow = crow(r, hi); const float rl = __builtin_amdgcn_rcpf(wsf[32 + orow]);
    #pragma unroll
    for (int d0 = 0; d0 < 2; ++d0) stg[orow * 64 + d0 * 32 + r32] = f2bf(o[d0][r] * rl); }
  asm volatile("s_waitcnt lgkmcnt(0)" ::: "memory");
  bf16* Ow = YS + (rowb + CTXL + rq * 64 + 32 * (wid & 1)) * 1024 + h * 64;
  #pragma unroll
  for (int i = 0; i < 4; ++i) { const int row = i * 8 + (lane >> 3), ch = lane & 7; const u32x4 v = *(const u32x4*)(stg + row * 64 + ch * 8); *(u32x4*)(Ow + (long)row * 1024 + ch * 8) = v; }
  asm volatile("s_waitcnt lgkmcnt(0)\n\ts_barrier" ::: "memory");
}
#undef SBAR
#undef WAIT_BAR
}

__device__ __forceinline__ void sgu_unit(long rowbase, const bf16_t* GU, const bf16_t* GV, const float* ng, const float* sw, const float* sb, bf16_t* YS, char* shm) {
    using attn_body::crow;
    const int tid = opaque_tid(), lane = tid & 63, wid = __builtin_amdgcn_readfirstlane(tid >> 6), r32 = lane & 31, hi = lane >> 5;
    const unsigned lds0 = (unsigned)(uintptr_t)shm;
    {
        const f32x4 g4 = *(const f32x4*)(ng + 4 * lane);
        const int gl = lane >> 4, d = 4 * (lane & 15);
#pragma unroll
        for (int rb = 0; rb < 4; ++rb) { v2u raw[4];
#pragma unroll
            for (int q4 = 0; q4 < 4; ++q4) raw[q4] = *(const v2u*)(GV + (rowbase + wid * 16 + rb * 4 + q4) * PQ + 4 * lane);
            __builtin_amdgcn_sched_barrier(0);
#pragma unroll
            for (int q4 = 0; q4 < 4; ++q4) { const int q = wid * 16 + rb * 4 + q4;
                f32x4 v = {bflo(raw[q4].x), bfhi(raw[q4].x), bflo(raw[q4].y), bfhi(raw[q4].y)};
                const float mean = wave_sum((v.x + v.y) + (v.z + v.w)) * (1.0f / 256.0f);
                v = v - mean;
                const float var = wave_sum((v.x * v.x + v.y * v.y) + (v.z * v.z + v.w * v.w)) * (1.0f / 256.0f);
                const float rstd = __builtin_amdgcn_rsqf(var + EPS);
                v = v * rstd * g4;
                v2u w; w.x = cvtpk(v.x, v.y); w.y = cvtpk(v.z, v.w);
                const int k = q & 63;
                *(v2u*)(shm + (2 * gl + (q >> 6)) * 8192 + ((d >> 5) * 4 + (k >> 4)) * 1024 + (k & 15) * 64 + (d & 31) * 2) = w; }
            __builtin_amdgcn_sched_barrier(0); }
    }
    __syncthreads();
    const int g = wid & 3, ph = wid >> 2;
    const int vb0 = (int)lds0 + ((lane >> 4) & 1) * 32 + (lane & 3) * 8 + (4 * hi + ((lane & 15) >> 2)) * 64;
    bf16_t* stg = (bf16_t*)(shm + 65536) + wid * 2048;
#pragma unroll
    for (int mt = 0; mt < 2; ++mt) {
        const int p0 = ph * 64 + mt * 32;
        const float* wrow = sw + ((size_t)g * 128 + p0 + r32) * 128 + 4 * hi;
        f32x16 o[2]; o[0] = f32x16{}; o[1] = f32x16{};
#pragma unroll
        for (int sl = 0; sl < 2; ++sl) {
            f32x4 wa[4], wc[4];
#pragma unroll
            for (int s4 = 0; s4 < 4; ++s4) { wa[s4] = *(const f32x4*)(wrow + 64 * sl + 16 * s4); wc[s4] = *(const f32x4*)(wrow + 64 * sl + 16 * s4 + 8); }
            __builtin_amdgcn_sched_barrier(0);
            bf16x8 pa[4];
#pragma unroll
            for (int s4 = 0; s4 < 4; ++s4) { const v4u w = {cvtpk(wa[s4].x, wa[s4].y), cvtpk(wa[s4].z, wa[s4].w), cvtpk(wc[s4].x, wc[s4].y), cvtpk(wc[s4].z, wc[s4].w)}; pa[s4] = __builtin_bit_cast(bf16x8, w); }
            attn_body::pv(o, vb0 + (2 * g + sl) * 8192, pa[0], pa[1], pa[2], pa[3]);
        }
        float bias[16];
#pragma unroll
        for (int r = 0; r < 16; ++r) bias[r] = sb[g * 128 + p0 + crow(r, hi)];
        v4u uu[4];
#pragma unroll
        for (int i = 0; i < 4; ++i) uu[i] = *(const v4u*)(GU + (rowbase + p0 + i * 8 + (lane >> 3)) * PQ + g * 64 + (lane & 7) * 8);
        __builtin_amdgcn_sched_barrier(0);
#pragma unroll
        for (int r = 0; r < 16; ++r) { const int orow = crow(r, hi);
#pragma unroll
            for (int d0 = 0; d0 < 2; ++d0) stg[orow * 64 + d0 * 32 + r32] = f2bf(o[d0][r] + bias[r]); }
        asm volatile("s_waitcnt lgkmcnt(0)" ::: "memory");
#pragma unroll
        for (int i = 0; i < 4; ++i) { const int row = i * 8 + (lane >> 3), ch = lane & 7; const v4u mv = *(const v4u*)(stg + row * 64 + ch * 8); const v4u u4 = uu[i];
            v4u w; w.x = cvtpk(bflo(u4.x) * bflo(mv.x), bfhi(u4.x) * bfhi(mv.x)); w.y = cvtpk(bflo(u4.y) * bflo(mv.y), bfhi(u4.y) * bfhi(mv.y));
            w.z = cvtpk(bflo(u4.z) * bflo(mv.z), bfhi(u4.z) * bfhi(mv.z)); w.w = cvtpk(bflo(u4.w) * bflo(mv.w), bfhi(u4.w) * bfhi(mv.w));
            *(v4u*)(YS + (rowbase + p0 + row) * 1024 + 512 + g * 64 + ch * 8) = w; }
        asm volatile("s_waitcnt lgkmcnt(0)" ::: "memory");
    }
    __syncthreads();
}

typedef GAS unsigned gu32;
#define XB_TMO      128
#define XB_XCNT(j)  (256  + 64 * (j))
#define XB_XSUB(j)  (1280 + 64 * (j))
#define XB_XGEN(j)  (2304 + 64 * (j))
#define XB_TOP      3328
#define XB_TOPGEN   3392
#define XCD_BAR_WORDS 3456
#define XB_SPIN_CAP (1u << 18)
__device__ __forceinline__ unsigned xb_ld(unsigned* p)              { return __hip_atomic_load(p, __ATOMIC_RELAXED, __HIP_MEMORY_SCOPE_AGENT); }
__device__ __forceinline__ unsigned xb_add(unsigned* p, unsigned v) { return __hip_atomic_fetch_add(p, v, __ATOMIC_RELAXED, __HIP_MEMORY_SCOPE_AGENT); }
__device__ __forceinline__ unsigned xb_xcc_id() { return (unsigned)__builtin_amdgcn_s_getreg((3 << 11) | 20) & 0xFu; }
#define XB_SPIN(cond, bar) do { unsigned _sp = 0; while (cond) { __builtin_amdgcn_s_sleep(1); \
    if ((++_sp & 255u) == 0u) { if (xb_ld(&(bar)[XB_TMO])) break; if (_sp > XB_SPIN_CAP) { atomicAdd(&(bar)[XB_TMO], 1u); break; } } } } while (0)
struct XcdBarrier { unsigned* bar; unsigned x; volatile LAS unsigned* st; };
__device__ __forceinline__ XcdBarrier xcd_barrier_post(unsigned* bar, volatile LAS unsigned* st) {
    XcdBarrier b; b.bar = bar; b.x = xb_xcc_id(); b.st = st;
    if (threadIdx.x == 0) (void)xb_add(&bar[XB_XCNT(b.x)], 1u);
    return b;
}
__device__ __forceinline__ void xcd_barrier_complete(unsigned* bar, unsigned x, unsigned& nloc, unsigned& nx) {
    const unsigned G = gridDim.x * gridDim.y * gridDim.z;
    unsigned sum, cnt, mine, sp = 0u;
    for (;;) {
        sum = 0u; cnt = 0u; mine = 0u;
#pragma unroll
        for (unsigned j = 0; j < 16; ++j) { const unsigned c = xb_ld(&bar[XB_XCNT(j)]); sum += c; cnt += (c > 0u) ? 1u : 0u; }
        if (sum == G) break;
        __builtin_amdgcn_s_sleep(1);
        if ((++sp & 255u) == 0u) { if (xb_ld(&bar[XB_TMO])) break; if (sp > XB_SPIN_CAP) { atomicAdd(&bar[XB_TMO], 1u); break; } }
    }
    mine = xb_ld(&bar[XB_XCNT(x)]);
    nloc = mine > 0u ? mine : 1u; nx = cnt > 0u ? cnt : 1u;
}
__device__ __forceinline__ void xcd_barrier(const XcdBarrier& b) {
    asm volatile("s_waitcnt vmcnt(0)" ::: "memory");
    __syncthreads();
    if (threadIdx.x == 0) {
        unsigned* bar = b.bar;
        __builtin_amdgcn_s_waitcnt(0);
        unsigned nloc = b.st[0], nx = b.st[1];
        if (nloc == 0u) { xcd_barrier_complete(bar, b.x, nloc, nx); b.st[0] = nloc; b.st[1] = nx; }
        const unsigned old = xb_add(&bar[XB_XSUB(b.x)], 1u);
        const unsigned gen = old / nloc;
        if (old + 1u == (gen + 1u) * nloc) {
            __builtin_amdgcn_fence(__ATOMIC_RELEASE, "agent");
            asm volatile("s_waitcnt vmcnt(0)" ::: "memory");
            const unsigned og = xb_add(&bar[XB_TOP], 1u);
            const unsigned tg = og / nx;
            if (og + 1u == (tg + 1u) * nx) xb_add(&bar[XB_TOPGEN], 1u);
            else XB_SPIN(xb_ld(&bar[XB_TOPGEN]) == tg, bar);
            __builtin_amdgcn_fence(__ATOMIC_ACQUIRE, "agent");
            xb_add(&bar[XB_XGEN(b.x)], 1u);
            asm volatile("s_waitcnt vmcnt(0)" ::: "memory");
        } else {
            XB_SPIN(xb_ld(&bar[XB_XGEN(b.x)]) == gen, bar);
            __builtin_amdgcn_fence(__ATOMIC_ACQUIRE, "agent");
            asm volatile("s_waitcnt vmcnt(0)" ::: "memory");
        }
    }
    __syncthreads();
}

struct Args { const float* in[28]; float* out; unsigned char* ws; int ph_lo, ph_hi, li, pad; };
typedef const __attribute__((address_space(4))) Args* KArgs;
__device__ __forceinline__ KArgs opaque_kargs() { KArgs p = (KArgs)__builtin_amdgcn_kernarg_segment_ptr(); asm volatile("" : "+s"(p)); return p; }
enum { I_X = 0, I_C, I_CTX, I_CCTX, I_WMOD, I_BMOD, I_N1G, I_N2G, I_WIN, I_QG, I_KG, I_RPB, I_LQ1, I_LK1, I_LQ2, I_LK2, I_SUBG, I_SGUNG, I_SGUW, I_SGUB, I_GATEB, I_WBR, I_WOUT, I_WRT, I_WEG, I_WEU, I_WED, I_FG };

constexpr int CW_WIN = 16 * 26, CW_WB = 4 * 4 * 4, CW_WO = 16 * 4, CW_EG = 16 * 16 * 8, CW_ED = 16 * 32 * 4, CW_LAYER = CW_WIN + CW_WB + CW_WO + 2 * CW_EG + CW_ED;
struct ConvItem { const float* src; unsigned char* dst; int N, dpitch, k0, n0, kind, aux; };
__device__ __forceinline__ ConvItem conv_decode(KArgs A, int it) {
    ConvItem c; const int l = it / CW_LAYER; int r = it % CW_LAYER; unsigned char* wl = A->ws + WS_W0 + (size_t)l * W_LAYER; c.aux = 0;
    if (r < CW_WIN) { const int kb = r / 26, pn = r % 26; c.src = A->in[I_WIN] + (size_t)l * DM * IN_W; c.N = IN_W; c.k0 = 64 * kb; c.n0 = 256 * pn; c.dpitch = DM;
        if (pn >= 5 && pn <= 20) { c.kind = 1; c.dst = wl + WO_WING + (size_t)(c.n0 - 1280) * DM; } else { c.kind = 2; c.dst = wl + WO_WIN + (size_t)256 * (pn < 5 ? pn : pn - 16) * DM * 2; }
        return c; }
    r -= CW_WIN;
    if (r < CW_WB) { const int n = r / 16, q = r % 16, kb = q / 4, nb = q % 4; c.src = A->in[I_WBR] + ((size_t)l * 4 + n) * 256 * DM; c.N = DM; c.k0 = 64 * kb; c.n0 = 256 * nb; c.dpitch = 256; c.kind = 0; c.dst = wl + WO_WB + ((size_t)n * 1024 + c.n0) * 256 * 2; return c; }
    r -= CW_WB;
    if (r < CW_WO) { const int kb = r / 4, nb = r % 4; c.src = A->in[I_WOUT] + (size_t)l * DM * DM; c.N = DM; c.k0 = 64 * kb; c.n0 = 256 * nb; c.dpitch = DM; c.kind = 0; c.dst = wl + WO_WO4 + (size_t)c.n0 * DM * 2; return c; }
    r -= CW_WO;
    if (r < 2 * CW_EG) { const int up = r >= CW_EG; if (up) r -= CW_EG; const int e = r / 128, q = r % 128, kb = q / 8, nb = q % 8; c.src = A->in[up ? I_WEU : I_WEG] + ((size_t)l * NEXP + e) * DM * EH; c.N = EH; c.k0 = 64 * kb; c.n0 = 256 * nb; c.dpitch = DM;
        c.kind = 3; c.aux = up ? 128 : 0; c.dst = wl + WO_WGU + (size_t)e * 4096 * DM; return c; }
    r -= 2 * CW_EG;
    { const int e = r / 128, q = r % 128, kb = q / 4, nb = q % 4; c.src = A->in[I_WED] + ((size_t)l * NEXP + e) * EH * DM; c.N = DM; c.k0 = 64 * kb; c.n0 = 256 * nb; c.dpitch = EH; c.kind = 1; c.dst = wl + WO_WD + ((size_t)e * DM + c.n0) * EH; return c; }
}
constexpr int CW_SMALL = CW_WIN + CW_WB + CW_WO, CW_MOE = 2 * CW_EG + CW_ED;
template <bool SMALL> __device__ __forceinline__ int conv_id(int it) { return SMALL ? (it / CW_SMALL) * CW_LAYER + it % CW_SMALL : it; }
template <bool SMALL> __device__ __forceinline__ void conv_load(KArgs A, int it, int NIT, f32x4 (&rg)[8], int wv, int lane) {
    if (it < NIT) { const ConvItem c = conv_decode(A, conv_id<SMALL>(it)); const float* p = c.src + (size_t)(c.k0 + wv * 8) * c.N + c.n0 + 4 * lane;
#pragma unroll
        for (int i = 0; i < 8; ++i) rg[i] = *(const f32x4*)(p + (size_t)i * c.N); }
}
constexpr int C8_WP = 2208, C8_JP = 528, C8_BYTES = 8 * C8_WP;
__device__ __forceinline__ void conv_out8(const ConvItem c, const f32x4 (&rg)[8], LAS unsigned char* T8, int tid, int wv, int lane) {
#pragma unroll
    for (int j = 0; j < 4; ++j) { v2u o; o.x = pk8(rg[0][j] * W8S, rg[1][j] * W8S, rg[2][j] * W8S, rg[3][j] * W8S); o.y = pk8(rg[4][j] * W8S, rg[5][j] * W8S, rg[6][j] * W8S, rg[7][j] * W8S);
        *(LAS v2u*)(T8 + wv * C8_WP + j * C8_JP + lane * 8) = o; }
    asm volatile("s_waitcnt lgkmcnt(0)" ::: "memory"); __builtin_amdgcn_s_barrier(); asm volatile("" ::: "memory");
#pragma unroll
    for (int jj = 0; jj < 2; ++jj) { const int q = tid + 512 * jj, cq = q & 3, n = q >> 2; const LAS unsigned char* t = T8 + (2 * cq) * C8_WP + (n & 3) * C8_JP + (n >> 2) * 8;
        const v2u a = *(const LAS v2u*)t, b = *(const LAS v2u*)(t + C8_WP); const int f = c.n0 + n;
        const int row = c.kind == 3 ? 256 * (f >> 7) + (f & 127) + c.aux : n;
        *(v4u*)(c.dst + (size_t)row * c.dpitch + c.k0 + 16 * cq) = (v4u){a.x, a.y, b.x, b.y}; }
}
template <bool SMALL> __device__ __forceinline__ void conv_out(KArgs A, int it, const f32x4 (&rg)[8], LAS float* T, int par, int tid, int wv, int lane) {
    { const ConvItem c8 = conv_decode(A, conv_id<SMALL>(it));
      if (!SMALL || c8.kind == 1 || c8.kind == 3) { conv_out8(c8, rg, (LAS unsigned char*)T + (SMALL ? 65536 : 0) + par * C8_BYTES, tid, wv, lane); return; } }
    constexpr int TP = 256;
#pragma unroll
    for (int i = 0; i < 8; ++i) *(LAS f32x4*)(T + (wv * 8 + i) * TP + 4 * (lane ^ wv)) = rg[i];
    asm volatile("s_waitcnt lgkmcnt(0)" ::: "memory"); __builtin_amdgcn_s_barrier(); asm volatile("" ::: "memory");
    const ConvItem c = conv_decode(A, conv_id<SMALL>(it));
#pragma unroll
    for (int jj = 0; jj < 4; ++jj) { const int q = tid + 512 * jj, ch = q & 7, n = q >> 3; const LAS float* t = T + (8 * ch) * TP + (n ^ (4 * ch));
        float v[8];
#pragma unroll
        for (int i = 0; i < 8; ++i) v[i] = t[i * TP];
        if (c.kind == 1) { v2u o; o.x = pk8(v[0] * W8S, v[1] * W8S, v[2] * W8S, v[3] * W8S); o.y = pk8(v[4] * W8S, v[5] * W8S, v[6] * W8S, v[7] * W8S); *(v2u*)(c.dst + (size_t)n * c.dpitch + c.k0 + 8 * ch) = o; }
        else if (c.kind == 3) { const int f = c.n0 + n; v2u o; o.x = pk8(v[0] * W8S, v[1] * W8S, v[2] * W8S, v[3] * W8S); o.y = pk8(v[4] * W8S, v[5] * W8S, v[6] * W8S, v[7] * W8S); *(v2u*)(c.dst + (size_t)(256 * (f >> 7) + (f & 127) + c.aux) * c.dpitch + c.k0 + 8 * ch) = o; }
        else { const int g = n >> 5, row = c.kind == 2 ? 32 * (4 * (g & 1) + (g >> 1)) + (n & 31) : n; st8((bf16_t*)c.dst + (size_t)row * c.dpitch + c.k0 + 8 * ch, v); } }
    asm volatile("s_waitcnt lgkmcnt(0)" ::: "memory"); __builtin_amdgcn_s_barrier(); asm volatile("" ::: "memory");
}
template <bool SMALL = false> __device__ __forceinline__ void conv_run(KArgs A, int first, int stride, int end, LAS unsigned char* lds, int tid) {
    const int lane = tid & 63, wv = tid >> 6; LAS float* T = (LAS float*)lds;
    f32x4 rg[4][8];
#pragma unroll
    for (int d = 0; d < 4; ++d) conv_load<SMALL>(A, first + d * stride, end, rg[d], wv, lane);
    for (int it = first; it < end; it += 4 * stride) {
#pragma unroll
        for (int d = 0; d < 4; ++d) if (it + d * stride < end) {
            f32x4 t0[8];
#pragma unroll
            for (int i = 0; i < 8; ++i) t0[i] = rg[d][i];
            conv_load<SMALL>(A, it + (4 + d) * stride, end, rg[d], wv, lane);
            conv_out<SMALL>(A, it + d * stride, t0, T, d & 1, tid, wv, lane);
        }
    }
    asm volatile("s_waitcnt lgkmcnt(0)" ::: "memory"); __builtin_amdgcn_s_barrier(); asm volatile("" ::: "memory");
}
__device__ __forceinline__ void mod_item(KArgs A, int item, LAS unsigned char* lds, int tid) {
    const int lane = tid & 63, wid = tid >> 6, l = item / 96, col0 = 64 * (item % 96);
    LAS float* sil = (LAS float*)lds;
    LAS float* part = sil + 3 * 1024;
    for (int i = tid; i < 3 * 1024; i += 512) { const int r = i >> 10, k = i & 1023; const float cv = r < 2 ? A->in[I_C][r * DM + k] : A->in[I_CCTX][k]; sil[i] = siluf_(cv); }
    __syncthreads();
    const float* W = A->in[I_WMOD] + (size_t)l * DM * 6144 + col0 + lane;
    float a0 = 0.f, a1 = 0.f, a2 = 0.f;
    for (int kb = 0; kb < 4; ++kb) { float w[32];
#pragma unroll
        for (int q = 0; q < 32; ++q) w[q] = W[(size_t)(wid * 128 + kb * 32 + q) * 6144];
        __builtin_amdgcn_sched_barrier(0);
#pragma unroll
        for (int q = 0; q < 32; ++q) { const int k = wid * 128 + kb * 32 + q; a0 += sil[k] * w[q]; a1 += sil[1024 + k] * w[q]; a2 += sil[2048 + k] * w[q]; }
        __builtin_amdgcn_sched_barrier(0); }
    part[(wid * 3 + 0) * 64 + lane] = a0; part[(wid * 3 + 1) * 64 + lane] = a1; part[(wid * 3 + 2) * 64 + lane] = a2;
    __syncthreads();
    if (tid < 192) { const int r = tid >> 6, cl = tid & 63; float s = A->in[I_BMOD][(size_t)l * 6144 + col0 + cl];
#pragma unroll
        for (int w = 0; w < 8; ++w) s += part[(w * 3 + r) * 64 + cl];
        ((float*)(A->ws + WS_MOD))[((size_t)l * 3 + r) * 6144 + col0 + cl] = s; }
    __syncthreads();
}

struct Row { f32x4 v[4]; };
__device__ __forceinline__ Row row_load(const float* p, int lane) { Row r; const f32x4* q = (const f32x4*)p + lane;
#pragma unroll
    for (int j = 0; j < 4; ++j) r.v[j] = q[64 * j]; return r; }
__device__ __forceinline__ Row row_load_bf16(const bf16_t* p, int lane) { Row r; const v2u* q = (const v2u*)p + lane; v2u t[4];
#pragma unroll
    for (int j = 0; j < 4; ++j) t[j] = q[64 * j];
#pragma unroll
    for (int j = 0; j < 4; ++j) r.v[j] = (f32x4){bflo(t[j].x), bfhi(t[j].x), bflo(t[j].y), bfhi(t[j].y)};
    return r; }
__device__ __forceinline__ void row_store(float* p, const Row& r, int lane) { f32x4* q = (f32x4*)p + lane;
#pragma unroll
    for (int j = 0; j < 4; ++j) q[64 * j] = r.v[j]; }
__device__ __forceinline__ float row_rstd(const Row& r) { float s = 0.f;
#pragma unroll
    for (int j = 0; j < 4; ++j) s += (r.v[j].x * r.v[j].x + r.v[j].y * r.v[j].y) + (r.v[j].z * r.v[j].z + r.v[j].w * r.v[j].w);
    return __builtin_amdgcn_rsqf(wave_sum(s) * (1.0f / DM) + EPS); }
__device__ __forceinline__ Row row_normmod(const Row& x, float rstd, const float* g, const float* sh, const float* sc, int lane) { Row y; f32x4 gg[4], ss[4], hh[4];
#pragma unroll
    for (int j = 0; j < 4; ++j) { gg[j] = ((const f32x4*)g)[lane + 64 * j]; ss[j] = ((const f32x4*)sc)[lane + 64 * j]; hh[j] = ((const f32x4*)sh)[lane + 64 * j]; }
    __builtin_amdgcn_sched_barrier(0);
#pragma unroll
    for (int j = 0; j < 4; ++j) y.v[j] = x.v[j] * rstd * gg[j] * (ss[j] + 1.0f) + hh[j];
    return y; }
struct NormP { f32x4 a[4], h[4]; };
__device__ __forceinline__ NormP normp_load(const float* g, const float* sh, const float* sc, int lane) { NormP p; f32x4 gg[4], ss[4];
#pragma unroll
    for (int j = 0; j < 4; ++j) { gg[j] = ((const f32x4*)g)[lane + 64 * j]; ss[j] = ((const f32x4*)sc)[lane + 64 * j]; p.h[j] = ((const f32x4*)sh)[lane + 64 * j]; }
    __builtin_amdgcn_sched_barrier(0);
#pragma unroll
    for (int j = 0; j < 4; ++j) p.a[j] = gg[j] * (ss[j] + 1.0f);
    return p; }
__device__ __forceinline__ Row row_normmod_p(const Row& x, float rstd, const NormP& p) { Row y;
#pragma unroll
    for (int j = 0; j < 4; ++j) y.v[j] = x.v[j] * rstd * p.a[j] + p.h[j];
    return y; }
__device__ __forceinline__ void row_store_bf16(bf16_t* p, const Row& r, int lane) { v2u* q = (v2u*)p + lane;
#pragma unroll
    for (int j = 0; j < 4; ++j) { v2u w; w.x = cvtpk(r.v[j].x, r.v[j].y); w.y = cvtpk(r.v[j].z, r.v[j].w); q[64 * j] = w; } }
__device__ __forceinline__ void row_store_fp8(unsigned char* p, const Row& r, int lane) { unsigned* q = (unsigned*)p + lane;
#pragma unroll
    for (int j = 0; j < 4; ++j) q[64 * j] = pk8(r.v[j].x, r.v[j].y, r.v[j].z, r.v[j].w); }
__device__ __forceinline__ const float* in_row(KArgs A, int R) { const int b = R / RB, r = R % RB; return r < CTXL ? A->in[I_CTX] + ((size_t)b * CTXL + r) * DM : A->in[I_X] + ((size_t)b * SEQ + (r - CTXL)) * DM; }
__device__ __forceinline__ int mod_row(int R) { const int b = R / RB, r = R % RB; return r < CTXL ? 2 : b; }

__device__ __forceinline__ int lat_tile(int im) { return (im >> 5) * TPB + 1 + (im & 31); }
struct SchedP1 { const char* HN; const char* W; int layer, G, c;
    __device__ __forceinline__ bool next(int i, pg8::Unit& u) const {
        const int nmain = 64 * 10, nextra = layer == 0 ? 2 * 10 : 2 * 5; const int L = i * G + c; if (L >= nmain + nextra) return false;
        int pm, pq;
        if (L < nmain) { int im, in; pg8::rect_order(L, 64, 10, im, in); pm = lat_tile(im); pq = in; }
        else { const int x = L - nmain; if (layer == 0) { pm = (x / 10) * TPB; pq = x % 10; } else { pm = (x / 5) * TPB; pq = 5 + x % 5; } }
        u.pm = pm; u.pn = pq < 5 ? pq : pq + 16; u.a = HN + (size_t)pm * 256 * DM * 2; u.b = W + (size_t)pq * 256 * DM * 2; return true; } };
struct SchedP1g { const char* HN8; const char* W8; int layer, G, c;
    __device__ __forceinline__ bool next(int i, pg8::Unit& u) const {
        const int nmain = 64 * 16, nextra = layer == 0 ? 2 * 16 : 0; const int L = i * G + (G - 1 - c); if (L >= nmain + nextra) return false;
        int pm, pn;
        if (L < nmain) { int im; pg8::rect_order(L, 64, 16, im, pn); pm = lat_tile(im); }
        else { const int x = L - nmain; pm = (x >> 4) * TPB; pn = x & 15; }
        u.pm = pm; u.pn = pn; u.a = HN8 + (size_t)pm * 256 * DM; u.b = W8 + (size_t)pn * 256 * DM; return true; } };
struct SchedP3a { const char* YS; const char* WB; int layer, G, c;
    __device__ __forceinline__ bool next(int i, pg8::Unit& u) const {
        int pm, dt, n;
        if (i < 4) { if (c >= 256) return false; int im; pg8::rect_order(c, 64, 4, im, dt); pm = lat_tile(im); n = i; }
        else { if (i > 4 || layer != 0 || c >= 32) return false; pm = (c >> 4) * TPB; dt = (c >> 2) & 3; n = c & 3; }
        u.pm = pm; u.pn = dt * 4 + n; u.a = YS + ((size_t)pm * 256 * DM + 256 * n) * 2; u.b = WB + ((size_t)n * 1024 + dt * 256) * 256 * 2; return true; } };
struct SchedP3b { const char* MRG; const char* WO; int G, c;
    __device__ __forceinline__ bool next(int i, pg8::Unit& u) const {
        const int L = i * G + c; if (L >= 64 * 4) return false;
        int im, in; pg8::rect_order(L, 64, 4, im, in); const int pm = lat_tile(im);
        u.pm = pm; u.pn = in; u.a = MRG + (size_t)pm * 256 * DM * 2; u.b = WO + (size_t)in * 256 * DM * 2; return true; } };
struct SchedP3c { const char* GPC; const char* WO; int G, c;
    __device__ __forceinline__ bool next(int i, pg8::Unit& u) const {
        const int L = i * G + c; if (L >= 128) return false;
        const int pm = L >> 6, ks = (L >> 2) & 15, ct = L & 3, n = ks >> 2, kq = ks & 3;
        u.pm = pm; u.pn = ks * 4 + ct; u.a = GPC + (((size_t)n * 512 + pm * 256) * DM + kq * 256) * 2; u.b = WO + ((size_t)ct * 256 * DM + kq * 256) * 2; return true; } };
struct SchedP6 { const char* XG; const char* WGU; int RT, G, c;
    __device__ __forceinline__ bool next(int i, pg8::Unit& u) const {
        const int nM = 16 * RT; const int L = i * G + c; if (L >= nM * 16) return false;
        int im, in; pg8::rect_order(L, nM, 16, im, in); const int e = im / RT;
        u.pm = im; u.pn = in; u.a = XG + (size_t)im * 256 * DM; u.b = WGU + ((size_t)e * 4096 + in * 256) * DM; return true; } };
struct SchedP7 { const char* HID; const char* WD; int RT, G, c;
    __device__ __forceinline__ bool next(int i, pg8::Unit& u) const {
        const int nM = 16 * 8; const int L = i * G + c; if (L >= nM * 4) return false;
        int im8, in; pg8::rect_order(L, nM, 4, im8, in); const int e = im8 >> 3, im = e * RT + (im8 & 7);
        u.pm = im; u.pn = in; u.a = HID + (size_t)im * 256 * EH; u.b = WD + ((size_t)e * DM + in * 256) * EH; return true; } };
struct SchedP7c { const char* HID; const char* WD; int G, c;
    __device__ __forceinline__ bool next(int i, pg8::Unit& u) const {
        const int L = i * G + c; if (L >= 256) return false;
        const int e = L >> 4, in = (L >> 2) & 3, kq = L & 3, im = e * 9 + 8;
        u.pm = im; u.pn = in + 4 * kq; u.a = HID + (size_t)im * 256 * EH + kq * 512; u.b = WD + ((size_t)e * DM + in * 256) * EH + kq * 512; return true; } };

__device__ __forceinline__ unsigned block_excl_scan(unsigned v, LAS unsigned* wtot, int lane, int wid) {
    unsigned inc = v;
#pragma unroll
    for (int o = 1; o < 64; o <<= 1) { const unsigned t = (unsigned)__builtin_amdgcn_ds_bpermute(((lane - o) & 63) << 2, (int)inc); if (lane >= o) inc += t; }
    if (lane == 63) wtot[wid] = inc;
    __syncthreads();
    unsigned base = 0;
#pragma unroll
    for (int w = 0; w < 8; ++w) base += (w < wid) ? wtot[w] : 0u;
    __syncthreads();
    return base + inc - v;
}
__device__ __forceinline__ void topk_unit(KArgs A, int RT, bool isctx, int b, int e, LAS unsigned char* lds, int tid) {
    const int lane = tid & 63, wid = tid >> 6;
    LAS unsigned* hist = (LAS unsigned*)lds; LAS unsigned* wtot = hist + 256; LAS unsigned* sel = wtot + 16;
    const int cap = isctx ? 32 : 1024;
    const float* aff = isctx ? (const float*)(A->ws + WS_AFFC) + ((size_t)b * 16 + e) * 256 : (const float*)(A->ws + WS_AFFL) + ((size_t)b * 16 + e) * 8192;
    unsigned key[16];
    if (isctx) {
#pragma unroll
        for (int j = 0; j < 16; ++j) key[j] = 0u;
        if (tid < 256) key[0] = __float_as_uint(aff[tid]);
    } else {
#pragma unroll
        for (int q = 0; q < 4; ++q) { const f32x4 t = *(const f32x4*)(aff + tid * 16 + 4 * q); key[4 * q] = __float_as_uint(t.x); key[4 * q + 1] = __float_as_uint(t.y); key[4 * q + 2] = __float_as_uint(t.z); key[4 * q + 3] = __float_as_uint(t.w); }
    }
#define TK_VALID(j) (isctx ? ((j) == 0 && tid < 256) : true)
    unsigned pfx = 0u, need = (unsigned)cap;
    for (int pass = 0; pass < 4; ++pass) { const int shift = 24 - 8 * pass;
        for (int i = tid; i < 256; i += 512) hist[i] = 0u;
        __syncthreads();
#pragma unroll
        for (int j = 0; j < 16; ++j) if (TK_VALID(j) && (pass == 0 || (key[j] >> (shift + 8)) == pfx)) __hip_atomic_fetch_add(&hist[(key[j] >> shift) & 255u], 1u, __ATOMIC_RELAXED, __HIP_MEMORY_SCOPE_WORKGROUP);
        __syncthreads();
        if (wid == 0) {
            const unsigned h0 = hist[4 * lane], h1 = hist[4 * lane + 1], h2 = hist[4 * lane + 2], h3 = hist[4 * lane + 3], s = h0 + h1 + h2 + h3;
            unsigned incl = s;
#pragma unroll
            for (int o = 1; o < 64; o <<= 1) { const unsigned t = (unsigned)__builtin_amdgcn_ds_bpermute(((lane + o) & 63) << 2, (int)incl); if (lane + o < 64) incl += t; }
            const unsigned excl = incl - s;
            if (excl < need && need <= incl) { unsigned c = excl; int bin;
                if (c + h3 >= need) bin = 3; else { c += h3; if (c + h2 >= need) bin = 2; else { c += h2; if (c + h1 >= need) bin = 1; else { c += h1; bin = 0; } } }
                sel[0] = (unsigned)(4 * lane + bin); sel[1] = need - c; }
        }
        __syncthreads();
        pfx = (pfx << 8) | sel[0]; need = sel[1];
        __syncthreads();
    }
    const unsigned T = pfx;
    unsigned ce = 0u;
#pragma unroll
    for (int j = 0; j < 16; ++j) ce += (TK_VALID(j) && key[j] == T) ? 1u : 0u;
    unsigned re = block_excl_scan(ce, wtot, lane, wid);
    unsigned selmask = 0u, cs = 0u;
#pragma unroll
    for (int j = 0; j < 16; ++j) if (TK_VALID(j)) { bool s = key[j] > T; if (key[j] == T) { s = re < need; ++re; } if (s) { selmask |= 1u << j; ++cs; } }
    unsigned slot = block_excl_scan(cs, wtot, lane, wid);
    int* IDXROW = (int*)(A->ws + WS_IDXROW); float* SCORE = (float*)(A->ws + WS_SCORE); int* INV = (int*)(A->ws + WS_INV);
    const int ybase = e * RT * 256 + (isctx ? 2048 + b * 32 : b * 1024);
#pragma unroll
    for (int j = 0; j < 16; ++j) if (TK_VALID(j)) { const int idx = isctx ? tid : tid * 16 + j; const int R = b * RB + (isctx ? idx : CTXL + idx);
        if (selmask & (1u << j)) { const int yrow = ybase + (int)slot; IDXROW[yrow] = R; SCORE[yrow] = __uint_as_float(key[j]); INV[((size_t)b * 16 + e) * RB + (R - b * RB)] = yrow; ++slot; }
        else INV[((size_t)b * 16 + e) * RB + (R - b * RB)] = -1; }
    if (isctx && b == 0 && tid < 192) IDXROW[e * RT * 256 + 2048 + 64 + tid] = -1;
#undef TK_VALID
    __syncthreads();
}

struct AJob { const attn_body::bf16 *Q, *K, *V; attn_body::bf16* O; int nt, mode, normed; const float* kmax; };
__device__ __forceinline__ bool mixer_job(unsigned char* ws, int l, int vcu, int i, AJob& j) {
    using attn_body::bf16;
    const bf16* QKV = (const bf16*)(ws + WS_QKV); bf16* YS = (bf16*)(ws + WS_YS); j.normed = 0; j.kmax = nullptr; const float* KNB = (const float*)(ws + WS_KNB) + l * 32;
    if (i < 3) { const int b = vcu >> 7, h = (vcu >> 5) & 3, qb = vcu & 31; const long q0 = (long)b * RB + CTXL + qb * 256, k0 = (long)b * RB;
        if (i < 2) { const int vh = 2 * h + i; j.Q = QKV + q0 * PQ + C_QB + vh * 64; j.K = QKV + k0 * PQ + C_KB + vh * 64; j.V = QKV + k0 * PQ + C_VB + h * 64; j.O = YS + q0 * 1024 + 256 + h * 64; j.nt = 132; j.mode = 1 + i; j.kmax = KNB + b * 8 + vh; }
        else { j.Q = QKV + q0 * PQ + C_QD + h * 64; j.K = QKV + k0 * PQ + C_KD + (h >> 1) * 64; j.V = QKV + k0 * PQ + C_VD + (h >> 1) * 64; j.O = YS + q0 * 1024 + 768 + h * 64; j.nt = 132; j.mode = 0; j.normed = 1; }
        return true; }
    if (l != 0) return false;
    const int uc = (vcu + 256 - 132) & 255; if (uc >= 24) return false;
    const int type = uc >> 3, b = (uc >> 2) & 1, h = uc & 3, k = i - 3; const long q0 = (long)b * RB;
    j.nt = 4;
    if (type == 0) { if (k > 0) return false; j.Q = QKV + q0 * PQ + C_QA + h * 64; j.K = QKV + q0 * PQ + C_KA + h * 64; j.V = QKV + q0 * PQ + C_VA + h * 64; j.O = YS + q0 * 1024 + h * 64; j.mode = 0; return true; }
    if (type == 1) { if (k > 1) return false; const int vh = 2 * h + k; j.Q = QKV + q0 * PQ + C_QB + vh * 64; j.K = QKV + q0 * PQ + C_KB + vh * 64; j.V = QKV + q0 * PQ + C_VB + h * 64; j.O = YS + q0 * 1024 + 256 + h * 64; j.mode = 1 + k; j.kmax = KNB + b * 8 + vh; return true; }
    if (k > 0) return false; j.Q = QKV + q0 * PQ + C_QD + h * 64; j.K = QKV + q0 * PQ + C_KD + (h >> 1) * 64; j.V = QKV + q0 * PQ + C_VD + (h >> 1) * 64; j.O = YS + q0 * 1024 + 768 + h * 64; j.mode = 0; j.normed = 1; return true;
}

__global__ void __launch_bounds__(512, 2) fwd_kernel(Args A_) {
    extern __shared__ __attribute__((aligned(16))) unsigned char lds[];
    LAS unsigned char* L = (LAS unsigned char*)lds;
    const int tid0 = threadIdx.x;
    const int G0 = gridDim.x, bx0 = blockIdx.x;
    unsigned char* ws = A_.ws;
    for (int u = tid0; u < (LDS_BYTES - LDSCTL_OFF) / 4; u += 512) ((LAS unsigned*)(L + LDSCTL_OFF))[u] = 0u;
    __syncthreads();
    XcdBarrier bar; bar.bar = (unsigned*)(ws + WS_CTL) + CW_BAR + A_.li * XCD_BAR_WORDS; bar.x = 0; bar.st = nullptr;
    if (!MK_PER_PHASE) bar = xcd_barrier_post((unsigned*)(ws + WS_CTL) + CW_BAR + A_.li * XCD_BAR_WORDS, (volatile LAS unsigned*)(L + MISC_OFF) + 8);
#define PHASE_PTRS KArgs A = opaque_kargs(); unsigned char* ws = A->ws; const int G = opaque_s(G0), bx = opaque_s(bx0), vcu = (bx % 8) * (G / 8) + bx / 8, wave = __builtin_amdgcn_readfirstlane(opaque_tid() >> 6), gw = vcu * 8 + wave, NGW = G * 8; (void)gw; (void)NGW; (void)vcu; const float* MOD = (const float*)(ws + WS_MOD); bf16_t* HN = (bf16_t*)(ws + WS_HN); bf16_t* H2 = (bf16_t*)(ws + WS_H2); bf16_t* YS = (bf16_t*)(ws + WS_YS); \
    bf16_t* GT = (bf16_t*)(ws + WS_GT); bf16_t* X1 = (bf16_t*)(ws + WS_X1); bf16_t* XR = (bf16_t*)(ws + WS_XR); float* PART = (float*)(ws + WS_PART); \
    (void)MOD; (void)HN; (void)H2; (void)YS; (void)GT; (void)X1; (void)XR; (void)PART;
    const int lo = A_.ph_lo, hi = A_.ph_hi;
#ifndef DBG_MASK
#define DBG_MASK 0xffffffffu
#endif
#define PHON(k) ((DBG_MASK >> ((k) < 2 ? (k) : 2 + ((k) - 2) % 10)) & 1u)
#define IN(k) (PHON(k) && lo <= (k) && (k) < hi)
#define SEAM(k) do { if (!MK_PER_PHASE && (k) + 1 < hi) { XcdBarrier b2_ = bar; b2_.bar = (unsigned*)opaque_ptr((unsigned char*)bar.bar); xcd_barrier(b2_); } } while (0)

    if (IN(0)) { PHASE_PTRS
        const int tid = opaque_tid(), lane = tid & 63; (void)tid; (void)lane;
        for (int item = bx; item < 192; item += G) mod_item(A, item, L, tid);
        __syncthreads();
        SEAM(0);
    }
    if (IN(1)) { PHASE_PTRS
        const int tid = opaque_tid(), lane = tid & 63; (void)tid; (void)lane;
        { const int Ra = gw * 9, Rb = min(Ra + 9, NR);
          Row xn = row_load(in_row(A, min(Ra, NR - 1)), lane), xn2 = row_load(in_row(A, min(Ra + 1, NR - 1)), lane), xn3 = row_load(in_row(A, min(Ra + 2, NR - 1)), lane);
          int cur = mod_row(min(Ra, NR - 1)); NormP np; { const float* m = MOD + (size_t)cur * 6144; np = normp_load(A->in[I_N1G], m, m + 1024, lane); }
          for (int R = Ra; R < Rb; ++R) { const Row x = xn; xn = xn2; xn2 = xn3; if (R + 3 < Rb) xn3 = row_load(in_row(A, R + 3), lane);
            const int mr = mod_row(R); if (mr != cur) { const float* m = MOD + (size_t)mr * 6144; np = normp_load(A->in[I_N1G], m, m + 1024, lane); cur = mr; }
            const Row y = row_normmod_p(x, row_rstd(x), np); row_store_bf16(HN + (size_t)R * DM, y, lane); row_store_fp8(ws + WS_HN8 + (size_t)R * DM, y, lane); } }
        __syncthreads();
        conv_run<true>(A, vcu, G, DEPTH * CW_SMALL, L, tid);
        SEAM(1);
    }
    for (int l = 0; l < DEPTH; ++l) {
        const int P = 2 + 10 * l; const int RT = l == 0 ? 9 : 8;
#define LAYER_PTRS PHASE_PTRS unsigned char* wl = ws + WS_W0 + (size_t)l * W_LAYER; const float* MODL = MOD + (size_t)l * 3 * 6144; (void)wl; (void)MODL;
        if (IN(P + 0)) { LAYER_PTRS
            { SchedP1 S{(const char*)HN, (const char*)(wl + WO_WIN), l, G, bx};
              EpiInProj E{(bf16_t*)(ws + WS_QKV), GT, A->in[I_QG] + l * 64, A->in[I_KG] + l * 64, A->in[I_GATEB] + (size_t)l * 4096, (float*)(ws + WS_KNB) + l * 32};
              pg8::gemm_phase<EpiInProj, SchedP1>(L, DM, DM, DM, S, E); }
            { SchedP1g S{(const char*)(ws + WS_HN8), (const char*)(wl + WO_WING), l, G, bx}; EpiGates E{(unsigned char*)GT, A->in[I_GATEB] + (size_t)l * 4096};
              pg8::gemm8_phase<EpiGates, SchedP1g>(L, DM / 2, DM / 2, DM / 2, S, E); }
            SEAM(P + 0);
        }
        if (IN(P + 1)) { LAYER_PTRS
            const int tid = opaque_tid(), lane = tid & 63; (void)tid; (void)lane;
            float s1 = lane < 32 ? A->in[I_LQ1][l * 32 + lane] * A->in[I_LK1][l * 32 + lane] : 0.f, s2 = lane < 32 ? A->in[I_LQ2][l * 32 + lane] * A->in[I_LK2][l * 32 + lane] : 0.f;
            const float lam_init = l == 0 ? 0.2f : 0.35550906759096934f;
            const float lam = expf(wave_sum(s1)) - expf(wave_sum(s2)) + lam_init;
            const attn_body::DiffEpi de{lam, 1.0f - lam_init, A->in[I_SUBG] + l * 64};
            const float gqm = wave_max(fabsf(A->in[I_QG][l * 64 + lane])), gkm = wave_max(fabsf(A->in[I_KG][l * 64 + lane]));
            const bool gqa_nomax = __builtin_amdgcn_readfirstlane((int)(64.0f * gqm * gkm * C2A * 1.05f <= 40.0f)) != 0;
            const int cslot = vcu & 3, cbase = l * CW_LAYER + CW_SMALL + vcu * (CW_MOE / 256);
#define CONV_SEAM(k) do { if (cslot == (k)) conv_run(A, cbase, 1, cbase + CW_MOE / 256, L, opaque_tid()); } while (0)
            static_assert(CW_MOE % 256 == 0, "expert-weight items split evenly over 256 CUs");
            CONV_SEAM(0);
            AJob j;
            for (int i = 0; mixer_job(ws, l, vcu, i, j); ++i) {
                if (i == 2) CONV_SEAM(1);
                if (i == 3) CONV_SEAM(2);
                if (j.mode == 0) attn_body::attn_unit<8, 0>(j.Q, j.K, j.V, j.nt, j.O, (char*)lds, de, !(j.normed && gqa_nomax));
                else if (j.mode == 1) attn_body::attn_unit<8, 1>(j.Q, j.K, j.V, j.nt, j.O, (char*)lds, de, true, j.kmax);
                else attn_body::attn_unit<8, 2>(j.Q, j.K, j.V, j.nt, j.O, (char*)lds, de, true, j.kmax);
            }
            if (l != 0 || ((vcu + 256 - 132) & 255) >= 24) CONV_SEAM(2);
            { const int b = vcu >> 7, h = (vcu >> 5) & 3, g4 = vcu & 31;
              attn_body::na_unit(b, h, g4, (const attn_body::bf16*)(ws + WS_QKV), (attn_body::bf16*)YS, A->in[I_RPB] + ((size_t)l * 4 + h) * 465, (char*)lds, (const float*)(ws + WS_KNB) + l * 32 + 16 + b * 4 + h); }
            CONV_SEAM(3);
            const int nsgu = 128 + (l == 0 ? 4 : 0);
            if (vcu < nsgu) { const long rowbase = vcu < 128 ? (long)(vcu >> 6) * RB + CTXL + (vcu & 63) * 128 : (long)((vcu - 128) >> 1) * RB + ((vcu - 128) & 1) * 128;
                sgu_unit(rowbase, (const bf16_t*)(ws + WS_QKV) + C_GU, (const bf16_t*)(ws + WS_QKV) + C_GV, A->in[I_SGUNG] + l * 256, A->in[I_SGUW] + (size_t)l * 4 * 128 * 128, A->in[I_SGUB] + l * 4 * 128, YS, (char*)lds); }
            SEAM(P + 1);
        }
        if (IN(P + 2)) { LAYER_PTRS
            SchedP3a S{(const char*)YS, (const char*)(wl + WO_WB), l, G, bx}; EpiGateAcc E{(const unsigned char*)GT, (bf16_t*)(ws + WS_MRG), (bf16_t*)(ws + WS_GPC)};
            pg8::gemm_phase<EpiGateAcc, SchedP3a>(L, 256, DM, 256, S, E);
            SEAM(P + 2);
        }
        if (IN(P + 3)) { LAYER_PTRS
            { SchedP3b S{(const char*)(ws + WS_MRG), (const char*)(wl + WO_WO4), G, bx}; EpiOutRes E{A->in[I_X], A->in[I_CTX], XR, X1, MODL, l};
              pg8::gemm_phase<EpiOutRes, SchedP3b>(L, DM, DM, DM, S, E); }
            if (l == 0) { SchedP3c S{(const char*)(ws + WS_GPC), (const char*)(wl + WO_WO4), G, bx}; EpiPart E{PART};
              pg8::gemm_phase<EpiPart, SchedP3c>(L, 256, DM, DM, S, E); }
            SEAM(P + 3);
        }
        if (IN(P + 4)) { LAYER_PTRS
            const int tid = opaque_tid(), lane = tid & 63; (void)tid; (void)lane;
            LAS float* wrT = (LAS float*)L;
            const float* wr = A->in[I_WRT] + (size_t)l * DM * 16;
            { f32x4 wv[8];
#pragma unroll
              for (int q = 0; q < 8; ++q) wv[q] = ((const f32x4*)wr)[tid + 512 * q];
              __builtin_amdgcn_sched_barrier(0);
#pragma unroll
              for (int q = 0; q < 8; ++q) { const int i4 = tid + 512 * q, k = i4 >> 2, e0 = (i4 & 3) * 4;
#pragma unroll
                  for (int j = 0; j < 4; ++j) wrT[(e0 + j) * DM + k] = wv[q][j]; } }
            __syncthreads();
            const int nit = 8 + ((l == 0 && gw < 512) ? 1 : 0);
            Row xn; { const int i0 = gw * 8; xn = row_load_bf16(X1 + ((size_t)(i0 >> 13) * RB + CTXL + (i0 & 8191)) * DM, lane); }
            NormP np; { const float* m0 = MODL + (size_t)((gw * 8) >> 13) * 6144; np = normp_load(A->in[I_N2G] + l * DM, m0 + 3072, m0 + 4096, lane); }
            for (int it = 0; it < nit; ++it) { const int i = it < 8 ? gw * 8 + it : 16384 + gw; const bool isctx = i >= 16384; const int b = isctx ? (i - 16384) >> 8 : i >> 13, r = isctx ? (i - 16384) & 255 : CTXL + (i & 8191); const int R = b * RB + r;
                const float* m = MODL + (size_t)(isctx ? 2 : b) * 6144;
                Row x = xn;
                if (it + 1 < 8) { const int in = i + 1; xn = row_load_bf16(X1 + ((size_t)(in >> 13) * RB + CTXL + (in & 8191)) * DM, lane); }
                if (isctx) { x = row_load(in_row(A, R), lane); Row s;
#pragma unroll
                    for (int j = 0; j < 4; ++j) s.v[j] = (f32x4){0.f, 0.f, 0.f, 0.f};
                    for (int ks = 0; ks < 16; ks += 4) { Row p[4];
#pragma unroll
                        for (int q = 0; q < 4; ++q) p[q] = row_load(PART + ((size_t)(ks + q) * 512 + b * 256 + r) * DM, lane);
                        __builtin_amdgcn_sched_barrier(0);
#pragma unroll
                        for (int q = 0; q < 4; ++q)
#pragma unroll
                            for (int j = 0; j < 4; ++j) s.v[j] += p[q].v[j]; }
#pragma unroll
                    for (int j = 0; j < 4; ++j) x.v[j] += ((const f32x4*)(m + 2048))[lane + 64 * j] * s.v[j];
                    row_store_bf16(X1 + (size_t)R * DM, x, lane);
                }
                if (isctx) np = normp_load(A->in[I_N2G] + l * DM, m + 3072, m + 4096, lane);
                const Row h = row_normmod_p(x, row_rstd(x), np);
                { unsigned* hq = (unsigned*)((unsigned char*)H2 + (size_t)R * DM) + lane;
#pragma unroll
                  for (int j = 0; j < 4; ++j) hq[64 * j] = pk8(h.v[j].x, h.v[j].y, h.v[j].z, h.v[j].w); }
                float lg[16];
#pragma unroll
                for (int e = 0; e < 16; ++e) { f32x2 a2 = (f32x2){0.f, 0.f};
#pragma unroll
                    for (int j = 0; j < 4; ++j) { const f32x4 w = *(const LAS f32x4*)(wrT + e * DM + 4 * lane + 256 * j);
                        a2 = __builtin_elementwise_fma((f32x2){h.v[j].x, h.v[j].y}, (f32x2){w.x, w.y}, a2); a2 = __builtin_elementwise_fma((f32x2){h.v[j].z, h.v[j].w}, (f32x2){w.z, w.w}, a2); }
                    lg[e] = a2.x + a2.y; if ((e & 3) == 3) __builtin_amdgcn_sched_barrier(0); }
                float c8[8], d[4];
#pragma unroll
                for (int i = 0; i < 8; ++i) { auto rr = __builtin_amdgcn_permlane32_swap(__float_as_uint(lg[i]), __float_as_uint(lg[i + 8]), false, false); c8[i] = __uint_as_float(rr[0]) + __uint_as_float(rr[1]); }
#pragma unroll
                for (int i = 0; i < 4; ++i) { auto rr = __builtin_amdgcn_permlane16_swap(__float_as_uint(c8[i]), __float_as_uint(c8[i + 4]), false, false); d[i] = row16_sum(__uint_as_float(rr[0]) + __uint_as_float(rr[1])); }
                float mx = fmaxf(fmaxf(d[0], d[1]), fmaxf(d[2], d[3]));
                { auto rr = __builtin_amdgcn_permlane16_swap(__float_as_uint(mx), __float_as_uint(mx), false, false); mx = fmaxf(__uint_as_float(rr[0]), __uint_as_float(rr[1])); }
                { auto rr = __builtin_amdgcn_permlane32_swap(__float_as_uint(mx), __float_as_uint(mx), false, false); mx = fmaxf(__uint_as_float(rr[0]), __uint_as_float(rr[1])); }
#pragma unroll
                for (int i = 0; i < 4; ++i) d[i] = __expf(d[i] - mx);
                const float sum = xor32_sum(xor16_sum((d[0] + d[1]) + (d[2] + d[3])));
                const int li = lane & 15, ex = 4 * (lane >> 4) + li;
                float mine = li == 0 ? d[0] : li == 1 ? d[1] : li == 2 ? d[2] : d[3];
                mine = mine / sum;
                if (li < 4) { if (isctx) ((float*)(ws + WS_AFFC))[((size_t)b * 16 + ex) * 256 + r] = mine; else ((float*)(ws + WS_AFFL))[((size_t)b * 16 + ex) * 8192 + (r - CTXL)] = mine; }
            }
            SEAM(P + 4);
        }
        if (IN(P + 5)) { LAYER_PTRS
            const int tid = opaque_tid(), lane = tid & 63; (void)tid; (void)lane;
            const int nun = l == 0 ? 64 : 32;
            for (int u = vcu; u < nun; u += G) topk_unit(A, RT, u >= 32, (u >> 4) & 1, u & 15, L, tid);
            SEAM(P + 5);
        }
        if (IN(P + 6)) { LAYER_PTRS
            const int tid = opaque_tid(), lane = tid & 63; (void)tid; (void)lane;
            const int* IDXROW = (const int*)(ws + WS_IDXROW); unsigned char* XG = ws + WS_XG;
            const int nyr = 16 * RT * 256;
            for (int y0 = gw; y0 < nyr; y0 += 9 * NGW) { int src[9]; v4u a[9];
#pragma unroll
                for (int q = 0; q < 9; ++q) { const int y = y0 + q * NGW; src[q] = y < nyr ? IDXROW[y] : -1; }
                __builtin_amdgcn_sched_barrier(0);
#pragma unroll
                for (int q = 0; q < 9; ++q) { a[q] = (v4u){0u, 0u, 0u, 0u}; if (src[q] >= 0) a[q] = ((const v4u*)((const unsigned char*)H2 + (size_t)src[q] * DM))[lane]; }
                __builtin_amdgcn_sched_barrier(0);
#pragma unroll
                for (int q = 0; q < 9; ++q) { const int y = y0 + q * NGW; if (y < nyr) ((v4u*)(XG + (size_t)y * DM))[lane] = a[q]; } }
            SEAM(P + 6);
        }
        if (IN(P + 7)) { LAYER_PTRS
            SchedP6 S{(const char*)(ws + WS_XG), (const char*)(wl + WO_WGU), RT, G, bx}; EpiSwiGLU E{ws + WS_HID};
            pg8::gemm8_phase<EpiSwiGLU, SchedP6>(L, DM / 2, DM / 2, DM / 2, S, E);
            SEAM(P + 7);
        }
        if (IN(P + 8)) { LAYER_PTRS
            SchedP7 S{(const char*)(ws + WS_HID), (const char*)(wl + WO_WD), RT, G, bx}; EpiDown E{(bf16_t*)(ws + WS_Y), (const float*)(ws + WS_SCORE)};
            pg8::gemm8_phase<EpiDown, SchedP7>(L, EH / 2, EH / 2, EH / 2, S, E);
            if (l == 0) { SchedP7c S2{(const char*)(ws + WS_HID), (const char*)(wl + WO_WD), G, bx}; EpiDownPart E2{(bf16_t*)(ws + WS_XG), (const float*)(ws + WS_SCORE)};
              pg8::gemm8_phase<EpiDownPart, SchedP7c>(L, 256, EH / 2, EH / 2, S2, E2); }
            SEAM(P + 8);
        }
        if (IN(P + 9)) { LAYER_PTRS
            const int tid = opaque_tid(), lane = tid & 63; (void)tid; (void)lane;
            const int* INV = (const int*)(ws + WS_INV); const bf16_t* Y = (const bf16_t*)(ws + WS_Y);
#define P8_INV(R_) (lane < 16 ? INV[((size_t)((R_) / RB) * 16 + lane) * RB + (R_) % RB] : -1)
#define P8_YISSUE(INVV, W, KEEP, REST) do { unsigned mk_ = (unsigned)(__ballot((INVV) >= 0) & 0xffffull); \
                _Pragma("unroll") for (int k = 0; k < 4; ++k) { const bool have = mk_ != 0u; const int e = have ? __builtin_ctz(mk_) : 0; mk_ &= mk_ - 1u; \
                    const int yr = have ? __builtin_amdgcn_readlane((INVV), e) : 0; const v2u* yp = (const v2u*)(Y + (size_t)yr * DM) + lane; KEEP[k] = have ? 0xffffffffu : 0u;     \
                    _Pragma("unroll") for (int j = 0; j < 4; ++j) W[k][j] = yp[64 * j]; } REST = mk_; } while (0)
            Row xn; int invn, invf; v2u wn[4][4]; unsigned kn[4], restn;
#define P8_ROW(k) ((k) < 8 ? (((gw * 8 + (k)) >> 13) * RB + CTXL + ((gw * 8 + (k)) & 8191)) : ((gw >> 8) * RB + (gw & 255)))
            const int nit = 8 + ((l == 0 && gw < 512) ? 1 : 0);
            { const int R0 = P8_ROW(0); xn = row_load_bf16(X1 + (size_t)R0 * DM, lane); invn = P8_INV(R0); P8_YISSUE(invn, wn, kn, restn); const int R1 = P8_ROW(1); invf = P8_INV(R1); }
            int curm; NormP np; f32x4 g2v[4];
#define P8_PARAMS(mr_) do { const float* m_ = MODL + (size_t)(mr_) * 6144; \
                _Pragma("unroll") for (int j = 0; j < 4; ++j) g2v[j] = ((const f32x4*)(m_ + 5120))[lane + 64 * j]; \
                if (l + 1 < DEPTH) { const float* m1 = MOD + ((size_t)(l + 1) * 3 + (mr_)) * 6144; np = normp_load(A->in[I_N1G] + (l + 1) * DM, m1, m1 + 1024, lane); } \
                else { _Pragma("unroll") for (int j = 0; j < 4; ++j) { np.a[j] = ((const f32x4*)A->in[I_FG])[lane + 64 * j]; np.h[j] = np.a[j]; } } \
                __builtin_amdgcn_sched_barrier(0); } while (0)
            { curm = (gw * 8) >> 13; P8_PARAMS(curm); }
            for (int k9 = 0; k9 < nit; ++k9) { const int R = P8_ROW(k9); const int b = R / RB, r = R % RB; const bool isctx = r < CTXL;
                Row x = xn; const int myinv = invn; v2u w0[4][4]; unsigned k0[4]; unsigned msk = restn;
#pragma unroll
                for (int k = 0; k < 4; ++k) { k0[k] = kn[k];
#pragma unroll
                    for (int j = 0; j < 4; ++j) w0[k][j] = wn[k][j]; }
                if (k9 + 1 < nit) { const int Rn = P8_ROW(k9 + 1); xn = row_load_bf16(X1 + (size_t)Rn * DM, lane); invn = invf; P8_YISSUE(invn, wn, kn, restn); const int Rf = P8_ROW(min(k9 + 2, nit - 1)); invf = P8_INV(Rf); }
                if (l == 1 && isctx) continue;
                const float* m = MODL + (size_t)(isctx ? 2 : b) * 6144;
                Row s;
#pragma unroll
                for (int j = 0; j < 4; ++j) s.v[j] = (f32x4){0.f, 0.f, 0.f, 0.f};
#pragma unroll
                for (int k = 0; k < 4; ++k)
#pragma unroll
                    for (int j = 0; j < 4; ++j) s.v[j] += (f32x4){bflo(w0[k][j].x & k0[k]), bfhi(w0[k][j].x & k0[k]), bflo(w0[k][j].y & k0[k]), bfhi(w0[k][j].y & k0[k])};
                if (isctx) {
#pragma unroll
                    for (int j = 0; j < 4; ++j) s.v[j] = (f32x4){0.f, 0.f, 0.f, 0.f};
                    msk = 0u; unsigned mk = (unsigned)(__ballot(myinv >= 0) & 0xffffull); const bf16_t* YP = (const bf16_t*)(ws + WS_XG);
                    while (mk) { const int e = __builtin_ctz(mk); mk &= mk - 1u; const int yr = __builtin_amdgcn_readlane(myinv, e); const int ex = yr / 2304, rr = yr % 2304 - 2048;
                        v2u t[4][4];
#pragma unroll
                        for (int kq = 0; kq < 4; ++kq) { const v2u* yp = (const v2u*)(YP + ((size_t)(kq * 16 + ex) * 256 + rr) * DM) + lane;
#pragma unroll
                            for (int j = 0; j < 4; ++j) t[kq][j] = yp[64 * j]; }
                        __builtin_amdgcn_sched_barrier(0);
#pragma unroll
                        for (int kq = 0; kq < 4; ++kq)
#pragma unroll
                            for (int j = 0; j < 4; ++j) s.v[j] += (f32x4){bflo(t[kq][j].x), bfhi(t[kq][j].x), bflo(t[kq][j].y), bfhi(t[kq][j].y)}; } }
                while (msk) {
                    v2u w[4][4];
#pragma unroll
                    for (int k = 0; k < 4; ++k) { const bool have = msk != 0u; const int e = have ? __builtin_ctz(msk) : 0; msk &= msk - 1u; if (!have) msk = 0u;
                        const int yr = have ? __builtin_amdgcn_readlane(myinv, e) : 0;
                        const v2u* yp = (const v2u*)(Y + (size_t)yr * DM) + lane; const unsigned keep = have ? 0xffffffffu : 0u;
#pragma unroll
                        for (int j = 0; j < 4; ++j) { v2u t = yp[64 * j]; t.x &= keep; t.y &= keep; w[k][j] = t; } }
#pragma unroll
                    for (int k = 0; k < 4; ++k)
#pragma unroll
                        for (int j = 0; j < 4; ++j) s.v[j] += (f32x4){bflo(w[k][j].x), bfhi(w[k][j].x), bflo(w[k][j].y), bfhi(w[k][j].y)};
                }
                { const int mr = isctx ? 2 : b; if (mr != curm) { curm = mr; P8_PARAMS(mr); } }
#pragma unroll
                for (int j = 0; j < 4; ++j) x.v[j] += g2v[j] * s.v[j];
                const float rstd = row_rstd(x);
                if (l + 1 < DEPTH) { row_store_bf16(XR + (size_t)R * DM, x, lane);
                    const Row y = row_normmod_p(x, rstd, np); row_store_bf16(HN + (size_t)R * DM, y, lane); if (!isctx) row_store_fp8(ws + WS_HN8 + (size_t)R * DM, y, lane); }
                else { Row y;
#pragma unroll
                    for (int j = 0; j < 4; ++j) y.v[j] = x.v[j] * rstd * np.a[j];
                    row_store(A->out + ((size_t)b * SEQ + (r - CTXL)) * DM, y, lane); }
            }
            SEAM(P + 9);
        }
    }
#undef IN
#undef SEAM
}

extern "C" void kernel_launch(void* const* d_in, const int* in_sizes, int n_in, void* d_out, int out_size, void* d_ws, size_t ws_size, hipStream_t stream) {
    static int grid = 0;
    if (grid == 0) {
        if (n_in != 28 || out_size != NB * SEQ * DM || ws_size < WS_END) { fprintf(stderr, "kernel_launch: unexpected shapes (n_in %d, out %d, ws %zu < %zu)\n", n_in, out_size, ws_size, (size_t)WS_END); grid = -1; return; }
        int dev = 0, cus = 0, per_cu = 0;
        if (hipGetDevice(&dev) != hipSuccess || hipDeviceGetAttribute(&cus, hipDeviceAttributeMultiprocessorCount, dev) != hipSuccess) { grid = -1; return; }
        if (hipFuncSetAttribute((const void*)fwd_kernel, hipFuncAttributeMaxDynamicSharedMemorySize, LDS_BYTES) != hipSuccess) { fprintf(stderr, "kernel_launch: hipFuncSetAttribute failed\n"); grid = -1; return; }
        if (hipOccupancyMaxActiveBlocksPerMultiprocessor(&per_cu, (const void*)fwd_kernel, 512, LDS_BYTES) != hipSuccess || per_cu < 1) fprintf(stderr, "kernel_launch: occupancy query reports %d blocks/CU\n", per_cu);
        (void)hipGetLastError();
        if (cus != 256) { fprintf(stderr, "kernel_launch: built for 256 CUs, device has %d\n", cus); grid = -1; return; }
        grid = 256;
    }
    if (grid < 0) return;
    (void)hipMemsetAsync((char*)d_ws + WS_CTL, 0, CTL_ZERO_BYTES, stream);
    Args a{};
    for (int i = 0; i < 28; ++i) a.in[i] = (const float*)d_in[i];
    a.out = (float*)d_out; a.ws = (unsigned char*)d_ws;
#if MK_PER_PHASE
    for (int p = 0; p < NPHASE; ++p) { a.ph_lo = p; a.ph_hi = p + 1; hipLaunchKernelGGL(fwd_kernel, dim3(grid), dim3(512), LDS_BYTES, stream, a); }
#elif defined(PROBE_REPEAT)
    { const int reps[] = {PROBE_REPEAT}; const int nr = sizeof(reps) / sizeof(int); int lo = 0;
      for (int i = 0; i <= nr; ++i) { a.ph_lo = lo; a.ph_hi = i < nr ? reps[i] + 1 : NPHASE; a.li = i; hipLaunchKernelGGL(fwd_kernel, dim3(grid), dim3(512), LDS_BYTES, stream, a); if (i < nr) lo = reps[i]; } }
#else
    a.ph_lo = 0; a.ph_hi = NPHASE; hipLaunchKernelGGL(fwd_kernel, dim3(grid), dim3(512), LDS_BYTES, stream, a);
#endif
}
```

```cpp
#include <hip/hip_runtime.h>
#include <hip/hip_bf16.h>
#include <cstdio>
#include <cstdint>
#include <cmath>

#ifndef MK_PER_PHASE
#define MK_PER_PHASE 0
#endif

constexpr int DM = 1024, NB = 2, SEQ = 8192, CTXL = 256, RB = SEQ + CTXL, NR = NB * RB, DEPTH = 2;
constexpr int IN_W = 6656, NEXP = 16, EH = 2048, TPB = RB / 256  ;
constexpr float EPS = 1e-6f, LOG2E = 1.4426950408889634f;
constexpr float C2A = 0.125f * LOG2E;
constexpr float C2B = 0.17677669529663687f * LOG2E;
constexpr int NPHASE = 2 + 10 * DEPTH;

constexpr size_t MiB = 1u << 20, KiB128 = 131072;
constexpr size_t WS_CTL = 0, CTL_ZERO_BYTES = 1 * MiB;
constexpr size_t WS_MOD = 1 * MiB;
constexpr size_t WS_AFFL = 2 * MiB, WS_AFFC = 3 * MiB;
constexpr size_t WS_IDXROW = 4 * MiB, WS_SCORE = 4 * MiB + 512 * 1024, WS_INV = 5 * MiB;
constexpr size_t WS_GPC = 8 * MiB;
constexpr size_t WS_W0 = 24 * MiB, W_LAYER = 215 * MiB;
constexpr size_t WO_WING = 8 * MiB  , WO_WIN = 0  , WO_WB = 13 * MiB, WO_WO4 = 15 * MiB, WO_WGU = 23 * MiB, WO_WD = 151 * MiB;
constexpr size_t WS_HN = 454 * MiB;
constexpr size_t WS_QKV = 487 * MiB;
constexpr int PQ = 3136;
constexpr int C_QA = 0, C_KA = 256, C_VA = 512, C_QB = 768, C_KB = 1280, C_VB = 1792, C_QD = 2048, C_KD = 2304, C_VD = 2432, C_GU = 2560, C_GV = 2816;
constexpr size_t WS_Y = WS_QKV;
constexpr size_t WS_KNB = 512 * 1024;
constexpr size_t WS_GT = 589 * MiB;
constexpr size_t WS_YS = 721 * MiB;
constexpr size_t WS_HID = WS_GT;
constexpr size_t WS_X1 = 754 * MiB, WS_XR = 820 * MiB, WS_H2 = 886 * MiB, WS_XG = 919 * MiB, WS_MRG = WS_H2, WS_PART = WS_XG  , WS_HN8 = 991 * MiB  , WS_END = 1008 * MiB;
static_assert(WS_QKV + (size_t)NR * PQ * 2 <= WS_GT && WS_Y + (size_t)16 * 9 * 256 * 1024 * 2 <= WS_GT && WS_HID + (size_t)16 * 9 * 256 * 2048 * 2 <= WS_X1 && WS_YS + (size_t)NR * 1024 * 2 <= WS_X1, "ws map");

constexpr int CW_BAR = 4096;

constexpr int RING_BYTES = 131072, LDSCTL_OFF = RING_BYTES, MISC_OFF = LDSCTL_OFF + 320, LDS_BYTES = 147456;

#define GAS __attribute__((address_space(1)))
#define LAS __attribute__((address_space(3)))
typedef unsigned short bf16_t;
typedef unsigned v4u __attribute__((ext_vector_type(4)));
typedef unsigned v2u __attribute__((ext_vector_type(2)));
typedef float f32x4 __attribute__((ext_vector_type(4)));
typedef float f32x2 __attribute__((ext_vector_type(2)));
typedef float f32x16 __attribute__((ext_vector_type(16)));
typedef short bf16x8 __attribute__((ext_vector_type(8)));
typedef short s16x4 __attribute__((ext_vector_type(4)));
typedef __bf16 bf16x2_t __attribute__((ext_vector_type(2)));
#define RLX_AGENT __ATOMIC_RELAXED, __HIP_MEMORY_SCOPE_AGENT
#define LDS_WAIT() asm volatile("s_waitcnt lgkmcnt(0)" ::: "memory")
#define VM_WAIT() asm volatile("s_waitcnt vmcnt(0)" ::: "memory")

__device__ __forceinline__ int opaque_tid() { int t = threadIdx.x; asm volatile("" : "+v"(t)); return t; }
__device__ __forceinline__ int opaque_s(int v) { asm volatile("" : "+s"(v)); return v; }
__device__ __forceinline__ unsigned char* opaque_ptr(unsigned char* p) { asm volatile("" : "+s"(p)); return p; }
__device__ __forceinline__ unsigned cvtpk(float lo, float hi) { f32x2 v = {lo, hi}; bf16x2_t b = __builtin_convertvector(v, bf16x2_t); return __builtin_bit_cast(unsigned, b); }
__device__ __forceinline__ float bflo(unsigned w) { return __uint_as_float(w << 16); }
__device__ __forceinline__ float bfhi(unsigned w) { return __uint_as_float(w & 0xffff0000u); }
__device__ __forceinline__ float bf2f(bf16_t h) { return __uint_as_float((unsigned)h << 16); }
__device__ __forceinline__ bf16_t f2bf(float f) { return (bf16_t)(cvtpk(f, 0.f) & 0xffffu); }
__device__ __forceinline__ float sigmoidf_(float x) { return __builtin_amdgcn_rcpf(1.0f + __builtin_amdgcn_exp2f(-x * LOG2E)); }
__device__ __forceinline__ float siluf_(float x) { return x * sigmoidf_(x); }
__device__ __forceinline__ float gelu_tanh(float x) { const float z = 0.7978845608028654f * (x + 0.044715f * x * x * x); return x * __builtin_amdgcn_rcpf(1.0f + __builtin_amdgcn_exp2f(-2.0f * LOG2E * z)); }
template <int CTRL> __device__ __forceinline__ float dpp_f(float v) { return __builtin_bit_cast(float, __builtin_amdgcn_update_dpp(0, __builtin_bit_cast(int, v), CTRL, 0xf, 0xf, true)); }
__device__ __forceinline__ float row16_sum(float v) { v += dpp_f<0xB1>(v); v += dpp_f<0x4E>(v); v += dpp_f<0x141>(v); v += dpp_f<0x140>(v); return v; }
__device__ __forceinline__ float xor16_sum(float v) { auto rr = __builtin_amdgcn_permlane16_swap(__float_as_uint(v), __float_as_uint(v), false, false); return __uint_as_float(rr[0]) + __uint_as_float(rr[1]); }
__device__ __forceinline__ float xor32_sum(float v) { auto rr = __builtin_amdgcn_permlane32_swap(__float_as_uint(v), __float_as_uint(v), false, false); return __uint_as_float(rr[0]) + __uint_as_float(rr[1]); }
__device__ __forceinline__ float half32_sum(float v) { return xor16_sum(row16_sum(v)); }
__device__ __forceinline__ float wave_sum(float v) { return xor32_sum(xor16_sum(row16_sum(v))); }
__device__ __forceinline__ float wave_max(float v) { v = fmaxf(v, dpp_f<0xB1>(v)); v = fmaxf(v, dpp_f<0x4E>(v)); v = fmaxf(v, dpp_f<0x141>(v)); v = fmaxf(v, dpp_f<0x140>(v));
    { auto rr = __builtin_amdgcn_permlane16_swap(__float_as_uint(v), __float_as_uint(v), false, false); v = fmaxf(__uint_as_float(rr[0]), __uint_as_float(rr[1])); }
    { auto rr = __builtin_amdgcn_permlane32_swap(__float_as_uint(v), __float_as_uint(v), false, false); v = fmaxf(__uint_as_float(rr[0]), __uint_as_float(rr[1])); } return v; }
__device__ __forceinline__ unsigned pk8(float a, float b, float c, float d) { unsigned w = 0u; w = __builtin_amdgcn_cvt_pk_fp8_f32(a, b, w, false); w = __builtin_amdgcn_cvt_pk_fp8_f32(c, d, w, true); return w; }
__device__ __forceinline__ void st8(bf16_t* p, const float* v) { v4u w; w.x = cvtpk(v[0], v[1]); w.y = cvtpk(v[2], v[3]); w.z = cvtpk(v[4], v[5]); w.w = cvtpk(v[6], v[7]); *(v4u*)p = w; }

__device__ const float INV16R[16] = {0.15915494309189535f, 0.08949940160889101f, 0.050329212104487035f, 0.0283021958306234f, 0.015915494309189534f, 0.008949940160889102f, 0.005032921210448704f, 0.00283021958306234f,
                                     0.0015915494309189536f, 0.0008949940160889102f, 0.0005032921210448703f, 0.00028302195830623395f, 0.00015915494309189535f, 8.949940160889102e-05f, 5.0329212104487035e-05f, 2.8302195830623396e-05f};
__device__ const float INV8R[8] = {0.15915494309189535f, 0.050329212104487035f, 0.015915494309189534f, 0.005032921210448704f, 0.0015915494309189536f, 0.0005032921210448703f, 0.00015915494309189535f, 5.0329212104487035e-05f};
__device__ __forceinline__ void sincos_rev(float rev, float& s, float& c) { const float f = __builtin_amdgcn_fractf(rev); s = __builtin_amdgcn_sinf(f); c = __builtin_amdgcn_cosf(f); }

namespace pg8 {
#define PG8_LAS __attribute__((address_space(3)))
constexpr int BM = 256, BK = 64, HALF = 128, HTB = HALF * BK * 2, STAGE_BYTES = 8 * HTB, NXCD = 8, WGM = 8;
__host__ __device__ __forceinline__ int lds_byte(int r, int c) { const int st = (r >> 4) * 2 + (c >> 5), rr = r & 15, cc = c & 31, ob = rr * 64 + cc * 2; return st * 1024 + (ob ^ (((ob >> 9) & 1) << 5)); }
__host__ __device__ __forceinline__ void stage_rc(int b, int& R, int& C) { const int st = b / 1024, sb = b % 1024, swz = sb ^ (((sb >> 9) & 1) << 5); R = (st >> 1) * 16 + swz / 64; C = (st & 1) * 32 + (swz % 64) / 2; }
__host__ __device__ __forceinline__ int perm32(int rho) { const int n = rho >> 4, i = rho & 15; return 8 * (i >> 2) + 4 * n + (i & 3); }

struct Unit { int pm, pn; const char* a; const char* b; };
__device__ __forceinline__ const char* uptr(const char* p) { const unsigned long long v = (unsigned long long)p; const unsigned lo = __builtin_amdgcn_readfirstlane((unsigned)v), hi = __builtin_amdgcn_readfirstlane((unsigned)(v >> 32)); return (const char*)(((unsigned long long)hi << 32) | lo); }
__device__ __forceinline__ void uunit(Unit& u) { u.pm = __builtin_amdgcn_readfirstlane(u.pm); u.pn = __builtin_amdgcn_readfirstlane(u.pn); u.a = uptr(u.a); u.b = uptr(u.b); }

typedef int v8i __attribute__((ext_vector_type(8)));
__device__ __forceinline__ void glds16s(const char* sbase, unsigned voff, unsigned lds_dst) { unsigned keep;
    asm volatile("s_mov_b32 %0, m0\n\ts_mov_b32 m0, %3\n\ts_nop 0\n\tglobal_load_lds_dwordx4 %1, %2\n\ts_mov_b32 m0, %0" : "=&s"(keep) : "v"(voff), "s"(sbase), "s"(lds_dst) : "memory"); }
__device__ __forceinline__ void rect_order(int L, int nM, int nN, int& im, int& in) {
    const int nwg = nM * nN; int wgid = L; { const int q = nwg / NXCD, r = nwg % NXCD, xcd = wgid % NXCD, off = wgid / NXCD; wgid = (xcd < r ? xcd * (q + 1) : r * (q + 1) + (xcd - r) * q) + off; }
    const int nig = WGM * nN, gid = wgid / nig, fm = gid * WGM, gsz = (nM - fm) < WGM ? (nM - fm) : WGM;
    im = fm + ((wgid % nig) % gsz); in = (wgid % nig) / gsz;
}

template <class Epi, class Sched>
__device__ __forceinline__ void gemm_phase(PG8_LAS unsigned char* lds, const int K, const int lda, const int ldb, const Sched& S, const Epi& E) {
    const int tid = opaque_tid(), wid = __builtin_amdgcn_readfirstlane(tid >> 6), lane = tid & 63, wr = wid >> 2, wc = wid & 3, fr = lane & 15, fq = lane >> 4;
    const int nt = K / BK;
    unsigned voffA[2], voffB[2];
#pragma unroll
    for (int i = 0; i < 2; ++i) { int R, C; stage_rc(tid * 16 + i * 8192, R, C); const int Rb = Epi::PERM ? ((R & ~31) + perm32(R & 31)) : R;
        voffA[i] = (unsigned)(R * lda + C) * 2u; voffB[i] = (unsigned)(Rb * ldb + C) * 2u; }
    const size_t kstep = (size_t)(BK * 2);
    const size_t hA = (size_t)HALF * lda * 2, hB = (size_t)HALF * ldb * 2;
    const unsigned ldsw = (unsigned)wid * 1024u, ldsbase = (unsigned)(size_t)lds;
    const int aoff = lds_byte(wr * 64 + fr, fq * 8), boff = lds_byte(wc * 32 + fr, fq * 8);
#define PG8_SA(b, h) (((b) * 2 + (h)) * HTB)
#define PG8_SB(b, h) ((4 + (b) * 2 + (h)) * HTB)
#define PG8_STAGE(bufoff, gbase, voff) do { _Pragma("unroll") for (int _i = 0; _i < 2; ++_i) \
        glds16s(uptr((const char*)(gbase)), (voff)[_i], (unsigned)__builtin_amdgcn_readfirstlane(ldsbase + (unsigned)(bufoff) + ldsw + _i * 8192u)); } while (0)
#define PG8_LDA(dst, b, h) do { _Pragma("unroll") for (int m = 0; m < 4; ++m) _Pragma("unroll") for (int k = 0; k < 2; ++k) dst[m][k] = *(const PG8_LAS bf16x8*)(lds + PG8_SA(b, h) + aoff + m * 2048 + k * 1024); } while (0)
#define PG8_LDB(dst, b, h) do { _Pragma("unroll") for (int n = 0; n < 2; ++n) _Pragma("unroll") for (int k = 0; k < 2; ++k) dst[n][k] = *(const PG8_LAS bf16x8*)(lds + PG8_SB(b, h) + boff + n * 2048 + k * 1024); } while (0)
#define PG8_MMA(ai, bj, At, Bt) do { __builtin_amdgcn_s_setprio(1); _Pragma("unroll") for (int m = 0; m < 4; ++m) _Pragma("unroll") for (int n = 0; n < 2; ++n) _Pragma("unroll") for (int k = 0; k < 2; ++k) \
        acc[ai][bj][m][n] = __builtin_amdgcn_mfma_f32_16x16x32_bf16(Bt[n][k], At[m][k], acc[ai][bj][m][n], 0, 0, 0); __builtin_amdgcn_s_setprio(0); } while (0)
#define PG8_WAIT_V(n) asm volatile("s_waitcnt vmcnt(" #n ")" ::: "memory")
#define PG8_WAIT_L(n) asm volatile("s_waitcnt lgkmcnt(" #n ")" ::: "memory")
#define PG8_BAR __builtin_amdgcn_s_barrier()
#define PG8_SCHED __builtin_amdgcn_sched_barrier(0)
    Unit cur, nxt; int ui = 0;
    if (!S.next(0, cur)) return;
    uunit(cur);
    f32x4 acc[2][2][4][2];
#pragma unroll
    for (int a = 0; a < 2; ++a)
#pragma unroll
        for (int b = 0; b < 2; ++b)
#pragma unroll
            for (int m = 0; m < 4; ++m)
#pragma unroll
                for (int n = 0; n < 2; ++n) acc[a][b][m][n] = (f32x4){0.f, 0.f, 0.f, 0.f};
    bf16x8 At[4][2], B0[2][2], B1[2][2];
    const char* cA = cur.a; const char* cB = cur.b;
    PG8_STAGE(PG8_SB(0, 0), cB, voffB); PG8_STAGE(PG8_SB(0, 1), cB + hB, voffB); PG8_STAGE(PG8_SA(0, 0), cA, voffA); PG8_STAGE(PG8_SA(0, 1), cA + hA, voffA);
    if (wr == 1) PG8_BAR;
    PG8_WAIT_V(2); PG8_BAR;
    PG8_STAGE(PG8_SB(1, 0), cB + kstep, voffB); PG8_STAGE(PG8_SA(1, 0), cA + kstep, voffA); PG8_STAGE(PG8_SB(1, 1), cB + hB + kstep, voffB);
    PG8_WAIT_V(6); PG8_BAR;
    for (;;) {
        const bool has_next = S.next(ui + 1, nxt); if (has_next) uunit(nxt);
        const char* nA = has_next ? nxt.a : cA; const char* nB = has_next ? nxt.b : cB;
        for (int t = 0; t < nt; t += 2) {
            const bool last = (t == nt - 2);
            const char* a1 = cA + (size_t)(t + 1) * kstep;
            const char* a2 = last ? nA : cA + (size_t)(t + 2) * kstep; const char* b2 = last ? nB : cB + (size_t)(t + 2) * kstep;
            const char* a3 = a2 + kstep; const char* b3 = b2 + kstep;
            PG8_LDB(B0, 0, 0); PG8_LDB(B1, 0, 1); PG8_SCHED; PG8_LDA(At, 0, 0); PG8_STAGE(PG8_SA(1, 1), a1 + hA, voffA);
            PG8_WAIT_V(8); PG8_WAIT_L(0); PG8_BAR; PG8_MMA(0, 0, At, B0); PG8_MMA(0, 1, At, B1); PG8_BAR; PG8_SCHED;
            PG8_LDA(At, 0, 1); PG8_STAGE(PG8_SB(0, 0), b2, voffB); PG8_STAGE(PG8_SB(0, 1), b2 + hB, voffB); PG8_STAGE(PG8_SA(0, 0), a2, voffA);
            PG8_WAIT_V(8); PG8_WAIT_L(0); PG8_BAR; PG8_MMA(1, 0, At, B0); PG8_MMA(1, 1, At, B1); PG8_BAR; PG8_SCHED;
            PG8_LDB(B0, 1, 0); PG8_LDB(B1, 1, 1); PG8_SCHED; PG8_LDA(At, 1, 0); PG8_STAGE(PG8_SA(0, 1), a2 + hA, voffA);
            PG8_WAIT_V(8); PG8_WAIT_L(0); PG8_BAR; PG8_MMA(0, 0, At, B0); PG8_MMA(0, 1, At, B1); PG8_BAR; PG8_SCHED;
            PG8_LDA(At, 1, 1); PG8_STAGE(PG8_SB(1, 0), b3, voffB); PG8_STAGE(PG8_SB(1, 1), b3 + hB, voffB); PG8_STAGE(PG8_SA(1, 0), a3, voffA);
            PG8_WAIT_V(8); PG8_WAIT_L(0); PG8_BAR; PG8_MMA(1, 0, At, B0); PG8_MMA(1, 1, At, B1); PG8_BAR; PG8_SCHED;
        }
        if (wr == 0) PG8_BAR;
        { const int t2 = opaque_tid(), l2 = t2 & 63; E(acc, cur, wr, wc, l2 & 15, l2 >> 4); }
        if (!has_next) break;
        if (!Epi::keep_acc(cur)) {
#pragma unroll
        for (int a = 0; a < 2; ++a)
#pragma unroll
            for (int b = 0; b < 2; ++b)
#pragma unroll
                for (int m = 0; m < 4; ++m)
#pragma unroll
                    for (int n = 0; n < 2; ++n) acc[a][b][m][n] = (f32x4){0.f, 0.f, 0.f, 0.f};
        }
        cur = nxt; cA = nA; cB = nB; ++ui;
        if (wr == 1) PG8_BAR;
    }
    PG8_WAIT_V(0);
    PG8_BAR;
#undef PG8_SA
#undef PG8_SB
#undef PG8_STAGE
#undef PG8_LDA
#undef PG8_LDB
#undef PG8_MMA
#undef PG8_WAIT_V
#undef PG8_WAIT_L
#undef PG8_BAR
#undef PG8_SCHED
}
template <class Epi, class Sched>
__device__ __forceinline__ void gemm8_phase(PG8_LAS unsigned char* lds, const int K, const int lda, const int ldb, const Sched& S, const Epi& E) {
    const int tid = opaque_tid(), wid = __builtin_amdgcn_readfirstlane(tid >> 6), lane = tid & 63, wr = wid >> 2, wc = wid & 3, fr = lane & 15, fq = lane >> 4;
    const int nt = opaque_s(K / BK);
    unsigned voffA[2], voffB[2];
#pragma unroll
    for (int i = 0; i < 2; ++i) { int R, C; stage_rc(tid * 16 + i * 8192, R, C); const int Rb = Epi::PERM ? ((R & ~31) + perm32(R & 31)) : R;
        voffA[i] = (unsigned)(R * lda + C) * 2u; voffB[i] = (unsigned)(Rb * ldb + C) * 2u; }
    const size_t kstep = (size_t)(BK * 2);
    const size_t hA = (size_t)HALF * lda * 2, hB = (size_t)HALF * ldb * 2;
    const unsigned ldsw = (unsigned)wid * 1024u, ldsbase = (unsigned)(size_t)lds;
    const int fcol = (fq >> 1) * 32 + (fq & 1) * 16;
    const int aoff = lds_byte(wr * 64 + fr, fcol), boff = lds_byte(wc * 32 + fr, fcol);
#define PG8_SA(b, h) (((b) * 2 + (h)) * HTB)
#define PG8_SB(b, h) ((4 + (b) * 2 + (h)) * HTB)
#define PG8_STAGE(bufoff, gbase, voff) do { _Pragma("unroll") for (int _i = 0; _i < 2; ++_i) \
        glds16s(uptr((const char*)(gbase)), (voff)[_i], (unsigned)__builtin_amdgcn_readfirstlane(ldsbase + (unsigned)(bufoff) + ldsw + _i * 8192u)); } while (0)
#define PG8_LDA(dst, b, h) do { _Pragma("unroll") for (int m = 0; m < 4; ++m) { const v4u lo_ = *(const PG8_LAS v4u*)(lds + PG8_SA(b, h) + aoff + m * 2048), hi_ = *(const PG8_LAS v4u*)(lds + PG8_SA(b, h) + aoff + m * 2048 + 16); dst[m] = (v8i){(int)lo_.x, (int)lo_.y, (int)lo_.z, (int)lo_.w, (int)hi_.x, (int)hi_.y, (int)hi_.z, (int)hi_.w}; } } while (0)
#define PG8_LDB(dst, b, h) do { _Pragma("unroll") for (int n = 0; n < 2; ++n) { const v4u lo_ = *(const PG8_LAS v4u*)(lds + PG8_SB(b, h) + boff + n * 2048), hi_ = *(const PG8_LAS v4u*)(lds + PG8_SB(b, h) + boff + n * 2048 + 16); dst[n] = (v8i){(int)lo_.x, (int)lo_.y, (int)lo_.z, (int)lo_.w, (int)hi_.x, (int)hi_.y, (int)hi_.z, (int)hi_.w}; } } while (0)
#define PG8_MMA(ai, bj, At, Bt) do { __builtin_amdgcn_s_setprio(1); _Pragma("unroll") for (int m = 0; m < 4; ++m) _Pragma("unroll") for (int n = 0; n < 2; ++n) \
        acc[ai][bj][m][n] = __builtin_amdgcn_mfma_scale_f32_16x16x128_f8f6f4(Bt[n], At[m], acc[ai][bj][m][n], 0, 0, 0, 0, 0, 0);     __builtin_amdgcn_s_setprio(0); } while (0)
#define PG8_WAIT_V(n) asm volatile("s_waitcnt vmcnt(" #n ")" ::: "memory")
#define PG8_WAIT_L(n) asm volatile("s_waitcnt lgkmcnt(" #n ")" ::: "memory")
#define PG8_BAR __builtin_amdgcn_s_barrier()
#define PG8_SCHED __builtin_amdgcn_sched_barrier(0)
    Unit cur, nxt; int ui = 0;
    if (!S.next(0, cur)) return;
    uunit(cur);
    f32x4 acc[2][2][4][2];
#pragma unroll
    for (int a = 0; a < 2; ++a)
#pragma unroll
        for (int b = 0; b < 2; ++b)
#pragma unroll
            for (int m = 0; m < 4; ++m)
#pragma unroll
                for (int n = 0; n < 2; ++n) acc[a][b][m][n] = (f32x4){0.f, 0.f, 0.f, 0.f};
    v8i At[4], B0[2], B1[2];
    const char* cA = cur.a; const char* cB = cur.b;
    PG8_STAGE(PG8_SB(0, 0), cB, voffB); PG8_STAGE(PG8_SB(0, 1), cB + hB, voffB); PG8_STAGE(PG8_SA(0, 0), cA, voffA); PG8_STAGE(PG8_SA(0, 1), cA + hA, voffA);
    if (wr == 1) PG8_BAR;
    PG8_WAIT_V(2); PG8_BAR;
    PG8_STAGE(PG8_SB(1, 0), cB + kstep, voffB); PG8_STAGE(PG8_SA(1, 0), cA + kstep, voffA); PG8_STAGE(PG8_SB(1, 1), cB + hB + kstep, voffB);
    PG8_WAIT_V(6); PG8_BAR;
    for (;;) {
        const bool has_next = S.next(ui + 1, nxt); if (has_next) uunit(nxt);
        const char* nA = has_next ? nxt.a : cA; const char* nB = has_next ? nxt.b : cB;
#pragma nounroll
        for (int t = 0; t < nt; t += 2) {
            const bool last = (t == nt - 2);
            const char* a1 = cA + (size_t)(t + 1) * kstep;
            const char* a2 = last ? nA : cA + (size_t)(t + 2) * kstep; const char* b2 = last ? nB : cB + (size_t)(t + 2) * kstep;
            const char* a3 = a2 + kstep; const char* b3 = b2 + kstep;
            PG8_LDB(B0, 0, 0); PG8_LDB(B1, 0, 1); PG8_SCHED; PG8_LDA(At, 0, 0); PG8_STAGE(PG8_SA(1, 1), a1 + hA, voffA);
            PG8_WAIT_V(8); PG8_WAIT_L(0); PG8_BAR; PG8_MMA(0, 0, At, B0); PG8_MMA(0, 1, At, B1); PG8_BAR; PG8_SCHED;
            PG8_LDA(At, 0, 1); PG8_STAGE(PG8_SB(0, 0), b2, voffB); PG8_STAGE(PG8_SB(0, 1), b2 + hB, voffB); PG8_STAGE(PG8_SA(0, 0), a2, voffA);
            PG8_WAIT_V(8); PG8_WAIT_L(0); PG8_BAR; PG8_MMA(1, 0, At, B0); PG8_MMA(1, 1, At, B1); PG8_BAR; PG8_SCHED;
            PG8_LDB(B0, 1, 0); PG8_LDB(B1, 1, 1); PG8_SCHED; PG8_LDA(At, 1, 0); PG8_STAGE(PG8_SA(0, 1), a2 + hA, voffA);
            PG8_WAIT_V(8); PG8_WAIT_L(0); PG8_BAR; PG8_MMA(0, 0, At, B0); PG8_MMA(0, 1, At, B1); PG8_BAR; PG8_SCHED;
            PG8_LDA(At, 1, 1); PG8_STAGE(PG8_SB(1, 0), b3, voffB); PG8_STAGE(PG8_SB(1, 1), b3 + hB, voffB); PG8_STAGE(PG8_SA(1, 0), a3, voffA);
            PG8_WAIT_V(8); PG8_WAIT_L(0); PG8_BAR; PG8_MMA(1, 0, At, B0); PG8_MMA(1, 1, At, B1); PG8_BAR; PG8_SCHED;
        }
        if (wr == 0) PG8_BAR;
        { const int t2 = opaque_tid(), l2 = t2 & 63; E(acc, cur, wr, wc, l2 & 15, l2 >> 4); }
        if (!has_next) break;
#pragma unroll
        for (int a = 0; a < 2; ++a)
#pragma unroll
            for (int b = 0; b < 2; ++b)
#pragma unroll
                for (int m = 0; m < 4; ++m)
#pragma unroll
                    for (int n = 0; n < 2; ++n) acc[a][b][m][n] = (f32x4){0.f, 0.f, 0.f, 0.f};
        cur = nxt; cA = nA; cB = nB; ++ui;
        if (wr == 1) PG8_BAR;
    }
    PG8_WAIT_V(0);
    PG8_BAR;
#undef PG8_SA
#undef PG8_SB
#undef PG8_STAGE
#undef PG8_LDA
#undef PG8_LDB
#undef PG8_MMA
#undef PG8_WAIT_V
#undef PG8_WAIT_L
#undef PG8_BAR
#undef PG8_SCHED
}
}

constexpr float W8S = 32.0f, W8I = 1.0f / 32.0f;
struct ModPtrs { const float* mod; };

struct EpiInProj {
    static constexpr bool PERM = true;
    static __device__ __forceinline__ bool keep_acc(const pg8::Unit&) { return false; }
    bf16_t *QKV, *GT;
    const float *q_gain, *k_gain, *gate_b; float* KNB;
    __device__ __forceinline__ void operator()(const f32x4 (&acc)[2][2][4][2], const pg8::Unit& u, int wr, int wc, int fr, int fq) const {
        const int pn = u.pn, pm = u.pm, jt = pm % TPB; const bool isctx = (jt == 0); const int t0 = (jt - 1) * 256;
        const int cb = 64 * wc + 8 * fq;
        const int rit0 = 64 * wr + fr;
        bf16_t* qrow = QKV + ((size_t)pm * 256 + rit0) * PQ;
#define ROWLOOP _Pragma("unroll") for (int ai = 0; ai < 2; ++ai) _Pragma("unroll") for (int m = 0; m < 4; ++m)
#define ROWVARS const int rit = 128 * ai + 16 * m + rit0; bf16_t* orow = qrow + (size_t)(128 * ai + 16 * m) * PQ; \
        float v[2][8]; _Pragma("unroll") for (int bj = 0; bj < 2; ++bj) _Pragma("unroll") for (int n = 0; n < 2; ++n) _Pragma("unroll") for (int j = 0; j < 4; ++j) v[bj][4 * n + j] = acc[ai][bj][m][n][j];
#define ROWEND __builtin_amdgcn_sched_barrier(0);
        if (pn == 0 || pn == 21 || pn == 22 || pn == 24) {
            const int oc = (pn == 0 ? C_QA : pn == 21 ? C_KA : pn == 22 ? C_VA : C_VB) + cb; const float sc = pn == 0 ? C2A : 1.0f;
            float kn2a = 0.f;
            ROWLOOP { ROWVARS
                if (pn == 21) { float ss = 0.f;
#pragma unroll
                    for (int bj = 0; bj < 2; ++bj)
#pragma unroll
                        for (int j = 0; j < 8; ++j) ss += v[bj][j] * v[bj][j];
                    kn2a = fmaxf(kn2a, xor32_sum(xor16_sum(ss))); }
#pragma unroll
                for (int bj = 0; bj < 2; ++bj) {
#pragma unroll
                    for (int j = 0; j < 8; ++j) v[bj][j] *= sc;
                    st8(orow + oc + 32 * bj, v[bj]); }
                ROWEND }
            if (pn == 21) { float mxv = kn2a; mxv = fmaxf(mxv, dpp_f<0xB1>(mxv)); mxv = fmaxf(mxv, dpp_f<0x4E>(mxv)); mxv = fmaxf(mxv, dpp_f<0x141>(mxv)); mxv = fmaxf(mxv, dpp_f<0x140>(mxv));
                if ((fr | fq) == 0) atomicMax((unsigned*)(KNB + 16 + (pm / TPB) * 4 + wc), __float_as_uint(sqrtf(mxv))); }
        } else if (pn == 3 || pn == 4) {
            const int oc = (pn == 3 ? C_GU : C_GV) + cb;
            ROWLOOP { ROWVARS
#pragma unroll
                for (int bj = 0; bj < 2; ++bj) {
#pragma unroll
                    for (int j = 0; j < 8; ++j) v[bj][j] = gelu_tanh(v[bj][j]);
                    st8(orow + oc + 32 * bj, v[bj]); }
                ROWEND }
        } else if (pn == 1 || pn == 23) {
            const int oc = (pn == 1 ? C_QB : C_KB) + 128 * wc + 8 * fq; const float sc = pn == 1 ? C2B : 1.0f;
            const f32x4 inv = *(const f32x4*)(INV8R + 4 * (fq & 1));
            float kn2[2] = {0.f, 0.f};
            ROWLOOP { ROWVARS
                if (pn == 23) {
#pragma unroll
                    for (int bj = 0; bj < 2; ++bj) { float ss = 0.f;
#pragma unroll
                        for (int j = 0; j < 8; ++j) ss += v[bj][j] * v[bj][j];
                        kn2[bj] = fmaxf(kn2[bj], xor32_sum(xor16_sum(ss))); } }
                const int t = t0 + rit; const float pos = (float)((fq < 2) ? (t >> 6) : (t & 63));
                float sn[4], cs[4];
#pragma unroll
                for (int p = 0; p < 4; ++p) { if (isctx) { sn[p] = 0.f; cs[p] = 1.f; } else sincos_rev(pos * inv[p], sn[p], cs[p]); }
#pragma unroll
                for (int bj = 0; bj < 2; ++bj) {
                    float o[8];
#pragma unroll
                    for (int p = 0; p < 4; ++p) { const float x0 = v[bj][2 * p], x1 = v[bj][2 * p + 1]; o[2 * p] = (x0 * cs[p] - x1 * sn[p]) * sc; o[2 * p + 1] = (x0 * sn[p] + x1 * cs[p]) * sc; }
                    st8(orow + oc + 64 * bj, o); }
                ROWEND }
            if (pn == 23) {
#pragma unroll
                for (int bj = 0; bj < 2; ++bj) { float mxv = kn2[bj]; mxv = fmaxf(mxv, dpp_f<0xB1>(mxv)); mxv = fmaxf(mxv, dpp_f<0x4E>(mxv)); mxv = fmaxf(mxv, dpp_f<0x141>(mxv)); mxv = fmaxf(mxv, dpp_f<0x140>(mxv));
                    if ((fr | fq) == 0) atomicMax((unsigned*)(KNB + (pm / TPB) * 8 + 2 * wc + bj), __float_as_uint(sqrtf(mxv))); } }
        } else {
            if (pn == 25 && wc >= 2) {
                const int oc = C_VD + (wc - 2) * 64 + 8 * fq;
                ROWLOOP { ROWVARS
#pragma unroll
                    for (int bj = 0; bj < 2; ++bj) st8(orow + oc + 32 * bj, v[bj]);
                    (void)rit; ROWEND }
            } else {
                const int oc = (pn == 2 ? C_QD : C_KD) + cb; const float sc = pn == 2 ? C2A : 1.0f; const float* gain = pn == 2 ? q_gain : k_gain;
                const f32x4 inv = *(const f32x4*)(INV16R + 4 * fq);
                f32x4 gn[2][2];
#pragma unroll
                for (int bj = 0; bj < 2; ++bj)
#pragma unroll
                    for (int n = 0; n < 2; ++n) gn[bj][n] = *(const f32x4*)(gain + 32 * bj + 8 * fq + 4 * n);
                ROWLOOP { ROWVARS
                    float ss = 0.f;
#pragma unroll
                    for (int bj = 0; bj < 2; ++bj)
#pragma unroll
                        for (int j = 0; j < 8; ++j) ss += v[bj][j] * v[bj][j];
                    ss = xor32_sum(xor16_sum(ss));
                    const float rstd = __builtin_amdgcn_rsqf(ss * (1.0f / 64.0f) + EPS);
                    const int t = t0 + rit;
#pragma unroll
                    for (int bj = 0; bj < 2; ++bj) {
                        const float pos = (float)(bj == 0 ? (t >> 6) : (t & 63));
                        float o[8];
#pragma unroll
                        for (int p = 0; p < 4; ++p) {
                            float sn, cs; if (isctx) { sn = 0.f; cs = 1.f; } else sincos_rev(pos * inv[p], sn, cs);
                            const float x0 = v[bj][2 * p] * rstd * gn[bj][(2 * p) >> 2][(2 * p) & 3], x1 = v[bj][2 * p + 1] * rstd * gn[bj][(2 * p + 1) >> 2][(2 * p + 1) & 3];
                            o[2 * p] = (x0 * cs - x1 * sn) * sc; o[2 * p + 1] = (x0 * sn + x1 * cs) * sc; }
                        st8(orow + oc + 32 * bj, o); }
                    ROWEND }
            }
        }
#undef ROWLOOP
#undef ROWVARS
#undef ROWEND
    }
};

__device__ __forceinline__ unsigned pk_u8x4(float a, float b, float c, float d) { unsigned w = 0u;
    w = __builtin_amdgcn_cvt_pk_u8_f32(__builtin_rintf(a * 255.0f), 0u, w); w = __builtin_amdgcn_cvt_pk_u8_f32(__builtin_rintf(b * 255.0f), 1u, w);
    w = __builtin_amdgcn_cvt_pk_u8_f32(__builtin_rintf(c * 255.0f), 2u, w); w = __builtin_amdgcn_cvt_pk_u8_f32(__builtin_rintf(d * 255.0f), 3u, w); return w; }
__device__ __forceinline__ float u8f(unsigned w, int i) { return (float)((w >> (8 * i)) & 0xffu); }
struct EpiGates {
    static constexpr bool PERM = true;
    unsigned char* GT; const float* gate_b;
    __device__ __forceinline__ void operator()(const f32x4 (&acc)[2][2][4][2], const pg8::Unit& u, int wr, int wc, int fr, int fq) const {
        const int col0 = u.pn * 256 + wc * 32 + 8 * fq;
        f32x4 gb[2][2];
#pragma unroll
        for (int bj = 0; bj < 2; ++bj)
#pragma unroll
            for (int n = 0; n < 2; ++n) gb[bj][n] = *(const f32x4*)(gate_b + col0 + bj * 128 + 4 * n) * (-LOG2E);
#pragma unroll
        for (int ai = 0; ai < 2; ++ai)
#pragma unroll
            for (int m = 0; m < 4; ++m) { unsigned char* rowp = GT + ((size_t)u.pm * 256 + ai * 128 + wr * 64 + m * 16 + fr) * 4096 + u.pn * 256 + (wc * 4 + fq) * 16;
                v4u w4;
#pragma unroll
                for (int bj = 0; bj < 2; ++bj) { unsigned o[8];
#pragma unroll
                    for (int n = 0; n < 2; ++n)
#pragma unroll
                        for (int j = 0; j < 4; j += 2) { const f32x2 a2 = (f32x2){acc[ai][bj][m][n][j], acc[ai][bj][m][n][j + 1]}, c2 = (f32x2){gb[bj][n][j], gb[bj][n][j + 1]};
                            const f32x2 t2 = __builtin_elementwise_fma(a2, (f32x2){-W8I * LOG2E, -W8I * LOG2E}, c2);
                            const f32x2 e2 = (f32x2){__builtin_amdgcn_exp2f(t2.x), __builtin_amdgcn_exp2f(t2.y)};
                            const f32x2 d2 = __builtin_elementwise_fma(e2, (f32x2){1.0f / 255.0f, 1.0f / 255.0f}, (f32x2){1.0f / 255.0f, 1.0f / 255.0f});
                            const f32x2 v2 = (f32x2){__builtin_amdgcn_rcpf(d2.x), __builtin_amdgcn_rcpf(d2.y)} + (f32x2){8388608.0f, 8388608.0f};
                            o[4 * n + j] = __float_as_uint(v2.x); o[4 * n + j + 1] = __float_as_uint(v2.y); }
                    v2u w; w.x = __builtin_amdgcn_perm(o[1], o[0], 0x0c0c0400u) | __builtin_amdgcn_perm(o[3], o[2], 0x04000c0cu); w.y = __builtin_amdgcn_perm(o[5], o[4], 0x0c0c0400u) | __builtin_amdgcn_perm(o[7], o[6], 0x04000c0cu);
                    if (bj == 0) { w4.x = w.x; w4.y = w.y; } else { w4.z = w.x; w4.w = w.y; } }
                *(v4u*)rowp = w4; }
    }
};
struct EpiGateAcc {
    static constexpr bool PERM = true;
    const unsigned char* GT; bf16_t* MRG; bf16_t* GPC;
    static __device__ __forceinline__ bool keep_acc(const pg8::Unit& u) { return (u.pn & 3) != 3 && (u.pm % TPB) != 0; }
    __device__ __forceinline__ void operator()(f32x4 (&acc)[2][2][4][2], const pg8::Unit& u, int wr, int wc, int fr, int fq) const {
        const int dt = u.pn >> 2, n = u.pn & 3; const int col0 = dt * 256 + wc * 32 + 8 * fq;
        const bool isctx = (u.pm % TPB) == 0;
        const size_t row0 = (size_t)u.pm * 256 + wr * 64 + fr;
        const unsigned char* gp0 = GT + row0 * 4096 + n * 1024 + dt * 256 + (wc * 4 + fq) * 16;
        constexpr float GMIN = 8.673617379884035e-19f;
#define GA_OFF(grp) ((size_t)(((grp) >> 3) * 128 + (((grp) >> 1) & 3) * 16))
        if (!isctx && n < 3) {
            v4u ga4[8], gb4[8];
#pragma unroll
            for (int am = 0; am < 8; ++am) { ga4[am] = *(const v4u*)(gp0 + GA_OFF(2 * am) * 4096); gb4[am] = *(const v4u*)(gp0 + 1024 + GA_OFF(2 * am) * 4096); }
            __builtin_amdgcn_sched_barrier(0);
#pragma unroll
            for (int grp = 0; grp < 16; ++grp) { const int ai = grp >> 3, m = (grp >> 1) & 3, bj = grp & 1; const v2u g0 = bj ? (v2u){ga4[grp >> 1].z, ga4[grp >> 1].w} : (v2u){ga4[grp >> 1].x, ga4[grp >> 1].y}, g1 = bj ? (v2u){gb4[grp >> 1].z, gb4[grp >> 1].w} : (v2u){gb4[grp >> 1].x, gb4[grp >> 1].y};
                float r[8];
#define GA_R(i, A, B) r[i] = fmaxf(A, GMIN) * __builtin_amdgcn_rcpf(fmaxf(B, GMIN))
                GA_R(0, u8f(g0.x, 0), u8f(g1.x, 0)); GA_R(1, u8f(g0.x, 1), u8f(g1.x, 1)); GA_R(2, u8f(g0.x, 2), u8f(g1.x, 2)); GA_R(3, u8f(g0.x, 3), u8f(g1.x, 3));
                GA_R(4, u8f(g0.y, 0), u8f(g1.y, 0)); GA_R(5, u8f(g0.y, 1), u8f(g1.y, 1)); GA_R(6, u8f(g0.y, 2), u8f(g1.y, 2)); GA_R(7, u8f(g0.y, 3), u8f(g1.y, 3));
#undef GA_R
#pragma unroll
                for (int j = 0; j < 4; ++j) { acc[ai][bj][m][0][j] *= r[j]; acc[ai][bj][m][1][j] *= r[4 + j]; } }
            __builtin_amdgcn_sched_barrier(0);
        } else {
            bf16_t* mp0 = isctx ? GPC + ((size_t)n * 512 + (u.pm / TPB) * 256 + wr * 64 + fr) * 1024 + col0 : MRG + row0 * 1024 + col0;
            const float lo = isctx ? 0.f : GMIN; constexpr float I255 = 1.0f / 255.0f;
            v4u ga4[8];
#pragma unroll
            for (int am = 0; am < 8; ++am) ga4[am] = *(const v4u*)(gp0 + GA_OFF(2 * am) * 4096);
            __builtin_amdgcn_sched_barrier(0);
#pragma unroll
            for (int grp = 0; grp < 16; ++grp) { const int ai = grp >> 3, m = (grp >> 1) & 3, bj = grp & 1; const v2u g = bj ? (v2u){ga4[grp >> 1].z, ga4[grp >> 1].w} : (v2u){ga4[grp >> 1].x, ga4[grp >> 1].y}; const f32x4 a0 = acc[ai][bj][m][0], a1 = acc[ai][bj][m][1];
                v4u w; w.x = cvtpk(a0[0] * (fmaxf(u8f(g.x, 0), lo) * I255), a0[1] * (fmaxf(u8f(g.x, 1), lo) * I255)); w.y = cvtpk(a0[2] * (fmaxf(u8f(g.x, 2), lo) * I255), a0[3] * (fmaxf(u8f(g.x, 3), lo) * I255));
                w.z = cvtpk(a1[0] * (fmaxf(u8f(g.y, 0), lo) * I255), a1[1] * (fmaxf(u8f(g.y, 1), lo) * I255)); w.w = cvtpk(a1[2] * (fmaxf(u8f(g.y, 2), lo) * I255), a1[3] * (fmaxf(u8f(g.y, 3), lo) * I255));
                *(v4u*)(mp0 + GA_OFF(grp) * 1024 + bj * 128) = w; }
            __builtin_amdgcn_sched_barrier(0);
        }
#undef GA_OFF
    }
};

struct EpiOutRes {
    static constexpr bool PERM = true;
    static __device__ __forceinline__ bool keep_acc(const pg8::Unit&) { return false; }
    const float* x_in; const float* ctx_in; const bf16_t* XR; bf16_t* X1; const float* mod_l; int layer;
    __device__ __forceinline__ void operator()(const f32x4 (&acc)[2][2][4][2], const pg8::Unit& u, int wr, int wc, int fr, int fq) const {
        const int pm = u.pm, b = pm / TPB, jt = pm % TPB; const bool isctx = jt == 0;
        const float* g1 = mod_l + (isctx ? 2 : b) * 6144 + 2048;
        const int col0 = u.pn * 256 + wc * 32 + 8 * fq;
        f32x4 gv[2][2];
#pragma unroll
        for (int bj = 0; bj < 2; ++bj)
#pragma unroll
            for (int n = 0; n < 2; ++n) gv[bj][n] = *(const f32x4*)(g1 + col0 + bj * 128 + n * 4);
        bf16_t* ob = X1 + ((size_t)pm * 256 + wr * 64 + fr) * DM + col0;
        if (layer == 0) {
            const float* base = (isctx ? ctx_in + (size_t)b * CTXL * DM : x_in + ((size_t)b * SEQ + (size_t)(jt - 1) * 256) * DM) + (size_t)(wr * 64 + fr) * DM + col0;
#pragma unroll
            for (int ai = 0; ai < 2; ++ai) { f32x4 rs[4][2][2];
#pragma unroll
                for (int m = 0; m < 4; ++m)
#pragma unroll
                    for (int bj = 0; bj < 2; ++bj)
#pragma unroll
                        for (int n = 0; n < 2; ++n) rs[m][bj][n] = *(const f32x4*)(base + (size_t)(ai * 128 + m * 16) * DM + bj * 128 + n * 4);
                __builtin_amdgcn_sched_barrier(0);
#pragma unroll
                for (int m = 0; m < 4; ++m)
#pragma unroll
                    for (int bj = 0; bj < 2; ++bj) { const f32x4 o0 = rs[m][bj][0] + gv[bj][0] * acc[ai][bj][m][0], o1 = rs[m][bj][1] + gv[bj][1] * acc[ai][bj][m][1];
                        v4u w; w.x = cvtpk(o0[0], o0[1]); w.y = cvtpk(o0[2], o0[3]); w.z = cvtpk(o1[0], o1[1]); w.w = cvtpk(o1[2], o1[3]);
                        *(v4u*)(ob + (size_t)(ai * 128 + m * 16) * DM + bj * 128) = w; }
                __builtin_amdgcn_sched_barrier(0); }
        } else {
            const bf16_t* base = XR + ((size_t)pm * 256 + wr * 64 + fr) * DM + col0;
#pragma unroll
            for (int ai = 0; ai < 2; ++ai) { v4u rb[4][2];
#pragma unroll
                for (int m = 0; m < 4; ++m)
#pragma unroll
                    for (int bj = 0; bj < 2; ++bj) rb[m][bj] = *(const v4u*)(base + (size_t)(ai * 128 + m * 16) * DM + bj * 128);
                __builtin_amdgcn_sched_barrier(0);
#pragma unroll
                for (int m = 0; m < 4; ++m)
#pragma unroll
                    for (int bj = 0; bj < 2; ++bj) { const v4u r = rb[m][bj];
                        const f32x4 r0 = (f32x4){bflo(r.x), bfhi(r.x), bflo(r.y), bfhi(r.y)}, r1 = (f32x4){bflo(r.z), bfhi(r.z), bflo(r.w), bfhi(r.w)};
                        const f32x4 o0 = r0 + gv[bj][0] * acc[ai][bj][m][0], o1 = r1 + gv[bj][1] * acc[ai][bj][m][1];
                        v4u w; w.x = cvtpk(o0[0], o0[1]); w.y = cvtpk(o0[2], o0[3]); w.z = cvtpk(o1[0], o1[1]); w.w = cvtpk(o1[2], o1[3]);
                        *(v4u*)(ob + (size_t)(ai * 128 + m * 16) * DM + bj * 128) = w; }
                __builtin_amdgcn_sched_barrier(0); }
        }
    }
};
struct EpiPart {
    static constexpr bool PERM = false;
    static __device__ __forceinline__ bool keep_acc(const pg8::Unit&) { return false; }
    float* PART;
    __device__ __forceinline__ void operator()(const f32x4 (&acc)[2][2][4][2], const pg8::Unit& u, int wr, int wc, int fr, int fq) const {
        const int ks = u.pn >> 2, ct = u.pn & 3; const int col0 = ct * 256 + wc * 32 + 4 * fq;
#pragma unroll
        for (int ai = 0; ai < 2; ++ai)
#pragma unroll
            for (int m = 0; m < 4; ++m) { float* op = PART + ((size_t)ks * 512 + u.pm * 256 + ai * 128 + wr * 64 + m * 16 + fr) * DM + col0;
#pragma unroll
                for (int bj = 0; bj < 2; ++bj)
#pragma unroll
                    for (int n = 0; n < 2; ++n) *(f32x4*)(op + bj * 128 + n * 16) = acc[ai][bj][m][n]; }
    }
};
struct EpiSwiGLU {
    static constexpr bool PERM = true;
    unsigned char* HID;
    __device__ __forceinline__ void operator()(const f32x4 (&acc)[2][2][4][2], const pg8::Unit& u, int wr, int wc, int fr, int fq) const {
        const int f0 = u.pn * 128 + wc * 32 + 8 * fq;
#pragma unroll
        for (int ai = 0; ai < 2; ++ai)
#pragma unroll
            for (int m = 0; m < 4; ++m) { float o[8];
#pragma unroll
                for (int n = 0; n < 2; ++n)
#pragma unroll
                    for (int j = 0; j < 4; j += 2) { const f32x2 g2 = (f32x2){acc[ai][0][m][n][j], acc[ai][0][m][n][j + 1]}, u2 = (f32x2){acc[ai][1][m][n][j], acc[ai][1][m][n][j + 1]};
                        const f32x2 t2 = g2 * (f32x2){-W8I * LOG2E, -W8I * LOG2E};
                        const f32x2 e2 = (f32x2){__builtin_amdgcn_exp2f(t2.x), __builtin_amdgcn_exp2f(t2.y)};
                        const f32x2 d2 = __builtin_elementwise_fma(e2, (f32x2){1024.0f, 1024.0f}, (f32x2){1024.0f, 1024.0f});
                        const f32x2 r2 = (f32x2){__builtin_amdgcn_rcpf(d2.x), __builtin_amdgcn_rcpf(d2.y)};
                        const f32x2 o2 = (g2 * u2) * r2; o[4 * n + j] = o2.x; o[4 * n + j + 1] = o2.y; }
                v2u w; w.x = pk8(o[0], o[1], o[2], o[3]); w.y = pk8(o[4], o[5], o[6], o[7]);
                *(v2u*)(HID + ((size_t)u.pm * 256 + ai * 128 + wr * 64 + m * 16 + fr) * EH + f0) = w; }
    }
};
struct EpiDown {
    static constexpr bool PERM = true;
    bf16_t* Y; const float* SCORE;
    __device__ __forceinline__ void operator()(const f32x4 (&acc)[2][2][4][2], const pg8::Unit& u, int wr, int wc, int fr, int fq) const {
        const int col0 = u.pn * 256 + wc * 32 + 8 * fq;
        float sc8[2][4];
#pragma unroll
        for (int ai = 0; ai < 2; ++ai)
#pragma unroll
            for (int m = 0; m < 4; ++m) sc8[ai][m] = SCORE[(size_t)u.pm * 256 + ai * 128 + wr * 64 + m * 16 + fr];
        __builtin_amdgcn_sched_barrier(0);
#pragma unroll
        for (int ai = 0; ai < 2; ++ai)
#pragma unroll
            for (int m = 0; m < 4; ++m) { const size_t row = (size_t)u.pm * 256 + ai * 128 + wr * 64 + m * 16 + fr; const float s = sc8[ai][m] * W8I;
#pragma unroll
                for (int bj = 0; bj < 2; ++bj) { float o[8];
#pragma unroll
                    for (int n = 0; n < 2; ++n)
#pragma unroll
                        for (int j = 0; j < 4; ++j) o[4 * n + j] = acc[ai][bj][m][n][j] * s;
                    st8(Y + row * DM + col0 + bj * 128, o); } }
    }
};
struct EpiDownPart {
    static constexpr bool PERM = true;
    bf16_t* YP; const float* SCORE;
    __device__ __forceinline__ void operator()(const f32x4 (&acc)[2][2][4][2], const pg8::Unit& u, int wr, int wc, int fr, int fq) const {
        if (wr != 0) return;
        const int in = u.pn & 3, kq = u.pn >> 2, e = u.pm / 9; const int col0 = in * 256 + wc * 32 + 8 * fq;
        float sc4[4];
#pragma unroll
        for (int m = 0; m < 4; ++m) sc4[m] = SCORE[(size_t)u.pm * 256 + m * 16 + fr];
        __builtin_amdgcn_sched_barrier(0);
#pragma unroll
        for (int m = 0; m < 4; ++m) { const size_t row = ((size_t)(kq * 16 + e) * 256 + m * 16 + fr); const float sc = sc4[m] * W8I;
#pragma unroll
            for (int bj = 0; bj < 2; ++bj) { float o[8];
#pragma unroll
                for (int n = 0; n < 2; ++n)
#pragma unroll
                    for (int j = 0; j < 4; ++j) o[4 * n + j] = acc[0][bj][m][n][j] * sc;
                st8(YP + row * DM + col0 + bj * 128, o); } }
    }
};

namespace attn_body {
using bf16 = __hip_bfloat16;
using u32x4 = __attribute__((ext_vector_type(4))) unsigned;
constexpr int NW = 8, QBLK = 32, QB = QBLK * NW, KVBLK = 64;
__device__ __forceinline__ int crow(int r, int hi) { return (r & 3) + 8 * (r >> 2) + 4 * hi; }
#define SBAR() __builtin_amdgcn_sched_barrier(0)
constexpr int NSLOT = 3, SLOTB = 8192;
constexpr int LDS_K = 0, LDS_V = NSLOT * SLOTB, LDS_WS = 2 * NSLOT * SLOTB, LDS_OST = LDS_WS + NW * 64 * 4, LDS_OST1 = LDS_OST + NW * 4096, LDS_RPB = LDS_OST1 + NW * 4096, LDS_ATT_BYTES = LDS_RPB + 2048;
static_assert(LDS_ATT_BYTES <= RING_BYTES, "attention LDS");
__device__ __forceinline__ void glds16(const void* gsrc, unsigned lds_dst) { unsigned keep;
  asm volatile("s_mov_b32 %0, m0\n\ts_mov_b32 m0, %2\n\ts_nop 0\n\tglobal_load_lds_dwordx4 %1, off\n\ts_mov_b32 m0, %0" : "=&s"(keep) : "v"(gsrc), "s"(lds_dst) : "memory"); }
__device__ __forceinline__ float max3f(float a, float b, float c) { float r; asm("v_max3_f32 %0, %1, %2, %3" : "=v"(r) : "v"(a), "v"(b), "v"(c)); return r; }
__device__ __forceinline__ float max2f(float a, float b) { float r; asm("v_max_f32_e32 %0, %1, %2" : "=v"(r) : "v"(a), "v"(b)); return r; }
__device__ __forceinline__ float fadd_s(float a, float b) { float r; asm("v_add_f32_e32 %0, %1, %2" : "=v"(r) : "v"(a), "v"(b)); return r; }
__device__ __forceinline__ float fsub_s(float a, float b) { float r; asm("v_sub_f32_e32 %0, %1, %2" : "=v"(r) : "v"(a), "v"(b)); return r; }
__device__ __forceinline__ unsigned cvtpk_s(float lo, float hi) { return cvtpk(lo, hi); }
#define WAIT_BAR(N) asm volatile("s_waitcnt vmcnt(" #N ") lgkmcnt(0)\n\ts_barrier" ::: "memory")

typedef __attribute__((address_space(3))) const char* lds_cptr;
typedef short v4i16_t __attribute__((ext_vector_type(4)));
template <bool HALFD> __device__ __forceinline__ void qkt(f32x16& p0, f32x16& p1, lds_cptr Kslot, const bf16x8* qr, const f32x16& negm, int r32, int hi) {
  lds_cptr kb = Kslot + hi * 1024 + r32 * 16;
  #pragma unroll
  for (int d0 = 0; d0 < (HALFD ? 2 : 4); ++d0) {
    const bf16x8 b0 = *(const __attribute__((address_space(3))) bf16x8*)(kb + d0 * 2048);
    const bf16x8 b1 = *(const __attribute__((address_space(3))) bf16x8*)(kb + d0 * 2048 + 512);
    if (d0 == 0) { p0 = __builtin_amdgcn_mfma_f32_32x32x16_bf16(b0, qr[0], negm, 0, 0, 0); p1 = __builtin_amdgcn_mfma_f32_32x32x16_bf16(b1, qr[0], negm, 0, 0, 0); }
    else { p0 = __builtin_amdgcn_mfma_f32_32x32x16_bf16(b0, qr[d0], p0, 0, 0, 0); p1 = __builtin_amdgcn_mfma_f32_32x32x16_bf16(b1, qr[d0], p1, 0, 0, 0); } }
}
__device__ __forceinline__ void kload8(bf16x8* kf, lds_cptr kp) {
  kf[0] = *(const __attribute__((address_space(3))) bf16x8*)(kp);        kf[1] = *(const __attribute__((address_space(3))) bf16x8*)(kp + 512);
  kf[2] = *(const __attribute__((address_space(3))) bf16x8*)(kp + 2048); kf[3] = *(const __attribute__((address_space(3))) bf16x8*)(kp + 2560);
  kf[4] = *(const __attribute__((address_space(3))) bf16x8*)(kp + 4096); kf[5] = *(const __attribute__((address_space(3))) bf16x8*)(kp + 4608);
  kf[6] = *(const __attribute__((address_space(3))) bf16x8*)(kp + 6144); kf[7] = *(const __attribute__((address_space(3))) bf16x8*)(kp + 6656);
}
__device__ __forceinline__ void kload2(bf16x8* kf, lds_cptr kp, int j) { kf[2 * j] = *(const __attribute__((address_space(3))) bf16x8*)(kp + j * 2048); kf[2 * j + 1] = *(const __attribute__((address_space(3))) bf16x8*)(kp + j * 2048 + 512); }
__device__ __forceinline__ s16x4 vtr(lds_cptr p) { return __builtin_bit_cast(s16x4, __builtin_amdgcn_ds_read_tr16_b64_v4i16((__attribute__((address_space(3))) v4i16_t*)p)); }
__device__ __forceinline__ float rowmax(const f32x16& p0, const f32x16& p1) {
  float a = max3f(p0[0], p0[1], p1[0]), b = max3f(p0[2], p0[3], p1[1]); a = max3f(a, p1[2], p1[3]);
  #pragma unroll
  for (int r = 4; r < 16; r += 4) { a = max3f(a, p0[r], p0[r + 1]); b = max3f(b, p0[r + 2], p0[r + 3]); a = max3f(a, p1[r], p1[r + 1]); b = max3f(b, p1[r + 2], p1[r + 3]); }
  const float m = max2f(a, b);
  auto rr = __builtin_amdgcn_permlane32_swap(__float_as_uint(m), __float_as_uint(m), false, false);
  return max2f(__uint_as_float(rr[0]), __uint_as_float(rr[1]));
}
__device__ __forceinline__ void pv(f32x16* o, int vb, bf16x8 pa0, bf16x8 pa1, bf16x8 pa2, bf16x8 pa3) {
  #pragma unroll
  for (int d0 = 0; d0 < 2; ++d0) { s16x4 lo[4], hi[4];
    #pragma unroll
    for (int ks = 0; ks < 4; ++ks) {
      asm volatile("ds_read_b64_tr_b16 %0,%1 offset:%c2" : "=&v"(lo[ks]) : "v"(vb), "i"(d0 * 4096 + ks * 1024) : "memory");
      asm volatile("ds_read_b64_tr_b16 %0,%1 offset:%c2" : "=&v"(hi[ks]) : "v"(vb), "i"(d0 * 4096 + ks * 1024 + 512) : "memory"); }
    asm volatile("s_waitcnt lgkmcnt(0)" ::: "memory"); SBAR();
    #define PK(k) (bf16x8){lo[k][0], lo[k][1], lo[k][2], lo[k][3], hi[k][0], hi[k][1], hi[k][2], hi[k][3]}
    o[d0] = __builtin_amdgcn_mfma_f32_32x32x16_bf16(pa0, PK(0), o[d0], 0, 0, 0);
    o[d0] = __builtin_amdgcn_mfma_f32_32x32x16_bf16(pa1, PK(1), o[d0], 0, 0, 0);
    o[d0] = __builtin_amdgcn_mfma_f32_32x32x16_bf16(pa2, PK(2), o[d0], 0, 0, 0);
    o[d0] = __builtin_amdgcn_mfma_f32_32x32x16_bf16(pa3, PK(3), o[d0], 0, 0, 0);
    #undef PK
  }
}

struct DiffEpi { float lam, post; const float* subg; };
template <int THRL, int MODE> __device__ __forceinline__ void attn_unit(const bf16* Qu, const bf16* __restrict__ Kh, const bf16* __restrict__ Vh, int NT, bf16* Ou, char* shm, const DiffEpi de, const bool usemax = true, const float* kmaxp = nullptr) {
  constexpr int PK = PQ, PV = PQ, PO = 1024;
  constexpr bool DQ32 = (MODE != 0);
  const int tid = opaque_tid(), lane = tid & 63, r32 = lane & 31, hi = lane >> 5; const int wid = __builtin_amdgcn_readfirstlane(tid >> 6);
  const bf16* Qw = Qu + (long)(wid * QBLK) * PQ;
  const unsigned lds0 = (unsigned)(uintptr_t)shm;
  float* wsf = (float*)(shm + LDS_WS) + wid * 64;
  const bf16* ksrc = Kh + (long)lane * PK + wid * 8;
  const bf16* vsrc = Vh + (long)(16 * (wid & 3) + (lane >> 2)) * PV + (wid >> 2) * 32 + (lane & 3) * 8;
  const unsigned kdst = lds0 + LDS_K + wid * 1024, vdst = lds0 + LDS_V + wid * 1024;
  #define DMA_K(t, slot) glds16(ksrc + (long)(t) * KVBLK * PK, (unsigned)__builtin_amdgcn_readfirstlane(kdst + (slot)))
  #define DMA_V(t, slot) glds16(vsrc + (long)(t) * KVBLK * PV, (unsigned)__builtin_amdgcn_readfirstlane(vdst + (slot)))
  const int vb0 = (int)(lds0 + LDS_V) + ((lane >> 4) & 1) * 32 + (lane & 3) * 8 + (4 * hi + ((lane & 15) >> 2)) * 64;
  bf16x8 kf[8];
  const lds_cptr shm3 = (lds_cptr)shm; const lds_cptr kp0 = shm3 + LDS_K + hi * 1024 + r32 * 16; const lds_cptr vp0 = shm3 + LDS_V + ((lane >> 4) & 1) * 32 + (lane & 3) * 8 + (4 * hi + ((lane & 15) >> 2)) * 64;
  DMA_K(0, 0); DMA_V(0, 0); DMA_K(1, SLOTB);
  bf16x8 qr[4];
  #pragma unroll
  for (int d0 = 0; d0 < 4; ++d0) qr[d0] = *reinterpret_cast<const bf16x8*>(&Qw[(long)r32 * PQ + d0 * 16 + hi * 8]);
  constexpr bool LMF = DQ32;
  bool um = usemax;
  if (MODE != 0) {
    float q2 = 0.f;
    #pragma unroll
    for (int d0 = 0; d0 < 2; ++d0)
      #pragma unroll
      for (int jq = 0; jq < 8; ++jq) { const float v = __uint_as_float((unsigned)(unsigned short)qr[d0][jq] << 16); q2 += v * v; }
    const float bq = sqrtf(xor32_sum(q2)) * (*kmaxp) * 1.02f;
    um = __builtin_amdgcn_readfirstlane((int)(__ballot(bq > 40.0f) != 0ull)) != 0; }
  float mhat = 0.f, l_reg = 0.f; f32x16 o[2]; o[0] = f32x16{}; o[1] = f32x16{}; f32x16 negm = f32x16{}; asm volatile("" : "+v"(negm));
  f32x16 lacc = f32x16{}; bf16x8 ones; { unsigned c0_, c1_, c2_, c3_; asm volatile("v_mov_b32 %0, 0x3f803f80\n\tv_mov_b32 %1, 0x3f803f80\n\tv_mov_b32 %2, 0x3f803f80\n\tv_mov_b32 %3, 0x3f803f80" : "=v"(c0_), "=v"(c1_), "=v"(c2_), "=v"(c3_)); ones = __builtin_bit_cast(bf16x8, (u32x4){c0_, c1_, c2_, c3_}); }
  bool resc = false;
  #define START(P0, P1) do { const float rm = rowmax(P0, P1); resc = false; \
    { const float dl = rm; mhat = fadd_s(mhat, dl); \
      _Pragma("unroll") for (int r = 0; r < 16; ++r) { P0[r] = fsub_s(P0[r], dl); P1[r] = fsub_s(P1[r], dl); } \
      _Pragma("unroll") for (int r = 0; r < 16; ++r) negm[r] = -mhat; asm volatile("" : "+v"(negm)); } \
    _Pragma("unroll") for (int r = 0; r < 16; ++r) P0[r] = __builtin_amdgcn_exp2f(P0[r]); } while (0)
  #define RESC() do { if (resc) { asm volatile("s_waitcnt lgkmcnt(0)" ::: "memory"); \
      _Pragma("unroll") for (int d_ = 0; d_ < 2; ++d_) _Pragma("unroll") for (int r = 0; r < 16; ++r) o[d_][r] *= wsf[crow(r, hi)]; \
      if (LMF) { _Pragma("unroll") for (int r = 0; r < 16; ++r) lacc[r] *= wsf[crow(r, hi)]; } } } while (0)
  f32x16 pA0, pA1, pB0, pB1;
  int sl_prev = 0, sl_cur = 0, sl_next = SLOTB;
  #define ROT() do { sl_prev = sl_cur; sl_cur = sl_next; sl_next = (sl_next == (NSLOT - 1) * SLOTB) ? 0 : sl_next + SLOTB; } while (0)
  DMA_K(2, 2 * SLOTB);
  WAIT_BAR(3);
  qkt<DQ32>(pA0, pA1, shm3 + LDS_K, qr, negm, r32, hi); asm volatile("s_nop 15\n\ts_nop 7" : "+v"(pA0), "+v"(pA1));
  START(pA0, pA1);
  _Pragma("unroll") for (int r = 0; r < 16; ++r) pA1[r] = __builtin_amdgcn_exp2f(pA1[r]);
  WAIT_BAR(0);
  DMA_K(3, 0); DMA_V(1, SLOTB);
  ROT();
  kload8(kf, kp0 + sl_cur);
  WAIT_BAR(2);
  s16x4 vlo[8], vhi[8]; u32x4 pw0, pw1, pw2, pw3;
  #define PKW(P, B) cvtpk_s(P[B], P[B + 1])
  #define PAF(k) __builtin_bit_cast(bf16x8, pw##k)
  #define VFR(i) (bf16x8){vlo[i][0], vlo[i][1], vlo[i][2], vlo[i][3], vhi[i][0], vhi[i][1], vhi[i][2], vhi[i][3]}
  #define PIN(x) asm volatile("" : "+v"(x))
  #define MX3(a, b, c) __builtin_fmaxf(__builtin_fmaxf((a), (b)), (c))
  #define GAPA(MF, A0, A1, A2, A3, W0, W1, PW) do { MF; if (!LMF) { sacc += A0; sacc += A1; sacc += A2; sacc += A3; PIN(sacc); } W0; W1; PIN(PW); SBAR(); } while (0)
  #define LMM(k) lacc = __builtin_amdgcn_mfma_f32_32x32x16_bf16(PAF(k), ones, lacc, 0, 0, 0)
  #define EX(v) __builtin_amdgcn_exp2f(v)
  #define GAPB(MF, X, B) do { MF; X[B] = EX(X[B]); X[B + 1] = EX(X[B + 1]); X[B + 2] = EX(X[B + 2]); X[B + 3] = EX(X[B + 3]); PIN(X); SBAR(); } while (0)
  #define VRD(i) do { vlo[i] = vtr(vp_ + (((i) >> 2) * 4096 + ((i) & 3) * 1024)); vhi[i] = vtr(vp_ + (((i) >> 2) * 4096 + ((i) & 3) * 1024 + 512)); } while (0)
  #define KRD(G, j) do { if (G) { kload2(kf, kp0 + sl_next, j); SBAR(); } } while (0)
  #define STEP(C0, C1, P0, P1, t, GK, GV, GL) do { SBAR(); \
    const lds_cptr vp_ = vp0 + sl_prev; \
    VRD(0); SBAR(); float sacc = (P0[0] + P0[1]); \
    GAPA(C0 = __builtin_amdgcn_mfma_f32_32x32x16_bf16(kf[0], qr[0], negm, 0, 0, 0), P0[2], P0[3], P0[4], P0[5],     pw0[0] = PKW(P0, 0), pw0[1] = PKW(P0, 2), pw0); \
    VRD(4); SBAR(); GAPA(C1 = __builtin_amdgcn_mfma_f32_32x32x16_bf16(kf[1], qr[0], negm, 0, 0, 0), P0[6], P0[7], P0[8], P0[9],     pw0[2] = PKW(P0, 4), pw0[3] = PKW(P0, 6), pw0); \
    VRD(1); SBAR(); GAPA(C0 = __builtin_amdgcn_mfma_f32_32x32x16_bf16(kf[2], qr[1], C0, 0, 0, 0),   P0[10], P0[11], P0[12], P0[13], pw1[0] = PKW(P0, 8), pw1[1] = PKW(P0, 10), pw1); \
    VRD(5); SBAR(); GAPA(C1 = __builtin_amdgcn_mfma_f32_32x32x16_bf16(kf[3], qr[1], C1, 0, 0, 0),   P0[14], P0[15], P1[0], P1[1],   pw1[2] = PKW(P0, 12), pw1[3] = PKW(P0, 14), pw1); \
    VRD(2); SBAR(); GAPA(do { if (!DQ32) { C0 = __builtin_amdgcn_mfma_f32_32x32x16_bf16(kf[4], qr[2], C0, 0, 0, 0); } else if (LMF) { LMM(0); } } while (0),   P1[2], P1[3], P1[4], P1[5],     pw2[0] = PKW(P1, 0), pw2[1] = PKW(P1, 2), pw2); \
    VRD(6); SBAR(); GAPA(do { if (!DQ32) { C1 = __builtin_amdgcn_mfma_f32_32x32x16_bf16(kf[5], qr[2], C1, 0, 0, 0); } else if (LMF) { LMM(1); } } while (0),   P1[6], P1[7], P1[8], P1[9],     pw2[2] = PKW(P1, 4), pw2[3] = PKW(P1, 6), pw2); \
    VRD(3); SBAR(); GAPA(do { if (!DQ32) { C0 = __builtin_amdgcn_mfma_f32_32x32x16_bf16(kf[6], qr[3], C0, 0, 0, 0); } else if (LMF) { LMM(2); } } while (0),   P1[10], P1[11], P1[12], P1[13], pw3[0] = PKW(P1, 8), pw3[1] = PKW(P1, 10), pw3); \
    VRD(7); SBAR(); GAPA(do { if (!DQ32) { C1 = __builtin_amdgcn_mfma_f32_32x32x16_bf16(kf[7], qr[3], C1, 0, 0, 0); } } while (0),   P1[14], P1[15], 0.f, 0.f,       pw3[2] = PKW(P1, 12), pw3[3] = PKW(P1, 14), pw3); \
    if (LMF) { LMM(3); } else { l_reg += sacc; } \
    if (GK) { DMA_K((t) + 3, sl_cur); } if (GV) { DMA_V((t) + 1, sl_next); } \
    if (um) { float a = MX3(C0[0], C0[1], C1[0]), b = MX3(C0[2], C0[3], C1[1]); a = MX3(a, C1[2], C1[3]); \
      _Pragma("unroll") for (int r = 4; r < 16; r += 4) { a = MX3(a, C0[r], C0[r + 1]); b = MX3(b, C0[r + 2], C0[r + 3]); a = MX3(a, C1[r], C1[r + 1]); b = MX3(b, C1[r + 2], C1[r + 3]); } \
      float rm = __builtin_fmaxf(a, b); { auto rr = __builtin_amdgcn_permlane32_swap(__float_as_uint(rm), __float_as_uint(rm), false, false); rm = __builtin_fmaxf(__uint_as_float(rr[0]), __uint_as_float(rr[1])); } \
      resc = false; \
      if (__builtin_expect(__any(rm > (float)THRL), 0)) { const float dl = __builtin_fmaxf(rm, 0.f); mhat += dl; \
        _Pragma("unroll") for (int r = 0; r < 16; ++r) { C0[r] -= dl; C1[r] -= dl; } \
        _Pragma("unroll") for (int r = 0; r < 16; ++r) negm[r] = -mhat; asm volatile("" : "+v"(negm)); \
        const float f = __builtin_amdgcn_exp2f(-dl); if (!LMF) l_reg *= f; if (hi == 0) wsf[r32] = f; resc = true; } } else { resc = false; } \
    SBAR(); \
    GAPB(o[0] = __builtin_amdgcn_mfma_f32_32x32x16_bf16(PAF(0), VFR(0), o[0], 0, 0, 0), C0, 0); \
    GAPB(o[1] = __builtin_amdgcn_mfma_f32_32x32x16_bf16(PAF(0), VFR(4), o[1], 0, 0, 0), C0, 4); \
    KRD(GL, 0); GAPB(o[0] = __builtin_amdgcn_mfma_f32_32x32x16_bf16(PAF(1), VFR(1), o[0], 0, 0, 0), C0, 8); \
    KRD(GL, 1); GAPB(o[1] = __builtin_amdgcn_mfma_f32_32x32x16_bf16(PAF(1), VFR(5), o[1], 0, 0, 0), C0, 12); \
    KRD(GL && !DQ32, 2); GAPB(o[0] = __builtin_amdgcn_mfma_f32_32x32x16_bf16(PAF(2), VFR(2), o[0], 0, 0, 0), C1, 0); \
    KRD(GL && !DQ32, 3); GAPB(o[1] = __builtin_amdgcn_mfma_f32_32x32x16_bf16(PAF(2), VFR(6), o[1], 0, 0, 0), C1, 4); \
    GAPB(o[0] = __builtin_amdgcn_mfma_f32_32x32x16_bf16(PAF(3), VFR(3), o[0], 0, 0, 0), C1, 8); \
    GAPB(o[1] = __builtin_amdgcn_mfma_f32_32x32x16_bf16(PAF(3), VFR(7), o[1], 0, 0, 0), C1, 12); \
    } while (0)
  int t = 1;
  for (; t + 5 < NT; t += 2) {
    STEP(pB0, pB1, pA0, pA1, t, true, true, true);     WAIT_BAR(2); RESC(); ROT();
    STEP(pA0, pA1, pB0, pB1, t + 1, true, true, true); WAIT_BAR(2); RESC(); ROT();
  }
  #define ENDW(tt) do { if ((tt) + 3 < NT) { WAIT_BAR(2); } else if ((tt) + 2 < NT) { WAIT_BAR(1); } else { WAIT_BAR(0); } } while (0)
  for (; t + 1 < NT; t += 2) {
    STEP(pB0, pB1, pA0, pA1, t, (t + 3 < NT), (t + 1 < NT), (t + 1 < NT));       ENDW(t);     RESC(); ROT();
    STEP(pA0, pA1, pB0, pB1, t + 1, (t + 4 < NT), (t + 2 < NT), (t + 2 < NT));   ENDW(t + 1); RESC(); ROT();
  }
  STEP(pB0, pB1, pA0, pA1, NT - 1, false, false, false); RESC();
  { if (!LMF) { float sacc = pB0[0] + pB0[1]; _Pragma("unroll") for (int r = 2; r < 16; ++r) sacc += pB0[r]; _Pragma("unroll") for (int r = 0; r < 16; ++r) sacc += pB1[r]; l_reg += sacc; }
    pw0 = (u32x4){PKW(pB0, 0), PKW(pB0, 2), PKW(pB0, 4), PKW(pB0, 6)}; pw1 = (u32x4){PKW(pB0, 8), PKW(pB0, 10), PKW(pB0, 12), PKW(pB0, 14)}; pw2 = (u32x4){PKW(pB1, 0), PKW(pB1, 2), PKW(pB1, 4), PKW(pB1, 6)}; pw3 = (u32x4){PKW(pB1, 8), PKW(pB1, 10), PKW(pB1, 12), PKW(pB1, 14)};
    SBAR(); if (LMF) { LMM(0); LMM(1); LMM(2); LMM(3); } pv(o, vb0 + sl_cur, PAF(0), PAF(1), PAF(2), PAF(3)); }
  #undef LMM
  #undef PKW
  #undef PAF
  #undef VFR
  #undef PIN
  #undef MX3
  #undef GAPA
  #undef GAPB
  #undef EX
  #undef VRD
  #undef KRD
  #undef STEP
  #undef ENDW
  float rli[16];
  if (LMF) {
    #pragma unroll
    for (int r = 0; r < 16; ++r) rli[r] = __builtin_amdgcn_rcpf(lacc[r]);
  } else {
    { auto rr = __builtin_amdgcn_permlane32_swap(__float_as_uint(l_reg), __float_as_uint(l_reg), false, false); l_reg = __uint_as_float(rr[0]) + __uint_as_float(rr[1]); }
    if (hi == 0) wsf[32 + r32] = l_reg; asm volatile("s_waitcnt lgkmcnt(0)" ::: "memory");
    #pragma unroll
    for (int r = 0; r < 16; ++r) rli[r] = __builtin_amdgcn_rcpf(wsf[32 + crow(r, hi)]);
  }
  bf16_t* stg = (bf16_t*)(shm + LDS_OST) + wid * 2048;
  bf16_t* stg1 = (bf16_t*)(shm + LDS_OST1) + wid * 2048;
  if (MODE == 1) {
    #pragma unroll
    for (int r = 0; r < 16; ++r) { const int orow = crow(r, hi);
      #pragma unroll
      for (int d0 = 0; d0 < 2; ++d0) stg1[orow * 64 + d0 * 32 + r32] = f2bf(o[d0][r] * rli[r]); }
    asm volatile("s_waitcnt lgkmcnt(0)" ::: "memory");
  } else {
    if (MODE == 2) {
      const float g0 = de.subg[r32] * de.post, g1 = de.subg[32 + r32] * de.post;
      #pragma unroll
      for (int r = 0; r < 16; ++r) { const int orow = crow(r, hi);
        const float d0v = bf2f(stg1[orow * 64 + r32]) - de.lam * (o[0][r] * rli[r]), d1v = bf2f(stg1[orow * 64 + 32 + r32]) - de.lam * (o[1][r] * rli[r]);
        float ss = d0v * d0v + d1v * d1v;
        ss = half32_sum(ss);
        const float rstd = __builtin_amdgcn_rsqf(ss * (1.0f / 64.0f) + EPS);
        stg[orow * 64 + r32] = f2bf(d0v * rstd * g0); stg[orow * 64 + 32 + r32] = f2bf(d1v * rstd * g1); }
    } else {
      #pragma unroll
      for (int r = 0; r < 16; ++r) { const int orow = crow(r, hi);
        #pragma unroll
        for (int d0 = 0; d0 < 2; ++d0) stg[orow * 64 + d0 * 32 + r32] = f2bf(o[d0][r] * rli[r]); }
    }
    asm volatile("s_waitcnt lgkmcnt(0)" ::: "memory");
    bf16* Ow = Ou + (long)(wid * QBLK) * PO;
    #pragma unroll
    for (int i = 0; i < 4; ++i) { const int row = i * 8 + (lane >> 3), ch = lane & 7; const u32x4 v = *(const u32x4*)(stg + row * 64 + ch * 8); *(u32x4*)(Ow + (long)row * PO + ch * 8) = v; }
  }
  asm volatile("s_waitcnt lgkmcnt(0)\n\ts_barrier" ::: "memory");
  #undef DMA_K
  #undef DMA_V
  #undef START
  #undef RESC
  #undef ROT
}

__device__ __forceinline__ void na_unit(int b, int h, int g4, const bf16* QKV, bf16* YS, const float* rpb_h, char* shm, const float* kmaxp) {
  const bf16 *QA = QKV + C_QA, *KA = QKV + C_KA, *VA = QKV + C_VA;
  const int tid = opaque_tid(), lane = tid & 63, r32 = lane & 31, hi = lane >> 5; const int wid = __builtin_amdgcn_readfirstlane(tid >> 6);
  const unsigned lds0 = (unsigned)(uintptr_t)shm;
  float* wsf = (float*)(shm + LDS_WS) + wid * 64;
  float* rp = (float*)(shm + LDS_RPB);
  const lds_cptr shm3 = (lds_cptr)shm;
  for (int i = tid; i < 15 * 31; i += 512) rp[i] = rpb_h[i] * LOG2E;
  const int rq = 4 * g4 + (wid >> 1), qc = 32 * (wid & 1) + r32;
  const long rowb = (long)b * RB;
  const bf16* Qw = QA + (rowb + CTXL + rq * 64 + 32 * (wid & 1)) * PQ + h * 64;
  bf16x8 qr[4];
  #pragma unroll
  for (int d0 = 0; d0 < 4; ++d0) qr[d0] = *reinterpret_cast<const bf16x8*>(&Qw[(long)r32 * PQ + d0 * 16 + hi * 8]);
  bool fx; { float q2 = 0.f;
    #pragma unroll
    for (int d0 = 0; d0 < 4; ++d0)
      #pragma unroll
      for (int jq = 0; jq < 8; ++jq) { const float v = __uint_as_float((unsigned)(unsigned short)qr[d0][jq] << 16); q2 += v * v; }
    float bm = 0.f; for (int i = lane; i < 15 * 31; i += 64) bm = fmaxf(bm, fabsf(rpb_h[i]));
    const float bq = sqrtf(xor32_sum(q2)) * (*kmaxp) * 1.02f + wave_max(bm) * LOG2E;
    fx = __builtin_amdgcn_readfirstlane((int)(__ballot(bq > 40.0f) != 0ull)) == 0; }
  const int r0 = min(max(rq - 4, 0), 120);
  const int kr_lo = min(max(4 * g4 - 4, 0), 120), kr_hi = min(max(4 * g4 - 1, 0), 120) + 7;
  const int ntiles = 4 + (kr_hi - kr_lo + 1);
  const int c0 = min(max(qc - 8, 0), 48);
  float mrun = -INFINITY, l_reg = 0.f; f32x16 o[2]; o[0] = f32x16{}; o[1] = f32x16{};
  const unsigned kdst = lds0 + LDS_K + wid * 1024, vdst = lds0 + LDS_V + wid * 1024;
  const int vb0 = (int)(lds0 + LDS_V) + ((lane >> 4) & 1) * 32 + (lane & 3) * 8 + (4 * hi + ((lane & 15) >> 2)) * 64;
  #define NA_DMA(TI) do { const int kr_ = kr_lo + (TI) - 4; const long krow_ = ((TI) < 4) ? rowb + 64 * (TI) : rowb + CTXL + (long)kr_ * 64; const unsigned so_ = ((TI) & 1) * SLOTB; \
      glds16(KA + (krow_ + lane) * PQ + h * 64 + wid * 8, (unsigned)__builtin_amdgcn_readfirstlane(kdst + so_)); \
      glds16(VA + (krow_ + 16 * (wid & 3) + (lane >> 2)) * PQ + h * 64 + (wid >> 2) * 32 + (lane & 3) * 8, (unsigned)__builtin_amdgcn_readfirstlane(vdst + so_)); } while (0)
  asm volatile("s_waitcnt lgkmcnt(0)\n\ts_barrier" ::: "memory");
  NA_DMA(0);
  for (int ti = 0; ti < ntiles; ++ti) {
    const int kr = kr_lo + ti - 4;
    asm volatile("s_waitcnt vmcnt(0) lgkmcnt(0)\n\ts_barrier" ::: "memory");
    if (ti + 1 < ntiles) NA_DMA(ti + 1);
    const unsigned so = (ti & 1) * SLOTB;
    const bool valid = (ti < 4) || (kr >= r0 && kr <= r0 + 7);
    if (valid) {
      f32x16 p0, p1; const f32x16 z = f32x16{};
      qkt<false>(p0, p1, shm3 + LDS_K + so, qr, z, r32, hi);
      if (ti >= 4) {
        const int dr = kr - rq + 7;
        #pragma unroll
        for (int r = 0; r < 16; ++r) { const int k0 = crow(r, hi), k1 = k0 + 32;
          const bool v0 = (k0 >= c0) && (k0 < c0 + 16), v1 = (k1 >= c0) && (k1 < c0 + 16);
          const float b0 = v0 ? rp[dr * 31 + (k0 - qc + 15)] : 0.f, b1 = v1 ? rp[dr * 31 + (k1 - qc + 15)] : 0.f;
          p0[r] = v0 ? p0[r] + b0 : -INFINITY; p1[r] = v1 ? p1[r] + b1 : -INFINITY; }
      }
      if (fx) { float sacc = 0.f;
        #pragma unroll
        for (int r = 0; r < 16; ++r) { p0[r] = __builtin_amdgcn_exp2f(p0[r]); p1[r] = __builtin_amdgcn_exp2f(p1[r]); sacc += p0[r] + p1[r]; }
        l_reg += sacc;
      } else {
      float rm = p0[0];
      #pragma unroll
      for (int r = 1; r < 16; ++r) rm = fmaxf(rm, p0[r]);
      #pragma unroll
      for (int r = 0; r < 16; ++r) rm = fmaxf(rm, p1[r]);
      { auto rr = __builtin_amdgcn_permlane32_swap(__float_as_uint(rm), __float_as_uint(rm), false, false); rm = fmaxf(__uint_as_float(rr[0]), __uint_as_float(rr[1])); }
      const float mnew = fmaxf(mrun, rm); const float f = __builtin_amdgcn_exp2f(mrun - mnew); mrun = mnew;
      float sacc = 0.f;
      #pragma unroll
      for (int r = 0; r < 16; ++r) { p0[r] = __builtin_amdgcn_exp2f(p0[r] - mnew); p1[r] = __builtin_amdgcn_exp2f(p1[r] - mnew); sacc += p0[r] + p1[r]; }
      l_reg = l_reg * f + sacc;
      if (hi == 0) wsf[r32] = f;
      asm volatile("s_waitcnt lgkmcnt(0)" ::: "memory");
      #pragma unroll
      for (int d_ = 0; d_ < 2; ++d_)
        #pragma unroll
        for (int r = 0; r < 16; ++r) o[d_][r] *= wsf[crow(r, hi)];
      }
      u32x4 pw0, pw1, pw2, pw3;
      pw0 = (u32x4){cvtpk(p0[0], p0[1]), cvtpk(p0[2], p0[3]), cvtpk(p0[4], p0[5]), cvtpk(p0[6], p0[7])}; pw1 = (u32x4){cvtpk(p0[8], p0[9]), cvtpk(p0[10], p0[11]), cvtpk(p0[12], p0[13]), cvtpk(p0[14], p0[15])};
      pw2 = (u32x4){cvtpk(p1[0], p1[1]), cvtpk(p1[2], p1[3]), cvtpk(p1[4], p1[5]), cvtpk(p1[6], p1[7])}; pw3 = (u32x4){cvtpk(p1[8], p1[9]), cvtpk(p1[10], p1[11]), cvtpk(p1[12], p1[13]), cvtpk(p1[14], p1[15])};
      asm volatile("s_waitcnt lgkmcnt(0)" ::: "memory");
      pv(o, vb0 + (int)so, __builtin_bit_cast(bf16x8, pw0), __builtin_bit_cast(bf16x8, pw1), __builtin_bit_cast(bf16x8, pw2), __builtin_bit_cast(bf16x8, pw3));
    }
  }
  #undef NA_DMA
  { auto rr = __builtin_amdgcn_permlane32_swap(__float_as_uint(l_reg), __float_as_uint(l_reg), false, false); l_reg = __uint_as_float(rr[0]) + __uint_as_float(rr[1]); }
  if (hi == 0) wsf[32 + r32] = l_reg; asm volatile("s_waitcnt lgkmcnt(0)" ::: "memory");
  bf16_t* stg = (bf16_t*)(shm + LDS_OST) + wid * 2048;
  #pragma unroll
  for (int r = 0; r < 16; ++r) { const int orow = crow(r, hi); const float rl = __builtin_amdgcn_rcpf(wsf[32 + orow]);
    #pragma unroll
    for (int d0 = 0; d0 < 2; ++d0) stg[orow * 64 + d0 * 32 + r32] = f2bf(o[d0][r] * rl); }
  asm volatile("s_waitcnt lgkmcnt(0)" ::: "memory");
  bf16* Ow = YS + (rowb + CTXL + rq * 64 + 32 * (wid & 1)) * 1024 + h * 64;
  #pragma unroll
  for (int i = 0; i < 4; ++i) { const int row = i * 8 + (lane >> 3), ch = lane & 7; const u32x4 v = *(const u32x4*)(stg + row * 64 + ch * 8); *(u32x4*)(Ow + (long)row * 1024 + ch * 8) = v; }
  asm volatile("s_waitcnt lgkmcnt(0)\n\ts_barrier" ::: "memory");
}
#undef SBAR
#undef WAIT_BAR
}

__device__ __forceinline__ void sgu_unit(long rowbase, const bf16_t* GU, const bf16_t* GV, const float* ng, const float* sw, const float* sb, bf16_t* YS, char* shm) {
    using attn_body::crow;
    const int tid = opaque_tid(), lane = tid & 63, wid = __builtin_amdgcn_readfirstlane(tid >> 6), r32 = lane & 31, hi = lane >> 5;
    const unsigned lds0 = (unsigned)(uintptr_t)shm;
    {
        const f32x4 g4 = *(const f32x4*)(ng + 4 * lane);
        const int gl = lane >> 4, d = 4 * (lane & 15);
#pragma unroll
        for (int rb = 0; rb < 4; ++rb) { v2u raw[4];
#pragma unroll
            for (int q4 = 0; q4 < 4; ++q4) raw[q4] = *(const v2u*)(GV + (rowbase + wid * 16 + rb * 4 + q4) * PQ + 4 * lane);
            __builtin_amdgcn_sched_barrier(0);
#pragma unroll
            for (int q4 = 0; q4 < 4; ++q4) { const int q = wid * 16 + rb * 4 + q4;
                f32x4 v = {bflo(raw[q4].x), bfhi(raw[q4].x), bflo(raw[q4].y), bfhi(raw[q4].y)};
                const float mean = wave_sum((v.x + v.y) + (v.z + v.w)) * (1.0f / 256.0f);
                v = v - mean;
                const float var = wave_sum((v.x * v.x + v.y * v.y) + (v.z * v.z + v.w * v.w)) * (1.0f / 256.0f);
                const float rstd = __builtin_amdgcn_rsqf(var + EPS);
                v = v * rstd * g4;
                v2u w; w.x = cvtpk(v.x, v.y); w.y = cvtpk(v.z, v.w);
                const int k = q & 63;
                *(v2u*)(shm + (2 * gl + (q >> 6)) * 8192 + ((d >> 5) * 4 + (k >> 4)) * 1024 + (k & 15) * 64 + (d & 31) * 2) = w; }
            __builtin_amdgcn_sched_barrier(0); }
    }
    __syncthreads();
    const int g = wid & 3, ph = wid >> 2;
    const int vb0 = (int)lds0 + ((lane >> 4) & 1) * 32 + (lane & 3) * 8 + (4 * hi + ((lane & 15) >> 2)) * 64;
    bf16_t* stg = (bf16_t*)(shm + 65536) + wid * 2048;
#pragma unroll
    for (int mt = 0; mt < 2; ++mt) {
        const int p0 = ph * 64 + mt * 32;
        const float* wrow = sw + ((size_t)g * 128 + p0 + r32) * 128 + 4 * hi;
        f32x16 o[2]; o[0] = f32x16{}; o[1] = f32x16{};
#pragma unroll
        for (int sl = 0; sl < 2; ++sl) {
            f32x4 wa[4], wc[4];
#pragma unroll
            for (int s4 = 0; s4 < 4; ++s4) { wa[s4] = *(const f32x4*)(wrow + 64 * sl + 16 * s4); wc[s4] = *(const f32x4*)(wrow + 64 * sl + 16 * s4 + 8); }
            __builtin_amdgcn_sched_barrier(0);
            bf16x8 pa[4];
#pragma unroll
            for (int s4 = 0; s4 < 4; ++s4) { const v4u w = {cvtpk(wa[s4].x, wa[s4].y), cvtpk(wa[s4].z, wa[s4].w), cvtpk(wc[s4].x, wc[s4].y), cvtpk(wc[s4].z, wc[s4].w)}; pa[s4] = __builtin_bit_cast(bf16x8, w); }
            attn_body::pv(o, vb0 + (2 * g + sl) * 8192, pa[0], pa[1], pa[2], pa[3]);
        }
        float bias[16];
#pragma unroll
        for (int r = 0; r < 16; ++r) bias[r] = sb[g * 128 + p0 + crow(r, hi)];
        v4u uu[4];
#pragma unroll
        for (int i = 0; i < 4; ++i) uu[i] = *(const v4u*)(GU + (rowbase + p0 + i * 8 + (lane >> 3)) * PQ + g * 64 + (lane & 7) * 8);
        __builtin_amdgcn_sched_barrier(0);
#pragma unroll
        for (int r = 0; r < 16; ++r) { const int orow = crow(r, hi);
#pragma unroll
            for (int d0 = 0; d0 < 2; ++d0) stg[orow * 64 + d0 * 32 + r32] = f2bf(o[d0][r] + bias[r]); }
        asm volatile("s_waitcnt lgkmcnt(0)" ::: "memory");
#pragma unroll
        for (int i = 0; i < 4; ++i) { const int row = i * 8 + (lane >> 3), ch = lane & 7; const v4u mv = *(const v4u*)(stg + row * 64 + ch * 8); const v4u u4 = uu[i];
            v4u w; w.x = cvtpk(bflo(u4.x) * bflo(mv.x), bfhi(u4.x) * bfhi(mv.x)); w.y = cvtpk(bflo(u4.y) * bflo(mv.y), bfhi(u4.y) * bfhi(mv.y));
            w.z = cvtpk(bflo(u4.z) * bflo(mv.z), bfhi(u4.z) * bfhi(mv.z)); w.w = cvtpk(bflo(u4.w) * bflo(mv.w), bfhi(u4.w) * bfhi(mv.w));
            *(v4u*)(YS + (rowbase + p0 + row) * 1024 + 512 + g * 64 + ch * 8) = w; }
        asm volatile("s_waitcnt lgkmcnt(0)" ::: "memory");
    }
    __syncthreads();
}

typedef GAS unsigned gu32;
#define XB_TMO      128
#define XB_XCNT(j)  (256  + 64 * (j))
#define XB_XSUB(j)  (1280 + 64 * (j))
#define XB_XGEN(j)  (2304 + 64 * (j))
#define XB_TOP      3328
#define XB_TOPGEN   3392
#define XCD_BAR_WORDS 3456
#define XB_SPIN_CAP (1u << 18)
__device__ __forceinline__ unsigned xb_ld(unsigned* p)              { return __hip_atomic_load(p, __ATOMIC_RELAXED, __HIP_MEMORY_SCOPE_AGENT); }
__device__ __forceinline__ unsigned xb_add(unsigned* p, unsigned v) { return __hip_atomic_fetch_add(p, v, __ATOMIC_RELAXED, __HIP_MEMORY_SCOPE_AGENT); }
__device__ __forceinline__ unsigned xb_xcc_id() { return (unsigned)__builtin_amdgcn_s_getreg((3 << 11) | 20) & 0xFu; }
#define XB_SPIN(cond, bar) do { unsigned _sp = 0; while (cond) { __builtin_amdgcn_s_sleep(1); \
    if ((++_sp & 255u) == 0u) { if (xb_ld(&(bar)[XB_TMO])) break; if (_sp > XB_SPIN_CAP) { atomicAdd(&(bar)[XB_TMO], 1u); break; } } } } while (0)
struct XcdBarrier { unsigned* bar; unsigned x; volatile LAS unsigned* st; };
__device__ __forceinline__ XcdBarrier xcd_barrier_post(unsigned* bar, volatile LAS unsigned* st) {
    XcdBarrier b; b.bar = bar; b.x = xb_xcc_id(); b.st = st;
    if (threadIdx.x == 0) (void)xb_add(&bar[XB_XCNT(b.x)], 1u);
    return b;
}
__device__ __forceinline__ void xcd_barrier_complete(unsigned* bar, unsigned x, unsigned& nloc, unsigned& nx) {
    const unsigned G = gridDim.x * gridDim.y * gridDim.z;
    unsigned sum, cnt, mine, sp = 0u;
    for (;;) {
        sum = 0u; cnt = 0u; mine = 0u;
#pragma unroll
        for (unsigned j = 0; j < 16; ++j) { const unsigned c = xb_ld(&bar[XB_XCNT(j)]); sum += c; cnt += (c > 0u) ? 1u : 0u; }
        if (sum == G) break;
        __builtin_amdgcn_s_sleep(1);
        if ((++sp & 255u) == 0u) { if (xb_ld(&bar[XB_TMO])) break; if (sp > XB_SPIN_CAP) { atomicAdd(&bar[XB_TMO], 1u); break; } }
    }
    mine = xb_ld(&bar[XB_XCNT(x)]);
    nloc = mine > 0u ? mine : 1u; nx = cnt > 0u ? cnt : 1u;
}
__device__ __forceinline__ void xcd_barrier(const XcdBarrier& b) {
    asm volatile("s_waitcnt vmcnt(0)" ::: "memory");
    __syncthreads();
    if (threadIdx.x == 0) {
        unsigned* bar = b.bar;
        __builtin_amdgcn_s_waitcnt(0);
        unsigned nloc = b.st[0], nx = b.st[1];
        if (nloc == 0u) { xcd_barrier_complete(bar, b.x, nloc, nx); b.st[0] = nloc; b.st[1] = nx; }
        const unsigned old = xb_add(&bar[XB_XSUB(b.x)], 1u);
        const unsigned gen = old / nloc;
        if (old + 1u == (gen + 1u) * nloc) {
            __builtin_amdgcn_fence(__ATOMIC_RELEASE, "agent");
            asm volatile("s_waitcnt vmcnt(0)" ::: "memory");
            const unsigned og = xb_add(&bar[XB_TOP], 1u);
            const unsigned tg = og / nx;
            if (og + 1u == (tg + 1u) * nx) xb_add(&bar[XB_TOPGEN], 1u);
            else XB_SPIN(xb_ld(&bar[XB_TOPGEN]) == tg, bar);
            __builtin_amdgcn_fence(__ATOMIC_ACQUIRE, "agent");
            xb_add(&bar[XB_XGEN(b.x)], 1u);
            asm volatile("s_waitcnt vmcnt(0)" ::: "memory");
        } else {
            XB_SPIN(xb_ld(&bar[XB_XGEN(b.x)]) == gen, bar);
            __builtin_amdgcn_fence(__ATOMIC_ACQUIRE, "agent");
            asm volatile("s_waitcnt vmcnt(0)" ::: "memory");
        }
    }
    __syncthreads();
}

struct Args { const float* in[28]; float* out; unsigned char* ws; int ph_lo, ph_hi, li, pad; };
typedef const __attribute__((address_space(4))) Args* KArgs;
__device__ __forceinline__ KArgs opaque_kargs() { KArgs p = (KArgs)__builtin_amdgcn_kernarg_segment_ptr(); asm volatile("" : "+s"(p)); return p; }
enum { I_X = 0, I_C, I_CTX, I_CCTX, I_WMOD, I_BMOD, I_N1G, I_N2G, I_WIN, I_QG, I_KG, I_RPB, I_LQ1, I_LK1, I_LQ2, I_LK2, I_SUBG, I_SGUNG, I_SGUW, I_SGUB, I_GATEB, I_WBR, I_WOUT, I_WRT, I_WEG, I_WEU, I_WED, I_FG };

constexpr int CW_WIN = 16 * 26, CW_WB = 4 * 4 * 4, CW_WO = 16 * 4, CW_EG = 16 * 16 * 8, CW_ED = 16 * 32 * 4, CW_LAYER = CW_WIN + CW_WB + CW_WO + 2 * CW_EG + CW_ED;
struct ConvItem { const float* src; unsigned char* dst; int N, dpitch, k0, n0, kind, aux; };
__device__ __forceinline__ ConvItem conv_decode(KArgs A, int it) {
    ConvItem c; const int l = it / CW_LAYER; int r = it % CW_LAYER; unsigned char* wl = A->ws + WS_W0 + (size_t)l * W_LAYER; c.aux = 0;
    if (r < CW_WIN) { const int kb = r / 26, pn = r % 26; c.src = A->in[I_WIN] + (size_t)l * DM * IN_W; c.N = IN_W; c.k0 = 64 * kb; c.n0 = 256 * pn; c.dpitch = DM;
        if (pn >= 5 && pn <= 20) { c.kind = 1; c.dst = wl + WO_WING + (size_t)(c.n0 - 1280) * DM; } else { c.kind = 2; c.dst = wl + WO_WIN + (size_t)256 * (pn < 5 ? pn : pn - 16) * DM * 2; }
        return c; }
    r -= CW_WIN;
    if (r < CW_WB) { const int n = r / 16, q = r % 16, kb = q / 4, nb = q % 4; c.src = A->in[I_WBR] + ((size_t)l * 4 + n) * 256 * DM; c.N = DM; c.k0 = 64 * kb; c.n0 = 256 * nb; c.dpitch = 256; c.kind = 0; c.dst = wl + WO_WB + ((size_t)n * 1024 + c.n0) * 256 * 2; return c; }
    r -= CW_WB;
    if (r < CW_WO) { const int kb = r / 4, nb = r % 4; c.src = A->in[I_WOUT] + (size_t)l * DM * DM; c.N = DM; c.k0 = 64 * kb; c.n0 = 256 * nb; c.dpitch = DM; c.kind = 0; c.dst = wl + WO_WO4 + (size_t)c.n0 * DM * 2; return c; }
    r -= CW_WO;
    if (r < 2 * CW_EG) { const int up = r >= CW_EG; if (up) r -= CW_EG; const int e = r / 128, q = r % 128, kb = q / 8, nb = q % 8; c.src = A->in[up ? I_WEU : I_WEG] + ((size_t)l * NEXP + e) * DM * EH; c.N = EH; c.k0 = 64 * kb; c.n0 = 256 * nb; c.dpitch = DM;
        c.kind = 3; c.aux = up ? 128 : 0; c.dst = wl + WO_WGU + (size_t)e * 4096 * DM; return c; }
    r -= 2 * CW_EG;
    { const int e = r / 128, q = r % 128, kb = q / 4, nb = q % 4; c.src = A->in[I_WED] + ((size_t)l * NEXP + e) * EH * DM; c.N = DM; c.k0 = 64 * kb; c.n0 = 256 * nb; c.dpitch = EH; c.kind = 1; c.dst = wl + WO_WD + ((size_t)e * DM + c.n0) * EH; return c; }
}
constexpr int CW_SMALL = CW_WIN + CW_WB + CW_WO, CW_MOE = 2 * CW_EG + CW_ED;
template <bool SMALL> __device__ __forceinline__ int conv_id(int it) { return SMALL ? (it / CW_SMALL) * CW_LAYER + it % CW_SMALL : it; }
template <bool SMALL> __device__ __forceinline__ void conv_load(KArgs A, int it, int NIT, f32x4 (&rg)[8], int wv, int lane) {
    if (it < NIT) { const ConvItem c = conv_decode(A, conv_id<SMALL>(it)); const float* p = c.src + (size_t)(c.k0 + wv * 8) * c.N + c.n0 + 4 * lane;
#pragma unroll
        for (int i = 0; i < 8; ++i) rg[i] = *(const f32x4*)(p + (size_t)i * c.N); }
}
constexpr int C8_WP = 2208, C8_JP = 528, C8_BYTES = 8 * C8_WP;
__device__ __forceinline__ void conv_out8(const ConvItem c, const f32x4 (&rg)[8], LAS unsigned char* T8, int tid, int wv, int lane) {
#pragma unroll
    for (int j = 0; j < 4; ++j) { v2u o; o.x = pk8(rg[0][j] * W8S, rg[1][j] * W8S, rg[2][j] * W8S, rg[3][j] * W8S); o.y = pk8(rg[4][j] * W8S, rg[5][j] * W8S, rg[6][j] * W8S, rg[7][j] * W8S);
        *(LAS v2u*)(T8 + wv * C8_WP + j * C8_JP + lane * 8) = o; }
    asm volatile("s_waitcnt lgkmcnt(0)" ::: "memory"); __builtin_amdgcn_s_barrier(); asm volatile("" ::: "memory");
#pragma unroll
    for (int jj = 0; jj < 2; ++jj) { const int q = tid + 512 * jj, cq = q & 3, n = q >> 2; const LAS unsigned char* t = T8 + (2 * cq) * C8_WP + (n & 3) * C8_JP + (n >> 2) * 8;
        const v2u a = *(const LAS v2u*)t, b = *(const LAS v2u*)(t + C8_WP); const int f = c.n0 + n;
        const int row = c.kind == 3 ? 256 * (f >> 7) + (f & 127) + c.aux : n;
        *(v4u*)(c.dst + (size_t)row * c.dpitch + c.k0 + 16 * cq) = (v4u){a.x, a.y, b.x, b.y}; }
}
template <bool SMALL> __device__ __forceinline__ void conv_out(KArgs A, int it, const f32x4 (&rg)[8], LAS float* T, int par, int tid, int wv, int lane) {
    { const ConvItem c8 = conv_decode(A, conv_id<SMALL>(it));
      if (!SMALL || c8.kind == 1 || c8.kind == 3) { conv_out8(c8, rg, (LAS unsigned char*)T + (SMALL ? 65536 : 0) + par * C8_BYTES, tid, wv, lane); return; } }
    constexpr int TP = 256;
#pragma unroll
    for (int i = 0; i < 8; ++i) *(LAS f32x4*)(T + (wv * 8 + i) * TP + 4 * (lane ^ wv)) = rg[i];
    asm volatile("s_waitcnt lgkmcnt(0)" ::: "memory"); __builtin_amdgcn_s_barrier(); asm volatile("" ::: "memory");
    const ConvItem c = conv_decode(A, conv_id<SMALL>(it));
#pragma unroll
    for (int jj = 0; jj < 4; ++jj) { const int q = tid + 512 * jj, ch = q & 7, n = q >> 3; const LAS float* t = T + (8 * ch) * TP + (n ^ (4 * ch));
        float v[8];
#pragma unroll
        for (int i = 0; i < 8; ++i) v[i] = t[i * TP];
        if (c.kind == 1) { v2u o; o.x = pk8(v[0] * W8S, v[1] * W8S, v[2] * W8S, v[3] * W8S); o.y = pk8(v[4] * W8S, v[5] * W8S, v[6] * W8S, v[7] * W8S); *(v2u*)(c.dst + (size_t)n * c.dpitch + c.k0 + 8 * ch) = o; }
        else if (c.kind == 3) { const int f = c.n0 + n; v2u o; o.x = pk8(v[0] * W8S, v[1] * W8S, v[2] * W8S, v[3] * W8S); o.y = pk8(v[4] * W8S, v[5] * W8S, v[6] * W8S, v[7] * W8S); *(v2u*)(c.dst + (size_t)(256 * (f >> 7) + (f & 127) + c.aux) * c.dpitch + c.k0 + 8 * ch) = o; }
        else { const int g = n >> 5, row = c.kind == 2 ? 32 * (4 * (g & 1) + (g >> 1)) + (n & 31) : n; st8((bf16_t*)c.dst + (size_t)row * c.dpitch + c.k0 + 8 * ch, v); } }
    asm volatile("s_waitcnt lgkmcnt(0)" ::: "memory"); __builtin_amdgcn_s_barrier(); asm volatile("" ::: "memory");
}
template <bool SMALL = false> __device__ __forceinline__ void conv_run(KArgs A, int first, int stride, int end, LAS unsigned char* lds, int tid) {
    const int lane = tid & 63, wv = tid >> 6; LAS float* T = (LAS float*)lds;
    f32x4 rg[4][8];
#pragma unroll
    for (int d = 0; d < 4; ++d) conv_load<SMALL>(A, first + d * stride, end, rg[d], wv, lane);
    for (int it = first; it < end; it += 4 * stride) {
#pragma unroll
        for (int d = 0; d < 4; ++d) if (it + d * stride < end) {
            f32x4 t0[8];
#pragma unroll
            for (int i = 0; i < 8; ++i) t0[i] = rg[d][i];
            conv_load<SMALL>(A, it + (4 + d) * stride, end, rg[d], wv, lane);
            conv_out<SMALL>(A, it + d * stride, t0, T, d & 1, tid, wv, lane);
        }
    }
    asm volatile("s_waitcnt lgkmcnt(0)" ::: "memory"); __builtin_amdgcn_s_barrier(); asm volatile("" ::: "memory");
}
__device__ __forceinline__ void mod_item(KArgs A, int item, LAS unsigned char* lds, int tid) {
    const int lane = tid & 63, wid = tid >> 6, l = item / 96, col0 = 64 * (item % 96);
    LAS float* sil = (LAS float*)lds;
    LAS float* part = sil + 3 * 1024;
    for (int i = tid; i < 3 * 1024; i += 512) { const int r = i >> 10, k = i & 1023; const float cv = r < 2 ? A->in[I_C][r * DM + k] : A->in[I_CCTX][k]; sil[i] = siluf_(cv); }
    __syncthreads();
    const float* W = A->in[I_WMOD] + (size_t)l * DM * 6144 + col0 + lane;
    float a0 = 0.f, a1 = 0.f, a2 = 0.f;
    for (int kb = 0; kb < 4; ++kb) { float w[32];
#pragma unroll
        for (int q = 0; q < 32; ++q) w[q] = W[(size_t)(wid * 128 + kb * 32 + q) * 6144];
        __builtin_amdgcn_sched_barrier(0);
#pragma unroll
        for (int q = 0; q < 32; ++q) { const int k = wid * 128 + kb * 32 + q; a0 += sil[k] * w[q]; a1 += sil[1024 + k] * w[q]; a2 += sil[2048 + k] * w[q]; }
        __builtin_amdgcn_sched_barrier(0); }
    part[(wid * 3 + 0) * 64 + lane] = a0; part[(wid * 3 + 1) * 64 + lane] = a1; part[(wid * 3 + 2) * 64 + lane] = a2;
    __syncthreads();
    if (tid < 192) { const int r = tid >> 6, cl = tid & 63; float s = A->in[I_BMOD][(size_t)l * 6144 + col0 + cl];
#pragma unroll
        for (int w = 0; w < 8; ++w) s += part[(w * 3 + r) * 64 + cl];
        ((float*)(A->ws + WS_MOD))[((size_t)l * 3 + r) * 6144 + col0 + cl] = s; }
    __syncthreads();
}

struct Row { f32x4 v[4]; };
__device__ __forceinline__ Row row_load(const float* p, int lane) { Row r; const f32x4* q = (const f32x4*)p + lane;
#pragma unroll
    for (int j = 0; j < 4; ++j) r.v[j] = q[64 * j]; return r; }
__device__ __forceinline__ Row row_load_bf16(const bf16_t* p, int lane) { Row r; const v2u* q = (const v2u*)p + lane; v2u t[4];
#pragma unroll
    for (int j = 0; j < 4; ++j) t[j] = q[64 * j];
#pragma unroll
    for (int j = 0; j < 4; ++j) r.v[j] = (f32x4){bflo(t[j].x), bfhi(t[j].x), bflo(t[j].y), bfhi(t[j].y)};
    return r; }
__device__ __forceinline__ void row_store(float* p, const Row& r, int lane) { f32x4* q = (f32x4*)p + lane;
#pragma unroll
    for (int j = 0; j < 4; ++j) q[64 * j] = r.v[j]; }
__device__ __forceinline__ float row_rstd(const Row& r) { float s = 0.f;
#pragma unroll
    for (int j = 0; j < 4; ++j) s += (r.v[j].x * r.v[j].x + r.v[j].y * r.v[j].y) + (r.v[j].z * r.v[j].z + r.v[j].w * r.v[j].w);
    return __builtin_amdgcn_rsqf(wave_sum(s) * (1.0f / DM) + EPS); }
__device__ __forceinline__ Row row_normmod(const Row& x, float rstd, const float* g, const float* sh, const float* sc, int lane) { Row y; f32x4 gg[4], ss[4], hh[4];
#pragma unroll
    for (int j = 0; j < 4; ++j) { gg[j] = ((const f32x4*)g)[lane + 64 * j]; ss[j] = ((const f32x4*)sc)[lane + 64 * j]; hh[j] = ((const f32x4*)sh)[lane + 64 * j]; }
    __builtin_amdgcn_sched_barrier(0);
#pragma unroll
    for (int j = 0; j < 4; ++j) y.v[j] = x.v[j] * rstd * gg[j] * (ss[j] + 1.0f) + hh[j];
    return y; }
struct NormP { f32x4 a[4], h[4]; };
__device__ __forceinline__ NormP normp_load(const float* g, const float* sh, const float* sc, int lane) { NormP p; f32x4 gg[4], ss[4];
#pragma unroll
    for (int j = 0; j < 4; ++j) { gg[j] = ((const f32x4*)g)[lane + 64 * j]; ss[j] = ((const f32x4*)sc)[lane + 64 * j]; p.h[j] = ((const f32x4*)sh)[lane + 64 * j]; }
    __builtin_amdgcn_sched_barrier(0);
#pragma unroll
    for (int j = 0; j < 4; ++j) p.a[j] = gg[j] * (ss[j] + 1.0f);
    return p; }
__device__ __forceinline__ Row row_normmod_p(const Row& x, float rstd, const NormP& p) { Row y;
#pragma unroll
    for (int j = 0; j < 4; ++j) y.v[j] = x.v[j] * rstd * p.a[j] + p.h[j];
    return y; }
__device__ __forceinline__ void row_store_bf16(bf16_t* p, const Row& r, int lane) { v2u* q = (v2u*)p + lane;
#pragma unroll
    for (int j = 0; j < 4; ++j) { v2u w; w.x = cvtpk(r.v[j].x, r.v[j].y); w.y = cvtpk(r.v[j].z, r.v[j].w); q[64 * j] = w; } }
__device__ __forceinline__ void row_store_fp8(unsigned char* p, const Row& r, int lane) { unsigned* q = (unsigned*)p + lane;
#pragma unroll
    for (int j = 0; j < 4; ++j) q[64 * j] = pk8(r.v[j].x, r.v[j].y, r.v[j].z, r.v[j].w); }
__device__ __forceinline__ const float* in_row(KArgs A, int R) { const int b = R / RB, r = R % RB; return r < CTXL ? A->in[I_CTX] + ((size_t)b * CTXL + r) * DM : A->in[I_X] + ((size_t)b * SEQ + (r - CTXL)) * DM; }
__device__ __forceinline__ int mod_row(int R) { const int b = R / RB, r = R % RB; return r < CTXL ? 2 : b; }

__device__ __forceinline__ int lat_tile(int im) { return (im >> 5) * TPB + 1 + (im & 31); }
struct SchedP1 { const char* HN; const char* W; int layer, G, c;
    __device__ __forceinline__ bool next(int i, pg8::Unit& u) const {
        const int nmain = 64 * 10, nextra = layer == 0 ? 2 * 10 : 2 * 5; const int L = i * G + c; if (L >= nmain + nextra) return false;
        int pm, pq;
        if (L < nmain) { int im, in; pg8::rect_order(L, 64, 10, im, in); pm = lat_tile(im); pq = in; }
        else { const int x = L - nmain; if (layer == 0) { pm = (x / 10) * TPB; pq = x % 10; } else { pm = (x / 5) * TPB; pq = 5 + x % 5; } }
        u.pm = pm; u.pn = pq < 5 ? pq : pq + 16; u.a = HN + (size_t)pm * 256 * DM * 2; u.b = W + (size_t)pq * 256 * DM * 2; return true; } };
struct SchedP1g { const char* HN8; const char* W8; int layer, G, c;
    __device__ __forceinline__ bool next(int i, pg8::Unit& u) const {
        const int nmain = 64 * 16, nextra = layer == 0 ? 2 * 16 : 0; const int L = i * G + (G - 1 - c); if (L >= nmain + nextra) return false;
        int pm, pn;
        if (L < nmain) { int im; pg8::rect_order(L, 64, 16, im, pn); pm = lat_tile(im); }
        else { const int x = L - nmain; pm = (x >> 4) * TPB; pn = x & 15; }
        u.pm = pm; u.pn = pn; u.a = HN8 + (size_t)pm * 256 * DM; u.b = W8 + (size_t)pn * 256 * DM; return true; } };
struct SchedP3a { const char* YS; const char* WB; int layer, G, c;
    __device__ __forceinline__ bool next(int i, pg8::Unit& u) const {
        int pm, dt, n;
        if (i < 4) { if (c >= 256) return false; int im; pg8::rect_order(c, 64, 4, im, dt); pm = lat_tile(im); n = i; }
        else { if (i > 4 || layer != 0 || c >= 32) return false; pm = (c >> 4) * TPB; dt = (c >> 2) & 3; n = c & 3; }
        u.pm = pm; u.pn = dt * 4 + n; u.a = YS + ((size_t)pm * 256 * DM + 256 * n) * 2; u.b = WB + ((size_t)n * 1024 + dt * 256) * 256 * 2; return true; } };
struct SchedP3b { const char* MRG; const char* WO; int G, c;
    __device__ __forceinline__ bool next(int i, pg8::Unit& u) const {
        const int L = i * G + c; if (L >= 64 * 4) return false;
        int im, in; pg8::rect_order(L, 64, 4, im, in); const int pm = lat_tile(im);
        u.pm = pm; u.pn = in; u.a = MRG + (size_t)pm * 256 * DM * 2; u.b = WO + (size_t)in * 256 * DM * 2; return true; } };
struct SchedP3c { const char* GPC; const char* WO; int G, c;
    __device__ __forceinline__ bool next(int i, pg8::Unit& u) const {
        const int L = i * G + c; if (L >= 128) return false;
        const int pm = L >> 6, ks = (L >> 2) & 15, ct = L & 3, n = ks >> 2, kq = ks & 3;
        u.pm = pm; u.pn = ks * 4 + ct; u.a = GPC + (((size_t)n * 512 + pm * 256) * DM + kq * 256) * 2; u.b = WO + ((size_t)ct * 256 * DM + kq * 256) * 2; return true; } };
struct SchedP6 { const char* XG; const char* WGU; int RT, G, c;
    __device__ __forceinline__ bool next(int i, pg8::Unit& u) const {
        const int nM = 16 * RT; const int L = i * G + c; if (L >= nM * 16) return false;
        int im, in; pg8::rect_order(L, nM, 16, im, in); const int e = im / RT;
        u.pm = im; u.pn = in; u.a = XG + (size_t)im * 256 * DM; u.b = WGU + ((size_t)e * 4096 + in * 256) * DM; return true; } };
struct SchedP7 { const char* HID; const char* WD; int RT, G, c;
    __device__ __forceinline__ bool next(int i, pg8::Unit& u) const {
        const int nM = 16 * 8; const int L = i * G + c; if (L >= nM * 4) return false;
        int im8, in; pg8::rect_order(L, nM, 4, im8, in); const int e = im8 >> 3, im = e * RT + (im8 & 7);
        u.pm = im; u.pn = in; u.a = HID + (size_t)im * 256 * EH; u.b = WD + ((size_t)e * DM + in * 256) * EH; return true; } };
struct SchedP7c { const char* HID; const char* WD; int G, c;
    __device__ __forceinline__ bool next(int i, pg8::Unit& u) const {
        const int L = i * G + c; if (L >= 256) return false;
        const int e = L >> 4, in = (L >> 2) & 3, kq = L & 3, im = e * 9 + 8;
        u.pm = im; u.pn = in + 4 * kq; u.a = HID + (size_t)im * 256 * EH + kq * 512; u.b = WD + ((size_t)e * DM + in * 256) * EH + kq * 512; return true; } };

__device__ __forceinline__ unsigned block_excl_scan(unsigned v, LAS unsigned* wtot, int lane, int wid) {
    unsigned inc = v;
#pragma unroll
    for (int o = 1; o < 64; o <<= 1) { const unsigned t = (unsigned)__builtin_amdgcn_ds_bpermute(((lane - o) & 63) << 2, (int)inc); if (lane >= o) inc += t; }
    if (lane == 63) wtot[wid] = inc;
    __syncthreads();
    unsigned base = 0;
#pragma unroll
    for (int w = 0; w < 8; ++w) base += (w < wid) ? wtot[w] : 0u;
    __syncthreads();
    return base + inc - v;
}
__device__ __forceinline__ void topk_unit(KArgs A, int RT, bool isctx, int b, int e, LAS unsigned char* lds, int tid) {
    const int lane = tid & 63, wid = tid >> 6;
    LAS unsigned* hist = (LAS unsigned*)lds; LAS unsigned* wtot = hist + 256; LAS unsigned* sel = wtot + 16;
    const int cap = isctx ? 32 : 1024;
    const float* aff = isctx ? (const float*)(A->ws + WS_AFFC) + ((size_t)b * 16 + e) * 256 : (const float*)(A->ws + WS_AFFL) + ((size_t)b * 16 + e) * 8192;
    unsigned key[16];
    if (isctx) {
#pragma unroll
        for (int j = 0; j < 16; ++j) key[j] = 0u;
        if (tid < 256) key[0] = __float_as_uint(aff[tid]);
    } else {
#pragma unroll
        for (int q = 0; q < 4; ++q) { const f32x4 t = *(const f32x4*)(aff + tid * 16 + 4 * q); key[4 * q] = __float_as_uint(t.x); key[4 * q + 1] = __float_as_uint(t.y); key[4 * q + 2] = __float_as_uint(t.z); key[4 * q + 3] = __float_as_uint(t.w); }
    }
#define TK_VALID(j) (isctx ? ((j) == 0 && tid < 256) : true)
    unsigned pfx = 0u, need = (unsigned)cap;
    for (int pass = 0; pass < 4; ++pass) { const int shift = 24 - 8 * pass;
        for (int i = tid; i < 256; i += 512) hist[i] = 0u;
        __syncthreads();
#pragma unroll
        for (int j = 0; j < 16; ++j) if (TK_VALID(j) && (pass == 0 || (key[j] >> (shift + 8)) == pfx)) __hip_atomic_fetch_add(&hist[(key[j] >> shift) & 255u], 1u, __ATOMIC_RELAXED, __HIP_MEMORY_SCOPE_WORKGROUP);
        __syncthreads();
        if (wid == 0) {
            const unsigned h0 = hist[4 * lane], h1 = hist[4 * lane + 1], h2 = hist[4 * lane + 2], h3 = hist[4 * lane + 3], s = h0 + h1 + h2 + h3;
            unsigned incl = s;
#pragma unroll
            for (int o = 1; o < 64; o <<= 1) { const unsigned t = (unsigned)__builtin_amdgcn_ds_bpermute(((lane + o) & 63) << 2, (int)incl); if (lane + o < 64) incl += t; }
            const unsigned excl = incl - s;
            if (excl < need && need <= incl) { unsigned c = excl; int bin;
                if (c + h3 >= need) bin = 3; else { c += h3; if (c + h2 >= need) bin = 2; else { c += h2; if (c + h1 >= need) bin = 1; else { c += h1; bin = 0; } } }
                sel[0] = (unsigned)(4 * lane + bin); sel[1] = need - c; }
        }
        __syncthreads();
        pfx = (pfx << 8) | sel[0]; need = sel[1];
        __syncthreads();
    }
    const unsigned T = pfx;
    unsigned ce = 0u;
#pragma unroll
    for (int j = 0; j < 16; ++j) ce += (TK_VALID(j) && key[j] == T) ? 1u : 0u;
    unsigned re = block_excl_scan(ce, wtot, lane, wid);
    unsigned selmask = 0u, cs = 0u;
#pragma unroll
    for (int j = 0; j < 16; ++j) if (TK_VALID(j)) { bool s = key[j] > T; if (key[j] == T) { s = re < need; ++re; } if (s) { selmask |= 1u << j; ++cs; } }
    unsigned slot = block_excl_scan(cs, wtot, lane, wid);
    int* IDXROW = (int*)(A->ws + WS_IDXROW); float* SCORE = (float*)(A->ws + WS_SCORE); int* INV = (int*)(A->ws + WS_INV);
    const int ybase = e * RT * 256 + (isctx ? 2048 + b * 32 : b * 1024);
#pragma unroll
    for (int j = 0; j < 16; ++j) if (TK_VALID(j)) { const int idx = isctx ? tid : tid * 16 + j; const int R = b * RB + (isctx ? idx : CTXL + idx);
        if (selmask & (1u << j)) { const int yrow = ybase + (int)slot; IDXROW[yrow] = R; SCORE[yrow] = __uint_as_float(key[j]); INV[((size_t)b * 16 + e) * RB + (R - b * RB)] = yrow; ++slot; }
        else INV[((size_t)b * 16 + e) * RB + (R - b * RB)] = -1; }
    if (isctx && b == 0 && tid < 192) IDXROW[e * RT * 256 + 2048 + 64 + tid] = -1;
#undef TK_VALID
    __syncthreads();
}

struct AJob { const attn_body::bf16 *Q, *K, *V; attn_body::bf16* O; int nt, mode, normed; const float* kmax; };
__device__ __forceinline__ bool mixer_job(unsigned char* ws, int l, int vcu, int i, AJob& j) {
    using attn_body::bf16;
    const bf16* QKV = (const bf16*)(ws + WS_QKV); bf16* YS = (bf16*)(ws + WS_YS); j.normed = 0; j.kmax = nullptr; const float* KNB = (const float*)(ws + WS_KNB) + l * 32;
    if (i < 3) { const int b = vcu >> 7, h = (vcu >> 5) & 3, qb = vcu & 31; const long q0 = (long)b * RB + CTXL + qb * 256, k0 = (long)b * RB;
        if (i < 2) { const int vh = 2 * h + i; j.Q = QKV + q0 * PQ + C_QB + vh * 64; j.K = QKV + k0 * PQ + C_KB + vh * 64; j.V = QKV + k0 * PQ + C_VB + h * 64; j.O = YS + q0 * 1024 + 256 + h * 64; j.nt = 132; j.mode = 1 + i; j.kmax = KNB + b * 8 + vh; }
        else { j.Q = QKV + q0 * PQ + C_QD + h * 64; j.K = QKV + k0 * PQ + C_KD + (h >> 1) * 64; j.V = QKV + k0 * PQ + C_VD + (h >> 1) * 64; j.O = YS + q0 * 1024 + 768 + h * 64; j.nt = 132; j.mode = 0; j.normed = 1; }
        return true; }
    if (l != 0) return false;
    const int uc = (vcu + 256 - 132) & 255; if (uc >= 24) return false;
    const int type = uc >> 3, b = (uc >> 2) & 1, h = uc & 3, k = i - 3; const long q0 = (long)b * RB;
    j.nt = 4;
    if (type == 0) { if (k > 0) return false; j.Q = QKV + q0 * PQ + C_QA + h * 64; j.K = QKV + q0 * PQ + C_KA + h * 64; j.V = QKV + q0 * PQ + C_VA + h * 64; j.O = YS + q0 * 1024 + h * 64; j.mode = 0; return true; }
    if (type == 1) { if (k > 1) return false; const int vh = 2 * h + k; j.Q = QKV + q0 * PQ + C_QB + vh * 64; j.K = QKV + q0 * PQ + C_KB + vh * 64; j.V = QKV + q0 * PQ + C_VB + h * 64; j.O = YS + q0 * 1024 + 256 + h * 64; j.mode = 1 + k; j.kmax = KNB + b * 8 + vh; return true; }
    if (k > 0) return false; j.Q = QKV + q0 * PQ + C_QD + h * 64; j.K = QKV + q0 * PQ + C_KD + (h >> 1) * 64; j.V = QKV + q0 * PQ + C_VD + (h >> 1) * 64; j.O = YS + q0 * 1024 + 768 + h * 64; j.mode = 0; j.normed = 1; return true;
}

__global__ void __launch_bounds__(512, 2) fwd_kernel(Args A_) {
    extern __shared__ __attribute__((aligned(16))) unsigned char lds[];
    LAS unsigned char* L = (LAS unsigned char*)lds;
    const int tid0 = threadIdx.x;
    const int G0 = gridDim.x, bx0 = blockIdx.x;
    unsigned char* ws = A_.ws;
    for (int u = tid0; u < (LDS_BYTES - LDSCTL_OFF) / 4; u += 512) ((LAS unsigned*)(L + LDSCTL_OFF))[u] = 0u;
    __syncthreads();
    XcdBarrier bar; bar.bar = (unsigned*)(ws + WS_CTL) + CW_BAR + A_.li * XCD_BAR_WORDS; bar.x = 0; bar.st = nullptr;
    if (!MK_PER_PHASE) bar = xcd_barrier_post((unsigned*)(ws + WS_CTL) + CW_BAR + A_.li * XCD_BAR_WORDS, (volatile LAS unsigned*)(L + MISC_OFF) + 8);
#define PHASE_PTRS KArgs A = opaque_kargs(); unsigned char* ws = A->ws; const int G = opaque_s(G0), bx = opaque_s(bx0), vcu = (bx % 8) * (G / 8) + bx / 8, wave = __builtin_amdgcn_readfirstlane(opaque_tid() >> 6), gw = vcu * 8 + wave, NGW = G * 8; (void)gw; (void)NGW; (void)vcu; const float* MOD = (const float*)(ws + WS_MOD); bf16_t* HN = (bf16_t*)(ws + WS_HN); bf16_t* H2 = (bf16_t*)(ws + WS_H2); bf16_t* YS = (bf16_t*)(ws + WS_YS); \
    bf16_t* GT = (bf16_t*)(ws + WS_GT); bf16_t* X1 = (bf16_t*)(ws + WS_X1); bf16_t* XR = (bf16_t*)(ws + WS_XR); float* PART = (float*)(ws + WS_PART); \
    (void)MOD; (void)HN; (void)H2; (void)YS; (void)GT; (void)X1; (void)XR; (void)PART;
    const int lo = A_.ph_lo, hi = A_.ph_hi;
#ifndef DBG_MASK
#define DBG_MASK 0xffffffffu
#endif
#define PHON(k) ((DBG_MASK >> ((k) < 2 ? (k) : 2 + ((k) - 2) % 10)) & 1u)
#define IN(k) (PHON(k) && lo <= (k) && (k) < hi)
#define SEAM(k) do { if (!MK_PER_PHASE && (k) + 1 < hi) { XcdBarrier b2_ = bar; b2_.bar = (unsigned*)opaque_ptr((unsigned char*)bar.bar); xcd_barrier(b2_); } } while (0)

    if (IN(0)) { PHASE_PTRS
        const int tid = opaque_tid(), lane = tid & 63; (void)tid; (void)lane;
        for (int item = bx; item < 192; item += G) mod_item(A, item, L, tid);
        __syncthreads();
        SEAM(0);
    }
    if (IN(1)) { PHASE_PTRS
        const int tid = opaque_tid(), lane = tid & 63; (void)tid; (void)lane;
        { const int Ra = gw * 9, Rb = min(Ra + 9, NR);
          Row xn = row_load(in_row(A, min(Ra, NR - 1)), lane), xn2 = row_load(in_row(A, min(Ra + 1, NR - 1)), lane), xn3 = row_load(in_row(A, min(Ra + 2, NR - 1)), lane);
          int cur = mod_row(min(Ra, NR - 1)); NormP np; { const float* m = MOD + (size_t)cur * 6144; np = normp_load(A->in[I_N1G], m, m + 1024, lane); }
          for (int R = Ra; R < Rb; ++R) { const Row x = xn; xn = xn2; xn2 = xn3; if (R + 3 < Rb) xn3 = row_load(in_row(A, R + 3), lane);
            const int mr = mod_row(R); if (mr != cur) { const float* m = MOD + (size_t)mr * 6144; np = normp_load(A->in[I_N1G], m, m + 1024, lane); cur = mr; }
            const Row y = row_normmod_p(x, row_rstd(x), np); row_store_bf16(HN + (size_t)R * DM, y, lane); row_store_fp8(ws + WS_HN8 + (size_t)R * DM, y, lane); } }
        __syncthreads();
        conv_run<true>(A, vcu, G, DEPTH * CW_SMALL, L, tid);
        SEAM(1);
    }
    for (int l = 0; l < DEPTH; ++l) {
        const int P = 2 + 10 * l; const int RT = l == 0 ? 9 : 8;
#define LAYER_PTRS PHASE_PTRS unsigned char* wl = ws + WS_W0 + (size_t)l * W_LAYER; const float* MODL = MOD + (size_t)l * 3 * 6144; (void)wl; (void)MODL;
        if (IN(P + 0)) { LAYER_PTRS
            { SchedP1 S{(const char*)HN, (const char*)(wl + WO_WIN), l, G, bx};
              EpiInProj E{(bf16_t*)(ws + WS_QKV), GT, A->in[I_QG] + l * 64, A->in[I_KG] + l * 64, A->in[I_GATEB] + (size_t)l * 4096, (float*)(ws + WS_KNB) + l * 32};
              pg8::gemm_phase<EpiInProj, SchedP1>(L, DM, DM, DM, S, E); }
            { SchedP1g S{(const char*)(ws + WS_HN8), (const char*)(wl + WO_WING), l, G, bx}; EpiGates E{(unsigned char*)GT, A->in[I_GATEB] + (size_t)l * 4096};
              pg8::gemm8_phase<EpiGates, SchedP1g>(L, DM / 2, DM / 2, DM / 2, S, E); }
            SEAM(P + 0);
        }
        if (IN(P + 1)) { LAYER_PTRS
            const int tid = opaque_tid(), lane = tid & 63; (void)tid; (void)lane;
            float s1 = lane < 32 ? A->in[I_LQ1][l * 32 + lane] * A->in[I_LK1][l * 32 + lane] : 0.f, s2 = lane < 32 ? A->in[I_LQ2][l * 32 + lane] * A->in[I_LK2][l * 32 + lane] : 0.f;
            const float lam_init = l == 0 ? 0.2f : 0.35550906759096934f;
            const float lam = expf(wave_sum(s1)) - expf(wave_sum(s2)) + lam_init;
            const attn_body::DiffEpi de{lam, 1.0f - lam_init, A->in[I_SUBG] + l * 64};
            const float gqm = wave_max(fabsf(A->in[I_QG][l * 64 + lane])), gkm = wave_max(fabsf(A->in[I_KG][l * 64 + lane]));
            const bool gqa_nomax = __builtin_amdgcn_readfirstlane((int)(64.0f * gqm * gkm * C2A * 1.05f <= 40.0f)) != 0;
            const int cslot = vcu & 3, cbase = l * CW_LAYER + CW_SMALL + vcu * (CW_MOE / 256);
#define CONV_SEAM(k) do { if (cslot == (k)) conv_run(A, cbase, 1, cbase + CW_MOE / 256, L, opaque_tid()); } while (0)
            static_assert(CW_MOE % 256 == 0, "expert-weight items split evenly over 256 CUs");
            CONV_SEAM(0);
            AJob j;
            for (int i = 0; mixer_job(ws, l, vcu, i, j); ++i) {
                if (i == 2) CONV_SEAM(1);
                if (i == 3) CONV_SEAM(2);
                if (j.mode == 0) attn_body::attn_unit<8, 0>(j.Q, j.K, j.V, j.nt, j.O, (char*)lds, de, !(j.normed && gqa_nomax));
                else if (j.mode == 1) attn_body::attn_unit<8, 1>(j.Q, j.K, j.V, j.nt, j.O, (char*)lds, de, true, j.kmax);
                else attn_body::attn_unit<8, 2>(j.Q, j.K, j.V, j.nt, j.O, (char*)lds, de, true, j.kmax);
            }
            if (l != 0 || ((vcu + 256 - 132) & 255) >= 24) CONV_SEAM(2);
            { const int b = vcu >> 7, h = (vcu >> 5) & 3, g4 = vcu & 31;
              attn_body::na_unit(b, h, g4, (const attn_body::bf16*)(ws + WS_QKV), (attn_body::bf16*)YS, A->in[I_RPB] + ((size_t)l * 4 + h) * 465, (char*)lds, (const float*)(ws + WS_KNB) + l * 32 + 16 + b * 4 + h); }
            CONV_SEAM(3);
            const int nsgu = 128 + (l == 0 ? 4 : 0);
            if (vcu < nsgu) { const long rowbase = vcu < 128 ? (long)(vcu >> 6) * RB + CTXL + (vcu & 63) * 128 : (long)((vcu - 128) >> 1) * RB + ((vcu - 128) & 1) * 128;
                sgu_unit(rowbase, (const bf16_t*)(ws + WS_QKV) + C_GU, (const bf16_t*)(ws + WS_QKV) + C_GV, A->in[I_SGUNG] + l * 256, A->in[I_SGUW] + (size_t)l * 4 * 128 * 128, A->in[I_SGUB] + l * 4 * 128, YS, (char*)lds); }
            SEAM(P + 1);
        }
        if (IN(P + 2)) { LAYER_PTRS
            SchedP3a S{(const char*)YS, (const char*)(wl + WO_WB), l, G, bx}; EpiGateAcc E{(const unsigned char*)GT, (bf16_t*)(ws + WS_MRG), (bf16_t*)(ws + WS_GPC)};
            pg8::gemm_phase<EpiGateAcc, SchedP3a>(L, 256, DM, 256, S, E);
            SEAM(P + 2);
        }
        if (IN(P + 3)) { LAYER_PTRS
            { SchedP3b S{(const char*)(ws + WS_MRG), (const char*)(wl + WO_WO4), G, bx}; EpiOutRes E{A->in[I_X], A->in[I_CTX], XR, X1, MODL, l};
              pg8::gemm_phase<EpiOutRes, SchedP3b>(L, DM, DM, DM, S, E); }
            if (l == 0) { SchedP3c S{(const char*)(ws + WS_GPC), (const char*)(wl + WO_WO4), G, bx}; EpiPart E{PART};
              pg8::gemm_phase<EpiPart, SchedP3c>(L, 256, DM, DM, S, E); }
            SEAM(P + 3);
        }
        if (IN(P + 4)) { LAYER_PTRS
            const int tid = opaque_tid(), lane = tid & 63; (void)tid; (void)lane;
            LAS float* wrT = (LAS float*)L;
            const float* wr = A->in[I_WRT] + (size_t)l * DM * 16;
            { f32x4 wv[8];
#pragma unroll
              for (int q = 0; q < 8; ++q) wv[q] = ((const f32x4*)wr)[tid + 512 * q];
              __builtin_amdgcn_sched_barrier(0);
#pragma unroll
              for (int q = 0; q < 8; ++q) { const int i4 = tid + 512 * q, k = i4 >> 2, e0 = (i4 & 3) * 4;
#pragma unroll
                  for (int j = 0; j < 4; ++j) wrT[(e0 + j) * DM + k] = wv[q][j]; } }
            __syncthreads();
            const int nit = 8 + ((l == 0 && gw < 512) ? 1 : 0);
            Row xn; { const int i0 = gw * 8; xn = row_load_bf16(X1 + ((size_t)(i0 >> 13) * RB + CTXL + (i0 & 8191)) * DM, lane); }
            NormP np; { const float* m0 = MODL + (size_t)((gw * 8) >> 13) * 6144; np = normp_load(A->in[I_N2G] + l * DM, m0 + 3072, m0 + 4096, lane); }
            for (int it = 0; it < nit; ++it) { const int i = it < 8 ? gw * 8 + it : 16384 + gw; const bool isctx = i >= 16384; const int b = isctx ? (i - 16384) >> 8 : i >> 13, r = isctx ? (i - 16384) & 255 : CTXL + (i & 8191); const int R = b * RB + r;
                const float* m = MODL + (size_t)(isctx ? 2 : b) * 6144;
                Row x = xn;
                if (it + 1 < 8) { const int in = i + 1; xn = row_load_bf16(X1 + ((size_t)(in >> 13) * RB + CTXL + (in & 8191)) * DM, lane); }
                if (isctx) { x = row_load(in_row(A, R), lane); Row s;
#pragma unroll
                    for (int j = 0; j < 4; ++j) s.v[j] = (f32x4){0.f, 0.f, 0.f, 0.f};
                    for (int ks = 0; ks < 16; ks += 4) { Row p[4];
#pragma unroll
                        for (int q = 0; q < 4; ++q) p[q] = row_load(PART + ((size_t)(ks + q) * 512 + b * 256 + r) * DM, lane);
                        __builtin_amdgcn_sched_barrier(0);
#pragma unroll
                        for (int q = 0; q < 4; ++q)
#pragma unroll
                            for (int j = 0; j < 4; ++j) s.v[j] += p[q].v[j]; }
#pragma unroll
                    for (int j = 0; j < 4; ++j) x.v[j] += ((const f32x4*)(m + 2048))[lane + 64 * j] * s.v[j];
                    row_store_bf16(X1 + (size_t)R * DM, x, lane);
                }
                if (isctx) np = normp_load(A->in[I_N2G] + l * DM, m + 3072, m + 4096, lane);
                const Row h = row_normmod_p(x, row_rstd(x), np);
                { unsigned* hq = (unsigned*)((unsigned char*)H2 + (size_t)R * DM) + lane;
#pragma unroll
                  for (int j = 0; j < 4; ++j) hq[64 * j] = pk8(h.v[j].x, h.v[j].y, h.v[j].z, h.v[j].w); }
                float lg[16];
#pragma unroll
                for (int e = 0; e < 16; ++e) { f32x2 a2 = (f32x2){0.f, 0.f};
#pragma unroll
                    for (int j = 0; j < 4; ++j) { const f32x4 w = *(const LAS f32x4*)(wrT + e * DM + 4 * lane + 256 * j);
                        a2 = __builtin_elementwise_fma((f32x2){h.v[j].x, h.v[j].y}, (f32x2){w.x, w.y}, a2); a2 = __builtin_elementwise_fma((f32x2){h.v[j].z, h.v[j].w}, (f32x2){w.z, w.w}, a2); }
                    lg[e] = a2.x + a2.y; if ((e & 3) == 3) __builtin_amdgcn_sched_barrier(0); }
                float c8[8], d[4];
#pragma unroll
                for (int i = 0; i < 8; ++i) { auto rr = __builtin_amdgcn_permlane32_swap(__float_as_uint(lg[i]), __float_as_uint(lg[i + 8]), false, false); c8[i] = __uint_as_float(rr[0]) + __uint_as_float(rr[1]); }
#pragma unroll
                for (int i = 0; i < 4; ++i) { auto rr = __builtin_amdgcn_permlane16_swap(__float_as_uint(c8[i]), __float_as_uint(c8[i + 4]), false, false); d[i] = row16_sum(__uint_as_float(rr[0]) + __uint_as_float(rr[1])); }
                float mx = fmaxf(fmaxf(d[0], d[1]), fmaxf(d[2], d[3]));
                { auto rr = __builtin_amdgcn_permlane16_swap(__float_as_uint(mx), __float_as_uint(mx), false, false); mx = fmaxf(__uint_as_float(rr[0]), __uint_as_float(rr[1])); }
                { auto rr = __builtin_amdgcn_permlane32_swap(__float_as_uint(mx), __float_as_uint(mx), false, false); mx = fmaxf(__uint_as_float(rr[0]), __uint_as_float(rr[1])); }
#pragma unroll
                for (int i = 0; i < 4; ++i) d[i] = __expf(d[i] - mx);
                const float sum = xor32_sum(xor16_sum((d[0] + d[1]) + (d[2] + d[3])));
                const int li = lane & 15, ex = 4 * (lane >> 4) + li;
                float mine = li == 0 ? d[0] : li == 1 ? d[1] : li == 2 ? d[2] : d[3];
                mine = mine / sum;
                if (li < 4) { if (isctx) ((float*)(ws + WS_AFFC))[((size_t)b * 16 + ex) * 256 + r] = mine; else ((float*)(ws + WS_AFFL))[((size_t)b * 16 + ex) * 8192 + (r - CTXL)] = mine; }
            }
            SEAM(P + 4);
        }
        if (IN(P + 5)) { LAYER_PTRS
            const int tid = opaque_tid(), lane = tid & 63; (void)tid; (void)lane;
            const int nun = l == 0 ? 64 : 32;
            for (int u = vcu; u < nun; u += G) topk_unit(A, RT, u >= 32, (u >> 4) & 1, u & 15, L, tid);
            SEAM(P + 5);
        }
        if (IN(P + 6)) { LAYER_PTRS
            const int tid = opaque_tid(), lane = tid & 63; (void)tid; (void)lane;
            const int* IDXROW = (const int*)(ws + WS_IDXROW); unsigned char* XG = ws + WS_XG;
            const int nyr = 16 * RT * 256;
            for (int y0 = gw; y0 < nyr; y0 += 9 * NGW) { int src[9]; v4u a[9];
#pragma unroll
                for (int q = 0; q < 9; ++q) { const int y = y0 + q * NGW; src[q] = y < nyr ? IDXROW[y] : -1; }
                __builtin_amdgcn_sched_barrier(0);
#pragma unroll
                for (int q = 0; q < 9; ++q) { a[q] = (v4u){0u, 0u, 0u, 0u}; if (src[q] >= 0) a[q] = ((const v4u*)((const unsigned char*)H2 + (size_t)src[q] * DM))[lane]; }
                __builtin_amdgcn_sched_barrier(0);
#pragma unroll
                for (int q = 0; q < 9; ++q) { const int y = y0 + q * NGW; if (y < nyr) ((v4u*)(XG + (size_t)y * DM))[lane] = a[q]; } }
            SEAM(P + 6);
        }
        if (IN(P + 7)) { LAYER_PTRS
            SchedP6 S{(const char*)(ws + WS_XG), (const char*)(wl + WO_WGU), RT, G, bx}; EpiSwiGLU E{ws + WS_HID};
            pg8::gemm8_phase<EpiSwiGLU, SchedP6>(L, DM / 2, DM / 2, DM / 2, S, E);
            SEAM(P + 7);
        }
        if (IN(P + 8)) { LAYER_PTRS
            SchedP7 S{(const char*)(ws + WS_HID), (const char*)(wl + WO_WD), RT, G, bx}; EpiDown E{(bf16_t*)(ws + WS_Y), (const float*)(ws + WS_SCORE)};
            pg8::gemm8_phase<EpiDown, SchedP7>(L, EH / 2, EH / 2, EH / 2, S, E);
            if (l == 0) { SchedP7c S2{(const char*)(ws + WS_HID), (const char*)(wl + WO_WD), G, bx}; EpiDownPart E2{(bf16_t*)(ws + WS_XG), (const float*)(ws + WS_SCORE)};
              pg8::gemm8_phase<EpiDownPart, SchedP7c>(L, 256, EH / 2, EH / 2, S2, E2); }
            SEAM(P + 8);
        }
        if (IN(P + 9)) { LAYER_PTRS
            const int tid = opaque_tid(), lane = tid & 63; (void)tid; (void)lane;
            const int* INV = (const int*)(ws + WS_INV); const bf16_t* Y = (const bf16_t*)(ws + WS_Y);
#define P8_INV(R_) (lane < 16 ? INV[((size_t)((R_) / RB) * 16 + lane) * RB + (R_) % RB] : -1)
#define P8_YISSUE(INVV, W, KEEP, REST) do { unsigned mk_ = (unsigned)(__ballot((INVV) >= 0) & 0xffffull); \
                _Pragma("unroll") for (int k = 0; k < 4; ++k) { const bool have = mk_ != 0u; const int e = have ? __builtin_ctz(mk_) : 0; mk_ &= mk_ - 1u; \
                    const int yr = have ? __builtin_amdgcn_readlane((INVV), e) : 0; const v2u* yp = (const v2u*)(Y + (size_t)yr * DM) + lane; KEEP[k] = have ? 0xffffffffu : 0u;     \
                    _Pragma("unroll") for (int j = 0; j < 4; ++j) W[k][j] = yp[64 * j]; } REST = mk_; } while (0)
            Row xn; int invn, invf; v2u wn[4][4]; unsigned kn[4], restn;
#define P8_ROW(k) ((k) < 8 ? (((gw * 8 + (k)) >> 13) * RB + CTXL + ((gw * 8 + (k)) & 8191)) : ((gw >> 8) * RB + (gw & 255)))
            const int nit = 8 + ((l == 0 && gw < 512) ? 1 : 0);
            { const int R0 = P8_ROW(0); xn = row_load_bf16(X1 + (size_t)R0 * DM, lane); invn = P8_INV(R0); P8_YISSUE(invn, wn, kn, restn); const int R1 = P8_ROW(1); invf = P8_INV(R1); }
            int curm; NormP np; f32x4 g2v[4];
#define P8_PARAMS(mr_) do { const float* m_ = MODL + (size_t)(mr_) * 6144; \
                _Pragma("unroll") for (int j = 0; j < 4; ++j) g2v[j] = ((const f32x4*)(m_ + 5120))[lane + 64 * j]; \
                if (l + 1 < DEPTH) { const float* m1 = MOD + ((size_t)(l + 1) * 3 + (mr_)) * 6144; np = normp_load(A->in[I_N1G] + (l + 1) * DM, m1, m1 + 1024, lane); } \
                else { _Pragma("unroll") for (int j = 0; j < 4; ++j) { np.a[j] = ((const f32x4*)A->in[I_FG])[lane + 64 * j]; np.h[j] = np.a[j]; } } \
                __builtin_amdgcn_sched_barrier(0); } while (0)
            { curm = (gw * 8) >> 13; P8_PARAMS(curm); }
            for (int k9 = 0; k9 < nit; ++k9) { const int R = P8_ROW(k9); const int b = R / RB, r = R % RB; const bool isctx = r < CTXL;
                Row x = xn; const int myinv = invn; v2u w0[4][4]; unsigned k0[4]; unsigned msk = restn;
#pragma unroll
                for (int k = 0; k < 4; ++k) { k0[k] = kn[k];
#pragma unroll
                    for (int j = 0; j < 4; ++j) w0[k][j] = wn[k][j]; }
                if (k9 + 1 < nit) { const int Rn = P8_ROW(k9 + 1); xn = row_load_bf16(X1 + (size_t)Rn * DM, lane); invn = invf; P8_YISSUE(invn, wn, kn, restn); const int Rf = P8_ROW(min(k9 + 2, nit - 1)); invf = P8_INV(Rf); }
                if (l == 1 && isctx) continue;
                const float* m = MODL + (size_t)(isctx ? 2 : b) * 6144;
                Row s;
#pragma unroll
                for (int j = 0; j < 4; ++j) s.v[j] = (f32x4){0.f, 0.f, 0.f, 0.f};
#pragma unroll
                for (int k = 0; k < 4; ++k)
#pragma unroll
                    for (int j = 0; j < 4; ++j) s.v[j] += (f32x4){bflo(w0[k][j].x & k0[k]), bfhi(w0[k][j].x & k0[k]), bflo(w0[k][j].y & k0[k]), bfhi(w0[k][j].y & k0[k])};
                if (isctx) {
#pragma unroll
                    for (int j = 0; j < 4; ++j) s.v[j] = (f32x4){0.f, 0.f, 0.f, 0.f};
                    msk = 0u; unsigned mk = (unsigned)(__ballot(myinv >= 0) & 0xffffull); const bf16_t* YP = (const bf16_t*)(ws + WS_XG);
                    while (mk) { const int e = __builtin_ctz(mk); mk &= mk - 1u; const int yr = __builtin_amdgcn_readlane(myinv, e); const int ex = yr / 2304, rr = yr % 2304 - 2048;
                        v2u t[4][4];
#pragma unroll
                        for (int kq = 0; kq < 4; ++kq) { const v2u* yp = (const v2u*)(YP + ((size_t)(kq * 16 + ex) * 256 + rr) * DM) + lane;
#pragma unroll
                            for (int j = 0; j < 4; ++j) t[kq][j] = yp[64 * j]; }
                        __builtin_amdgcn_sched_barrier(0);
#pragma unroll
                        for (int kq = 0; kq < 4; ++kq)
#pragma unroll
                            for (int j = 0; j < 4; ++j) s.v[j] += (f32x4){bflo(t[kq][j].x), bfhi(t[kq][j].x), bflo(t[kq][j].y), bfhi(t[kq][j].y)}; } }
                while (msk) {
                    v2u w[4][4];
#pragma unroll
                    for (int k = 0; k < 4; ++k) { const bool have = msk != 0u; const int e = have ? __builtin_ctz(msk) : 0; msk &= msk - 1u; if (!have) msk = 0u;
                        const int yr = have ? __builtin_amdgcn_readlane(myinv, e) : 0;
                        const v2u* yp = (const v2u*)(Y + (size_t)yr * DM) + lane; const unsigned keep = have ? 0xffffffffu : 0u;
#pragma unroll
                        for (int j = 0; j < 4; ++j) { v2u t = yp[64 * j]; t.x &= keep; t.y &= keep; w[k][j] = t; } }
#pragma unroll
                    for (int k = 0; k < 4; ++k)
#pragma unroll
                        for (int j = 0; j < 4; ++j) s.v[j] += (f32x4){bflo(w[k][j].x), bfhi(w[k][j].x), bflo(w[k][j].y), bfhi(w[k][j].y)};
                }
                { const int mr = isctx ? 2 : b; if (mr != curm) { curm = mr; P8_PARAMS(mr); } }
#pragma unroll
                for (int j = 0; j < 4; ++j) x.v[j] += g2v[j] * s.v[j];
                const float rstd = row_rstd(x);
                if (l + 1 < DEPTH) { row_store_bf16(XR + (size_t)R * DM, x, lane);
                    const Row y = row_normmod_p(x, rstd, np); row_store_bf16(HN + (size_t)R * DM, y, lane); if (!isctx) row_store_fp8(ws + WS_HN8 + (size_t)R * DM, y, lane); }
                else { Row y;
#pragma unroll
                    for (int j = 0; j < 4; ++j) y.v[j] = x.v[j] * rstd * np.a[j];
                    row_store(A->out + ((size_t)b * SEQ + (r - CTXL)) * DM, y, lane); }
            }
            SEAM(P + 9);
        }
    }
#undef IN
#undef SEAM
}

extern "C" void kernel_launch(void* const* d_in, const int* in_sizes, int n_in, void* d_out, int out_size, void* d_ws, size_t ws_size, hipStream_t stream) {
    static int grid = 0;
    if (grid == 0) {
        if (n_in != 28 || out_size != NB * SEQ * DM || ws_size < WS_END) { fprintf(stderr, "kernel_launch: unexpected shapes (n_in %d, out %d, ws %zu < %zu)\n", n_in, out_size, ws_size, (size_t)WS_END); grid = -1; return; }
        int dev = 0, cus = 0, per_cu = 0;
        if (hipGetDevice(&dev) != hipSuccess || hipDeviceGetAttribute(&cus, hipDeviceAttributeMultiprocessorCount, dev) != hipSuccess) { grid = -1; return; }
        if (hipFuncSetAttribute((const void*)fwd_kernel, hipFuncAttributeMaxDynamicSharedMemorySize, LDS_BYTES) != hipSuccess) { fprintf(stderr, "kernel_launch: hipFuncSetAttribute failed\n"); grid = -1; return; }
        if (hipOccupancyMaxActiveBlocksPerMultiprocessor(&per_cu, (const void*)fwd_kernel, 512, LDS_BYTES) != hipSuccess || per_cu < 1) fprintf(stderr, "kernel_launch: occupancy query reports %d blocks/CU\n", per_cu);
        (void)hipGetLastError();
        if (cus != 256) { fprintf(stderr, "kernel_launch: built for 256 CUs, device has %d\n", cus); grid = -1; return; }
        grid = 256;
    }
    if (grid < 0) return;
    (void)hipMemsetAsync((char*)d_ws + WS_CTL, 0, CTL_ZERO_BYTES, stream);
    Args a{};
    for (int i = 0; i < 28; ++i) a.in[i] = (const float*)d_in[i];
    a.out = (float*)d_out; a.ws = (unsigned char*)d_ws;
#if MK_PER_PHASE
    for (int p = 0; p < NPHASE; ++p) { a.ph_lo = p; a.ph_hi = p + 1; hipLaunchKernelGGL(fwd_kernel, dim3(grid), dim3(512), LDS_BYTES, stream, a); }
#elif defined(PROBE_REPEAT)
    { const int reps[] = {PROBE_REPEAT}; const int nr = sizeof(reps) / sizeof(int); int lo = 0;
      for (int i = 0; i <= nr; ++i) { a.ph_lo = lo; a.ph_hi = i < nr ? reps[i] + 1 : NPHASE; a.li = i; hipLaunchKernelGGL(fwd_kernel, dim3(grid), dim3(512), LDS_BYTES, stream, a); if (i < nr) lo = reps[i]; } }
#else
    a.ph_lo = 0; a.ph_hi = NPHASE; hipLaunchKernelGGL(fwd_kernel, dim3(grid), dim3(512), LDS_BYTES, stream, a);
#endif
}
```

```cpp
#include <hip/hip_runtime.h>
#include <hip/hip_bf16.h>
#include <cstdio>
#include <cstdint>
#include <cmath>

#ifndef MK_PER_PHASE
#define MK_PER_PHASE 0
#endif

constexpr int DM = 1024, NB = 2, SEQ = 8192, CTXL = 256, RB = SEQ + CTXL, NR = NB * RB, DEPTH = 2;
constexpr int IN_W = 6656, NEXP = 16, EH = 2048, TPB = RB / 256  ;
constexpr float EPS = 1e-6f, LOG2E = 1.4426950408889634f;
constexpr float C2A = 0.125f * LOG2E;
constexpr float C2B = 0.17677669529663687f * LOG2E;
constexpr int NPHASE = 2 + 10 * DEPTH;

constexpr size_t MiB = 1u << 20, KiB128 = 131072;
constexpr size_t WS_CTL = 0, CTL_ZERO_BYTES = 1 * MiB;
constexpr size_t WS_MOD = 1 * MiB;
constexpr size_t WS_AFFL = 2 * MiB, WS_AFFC = 3 * MiB;
constexpr size_t WS_IDXROW = 4 * MiB, WS_SCORE = 4 * MiB + 512 * 1024, WS_INV = 5 * MiB;
constexpr size_t WS_GPC = 8 * MiB;
constexpr size_t WS_W0 = 24 * MiB, W_LAYER = 215 * MiB;
constexpr size_t WO_WING = 8 * MiB  , WO_WIN = 0  , WO_WB = 13 * MiB, WO_WO4 = 15 * MiB, WO_WGU = 23 * MiB, WO_WD = 151 * MiB;
constexpr size_t WS_HN = 454 * MiB;
constexpr size_t WS_QKV = 487 * MiB;
constexpr int PQ = 3136;
constexpr int C_QA = 0, C_KA = 256, C_VA = 512, C_QB = 768, C_KB = 1280, C_VB = 1792, C_QD = 2048, C_KD = 2304, C_VD = 2432, C_GU = 2560, C_GV = 2816;
constexpr size_t WS_Y = WS_QKV;
constexpr size_t WS_KNB = 512 * 1024;
constexpr size_t WS_GT = 589 * MiB;
constexpr size_t WS_YS = 721 * MiB;
constexpr size_t WS_HID = WS_GT;
constexpr size_t WS_X1 = 754 * MiB, WS_XR = 820 * MiB, WS_H2 = 886 * MiB, WS_XG = 919 * MiB, WS_MRG = WS_H2, WS_PART = WS_XG  , WS_HN8 = 991 * MiB  , WS_END = 1008 * MiB;
static_assert(WS_QKV + (size_t)NR * PQ * 2 <= WS_GT && WS_Y + (size_t)16 * 9 * 256 * 1024 * 2 <= WS_GT && WS_HID + (size_t)16 * 9 * 256 * 2048 * 2 <= WS_X1 && WS_YS + (size_t)NR * 1024 * 2 <= WS_X1, "ws map");

constexpr int CW_BAR = 4096;

constexpr int RING_BYTES = 131072, LDSCTL_OFF = RING_BYTES, MISC_OFF = LDSCTL_OFF + 320, LDS_BYTES = 147456;

#define GAS __attribute__((address_space(1)))
#define LAS __attribute__((address_space(3)))
typedef unsigned short bf16_t;
typedef unsigned v4u __attribute__((ext_vector_type(4)));
typedef unsigned v2u __attribute__((ext_vector_type(2)));
typedef float f32x4 __attribute__((ext_vector_type(4)));
typedef float f32x2 __attribute__((ext_vector_type(2)));
typedef float f32x16 __attribute__((ext_vector_type(16)));
typedef short bf16x8 __attribute__((ext_vector_type(8)));
typedef short s16x4 __attribute__((ext_vector_type(4)));
typedef __bf16 bf16x2_t __attribute__((ext_vector_type(2)));
#define RLX_AGENT __ATOMIC_RELAXED, __HIP_MEMORY_SCOPE_AGENT
#define LDS_WAIT() asm volatile("s_waitcnt lgkmcnt(0)" ::: "memory")
#define VM_WAIT() asm volatile("s_waitcnt vmcnt(0)" ::: "memory")

__device__ __forceinline__ int opaque_tid() { int t = threadIdx.x; asm volatile("" : "+v"(t)); return t; }
__device__ __forceinline__ int opaque_s(int v) { asm volatile("" : "+s"(v)); return v; }
__device__ __forceinline__ unsigned char* opaque_ptr(unsigned char* p) { asm volatile("" : "+s"(p)); return p; }
__device__ __forceinline__ unsigned cvtpk(float lo, float hi) { f32x2 v = {lo, hi}; bf16x2_t b = __builtin_convertvector(v, bf16x2_t); return __builtin_bit_cast(unsigned, b); }
__device__ __forceinline__ float bflo(unsigned w) { return __uint_as_float(w << 16); }
__device__ __forceinline__ float bfhi(unsigned w) { return __uint_as_float(w & 0xffff0000u); }
__device__ __forceinline__ float bf2f(bf16_t h) { return __uint_as_float((unsigned)h << 16); }
__device__ __forceinline__ bf16_t f2bf(float f) { return (bf16_t)(cvtpk(f, 0.f) & 0xffffu); }
__device__ __forceinline__ float sigmoidf_(float x) { return __builtin_amdgcn_rcpf(1.0f + __builtin_amdgcn_exp2f(-x * LOG2E)); }
__device__ __forceinline__ float siluf_(float x) { return x * sigmoidf_(x); }
__device__ __forceinline__ float gelu_tanh(float x) { const float z = 0.7978845608028654f * (x + 0.044715f * x * x * x); return x * __builtin_amdgcn_rcpf(1.0f + __builtin_amdgcn_exp2f(-2.0f * LOG2E * z)); }
template <int CTRL> __device__ __forceinline__ float dpp_f(float v) { return __builtin_bit_cast(float, __builtin_amdgcn_update_dpp(0, __builtin_bit_cast(int, v), CTRL, 0xf, 0xf, true)); }
__device__ __forceinline__ float row16_sum(float v) { v += dpp_f<0xB1>(v); v += dpp_f<0x4E>(v); v += dpp_f<0x141>(v); v += dpp_f<0x140>(v); return v; }
__device__ __forceinline__ float xor16_sum(float v) { auto rr = __builtin_amdgcn_permlane16_swap(__float_as_uint(v), __float_as_uint(v), false, false); return __uint_as_float(rr[0]) + __uint_as_float(rr[1]); }
__device__ __forceinline__ float xor32_sum(float v) { auto rr = __builtin_amdgcn_permlane32_swap(__float_as_uint(v), __float_as_uint(v), false, false); return __uint_as_float(rr[0]) + __uint_as_float(rr[1]); }
__device__ __forceinline__ float half32_sum(float v) { return xor16_sum(row16_sum(v)); }
__device__ __forceinline__ float wave_sum(float v) { return xor32_sum(xor16_sum(row16_sum(v))); }
__device__ __forceinline__ float wave_max(float v) { v = fmaxf(v, dpp_f<0xB1>(v)); v = fmaxf(v, dpp_f<0x4E>(v)); v = fmaxf(v, dpp_f<0x141>(v)); v = fmaxf(v, dpp_f<0x140>(v));
    { auto rr = __builtin_amdgcn_permlane16_swap(__float_as_uint(v), __float_as_uint(v), false, false); v = fmaxf(__uint_as_float(rr[0]), __uint_as_float(rr[1])); }
    { auto rr = __builtin_amdgcn_permlane32_swap(__float_as_uint(v), __float_as_uint(v), false, false); v = fmaxf(__uint_as_float(rr[0]), __uint_as_float(rr[1])); } return v; }
__device__ __forceinline__ unsigned pk8(float a, float b, float c, float d) { unsigned w = 0u; w = __builtin_amdgcn_cvt_pk_fp8_f32(a, b, w, false); w = __builtin_amdgcn_cvt_pk_fp8_f32(c, d, w, true); return w; }
__device__ __forceinline__ void st8(bf16_t* p, const float* v) { v4u w; w.x = cvtpk(v[0], v[1]); w.y = cvtpk(v[2], v[3]); w.z = cvtpk(v[4], v[5]); w.w = cvtpk(v[6], v[7]); *(v4u*)p = w; }

__device__ const float INV16R[16] = {0.15915494309189535f, 0.08949940160889101f, 0.050329212104487035f, 0.0283021958306234f, 0.015915494309189534f, 0.008949940160889102f, 0.005032921210448704f, 0.00283021958306234f,
                                     0.0015915494309189536f, 0.0008949940160889102f, 0.0005032921210448703f, 0.00028302195830623395f, 0.00015915494309189535f, 8.949940160889102e-05f, 5.0329212104487035e-05f, 2.8302195830623396e-05f};
__device__ const float INV8R[8] = {0.15915494309189535f, 0.050329212104487035f, 0.015915494309189534f, 0.005032921210448704f, 0.0015915494309189536f, 0.0005032921210448703f, 0.00015915494309189535f, 5.0329212104487035e-05f};
__device__ __forceinline__ void sincos_rev(float rev, float& s, float& c) { const float f = __builtin_amdgcn_fractf(rev); s = __builtin_amdgcn_sinf(f); c = __builtin_amdgcn_cosf(f); }

namespace pg8 {
#define PG8_LAS __attribute__((address_space(3)))
constexpr int BM = 256, BK = 64, HALF = 128, HTB = HALF * BK * 2, STAGE_BYTES = 8 * HTB, NXCD = 8, WGM = 8;
__host__ __device__ __forceinline__ int lds_byte(int r, int c) { const int st = (r >> 4) * 2 + (c >> 5), rr = r & 15, cc = c & 31, ob = rr * 64 + cc * 2; return st * 1024 + (ob ^ (((ob >> 9) & 1) << 5)); }
__host__ __device__ __forceinline__ void stage_rc(int b, int& R, int& C) { const int st = b / 1024, sb = b % 1024, swz = sb ^ (((sb >> 9) & 1) << 5); R = (st >> 1) * 16 + swz / 64; C = (st & 1) * 32 + (swz % 64) / 2; }
__host__ __device__ __forceinline__ int perm32(int rho) { const int n = rho >> 4, i = rho & 15; return 8 * (i >> 2) + 4 * n + (i & 3); }

struct Unit { int pm, pn; const char* a; const char* b; };
__device__ __forceinline__ const char* uptr(const char* p) { const unsigned long long v = (unsigned long long)p; const unsigned lo = __builtin_amdgcn_readfirstlane((unsigned)v), hi = __builtin_amdgcn_readfirstlane((unsigned)(v >> 32)); return (const char*)(((unsigned long long)hi << 32) | lo); }
__device__ __forceinline__ void uunit(Unit& u) { u.pm = __builtin_amdgcn_readfirstlane(u.pm); u.pn = __builtin_amdgcn_readfirstlane(u.pn); u.a = uptr(u.a); u.b = uptr(u.b); }

typedef int v8i __attribute__((ext_vector_type(8)));
__device__ __forceinline__ void glds16s(const char* sbase, unsigned voff, unsigned lds_dst) { unsigned keep;
    asm volatile("s_mov_b32 %0, m0\n\ts_mov_b32 m0, %3\n\ts_nop 0\n\tglobal_load_lds_dwordx4 %1, %2\n\ts_mov_b32 m0, %0" : "=&s"(keep) : "v"(voff), "s"(sbase), "s"(lds_dst) : "memory"); }
__device__ __forceinline__ void rect_order(int L, int nM, int nN, int& im, int& in) {
    const int nwg = nM * nN; int wgid = L; { const int q = nwg / NXCD, r = nwg % NXCD, xcd = wgid % NXCD, off = wgid / NXCD; wgid = (xcd < r ? xcd * (q + 1) : r * (q + 1) + (xcd - r) * q) + off; }
    const int nig = WGM * nN, gid = wgid / nig, fm = gid * WGM, gsz = (nM - fm) < WGM ? (nM - fm) : WGM;
    im = fm + ((wgid % nig) % gsz); in = (wgid % nig) / gsz;
}

template <class Epi, class Sched>
__device__ __forceinline__ void gemm_phase(PG8_LAS unsigned char* lds, const int K, const int lda, const int ldb, const Sched& S, const Epi& E) {
    const int tid = opaque_tid(), wid = __builtin_amdgcn_readfirstlane(tid >> 6), lane = tid & 63, wr = wid >> 2, wc = wid & 3, fr = lane & 15, fq = lane >> 4;
    const int nt = K / BK;
    unsigned voffA[2], voffB[2];
#pragma unroll
    for (int i = 0; i < 2; ++i) { int R, C; stage_rc(tid * 16 + i * 8192, R, C); const int Rb = Epi::PERM ? ((R & ~31) + perm32(R & 31)) : R;
        voffA[i] = (unsigned)(R * lda + C) * 2u; voffB[i] = (unsigned)(Rb * ldb + C) * 2u; }
    const size_t kstep = (size_t)(BK * 2);
    const size_t hA = (size_t)HALF * lda * 2, hB = (size_t)HALF * ldb * 2;
    const unsigned ldsw = (unsigned)wid * 1024u, ldsbase = (unsigned)(size_t)lds;
    const int aoff = lds_byte(wr * 64 + fr, fq * 8), boff = lds_byte(wc * 32 + fr, fq * 8);
#define PG8_SA(b, h) (((b) * 2 + (h)) * HTB)
#define PG8_SB(b, h) ((4 + (b) * 2 + (h)) * HTB)
#define PG8_STAGE(bufoff, gbase, voff) do { _Pragma("unroll") for (int _i = 0; _i < 2; ++_i) \
        glds16s(uptr((const char*)(gbase)), (voff)[_i], (unsigned)__builtin_amdgcn_readfirstlane(ldsbase + (unsigned)(bufoff) + ldsw + _i * 8192u)); } while (0)
#define PG8_LDA(dst, b, h) do { _Pragma("unroll") for (int m = 0; m < 4; ++m) _Pragma("unroll") for (int k = 0; k < 2; ++k) dst[m][k] = *(const PG8_LAS bf16x8*)(lds + PG8_SA(b, h) + aoff + m * 2048 + k * 1024); } while (0)
#define PG8_LDB(dst, b, h) do { _Pragma("unroll") for (int n = 0; n < 2; ++n) _Pragma("unroll") for (int k = 0; k < 2; ++k) dst[n][k] = *(const PG8_LAS bf16x8*)(lds + PG8_SB(b, h) + boff + n * 2048 + k * 1024); } while (0)
#define PG8_MMA(ai, bj, At, Bt) do { __builtin_amdgcn_s_setprio(1); _Pragma("unroll") for (int m = 0; m < 4; ++m) _Pragma("unroll") for (int n = 0; n < 2; ++n) _Pragma("unroll") for (int k = 0; k < 2; ++k) \
        acc[ai][bj][m][n] = __builtin_amdgcn_mfma_f32_16x16x32_bf16(Bt[n][k], At[m][k], acc[ai][bj][m][n], 0, 0, 0); __builtin_amdgcn_s_setprio(0); } while (0)
#define PG8_WAIT_V(n) asm volatile("s_waitcnt vmcnt(" #n ")" ::: "memory")
#define PG8_WAIT_L(n) asm volatile("s_waitcnt lgkmcnt(" #n ")" ::: "memory")
#define PG8_BAR __builtin_amdgcn_s_barrier()
#define PG8_SCHED __builtin_amdgcn_sched_barrier(0)
    Unit cur, nxt; int ui = 0;
    if (!S.next(0, cur)) return;
    uunit(cur);
    f32x4 acc[2][2][4][2];
#pragma unroll
    for (int a = 0; a < 2; ++a)
#pragma unroll
        for (int b = 0; b < 2; ++b)
#pragma unroll
            for (int m = 0; m < 4; ++m)
#pragma unroll
                for (int n = 0; n < 2; ++n) acc[a][b][m][n] = (f32x4){0.f, 0.f, 0.f, 0.f};
    bf16x8 At[4][2], B0[2][2], B1[2][2];
    const char* cA = cur.a; const char* cB = cur.b;
    PG8_STAGE(PG8_SB(0, 0), cB, voffB); PG8_STAGE(PG8_SB(0, 1), cB + hB, voffB); PG8_STAGE(PG8_SA(0, 0), cA, voffA); PG8_STAGE(PG8_SA(0, 1), cA + hA, voffA);
    if (wr == 1) PG8_BAR;
    PG8_WAIT_V(2); PG8_BAR;
    PG8_STAGE(PG8_SB(1, 0), cB + kstep, voffB); PG8_STAGE(PG8_SA(1, 0), cA + kstep, voffA); PG8_STAGE(PG8_SB(1, 1), cB + hB + kstep, voffB);
    PG8_WAIT_V(6); PG8_BAR;
    for (;;) {
        const bool has_next = S.next(ui + 1, nxt); if (has_next) uunit(nxt);
        const char* nA = has_next ? nxt.a : cA; const char* nB = has_next ? nxt.b : cB;
        for (int t = 0; t < nt; t += 2) {
            const bool last = (t == nt - 2);
            const char* a1 = cA + (size_t)(t + 1) * kstep;
            const char* a2 = last ? nA : cA + (size_t)(t + 2) * kstep; const char* b2 = last ? nB : cB + (size_t)(t + 2) * kstep;
            const char* a3 = a2 + kstep; const char* b3 = b2 + kstep;
            PG8_LDB(B0, 0, 0); PG8_LDB(B1, 0, 1); PG8_SCHED; PG8_LDA(At, 0, 0); PG8_STAGE(PG8_SA(1, 1), a1 + hA, voffA);
            PG8_WAIT_V(8); PG8_WAIT_L(0); PG8_BAR; PG8_MMA(0, 0, At, B0); PG8_MMA(0, 1, At, B1); PG8_BAR; PG8_SCHED;
            PG8_LDA(At, 0, 1); PG8_STAGE(PG8_SB(0, 0), b2, voffB); PG8_STAGE(PG8_SB(0, 1), b2 + hB, voffB); PG8_STAGE(PG8_SA(0, 0), a2, voffA);
            PG8_WAIT_V(8); PG8_WAIT_L(0); PG8_BAR; PG8_MMA(1, 0, At, B0); PG8_MMA(1, 1, At, B1); PG8_BAR; PG8_SCHED;
            PG8_LDB(B0, 1, 0); PG8_LDB(B1, 1, 1); PG8_SCHED; PG8_LDA(At, 1, 0); PG8_STAGE(PG8_SA(0, 1), a2 + hA, voffA);
            PG8_WAIT_V(8); PG8_WAIT_L(0); PG8_BAR; PG8_MMA(0, 0, At, B0); PG8_MMA(0, 1, At, B1); PG8_BAR; PG8_SCHED;
            PG8_LDA(At, 1, 1); PG8_STAGE(PG8_SB(1, 0), b3, voffB); PG8_STAGE(PG8_SB(1, 1), b3 + hB, voffB); PG8_STAGE(PG8_SA(1, 0), a3, voffA);
            PG8_WAIT_V(8); PG8_WAIT_L(0); PG8_BAR; PG8_MMA(1, 0, At, B0); PG8_MMA(1, 1, At, B1); PG8_BAR; PG8_SCHED;
        }
        if (wr == 0) PG8_BAR;
        { const int t2 = opaque_tid(), l2 = t2 & 63; E(acc, cur, wr, wc, l2 & 15, l2 >> 4); }
        if (!has_next) break;
        if (!Epi::keep_acc(cur)) {
#pragma unroll
        for (int a = 0; a < 2; ++a)
#pragma unroll
            for (int b = 0; b < 2; ++b)
#pragma unroll
                for (int m = 0; m < 4; ++m)
#pragma unroll
                    for (int n = 0; n < 2; ++n) acc[a][b][m][n] = (f32x4){0.f, 0.f, 0.f, 0.f};
        }
        cur = nxt; cA = nA; cB = nB; ++ui;
        if (wr == 1) PG8_BAR;
    }
    PG8_WAIT_V(0);
    PG8_BAR;
#undef PG8_SA
#undef PG8_SB
#undef PG8_STAGE
#undef PG8_LDA
#undef PG8_LDB
#undef PG8_MMA
#undef PG8_WAIT_V
#undef PG8_WAIT_L
#undef PG8_BAR
#undef PG8_SCHED
}
template <class Epi, class Sched>
__device__ __forceinline__ void gemm8_phase(PG8_LAS unsigned char* lds, const int K, const int lda, const int ldb, const Sched& S, const Epi& E) {
    const int tid = opaque_tid(), wid = __builtin_amdgcn_readfirstlane(tid >> 6), lane = tid & 63, wr = wid >> 2, wc = wid & 3, fr = lane & 15, fq = lane >> 4;
    const int nt = opaque_s(K / BK);
    unsigned voffA[2], voffB[2];
#pragma unroll
    for (int i = 0; i < 2; ++i) { int R, C; stage_rc(tid * 16 + i * 8192, R, C); const int Rb = Epi::PERM ? ((R & ~31) + perm32(R & 31)) : R;
        voffA[i] = (unsigned)(R * lda + C) * 2u; voffB[i] = (unsigned)(Rb * ldb + C) * 2u; }
    const size_t kstep = (size_t)(BK * 2);
    const size_t hA = (size_t)HALF * lda * 2, hB = (size_t)HALF * ldb * 2;
    const unsigned ldsw = (unsigned)wid * 1024u, ldsbase = (unsigned)(size_t)lds;
    const int fcol = (fq >> 1) * 32 + (fq & 1) * 16;
    const int aoff = lds_byte(wr * 64 + fr, fcol), boff = lds_byte(wc * 32 + fr, fcol);
#define PG8_SA(b, h) (((b) * 2 + (h)) * HTB)
#define PG8_SB(b, h) ((4 + (b) * 2 + (h)) * HTB)
#define PG8_STAGE(bufoff, gbase, voff) do { _Pragma("unroll") for (int _i = 0; _i < 2; ++_i) \
        glds16s(uptr((const char*)(gbase)), (voff)[_i], (unsigned)__builtin_amdgcn_readfirstlane(ldsbase + (unsigned)(bufoff) + ldsw + _i * 8192u)); } while (0)
#define PG8_LDA(dst, b, h) do { _Pragma("unroll") for (int m = 0; m < 4; ++m) { const v4u lo_ = *(const PG8_LAS v4u*)(lds + PG8_SA(b, h) + aoff + m * 2048), hi_ = *(const PG8_LAS v4u*)(lds + PG8_SA(b, h) + aoff + m * 2048 + 16); dst[m] = (v8i){(int)lo_.x, (int)lo_.y, (int)lo_.z, (int)lo_.w, (int)hi_.x, (int)hi_.y, (int)hi_.z, (int)hi_.w}; } } while (0)
#define PG8_LDB(dst, b, h) do { _Pragma("unroll") for (int n = 0; n < 2; ++n) { const v4u lo_ = *(const PG8_LAS v4u*)(lds + PG8_SB(b, h) + boff + n * 2048), hi_ = *(const PG8_LAS v4u*)(lds + PG8_SB(b, h) + boff + n * 2048 + 16); dst[n] = (v8i){(int)lo_.x, (int)lo_.y, (int)lo_.z, (int)lo_.w, (int)hi_.x, (int)hi_.y, (int)hi_.z, (int)hi_.w}; } } while (0)
#define PG8_MMA(ai, bj, At, Bt) do { __builtin_amdgcn_s_setprio(1); _Pragma("unroll") for (int m = 0; m < 4; ++m) _Pragma("unroll") for (int n = 0; n < 2; ++n) \
        acc[ai][bj][m][n] = __builtin_amdgcn_mfma_scale_f32_16x16x128_f8f6f4(Bt[n], At[m], acc[ai][bj][m][n], 0, 0, 0, 0, 0, 0);     __builtin_amdgcn_s_setprio(0); } while (0)
#define PG8_MMAZ(ai, bj, At, Bt) do { __builtin_amdgcn_s_setprio(1); _Pragma("unroll") for (int m = 0; m < 4; ++m) _Pragma("unroll") for (int n = 0; n < 2; ++n) \
        acc[ai][bj][m][n] = __builtin_amdgcn_mfma_scale_f32_16x16x128_f8f6f4(Bt[n], At[m], (f32x4){0.f, 0.f, 0.f, 0.f}, 0, 0, 0, 0, 0, 0);     __builtin_amdgcn_s_setprio(0); } while (0)
#define PG8_WAIT_V(n) asm volatile("s_waitcnt vmcnt(" #n ")" ::: "memory")
#define PG8_WAIT_L(n) asm volatile("s_waitcnt lgkmcnt(" #n ")" ::: "memory")
#define PG8_BAR __builtin_amdgcn_s_barrier()
#define PG8_SCHED __builtin_amdgcn_sched_barrier(0)
    Unit cur, nxt; int ui = 0;
    if (!S.next(0, cur)) return;
    uunit(cur);
    f32x4 acc[2][2][4][2];
#pragma unroll
    for (int a = 0; a < 2; ++a)
#pragma unroll
        for (int b = 0; b < 2; ++b)
#pragma unroll
            for (int m = 0; m < 4; ++m)
#pragma unroll
                for (int n = 0; n < 2; ++n) acc[a][b][m][n] = (f32x4){0.f, 0.f, 0.f, 0.f};
    v8i At[4], B0[2], B1[2];
    const char* cA = cur.a; const char* cB = cur.b;
    PG8_STAGE(PG8_SB(0, 0), cB, voffB); PG8_STAGE(PG8_SB(0, 1), cB + hB, voffB); PG8_STAGE(PG8_SA(0, 0), cA, voffA); PG8_STAGE(PG8_SA(0, 1), cA + hA, voffA);
    if (wr == 1) PG8_BAR;
    PG8_WAIT_V(2); PG8_BAR;
    PG8_STAGE(PG8_SB(1, 0), cB + kstep, voffB); PG8_STAGE(PG8_SA(1, 0), cA + kstep, voffA); PG8_STAGE(PG8_SB(1, 1), cB + hB + kstep, voffB);
    PG8_WAIT_V(6); PG8_BAR;
    for (;;) {
        const bool has_next = S.next(ui + 1, nxt); if (has_next) uunit(nxt);
        const char* nA = has_next ? nxt.a : cA; const char* nB = has_next ? nxt.b : cB;
#pragma nounroll
        for (int t = 0; t < nt; t += 2) {
            const bool last = (t == nt - 2);
            const char* a1 = cA + (size_t)(t + 1) * kstep;
            const char* a2 = last ? nA : cA + (size_t)(t + 2) * kstep; const char* b2 = last ? nB : cB + (size_t)(t + 2) * kstep;
            const char* a3 = a2 + kstep; const char* b3 = b2 + kstep;
            PG8_LDB(B0, 0, 0); PG8_LDB(B1, 0, 1); PG8_SCHED; PG8_LDA(At, 0, 0); PG8_STAGE(PG8_SA(1, 1), a1 + hA, voffA);
            PG8_WAIT_V(8); PG8_WAIT_L(0); PG8_BAR; if (t == 0) { PG8_MMAZ(0, 0, At, B0); PG8_MMAZ(0, 1, At, B1); } else { PG8_MMA(0, 0, At, B0); PG8_MMA(0, 1, At, B1); } PG8_BAR; PG8_SCHED;
            PG8_LDA(At, 0, 1); PG8_STAGE(PG8_SB(0, 0), b2, voffB); PG8_STAGE(PG8_SB(0, 1), b2 + hB, voffB); PG8_STAGE(PG8_SA(0, 0), a2, voffA);
            PG8_WAIT_V(8); PG8_WAIT_L(0); PG8_BAR; if (t == 0) { PG8_MMAZ(1, 0, At, B0); PG8_MMAZ(1, 1, At, B1); } else { PG8_MMA(1, 0, At, B0); PG8_MMA(1, 1, At, B1); } PG8_BAR; PG8_SCHED;
            PG8_LDB(B0, 1, 0); PG8_LDB(B1, 1, 1); PG8_SCHED; PG8_LDA(At, 1, 0); PG8_STAGE(PG8_SA(0, 1), a2 + hA, voffA);
            PG8_WAIT_V(8); PG8_WAIT_L(0); PG8_BAR; PG8_MMA(0, 0, At, B0); PG8_MMA(0, 1, At, B1); PG8_BAR; PG8_SCHED;
            PG8_LDA(At, 1, 1); PG8_STAGE(PG8_SB(1, 0), b3, voffB); PG8_STAGE(PG8_SB(1, 1), b3 + hB, voffB); PG8_STAGE(PG8_SA(1, 0), a3, voffA);
            PG8_WAIT_V(8); PG8_WAIT_L(0); PG8_BAR; PG8_MMA(1, 0, At, B0); PG8_MMA(1, 1, At, B1); PG8_BAR; PG8_SCHED;
        }
        if (wr == 0) PG8_BAR;
        { const int t2 = opaque_tid(), l2 = t2 & 63; E(acc, cur, wr, wc, l2 & 15, l2 >> 4); }
        if (!has_next) break;
        cur = nxt; cA = nA; cB = nB; ++ui;
        if (wr == 1) PG8_BAR;
    }
    PG8_WAIT_V(0);
    PG8_BAR;
#undef PG8_SA
#undef PG8_SB
#undef PG8_STAGE
#undef PG8_LDA
#undef PG8_LDB
#undef PG8_MMA
#undef PG8_MMAZ
#undef PG8_WAIT_V
#undef PG8_WAIT_L
#undef PG8_BAR
#undef PG8_SCHED
}
}

constexpr float W8S = 32.0f, W8I = 1.0f / 32.0f;
struct ModPtrs { const float* mod; };

struct EpiInProj {
    static constexpr bool PERM = true;
    static __device__ __forceinline__ bool keep_acc(const pg8::Unit&) { return false; }
    bf16_t *QKV, *GT;
    const float *q_gain, *k_gain, *gate_b; float* KNB;
    __device__ __forceinline__ void operator()(const f32x4 (&acc)[2][2][4][2], const pg8::Unit& u, int wr, int wc, int fr, int fq) const {
        const int pn = u.pn, pm = u.pm, jt = pm % TPB; const bool isctx = (jt == 0); const int t0 = (jt - 1) * 256;
        const int cb = 64 * wc + 8 * fq;
        const int rit0 = 64 * wr + fr;
        bf16_t* qrow = QKV + ((size_t)pm * 256 + rit0) * PQ;
#define ROWLOOP _Pragma("unroll") for (int ai = 0; ai < 2; ++ai) _Pragma("unroll") for (int m = 0; m < 4; ++m)
#define ROWVARS const int rit = 128 * ai + 16 * m + rit0; bf16_t* orow = qrow + (size_t)(128 * ai + 16 * m) * PQ; \
        float v[2][8]; _Pragma("unroll") for (int bj = 0; bj < 2; ++bj) _Pragma("unroll") for (int n = 0; n < 2; ++n) _Pragma("unroll") for (int j = 0; j < 4; ++j) v[bj][4 * n + j] = acc[ai][bj][m][n][j];
#define ROWEND __builtin_amdgcn_sched_barrier(0);
        if (pn == 0 || pn == 21 || pn == 22 || pn == 24) {
            const int oc = (pn == 0 ? C_QA : pn == 21 ? C_KA : pn == 22 ? C_VA : C_VB) + cb; const float sc = pn == 0 ? C2A : 1.0f;
            float kn2a = 0.f;
            ROWLOOP { ROWVARS
                if (pn == 21) { float ss = 0.f;
#pragma unroll
                    for (int bj = 0; bj < 2; ++bj)
#pragma unroll
                        for (int j = 0; j < 8; ++j) ss += v[bj][j] * v[bj][j];
                    kn2a = fmaxf(kn2a, xor32_sum(xor16_sum(ss))); }
#pragma unroll
                for (int bj = 0; bj < 2; ++bj) {
#pragma unroll
                    for (int j = 0; j < 8; ++j) v[bj][j] *= sc;
                    st8(orow + oc + 32 * bj, v[bj]); }
                ROWEND }
            if (pn == 21) { float mxv = kn2a; mxv = fmaxf(mxv, dpp_f<0xB1>(mxv)); mxv = fmaxf(mxv, dpp_f<0x4E>(mxv)); mxv = fmaxf(mxv, dpp_f<0x141>(mxv)); mxv = fmaxf(mxv, dpp_f<0x140>(mxv));
                if ((fr | fq) == 0) atomicMax((unsigned*)(KNB + 16 + (pm / TPB) * 4 + wc), __float_as_uint(sqrtf(mxv))); }
        } else if (pn == 3 || pn == 4) {
            const int oc = (pn == 3 ? C_GU : C_GV) + cb;
            ROWLOOP { ROWVARS
#pragma unroll
                for (int bj = 0; bj < 2; ++bj) {
#pragma unroll
                    for (int j = 0; j < 8; ++j) v[bj][j] = gelu_tanh(v[bj][j]);
                    st8(orow + oc + 32 * bj, v[bj]); }
                ROWEND }
        } else if (pn == 1 || pn == 23) {
            const int oc = (pn == 1 ? C_QB : C_KB) + 128 * wc + 8 * fq; const float sc = pn == 1 ? C2B : 1.0f;
            const f32x4 inv = *(const f32x4*)(INV8R + 4 * (fq & 1));
            float kn2[2] = {0.f, 0.f};
            ROWLOOP { ROWVARS
                if (pn == 23) {
#pragma unroll
                    for (int bj = 0; bj < 2; ++bj) { float ss = 0.f;
#pragma unroll
                        for (int j = 0; j < 8; ++j) ss += v[bj][j] * v[bj][j];
                        kn2[bj] = fmaxf(kn2[bj], xor32_sum(xor16_sum(ss))); } }
                const int t = t0 + rit; const float pos = (float)((fq < 2) ? (t >> 6) : (t & 63));
                float sn[4], cs[4];
#pragma unroll
                for (int p = 0; p < 4; ++p) { if (isctx) { sn[p] = 0.f; cs[p] = 1.f; } else sincos_rev(pos * inv[p], sn[p], cs[p]); }
#pragma unroll
                for (int bj = 0; bj < 2; ++bj) {
                    float o[8];
#pragma unroll
                    for (int p = 0; p < 4; ++p) { const float x0 = v[bj][2 * p], x1 = v[bj][2 * p + 1]; o[2 * p] = (x0 * cs[p] - x1 * sn[p]) * sc; o[2 * p + 1] = (x0 * sn[p] + x1 * cs[p]) * sc; }
                    st8(orow + oc + 64 * bj, o); }
                ROWEND }
            if (pn == 23) {
#pragma unroll
                for (int bj = 0; bj < 2; ++bj) { float mxv = kn2[bj]; mxv = fmaxf(mxv, dpp_f<0xB1>(mxv)); mxv = fmaxf(mxv, dpp_f<0x4E>(mxv)); mxv = fmaxf(mxv, dpp_f<0x141>(mxv)); mxv = fmaxf(mxv, dpp_f<0x140>(mxv));
                    if ((fr | fq) == 0) atomicMax((unsigned*)(KNB + (pm / TPB) * 8 + 2 * wc + bj), __float_as_uint(sqrtf(mxv))); } }
        } else {
            if (pn == 25 && wc >= 2) {
                const int oc = C_VD + (wc - 2) * 64 + 8 * fq;
                ROWLOOP { ROWVARS
#pragma unroll
                    for (int bj = 0; bj < 2; ++bj) st8(orow + oc + 32 * bj, v[bj]);
                    (void)rit; ROWEND }
            } else {
                const int oc = (pn == 2 ? C_QD : C_KD) + cb; const float sc = pn == 2 ? C2A : 1.0f; const float* gain = pn == 2 ? q_gain : k_gain;
                const f32x4 inv = *(const f32x4*)(INV16R + 4 * fq);
                f32x4 gn[2][2];
#pragma unroll
                for (int bj = 0; bj < 2; ++bj)
#pragma unroll
                    for (int n = 0; n < 2; ++n) gn[bj][n] = *(const f32x4*)(gain + 32 * bj + 8 * fq + 4 * n);
                ROWLOOP { ROWVARS
                    float ss = 0.f;
#pragma unroll
                    for (int bj = 0; bj < 2; ++bj)
#pragma unroll
                        for (int j = 0; j < 8; ++j) ss += v[bj][j] * v[bj][j];
                    ss = xor32_sum(xor16_sum(ss));
                    const float rstd = __builtin_amdgcn_rsqf(ss * (1.0f / 64.0f) + EPS);
                    const int t = t0 + rit;
#pragma unroll
                    for (int bj = 0; bj < 2; ++bj) {
                        const float pos = (float)(bj == 0 ? (t >> 6) : (t & 63));
                        float o[8];
#pragma unroll
                        for (int p = 0; p < 4; ++p) {
                            float sn, cs; if (isctx) { sn = 0.f; cs = 1.f; } else sincos_rev(pos * inv[p], sn, cs);
                            const float x0 = v[bj][2 * p] * rstd * gn[bj][(2 * p) >> 2][(2 * p) & 3], x1 = v[bj][2 * p + 1] * rstd * gn[bj][(2 * p + 1) >> 2][(2 * p + 1) & 3];
                            o[2 * p] = (x0 * cs - x1 * sn) * sc; o[2 * p + 1] = (x0 * sn + x1 * cs) * sc; }
                        st8(orow + oc + 32 * bj, o); }
                    ROWEND }
            }
        }
#undef ROWLOOP
#undef ROWVARS
#undef ROWEND
    }
};

__device__ __forceinline__ unsigned pk_u8x4(float a, float b, float c, float d) { unsigned w = 0u;
    w = __builtin_amdgcn_cvt_pk_u8_f32(__builtin_rintf(a * 255.0f), 0u, w); w = __builtin_amdgcn_cvt_pk_u8_f32(__builtin_rintf(b * 255.0f), 1u, w);
    w = __builtin_amdgcn_cvt_pk_u8_f32(__builtin_rintf(c * 255.0f), 2u, w); w = __builtin_amdgcn_cvt_pk_u8_f32(__builtin_rintf(d * 255.0f), 3u, w); return w; }
__device__ __forceinline__ float u8f(unsigned w, int i) { return (float)((w >> (8 * i)) & 0xffu); }
struct EpiGates {
    static constexpr bool PERM = true;
    unsigned char* GT; const float* gate_b;
    __device__ __forceinline__ void operator()(const f32x4 (&acc)[2][2][4][2], const pg8::Unit& u, int wr, int wc, int fr, int fq) const {
        const int col0 = u.pn * 256 + wc * 32 + 8 * fq;
        f32x4 gb[2][2];
#pragma unroll
        for (int bj = 0; bj < 2; ++bj)
#pragma unroll
            for (int n = 0; n < 2; ++n) gb[bj][n] = *(const f32x4*)(gate_b + col0 + bj * 128 + 4 * n) * (-LOG2E);
#pragma unroll
        for (int ai = 0; ai < 2; ++ai)
#pragma unroll
            for (int m = 0; m < 4; ++m) { unsigned char* rowp = GT + ((size_t)u.pm * 256 + ai * 128 + wr * 64 + m * 16 + fr) * 4096 + u.pn * 256 + (wc * 4 + fq) * 16;
                v4u w4;
#pragma unroll
                for (int bj = 0; bj < 2; ++bj) { unsigned o[8];
#pragma unroll
                    for (int n = 0; n < 2; ++n)
#pragma unroll
                        for (int j = 0; j < 4; j += 2) { const f32x2 a2 = (f32x2){acc[ai][bj][m][n][j], acc[ai][bj][m][n][j + 1]}, c2 = (f32x2){gb[bj][n][j], gb[bj][n][j + 1]};
                            const f32x2 t2 = __builtin_elementwise_fma(a2, (f32x2){-W8I * LOG2E, -W8I * LOG2E}, c2);
                            const f32x2 e2 = (f32x2){__builtin_amdgcn_exp2f(t2.x), __builtin_amdgcn_exp2f(t2.y)};
                            const f32x2 d2 = __builtin_elementwise_fma(e2, (f32x2){1.0f / 255.0f, 1.0f / 255.0f}, (f32x2){1.0f / 255.0f, 1.0f / 255.0f});
                            const f32x2 v2 = (f32x2){__builtin_amdgcn_rcpf(d2.x), __builtin_amdgcn_rcpf(d2.y)} + (f32x2){8388608.0f, 8388608.0f};
                            o[4 * n + j] = __float_as_uint(v2.x); o[4 * n + j + 1] = __float_as_uint(v2.y); }
                    v2u w; w.x = __builtin_amdgcn_perm(o[1], o[0], 0x0c0c0400u) | __builtin_amdgcn_perm(o[3], o[2], 0x04000c0cu); w.y = __builtin_amdgcn_perm(o[5], o[4], 0x0c0c0400u) | __builtin_amdgcn_perm(o[7], o[6], 0x04000c0cu);
                    if (bj == 0) { w4.x = w.x; w4.y = w.y; } else { w4.z = w.x; w4.w = w.y; } }
                *(v4u*)rowp = w4; }
    }
};
struct EpiGateAcc {
    static constexpr bool PERM = true;
    const unsigned char* GT; bf16_t* MRG; bf16_t* GPC;
    static __device__ __forceinline__ bool keep_acc(const pg8::Unit& u) { return (u.pn & 3) != 3 && (u.pm % TPB) != 0; }
    __device__ __forceinline__ void operator()(f32x4 (&acc)[2][2][4][2], const pg8::Unit& u, int wr, int wc, int fr, int fq) const {
        const int dt = u.pn >> 2, n = u.pn & 3; const int col0 = dt * 256 + wc * 32 + 8 * fq;
        const bool isctx = (u.pm % TPB) == 0;
        const size_t row0 = (size_t)u.pm * 256 + wr * 64 + fr;
        const unsigned char* gp0 = GT + row0 * 4096 + n * 1024 + dt * 256 + (wc * 4 + fq) * 16;
        constexpr float GMIN = 8.673617379884035e-19f;
#define GA_OFF(grp) ((size_t)(((grp) >> 3) * 128 + (((grp) >> 1) & 3) * 16))
        if (!isctx && n < 3) {
            v4u ga4[8], gb4[8];
#pragma unroll
            for (int am = 0; am < 8; ++am) { ga4[am] = *(const v4u*)(gp0 + GA_OFF(2 * am) * 4096); gb4[am] = *(const v4u*)(gp0 + 1024 + GA_OFF(2 * am) * 4096); }
            __builtin_amdgcn_sched_barrier(0);
#pragma unroll
            for (int grp = 0; grp < 16; ++grp) { const int ai = grp >> 3, m = (grp >> 1) & 3, bj = grp & 1; const v2u g0 = bj ? (v2u){ga4[grp >> 1].z, ga4[grp >> 1].w} : (v2u){ga4[grp >> 1].x, ga4[grp >> 1].y}, g1 = bj ? (v2u){gb4[grp >> 1].z, gb4[grp >> 1].w} : (v2u){gb4[grp >> 1].x, gb4[grp >> 1].y};
                float r[8];
#define GA_R(i, A, B) r[i] = fmaxf(A, GMIN) * __builtin_amdgcn_rcpf(fmaxf(B, GMIN))
                GA_R(0, u8f(g0.x, 0), u8f(g1.x, 0)); GA_R(1, u8f(g0.x, 1), u8f(g1.x, 1)); GA_R(2, u8f(g0.x, 2), u8f(g1.x, 2)); GA_R(3, u8f(g0.x, 3), u8f(g1.x, 3));
                GA_R(4, u8f(g0.y, 0), u8f(g1.y, 0)); GA_R(5, u8f(g0.y, 1), u8f(g1.y, 1)); GA_R(6, u8f(g0.y, 2), u8f(g1.y, 2)); GA_R(7, u8f(g0.y, 3), u8f(g1.y, 3));
#undef GA_R
#pragma unroll
                for (int j = 0; j < 4; ++j) { acc[ai][bj][m][0][j] *= r[j]; acc[ai][bj][m][1][j] *= r[4 + j]; } }
            __builtin_amdgcn_sched_barrier(0);
        } else {
            bf16_t* mp0 = isctx ? GPC + ((size_t)n * 512 + (u.pm / TPB) * 256 + wr * 64 + fr) * 1024 + col0 : MRG + row0 * 1024 + col0;
            const float lo = isctx ? 0.f : GMIN; constexpr float I255 = 1.0f / 255.0f;
            v4u ga4[8];
#pragma unroll
            for (int am = 0; am < 8; ++am) ga4[am] = *(const v4u*)(gp0 + GA_OFF(2 * am) * 4096);
            __builtin_amdgcn_sched_barrier(0);
#pragma unroll
            for (int grp = 0; grp < 16; ++grp) { const int ai = grp >> 3, m = (grp >> 1) & 3, bj = grp & 1; const v2u g = bj ? (v2u){ga4[grp >> 1].z, ga4[grp >> 1].w} : (v2u){ga4[grp >> 1].x, ga4[grp >> 1].y}; const f32x4 a0 = acc[ai][bj][m][0], a1 = acc[ai][bj][m][1];
                v4u w; w.x = cvtpk(a0[0] * (fmaxf(u8f(g.x, 0), lo) * I255), a0[1] * (fmaxf(u8f(g.x, 1), lo) * I255)); w.y = cvtpk(a0[2] * (fmaxf(u8f(g.x, 2), lo) * I255), a0[3] * (fmaxf(u8f(g.x, 3), lo) * I255));
                w.z = cvtpk(a1[0] * (fmaxf(u8f(g.y, 0), lo) * I255), a1[1] * (fmaxf(u8f(g.y, 1), lo) * I255)); w.w = cvtpk(a1[2] * (fmaxf(u8f(g.y, 2), lo) * I255), a1[3] * (fmaxf(u8f(g.y, 3), lo) * I255));
                *(v4u*)(mp0 + GA_OFF(grp) * 1024 + bj * 128) = w; }
            __builtin_amdgcn_sched_barrier(0);
        }
#undef GA_OFF
    }
};

struct EpiOutRes {
    static constexpr bool PERM = true;
    static __device__ __forceinline__ bool keep_acc(const pg8::Unit&) { return false; }
    const float* x_in; const float* ctx_in; const bf16_t* XR; bf16_t* X1; const float* mod_l; int layer;
    __device__ __forceinline__ void operator()(const f32x4 (&acc)[2][2][4][2], const pg8::Unit& u, int wr, int wc, int fr, int fq) const {
        const int pm = u.pm, b = pm / TPB, jt = pm % TPB; const bool isctx = jt == 0;
        const float* g1 = mod_l + (isctx ? 2 : b) * 6144 + 2048;
        const int col0 = u.pn * 256 + wc * 32 + 8 * fq;
        f32x4 gv[2][2];
#pragma unroll
        for (int bj = 0; bj < 2; ++bj)
#pragma unroll
            for (int n = 0; n < 2; ++n) gv[bj][n] = *(const f32x4*)(g1 + col0 + bj * 128 + n * 4);
        bf16_t* ob = X1 + ((size_t)pm * 256 + wr * 64 + fr) * DM + col0;
        if (layer == 0) {
            const float* base = (isctx ? ctx_in + (size_t)b * CTXL * DM : x_in + ((size_t)b * SEQ + (size_t)(jt - 1) * 256) * DM) + (size_t)(wr * 64 + fr) * DM + col0;
#pragma unroll
            for (int ai = 0; ai < 2; ++ai) { f32x4 rs[4][2][2];
#pragma unroll
                for (int m = 0; m < 4; ++m)
#pragma unroll
                    for (int bj = 0; bj < 2; ++bj)
#pragma unroll
                        for (int n = 0; n < 2; ++n) rs[m][bj][n] = *(const f32x4*)(base + (size_t)(ai * 128 + m * 16) * DM + bj * 128 + n * 4);
                __builtin_amdgcn_sched_barrier(0);
#pragma unroll
                for (int m = 0; m < 4; ++m)
#pragma unroll
                    for (int bj = 0; bj < 2; ++bj) { const f32x4 o0 = rs[m][bj][0] + gv[bj][0] * acc[ai][bj][m][0], o1 = rs[m][bj][1] + gv[bj][1] * acc[ai][bj][m][1];
                        v4u w; w.x = cvtpk(o0[0], o0[1]); w.y = cvtpk(o0[2], o0[3]); w.z = cvtpk(o1[0], o1[1]); w.w = cvtpk(o1[2], o1[3]);
                        *(v4u*)(ob + (size_t)(ai * 128 + m * 16) * DM + bj * 128) = w; }
                __builtin_amdgcn_sched_barrier(0); }
        } else {
            const bf16_t* base = XR + ((size_t)pm * 256 + wr * 64 + fr) * DM + col0;
#pragma unroll
            for (int ai = 0; ai < 2; ++ai) { v4u rb[4][2];
#pragma unroll
                for (int m = 0; m < 4; ++m)
#pragma unroll
                    for (int bj = 0; bj < 2; ++bj) rb[m][bj] = *(const v4u*)(base + (size_t)(ai * 128 + m * 16) * DM + bj * 128);
                __builtin_amdgcn_sched_barrier(0);
#pragma unroll
                for (int m = 0; m < 4; ++m)
#pragma unroll
                    for (int bj = 0; bj < 2; ++bj) { const v4u r = rb[m][bj];
                        const f32x4 r0 = (f32x4){bflo(r.x), bfhi(r.x), bflo(r.y), bfhi(r.y)}, r1 = (f32x4){bflo(r.z), bfhi(r.z), bflo(r.w), bfhi(r.w)};
                        const f32x4 o0 = r0 + gv[bj][0] * acc[ai][bj][m][0], o1 = r1 + gv[bj][1] * acc[ai][bj][m][1];
                        v4u w; w.x = cvtpk(o0[0], o0[1]); w.y = cvtpk(o0[2], o0[3]); w.z = cvtpk(o1[0], o1[1]); w.w = cvtpk(o1[2], o1[3]);
                        *(v4u*)(ob + (size_t)(ai * 128 + m * 16) * DM + bj * 128) = w; }
                __builtin_amdgcn_sched_barrier(0); }
        }
    }
};
struct EpiPart {
    static constexpr bool PERM = false;
    static __device__ __forceinline__ bool keep_acc(const pg8::Unit&) { return false; }
    float* PART;
    __device__ __forceinline__ void operator()(const f32x4 (&acc)[2][2][4][2], const pg8::Unit& u, int wr, int wc, int fr, int fq) const {
        const int ks = u.pn >> 2, ct = u.pn & 3; const int col0 = ct * 256 + wc * 32 + 4 * fq;
#pragma unroll
        for (int ai = 0; ai < 2; ++ai)
#pragma unroll
            for (int m = 0; m < 4; ++m) { float* op = PART + ((size_t)ks * 512 + u.pm * 256 + ai * 128 + wr * 64 + m * 16 + fr) * DM + col0;
#pragma unroll
                for (int bj = 0; bj < 2; ++bj)
#pragma unroll
                    for (int n = 0; n < 2; ++n) *(f32x4*)(op + bj * 128 + n * 16) = acc[ai][bj][m][n]; }
    }
};
struct EpiSwiGLU {
    static constexpr bool PERM = true;
    unsigned char* HID;
    __device__ __forceinline__ void operator()(const f32x4 (&acc)[2][2][4][2], const pg8::Unit& u, int wr, int wc, int fr, int fq) const {
        const int f0 = u.pn * 128 + wc * 32 + 16 * (fq >> 1);
        v2u wm[4];
#pragma unroll
        for (int ai = 0; ai < 2; ++ai) {
#pragma unroll
            for (int m = 0; m < 4; ++m) { float o[8];
#pragma unroll
                for (int n = 0; n < 2; ++n)
#pragma unroll
                    for (int j = 0; j < 4; j += 2) { const f32x2 g2 = (f32x2){acc[ai][0][m][n][j], acc[ai][0][m][n][j + 1]}, u2 = (f32x2){acc[ai][1][m][n][j], acc[ai][1][m][n][j + 1]};
                        const f32x2 t2 = g2 * (f32x2){-W8I * LOG2E, -W8I * LOG2E};
                        const f32x2 e2 = (f32x2){__builtin_amdgcn_exp2f(t2.x), __builtin_amdgcn_exp2f(t2.y)};
                        const f32x2 d2 = __builtin_elementwise_fma(e2, (f32x2){1024.0f, 1024.0f}, (f32x2){1024.0f, 1024.0f});
                        const f32x2 r2 = (f32x2){__builtin_amdgcn_rcpf(d2.x), __builtin_amdgcn_rcpf(d2.y)};
                        const f32x2 o2 = (g2 * u2) * r2; o[4 * n + j] = o2.x; o[4 * n + j + 1] = o2.y; }
                wm[m].x = pk8(o[0], o[1], o[2], o[3]); wm[m].y = pk8(o[4], o[5], o[6], o[7]); }
#pragma unroll
            for (int mp = 0; mp < 2; ++mp) { auto r0 = __builtin_amdgcn_permlane16_swap(wm[2 * mp].x, wm[2 * mp + 1].x, false, false); auto r1 = __builtin_amdgcn_permlane16_swap(wm[2 * mp].y, wm[2 * mp + 1].y, false, false);
                const int m = 2 * mp + (fq & 1);
                *(v4u*)(HID + ((size_t)u.pm * 256 + ai * 128 + wr * 64 + m * 16 + fr) * EH + f0) = (v4u){r0[0], r1[0], r0[1], r1[1]}; } }
    }
};
struct EpiDown {
    static constexpr bool PERM = true;
    bf16_t* Y; const float* SCORE;
    __device__ __forceinline__ void operator()(const f32x4 (&acc)[2][2][4][2], const pg8::Unit& u, int wr, int wc, int fr, int fq) const {
        const int col0 = u.pn * 256 + wc * 32 + 8 * fq;
        float sc8[2][4];
#pragma unroll
        for (int ai = 0; ai < 2; ++ai)
#pragma unroll
            for (int m = 0; m < 4; ++m) sc8[ai][m] = SCORE[(size_t)u.pm * 256 + ai * 128 + wr * 64 + m * 16 + fr];
        __builtin_amdgcn_sched_barrier(0);
#pragma unroll
        for (int ai = 0; ai < 2; ++ai)
#pragma unroll
            for (int m = 0; m < 4; ++m) { const size_t row = (size_t)u.pm * 256 + ai * 128 + wr * 64 + m * 16 + fr; const float s = sc8[ai][m] * W8I;
#pragma unroll
                for (int bj = 0; bj < 2; ++bj) { float o[8];
#pragma unroll
                    for (int n = 0; n < 2; ++n)
#pragma unroll
                        for (int j = 0; j < 4; ++j) o[4 * n + j] = acc[ai][bj][m][n][j] * s;
                    st8(Y + row * DM + col0 + bj * 128, o); } }
    }
};
struct EpiDownPart {
    static constexpr bool PERM = true;
    bf16_t* YP; const float* SCORE;
    __device__ __forceinline__ void operator()(const f32x4 (&acc)[2][2][4][2], const pg8::Unit& u, int wr, int wc, int fr, int fq) const {
        if (wr != 0) return;
        const int in = u.pn & 3, kq = u.pn >> 2, e = u.pm / 9; const int col0 = in * 256 + wc * 32 + 8 * fq;
        float sc4[4];
#pragma unroll
        for (int m = 0; m < 4; ++m) sc4[m] = SCORE[(size_t)u.pm * 256 + m * 16 + fr];
        __builtin_amdgcn_sched_barrier(0);
#pragma unroll
        for (int m = 0; m < 4; ++m) { const size_t row = ((size_t)(kq * 16 + e) * 256 + m * 16 + fr); const float sc = sc4[m] * W8I;
#pragma unroll
            for (int bj = 0; bj < 2; ++bj) { float o[8];
#pragma unroll
                for (int n = 0; n < 2; ++n)
#pragma unroll
                    for (int j = 0; j < 4; ++j) o[4 * n + j] = acc[0][bj][m][n][j] * sc;
                st8(YP + row * DM + col0 + bj * 128, o); } }
    }
};

namespace attn_body {
using bf16 = __hip_bfloat16;
using u32x4 = __attribute__((ext_vector_type(4))) unsigned;
constexpr int NW = 8, QBLK = 32, QB = QBLK * NW, KVBLK = 64;
__device__ __forceinline__ int crow(int r, int hi) { return (r & 3) + 8 * (r >> 2) + 4 * hi; }
#define SBAR() __builtin_amdgcn_sched_barrier(0)
constexpr int NSLOT = 3, SLOTB = 8192;
constexpr int LDS_K = 0, LDS_V = NSLOT * SLOTB, LDS_WS = 2 * NSLOT * SLOTB, LDS_OST = LDS_WS + NW * 64 * 4, LDS_OST1 = LDS_OST + NW * 4096, LDS_RPB = LDS_OST1 + NW * 4096, LDS_ATT_BYTES = LDS_RPB + 2048;
static_assert(LDS_ATT_BYTES <= RING_BYTES, "attention LDS");
__device__ __forceinline__ void glds16(const void* gsrc, unsigned lds_dst) { unsigned keep;
  asm volatile("s_mov_b32 %0, m0\n\ts_mov_b32 m0, %2\n\ts_nop 0\n\tglobal_load_lds_dwordx4 %1, off\n\ts_mov_b32 m0, %0" : "=&s"(keep) : "v"(gsrc), "s"(lds_dst) : "memory"); }
__device__ __forceinline__ float max3f(float a, float b, float c) { float r; asm("v_max3_f32 %0, %1, %2, %3" : "=v"(r) : "v"(a), "v"(b), "v"(c)); return r; }
__device__ __forceinline__ float max2f(float a, float b) { float r; asm("v_max_f32_e32 %0, %1, %2" : "=v"(r) : "v"(a), "v"(b)); return r; }
__device__ __forceinline__ float fadd_s(float a, float b) { float r; asm("v_add_f32_e32 %0, %1, %2" : "=v"(r) : "v"(a), "v"(b)); return r; }
__device__ __forceinline__ float fsub_s(float a, float b) { float r; asm("v_sub_f32_e32 %0, %1, %2" : "=v"(r) : "v"(a), "v"(b)); return r; }
__device__ __forceinline__ unsigned cvtpk_s(float lo, float hi) { return cvtpk(lo, hi); }
#define WAIT_BAR(N) asm volatile("s_waitcnt vmcnt(" #N ") lgkmcnt(0)\n\ts_barrier" ::: "memory")

typedef __attribute__((address_space(3))) const char* lds_cptr;
typedef short v4i16_t __attribute__((ext_vector_type(4)));
template <bool HALFD> __device__ __forceinline__ void qkt(f32x16& p0, f32x16& p1, lds_cptr Kslot, const bf16x8* qr, const f32x16& negm, int r32, int hi) {
  lds_cptr kb = Kslot + hi * 1024 + r32 * 16;
  #pragma unroll
  for (int d0 = 0; d0 < (HALFD ? 2 : 4); ++d0) {
    const bf16x8 b0 = *(const __attribute__((address_space(3))) bf16x8*)(kb + d0 * 2048);
    const bf16x8 b1 = *(const __attribute__((address_space(3))) bf16x8*)(kb + d0 * 2048 + 512);
    if (d0 == 0) { p0 = __builtin_amdgcn_mfma_f32_32x32x16_bf16(b0, qr[0], negm, 0, 0, 0); p1 = __builtin_amdgcn_mfma_f32_32x32x16_bf16(b1, qr[0], negm, 0, 0, 0); }
    else { p0 = __builtin_amdgcn_mfma_f32_32x32x16_bf16(b0, qr[d0], p0, 0, 0, 0); p1 = __builtin_amdgcn_mfma_f32_32x32x16_bf16(b1, qr[d0], p1, 0, 0, 0); } }
}
__device__ __forceinline__ void kload8(bf16x8* kf, lds_cptr kp) {
  kf[0] = *(const __attribute__((address_space(3))) bf16x8*)(kp);        kf[1] = *(const __attribute__((address_space(3))) bf16x8*)(kp + 512);
  kf[2] = *(const __attribute__((address_space(3))) bf16x8*)(kp + 2048); kf[3] = *(const __attribute__((address_space(3))) bf16x8*)(kp + 2560);
  kf[4] = *(const __attribute__((address_space(3))) bf16x8*)(kp + 4096); kf[5] = *(const __attribute__((address_space(3))) bf16x8*)(kp + 4608);
  kf[6] = *(const __attribute__((address_space(3))) bf16x8*)(kp + 6144); kf[7] = *(const __attribute__((address_space(3))) bf16x8*)(kp + 6656);
}
__device__ __forceinline__ void kload2(bf16x8* kf, lds_cptr kp, int j) { kf[2 * j] = *(const __attribute__((address_space(3))) bf16x8*)(kp + j * 2048); kf[2 * j + 1] = *(const __attribute__((address_space(3))) bf16x8*)(kp + j * 2048 + 512); }
__device__ __forceinline__ s16x4 vtr(lds_cptr p) { return __builtin_bit_cast(s16x4, __builtin_amdgcn_ds_read_tr16_b64_v4i16((__attribute__((address_space(3))) v4i16_t*)p)); }
__device__ __forceinline__ float rowmax(const f32x16& p0, const f32x16& p1) {
  float a = max3f(p0[0], p0[1], p1[0]), b = max3f(p0[2], p0[3], p1[1]); a = max3f(a, p1[2], p1[3]);
  #pragma unroll
  for (int r = 4; r < 16; r += 4) { a = max3f(a, p0[r], p0[r + 1]); b = max3f(b, p0[r + 2], p0[r + 3]); a = max3f(a, p1[r], p1[r + 1]); b = max3f(b, p1[r + 2], p1[r + 3]); }
  const float m = max2f(a, b);
  auto rr = __builtin_amdgcn_permlane32_swap(__float_as_uint(m), __float_as_uint(m), false, false);
  return max2f(__uint_as_float(rr[0]), __uint_as_float(rr[1]));
}
__device__ __forceinline__ void pv(f32x16* o, int vb, bf16x8 pa0, bf16x8 pa1, bf16x8 pa2, bf16x8 pa3) {
  #pragma unroll
  for (int d0 = 0; d0 < 2; ++d0) { s16x4 lo[4], hi[4];
    #pragma unroll
    for (int ks = 0; ks < 4; ++ks) {
      asm volatile("ds_read_b64_tr_b16 %0,%1 offset:%c2" : "=&v"(lo[ks]) : "v"(vb), "i"(d0 * 4096 + ks * 1024) : "memory");
      asm volatile("ds_read_b64_tr_b16 %0,%1 offset:%c2" : "=&v"(hi[ks]) : "v"(vb), "i"(d0 * 4096 + ks * 1024 + 512) : "memory"); }
    asm volatile("s_waitcnt lgkmcnt(0)" ::: "memory"); SBAR();
    #define PK(k) (bf16x8){lo[k][0], lo[k][1], lo[k][2], lo[k][3], hi[k][0], hi[k][1], hi[k][2], hi[k][3]}
    o[d0] = __builtin_amdgcn_mfma_f32_32x32x16_bf16(pa0, PK(0), o[d0], 0, 0, 0);
    o[d0] = __builtin_amdgcn_mfma_f32_32x32x16_bf16(pa1, PK(1), o[d0], 0, 0, 0);
    o[d0] = __builtin_amdgcn_mfma_f32_32x32x16_bf16(pa2, PK(2), o[d0], 0, 0, 0);
    o[d0] = __builtin_amdgcn_mfma_f32_32x32x16_bf16(pa3, PK(3), o[d0], 0, 0, 0);
    #undef PK
  }
}

struct DiffEpi { float lam, post; const float* subg; };
template <int THRL, int MODE> __device__ __forceinline__ void attn_unit(const bf16* Qu, const bf16* __restrict__ Kh, const bf16* __restrict__ Vh, int NT, bf16* Ou, char* shm, const DiffEpi de, const bool usemax = true, const float* kmaxp = nullptr) {
  constexpr int PK = PQ, PV = PQ, PO = 1024;
  constexpr bool DQ32 = (MODE != 0);
  const int tid = opaque_tid(), lane = tid & 63, r32 = lane & 31, hi = lane >> 5; const int wid = __builtin_amdgcn_readfirstlane(tid >> 6);
  const bf16* Qw = Qu + (long)(wid * QBLK) * PQ;
  const unsigned lds0 = (unsigned)(uintptr_t)shm;
  float* wsf = (float*)(shm + LDS_WS) + wid * 64;
  const bf16* ksrc = Kh + (long)lane * PK + wid * 8;
  const bf16* vsrc = Vh + (long)(16 * (wid & 3) + (lane >> 2)) * PV + (wid >> 2) * 32 + (lane & 3) * 8;
  const unsigned kdst = lds0 + LDS_K + wid * 1024, vdst = lds0 + LDS_V + wid * 1024;
  #define DMA_K(t, slot) glds16(ksrc + (long)(t) * KVBLK * PK, (unsigned)__builtin_amdgcn_readfirstlane(kdst + (slot)))
  #define DMA_V(t, slot) glds16(vsrc + (long)(t) * KVBLK * PV, (unsigned)__builtin_amdgcn_readfirstlane(vdst + (slot)))
  const int vb0 = (int)(lds0 + LDS_V) + ((lane >> 4) & 1) * 32 + (lane & 3) * 8 + (4 * hi + ((lane & 15) >> 2)) * 64;
  bf16x8 kf[8];
  const lds_cptr shm3 = (lds_cptr)shm; const lds_cptr kp0 = shm3 + LDS_K + hi * 1024 + r32 * 16; const lds_cptr vp0 = shm3 + LDS_V + ((lane >> 4) & 1) * 32 + (lane & 3) * 8 + (4 * hi + ((lane & 15) >> 2)) * 64;
  DMA_K(0, 0); DMA_V(0, 0); DMA_K(1, SLOTB);
  bf16x8 qr[4];
  #pragma unroll
  for (int d0 = 0; d0 < 4; ++d0) qr[d0] = *reinterpret_cast<const bf16x8*>(&Qw[(long)r32 * PQ + d0 * 16 + hi * 8]);
  constexpr bool LMF = DQ32;
  bool um = usemax;
  if (MODE != 0) {
    float q2 = 0.f;
    #pragma unroll
    for (int d0 = 0; d0 < 2; ++d0)
      #pragma unroll
      for (int jq = 0; jq < 8; ++jq) { const float v = __uint_as_float((unsigned)(unsigned short)qr[d0][jq] << 16); q2 += v * v; }
    const float bq = sqrtf(xor32_sum(q2)) * (*kmaxp) * 1.02f;
    um = __builtin_amdgcn_readfirstlane((int)(__ballot(bq > 40.0f) != 0ull)) != 0; }
  float mhat = 0.f, l_reg = 0.f; f32x16 o[2]; o[0] = f32x16{}; o[1] = f32x16{}; f32x16 negm = f32x16{}; asm volatile("" : "+v"(negm));
  f32x16 lacc = f32x16{}; bf16x8 ones; { unsigned c0_, c1_, c2_, c3_; asm volatile("v_mov_b32 %0, 0x3f803f80\n\tv_mov_b32 %1, 0x3f803f80\n\tv_mov_b32 %2, 0x3f803f80\n\tv_mov_b32 %3, 0x3f803f80" : "=v"(c0_), "=v"(c1_), "=v"(c2_), "=v"(c3_)); ones = __builtin_bit_cast(bf16x8, (u32x4){c0_, c1_, c2_, c3_}); }
  bool resc = false;
  #define START(P0, P1) do { const float rm = rowmax(P0, P1); resc = false; \
    { const float dl = rm; mhat = fadd_s(mhat, dl); \
      _Pragma("unroll") for (int r = 0; r < 16; ++r) { P0[r] = fsub_s(P0[r], dl); P1[r] = fsub_s(P1[r], dl); } \
      _Pragma("unroll") for (int r = 0; r < 16; ++r) negm[r] = -mhat; asm volatile("" : "+v"(negm)); } \
    _Pragma("unroll") for (int r = 0; r < 16; ++r) P0[r] = __builtin_amdgcn_exp2f(P0[r]); } while (0)
  #define RESC() do { if (resc) { asm volatile("s_waitcnt lgkmcnt(0)" ::: "memory"); \
      _Pragma("unroll") for (int d_ = 0; d_ < 2; ++d_) _Pragma("unroll") for (int r = 0; r < 16; ++r) o[d_][r] *= wsf[crow(r, hi)]; \
      if (LMF) { _Pragma("unroll") for (int r = 0; r < 16; ++r) lacc[r] *= wsf[crow(r, hi)]; } } } while (0)
  f32x16 pA0, pA1, pB0, pB1;
  int sl_prev = 0, sl_cur = 0, sl_next = SLOTB;
  #define ROT() do { sl_prev = sl_cur; sl_cur = sl_next; sl_next = (sl_next == (NSLOT - 1) * SLOTB) ? 0 : sl_next + SLOTB; } while (0)
  DMA_K(2, 2 * SLOTB);
  WAIT_BAR(3);
  qkt<DQ32>(pA0, pA1, shm3 + LDS_K, qr, negm, r32, hi); asm volatile("s_nop 15\n\ts_nop 7" : "+v"(pA0), "+v"(pA1));
  START(pA0, pA1);
  _Pragma("unroll") for (int r = 0; r < 16; ++r) pA1[r] = __builtin_amdgcn_exp2f(pA1[r]);
  WAIT_BAR(0);
  DMA_K(3, 0); DMA_V(1, SLOTB);
  ROT();
  kload8(kf, kp0 + sl_cur);
  WAIT_BAR(2);
  s16x4 vlo[8], vhi[8]; u32x4 pw0, pw1, pw2, pw3;
  #define PKW(P, B) cvtpk_s(P[B], P[B + 1])
  #define PAF(k) __builtin_bit_cast(bf16x8, pw##k)
  #define VFR(i) (bf16x8){vlo[i][0], vlo[i][1], vlo[i][2], vlo[i][3], vhi[i][0], vhi[i][1], vhi[i][2], vhi[i][3]}
  #define PIN(x) asm volatile("" : "+v"(x))
  #define MX3(a, b, c) __builtin_fmaxf(__builtin_fmaxf((a), (b)), (c))
  #define GAPA(MF, A0, A1, A2, A3, W0, W1, PW) do { MF; if (!LMF) { sacc += A0; sacc += A1; sacc += A2; sacc += A3; PIN(sacc); } W0; W1; PIN(PW); SBAR(); } while (0)
  #define LMM(k) lacc = __builtin_amdgcn_mfma_f32_32x32x16_bf16(PAF(k), ones, lacc, 0, 0, 0)
  #define EX(v) __builtin_amdgcn_exp2f(v)
  #define GAPB(MF, X, B) do { MF; X[B] = EX(X[B]); X[B + 1] = EX(X[B + 1]); X[B + 2] = EX(X[B + 2]); X[B + 3] = EX(X[B + 3]); PIN(X); SBAR(); } while (0)
  #define VRD(i) do { vlo[i] = vtr(vp_ + (((i) >> 2) * 4096 + ((i) & 3) * 1024)); vhi[i] = vtr(vp_ + (((i) >> 2) * 4096 + ((i) & 3) * 1024 + 512)); } while (0)
  #define KRD(G, j) do { if (G) { kload2(kf, kp0 + sl_next, j); SBAR(); } } while (0)
  #define STEP(C0, C1, P0, P1, t, GK, GV, GL) do { SBAR(); \
    const lds_cptr vp_ = vp0 + sl_prev; \
    VRD(0); SBAR(); float sacc = (P0[0] + P0[1]); \
    GAPA(C0 = __builtin_amdgcn_mfma_f32_32x32x16_bf16(kf[0], qr[0], negm, 0, 0, 0), P0[2], P0[3], P0[4], P0[5],     pw0[0] = PKW(P0, 0), pw0[1] = PKW(P0, 2), pw0); \
    VRD(4); SBAR(); GAPA(C1 = __builtin_amdgcn_mfma_f32_32x32x16_bf16(kf[1], qr[0], negm, 0, 0, 0), P0[6], P0[7], P0[8], P0[9],     pw0[2] = PKW(P0, 4), pw0[3] = PKW(P0, 6), pw0); \
    VRD(1); SBAR(); GAPA(C0 = __builtin_amdgcn_mfma_f32_32x32x16_bf16(kf[2], qr[1], C0, 0, 0, 0),   P0[10], P0[11], P0[12], P0[13], pw1[0] = PKW(P0, 8), pw1[1] = PKW(P0, 10), pw1); \
    VRD(5); SBAR(); GAPA(C1 = __builtin_amdgcn_mfma_f32_32x32x16_bf16(kf[3], qr[1], C1, 0, 0, 0),   P0[14], P0[15], P1[0], P1[1],   pw1[2] = PKW(P0, 12), pw1[3] = PKW(P0, 14), pw1); \
    VRD(2); SBAR(); GAPA(do { if (!DQ32) { C0 = __builtin_amdgcn_mfma_f32_32x32x16_bf16(kf[4], qr[2], C0, 0, 0, 0); } else if (LMF) { LMM(0); } } while (0),   P1[2], P1[3], P1[4], P1[5],     pw2[0] = PKW(P1, 0), pw2[1] = PKW(P1, 2), pw2); \
    VRD(6); SBAR(); GAPA(do { if (!DQ32) { C1 = __builtin_amdgcn_mfma_f32_32x32x16_bf16(kf[5], qr[2], C1, 0, 0, 0); } else if (LMF) { LMM(1); } } while (0),   P1[6], P1[7], P1[8], P1[9],     pw2[2] = PKW(P1, 4), pw2[3] = PKW(P1, 6), pw2); \
    VRD(3); SBAR(); GAPA(do { if (!DQ32) { C0 = __builtin_amdgcn_mfma_f32_32x32x16_bf16(kf[6], qr[3], C0, 0, 0, 0); } else if (LMF) { LMM(2); } } while (0),   P1[10], P1[11], P1[12], P1[13], pw3[0] = PKW(P1, 8), pw3[1] = PKW(P1, 10), pw3); \
    VRD(7); SBAR(); GAPA(do { if (!DQ32) { C1 = __builtin_amdgcn_mfma_f32_32x32x16_bf16(kf[7], qr[3], C1, 0, 0, 0); } } while (0),   P1[14], P1[15], 0.f, 0.f,       pw3[2] = PKW(P1, 12), pw3[3] = PKW(P1, 14), pw3); \
    if (LMF) { LMM(3); } else { l_reg += sacc; } \
    if (GK) { DMA_K((t) + 3, sl_cur); } if (GV) { DMA_V((t) + 1, sl_next); } \
    if (um) { float a = MX3(C0[0], C0[1], C1[0]), b = MX3(C0[2], C0[3], C1[1]); a = MX3(a, C1[2], C1[3]); \
      _Pragma("unroll") for (int r = 4; r < 16; r += 4) { a = MX3(a, C0[r], C0[r + 1]); b = MX3(b, C0[r + 2], C0[r + 3]); a = MX3(a, C1[r], C1[r + 1]); b = MX3(b, C1[r + 2], C1[r + 3]); } \
      float rm = __builtin_fmaxf(a, b); { auto rr = __builtin_amdgcn_permlane32_swap(__float_as_uint(rm), __float_as_uint(rm), false, false); rm = __builtin_fmaxf(__uint_as_float(rr[0]), __uint_as_float(rr[1])); } \
      resc = false; \
      if (__builtin_expect(__any(rm > (float)THRL), 0)) { const float dl = __builtin_fmaxf(rm, 0.f); mhat += dl; \
        _Pragma("unroll") for (int r = 0; r < 16; ++r) { C0[r] -= dl; C1[r] -= dl; } \
        _Pragma("unroll") for (int r = 0; r < 16; ++r) negm[r] = -mhat; asm volatile("" : "+v"(negm)); \
        const float f = __builtin_amdgcn_exp2f(-dl); if (!LMF) l_reg *= f; if (hi == 0) wsf[r32] = f; resc = true; } } else { resc = false; } \
    SBAR(); \
    GAPB(o[0] = __builtin_amdgcn_mfma_f32_32x32x16_bf16(PAF(0), VFR(0), o[0], 0, 0, 0), C0, 0); \
    GAPB(o[1] = __builtin_amdgcn_mfma_f32_32x32x16_bf16(PAF(0), VFR(4), o[1], 0, 0, 0), C0, 4); \
    KRD(GL, 0); GAPB(o[0] = __builtin_amdgcn_mfma_f32_32x32x16_bf16(PAF(1), VFR(1), o[0], 0, 0, 0), C0, 8); \
    KRD(GL, 1); GAPB(o[1] = __builtin_amdgcn_mfma_f32_32x32x16_bf16(PAF(1), VFR(5), o[1], 0, 0, 0), C0, 12); \
    KRD(GL && !DQ32, 2); GAPB(o[0] = __builtin_amdgcn_mfma_f32_32x32x16_bf16(PAF(2), VFR(2), o[0], 0, 0, 0), C1, 0); \
    KRD(GL && !DQ32, 3); GAPB(o[1] = __builtin_amdgcn_mfma_f32_32x32x16_bf16(PAF(2), VFR(6), o[1], 0, 0, 0), C1, 4); \
    GAPB(o[0] = __builtin_amdgcn_mfma_f32_32x32x16_bf16(PAF(3), VFR(3), o[0], 0, 0, 0), C1, 8); \
    GAPB(o[1] = __builtin_amdgcn_mfma_f32_32x32x16_bf16(PAF(3), VFR(7), o[1], 0, 0, 0), C1, 12); \
    } while (0)
  if (wid >= 4) __builtin_amdgcn_s_setprio(1);
  int t = 1;
  for (; t + 5 < NT; t += 2) {
    STEP(pB0, pB1, pA0, pA1, t, true, true, true);     WAIT_BAR(2); RESC(); ROT();
    STEP(pA0, pA1, pB0, pB1, t + 1, true, true, true); WAIT_BAR(2); RESC(); ROT();
  }
  #define ENDW(tt) do { if ((tt) + 3 < NT) { WAIT_BAR(2); } else if ((tt) + 2 < NT) { WAIT_BAR(1); } else { WAIT_BAR(0); } } while (0)
  for (; t + 1 < NT; t += 2) {
    STEP(pB0, pB1, pA0, pA1, t, (t + 3 < NT), (t + 1 < NT), (t + 1 < NT));       ENDW(t);     RESC(); ROT();
    STEP(pA0, pA1, pB0, pB1, t + 1, (t + 4 < NT), (t + 2 < NT), (t + 2 < NT));   ENDW(t + 1); RESC(); ROT();
  }
  STEP(pB0, pB1, pA0, pA1, NT - 1, false, false, false); RESC();
  __builtin_amdgcn_s_setprio(0);
  { if (!LMF) { float sacc = pB0[0] + pB0[1]; _Pragma("unroll") for (int r = 2; r < 16; ++r) sacc += pB0[r]; _Pragma("unroll") for (int r = 0; r < 16; ++r) sacc += pB1[r]; l_reg += sacc; }
    pw0 = (u32x4){PKW(pB0, 0), PKW(pB0, 2), PKW(pB0, 4), PKW(pB0, 6)}; pw1 = (u32x4){PKW(pB0, 8), PKW(pB0, 10), PKW(pB0, 12), PKW(pB0, 14)}; pw2 = (u32x4){PKW(pB1, 0), PKW(pB1, 2), PKW(pB1, 4), PKW(pB1, 6)}; pw3 = (u32x4){PKW(pB1, 8), PKW(pB1, 10), PKW(pB1, 12), PKW(pB1, 14)};
    SBAR(); if (LMF) { LMM(0); LMM(1); LMM(2); LMM(3); } pv(o, vb0 + sl_cur, PAF(0), PAF(1), PAF(2), PAF(3)); }
  #undef LMM
  #undef PKW
  #undef PAF
  #undef VFR
  #undef PIN
  #undef MX3
  #undef GAPA
  #undef GAPB
  #undef EX
  #undef VRD
  #undef KRD
  #undef STEP
  #undef ENDW
  float rli[16];
  if (LMF) {
    #pragma unroll
    for (int r = 0; r < 16; ++r) rli[r] = __builtin_amdgcn_rcpf(lacc[r]);
  } else {
    { auto rr = __builtin_amdgcn_permlane32_swap(__float_as_uint(l_reg), __float_as_uint(l_reg), false, false); l_reg = __uint_as_float(rr[0]) + __uint_as_float(rr[1]); }
    if (hi == 0) wsf[32 + r32] = l_reg; asm volatile("s_waitcnt lgkmcnt(0)" ::: "memory");
    #pragma unroll
    for (int r = 0; r < 16; ++r) rli[r] = __builtin_amdgcn_rcpf(wsf[32 + crow(r, hi)]);
  }
  bf16_t* stg = (bf16_t*)(shm + LDS_OST) + wid * 2048;
  bf16_t* stg1 = (bf16_t*)(shm + LDS_OST1) + wid * 2048;
  if (MODE == 1) {
    #pragma unroll
    for (int r = 0; r < 16; ++r) { const int orow = crow(r, hi);
      #pragma unroll
      for (int d0 = 0; d0 < 2; ++d0) stg1[orow * 64 + d0 * 32 + r32] = f2bf(o[d0][r] * rli[r]); }
    asm volatile("s_waitcnt lgkmcnt(0)" ::: "memory");
  } else {
    if (MODE == 2) {
      const float g0 = de.subg[r32] * de.post, g1 = de.subg[32 + r32] * de.post;
      #pragma unroll
      for (int r = 0; r < 16; ++r) { const int orow = crow(r, hi);
        const float d0v = bf2f(stg1[orow * 64 + r32]) - de.lam * (o[0][r] * rli[r]), d1v = bf2f(stg1[orow * 64 + 32 + r32]) - de.lam * (o[1][r] * rli[r]);
        float ss = d0v * d0v + d1v * d1v;
        ss = half32_sum(ss);
        const float rstd = __builtin_amdgcn_rsqf(ss * (1.0f / 64.0f) + EPS);
        stg[orow * 64 + r32] = f2bf(d0v * rstd * g0); stg[orow * 64 + 32 + r32] = f2bf(d1v * rstd * g1); }
    } else {
      #pragma unroll
      for (int r = 0; r < 16; ++r) { const int orow = crow(r, hi);
        #pragma unroll
        for (int d0 = 0; d0 < 2; ++d0) stg[orow * 64 + d0 * 32 + r32] = f2bf(o[d0][r] * rli[r]); }
    }
    asm volatile("s_waitcnt lgkmcnt(0)" ::: "memory");
    bf16* Ow = Ou + (long)(wid * QBLK) * PO;
    #pragma unroll
    for (int i = 0; i < 4; ++i) { const int row = i * 8 + (lane >> 3), ch = lane & 7; const u32x4 v = *(const u32x4*)(stg + row * 64 + ch * 8); *(u32x4*)(Ow + (long)row * PO + ch * 8) = v; }
  }
  asm volatile("s_waitcnt lgkmcnt(0)\n\ts_barrier" ::: "memory");
  #undef DMA_K
  #undef DMA_V
  #undef START
  #undef RESC
  #undef ROT
}

__device__ __forceinline__ void na_unit(int b, int h, int g4, const bf16* QKV, bf16* YS, const float* rpb_h, char* shm, const float* kmaxp) {
  const bf16 *QA = QKV + C_QA, *KA = QKV + C_KA, *VA = QKV + C_VA;
  const int tid = opaque_tid(), lane = tid & 63, r32 = lane & 31, hi = lane >> 5; const int wid = __builtin_amdgcn_readfirstlane(tid >> 6);
  const unsigned lds0 = (unsigned)(uintptr_t)shm;
  float* wsf = (float*)(shm + LDS_WS) + wid * 64;
  float* rp = (float*)(shm + LDS_RPB);
  const lds_cptr shm3 = (lds_cptr)shm;
  for (int i = tid; i < 15 * 31; i += 512) rp[i] = rpb_h[i] * LOG2E;
  const int rq = 4 * g4 + (wid >> 1), qc = 32 * (wid & 1) + r32;
  const long rowb = (long)b * RB;
  const bf16* Qw = QA + (rowb + CTXL + rq * 64 + 32 * (wid & 1)) * PQ + h * 64;
  bf16x8 qr[4];
  #pragma unroll
  for (int d0 = 0; d0 < 4; ++d0) qr[d0] = *reinterpret_cast<const bf16x8*>(&Qw[(long)r32 * PQ + d0 * 16 + hi * 8]);
  bool fx; { float q2 = 0.f;
    #pragma unroll
    for (int d0 = 0; d0 < 4; ++d0)
      #pragma unroll
      for (int jq = 0; jq < 8; ++jq) { const float v = __uint_as_float((unsigned)(unsigned short)qr[d0][jq] << 16); q2 += v * v; }
    float bm = 0.f; for (int i = lane; i < 15 * 31; i += 64) bm = fmaxf(bm, fabsf(rpb_h[i]));
    const float bq = sqrtf(xor32_sum(q2)) * (*kmaxp) * 1.02f + wave_max(bm) * LOG2E;
    fx = __builtin_amdgcn_readfirstlane((int)(__ballot(bq > 40.0f) != 0ull)) == 0; }
  const int r0 = min(max(rq - 4, 0), 120);
  const int kr_lo = min(max(4 * g4 - 4, 0), 120), kr_hi = min(max(4 * g4 - 1, 0), 120) + 7;
  const int ntiles = 4 + (kr_hi - kr_lo + 1);
  const int c0 = min(max(qc - 8, 0), 48);
  float mrun = -INFINITY, l_reg = 0.f; f32x16 o[2]; o[0] = f32x16{}; o[1] = f32x16{};
  const unsigned kdst = lds0 + LDS_K + wid * 1024, vdst = lds0 + LDS_V + wid * 1024;
  const int vb0 = (int)(lds0 + LDS_V) + ((lane >> 4) & 1) * 32 + (lane & 3) * 8 + (4 * hi + ((lane & 15) >> 2)) * 64;
  #define NA_DMA(TI) do { const int kr_ = kr_lo + (TI) - 4; const long krow_ = ((TI) < 4) ? rowb + 64 * (TI) : rowb + CTXL + (long)kr_ * 64; const unsigned so_ = ((TI) & 1) * SLOTB; \
      glds16(KA + (krow_ + lane) * PQ + h * 64 + wid * 8, (unsigned)__builtin_amdgcn_readfirstlane(kdst + so_)); \
      glds16(VA + (krow_ + 16 * (wid & 3) + (lane >> 2)) * PQ + h * 64 + (wid >> 2) * 32 + (lane & 3) * 8, (unsigned)__builtin_amdgcn_readfirstlane(vdst + so_)); } while (0)
  asm volatile("s_waitcnt lgkmcnt(0)\n\ts_barrier" ::: "memory");
  NA_DMA(0);
  for (int ti = 0; ti < ntiles; ++ti) {
    const int kr = kr_lo + ti - 4;
    asm volatile("s_waitcnt vmcnt(0) lgkmcnt(0)\n\ts_barrier" ::: "memory");
    if (ti + 1 < ntiles) NA_DMA(ti + 1);
    const unsigned so = (ti & 1) * SLOTB;
    const bool valid = (ti < 4) || (kr >= r0 && kr <= r0 + 7);
    if (valid) {
      f32x16 p0, p1; const f32x16 z = f32x16{};
      qkt<false>(p0, p1, shm3 + LDS_K + so, qr, z, r32, hi);
      if (ti >= 4) {
        const int dr = kr - rq + 7;
        #pragma unroll
        for (int r = 0; r < 16; ++r) { const int k0 = crow(r, hi), k1 = k0 + 32;
          const bool v0 = (k0 >= c0) && (k0 < c0 + 16), v1 = (k1 >= c0) && (k1 < c0 + 16);
          const float b0 = v0 ? rp[dr * 31 + (k0 - qc + 15)] : 0.f, b1 = v1 ? rp[dr * 31 + (k1 - qc + 15)] : 0.f;
          p0[r] = v0 ? p0[r] + b0 : -INFINITY; p1[r] = v1 ? p1[r] + b1 : -INFINITY; }
      }
      if (fx) { float sacc = 0.f;
        #pragma unroll
        for (int r = 0; r < 16; ++r) { p0[r] = __builtin_amdgcn_exp2f(p0[r]); p1[r] = __builtin_amdgcn_exp2f(p1[r]); sacc += p0[r] + p1[r]; }
        l_reg += sacc;
      } else {
      float rm = p0[0];
      #pragma unroll
      for (int r = 1; r < 16; ++r) rm = fmaxf(rm, p0[r]);
      #pragma unroll
      for (int r = 0; r < 16; ++r) rm = fmaxf(rm, p1[r]);
      { auto rr = __builtin_amdgcn_permlane32_swap(__float_as_uint(rm), __float_as_uint(rm), false, false); rm = fmaxf(__uint_as_float(rr[0]), __uint_as_float(rr[1])); }
      const float mnew = fmaxf(mrun, rm); const float f = __builtin_amdgcn_exp2f(mrun - mnew); mrun = mnew;
      float sacc = 0.f;
      #pragma unroll
      for (int r = 0; r < 16; ++r) { p0[r] = __builtin_amdgcn_exp2f(p0[r] - mnew); p1[r] = __builtin_amdgcn_exp2f(p1[r] - mnew); sacc += p0[r] + p1[r]; }
      l_reg = l_reg * f + sacc;
      if (hi == 0) wsf[r32] = f;
      asm volatile("s_waitcnt lgkmcnt(0)" ::: "memory");
      #pragma unroll
      for (int d_ = 0; d_ < 2; ++d_)
        #pragma unroll
        for (int r = 0; r < 16; ++r) o[d_][r] *= wsf[crow(r, hi)];
      }
      u32x4 pw0, pw1, pw2, pw3;
      pw0 = (u32x4){cvtpk(p0[0], p0[1]), cvtpk(p0[2], p0[3]), cvtpk(p0[4], p0[5]), cvtpk(p0[6], p0[7])}; pw1 = (u32x4){cvtpk(p0[8], p0[9]), cvtpk(p0[10], p0[11]), cvtpk(p0[12], p0[13]), cvtpk(p0[14], p0[15])};
      pw2 = (u32x4){cvtpk(p1[0], p1[1]), cvtpk(p1[2], p1[3]), cvtpk(p1[4], p1[5]), cvtpk(p1[6], p1[7])}; pw3 = (u32x4){cvtpk(p1[8], p1[9]), cvtpk(p1[10], p1[11]), cvtpk(p1[12], p1[13]), cvtpk(p1[14], p1[15])};
      asm volatile("s_waitcnt lgkmcnt(0)" ::: "memory");
      pv(o, vb0 + (int)so, __builtin_bit_cast(bf16x8, pw0), __builtin_bit_cast(bf16x8, pw1), __builtin_bit_cast(bf16x8, pw2), __builtin_bit_cast(bf16x8, pw3));
    }
  }
  #undef NA_DMA
  { auto rr = __builtin_amdgcn_permlane32_swap(__float_as_uint(l_reg), __float_as_uint(l_reg), false, false); l_reg = __uint_as_float(rr[0]) + __uint_as_float(rr[1]); }
  if (hi == 0) wsf[32 + r32] = l_reg; asm volatile("s_waitcnt lgkmcnt(0)" ::: "memory");
  bf16_t* stg = (bf16_t*)(shm + LDS_OST) + wid * 2048;
  #pragma unroll
  for (int r = 0; r < 16; ++r) { const int orow = crow(r, hi); const float rl = __builtin_amdgcn_rcpf(wsf[32 + orow]);
    #pragma unroll
    for (int d0 = 0; d0 < 2; ++d0) stg[orow * 64 + d0 * 32 + r32] = f2bf(o[d0][r] * rl); }
  asm volatile("s_waitcnt lgkmcnt(0)" ::: "memory");
  bf16* Ow = YS + (rowb + CTXL + rq * 64 + 32 * (wid & 1)) * 1024 + h * 64;
  #pragma unroll
  for (int i = 0; i < 4; ++i) { const int row = i * 8 + (lane >> 3), ch = lane & 7; const u32x4 v = *(const u32x4*)(stg + row * 64 + ch * 8); *(u32x4*)(Ow + (long)row * 1024 + ch * 8) = v; }
  asm volatile("s_waitcnt lgkmcnt(0)\n\ts_barrier" ::: "memory");
}
#undef SBAR
#undef WAIT_BAR
}

__device__ __forceinline__ void sgu_unit(long rowbase, const bf16_t* GU, const bf16_t* GV, const float* ng, const float* sw, const float* sb, bf16_t* YS, char* shm) {
    using attn_body::crow;
    const int tid = opaque_tid(), lane = tid & 63, wid = __builtin_amdgcn_readfirstlane(tid >> 6), r32 = lane & 31, hi = lane >> 5;
    const unsigned lds0 = (unsigned)(uintptr_t)shm;
    {
        const f32x4 g4 = *(const f32x4*)(ng + 4 * lane);
        const int gl = lane >> 4, d = 4 * (lane & 15);
#pragma unroll
        for (int rb = 0; rb < 4; ++rb) { v2u raw[4];
#pragma unroll
            for (int q4 = 0; q4 < 4; ++q4) raw[q4] = *(const v2u*)(GV + (rowbase + wid * 16 + rb * 4 + q4) * PQ + 4 * lane);
            __builtin_amdgcn_sched_barrier(0);
#pragma unroll
            for (int q4 = 0; q4 < 4; ++q4) { const int q = wid * 16 + rb * 4 + q4;
                f32x4 v = {bflo(raw[q4].x), bfhi(raw[q4].x), bflo(raw[q4].y), bfhi(raw[q4].y)};
                const float mean = wave_sum((v.x + v.y) + (v.z + v.w)) * (1.0f / 256.0f);
                v = v - mean;
                const float var = wave_sum((v.x * v.x + v.y * v.y) + (v.z * v.z + v.w * v.w)) * (1.0f / 256.0f);
                const float rstd = __builtin_amdgcn_rsqf(var + EPS);
                v = v * rstd * g4;
                v2u w; w.x = cvtpk(v.x, v.y); w.y = cvtpk(v.z, v.w);
                const int k = q & 63;
                *(v2u*)(shm + (2 * gl + (q >> 6)) * 8192 + ((d >> 5) * 4 + (k >> 4)) * 1024 + (k & 15) * 64 + (d & 31) * 2) = w; }
            __builtin_amdgcn_sched_barrier(0); }
    }
    __syncthreads();
    const int g = wid & 3, ph = wid >> 2;
    const int vb0 = (int)lds0 + ((lane >> 4) & 1) * 32 + (lane & 3) * 8 + (4 * hi + ((lane & 15) >> 2)) * 64;
    bf16_t* stg = (bf16_t*)(shm + 65536) + wid * 2048;
#pragma unroll
    for (int mt = 0; mt < 2; ++mt) {
        const int p0 = ph * 64 + mt * 32;
        const float* wrow = sw + ((size_t)g * 128 + p0 + r32) * 128 + 4 * hi;
        f32x16 o[2]; o[0] = f32x16{}; o[1] = f32x16{};
#pragma unroll
        for (int sl = 0; sl < 2; ++sl) {
            f32x4 wa[4], wc[4];
#pragma unroll
            for (int s4 = 0; s4 < 4; ++s4) { wa[s4] = *(const f32x4*)(wrow + 64 * sl + 16 * s4); wc[s4] = *(const f32x4*)(wrow + 64 * sl + 16 * s4 + 8); }
            __builtin_amdgcn_sched_barrier(0);
            bf16x8 pa[4];
#pragma unroll
            for (int s4 = 0; s4 < 4; ++s4) { const v4u w = {cvtpk(wa[s4].x, wa[s4].y), cvtpk(wa[s4].z, wa[s4].w), cvtpk(wc[s4].x, wc[s4].y), cvtpk(wc[s4].z, wc[s4].w)}; pa[s4] = __builtin_bit_cast(bf16x8, w); }
            attn_body::pv(o, vb0 + (2 * g + sl) * 8192, pa[0], pa[1], pa[2], pa[3]);
        }
        float bias[16];
#pragma unroll
        for (int r = 0; r < 16; ++r) bias[r] = sb[g * 128 + p0 + crow(r, hi)];
        v4u uu[4];
#pragma unroll
        for (int i = 0; i < 4; ++i) uu[i] = *(const v4u*)(GU + (rowbase + p0 + i * 8 + (lane >> 3)) * PQ + g * 64 + (lane & 7) * 8);
        __builtin_amdgcn_sched_barrier(0);
#pragma unroll
        for (int r = 0; r < 16; ++r) { const int orow = crow(r, hi);
#pragma unroll
            for (int d0 = 0; d0 < 2; ++d0) stg[orow * 64 + d0 * 32 + r32] = f2bf(o[d0][r] + bias[r]); }
        asm volatile("s_waitcnt lgkmcnt(0)" ::: "memory");
#pragma unroll
        for (int i = 0; i < 4; ++i) { const int row = i * 8 + (lane >> 3), ch = lane & 7; const v4u mv = *(const v4u*)(stg + row * 64 + ch * 8); const v4u u4 = uu[i];
            v4u w; w.x = cvtpk(bflo(u4.x) * bflo(mv.x), bfhi(u4.x) * bfhi(mv.x)); w.y = cvtpk(bflo(u4.y) * bflo(mv.y), bfhi(u4.y) * bfhi(mv.y));
            w.z = cvtpk(bflo(u4.z) * bflo(mv.z), bfhi(u4.z) * bfhi(mv.z)); w.w = cvtpk(bflo(u4.w) * bflo(mv.w), bfhi(u4.w) * bfhi(mv.w));
            *(v4u*)(YS + (rowbase + p0 + row) * 1024 + 512 + g * 64 + ch * 8) = w; }
        asm volatile("s_waitcnt lgkmcnt(0)" ::: "memory");
    }
    __syncthreads();
}

typedef GAS unsigned gu32;
#define XB_TMO      128
#define XB_XCNT(j)  (256  + 64 * (j))
#define XB_XSUB(j)  (1280 + 64 * (j))
#define XB_XGEN(j)  (2304 + 64 * (j))
#define XB_TOP      3328
#define XB_TOPGEN   3392
#define XCD_BAR_WORDS 3456
#define XB_SPIN_CAP (1u << 18)
__device__ __forceinline__ unsigned xb_ld(unsigned* p)              { return __hip_atomic_load(p, __ATOMIC_RELAXED, __HIP_MEMORY_SCOPE_AGENT); }
__device__ __forceinline__ unsigned xb_add(unsigned* p, unsigned v) { return __hip_atomic_fetch_add(p, v, __ATOMIC_RELAXED, __HIP_MEMORY_SCOPE_AGENT); }
__device__ __forceinline__ unsigned xb_xcc_id() { return (unsigned)__builtin_amdgcn_s_getreg((3 << 11) | 20) & 0xFu; }
#define XB_SPIN(cond, bar) do { unsigned _sp = 0; while (cond) { __builtin_amdgcn_s_sleep(1); \
    if ((++_sp & 255u) == 0u) { if (xb_ld(&(bar)[XB_TMO])) break; if (_sp > XB_SPIN_CAP) { atomicAdd(&(bar)[XB_TMO], 1u); break; } } } } while (0)
struct XcdBarrier { unsigned* bar; unsigned x; volatile LAS unsigned* st; };
__device__ __forceinline__ XcdBarrier xcd_barrier_post(unsigned* bar, volatile LAS unsigned* st) {
    XcdBarrier b; b.bar = bar; b.x = xb_xcc_id(); b.st = st;
    if (threadIdx.x == 0) (void)xb_add(&bar[XB_XCNT(b.x)], 1u);
    return b;
}
__device__ __forceinline__ void xcd_barrier_complete(unsigned* bar, unsigned x, unsigned& nloc, unsigned& nx) {
    const unsigned G = gridDim.x * gridDim.y * gridDim.z;
    unsigned sum, cnt, mine, sp = 0u;
    for (;;) {
        sum = 0u; cnt = 0u; mine = 0u;
#pragma unroll
        for (unsigned j = 0; j < 16; ++j) { const unsigned c = xb_ld(&bar[XB_XCNT(j)]); sum += c; cnt += (c > 0u) ? 1u : 0u; }
        if (sum == G) break;
        __builtin_amdgcn_s_sleep(1);
        if ((++sp & 255u) == 0u) { if (xb_ld(&bar[XB_TMO])) break; if (sp > XB_SPIN_CAP) { atomicAdd(&bar[XB_TMO], 1u); break; } }
    }
    mine = xb_ld(&bar[XB_XCNT(x)]);
    nloc = mine > 0u ? mine : 1u; nx = cnt > 0u ? cnt : 1u;
}
__device__ __forceinline__ void xcd_barrier(const XcdBarrier& b) {
    asm volatile("s_waitcnt vmcnt(0)" ::: "memory");
    __syncthreads();
    if (threadIdx.x == 0) {
        unsigned* bar = b.bar;
        __builtin_amdgcn_s_waitcnt(0);
        unsigned nloc = b.st[0], nx = b.st[1];
        if (nloc == 0u) { xcd_barrier_complete(bar, b.x, nloc, nx); b.st[0] = nloc; b.st[1] = nx; }
        const unsigned old = xb_add(&bar[XB_XSUB(b.x)], 1u);
        const unsigned gen = old / nloc;
        if (old + 1u == (gen + 1u) * nloc) {
            __builtin_amdgcn_fence(__ATOMIC_RELEASE, "agent");
            asm volatile("s_waitcnt vmcnt(0)" ::: "memory");
            const unsigned og = xb_add(&bar[XB_TOP], 1u);
            const unsigned tg = og / nx;
            if (og + 1u == (tg + 1u) * nx) xb_add(&bar[XB_TOPGEN], 1u);
            else XB_SPIN(xb_ld(&bar[XB_TOPGEN]) == tg, bar);
            __builtin_amdgcn_fence(__ATOMIC_ACQUIRE, "agent");
            xb_add(&bar[XB_XGEN(b.x)], 1u);
            asm volatile("s_waitcnt vmcnt(0)" ::: "memory");
        } else {
            XB_SPIN(xb_ld(&bar[XB_XGEN(b.x)]) == gen, bar);
            __builtin_amdgcn_fence(__ATOMIC_ACQUIRE, "agent");
            asm volatile("s_waitcnt vmcnt(0)" ::: "memory");
        }
    }
    __syncthreads();
}

struct Args { const float* in[28]; float* out; unsigned char* ws; int ph_lo, ph_hi, li, pad; };
typedef const __attribute__((address_space(4))) Args* KArgs;
__device__ __forceinline__ KArgs opaque_kargs() { KArgs p = (KArgs)__builtin_amdgcn_kernarg_segment_ptr(); asm volatile("" : "+s"(p)); return p; }
enum { I_X = 0, I_C, I_CTX, I_CCTX, I_WMOD, I_BMOD, I_N1G, I_N2G, I_WIN, I_QG, I_KG, I_RPB, I_LQ1, I_LK1, I_LQ2, I_LK2, I_SUBG, I_SGUNG, I_SGUW, I_SGUB, I_GATEB, I_WBR, I_WOUT, I_WRT, I_WEG, I_WEU, I_WED, I_FG };

constexpr int CW_WIN = 16 * 26, CW_WB = 4 * 4 * 4, CW_WO = 16 * 4, CW_EG = 16 * 16 * 8, CW_ED = 16 * 32 * 4, CW_LAYER = CW_WIN + CW_WB + CW_WO + 2 * CW_EG + CW_ED;
struct ConvItem { const float* src; unsigned char* dst; int N, dpitch, k0, n0, kind, aux; };
__device__ __forceinline__ ConvItem conv_decode(KArgs A, int it) {
    ConvItem c; const int l = it / CW_LAYER; int r = it % CW_LAYER; unsigned char* wl = A->ws + WS_W0 + (size_t)l * W_LAYER; c.aux = 0;
    if (r < CW_WIN) { const int kb = r / 26, pn = r % 26; c.src = A->in[I_WIN] + (size_t)l * DM * IN_W; c.N = IN_W; c.k0 = 64 * kb; c.n0 = 256 * pn; c.dpitch = DM;
        if (pn >= 5 && pn <= 20) { c.kind = 1; c.dst = wl + WO_WING + (size_t)(c.n0 - 1280) * DM; } else { c.kind = 2; c.dst = wl + WO_WIN + (size_t)256 * (pn < 5 ? pn : pn - 16) * DM * 2; }
        return c; }
    r -= CW_WIN;
    if (r < CW_WB) { const int n = r / 16, q = r % 16, kb = q / 4, nb = q % 4; c.src = A->in[I_WBR] + ((size_t)l * 4 + n) * 256 * DM; c.N = DM; c.k0 = 64 * kb; c.n0 = 256 * nb; c.dpitch = 256; c.kind = 0; c.dst = wl + WO_WB + ((size_t)n * 1024 + c.n0) * 256 * 2; return c; }
    r -= CW_WB;
    if (r < CW_WO) { const int kb = r / 4, nb = r % 4; c.src = A->in[I_WOUT] + (size_t)l * DM * DM; c.N = DM; c.k0 = 64 * kb; c.n0 = 256 * nb; c.dpitch = DM; c.kind = 0; c.dst = wl + WO_WO4 + (size_t)c.n0 * DM * 2; return c; }
    r -= CW_WO;
    if (r < 2 * CW_EG) { const int up = r >= CW_EG; if (up) r -= CW_EG; const int e = r / 128, q = r % 128, kb = q / 8, nb = q % 8; c.src = A->in[up ? I_WEU : I_WEG] + ((size_t)l * NEXP + e) * DM * EH; c.N = EH; c.k0 = 64 * kb; c.n0 = 256 * nb; c.dpitch = DM;
        c.kind = 3; c.aux = up ? 128 : 0; c.dst = wl + WO_WGU + (size_t)e * 4096 * DM; return c; }
    r -= 2 * CW_EG;
    { const int e = r / 128, q = r % 128, kb = q / 4, nb = q % 4; c.src = A->in[I_WED] + ((size_t)l * NEXP + e) * EH * DM; c.N = DM; c.k0 = 64 * kb; c.n0 = 256 * nb; c.dpitch = EH; c.kind = 1; c.dst = wl + WO_WD + ((size_t)e * DM + c.n0) * EH; return c; }
}
constexpr int CW_SMALL = CW_WIN + CW_WB + CW_WO, CW_MOE = 2 * CW_EG + CW_ED;
template <bool SMALL> __device__ __forceinline__ int conv_id(int it) { return SMALL ? (it / CW_SMALL) * CW_LAYER + it % CW_SMALL : it; }
template <bool SMALL> __device__ __forceinline__ void conv_load(KArgs A, int it, int NIT, f32x4 (&rg)[8], int wv, int lane) {
    if (it < NIT) { const ConvItem c = conv_decode(A, conv_id<SMALL>(it)); const float* p = c.src + (size_t)(c.k0 + wv * 8) * c.N + c.n0 + 4 * lane;
#pragma unroll
        for (int i = 0; i < 8; ++i) rg[i] = *(const f32x4*)(p + (size_t)i * c.N); }
}
constexpr int C8_WP = 2208, C8_JP = 528, C8_BYTES = 8 * C8_WP;
__device__ __forceinline__ void conv_out8(const ConvItem c, const f32x4 (&rg)[8], LAS unsigned char* T8, int tid, int wv, int lane) {
#pragma unroll
    for (int j = 0; j < 4; ++j) { v2u o; o.x = pk8(rg[0][j] * W8S, rg[1][j] * W8S, rg[2][j] * W8S, rg[3][j] * W8S); o.y = pk8(rg[4][j] * W8S, rg[5][j] * W8S, rg[6][j] * W8S, rg[7][j] * W8S);
        *(LAS v2u*)(T8 + wv * C8_WP + j * C8_JP + lane * 8) = o; }
    asm volatile("s_waitcnt lgkmcnt(0)" ::: "memory"); __builtin_amdgcn_s_barrier(); asm volatile("" ::: "memory");
#pragma unroll
    for (int jj = 0; jj < 2; ++jj) { const int q = tid + 512 * jj, cq = q & 3, n = q >> 2; const LAS unsigned char* t = T8 + (2 * cq) * C8_WP + (n & 3) * C8_JP + (n >> 2) * 8;
        const v2u a = *(const LAS v2u*)t, b = *(const LAS v2u*)(t + C8_WP); const int f = c.n0 + n;
        const int row = c.kind == 3 ? 256 * (f >> 7) + (f & 127) + c.aux : n;
        *(v4u*)(c.dst + (size_t)row * c.dpitch + c.k0 + 16 * cq) = (v4u){a.x, a.y, b.x, b.y}; }
}
template <bool SMALL> __device__ __forceinline__ void conv_out(KArgs A, int it, const f32x4 (&rg)[8], LAS float* T, int par, int tid, int wv, int lane) {
    { const ConvItem c8 = conv_decode(A, conv_id<SMALL>(it));
      if (!SMALL || c8.kind == 1 || c8.kind == 3) { conv_out8(c8, rg, (LAS unsigned char*)T + (SMALL ? 65536 : 0) + par * C8_BYTES, tid, wv, lane); return; } }
    constexpr int TP = 256;
#pragma unroll
    for (int i = 0; i < 8; ++i) *(LAS f32x4*)(T + (wv * 8 + i) * TP + 4 * (lane ^ wv)) = rg[i];
    asm volatile("s_waitcnt lgkmcnt(0)" ::: "memory"); __builtin_amdgcn_s_barrier(); asm volatile("" ::: "memory");
    const ConvItem c = conv_decode(A, conv_id<SMALL>(it));
#pragma unroll
    for (int jj = 0; jj < 4; ++jj) { const int q = tid + 512 * jj, ch = q & 7, n = q >> 3; const LAS float* t = T + (8 * ch) * TP + (n ^ (4 * ch));
        float v[8];
#pragma unroll
        for (int i = 0; i < 8; ++i) v[i] = t[i * TP];
        if (c.kind == 1) { v2u o; o.x = pk8(v[0] * W8S, v[1] * W8S, v[2] * W8S, v[3] * W8S); o.y = pk8(v[4] * W8S, v[5] * W8S, v[6] * W8S, v[7] * W8S); *(v2u*)(c.dst + (size_t)n * c.dpitch + c.k0 + 8 * ch) = o; }
        else if (c.kind == 3) { const int f = c.n0 + n; v2u o; o.x = pk8(v[0] * W8S, v[1] * W8S, v[2] * W8S, v[3] * W8S); o.y = pk8(v[4] * W8S, v[5] * W8S, v[6] * W8S, v[7] * W8S); *(v2u*)(c.dst + (size_t)(256 * (f >> 7) + (f & 127) + c.aux) * c.dpitch + c.k0 + 8 * ch) = o; }
        else { const int g = n >> 5, row = c.kind == 2 ? 32 * (4 * (g & 1) + (g >> 1)) + (n & 31) : n; st8((bf16_t*)c.dst + (size_t)row * c.dpitch + c.k0 + 8 * ch, v); } }
    asm volatile("s_waitcnt lgkmcnt(0)" ::: "memory"); __builtin_amdgcn_s_barrier(); asm volatile("" ::: "memory");
}
template <bool SMALL = false> __device__ __forceinline__ void conv_run(KArgs A, int first, int stride, int end, LAS unsigned char* lds, int tid) {
    const int lane = tid & 63, wv = tid >> 6; LAS float* T = (LAS float*)lds;
    f32x4 rg[4][8];
#pragma unroll
    for (int d = 0; d < 4; ++d) conv_load<SMALL>(A, first + d * stride, end, rg[d], wv, lane);
    for (int it = first; it < end; it += 4 * stride) {
#pragma unroll
        for (int d = 0; d < 4; ++d) if (it + d * stride < end) {
            f32x4 t0[8];
#pragma unroll
            for (int i = 0; i < 8; ++i) t0[i] = rg[d][i];
            conv_load<SMALL>(A, it + (4 + d) * stride, end, rg[d], wv, lane);
            conv_out<SMALL>(A, it + d * stride, t0, T, d & 1, tid, wv, lane);
        }
    }
    asm volatile("s_waitcnt lgkmcnt(0)" ::: "memory"); __builtin_amdgcn_s_barrier(); asm volatile("" ::: "memory");
}
__device__ __forceinline__ void mod_item(KArgs A, int item, LAS unsigned char* lds, int tid) {
    const int lane = tid & 63, wid = tid >> 6, l = item / 96, col0 = 64 * (item % 96);
    LAS float* sil = (LAS float*)lds;
    LAS float* part = sil + 3 * 1024;
    for (int i = tid; i < 3 * 1024; i += 512) { const int r = i >> 10, k = i & 1023; const float cv = r < 2 ? A->in[I_C][r * DM + k] : A->in[I_CCTX][k]; sil[i] = siluf_(cv); }
    __syncthreads();
    const float* W = A->in[I_WMOD] + (size_t)l * DM * 6144 + col0 + lane;
    float a0 = 0.f, a1 = 0.f, a2 = 0.f;
    for (int kb = 0; kb < 4; ++kb) { float w[32];
#pragma unroll
        for (int q = 0; q < 32; ++q) w[q] = W[(size_t)(wid * 128 + kb * 32 + q) * 6144];
        __builtin_amdgcn_sched_barrier(0);
#pragma unroll
        for (int q = 0; q < 32; ++q) { const int k = wid * 128 + kb * 32 + q; a0 += sil[k] * w[q]; a1 += sil[1024 + k] * w[q]; a2 += sil[2048 + k] * w[q]; }
        __builtin_amdgcn_sched_barrier(0); }
    part[(wid * 3 + 0) * 64 + lane] = a0; part[(wid * 3 + 1) * 64 + lane] = a1; part[(wid * 3 + 2) * 64 + lane] = a2;
    __syncthreads();
    if (tid < 192) { const int r = tid >> 6, cl = tid & 63; float s = A->in[I_BMOD][(size_t)l * 6144 + col0 + cl];
#pragma unroll
        for (int w = 0; w < 8; ++w) s += part[(w * 3 + r) * 64 + cl];
        ((float*)(A->ws + WS_MOD))[((size_t)l * 3 + r) * 6144 + col0 + cl] = s; }
    __syncthreads();
}

struct Row { f32x4 v[4]; };
__device__ __forceinline__ Row row_load(const float* p, int lane) { Row r; const f32x4* q = (const f32x4*)p + lane;
#pragma unroll
    for (int j = 0; j < 4; ++j) r.v[j] = q[64 * j]; return r; }
__device__ __forceinline__ Row row_load_bf16(const bf16_t* p, int lane) { Row r; const v2u* q = (const v2u*)p + lane; v2u t[4];
#pragma unroll
    for (int j = 0; j < 4; ++j) t[j] = q[64 * j];
#pragma unroll
    for (int j = 0; j < 4; ++j) r.v[j] = (f32x4){bflo(t[j].x), bfhi(t[j].x), bflo(t[j].y), bfhi(t[j].y)};
    return r; }
__device__ __forceinline__ void row_store(float* p, const Row& r, int lane) { f32x4* q = (f32x4*)p + lane;
#pragma unroll
    for (int j = 0; j < 4; ++j) q[64 * j] = r.v[j]; }
__device__ __forceinline__ float row_rstd(const Row& r) { float s = 0.f;
#pragma unroll
    for (int j = 0; j < 4; ++j) s += (r.v[j].x * r.v[j].x + r.v[j].y * r.v[j].y) + (r.v[j].z * r.v[j].z + r.v[j].w * r.v[j].w);
    return __builtin_amdgcn_rsqf(wave_sum(s) * (1.0f / DM) + EPS); }
__device__ __forceinline__ Row row_normmod(const Row& x, float rstd, const float* g, const float* sh, const float* sc, int lane) { Row y; f32x4 gg[4], ss[4], hh[4];
#pragma unroll
    for (int j = 0; j < 4; ++j) { gg[j] = ((const f32x4*)g)[lane + 64 * j]; ss[j] = ((const f32x4*)sc)[lane + 64 * j]; hh[j] = ((const f32x4*)sh)[lane + 64 * j]; }
    __builtin_amdgcn_sched_barrier(0);
#pragma unroll
    for (int j = 0; j < 4; ++j) y.v[j] = x.v[j] * rstd * gg[j] * (ss[j] + 1.0f) + hh[j];
    return y; }
struct NormP { f32x4 a[4], h[4]; };
__device__ __forceinline__ NormP normp_load(const float* g, const float* sh, const float* sc, int lane) { NormP p; f32x4 gg[4], ss[4];
#pragma unroll
    for (int j = 0; j < 4; ++j) { gg[j] = ((const f32x4*)g)[lane + 64 * j]; ss[j] = ((const f32x4*)sc)[lane + 64 * j]; p.h[j] = ((const f32x4*)sh)[lane + 64 * j]; }
    __builtin_amdgcn_sched_barrier(0);
#pragma unroll
    for (int j = 0; j < 4; ++j) p.a[j] = gg[j] * (ss[j] + 1.0f);
    return p; }
__device__ __forceinline__ Row row_normmod_p(const Row& x, float rstd, const NormP& p) { Row y;
#pragma unroll
    for (int j = 0; j < 4; ++j) y.v[j] = x.v[j] * rstd * p.a[j] + p.h[j];
    return y; }
__device__ __forceinline__ void row_store_bf16(bf16_t* p, const Row& r, int lane) { v2u* q = (v2u*)p + lane;
#pragma unroll
    for (int j = 0; j < 4; ++j) { v2u w; w.x = cvtpk(r.v[j].x, r.v[j].y); w.y = cvtpk(r.v[j].z, r.v[j].w); q[64 * j] = w; } }
__device__ __forceinline__ void row_store_fp8(unsigned char* p, const Row& r, int lane) { unsigned* q = (unsigned*)p + lane;
#pragma unroll
    for (int j = 0; j < 4; ++j) q[64 * j] = pk8(r.v[j].x, r.v[j].y, r.v[j].z, r.v[j].w); }
__device__ __forceinline__ const float* in_row(KArgs A, int R) { const int b = R / RB, r = R % RB; return r < CTXL ? A->in[I_CTX] + ((size_t)b * CTXL + r) * DM : A->in[I_X] + ((size_t)b * SEQ + (r - CTXL)) * DM; }
__device__ __forceinline__ int mod_row(int R) { const int b = R / RB, r = R % RB; return r < CTXL ? 2 : b; }

__device__ __forceinline__ int lat_tile(int im) { return (im >> 5) * TPB + 1 + (im & 31); }
struct SchedP1 { const char* HN; const char* W; int layer, G, c;
    __device__ __forceinline__ bool next(int i, pg8::Unit& u) const {
        const int nmain = 64 * 10, nextra = layer == 0 ? 2 * 10 : 2 * 5; const int L = i * G + c; if (L >= nmain + nextra) return false;
        int pm, pq;
        if (L < nmain) { int im, in; pg8::rect_order(L, 64, 10, im, in); pm = lat_tile(im); pq = in; }
        else { const int x = L - nmain; if (layer == 0) { pm = (x / 10) * TPB; pq = x % 10; } else { pm = (x / 5) * TPB; pq = 5 + x % 5; } }
        u.pm = pm; u.pn = pq < 5 ? pq : pq + 16; u.a = HN + (size_t)pm * 256 * DM * 2; u.b = W + (size_t)pq * 256 * DM * 2; return true; } };
struct SchedP1g { const char* HN8; const char* W8; int layer, G, c;
    __device__ __forceinline__ bool next(int i, pg8::Unit& u) const {
        const int nmain = 64 * 16, nextra = layer == 0 ? 2 * 16 : 0; const int L = i * G + (G - 1 - c); if (L >= nmain + nextra) return false;
        int pm, pn;
        if (L < nmain) { int im; pg8::rect_order(L, 64, 16, im, pn); pm = lat_tile(im); }
        else { const int x = L - nmain; pm = (x >> 4) * TPB; pn = x & 15; }
        u.pm = pm; u.pn = pn; u.a = HN8 + (size_t)pm * 256 * DM; u.b = W8 + (size_t)pn * 256 * DM; return true; } };
struct SchedP3a { const char* YS; const char* WB; int layer, G, c;
    __device__ __forceinline__ bool next(int i, pg8::Unit& u) const {
        int pm, dt, n;
        if (i < 4) { if (c >= 256) return false; int im; pg8::rect_order(c, 64, 4, im, dt); pm = lat_tile(im); n = i; }
        else { if (i > 4 || layer != 0 || c >= 32) return false; pm = (c >> 4) * TPB; dt = (c >> 2) & 3; n = c & 3; }
        u.pm = pm; u.pn = dt * 4 + n; u.a = YS + ((size_t)pm * 256 * DM + 256 * n) * 2; u.b = WB + ((size_t)n * 1024 + dt * 256) * 256 * 2; return true; } };
struct SchedP3b { const char* MRG; const char* WO; int G, c;
    __device__ __forceinline__ bool next(int i, pg8::Unit& u) const {
        const int L = i * G + c; if (L >= 64 * 4) return false;
        int im, in; pg8::rect_order(L, 64, 4, im, in); const int pm = lat_tile(im);
        u.pm = pm; u.pn = in; u.a = MRG + (size_t)pm * 256 * DM * 2; u.b = WO + (size_t)in * 256 * DM * 2; return true; } };
struct SchedP3c { const char* GPC; const char* WO; int G, c;
    __device__ __forceinline__ bool next(int i, pg8::Unit& u) const {
        const int L = i * G + c; if (L >= 128) return false;
        const int pm = L >> 6, ks = (L >> 2) & 15, ct = L & 3, n = ks >> 2, kq = ks & 3;
        u.pm = pm; u.pn = ks * 4 + ct; u.a = GPC + (((size_t)n * 512 + pm * 256) * DM + kq * 256) * 2; u.b = WO + ((size_t)ct * 256 * DM + kq * 256) * 2; return true; } };
struct SchedP6 { const char* XG; const char* WGU; int RT, G, c;
    __device__ __forceinline__ bool next(int i, pg8::Unit& u) const {
        const int nM = 16 * RT; const int L = i * G + c; if (L >= nM * 16) return false;
        int im, in; pg8::rect_order(L, nM, 16, im, in); const int e = im / RT;
        u.pm = im; u.pn = in; u.a = XG + (size_t)im * 256 * DM; u.b = WGU + ((size_t)e * 4096 + in * 256) * DM; return true; } };
struct SchedP7 { const char* HID; const char* WD; int RT, G, c;
    __device__ __forceinline__ bool next(int i, pg8::Unit& u) const {
        const int nM = 16 * 8; const int L = i * G + c; if (L >= nM * 4) return false;
        int im8, in; pg8::rect_order(L, nM, 4, im8, in); const int e = im8 >> 3, im = e * RT + (im8 & 7);
        u.pm = im; u.pn = in; u.a = HID + (size_t)im * 256 * EH; u.b = WD + ((size_t)e * DM + in * 256) * EH; return true; } };
struct SchedP7c { const char* HID; const char* WD; int G, c;
    __device__ __forceinline__ bool next(int i, pg8::Unit& u) const {
        const int L = i * G + c; if (L >= 256) return false;
        const int e = L >> 4, in = (L >> 2) & 3, kq = L & 3, im = e * 9 + 8;
        u.pm = im; u.pn = in + 4 * kq; u.a = HID + (size_t)im * 256 * EH + kq * 512; u.b = WD + ((size_t)e * DM + in * 256) * EH + kq * 512; return true; } };

__device__ __forceinline__ unsigned block_excl_scan(unsigned v, LAS unsigned* wtot, int lane, int wid) {
    unsigned inc = v;
#pragma unroll
    for (int o = 1; o < 64; o <<= 1) { const unsigned t = (unsigned)__builtin_amdgcn_ds_bpermute(((lane - o) & 63) << 2, (int)inc); if (lane >= o) inc += t; }
    if (lane == 63) wtot[wid] = inc;
    __syncthreads();
    unsigned base = 0;
#pragma unroll
    for (int w = 0; w < 8; ++w) base += (w < wid) ? wtot[w] : 0u;
    __syncthreads();
    return base + inc - v;
}
__device__ __forceinline__ void topk_unit(KArgs A, int RT, bool isctx, int b, int e, LAS unsigned char* lds, int tid) {
    const int lane = tid & 63, wid = tid >> 6;
    LAS unsigned* hist = (LAS unsigned*)lds; LAS unsigned* wtot = hist + 256; LAS unsigned* sel = wtot + 16;
    const int cap = isctx ? 32 : 1024;
    const float* aff = isctx ? (const float*)(A->ws + WS_AFFC) + ((size_t)b * 16 + e) * 256 : (const float*)(A->ws + WS_AFFL) + ((size_t)b * 16 + e) * 8192;
    unsigned key[16];
    if (isctx) {
#pragma unroll
        for (int j = 0; j < 16; ++j) key[j] = 0u;
        if (tid < 256) key[0] = __float_as_uint(aff[tid]);
    } else {
#pragma unroll
        for (int q = 0; q < 4; ++q) { const f32x4 t = *(const f32x4*)(aff + tid * 16 + 4 * q); key[4 * q] = __float_as_uint(t.x); key[4 * q + 1] = __float_as_uint(t.y); key[4 * q + 2] = __float_as_uint(t.z); key[4 * q + 3] = __float_as_uint(t.w); }
    }
#define TK_VALID(j) (isctx ? ((j) == 0 && tid < 256) : true)
    unsigned kmin; int sh;
    { float fmx = 0.f, fmn = 3.0e38f;
#pragma unroll
      for (int j = 0; j < 16; ++j) if (TK_VALID(j)) { fmx = fmaxf(fmx, __uint_as_float(key[j])); fmn = fminf(fmn, __uint_as_float(key[j])); }
      fmx = wave_max(fmx); fmn = -wave_max(-fmn);
      if (lane == 0) { wtot[wid] = __float_as_uint(fmx); wtot[8 + wid] = __float_as_uint(fmn); }
      __syncthreads();
      unsigned kmax = 0u; kmin = 0xffffffffu;
#pragma unroll
      for (int w = 0; w < 8; ++w) { kmax = max(kmax, wtot[w]); kmin = min(kmin, wtot[8 + w]); }
      __syncthreads();
      sh = 32 - __builtin_clz((kmax - kmin) | 1u);
#pragma unroll
      for (int j = 0; j < 16; ++j) key[j] -= kmin; }
    unsigned pfx = 0u, need = (unsigned)cap;
    while (sh > 0) { const int nb = sh < 8 ? sh : 8; sh -= nb; const int shift = sh; const unsigned dmask = (1u << nb) - 1u;
        for (int i = tid; i < 256; i += 512) hist[i] = 0u;
        __syncthreads();
#pragma unroll
        for (int j = 0; j < 16; ++j) if (TK_VALID(j) && (key[j] >> (shift + nb)) == pfx) __hip_atomic_fetch_add(&hist[(key[j] >> shift) & dmask], 1u, __ATOMIC_RELAXED, __HIP_MEMORY_SCOPE_WORKGROUP);
        __syncthreads();
        if (wid == 0) {
            const unsigned h0 = hist[4 * lane], h1 = hist[4 * lane + 1], h2 = hist[4 * lane + 2], h3 = hist[4 * lane + 3], s = h0 + h1 + h2 + h3;
            unsigned incl = s;
#pragma unroll
            for (int o = 1; o < 64; o <<= 1) { const unsigned t = (unsigned)__builtin_amdgcn_ds_bpermute(((lane + o) & 63) << 2, (int)incl); if (lane + o < 64) incl += t; }
            const unsigned excl = incl - s;
            if (excl < need && need <= incl) { unsigned c = excl; int bin;
                if (c + h3 >= need) bin = 3; else { c += h3; if (c + h2 >= need) bin = 2; else { c += h2; if (c + h1 >= need) bin = 1; else { c += h1; bin = 0; } } }
                sel[0] = (unsigned)(4 * lane + bin); sel[1] = need - c; }
        }
        __syncthreads();
        pfx = (pfx << nb) | sel[0]; need = sel[1];
        __syncthreads();
    }
    const unsigned T = pfx;
    unsigned ce = 0u;
#pragma unroll
    for (int j = 0; j < 16; ++j) ce += (TK_VALID(j) && key[j] == T) ? 1u : 0u;
    unsigned re = block_excl_scan(ce, wtot, lane, wid);
    unsigned selmask = 0u, cs = 0u;
#pragma unroll
    for (int j = 0; j < 16; ++j) if (TK_VALID(j)) { bool s = key[j] > T; if (key[j] == T) { s = re < need; ++re; } if (s) { selmask |= 1u << j; ++cs; } }
    unsigned slot = block_excl_scan(cs, wtot, lane, wid);
    int* IDXROW = (int*)(A->ws + WS_IDXROW); float* SCORE = (float*)(A->ws + WS_SCORE); int* INV = (int*)(A->ws + WS_INV);
    const int ybase = e * RT * 256 + (isctx ? 2048 + b * 32 : b * 1024);
#pragma unroll
    for (int j = 0; j < 16; ++j) if (TK_VALID(j)) { const int idx = isctx ? tid : tid * 16 + j; const int R = b * RB + (isctx ? idx : CTXL + idx);
        if (selmask & (1u << j)) { const int yrow = ybase + (int)slot; IDXROW[yrow] = R; SCORE[yrow] = __uint_as_float(key[j] + kmin); INV[((size_t)b * 16 + e) * RB + (R - b * RB)] = yrow; ++slot; }
        else INV[((size_t)b * 16 + e) * RB + (R - b * RB)] = -1; }
    if (isctx && b == 0 && tid < 192) IDXROW[e * RT * 256 + 2048 + 64 + tid] = -1;
#undef TK_VALID
    __syncthreads();
}

struct AJob { const attn_body::bf16 *Q, *K, *V; attn_body::bf16* O; int nt, mode, normed; const float* kmax; };
__device__ __forceinline__ bool mixer_job(unsigned char* ws, int l, int vcu, int i, AJob& j) {
    using attn_body::bf16;
    const bf16* QKV = (const bf16*)(ws + WS_QKV); bf16* YS = (bf16*)(ws + WS_YS); j.normed = 0; j.kmax = nullptr; const float* KNB = (const float*)(ws + WS_KNB) + l * 32;
    if (i < 3) { const int b = vcu >> 7, h = (vcu >> 5) & 3, qb = vcu & 31; const long q0 = (long)b * RB + CTXL + qb * 256, k0 = (long)b * RB;
        if (i < 2) { const int vh = 2 * h + i; j.Q = QKV + q0 * PQ + C_QB + vh * 64; j.K = QKV + k0 * PQ + C_KB + vh * 64; j.V = QKV + k0 * PQ + C_VB + h * 64; j.O = YS + q0 * 1024 + 256 + h * 64; j.nt = 132; j.mode = 1 + i; j.kmax = KNB + b * 8 + vh; }
        else { j.Q = QKV + q0 * PQ + C_QD + h * 64; j.K = QKV + k0 * PQ + C_KD + (h >> 1) * 64; j.V = QKV + k0 * PQ + C_VD + (h >> 1) * 64; j.O = YS + q0 * 1024 + 768 + h * 64; j.nt = 132; j.mode = 0; j.normed = 1; }
        return true; }
    if (l != 0) return false;
    const int uc = (vcu + 256 - 132) & 255; if (uc >= 24) return false;
    const int type = uc >> 3, b = (uc >> 2) & 1, h = uc & 3, k = i - 3; const long q0 = (long)b * RB;
    j.nt = 4;
    if (type == 0) { if (k > 0) return false; j.Q = QKV + q0 * PQ + C_QA + h * 64; j.K = QKV + q0 * PQ + C_KA + h * 64; j.V = QKV + q0 * PQ + C_VA + h * 64; j.O = YS + q0 * 1024 + h * 64; j.mode = 0; return true; }
    if (type == 1) { if (k > 1) return false; const int vh = 2 * h + k; j.Q = QKV + q0 * PQ + C_QB + vh * 64; j.K = QKV + q0 * PQ + C_KB + vh * 64; j.V = QKV + q0 * PQ + C_VB + h * 64; j.O = YS + q0 * 1024 + 256 + h * 64; j.mode = 1 + k; j.kmax = KNB + b * 8 + vh; return true; }
    if (k > 0) return false; j.Q = QKV + q0 * PQ + C_QD + h * 64; j.K = QKV + q0 * PQ + C_KD + (h >> 1) * 64; j.V = QKV + q0 * PQ + C_VD + (h >> 1) * 64; j.O = YS + q0 * 1024 + 768 + h * 64; j.mode = 0; j.normed = 1; return true;
}

__global__ void __launch_bounds__(512, 2) fwd_kernel(Args A_) {
    extern __shared__ __attribute__((aligned(16))) unsigned char lds[];
    LAS unsigned char* L = (LAS unsigned char*)lds;
    const int tid0 = threadIdx.x;
    const int G0 = gridDim.x, bx0 = blockIdx.x;
    unsigned char* ws = A_.ws;
    for (int u = tid0; u < (LDS_BYTES - LDSCTL_OFF) / 4; u += 512) ((LAS unsigned*)(L + LDSCTL_OFF))[u] = 0u;
    __syncthreads();
    XcdBarrier bar; bar.bar = (unsigned*)(ws + WS_CTL) + CW_BAR + A_.li * XCD_BAR_WORDS; bar.x = 0; bar.st = nullptr;
    if (!MK_PER_PHASE) bar = xcd_barrier_post((unsigned*)(ws + WS_CTL) + CW_BAR + A_.li * XCD_BAR_WORDS, (volatile LAS unsigned*)(L + MISC_OFF) + 8);
#define PHASE_PTRS KArgs A = opaque_kargs(); unsigned char* ws = A->ws; const int G = opaque_s(G0), bx = opaque_s(bx0), vcu = (bx % 8) * (G / 8) + bx / 8, wave = __builtin_amdgcn_readfirstlane(opaque_tid() >> 6), gw = vcu * 8 + wave, NGW = G * 8; (void)gw; (void)NGW; (void)vcu; const float* MOD = (const float*)(ws + WS_MOD); bf16_t* HN = (bf16_t*)(ws + WS_HN); bf16_t* H2 = (bf16_t*)(ws + WS_H2); bf16_t* YS = (bf16_t*)(ws + WS_YS); \
    bf16_t* GT = (bf16_t*)(ws + WS_GT); bf16_t* X1 = (bf16_t*)(ws + WS_X1); bf16_t* XR = (bf16_t*)(ws + WS_XR); float* PART = (float*)(ws + WS_PART); \
    (void)MOD; (void)HN; (void)H2; (void)YS; (void)GT; (void)X1; (void)XR; (void)PART;
    const int lo = A_.ph_lo, hi = A_.ph_hi;
#ifndef DBG_MASK
#define DBG_MASK 0xffffffffu
#endif
#define PHON(k) ((DBG_MASK >> ((k) < 2 ? (k) : 2 + ((k) - 2) % 10)) & 1u)
#define IN(k) (PHON(k) && lo <= (k) && (k) < hi)
#define SEAM(k) do { if (!MK_PER_PHASE && (k) + 1 < hi) { XcdBarrier b2_ = bar; b2_.bar = (unsigned*)opaque_ptr((unsigned char*)bar.bar); xcd_barrier(b2_); } } while (0)

    if (IN(0)) { PHASE_PTRS
        const int tid = opaque_tid(), lane = tid & 63; (void)tid; (void)lane;
        for (int item = bx; item < 192; item += G) mod_item(A, item, L, tid);
        __syncthreads();
        static_assert(DEPTH * CW_SMALL == 192 * 3 + 64 * 8, "small-weight items split 3 / 8");
        { const int cfirst = bx < 192 ? 3 * bx : 576 + 8 * (bx - 192), cn = bx < 192 ? 3 : 8; conv_run<true>(A, cfirst, 1, cfirst + cn, L, tid); }
        SEAM(0);
    }
    if (IN(1)) { PHASE_PTRS
        const int tid = opaque_tid(), lane = tid & 63; (void)tid; (void)lane;
        { const int Ra = gw * 9, Rb = min(Ra + 9, NR);
          Row xn = row_load(in_row(A, min(Ra, NR - 1)), lane), xn2 = row_load(in_row(A, min(Ra + 1, NR - 1)), lane), xn3 = row_load(in_row(A, min(Ra + 2, NR - 1)), lane);
          int cur = mod_row(min(Ra, NR - 1)); NormP np; { const float* m = MOD + (size_t)cur * 6144; np = normp_load(A->in[I_N1G], m, m + 1024, lane); }
          for (int R = Ra; R < Rb; ++R) { const Row x = xn; xn = xn2; xn2 = xn3; if (R + 3 < Rb) xn3 = row_load(in_row(A, R + 3), lane);
            const int mr = mod_row(R); if (mr != cur) { const float* m = MOD + (size_t)mr * 6144; np = normp_load(A->in[I_N1G], m, m + 1024, lane); cur = mr; }
            const Row y = row_normmod_p(x, row_rstd(x), np); row_store_bf16(HN + (size_t)R * DM, y, lane); row_store_fp8(ws + WS_HN8 + (size_t)R * DM, y, lane); } }
        __syncthreads();
        SEAM(1);
    }
    for (int l = 0; l < DEPTH; ++l) {
        const int P = 2 + 10 * l; const int RT = l == 0 ? 9 : 8;
#define LAYER_PTRS PHASE_PTRS unsigned char* wl = ws + WS_W0 + (size_t)l * W_LAYER; const float* MODL = MOD + (size_t)l * 3 * 6144; (void)wl; (void)MODL;
        if (IN(P + 0)) { LAYER_PTRS
            { SchedP1 S{(const char*)HN, (const char*)(wl + WO_WIN), l, G, bx};
              EpiInProj E{(bf16_t*)(ws + WS_QKV), GT, A->in[I_QG] + l * 64, A->in[I_KG] + l * 64, A->in[I_GATEB] + (size_t)l * 4096, (float*)(ws + WS_KNB) + l * 32};
              pg8::gemm_phase<EpiInProj, SchedP1>(L, DM, DM, DM, S, E); }
            { SchedP1g S{(const char*)(ws + WS_HN8), (const char*)(wl + WO_WING), l, G, bx}; EpiGates E{(unsigned char*)GT, A->in[I_GATEB] + (size_t)l * 4096};
              pg8::gemm8_phase<EpiGates, SchedP1g>(L, DM / 2, DM / 2, DM / 2, S, E); }
            SEAM(P + 0);
        }
        if (IN(P + 1)) { LAYER_PTRS
            const int tid = opaque_tid(), lane = tid & 63; (void)tid; (void)lane;
            float s1 = lane < 32 ? A->in[I_LQ1][l * 32 + lane] * A->in[I_LK1][l * 32 + lane] : 0.f, s2 = lane < 32 ? A->in[I_LQ2][l * 32 + lane] * A->in[I_LK2][l * 32 + lane] : 0.f;
            const float lam_init = l == 0 ? 0.2f : 0.35550906759096934f;
            const float lam = expf(wave_sum(s1)) - expf(wave_sum(s2)) + lam_init;
            const attn_body::DiffEpi de{lam, 1.0f - lam_init, A->in[I_SUBG] + l * 64};
            const float gqm = wave_max(fabsf(A->in[I_QG][l * 64 + lane])), gkm = wave_max(fabsf(A->in[I_KG][l * 64 + lane]));
            const bool gqa_nomax = __builtin_amdgcn_readfirstlane((int)(64.0f * gqm * gkm * C2A * 1.05f <= 40.0f)) != 0;
            const int cslot = vcu & 3, cbase = l * CW_LAYER + CW_SMALL + vcu * (CW_MOE / 256);
#define CONV_SEAM(k) do { if (cslot == (k)) conv_run(A, cbase, 1, cbase + CW_MOE / 256, L, opaque_tid()); } while (0)
            static_assert(CW_MOE % 256 == 0, "expert-weight items split evenly over 256 CUs");
            CONV_SEAM(0);
            AJob j;
            for (int i = 0; mixer_job(ws, l, vcu, i, j); ++i) {
                if (i == 2) CONV_SEAM(1);
                if (i == 3) CONV_SEAM(2);
                if (j.mode == 0) attn_body::attn_unit<8, 0>(j.Q, j.K, j.V, j.nt, j.O, (char*)lds, de, !(j.normed && gqa_nomax));
                else if (j.mode == 1) attn_body::attn_unit<8, 1>(j.Q, j.K, j.V, j.nt, j.O, (char*)lds, de, true, j.kmax);
                else attn_body::attn_unit<8, 2>(j.Q, j.K, j.V, j.nt, j.O, (char*)lds, de, true, j.kmax);
            }
            if (l != 0 || ((vcu + 256 - 132) & 255) >= 24) CONV_SEAM(2);
            { const int b = vcu >> 7, h = (vcu >> 5) & 3, g4 = vcu & 31;
              attn_body::na_unit(b, h, g4, (const attn_body::bf16*)(ws + WS_QKV), (attn_body::bf16*)YS, A->in[I_RPB] + ((size_t)l * 4 + h) * 465, (char*)lds, (const float*)(ws + WS_KNB) + l * 32 + 16 + b * 4 + h); }
            CONV_SEAM(3);
            const int nsgu = 128 + (l == 0 ? 4 : 0);
            if (vcu < nsgu) { const long rowbase = vcu < 128 ? (long)(vcu >> 6) * RB + CTXL + (vcu & 63) * 128 : (long)((vcu - 128) >> 1) * RB + ((vcu - 128) & 1) * 128;
                sgu_unit(rowbase, (const bf16_t*)(ws + WS_QKV) + C_GU, (const bf16_t*)(ws + WS_QKV) + C_GV, A->in[I_SGUNG] + l * 256, A->in[I_SGUW] + (size_t)l * 4 * 128 * 128, A->in[I_SGUB] + l * 4 * 128, YS, (char*)lds); }
            SEAM(P + 1);
        }
        if (IN(P + 2)) { LAYER_PTRS
            SchedP3a S{(const char*)YS, (const char*)(wl + WO_WB), l, G, bx}; EpiGateAcc E{(const unsigned char*)GT, (bf16_t*)(ws + WS_MRG), (bf16_t*)(ws + WS_GPC)};
            pg8::gemm_phase<EpiGateAcc, SchedP3a>(L, 256, DM, 256, S, E);
            SEAM(P + 2);
        }
        if (IN(P + 3)) { LAYER_PTRS
            { SchedP3b S{(const char*)(ws + WS_MRG), (const char*)(wl + WO_WO4), G, bx}; EpiOutRes E{A->in[I_X], A->in[I_CTX], XR, X1, MODL, l};
              pg8::gemm_phase<EpiOutRes, SchedP3b>(L, DM, DM, DM, S, E); }
            if (l == 0) { SchedP3c S{(const char*)(ws + WS_GPC), (const char*)(wl + WO_WO4), G, bx}; EpiPart E{PART};
              pg8::gemm_phase<EpiPart, SchedP3c>(L, 256, DM, DM, S, E); }
            SEAM(P + 3);
        }
        if (IN(P + 4)) { LAYER_PTRS
            const int tid = opaque_tid(), lane = tid & 63; (void)tid; (void)lane;
            LAS float* wrT = (LAS float*)L;
            const float* wr = A->in[I_WRT] + (size_t)l * DM * 16;
            { f32x4 wv[8];
#pragma unroll
              for (int q = 0; q < 8; ++q) wv[q] = ((const f32x4*)wr)[tid + 512 * q];
              __builtin_amdgcn_sched_barrier(0);
#pragma unroll
              for (int q = 0; q < 8; ++q) { const int i4 = tid + 512 * q, k = i4 >> 2, e0 = (i4 & 3) * 4;
#pragma unroll
                  for (int j = 0; j < 4; ++j) wrT[(e0 + j) * DM + k] = wv[q][j]; } }
            __syncthreads();
            const int nit = 8 + ((l == 0 && gw < 512) ? 1 : 0);
            Row xn; { const int i0 = gw * 8; xn = row_load_bf16(X1 + ((size_t)(i0 >> 13) * RB + CTXL + (i0 & 8191)) * DM, lane); }
            NormP np; { const float* m0 = MODL + (size_t)((gw * 8) >> 13) * 6144; np = normp_load(A->in[I_N2G] + l * DM, m0 + 3072, m0 + 4096, lane); }
            for (int it = 0; it < nit; ++it) { const int i = it < 8 ? gw * 8 + it : 16384 + gw; const bool isctx = i >= 16384; const int b = isctx ? (i - 16384) >> 8 : i >> 13, r = isctx ? (i - 16384) & 255 : CTXL + (i & 8191); const int R = b * RB + r;
                const float* m = MODL + (size_t)(isctx ? 2 : b) * 6144;
                Row x = xn;
                if (it + 1 < 8) { const int in = i + 1; xn = row_load_bf16(X1 + ((size_t)(in >> 13) * RB + CTXL + (in & 8191)) * DM, lane); }
                if (isctx) { x = row_load(in_row(A, R), lane); Row s;
#pragma unroll
                    for (int j = 0; j < 4; ++j) s.v[j] = (f32x4){0.f, 0.f, 0.f, 0.f};
                    for (int ks = 0; ks < 16; ks += 4) { Row p[4];
#pragma unroll
                        for (int q = 0; q < 4; ++q) p[q] = row_load(PART + ((size_t)(ks + q) * 512 + b * 256 + r) * DM, lane);
                        __builtin_amdgcn_sched_barrier(0);
#pragma unroll
                        for (int q = 0; q < 4; ++q)
#pragma unroll
                            for (int j = 0; j < 4; ++j) s.v[j] += p[q].v[j]; }
#pragma unroll
                    for (int j = 0; j < 4; ++j) x.v[j] += ((const f32x4*)(m + 2048))[lane + 64 * j] * s.v[j];
                    row_store_bf16(X1 + (size_t)R * DM, x, lane);
                }
                if (isctx) np = normp_load(A->in[I_N2G] + l * DM, m + 3072, m + 4096, lane);
                const Row h = row_normmod_p(x, row_rstd(x), np);
                { unsigned* hq = (unsigned*)((unsigned char*)H2 + (size_t)R * DM) + lane;
#pragma unroll
                  for (int j = 0; j < 4; ++j) hq[64 * j] = pk8(h.v[j].x, h.v[j].y, h.v[j].z, h.v[j].w); }
                float lg[16];
#pragma unroll
                for (int e = 0; e < 16; ++e) { f32x2 a2 = (f32x2){0.f, 0.f};
#pragma unroll
                    for (int j = 0; j < 4; ++j) { const f32x4 w = *(const LAS f32x4*)(wrT + e * DM + 4 * lane + 256 * j);
                        a2 = __builtin_elementwise_fma((f32x2){h.v[j].x, h.v[j].y}, (f32x2){w.x, w.y}, a2); a2 = __builtin_elementwise_fma((f32x2){h.v[j].z, h.v[j].w}, (f32x2){w.z, w.w}, a2); }
                    lg[e] = a2.x + a2.y; if ((e & 3) == 3) __builtin_amdgcn_sched_barrier(0); }
                float c8[8], d[4];
#pragma unroll
                for (int i = 0; i < 8; ++i) { auto rr = __builtin_amdgcn_permlane32_swap(__float_as_uint(lg[i]), __float_as_uint(lg[i + 8]), false, false); c8[i] = __uint_as_float(rr[0]) + __uint_as_float(rr[1]); }
#pragma unroll
                for (int i = 0; i < 4; ++i) { auto rr = __builtin_amdgcn_permlane16_swap(__float_as_uint(c8[i]), __float_as_uint(c8[i + 4]), false, false); d[i] = row16_sum(__uint_as_float(rr[0]) + __uint_as_float(rr[1])); }
                float mx = fmaxf(fmaxf(d[0], d[1]), fmaxf(d[2], d[3]));
                { auto rr = __builtin_amdgcn_permlane16_swap(__float_as_uint(mx), __float_as_uint(mx), false, false); mx = fmaxf(__uint_as_float(rr[0]), __uint_as_float(rr[1])); }
                { auto rr = __builtin_amdgcn_permlane32_swap(__float_as_uint(mx), __float_as_uint(mx), false, false); mx = fmaxf(__uint_as_float(rr[0]), __uint_as_float(rr[1])); }
#pragma unroll
                for (int i = 0; i < 4; ++i) d[i] = __expf(d[i] - mx);
                const float sum = xor32_sum(xor16_sum((d[0] + d[1]) + (d[2] + d[3])));
                const int li = lane & 15, ex = 4 * (lane >> 4) + li;
                float mine = li == 0 ? d[0] : li == 1 ? d[1] : li == 2 ? d[2] : d[3];
                mine = mine / sum;
                if (li < 4) { if (isctx) ((float*)(ws + WS_AFFC))[((size_t)b * 16 + ex) * 256 + r] = mine; else ((float*)(ws + WS_AFFL))[((size_t)b * 16 + ex) * 8192 + (r - CTXL)] = mine; }
            }
            SEAM(P + 4);
        }
        if (IN(P + 5)) { LAYER_PTRS
            const int tid = opaque_tid(), lane = tid & 63; (void)tid; (void)lane;
            const int nun = l == 0 ? 64 : 32;
            for (int u = vcu; u < nun; u += G) topk_unit(A, RT, u >= 32, (u >> 4) & 1, u & 15, L, tid);
            SEAM(P + 5);
        }
        if (IN(P + 6)) { LAYER_PTRS
            const int tid = opaque_tid(), lane = tid & 63; (void)tid; (void)lane;
            const int* IDXROW = (const int*)(ws + WS_IDXROW); unsigned char* XG = ws + WS_XG;
            const int nyr = 16 * RT * 256;
            for (int y0 = gw; y0 < nyr; y0 += 9 * NGW) { int src[9]; v4u a[9];
#pragma unroll
                for (int q = 0; q < 9; ++q) { const int y = y0 + q * NGW; src[q] = y < nyr ? IDXROW[y] : -1; }
                __builtin_amdgcn_sched_barrier(0);
#pragma unroll
                for (int q = 0; q < 9; ++q) { a[q] = (v4u){0u, 0u, 0u, 0u}; if (src[q] >= 0) a[q] = ((const v4u*)((const unsigned char*)H2 + (size_t)src[q] * DM))[lane]; }
                __builtin_amdgcn_sched_barrier(0);
#pragma unroll
                for (int q = 0; q < 9; ++q) { const int y = y0 + q * NGW; if (y < nyr) ((v4u*)(XG + (size_t)y * DM))[lane] = a[q]; } }
            SEAM(P + 6);
        }
        if (IN(P + 7)) { LAYER_PTRS
            SchedP6 S{(const char*)(ws + WS_XG), (const char*)(wl + WO_WGU), RT, G, bx}; EpiSwiGLU E{ws + WS_HID};
            pg8::gemm8_phase<EpiSwiGLU, SchedP6>(L, DM / 2, DM / 2, DM / 2, S, E);
            SEAM(P + 7);
        }
        if (IN(P + 8)) { LAYER_PTRS
            SchedP7 S{(const char*)(ws + WS_HID), (const char*)(wl + WO_WD), RT, G, bx}; EpiDown E{(bf16_t*)(ws + WS_Y), (const float*)(ws + WS_SCORE)};
            pg8::gemm8_phase<EpiDown, SchedP7>(L, EH / 2, EH / 2, EH / 2, S, E);
            if (l == 0) { SchedP7c S2{(const char*)(ws + WS_HID), (const char*)(wl + WO_WD), G, bx}; EpiDownPart E2{(bf16_t*)(ws + WS_XG), (const float*)(ws + WS_SCORE)};
              pg8::gemm8_phase<EpiDownPart, SchedP7c>(L, 256, EH / 2, EH / 2, S2, E2); }
            SEAM(P + 8);
        }
        if (IN(P + 9)) { LAYER_PTRS
            const int tid = opaque_tid(), lane = tid & 63; (void)tid; (void)lane;
            const int* INV = (const int*)(ws + WS_INV); const bf16_t* Y = (const bf16_t*)(ws + WS_Y);
#define P8_INV(R_) (lane < 16 ? INV[((size_t)((R_) / RB) * 16 + lane) * RB + (R_) % RB] : -1)
#define P8_YISSUE(INVV, W, KEEP, REST) do { unsigned mk_ = (unsigned)(__ballot((INVV) >= 0) & 0xffffull); \
                _Pragma("unroll") for (int k = 0; k < 4; ++k) { const bool have = mk_ != 0u; const int e = have ? __builtin_ctz(mk_) : 0; mk_ &= mk_ - 1u; \
                    const int yr = have ? __builtin_amdgcn_readlane((INVV), e) : 0; const v2u* yp = (const v2u*)(Y + (size_t)yr * DM) + lane; KEEP[k] = have ? 0xffffffffu : 0u;     \
                    if (have) { _Pragma("unroll") for (int j = 0; j < 4; ++j) W[k][j] = yp[64 * j]; } else { _Pragma("unroll") for (int j = 0; j < 4; ++j) W[k][j] = (v2u){0u, 0u}; } } REST = mk_; } while (0)
            Row xn; int invn, invf; v2u wn[4][4]; unsigned kn[4], restn;
#define P8_ROW(k) ((k) < 8 ? (((gw * 8 + (k)) >> 13) * RB + CTXL + ((gw * 8 + (k)) & 8191)) : ((gw >> 8) * RB + (gw & 255)))
            const int nit = 8 + ((l == 0 && gw < 512) ? 1 : 0);
            { const int R0 = P8_ROW(0); xn = row_load_bf16(X1 + (size_t)R0 * DM, lane); invn = P8_INV(R0); P8_YISSUE(invn, wn, kn, restn); const int R1 = P8_ROW(1); invf = P8_INV(R1); }
            int curm; NormP np; f32x4 g2v[4];
#define P8_PARAMS(mr_) do { const float* m_ = MODL + (size_t)(mr_) * 6144; \
                _Pragma("unroll") for (int j = 0; j < 4; ++j) g2v[j] = ((const f32x4*)(m_ + 5120))[lane + 64 * j]; \
                if (l + 1 < DEPTH) { const float* m1 = MOD + ((size_t)(l + 1) * 3 + (mr_)) * 6144; np = normp_load(A->in[I_N1G] + (l + 1) * DM, m1, m1 + 1024, lane); } \
                else { _Pragma("unroll") for (int j = 0; j < 4; ++j) { np.a[j] = ((const f32x4*)A->in[I_FG])[lane + 64 * j]; np.h[j] = np.a[j]; } } \
                __builtin_amdgcn_sched_barrier(0); } while (0)
            { curm = (gw * 8) >> 13; P8_PARAMS(curm); }
            for (int k9 = 0; k9 < nit; ++k9) { const int R = P8_ROW(k9); const int b = R / RB, r = R % RB; const bool isctx = r < CTXL;
                Row x = xn; const int myinv = invn; v2u w0[4][4]; unsigned k0[4]; unsigned msk = restn;
#pragma unroll
                for (int k = 0; k < 4; ++k) { k0[k] = kn[k];
#pragma unroll
                    for (int j = 0; j < 4; ++j) w0[k][j] = wn[k][j]; }
                if (k9 + 1 < nit) { const int Rn = P8_ROW(k9 + 1); xn = row_load_bf16(X1 + (size_t)Rn * DM, lane); invn = invf; P8_YISSUE(invn, wn, kn, restn); const int Rf = P8_ROW(min(k9 + 2, nit - 1)); invf = P8_INV(Rf); }
                if (l == 1 && isctx) continue;
                const float* m = MODL + (size_t)(isctx ? 2 : b) * 6144;
                Row s;
#pragma unroll
                for (int j = 0; j < 4; ++j) s.v[j] = (f32x4){0.f, 0.f, 0.f, 0.f};
#pragma unroll
                for (int k = 0; k < 4; ++k)
#pragma unroll
                    for (int j = 0; j < 4; ++j) s.v[j] += (f32x4){bflo(w0[k][j].x & k0[k]), bfhi(w0[k][j].x & k0[k]), bflo(w0[k][j].y & k0[k]), bfhi(w0[k][j].y & k0[k])};
                if (isctx) {
#pragma unroll
                    for (int j = 0; j < 4; ++j) s.v[j] = (f32x4){0.f, 0.f, 0.f, 0.f};
                    msk = 0u; unsigned mk = (unsigned)(__ballot(myinv >= 0) & 0xffffull); const bf16_t* YP = (const bf16_t*)(ws + WS_XG);
                    while (mk) { const int e = __builtin_ctz(mk); mk &= mk - 1u; const int yr = __builtin_amdgcn_readlane(myinv, e); const int ex = yr / 2304, rr = yr % 2304 - 2048;
                        v2u t[4][4];
#pragma unroll
                        for (int kq = 0; kq < 4; ++kq) { const v2u* yp = (const v2u*)(YP + ((size_t)(kq * 16 + ex) * 256 + rr) * DM) + lane;
#pragma unroll
                            for (int j = 0; j < 4; ++j) t[kq][j] = yp[64 * j]; }
                        __builtin_amdgcn_sched_barrier(0);
#pragma unroll
                        for (int kq = 0; kq < 4; ++kq)
#pragma unroll
                            for (int j = 0; j < 4; ++j) s.v[j] += (f32x4){bflo(t[kq][j].x), bfhi(t[kq][j].x), bflo(t[kq][j].y), bfhi(t[kq][j].y)}; } }
                while (msk) {
                    v2u w[4][4];
#pragma unroll
                    for (int k = 0; k < 4; ++k) { const bool have = msk != 0u; const int e = have ? __builtin_ctz(msk) : 0; msk &= msk - 1u; if (!have) msk = 0u;
                        const int yr = have ? __builtin_amdgcn_readlane(myinv, e) : 0;
                        const v2u* yp = (const v2u*)(Y + (size_t)yr * DM) + lane; const unsigned keep = have ? 0xffffffffu : 0u;
#pragma unroll
                        for (int j = 0; j < 4; ++j) { v2u t = yp[64 * j]; t.x &= keep; t.y &= keep; w[k][j] = t; } }
#pragma unroll
                    for (int k = 0; k < 4; ++k)
#pragma unroll
                        for (int j = 0; j < 4; ++j) s.v[j] += (f32x4){bflo(w[k][j].x), bfhi(w[k][j].x), bflo(w[k][j].y), bfhi(w[k][j].y)};
                }
                { const int mr = isctx ? 2 : b; if (mr != curm) { curm = mr; P8_PARAMS(mr); } }
#pragma unroll
                for (int j = 0; j < 4; ++j) x.v[j] += g2v[j] * s.v[j];
                const float rstd = row_rstd(x);
                if (l + 1 < DEPTH) { row_store_bf16(XR + (size_t)R * DM, x, lane);
                    const Row y = row_normmod_p(x, rstd, np); row_store_bf16(HN + (size_t)R * DM, y, lane); if (!isctx) row_store_fp8(ws + WS_HN8 + (size_t)R * DM, y, lane); }
                else { Row y;
#pragma unroll
                    for (int j = 0; j < 4; ++j) y.v[j] = x.v[j] * rstd * np.a[j];
                    row_store(A->out + ((size_t)b * SEQ + (r - CTXL)) * DM, y, lane); }
            }
            SEAM(P + 9);
        }
    }
#undef IN
#undef SEAM
}

extern "C" void kernel_launch(void* const* d_in, const int* in_sizes, int n_in, void* d_out, int out_size, void* d_ws, size_t ws_size, hipStream_t stream) {
    static int grid = 0;
    if (grid == 0) {
        if (n_in != 28 || out_size != NB * SEQ * DM || ws_size < WS_END) { fprintf(stderr, "kernel_launch: unexpected shapes (n_in %d, out %d, ws %zu < %zu)\n", n_in, out_size, ws_size, (size_t)WS_END); grid = -1; return; }
        int dev = 0, cus = 0, per_cu = 0;
        if (hipGetDevice(&dev) != hipSuccess || hipDeviceGetAttribute(&cus, hipDeviceAttributeMultiprocessorCount, dev) != hipSuccess) { grid = -1; return; }
        if (hipFuncSetAttribute((const void*)fwd_kernel, hipFuncAttributeMaxDynamicSharedMemorySize, LDS_BYTES) != hipSuccess) { fprintf(stderr, "kernel_launch: hipFuncSetAttribute failed\n"); grid = -1; return; }
        if (hipOccupancyMaxActiveBlocksPerMultiprocessor(&per_cu, (const void*)fwd_kernel, 512, LDS_BYTES) != hipSuccess || per_cu < 1) fprintf(stderr, "kernel_launch: occupancy query reports %d blocks/CU\n", per_cu);
        (void)hipGetLastError();
        if (cus != 256) { fprintf(stderr, "kernel_launch: built for 256 CUs, device has %d\n", cus); grid = -1; return; }
        grid = 256;
    }
    if (grid < 0) return;
    (void)hipMemsetAsync((char*)d_ws + WS_CTL, 0, CTL_ZERO_BYTES, stream);
    Args a{};
    for (int i = 0; i < 28; ++i) a.in[i] = (const float*)d_in[i];
    a.out = (float*)d_out; a.ws = (unsigned char*)d_ws;
#if MK_PER_PHASE
    for (int p = 0; p < NPHASE; ++p) { a.ph_lo = p; a.ph_hi = p + 1; hipLaunchKernelGGL(fwd_kernel, dim3(grid), dim3(512), LDS_BYTES, stream, a); }
#elif defined(PROBE_REPEAT)
    { const int reps[] = {PROBE_REPEAT}; const int nr = sizeof(reps) / sizeof(int); int lo = 0;
      for (int i = 0; i <= nr; ++i) { a.ph_lo = lo; a.ph_hi = i < nr ? reps[i] + 1 : NPHASE; a.li = i; hipLaunchKernelGGL(fwd_kernel, dim3(grid), dim3(512), LDS_BYTES, stream, a); if (i < nr) lo = reps[i]; } }
#else
    a.ph_lo = 0; a.ph_hi = NPHASE; hipLaunchKernelGGL(fwd_kernel, dim3(grid), dim3(512), LDS_BYTES, stream, a);
#endif
}
```
